# Optimizing an MI355X kernel written in HIP

```python
import math
import jax
import jax.numpy as jnp
from jax import lax
import numpy as np

D_MODEL = 2048
BATCH = 4
SEQ = 2048
DEPTH = 2
DEC_BATCH = 128
DEC_SEQ = 4
PAST_LEN = 16384
PAGE_SIZE = 128

N_EVEN = (DEPTH + 1) // 2
N_ODD = DEPTH // 2
CHUNK = 64
EPS = 1e-6
F32 = jnp.float32

SSD_HEADS = 32
SSD_HEAD_DIM = 64
D_SSD = SSD_HEADS * SSD_HEAD_DIM
SSD_GROUPS = 4
SSD_STATE = 128
SSD_CONV = 4
SSD_CONV_DIM = D_SSD + 2 * SSD_GROUPS * SSD_STATE
RET_HEADS = 8
RET_DK = 128
RET_DV = 256
RET_QK = RET_HEADS * RET_DK
D_RET = RET_HEADS * RET_DV
ROPE_BASE = 10000.0
HG_HEADS = 16
HG_DK = 128
HG_DV = 128
D_HG_K = HG_HEADS * HG_DK
D_HG = HG_HEADS * HG_DV
D_RNN = 2048
LRU_BLOCKS = 8
LRU_BW = D_RNN // LRU_BLOCKS
LRU_CONV = 4
LRU_C = 8.0
D_FF = 5632
FFN_CONV = 3

SIZES_EVEN = (D_SSD, SSD_CONV_DIM, SSD_HEADS, RET_QK, RET_QK, D_RET, D_RET)
SIZES_ODD = (D_HG_K, D_HG_K, D_HG, D_HG, D_RNN, D_RNN)
D_IN_EVEN = sum(SIZES_EVEN)
D_IN_ODD = sum(SIZES_ODD)
D_MIX_EVEN = D_SSD + D_RET
D_MIX_ODD = D_HG + D_RNN
STATE_KEYS = ('ssm', 'ssm_conv', 'ret', 'hgrn', 'lru', 'lru_conv', 'ffn_conv')

kernel_name = 'hybrid_ssd_retention_hgrn2_rglru_step'


def split_cols(t, sizes):
    idx = [int(i) for i in np.cumsum(sizes)[:-1]]
    return jnp.split(t, idx, axis=-1)


def rmsnorm(x, w):
    xf = x.astype(F32)
    y = xf * lax.rsqrt(jnp.mean(xf * xf, axis=-1, keepdims=True) + EPS)
    return (y * w.astype(F32)).astype(x.dtype)


def _normalize(x):
    return x * lax.rsqrt(jnp.mean(x * x, axis=-1, keepdims=True) + EPS)


def causal_dwconv(x, prev, w, b):
    width = w.shape[0]
    length = x.shape[1]
    xp = jnp.concatenate([prev.astype(x.dtype), x], axis=1)
    out = b.astype(x.dtype) + sum(xp[:, j:j + length] * w[j].astype(x.dtype) for j in range(width))
    return out, xp[:, length:]


def rotary(x, pos):
    half = x.shape[-1] // 2
    inv = ROPE_BASE ** (-jnp.arange(half, dtype=F32) / half)
    ang = pos.astype(F32)[:, None] * inv[None, :]
    cos = jnp.cos(ang)[None, :, None, :]
    sin = jnp.sin(ang)[None, :, None, :]
    x1, x2 = x[..., :half], x[..., half:]
    return jnp.concatenate([x1 * cos - x2 * sin, x1 * sin + x2 * cos], axis=-1)


def chunked_linear_recurrence(q, k, v, log_a, s0):
    bsz, length, heads, _ = q.shape
    c = math.gcd(length, CHUNK)
    n_chunks = length // c
    scalar = log_a.shape[-1] == 1

    def to_chunks(t):
        return jnp.moveaxis(t.reshape((bsz, n_chunks, c) + t.shape[2:]), 1, 0)

    causal = jnp.tril(jnp.ones((c, c), dtype=bool))[None, :, :, None, None]

    def step(s, inp):
        qc, kc, vc, la = inp
        cum = jnp.cumsum(la, axis=1)
        last = cum[:, -1]
        diff = cum[:, :, None] - cum[:, None, :]
        dec = jnp.exp(jnp.where(causal, diff, -jnp.inf))
        if scalar:
            scores = jnp.einsum('bihk,bjhk->bijh', qc, kc) * dec[..., 0]
        else:
            scores = jnp.einsum('bihk,bjhk,bijhk->bijh', qc, kc, dec)
        o = (jnp.einsum('bijh,bjhv->bihv', scores, vc)
             + jnp.einsum('bihk,bhkv->bihv', qc * jnp.exp(cum), s))
        s_new = (jnp.exp(last)[..., None] * s
                 + jnp.einsum('bjhk,bjhv->bhkv', kc * jnp.exp(last[:, None] - cum), vc))
        return s_new, o

    s_fin, o = lax.scan(step, s0.astype(F32),
                        (to_chunks(q), to_chunks(k), to_chunks(v), to_chunks(log_a)))
    o = jnp.moveaxis(o, 0, 1).reshape(bsz, length, heads, v.shape[-1])
    return o, s_fin


def even_mixer(h, s_ssm, s_conv, s_ret, pos, prm, j):
    bsz, length, _ = h.shape
    proj = h @ prm['even_w_in'][j]
    z, xbc, dt_raw, q, k, v, g = split_cols(proj, SIZES_EVEN)
    xbc, conv_new = causal_dwconv(xbc, s_conv, prm['ssd_conv_w'][j], prm['ssd_conv_b'][j])
    xbc = jax.nn.silu(xbc.astype(F32))
    xs, bm, cm = split_cols(xbc, (D_SSD, SSD_GROUPS * SSD_STATE, SSD_GROUPS * SSD_STATE))
    xs = xs.reshape(bsz, length, SSD_HEADS, SSD_HEAD_DIM)
    rep = SSD_HEADS // SSD_GROUPS
    bh = jnp.repeat(bm.reshape(bsz, length, SSD_GROUPS, SSD_STATE), rep, axis=2)
    ch = jnp.repeat(cm.reshape(bsz, length, SSD_GROUPS, SSD_STATE), rep, axis=2)
    dt = jax.nn.softplus(dt_raw.astype(F32) + prm['ssd_dt_bias'][j].astype(F32))
    a = -jnp.exp(prm['ssd_A_log'][j].astype(F32))
    y, ssm_new = chunked_linear_recurrence(ch, bh, xs * dt[..., None], (dt * a)[..., None], s_ssm)
    y = y + prm['ssd_D'][j].astype(F32)[:, None] * xs
    y = y.reshape(bsz, length, D_SSD) * jax.nn.silu(z.astype(F32))
    y = _normalize(y.reshape(bsz, length, SSD_GROUPS, D_SSD // SSD_GROUPS)).reshape(bsz, length, D_SSD)
    y = y * prm['ssd_norm_w'][j].astype(F32)
    qr = rotary(q.astype(F32).reshape(bsz, length, RET_HEADS, RET_DK), pos)
    kr = rotary(k.astype(F32).reshape(bsz, length, RET_HEADS, RET_DK), pos) * (RET_DK ** -0.5)
    vr = v.astype(F32).reshape(bsz, length, RET_HEADS, RET_DV)
    log_gamma = jnp.log1p(-jnp.exp(jnp.linspace(math.log(1.0 / 32.0), math.log(1.0 / 512.0), RET_HEADS, dtype=F32)))
    log_g = jnp.broadcast_to(log_gamma[None, None, :, None], (bsz, length, RET_HEADS, 1))
    o, ret_new = chunked_linear_recurrence(qr, kr, vr, log_g, s_ret)
    o = _normalize(o).reshape(bsz, length, D_RET) * jax.nn.silu(g.astype(F32))
    mix = jnp.concatenate([y, o], axis=-1).astype(h.dtype) @ prm['even_w_out'][j]
    return mix, ssm_new, conv_new, ret_new


def lru_combine(c1, c2):
    a1, b1 = c1
    a2, b2 = c2
    return a1 * a2, a2 * b1 + b2


def odd_mixer(h, s_hg, s_lru, s_lconv, pos, lb, prm, j):
    bsz, length, _ = h.shape
    proj = h @ prm['odd_w_in'][j]
    hq, hf, hi, hg, rx, rg = split_cols(proj, SIZES_ODD)
    q = jax.nn.silu(hq.astype(F32)).reshape(bsz, length, HG_HEADS, HG_DK)
    f = (lb + (1.0 - lb) * jax.nn.sigmoid(hf.astype(F32))).reshape(bsz, length, HG_HEADS, HG_DK)
    i = hi.astype(F32).reshape(bsz, length, HG_HEADS, HG_DV)
    og, hg_new = chunked_linear_recurrence(q, 1.0 - f, i, jnp.log(f), s_hg)
    og = (_normalize(og) * prm['hg_norm_w'][j].astype(F32)).reshape(bsz, length, D_HG)
    og = og * jax.nn.silu(hg.astype(F32))
    xr, lconv_new = causal_dwconv(rx, s_lconv, prm['lru_conv_w'][j], prm['lru_conv_b'][j])
    xr = xr.astype(F32)
    xb = xr.reshape(bsz, length, LRU_BLOCKS, LRU_BW)
    r = jax.nn.sigmoid(jnp.einsum('blnc,ncd->blnd', xb, prm['lru_w_r'][j].astype(F32)).reshape(bsz, length, D_RNN)
                       + prm['lru_b_r'][j].astype(F32))
    gi = jax.nn.sigmoid(jnp.einsum('blnc,ncd->blnd', xb, prm['lru_w_i'][j].astype(F32)).reshape(bsz, length, D_RNN)
                        + prm['lru_b_i'][j].astype(F32))
    log_a = -LRU_C * r * jax.nn.softplus(-prm['lru_a_param'][j].astype(F32))
    a = jnp.exp(log_a)
    mult = jnp.where((pos == 0)[None, :, None], 1.0, jnp.sqrt(-jnp.expm1(2.0 * log_a)))
    b = mult * gi * xr
    b = b.at[:, 0].add(a[:, 0] * s_lru.astype(F32))
    _, hs = lax.associative_scan(lru_combine, (a, b), axis=1)
    yl = hs * jax.nn.gelu(rg.astype(F32))
    mix = jnp.concatenate([og, yl], axis=-1).astype(h.dtype) @ prm['odd_w_out'][j]
    return mix, hg_new, hs[:, -1], lconv_new


def conv_ffn(h, prev, prm, l):
    up = h @ prm['ffn_w_up'][l]
    g, u = up[..., :D_FF], up[..., D_FF:]
    g, buf = causal_dwconv(g, prev, prm['ffn_conv_w'][l], prm['ffn_conv_b'][l])
    act = (jax.nn.silu(g.astype(F32)) * u.astype(F32)).astype(h.dtype)
    return act @ prm['ffn_w_down'][l], buf


def zero_states(bsz, dtype):
    return {
        'ssm': jnp.zeros((N_EVEN, bsz, SSD_HEADS, SSD_STATE, SSD_HEAD_DIM), dtype),
        'ssm_conv': jnp.zeros((N_EVEN, bsz, SSD_CONV - 1, SSD_CONV_DIM), dtype),
        'ret': jnp.zeros((N_EVEN, bsz, RET_HEADS, RET_DK, RET_DV), dtype),
        'hgrn': jnp.zeros((N_ODD, bsz, HG_HEADS, HG_DK, HG_DV), dtype),
        'lru': jnp.zeros((N_ODD, bsz, D_RNN), dtype),
        'lru_conv': jnp.zeros((N_ODD, bsz, LRU_CONV - 1, D_RNN), dtype),
        'ffn_conv': jnp.zeros((DEPTH, bsz, FFN_CONV - 1, D_FF), dtype),
    }


def trunk(x, st, pos0, prm):
    length = x.shape[1]
    pos = pos0 + jnp.arange(length, dtype=jnp.int32)
    lbs = jnp.cumsum(jax.nn.softmax(prm['hg_lower_bounds'].astype(F32), axis=0), axis=0)
    lbs = lbs - lbs[0]
    new = {name: [] for name in STATE_KEYS}
    for l in range(DEPTH):
        j = l // 2
        h = rmsnorm(x, prm['norm_mix'][l])
        if l % 2 == 0:
            mix, s1, s2, s3 = even_mixer(h, st['ssm'][j], st['ssm_conv'][j], st['ret'][j], pos, prm, j)
            new['ssm'].append(s1)
            new['ssm_conv'].append(s2)
            new['ret'].append(s3)
        else:
            mix, s1, s2, s3 = odd_mixer(h, st['hgrn'][j], st['lru'][j], st['lru_conv'][j], pos, lbs[l], prm, j)
            new['hgrn'].append(s1)
            new['lru'].append(s2)
            new['lru_conv'].append(s3)
        x = x + mix.astype(x.dtype)
        f, s4 = conv_ffn(rmsnorm(x, prm['norm_ffn'][l]), st['ffn_conv'][l], prm, l)
        new['ffn_conv'].append(s4)
        x = x + f.astype(x.dtype)
    y = rmsnorm(x, prm['norm_final'])
    return y, {name: jnp.stack(vals).astype(x.dtype) for name, vals in new.items()}


def setup_inputs(seed: int = 0) -> dict:
    key = jax.random.key(seed)
    keys = iter(jax.random.split(key, 48))

    def nrm(shape, scale):
        return scale * jax.random.normal(next(keys), shape, F32)

    def unif(shape, lo, hi):
        return jax.random.uniform(next(keys), shape, F32, lo, hi)

    dt0 = jnp.exp(unif((N_EVEN, SSD_HEADS), math.log(1e-3), math.log(1e-1)))
    a0 = unif((N_ODD, D_RNN), 0.9, 0.999)
    return {
        'x_prompt': nrm((BATCH, SEQ, D_MODEL), 1.0),
        'x_sample': nrm((DEC_BATCH, DEC_SEQ, D_MODEL), 1.0),
        'state_ssm': nrm((N_EVEN, DEC_BATCH, SSD_HEADS, SSD_STATE, SSD_HEAD_DIM), 0.5),
        'state_ssm_conv': nrm((N_EVEN, DEC_BATCH, SSD_CONV - 1, SSD_CONV_DIM), 1.0),
        'state_ret': nrm((N_EVEN, DEC_BATCH, RET_HEADS, RET_DK, RET_DV), 0.5),
        'state_hgrn': nrm((N_ODD, DEC_BATCH, HG_HEADS, HG_DK, HG_DV), 0.5),
        'state_lru': nrm((N_ODD, DEC_BATCH, D_RNN), 0.5),
        'state_lru_conv': nrm((N_ODD, DEC_BATCH, LRU_CONV - 1, D_RNN), 1.0),
        'state_ffn_conv': nrm((DEPTH, DEC_BATCH, FFN_CONV - 1, D_FF), 1.0),
        'norm_mix': 1.0 + nrm((DEPTH, D_MODEL), 0.02),
        'norm_ffn': 1.0 + nrm((DEPTH, D_MODEL), 0.02),
        'norm_final': 1.0 + nrm((D_MODEL,), 0.02),
        'even_w_in': nrm((N_EVEN, D_MODEL, D_IN_EVEN), D_MODEL ** -0.5),
        'ssd_conv_w': nrm((N_EVEN, SSD_CONV, SSD_CONV_DIM), SSD_CONV ** -0.5),
        'ssd_conv_b': nrm((N_EVEN, SSD_CONV_DIM), 0.01),
        'ssd_dt_bias': dt0 + jnp.log(-jnp.expm1(-dt0)),
        'ssd_A_log': jnp.log(unif((N_EVEN, SSD_HEADS), 1.0, 16.0)),
        'ssd_D': 1.0 + nrm((N_EVEN, SSD_HEADS), 0.02),
        'ssd_norm_w': 1.0 + nrm((N_EVEN, D_SSD), 0.02),
        'even_w_out': nrm((N_EVEN, D_MIX_EVEN, D_MODEL), D_MIX_EVEN ** -0.5),
        'odd_w_in': nrm((N_ODD, D_MODEL, D_IN_ODD), D_MODEL ** -0.5),
        'hg_lower_bounds': nrm((DEPTH, D_HG_K), 0.5),
        'hg_norm_w': 1.0 + nrm((N_ODD, HG_DV), 0.02),
        'lru_conv_w': nrm((N_ODD, LRU_CONV, D_RNN), LRU_CONV ** -0.5),
        'lru_conv_b': nrm((N_ODD, D_RNN), 0.01),
        'lru_w_r': nrm((N_ODD, LRU_BLOCKS, LRU_BW, LRU_BW), LRU_BW ** -0.5),
        'lru_b_r': nrm((N_ODD, D_RNN), 0.01),
        'lru_w_i': nrm((N_ODD, LRU_BLOCKS, LRU_BW, LRU_BW), LRU_BW ** -0.5),
        'lru_b_i': nrm((N_ODD, D_RNN), 0.01),
        'lru_a_param': jnp.log(a0) - jnp.log1p(-a0),
        'odd_w_out': nrm((N_ODD, D_MIX_ODD, D_MODEL), D_MIX_ODD ** -0.5),
        'ffn_w_up': nrm((DEPTH, D_MODEL, 2 * D_FF), D_MODEL ** -0.5),
        'ffn_conv_w': nrm((DEPTH, FFN_CONV, D_FF), FFN_CONV ** -0.5),
        'ffn_conv_b': nrm((DEPTH, D_FF), 0.01),
        'ffn_w_down': nrm((DEPTH, D_FF, D_MODEL), D_FF ** -0.5),
    }


def reference(x_prompt, x_sample, state_ssm, state_ssm_conv, state_ret, state_hgrn, state_lru,
              state_lru_conv, state_ffn_conv, norm_mix, norm_ffn, norm_final, even_w_in,
              ssd_conv_w, ssd_conv_b, ssd_dt_bias, ssd_A_log, ssd_D, ssd_norm_w, even_w_out,
              odd_w_in, hg_lower_bounds, hg_norm_w, lru_conv_w, lru_conv_b, lru_w_r, lru_b_r,
              lru_w_i, lru_b_i, lru_a_param, odd_w_out, ffn_w_up, ffn_conv_w, ffn_conv_b,
              ffn_w_down):
    prm = {
        'norm_mix': norm_mix, 'norm_ffn': norm_ffn, 'norm_final': norm_final,
        'even_w_in': even_w_in, 'ssd_conv_w': ssd_conv_w, 'ssd_conv_b': ssd_conv_b,
        'ssd_dt_bias': ssd_dt_bias, 'ssd_A_log': ssd_A_log, 'ssd_D': ssd_D,
        'ssd_norm_w': ssd_norm_w, 'even_w_out': even_w_out, 'odd_w_in': odd_w_in,
        'hg_lower_bounds': hg_lower_bounds, 'hg_norm_w': hg_norm_w,
        'lru_conv_w': lru_conv_w, 'lru_conv_b': lru_conv_b, 'lru_w_r': lru_w_r,
        'lru_b_r': lru_b_r, 'lru_w_i': lru_w_i, 'lru_b_i': lru_b_i,
        'lru_a_param': lru_a_param, 'odd_w_out': odd_w_out, 'ffn_w_up': ffn_w_up,
        'ffn_conv_w': ffn_conv_w, 'ffn_conv_b': ffn_conv_b, 'ffn_w_down': ffn_w_down,
    }
    st_sample = {
        'ssm': state_ssm, 'ssm_conv': state_ssm_conv, 'ret': state_ret, 'hgrn': state_hgrn,
        'lru': state_lru, 'lru_conv': state_lru_conv, 'ffn_conv': state_ffn_conv,
    }
    y_prompt, new_p = trunk(x_prompt, zero_states(x_prompt.shape[0], x_prompt.dtype), 0, prm)
    y_sample, new_s = trunk(x_sample, st_sample, PAST_LEN, prm)
    return (y_prompt, y_sample,
            new_p['ssm'], new_s['ssm'], new_p['ssm_conv'], new_s['ssm_conv'],
            new_p['ret'], new_s['ret'], new_p['hgrn'], new_s['hgrn'],
            new_p['lru'], new_s['lru'], new_p['lru_conv'], new_s['lru_conv'],
            new_p['ffn_conv'], new_s['ffn_conv'])
```

```cpp
#include <hip/hip_runtime.h>
#include <hip/hip_cooperative_groups.h>
#include <cstdio>
#include <cstdint>
namespace cg = cooperative_groups;

#define LAS __attribute__((address_space(3)))
typedef unsigned short bf16_t;
typedef short bf16x8 __attribute__((ext_vector_type(8)));
typedef float f32x4 __attribute__((ext_vector_type(4)));
typedef float f32x2 __attribute__((ext_vector_type(2)));
typedef unsigned u32x4 __attribute__((ext_vector_type(4)));
typedef unsigned u32x2 __attribute__((ext_vector_type(2)));

constexpr int D = 2048, MP = 8192, MS = 512, MT = 8704;
constexpr int LD0 = 11520, LD1 = 12288, LDU = 11264, DFF = 5632;
constexpr float EPS = 1e-6f;
constexpr size_t O_YP = 0;
constexpr size_t O_YS = O_YP + (size_t)4 * 2048 * 2048;
constexpr size_t O_SSMP = O_YS + (size_t)128 * 4 * 2048;
constexpr size_t O_SSMS = O_SSMP + (size_t)4 * 32 * 128 * 64;
constexpr size_t O_SCP = O_SSMS + (size_t)128 * 32 * 128 * 64;
constexpr size_t O_SCS = O_SCP + (size_t)4 * 3 * 3072;
constexpr size_t O_RETP = O_SCS + (size_t)128 * 3 * 3072;
constexpr size_t O_RETS = O_RETP + (size_t)4 * 8 * 128 * 256;
constexpr size_t O_HGP = O_RETS + (size_t)128 * 8 * 128 * 256;
constexpr size_t O_HGS = O_HGP + (size_t)4 * 16 * 128 * 128;
constexpr size_t O_LRUP = O_HGS + (size_t)128 * 16 * 128 * 128;
constexpr size_t O_LRUS = O_LRUP + (size_t)4 * 2048;
constexpr size_t O_LCP = O_LRUS + (size_t)128 * 2048;
constexpr size_t O_LCS = O_LCP + (size_t)4 * 3 * 2048;
constexpr size_t O_FCP = O_LCS + (size_t)128 * 3 * 2048;
constexpr size_t O_FCS = O_FCP + (size_t)2 * 4 * 2 * 5632;
constexpr size_t O_END = O_FCS + (size_t)2 * 128 * 2 * 5632;
constexpr size_t al256(size_t x) { return (x + 255) & ~(size_t)255; }
constexpr size_t WS_CTL = 0;
constexpr size_t WS_SS = 4096;
constexpr size_t WS_SP = al256(WS_SS + (size_t)5 * MT * 4);
constexpr size_t WS_LB = WS_SP + 8192;
constexpr size_t WS_WIN0 = WS_LB + 8192;
constexpr size_t WS_WOUT0 = WS_WIN0 + (size_t)LD0 * 2048 * 2;
constexpr size_t WS_WUP0 = WS_WOUT0 + (size_t)2048 * 4096 * 2;
constexpr size_t WS_WDN0 = WS_WUP0 + (size_t)LDU * 2048 * 2;
constexpr size_t WS_WIN1 = WS_WDN0 + (size_t)2048 * DFF * 2;
constexpr size_t WS_WOUT1 = WS_WIN1 + (size_t)LD1 * 2048 * 2;
constexpr size_t WS_WUP1 = WS_WOUT1 + (size_t)2048 * 4096 * 2;
constexpr size_t WS_WDN1 = WS_WUP1 + (size_t)LDU * 2048 * 2;
constexpr size_t WS_WLRU = WS_WDN1 + (size_t)2048 * DFF * 2;
constexpr size_t WS_X = WS_WLRU + (size_t)16 * 256 * 256 * 2;
constexpr size_t WS_XB = WS_X + (size_t)MT * 2048 * 4;
constexpr size_t WS_PROJ = WS_XB + (size_t)MT * 2048 * 2;
constexpr size_t WS_ACT = WS_PROJ + (size_t)MT * LD1 * 2;
constexpr size_t WS_YZ = WS_ACT + (size_t)MT * DFF * 2;
constexpr size_t WS_LA = WS_YZ + (size_t)MT * 4096 * 2;
constexpr size_t WS_LBB = WS_LA + (size_t)MT * 2048 * 4;
constexpr size_t WS_XR = WS_LBB + (size_t)MT * 2048 * 2;
constexpr size_t WS_END = WS_XR + (size_t)MT * 2048 * 2;

constexpr int LDS_BYTES = 131072 + 256;
constexpr int NPHASE = 18;

struct Params {
    const float* in[35];
    float* out;
    unsigned char* ws;
    int ph_lo, ph_hi;
    int z, pad;
};

__device__ __forceinline__ float bf2f(unsigned v) { return __uint_as_float(v << 16); }
__device__ __forceinline__ unsigned pk2(float lo, float hi) { unsigned r; asm volatile("v_cvt_pk_bf16_f32 %0, %1, %2" : "=v"(r) : "v"(lo), "v"(hi)); return r; }
__device__ __forceinline__ bf16_t f2bf(float x) { return (bf16_t)(pk2(x, 0.f) & 0xffffu); }
__device__ __forceinline__ float sigm(float x) { return __builtin_amdgcn_rcpf(1.f + __expf(-x)); }
__device__ __forceinline__ float silu(float x) { return x * __builtin_amdgcn_rcpf(1.f + __expf(-x)); }
__device__ __forceinline__ float softplus(float x) { return fmaxf(x, 0.f) + log1pf(__expf(-fabsf(x))); }
__device__ __forceinline__ float gelu_tanh(float x) { const float u = 0.7978845608f * (x + 0.044715f * x * x * x); const float t = 1.f - 2.f * __builtin_amdgcn_rcpf(1.f + __expf(2.f * u)); return 0.5f * x * (1.f + t); }
__device__ __forceinline__ float wave_sum(float v) {
#pragma unroll
    for (int o = 1; o < 64; o <<= 1) v += __shfl_xor(v, o);
    return v;
}
__device__ __forceinline__ void unpack8(u32x4 r, float* f) {
    f[0] = bf2f(r.x & 0xffffu); f[1] = __uint_as_float(r.x & 0xffff0000u); f[2] = bf2f(r.y & 0xffffu); f[3] = __uint_as_float(r.y & 0xffff0000u);
    f[4] = bf2f(r.z & 0xffffu); f[5] = __uint_as_float(r.z & 0xffff0000u); f[6] = bf2f(r.w & 0xffffu); f[7] = __uint_as_float(r.w & 0xffff0000u);
}
__device__ __forceinline__ void unpack4(u32x2 r, float* f) {
    f[0] = bf2f(r.x & 0xffffu); f[1] = __uint_as_float(r.x & 0xffff0000u); f[2] = bf2f(r.y & 0xffffu); f[3] = __uint_as_float(r.y & 0xffff0000u);
}
#define LDS_WAIT() asm volatile("s_waitcnt lgkmcnt(0)" ::: "memory")

namespace pg8 {
constexpr int BM = 256, BK = 64, HALF = 128, HTB = HALF * BK * 2, NXCD = 8, WGM = 8;
__device__ __forceinline__ int lds_byte(int r, int c) { const int st = (r >> 4) * 2 + (c >> 5), rr = r & 15, cc = c & 31, ob = rr * 64 + cc * 2; return st * 1024 + (ob ^ (((ob >> 9) & 1) << 5)); }
__device__ __forceinline__ void stage_rc(int b, int& R, int& C) { const int st = b / 1024, sb = b % 1024, swz = sb ^ (((sb >> 9) & 1) << 5); R = (st >> 1) * 16 + swz / 64; C = (st & 1) * 32 + (swz % 64) / 2; }
__device__ __forceinline__ int perm32(int rho) { const int n = rho >> 4, i = rho & 15; return 8 * (i >> 2) + 4 * n + (i & 3); }

struct Unit { int pm, pn; size_t aoff, boff; };
struct Gemm { const char* A; const char* Bt; int lda, ldb, nt; };
struct Order {
    int nM, nN, nwg, G, c; size_t a_t, b_t, acol;
    __device__ __forceinline__ bool next(int i, Unit& u) const {
        const long L = (long)i * G + c; if (L >= nwg) return false;
        int wgid = (int)L; { const int q = nwg / NXCD, r = nwg % NXCD, xcd = wgid % NXCD, off = wgid / NXCD; wgid = (xcd < r ? xcd * (q + 1) : r * (q + 1) + (xcd - r) * q) + off; }
        const int nig = WGM * nN, gid = wgid / nig, fm = gid * WGM, gsz = (nM - fm) < WGM ? (nM - fm) : WGM;
        u.pm = fm + ((wgid % nig) % gsz); u.pn = (wgid % nig) / gsz;
        u.aoff = (size_t)u.pm * a_t + (size_t)(u.pn >> 1) * acol; u.boff = (size_t)u.pn * b_t; return true;
    }
};

struct EpiScaleBf16 {
    static constexpr bool PERM = true;
    bf16_t* O; int ldc; const float* ss;
    __device__ __forceinline__ void operator()(const f32x4 (&acc)[2][2][4][2], const Unit& u, int wr, int wc, int fr, int fq) const {
        const int row0 = u.pm * BM + wr * 64 + fr, col0 = u.pn * BM + wc * 32 + 8 * fq;
#pragma unroll
        for (int ai = 0; ai < 2; ++ai)
#pragma unroll
            for (int m = 0; m < 4; ++m) {
                const int row = row0 + ai * HALF + m * 16;
                const float rs = rsqrtf(ss[row] * (1.0f / 2048.0f) + EPS);
                bf16_t* rowp = O + ((unsigned)row * (unsigned)ldc + (unsigned)col0);
#pragma unroll
                for (int bj = 0; bj < 2; ++bj) {
                    const f32x4 v0 = acc[ai][bj][m][0] * rs, v1 = acc[ai][bj][m][1] * rs;
                    u32x4 w; w.x = pk2(v0[0], v0[1]); w.y = pk2(v0[2], v0[3]); w.z = pk2(v1[0], v1[1]); w.w = pk2(v1[2], v1[3]);
                    *(u32x4*)(rowp + bj * HALF) = w;
                }
            }
    }
};
struct EpiResid {
    static constexpr bool PERM = false;
    float* X; bf16_t* XB; float* ssout;
    __device__ __forceinline__ void operator()(const f32x4 (&acc)[2][2][4][2], const Unit& u, int wr, int wc, int fr, int fq) const {
        const int row0 = u.pm * BM + wr * 64 + fr, col0 = u.pn * BM + wc * 32 + 4 * fq;
#pragma unroll
        for (int ai = 0; ai < 2; ++ai)
#pragma unroll
            for (int m = 0; m < 4; ++m) {
                const int row = row0 + ai * HALF + m * 16;
                const unsigned off = (unsigned)row * 2048u + (unsigned)col0;
                float sq = 0.f;
#pragma unroll
                for (int bj = 0; bj < 2; ++bj)
#pragma unroll
                    for (int n = 0; n < 2; ++n) {
                        const unsigned o = off + bj * HALF + n * 16;
                        f32x4 x = *(const f32x4*)(X + o) + acc[ai][bj][m][n];
                        *(f32x4*)(X + o) = x;
                        u32x2 w; w.x = pk2(x[0], x[1]); w.y = pk2(x[2], x[3]);
                        *(u32x2*)(XB + o) = w;
                        sq += (x[0] * x[0] + x[1] * x[1]) + (x[2] * x[2] + x[3] * x[3]);
                    }
                sq += __shfl_xor(sq, 16); sq += __shfl_xor(sq, 32);
                if (fq == 0) atomicAdd(ssout + row, sq);
                asm volatile("" ::: "memory");
            }
    }
};
struct EpiLru {
    static constexpr bool PERM = false;
    const float* br; const float* bi; const float* sp; const bf16_t* XR; float* LA; bf16_t* LBv;
    __device__ __forceinline__ void operator()(const f32x4 (&acc)[2][2][4][2], const Unit& u, int wr, int wc, int fr, int fq) const {
        const int row0 = u.pm * BM + wr * 64 + fr;
        const int cbase = (u.pn >> 1) * 256 + (u.pn & 1) * 128 + wc * 32 + 4 * fq;
#pragma unroll
        for (int ai = 0; ai < 2; ++ai)
#pragma unroll
            for (int m = 0; m < 4; ++m) {
                const int row = row0 + ai * HALF + m * 16;
                const bool first = (row < MP) && ((row & 2047) == 0);
#pragma unroll
                for (int n = 0; n < 2; ++n) {
                    const int c = cbase + n * 16;
                    const f32x4 br4 = *(const f32x4*)(br + c), bi4 = *(const f32x4*)(bi + c), sp4 = *(const f32x4*)(sp + c);
                    const unsigned o = (unsigned)row * 2048u + (unsigned)c;
                    float xr[4]; unpack4(*(const u32x2*)(XR + o), xr);
                    f32x4 av; float bb[4];
#pragma unroll
                    for (int j = 0; j < 4; ++j) {
                        const float r = sigm(acc[ai][0][m][n][j] + br4[j]), gi = sigm(acc[ai][1][m][n][j] + bi4[j]);
                        const float la = -8.0f * r * sp4[j];
                        const float a = __expf(la);
                        const float mult = first ? 1.0f : __builtin_amdgcn_sqrtf(fmaxf(1.0f - a * a, 0.f));
                        av[j] = a; bb[j] = mult * gi * xr[j];
                    }
                    *(f32x4*)(LA + o) = av;
                    u32x2 w; w.x = pk2(bb[0], bb[1]); w.y = pk2(bb[2], bb[3]);
                    *(u32x2*)(LBv + o) = w;
                    asm volatile("" ::: "memory");
                }
            }
    }
};

template <class Epi>
__device__ __forceinline__ void gemm_phase(LAS unsigned char* lds, const Gemm g, const Order& S, const Epi& E) {
    int tid = threadIdx.x; asm volatile("" : "+v"(tid));
    const int wid = __builtin_amdgcn_readfirstlane(tid >> 6), lane = tid & 63, wr = wid >> 2, wc = wid & 3, fr = lane & 15, fq = lane >> 4;
    const int nt = g.nt;
    unsigned voffA[2], voffB[2];
#pragma unroll
    for (int i = 0; i < 2; ++i) { int R, C; stage_rc(tid * 16 + i * 8192, R, C); const int Rb = Epi::PERM ? ((R & ~31) + perm32(R & 31)) : R;
        voffA[i] = (unsigned)(R * g.lda + C) * 2u; voffB[i] = (unsigned)(Rb * g.ldb + C) * 2u; }
    const size_t kstep = (size_t)(BK * 2);
    const size_t hstepA = (size_t)HALF * g.lda * 2, hstepB = (size_t)HALF * g.ldb * 2;
    const unsigned ldsw = (unsigned)wid * 1024u;
    const int aoff = lds_byte(wr * 64 + fr, fq * 8), boff = lds_byte(wc * 32 + fr, fq * 8);
#define PG8_SA(b, h) (((b) * 2 + (h)) * HTB)
#define PG8_SB(b, h) ((4 + (b) * 2 + (h)) * HTB)
#define PG8_STAGE(bufoff, gbase, voff) do { _Pragma("unroll") for (int _i = 0; _i < 2; ++_i) \
        __builtin_amdgcn_global_load_lds((const unsigned*)((const char*)(gbase) + (voff)[_i]), (LAS unsigned*)(lds + (bufoff) + ldsw + _i * 8192), 16, 0, 0); } while (0)
#define PG8_LDA(dst, b, h) do { _Pragma("unroll") for (int m = 0; m < 4; ++m) _Pragma("unroll") for (int k = 0; k < 2; ++k) dst[m][k] = *(const LAS bf16x8*)(lds + PG8_SA(b, h) + aoff + m * 2048 + k * 1024); } while (0)
#define PG8_LDB(dst, b, h) do { _Pragma("unroll") for (int n = 0; n < 2; ++n) _Pragma("unroll") for (int k = 0; k < 2; ++k) dst[n][k] = *(const LAS bf16x8*)(lds + PG8_SB(b, h) + boff + n * 2048 + k * 1024); } while (0)
#define PG8_MMA(ai, bj, At, Bt) do { __builtin_amdgcn_s_setprio(1); _Pragma("unroll") for (int m = 0; m < 4; ++m) _Pragma("unroll") for (int n = 0; n < 2; ++n) _Pragma("unroll") for (int k = 0; k < 2; ++k) \
        acc[ai][bj][m][n] = __builtin_amdgcn_mfma_f32_16x16x32_bf16(Bt[n][k], At[m][k], acc[ai][bj][m][n], 0, 0, 0); __builtin_amdgcn_s_setprio(0); } while (0)
#define PG8_WAIT_V(n) asm volatile("s_waitcnt vmcnt(" #n ")" ::: "memory")
#define PG8_WAIT_L(n) asm volatile("s_waitcnt lgkmcnt(" #n ")" ::: "memory")
#define PG8_BAR __builtin_amdgcn_s_barrier()
#define PG8_SCHED __builtin_amdgcn_sched_barrier(0)
    Unit cur, nxt; int ui = 0;
    if (!S.next(0, cur)) return;
    f32x4 acc[2][2][4][2];
#pragma unroll
    for (int a = 0; a < 2; ++a)
#pragma unroll
        for (int b = 0; b < 2; ++b)
#pragma unroll
            for (int m = 0; m < 4; ++m)
#pragma unroll
                for (int n = 0; n < 2; ++n) acc[a][b][m][n] = (f32x4){0.f, 0.f, 0.f, 0.f};
    bf16x8 At[4][2], B0[2][2], B1[2][2];
    const char* cA = g.A + cur.aoff; const char* cB = g.Bt + cur.boff;
    PG8_STAGE(PG8_SB(0, 0), cB, voffB); PG8_STAGE(PG8_SA(0, 0), cA, voffA); PG8_STAGE(PG8_SB(0, 1), cB + hstepB, voffB); PG8_STAGE(PG8_SA(0, 1), cA + hstepA, voffA);
    if (wr == 1) PG8_BAR;
    PG8_WAIT_V(4); PG8_BAR;
    PG8_STAGE(PG8_SB(1, 0), cB + kstep, voffB); PG8_STAGE(PG8_SA(1, 0), cA + kstep, voffA); PG8_STAGE(PG8_SB(1, 1), cB + hstepB + kstep, voffB);
    PG8_WAIT_V(6); PG8_BAR;
    for (;;) {
        const bool has_next = S.next(ui + 1, nxt);
        const char* nA = has_next ? g.A + nxt.aoff : cA; const char* nB = has_next ? g.Bt + nxt.boff : cB;
        for (int t = 0; t < nt; t += 2) {
            const bool last = (t == nt - 2);
            const char* a1 = cA + (size_t)(t + 1) * kstep;
            const char* a2 = last ? nA : cA + (size_t)(t + 2) * kstep; const char* b2 = last ? nB : cB + (size_t)(t + 2) * kstep;
            const char* a3 = a2 + kstep; const char* b3 = b2 + kstep;
            PG8_LDB(B0, 0, 0); PG8_SCHED; PG8_LDA(At, 0, 0); PG8_STAGE(PG8_SA(1, 1), a1 + hstepA, voffA);
            PG8_WAIT_L(8); PG8_BAR; PG8_WAIT_L(0); PG8_MMA(0, 0, At, B0); PG8_BAR; PG8_SCHED;
            PG8_LDB(B1, 0, 1); PG8_STAGE(PG8_SB(0, 0), b2, voffB);
            PG8_BAR; PG8_WAIT_L(0); PG8_MMA(0, 1, At, B1); PG8_BAR;
            PG8_LDA(At, 0, 1); PG8_STAGE(PG8_SA(0, 0), a2, voffA);
            PG8_BAR; PG8_WAIT_L(0); PG8_MMA(1, 0, At, B0); PG8_BAR; PG8_SCHED;
            PG8_STAGE(PG8_SB(0, 1), b2 + hstepB, voffB);
            PG8_WAIT_V(6); PG8_BAR; PG8_MMA(1, 1, At, B1); PG8_BAR;
            PG8_LDB(B0, 1, 0); PG8_SCHED; PG8_LDA(At, 1, 0); PG8_STAGE(PG8_SA(0, 1), a2 + hstepA, voffA);
            PG8_WAIT_L(8); PG8_BAR; PG8_WAIT_L(0); PG8_MMA(0, 0, At, B0); PG8_BAR; PG8_SCHED;
            PG8_LDB(B1, 1, 1); PG8_STAGE(PG8_SB(1, 0), b3, voffB);
            PG8_BAR; PG8_WAIT_L(0); PG8_MMA(0, 1, At, B1); PG8_BAR;
            PG8_LDA(At, 1, 1); PG8_STAGE(PG8_SA(1, 0), a3, voffA);
            PG8_BAR; PG8_WAIT_L(0); PG8_MMA(1, 0, At, B0); PG8_BAR; PG8_SCHED;
            PG8_STAGE(PG8_SB(1, 1), b3 + hstepB, voffB);
            PG8_WAIT_V(6); PG8_BAR; PG8_MMA(1, 1, At, B1); PG8_BAR;
        }
        E(acc, cur, wr, wc, fr, fq);
        if (!has_next) break;
#pragma unroll
        for (int a = 0; a < 2; ++a)
#pragma unroll
            for (int b = 0; b < 2; ++b)
#pragma unroll
                for (int m = 0; m < 4; ++m)
#pragma unroll
                    for (int n = 0; n < 2; ++n) acc[a][b][m][n] = (f32x4){0.f, 0.f, 0.f, 0.f};
        cur = nxt; cA = nA; cB = nB; ++ui;
    }
    PG8_WAIT_V(0);
    if (wr == 0) PG8_BAR;
    PG8_BAR;
#undef PG8_SA
#undef PG8_SB
#undef PG8_STAGE
#undef PG8_LDA
#undef PG8_LDB
#undef PG8_MMA
#undef PG8_WAIT_V
#undef PG8_WAIT_L
#undef PG8_BAR
#undef PG8_SCHED
}
}

__device__ __forceinline__ void tr_item(const float* __restrict__ W, int ldw, int k0, int n0, const float* __restrict__ scale, bf16_t* __restrict__ dst, int ldd, float* scr, int lane) {
#pragma unroll 8
    for (int i = 0; i < 32; ++i) { const int kk = 2 * i + (lane >> 5); float v = W[(size_t)(k0 + kk) * ldw + n0 + (lane & 31)]; if (scale) v *= scale[k0 + kk]; scr[kk * 33 + (lane & 31)] = v; }
    LDS_WAIT();
    const int c = lane & 7;
#pragma unroll
    for (int j = 0; j < 4; ++j) { const int n = (lane >> 3) + 8 * j; const float* s = scr + (8 * c) * 33 + n;
        u32x4 o; o.x = pk2(s[0 * 33], s[1 * 33]); o.y = pk2(s[2 * 33], s[3 * 33]); o.z = pk2(s[4 * 33], s[5 * 33]); o.w = pk2(s[6 * 33], s[7 * 33]);
        *(u32x4*)(dst + (size_t)n * ldd + 8 * c) = o; }
    LDS_WAIT();
}

__device__ __forceinline__ void phase_prologue(const Params& p, float* ldsf) {
    int tid = threadIdx.x; asm volatile("" : "+v"(tid));
    const int wave = tid >> 6, lane = tid & 63;
    const int gw = blockIdx.x * 8 + wave, NGW = gridDim.x * 8;
    float* scr = ldsf + wave * 2304;
    unsigned char* ws = p.ws;
    constexpr int I0 = 32 * 353, I1 = 64 * 64, I2 = 32 * 352, I3 = 88 * 64, I4 = 32 * 384, I5 = I1, I6 = I2, I7 = I3, I8 = 256, I9 = 256;
    constexpr int NIT = I0 + I1 + I2 + I3 + I4 + I5 + I6 + I7 + I8 + I9;
    for (int it = gw; it < NIT; it += NGW) {
        int r = it;
        const float* W; int K, N; const float* sc = nullptr; bf16_t* WT;
        if (r < I0) { W = p.in[12 + p.z]; K = 2048; N = 11296; sc = p.in[9 + p.z]; WT = (bf16_t*)(ws + WS_WIN0); }
        else if ((r -= I0) < I1) { W = p.in[19 + p.z]; K = 4096; N = 2048; WT = (bf16_t*)(ws + WS_WOUT0); }
        else if ((r -= I1) < I2) { W = p.in[31 + p.z]; K = 2048; N = 11264; sc = p.in[10 + p.z]; WT = (bf16_t*)(ws + WS_WUP0); }
        else if ((r -= I2) < I3) { W = p.in[34 + p.z]; K = 5632; N = 2048; WT = (bf16_t*)(ws + WS_WDN0); }
        else if ((r -= I3) < I4) { W = p.in[20 + p.z]; K = 2048; N = 12288; sc = p.in[9 + p.z] + 2048; WT = (bf16_t*)(ws + WS_WIN1); }
        else if ((r -= I4) < I5) { W = p.in[30 + p.z]; K = 4096; N = 2048; WT = (bf16_t*)(ws + WS_WOUT1); }
        else if ((r -= I5) < I6) { W = p.in[31 + p.z] + (size_t)2048 * 11264; K = 2048; N = 11264; sc = p.in[10 + p.z] + 2048; WT = (bf16_t*)(ws + WS_WUP1); }
        else if ((r -= I6) < I7) { W = p.in[34 + p.z] + (size_t)5632 * 2048; K = 5632; N = 2048; WT = (bf16_t*)(ws + WS_WDN1); }
        else {
            r -= I7; const int which = r >> 8; r &= 255;
            const int blk = r >> 5, kb = (r >> 3) & 3, nb = r & 7, n0 = 32 * nb, k0 = 64 * kb;
            const float* Wl = (which ? p.in[27 + p.z] : p.in[25 + p.z]) + (size_t)blk * 65536;
            const int drow = (blk * 2 + (n0 >> 7)) * 256 + which * 128 + (n0 & 127);
            tr_item(Wl, 256, k0, n0, nullptr, (bf16_t*)(ws + WS_WLRU) + (size_t)drow * 256 + k0, 256, scr, lane);
            continue;
        }
        const int nblk = N / 32, kb = r / nblk, nb = r % nblk, k0 = 64 * kb, n0 = 32 * nb;
        tr_item(W, N, k0, n0, sc, WT + (size_t)n0 * K + k0, K, scr, lane);
    }
    {
        u32x4* z = (u32x4*)((bf16_t*)(ws + WS_WIN0) + (size_t)11296 * 2048);
        const int n16 = 224 * 2048 * 2 / 16;
        for (int i = blockIdx.x * 512 + tid; i < n16; i += gridDim.x * 512) z[i] = (u32x4){0u, 0u, 0u, 0u};
    }
    float* X = (float*)(ws + WS_X); bf16_t* XB = (bf16_t*)(ws + WS_XB); float* ss = (float*)(ws + WS_SS);
    for (int row = gw; row < MT; row += NGW) {
        const float* src = row < MP ? p.in[0 + p.z] + (size_t)row * 2048 : p.in[1 + p.z] + (size_t)(row - MP) * 2048;
        float s = 0.f;
#pragma unroll
        for (int j = 0; j < 8; ++j) {
            const f32x4 v = *(const f32x4*)(src + (lane + 64 * j) * 4);
            *(f32x4*)(X + (size_t)row * 2048 + (lane + 64 * j) * 4) = v;
            u32x2 w; w.x = pk2(v[0], v[1]); w.y = pk2(v[2], v[3]);
            *(u32x2*)(XB + (size_t)row * 2048 + (lane + 64 * j) * 4) = w;
            s += (v[0] * v[0] + v[1] * v[1]) + (v[2] * v[2] + v[3] * v[3]);
        }
        s = wave_sum(s);
        if (lane == 0) ss[row] = s;
    }
    for (int i = blockIdx.x * 512 + tid; i < 4 * MT; i += gridDim.x * 512) ss[MT + i] = 0.f;
    for (int i = blockIdx.x * 512 + tid; i < 2048; i += gridDim.x * 512) {
        ((float*)(ws + WS_SP))[i] = softplus(-p.in[29 + p.z][i]);
        ((float*)(ws + WS_LB))[i] = sigm(p.in[21 + p.z][2048 + i] - p.in[21 + p.z][i]);
    }
}

__device__ __forceinline__ int next_item(unsigned* ctr, float* ldsf) {
    __syncthreads();
    if (threadIdx.x == 0) ((volatile unsigned*)ldsf)[24576] = atomicAdd(ctr, 1u);
    __syncthreads();
    return (int)((volatile unsigned*)ldsf)[24576];
}

template <int TYPE>
__device__ __forceinline__ void rec_item(const Params& p, float* ldsf, int sample, int b, int h, int s) {
    int tid = threadIdx.x; asm volatile("" : "+v"(tid));
    const int w = tid >> 6, lane = tid & 63, kg = lane >> 4, vq = lane & 15, kb = 16 * w + 4 * kg;
    const int L = sample ? 4 : 2048, row0 = sample ? MP + 4 * b : 2048 * b, pos0 = sample ? 16384 : 0;
    constexpr int LDP = TYPE < 2 ? LD0 : LD1;
    const bf16_t* proj = (const bf16_t*)(p.ws + WS_PROJ) + (size_t)row0 * LDP;
    bf16_t* yz = (bf16_t*)(p.ws + WS_YZ) + (size_t)row0 * 4096;
    float* part = ldsf + 8192;
    int colA = -1, colB = -1, role = -1, didx = 0;
    float w0 = 0.f, w1 = 0.f, w2 = 0.f, w3 = 0.f, cbias = 0.f, c0 = 0.f, c1 = 0.f, c2 = 0.f, aux = 0.f, aux2 = 0.f;
    if constexpr (TYPE == 0) {
        if (tid < 320) {
            role = tid < 128 ? 0 : (tid < 256 ? 1 : 2);
            didx = tid < 128 ? tid : (tid < 256 ? tid - 128 : tid - 256);
            const int ch = tid < 128 ? 2560 + (h >> 3) * 128 + tid : (tid < 256 ? 2048 + (h >> 3) * 128 + (tid - 128) : h * 64 + (tid - 256));
            colA = 2048 + ch;
            const float* cw = p.in[13 + p.z];
            w0 = cw[ch]; w1 = cw[3072 + ch]; w2 = cw[2 * 3072 + ch]; w3 = cw[3 * 3072 + ch]; cbias = p.in[14 + p.z][ch];
            if (sample) { const float* st = p.in[3 + p.z] + (size_t)b * 3 * 3072; c0 = st[ch]; c1 = st[3072 + ch]; c2 = st[2 * 3072 + ch]; }
        } else if (tid < 328) { role = 3; didx = tid - 320; colA = 5120 + h; aux = p.in[15 + p.z][h]; aux2 = -__expf(p.in[16 + p.z][h]); }
    } else if constexpr (TYPE == 1) {
        if (tid < 128) { role = tid < 64 ? 0 : 1; didx = tid & 63; colA = (tid < 64 ? 5152 : 6176) + h * 128 + didx; colB = colA + 64;
            aux = exp2f(-(float)didx * 0.20762050593046014f); }
        else if (tid < 192) { role = 2; didx = tid - 128; colA = 7200 + h * 256 + s * 64 + didx; }
    } else {
        if (tid < 128) { role = 0; didx = tid; colA = h * 128 + tid; }
        else if (tid < 256) { role = 1; didx = tid - 128; colA = 2048 + h * 128 + didx; aux = ((const float*)(p.ws + WS_LB))[h * 128 + didx]; }
        else if (tid < 320) { role = 2; didx = tid - 256; colA = 4096 + h * 128 + s * 64 + didx; }
    }
    const float Dh = TYPE == 0 ? p.in[17 + p.z][h] : 0.f;
    const float gamma = TYPE == 1 ? 1.0f - exp2f(-5.0f - (float)h * (4.0f / 7.0f)) : 0.f;
    const int ldS = TYPE == 0 ? 64 : (TYPE == 1 ? 256 : 128);
    size_t soff;
    if constexpr (TYPE == 0) soff = ((size_t)(b * 32 + h) * 128) * 64;
    else if constexpr (TYPE == 1) soff = ((size_t)(b * 8 + h) * 128) * 256 + s * 64;
    else soff = ((size_t)(b * 16 + h) * 128) * 128 + s * 64;
    const float* S0 = TYPE == 0 ? p.in[2 + p.z] : (TYPE == 1 ? p.in[4 + p.z] : p.in[5 + p.z]);
    float* Sout = p.out + (TYPE == 0 ? (sample ? O_SSMS : O_SSMP) : (TYPE == 1 ? (sample ? O_RETS : O_RETP) : (sample ? O_HGS : O_HGP))) + soff;
    f32x4 S[4];
#pragma unroll
    for (int i = 0; i < 4; ++i) S[i] = sample ? *(const f32x4*)(S0 + soff + (size_t)(kb + i) * ldS + 4 * vq) : (f32x4){0.f, 0.f, 0.f, 0.f};
    unsigned short ra[8], rb[8]; unsigned short zr = 0;
    const int R = (L + 7) >> 3;
    auto load_raw = [&](int r) {
#pragma unroll
        for (int t = 0; t < 8; ++t) {
            const int tt = 8 * r + t;
            ra[t] = 0; rb[t] = 0;
            if (tt < L) {
                if (colA >= 0) ra[t] = proj[(size_t)tt * LDP + colA];
                if (TYPE == 1 && colB >= 0) rb[t] = proj[(size_t)tt * LDP + colB];
            }
        }
        if (TYPE == 0) { const int tt = 8 * r + w; if (tt < L) zr = proj[(size_t)tt * LDP + h * 64 + lane]; }
    };
    load_raw(0);
    for (int r = 0; r < R; ++r) {
        const int nv = (L - 8 * r) < 8 ? (L - 8 * r) : 8;
        float* stg = ldsf + (r & 1) * 4096;
        float* qs = stg; float* ks = stg + 1024; float* as = stg + 2048; float* vs = stg + 3072; float* ad = stg + 3584;
        if constexpr (TYPE == 0) {
            if (role >= 0 && role < 3) {
                float* dst = role == 0 ? qs : (role == 1 ? ks : vs); const int dstr = role == 2 ? 64 : 128;
#pragma unroll
                for (int t = 0; t < 8; ++t) {
                    const float x = bf2f(ra[t]);
                    const float y = cbias + w0 * c0 + w1 * c1 + w2 * c2 + w3 * x;
                    c0 = c1; c1 = c2; c2 = x;
                    dst[t * dstr + didx] = silu(y);
                }
            } else if (role == 3) {
                float xv = 0.f;
#pragma unroll
                for (int t = 0; t < 8; ++t) if (t == didx) xv = bf2f(ra[t]);
                const float dt = softplus(xv + aux);
                ad[2 * didx] = __expf(dt * aux2); ad[2 * didx + 1] = dt;
            }
        } else if constexpr (TYPE == 1) {
            if (role == 0 || role == 1) {
                float* dst = role == 0 ? qs : ks; const float sc = role == 0 ? 1.0f : 0.08838834764831845f;
#pragma unroll
                for (int t = 0; t < 8; ++t) {
                    const int pos = pos0 + 8 * r + t;
                    const double rev = (double)pos * (double)aux * 0.15915494309189535;
                    const float fr = (float)(rev - floor(rev));
                    const float sn = __builtin_amdgcn_sinf(fr), cs = __builtin_amdgcn_cosf(fr);
                    const float x1 = bf2f(ra[t]) * sc, x2 = bf2f(rb[t]) * sc;
                    dst[t * 128 + didx] = x1 * cs - x2 * sn;
                    dst[t * 128 + 64 + didx] = x1 * sn + x2 * cs;
                }
            } else if (role == 2) {
#pragma unroll
                for (int t = 0; t < 8; ++t) vs[t * 64 + didx] = bf2f(ra[t]);
            }
        } else {
            if (role == 0) {
#pragma unroll
                for (int t = 0; t < 8; ++t) qs[t * 128 + didx] = silu(bf2f(ra[t]));
            } else if (role == 1) {
#pragma unroll
                for (int t = 0; t < 8; ++t) { const float f = aux + (1.0f - aux) * sigm(bf2f(ra[t])); as[t * 128 + didx] = f; ks[t * 128 + didx] = 1.0f - f; }
            } else if (role == 2) {
#pragma unroll
                for (int t = 0; t < 8; ++t) vs[t * 64 + didx] = bf2f(ra[t]);
            }
        }
        const unsigned short zc = zr;
        __syncthreads();
        if (r + 1 < R) load_raw(r + 1);
        for (int t0 = 0; t0 < nv; t0 += 4) {
#pragma unroll
            for (int tt = 0; tt < 4; ++tt) {
                const int t = t0 + tt;
                const f32x4 q4 = *(const f32x4*)(qs + t * 128 + kb);
                f32x4 k4 = *(const f32x4*)(ks + t * 128 + kb);
                const f32x4 v4 = *(const f32x4*)(vs + t * 64 + 4 * vq);
                f32x4 a4;
                if constexpr (TYPE == 0) { const f32x2 adv = *(const f32x2*)(ad + 2 * t); a4 = (f32x4){adv.x, adv.x, adv.x, adv.x}; k4 = k4 * adv.y; }
                else if constexpr (TYPE == 1) a4 = (f32x4){gamma, gamma, gamma, gamma};
                else a4 = *(const f32x4*)(as + t * 128 + kb);
                f32x4 o = (f32x4){0.f, 0.f, 0.f, 0.f};
#pragma unroll
                for (int i = 0; i < 4; ++i) { S[i] = a4[i] * S[i] + k4[i] * v4; o += q4[i] * S[i]; }
                *(f32x4*)(part + ((t * 32 + w * 4 + kg) * 64 + 4 * vq)) = o;
            }
        }
        __syncthreads();
        if (w < nv) {
            float o = 0.f;
#pragma unroll
            for (int pp = 0; pp < 32; ++pp) o += part[(w * 32 + pp) * 64 + lane];
            const size_t trow = (size_t)(8 * r + w);
            if constexpr (TYPE == 0) {
                const float y = (o + Dh * vs[w * 64 + lane]) * silu(bf2f(zc));
                yz[trow * 4096 + h * 64 + lane] = f2bf(y);
            } else if constexpr (TYPE == 1) {
                yz[trow * 4096 + 2048 + h * 256 + s * 64 + lane] = f2bf(o);
            } else {
                yz[trow * 4096 + h * 128 + s * 64 + lane] = f2bf(o);
            }
        }
    }
#pragma unroll
    for (int i = 0; i < 4; ++i) *(f32x4*)(Sout + (size_t)(kb + i) * ldS + 4 * vq) = S[i];
}

__device__ __forceinline__ void lru_item(const Params& p, int sample, int b, int cb) {
    const int c = cb * 512 + threadIdx.x;
    const int L = sample ? 4 : 2048, row0 = sample ? MP + 4 * b : 2048 * b;
    const float* LA = (const float*)(p.ws + WS_LA) + (size_t)row0 * 2048 + c;
    const bf16_t* LBv = (const bf16_t*)(p.ws + WS_LBB) + (size_t)row0 * 2048 + c;
    const bf16_t* rg = (const bf16_t*)(p.ws + WS_PROJ) + (size_t)row0 * LD1 + 10240 + c;
    bf16_t* mixa = (bf16_t*)(p.ws + WS_ACT) + (size_t)row0 * 4096 + 2048 + c;
    float hst = sample ? p.in[6 + p.z][(size_t)b * 2048 + c] : 0.f;
    if (sample) {
#pragma unroll
        for (int t = 0; t < 4; ++t) {
            hst = LA[(size_t)t * 2048] * hst + bf2f(LBv[(size_t)t * 2048]);
            mixa[(size_t)t * 4096] = f2bf(hst * gelu_tanh(bf2f(rg[(size_t)t * LD1])));
        }
    } else {
        float a0[16]; unsigned short b0[16], g0[16];
#pragma unroll
        for (int t = 0; t < 16; ++t) { a0[t] = LA[(size_t)t * 2048]; b0[t] = LBv[(size_t)t * 2048]; g0[t] = rg[(size_t)t * LD1]; }
        for (int tb = 0; tb < 2048; tb += 16) {
            float a1[16]; unsigned short b1[16], g1[16];
            const int tn = (tb + 16 < 2048) ? tb + 16 : tb;
#pragma unroll
            for (int t = 0; t < 16; ++t) { a1[t] = LA[(size_t)(tn + t) * 2048]; b1[t] = LBv[(size_t)(tn + t) * 2048]; g1[t] = rg[(size_t)(tn + t) * LD1]; }
#pragma unroll
            for (int t = 0; t < 16; ++t) {
                hst = a0[t] * hst + bf2f(b0[t]);
                mixa[(size_t)(tb + t) * 4096] = f2bf(hst * gelu_tanh(bf2f(g0[t])));
            }
#pragma unroll
            for (int t = 0; t < 16; ++t) { a0[t] = a1[t]; b0[t] = b1[t]; g0[t] = g1[t]; }
        }
    }
    p.out[(sample ? O_LRUS : O_LRUP) + (size_t)b * 2048 + c] = hst;
}

__device__ __forceinline__ void phase_rec0(const Params& p, float* ldsf) {
    unsigned* ctr = (unsigned*)(p.ws + WS_CTL);
    const int total = 256 + 8192;
    for (;;) {
        const int it = next_item(ctr, ldsf);
        if (it >= total) break;
        int sample, j, type;
        if (it < 128) { sample = 0; j = it; type = 0; }
        else if (it < 256) { sample = 0; j = it - 128; type = 1; }
        else if (it < 256 + 4096) { sample = 1; j = it - 256; type = 0; }
        else { sample = 1; j = it - 256 - 4096; type = 1; }
        if (type == 0) rec_item<0>(p, ldsf, sample, j >> 5, j & 31, 0);
        else rec_item<1>(p, ldsf, sample, j >> 5, (j & 31) >> 2, j & 3);
    }
}
__device__ __forceinline__ void phase_rec1(const Params& p, float* ldsf) {
    unsigned* ctr = (unsigned*)(p.ws + WS_CTL) + 64;
    const int total = 128 + 16 + 4096 + 512;
    for (;;) {
        const int it = next_item(ctr, ldsf);
        if (it >= total) break;
        if (it < 128) rec_item<2>(p, ldsf, 0, it >> 5, (it & 31) >> 1, it & 1);
        else if (it < 144) lru_item(p, 0, (it - 128) >> 2, (it - 128) & 3);
        else if (it < 144 + 4096) { const int j = it - 144; rec_item<2>(p, ldsf, 1, j >> 5, (j & 31) >> 1, j & 1); }
        else { const int j = it - 144 - 4096; lru_item(p, 1, j >> 2, j & 3); }
    }
}

__device__ __forceinline__ void seq_of_row(int row, int& sample, int& b, int& t, int& L) {
    if (row < MP) { sample = 0; b = row >> 11; t = row & 2047; L = 2048; } else { sample = 1; b = (row - MP) >> 2; t = (row - MP) & 3; L = 4; }
}

__device__ __forceinline__ void phase_prep0(const Params& p) {
    int tid = threadIdx.x; asm volatile("" : "+v"(tid));
    const int wave = tid >> 6, lane = tid & 63;
    const int gw = blockIdx.x * 8 + wave, NGW = gridDim.x * 8;
    const bf16_t* YZ = (const bf16_t*)(p.ws + WS_YZ); const bf16_t* PR = (const bf16_t*)(p.ws + WS_PROJ);
    bf16_t* MX = (bf16_t*)(p.ws + WS_ACT);
    const float* nw = p.in[18 + p.z];
    for (int row = gw; row < MT; row += NGW) {
        const bf16_t* yz = YZ + (size_t)row * 4096; bf16_t* mx = MX + (size_t)row * 4096;
#pragma unroll 1
        for (int g = 0; g < 4; ++g) {
            const int c = g * 512 + lane * 8;
            float v[8]; unpack8(*(const u32x4*)(yz + c), v);
            float s = 0.f;
#pragma unroll
            for (int j = 0; j < 8; ++j) s += v[j] * v[j];
            s = wave_sum(s);
            const float rs = rsqrtf(s * (1.0f / 512.0f) + EPS);
            const f32x4 n0 = *(const f32x4*)(nw + c), n1 = *(const f32x4*)(nw + c + 4);
            u32x4 o; o.x = pk2(v[0] * rs * n0[0], v[1] * rs * n0[1]); o.y = pk2(v[2] * rs * n0[2], v[3] * rs * n0[3]);
            o.z = pk2(v[4] * rs * n1[0], v[5] * rs * n1[1]); o.w = pk2(v[6] * rs * n1[2], v[7] * rs * n1[3]);
            *(u32x4*)(mx + c) = o;
        }
#pragma unroll 2
        for (int hh = 0; hh < 8; ++hh) {
            const int c = hh * 256 + lane * 4;
            float v[4]; unpack4(*(const u32x2*)(yz + 2048 + c), v);
            float gt[4]; unpack4(*(const u32x2*)(PR + (size_t)row * LD0 + 9248 + c), gt);
            float s = (v[0] * v[0] + v[1] * v[1]) + (v[2] * v[2] + v[3] * v[3]);
            s = wave_sum(s);
            const float rs = rsqrtf(s * (1.0f / 256.0f) + EPS);
            u32x2 o; o.x = pk2(v[0] * rs * silu(gt[0]), v[1] * rs * silu(gt[1])); o.y = pk2(v[2] * rs * silu(gt[2]), v[3] * rs * silu(gt[3]));
            *(u32x2*)(mx + 2048 + c) = o;
        }
        int sample, b, t, L; seq_of_row(row, sample, b, t, L);
        if (t >= L - 3) {
            float* dst = p.out + (sample ? O_SCS : O_SCP) + ((size_t)b * 3 + (t - (L - 3))) * 3072;
            const bf16_t* src = PR + (size_t)row * LD0 + 2048;
#pragma unroll 4
            for (int c = lane; c < 3072; c += 64) dst[c] = bf2f(src[c]);
        }
    }
}

__device__ __forceinline__ void phase_prep1(const Params& p) {
    int tid = threadIdx.x; asm volatile("" : "+v"(tid));
    const int wave = tid >> 6, lane = tid & 63;
    const int gw = blockIdx.x * 8 + wave, NGW = gridDim.x * 8;
    const bf16_t* YZ = (const bf16_t*)(p.ws + WS_YZ); const bf16_t* PR = (const bf16_t*)(p.ws + WS_PROJ);
    bf16_t* MX = (bf16_t*)(p.ws + WS_ACT);
    const float* nw = p.in[22 + p.z];
    for (int row = gw; row < MT; row += NGW) {
#pragma unroll 1
        for (int it = 0; it < 4; ++it) {
            const int c = it * 512 + lane * 8;
            float v[8]; unpack8(*(const u32x4*)(YZ + (size_t)row * 4096 + c), v);
            float gt[8]; unpack8(*(const u32x4*)(PR + (size_t)row * LD1 + 6144 + c), gt);
            float s = 0.f;
#pragma unroll
            for (int j = 0; j < 8; ++j) s += v[j] * v[j];
            s += __shfl_xor(s, 1); s += __shfl_xor(s, 2); s += __shfl_xor(s, 4); s += __shfl_xor(s, 8);
            const float rs = rsqrtf(s * (1.0f / 128.0f) + EPS);
            const f32x4 n0 = *(const f32x4*)(nw + (c & 127)), n1 = *(const f32x4*)(nw + (c & 127) + 4);
            float o[8];
#pragma unroll
            for (int j = 0; j < 8; ++j) o[j] = v[j] * rs * (j < 4 ? n0[j] : n1[j - 4]) * silu(gt[j]);
            u32x4 ov; ov.x = pk2(o[0], o[1]); ov.y = pk2(o[2], o[3]); ov.z = pk2(o[4], o[5]); ov.w = pk2(o[6], o[7]);
            *(u32x4*)(MX + (size_t)row * 4096 + c) = ov;
        }
    }
}

__device__ __forceinline__ void phase_act(const Params& p, int l) {
    const bf16_t* PR = (const bf16_t*)(p.ws + WS_PROJ); bf16_t* ACT = (bf16_t*)(p.ws + WS_ACT);
    const float* cw = p.in[32 + p.z] + (size_t)l * 3 * DFF; const float* cbv = p.in[33 + p.z] + (size_t)l * DFF;
    const float* st = p.in[8 + p.z] + (size_t)l * 128 * 2 * DFF;
    const int total = MT * 704;
    for (int idx = blockIdx.x * 512 + threadIdx.x; idx < total; idx += gridDim.x * 512) {
        const int row = idx / 704, c = (idx - row * 704) * 8;
        int sample, b, t, L; seq_of_row(row, sample, b, t, L);
        float g2[8], g1[8], g0[8], uu[8];
        unpack8(*(const u32x4*)(PR + (size_t)row * LDU + c), g2);
        unpack8(*(const u32x4*)(PR + (size_t)row * LDU + DFF + c), uu);
        if (t >= 1) unpack8(*(const u32x4*)(PR + (size_t)(row - 1) * LDU + c), g1);
        else {
#pragma unroll
            for (int j = 0; j < 8; ++j) g1[j] = sample ? st[((size_t)b * 2 + 1) * DFF + c + j] : 0.f;
        }
        if (t >= 2) unpack8(*(const u32x4*)(PR + (size_t)(row - 2) * LDU + c), g0);
        else {
#pragma unroll
            for (int j = 0; j < 8; ++j) g0[j] = sample ? st[((size_t)b * 2 + t) * DFF + c + j] : 0.f;
        }
        float o[8];
#pragma unroll
        for (int j = 0; j < 8; ++j) {
            const float y = cbv[c + j] + cw[c + j] * g0[j] + cw[DFF + c + j] * g1[j] + cw[2 * DFF + c + j] * g2[j];
            o[j] = silu(y) * uu[j];
        }
        u32x4 ov; ov.x = pk2(o[0], o[1]); ov.y = pk2(o[2], o[3]); ov.z = pk2(o[4], o[5]); ov.w = pk2(o[6], o[7]);
        *(u32x4*)(ACT + (size_t)row * DFF + c) = ov;
        if (t >= L - 2) {
            float* dst = p.out + (sample ? O_FCS + (((size_t)l * 128 + b) * 2 + (t - (L - 2))) * DFF : O_FCP + (((size_t)l * 4 + b) * 2 + (t - (L - 2))) * DFF) + c;
            *(f32x4*)dst = (f32x4){g2[0], g2[1], g2[2], g2[3]}; *(f32x4*)(dst + 4) = (f32x4){g2[4], g2[5], g2[6], g2[7]};
        }
    }
}

__device__ __forceinline__ void phase_lruconv(const Params& p) {
    const bf16_t* PR = (const bf16_t*)(p.ws + WS_PROJ); bf16_t* XR = (bf16_t*)(p.ws + WS_XR);
    const float* cw = p.in[23 + p.z]; const float* cbv = p.in[24 + p.z]; const float* st = p.in[7 + p.z];
    const int total = MT * 256;
    for (int idx = blockIdx.x * 512 + threadIdx.x; idx < total; idx += gridDim.x * 512) {
        const int row = idx >> 8, c = (idx & 255) * 8;
        int sample, b, t, L; seq_of_row(row, sample, b, t, L);
        float x[4][8];
#pragma unroll
        for (int j = 0; j < 4; ++j) {
            const int tt = t + j - 3;
            if (tt >= 0) unpack8(*(const u32x4*)(PR + (size_t)(row + j - 3) * LD1 + 8192 + c), x[j]);
            else {
#pragma unroll
                for (int i = 0; i < 8; ++i) x[j][i] = sample ? st[((size_t)b * 3 + (t + j)) * 2048 + c + i] : 0.f;
            }
        }
        float o[8];
#pragma unroll
        for (int i = 0; i < 8; ++i) o[i] = cbv[c + i] + cw[c + i] * x[0][i] + cw[2048 + c + i] * x[1][i] + cw[4096 + c + i] * x[2][i] + cw[6144 + c + i] * x[3][i];
        u32x4 ov; ov.x = pk2(o[0], o[1]); ov.y = pk2(o[2], o[3]); ov.z = pk2(o[4], o[5]); ov.w = pk2(o[6], o[7]);
        *(u32x4*)(XR + (size_t)row * 2048 + c) = ov;
        if (t >= L - 3) {
            float* dst = p.out + (sample ? O_LCS : O_LCP) + ((size_t)b * 3 + (t - (L - 3))) * 2048 + c;
            *(f32x4*)dst = (f32x4){x[3][0], x[3][1], x[3][2], x[3][3]}; *(f32x4*)(dst + 4) = (f32x4){x[3][4], x[3][5], x[3][6], x[3][7]};
        }
    }
}

__device__ __forceinline__ void phase_final(const Params& p) {
    int tid = threadIdx.x; asm volatile("" : "+v"(tid));
    const int wave = tid >> 6, lane = tid & 63;
    const int gw = blockIdx.x * 8 + wave, NGW = gridDim.x * 8;
    const float* X = (const float*)(p.ws + WS_X); const float* ss = (const float*)(p.ws + WS_SS) + 4 * MT; const float* nf = p.in[11 + p.z];
    for (int row = gw; row < MT; row += NGW) {
        const float rs = rsqrtf(ss[row] * (1.0f / 2048.0f) + EPS);
        float* dst = p.out + (row < MP ? O_YP + (size_t)row * 2048 : O_YS + (size_t)(row - MP) * 2048);
#pragma unroll
        for (int j = 0; j < 8; ++j) {
            const int c = (lane + 64 * j) * 4;
            const f32x4 v = *(const f32x4*)(X + (size_t)row * 2048 + c), n = *(const f32x4*)(nf + c);
            *(f32x4*)(dst + c) = v * rs * n;
        }
    }
}

#ifndef PHMASK
#define PHMASK 0xFFFFFFFFu
#endif
#define EN(i) (((PHMASK) >> (i)) & 1u)
__global__ void __launch_bounds__(512, 2) fwd_megakernel(Params p) {
    extern __shared__ __attribute__((aligned(16))) unsigned char shm[];
    float* ldsf = (float*)shm;
    LAS unsigned char* ldsg = (LAS unsigned char*)shm;
    unsigned char* ws = p.ws;
    float* ssb = (float*)(ws + WS_SS);
    for (int ph = p.ph_lo; ph < p.ph_hi; ++ph) {
        if (ph > p.ph_lo) cg::this_grid().sync();
        if (EN(0) && ph == 0) phase_prologue(p, ldsf);
        else if (EN(1) && (ph == 1 || ph == 5 || ph == 8 || ph == 14)) {
            pg8::Gemm g; pg8::EpiScaleBf16 E; int N;
            g.A = (const char*)(ws + WS_XB); g.lda = 2048; g.ldb = 2048; g.nt = 32;
            if (ph == 1) { g.Bt = (const char*)(ws + WS_WIN0); N = LD0; E.ss = ssb; }
            else if (ph == 5) { g.Bt = (const char*)(ws + WS_WUP0); N = LDU; E.ss = ssb + MT; }
            else if (ph == 8) { g.Bt = (const char*)(ws + WS_WIN1); N = LD1; E.ss = ssb + 2 * MT; }
            else { g.Bt = (const char*)(ws + WS_WUP1); N = LDU; E.ss = ssb + 3 * MT; }
            E.O = (bf16_t*)(ws + WS_PROJ); E.ldc = N;
            pg8::Order S; S.nM = MT / 256; S.nN = N / 256; S.nwg = S.nM * S.nN; S.G = gridDim.x; S.c = blockIdx.x;
            S.a_t = (size_t)256 * 2048 * 2; S.b_t = (size_t)256 * 2048 * 2; S.acol = 0;
            pg8::gemm_phase<pg8::EpiScaleBf16>(ldsg, g, S, E);
        }
        else if (EN(4) && (ph == 4 || ph == 7 || ph == 13 || ph == 16)) {
            pg8::Gemm g; pg8::EpiResid E;
            g.A = (const char*)(ws + WS_ACT);
            if (ph == 4) { g.Bt = (const char*)(ws + WS_WOUT0); g.lda = 4096; E.ssout = ssb + MT; }
            else if (ph == 7) { g.Bt = (const char*)(ws + WS_WDN0); g.lda = DFF; E.ssout = ssb + 2 * MT; }
            else if (ph == 13) { g.Bt = (const char*)(ws + WS_WOUT1); g.lda = 4096; E.ssout = ssb + 3 * MT; }
            else { g.Bt = (const char*)(ws + WS_WDN1); g.lda = DFF; E.ssout = ssb + 4 * MT; }
            g.ldb = g.lda; g.nt = g.lda / 64;
            E.X = (float*)(ws + WS_X); E.XB = (bf16_t*)(ws + WS_XB);
            pg8::Order S; S.nM = MT / 256; S.nN = 8; S.nwg = S.nM * 8; S.G = gridDim.x; S.c = blockIdx.x;
            S.a_t = (size_t)256 * g.lda * 2; S.b_t = (size_t)256 * g.ldb * 2; S.acol = 0;
            pg8::gemm_phase<pg8::EpiResid>(ldsg, g, S, E);
        }
        else if (EN(10) && ph == 10) {
            pg8::Gemm g; pg8::EpiLru E;
            g.A = (const char*)(ws + WS_XR); g.Bt = (const char*)(ws + WS_WLRU); g.lda = 2048; g.ldb = 256; g.nt = 4 + (p.ph_hi >> 8);
            E.br = p.in[26 + p.z]; E.bi = p.in[28 + p.z]; E.sp = (const float*)(ws + WS_SP); E.XR = (const bf16_t*)(ws + WS_XR);
            E.LA = (float*)(ws + WS_LA); E.LBv = (bf16_t*)(ws + WS_LBB);
            pg8::Order S; S.nM = MT / 256; S.nN = 16; S.nwg = S.nM * 16; S.G = gridDim.x; S.c = blockIdx.x;
            S.a_t = (size_t)256 * 2048 * 2; S.b_t = (size_t)256 * 256 * 2; S.acol = 512;
            pg8::gemm_phase<pg8::EpiLru>(ldsg, g, S, E);
        }
        else if (EN(2) && ph == 2) phase_rec0(p, ldsf);
        else if (EN(3) && ph == 3) phase_prep0(p);
        else if (EN(6) && ph == 6) phase_act(p, 0);
        else if (EN(9) && ph == 9) phase_lruconv(p);
        else if (EN(11) && ph == 11) phase_rec1(p, ldsf);
        else if (EN(12) && ph == 12) phase_prep1(p);
        else if (EN(15) && ph == 15) phase_act(p, 1);
        else if (EN(17) && ph == 17) phase_final(p);
    }
}

#ifndef N_LAUNCH_MODE
#define N_LAUNCH_MODE 0
#endif

extern "C" void kernel_launch(void* const* d_in, const int* in_sizes, int n_in, void* d_out, int out_size, void* d_ws, size_t ws_size, hipStream_t stream) {
    static int grid = 0;
    if (grid == 0) {
        if (n_in != 35 || (size_t)out_size != O_END || ws_size < WS_END) { fprintf(stderr, "kernel_launch: unexpected shapes: n_in %d out %d ws %zu (need %zu)\n", n_in, out_size, ws_size, (size_t)WS_END); grid = -1; return; }
        int dev = 0, cus = 0, per_cu = 0;
        hipGetDevice(&dev);
        hipDeviceGetAttribute(&cus, hipDeviceAttributeMultiprocessorCount, dev);
        if (hipFuncSetAttribute((const void*)fwd_megakernel, hipFuncAttributeMaxDynamicSharedMemorySize, LDS_BYTES) != hipSuccess) { fprintf(stderr, "kernel_launch: hipFuncSetAttribute failed\n"); grid = -1; return; }
        if (hipOccupancyMaxActiveBlocksPerMultiprocessor(&per_cu, (const void*)fwd_megakernel, 512, LDS_BYTES) != hipSuccess || per_cu < 1) { fprintf(stderr, "kernel_launch: occupancy query says %d\n", per_cu); per_cu = 1; }
        (void)hipGetLastError();
        grid = cus;
    }
    if (grid < 0) return;
    hipMemsetAsync((char*)d_ws + WS_CTL, 0, 4096, stream);
    Params p{};
    for (int i = 0; i < 35; ++i) p.in[i] = (const float*)d_in[i];
    p.z = 0; p.pad = 0;
    p.out = (float*)d_out; p.ws = (unsigned char*)d_ws;
#if N_LAUNCH_MODE == 0
    p.ph_lo = 0; p.ph_hi = NPHASE;
    void* args[] = {&p};
    hipError_t e = hipLaunchCooperativeKernel((const void*)fwd_megakernel, dim3(grid), dim3(512), args, LDS_BYTES, stream);
    if (e != hipSuccess) fprintf(stderr, "cooperative launch failed: %s (grid %d)\n", hipGetErrorString(e), grid);
#else
    for (int ph = 0; ph < NPHASE; ++ph) {
        p.ph_lo = ph; p.ph_hi = ph + 1;
        hipLaunchKernelGGL(fwd_megakernel, dim3(grid), dim3(512), LDS_BYTES, stream, p);
    }
#endif
}
```

```cpp
#include <hip/hip_runtime.h>
#include <hip/hip_cooperative_groups.h>
#include <cstdio>
#include <cstdint>
namespace cg = cooperative_groups;

#define LAS __attribute__((address_space(3)))
typedef unsigned short bf16_t;
typedef short bf16x8 __attribute__((ext_vector_type(8)));
typedef float f32x4 __attribute__((ext_vector_type(4)));
typedef float f32x2 __attribute__((ext_vector_type(2)));
typedef unsigned u32x4 __attribute__((ext_vector_type(4)));
typedef unsigned u32x2 __attribute__((ext_vector_type(2)));

constexpr int D = 2048, MP = 8192, MS = 512, MT = 8704;
constexpr int LD0 = 11520, LD1 = 12288, LDU = 11264, DFF = 5632;
constexpr float EPS = 1e-6f;
constexpr size_t O_YP = 0;
constexpr size_t O_YS = O_YP + (size_t)4 * 2048 * 2048;
constexpr size_t O_SSMP = O_YS + (size_t)128 * 4 * 2048;
constexpr size_t O_SSMS = O_SSMP + (size_t)4 * 32 * 128 * 64;
constexpr size_t O_SCP = O_SSMS + (size_t)128 * 32 * 128 * 64;
constexpr size_t O_SCS = O_SCP + (size_t)4 * 3 * 3072;
constexpr size_t O_RETP = O_SCS + (size_t)128 * 3 * 3072;
constexpr size_t O_RETS = O_RETP + (size_t)4 * 8 * 128 * 256;
constexpr size_t O_HGP = O_RETS + (size_t)128 * 8 * 128 * 256;
constexpr size_t O_HGS = O_HGP + (size_t)4 * 16 * 128 * 128;
constexpr size_t O_LRUP = O_HGS + (size_t)128 * 16 * 128 * 128;
constexpr size_t O_LRUS = O_LRUP + (size_t)4 * 2048;
constexpr size_t O_LCP = O_LRUS + (size_t)128 * 2048;
constexpr size_t O_LCS = O_LCP + (size_t)4 * 3 * 2048;
constexpr size_t O_FCP = O_LCS + (size_t)128 * 3 * 2048;
constexpr size_t O_FCS = O_FCP + (size_t)2 * 4 * 2 * 5632;
constexpr size_t O_END = O_FCS + (size_t)2 * 128 * 2 * 5632;
constexpr size_t al256(size_t x) { return (x + 255) & ~(size_t)255; }
constexpr size_t WS_CTL = 0;
constexpr size_t WS_SS = 16384;
constexpr size_t WS_SP = al256(WS_SS + (size_t)5 * MT * 4);
constexpr size_t WS_LB = WS_SP + 8192;
constexpr size_t WS_WIN0 = WS_LB + 8192;
constexpr size_t WS_WOUT0 = WS_WIN0 + (size_t)LD0 * 2048 * 2;
constexpr size_t WS_WUP0 = WS_WOUT0 + (size_t)2048 * 4096 * 2;
constexpr size_t WS_WDN0 = WS_WUP0 + (size_t)LDU * 2048 * 2;
constexpr size_t WS_WIN1 = WS_WDN0 + (size_t)2048 * DFF * 2;
constexpr size_t WS_WOUT1 = WS_WIN1 + (size_t)LD1 * 2048 * 2;
constexpr size_t WS_WUP1 = WS_WOUT1 + (size_t)2048 * 4096 * 2;
constexpr size_t WS_WDN1 = WS_WUP1 + (size_t)LDU * 2048 * 2;
constexpr size_t WS_WLRU = WS_WDN1 + (size_t)2048 * DFF * 2;
constexpr size_t WS_X = WS_WLRU + (size_t)16 * 256 * 256 * 2;
constexpr size_t WS_XB = WS_X + (size_t)MT * 2048 * 4;
constexpr size_t WS_PROJ = WS_XB + (size_t)MT * 2048 * 2;
constexpr size_t WS_ACT = WS_PROJ + (size_t)MT * LD1 * 2;
constexpr size_t WS_YZ = WS_ACT + (size_t)MT * DFF * 2;
constexpr size_t WS_LA = WS_YZ + (size_t)MT * 4096 * 2;
constexpr size_t WS_LBB = WS_LA + (size_t)MT * 2048 * 4;
constexpr size_t WS_XR = WS_LBB + (size_t)MT * 2048 * 2;
constexpr size_t WS_END = WS_XR + (size_t)MT * 2048 * 2;

constexpr int LDS_BYTES = 131072 + 256;
constexpr int NPHASE = 18;

struct Params {
    const float* in[35];
    float* out;
    unsigned char* ws;
    int ph_lo, ph_hi;
    int z, pad;
};

__device__ __forceinline__ float bf2f(unsigned v) { return __uint_as_float(v << 16); }
__device__ __forceinline__ unsigned pk2(float lo, float hi) { unsigned r; asm volatile("v_cvt_pk_bf16_f32 %0, %1, %2" : "=v"(r) : "v"(lo), "v"(hi)); return r; }
__device__ __forceinline__ bf16_t f2bf(float x) { return (bf16_t)(pk2(x, 0.f) & 0xffffu); }
__device__ __forceinline__ float sigm(float x) { return __builtin_amdgcn_rcpf(1.f + __expf(-x)); }
__device__ __forceinline__ float silu(float x) { return x * __builtin_amdgcn_rcpf(1.f + __expf(-x)); }
__device__ __forceinline__ float softplus(float x) { return fmaxf(x, 0.f) + log1pf(__expf(-fabsf(x))); }
__device__ __forceinline__ float gelu_tanh(float x) { const float u = 0.7978845608f * (x + 0.044715f * x * x * x); const float t = 1.f - 2.f * __builtin_amdgcn_rcpf(1.f + __expf(2.f * u)); return 0.5f * x * (1.f + t); }
__device__ __forceinline__ float wave_sum(float v) {
#pragma unroll
    for (int o = 1; o < 64; o <<= 1) v += __shfl_xor(v, o);
    return v;
}
__device__ __forceinline__ void unpack8(u32x4 r, float* f) {
    f[0] = bf2f(r.x & 0xffffu); f[1] = __uint_as_float(r.x & 0xffff0000u); f[2] = bf2f(r.y & 0xffffu); f[3] = __uint_as_float(r.y & 0xffff0000u);
    f[4] = bf2f(r.z & 0xffffu); f[5] = __uint_as_float(r.z & 0xffff0000u); f[6] = bf2f(r.w & 0xffffu); f[7] = __uint_as_float(r.w & 0xffff0000u);
}
__device__ __forceinline__ void unpack4(u32x2 r, float* f) {
    f[0] = bf2f(r.x & 0xffffu); f[1] = __uint_as_float(r.x & 0xffff0000u); f[2] = bf2f(r.y & 0xffffu); f[3] = __uint_as_float(r.y & 0xffff0000u);
}
#define LDS_WAIT() asm volatile("s_waitcnt lgkmcnt(0)" ::: "memory")

namespace pg8 {
constexpr int BM = 256, BK = 64, HALF = 128, HTB = HALF * BK * 2, NXCD = 8, WGM = 8;
__device__ __forceinline__ int lds_byte(int r, int c) { const int st = (r >> 4) * 2 + (c >> 5), rr = r & 15, cc = c & 31, ob = rr * 64 + cc * 2; return st * 1024 + (ob ^ (((ob >> 9) & 1) << 5)); }
__device__ __forceinline__ void stage_rc(int b, int& R, int& C) { const int st = b / 1024, sb = b % 1024, swz = sb ^ (((sb >> 9) & 1) << 5); R = (st >> 1) * 16 + swz / 64; C = (st & 1) * 32 + (swz % 64) / 2; }
__device__ __forceinline__ int perm32(int rho) { const int n = rho >> 4, i = rho & 15; return 8 * (i >> 2) + 4 * n + (i & 3); }

struct Unit { int pm, pn; size_t aoff, boff; };
struct Gemm { const char* A; const char* Bt; int lda, ldb, nt; };
struct Order {
    int nM, nN, nwg, G, c; size_t a_t, b_t, acol;
    __device__ __forceinline__ bool next(int i, Unit& u) const {
        const long L = (long)i * G + c; if (L >= nwg) return false;
        int wgid = (int)L; { const int q = nwg / NXCD, r = nwg % NXCD, xcd = wgid % NXCD, off = wgid / NXCD; wgid = (xcd < r ? xcd * (q + 1) : r * (q + 1) + (xcd - r) * q) + off; }
        const int nig = WGM * nN, gid = wgid / nig, fm = gid * WGM, gsz = (nM - fm) < WGM ? (nM - fm) : WGM;
        u.pm = fm + ((wgid % nig) % gsz); u.pn = (wgid % nig) / gsz;
        u.aoff = (size_t)u.pm * a_t + (size_t)(u.pn >> 1) * acol; u.boff = (size_t)u.pn * b_t; return true;
    }
};

struct EpiScaleBf16 {
    static constexpr bool PERM = true;
    bf16_t* O; int ldc; const float* ss;
    __device__ __forceinline__ void operator()(const f32x4 (&acc)[2][2][4][2], const Unit& u, int wr, int wc, int fr, int fq) const {
        const int row0 = u.pm * BM + wr * 64 + fr, col0 = u.pn * BM + wc * 32 + 8 * fq;
#pragma unroll
        for (int ai = 0; ai < 2; ++ai)
#pragma unroll
            for (int m = 0; m < 4; ++m) {
                const int row = row0 + ai * HALF + m * 16;
                const float rs = rsqrtf(ss[row] * (1.0f / 2048.0f) + EPS);
                bf16_t* rowp = O + ((unsigned)row * (unsigned)ldc + (unsigned)col0);
#pragma unroll
                for (int bj = 0; bj < 2; ++bj) {
                    const f32x4 v0 = acc[ai][bj][m][0] * rs, v1 = acc[ai][bj][m][1] * rs;
                    u32x4 w; w.x = pk2(v0[0], v0[1]); w.y = pk2(v0[2], v0[3]); w.z = pk2(v1[0], v1[1]); w.w = pk2(v1[2], v1[3]);
                    *(u32x4*)(rowp + bj * HALF) = w;
                }
            }
    }
};
struct EpiResid {
    static constexpr bool PERM = false;
    float* X; bf16_t* XB; float* ssout;
    __device__ __forceinline__ void operator()(const f32x4 (&acc)[2][2][4][2], const Unit& u, int wr, int wc, int fr, int fq) const {
        const int row0 = u.pm * BM + wr * 64 + fr, col0 = u.pn * BM + wc * 32 + 4 * fq;
#pragma unroll
        for (int ai = 0; ai < 2; ++ai)
#pragma unroll
            for (int m = 0; m < 4; ++m) {
                const int row = row0 + ai * HALF + m * 16;
                const unsigned off = (unsigned)row * 2048u + (unsigned)col0;
                float sq = 0.f;
#pragma unroll
                for (int bj = 0; bj < 2; ++bj)
#pragma unroll
                    for (int n = 0; n < 2; ++n) {
                        const unsigned o = off + bj * HALF + n * 16;
                        f32x4 x = *(const f32x4*)(X + o) + acc[ai][bj][m][n];
                        *(f32x4*)(X + o) = x;
                        u32x2 w; w.x = pk2(x[0], x[1]); w.y = pk2(x[2], x[3]);
                        *(u32x2*)(XB + o) = w;
                        sq += (x[0] * x[0] + x[1] * x[1]) + (x[2] * x[2] + x[3] * x[3]);
                    }
                sq += __shfl_xor(sq, 16); sq += __shfl_xor(sq, 32);
                if (fq == 0) atomicAdd(ssout + row, sq);
                asm volatile("" ::: "memory");
            }
    }
};
struct EpiLru {
    static constexpr bool PERM = false;
    const float* br; const float* bi; const float* sp; const bf16_t* XR; float* LA; bf16_t* LBv;
    __device__ __forceinline__ void operator()(const f32x4 (&acc)[2][2][4][2], const Unit& u, int wr, int wc, int fr, int fq) const {
        const int row0 = u.pm * BM + wr * 64 + fr;
        const int cbase = (u.pn >> 1) * 256 + (u.pn & 1) * 128 + wc * 32 + 4 * fq;
#pragma unroll
        for (int ai = 0; ai < 2; ++ai)
#pragma unroll
            for (int m = 0; m < 4; ++m) {
                const int row = row0 + ai * HALF + m * 16;
                const bool first = (row < MP) && ((row & 2047) == 0);
#pragma unroll
                for (int n = 0; n < 2; ++n) {
                    const int c = cbase + n * 16;
                    const f32x4 br4 = *(const f32x4*)(br + c), bi4 = *(const f32x4*)(bi + c), sp4 = *(const f32x4*)(sp + c);
                    const unsigned o = (unsigned)row * 2048u + (unsigned)c;
                    float xr[4]; unpack4(*(const u32x2*)(XR + o), xr);
                    f32x4 av; float bb[4];
#pragma unroll
                    for (int j = 0; j < 4; ++j) {
                        const float r = sigm(acc[ai][0][m][n][j] + br4[j]), gi = sigm(acc[ai][1][m][n][j] + bi4[j]);
                        const float la = -8.0f * r * sp4[j];
                        const float a = __expf(la);
                        const float mult = first ? 1.0f : __builtin_amdgcn_sqrtf(fmaxf(1.0f - a * a, 0.f));
                        av[j] = a; bb[j] = mult * gi * xr[j];
                    }
                    *(f32x4*)(LA + o) = av;
                    u32x2 w; w.x = pk2(bb[0], bb[1]); w.y = pk2(bb[2], bb[3]);
                    *(u32x2*)(LBv + o) = w;
                    asm volatile("" ::: "memory");
                }
            }
    }
};

template <class Epi>
__device__ __forceinline__ void gemm_phase(LAS unsigned char* lds, const Gemm g, const Order& S, const Epi& E) {
    int tid = threadIdx.x; asm volatile("" : "+v"(tid));
    const int wid = __builtin_amdgcn_readfirstlane(tid >> 6), lane = tid & 63, wr = wid >> 2, wc = wid & 3, fr = lane & 15, fq = lane >> 4;
    const int nt = g.nt;
    unsigned voffA[2], voffB[2];
#pragma unroll
    for (int i = 0; i < 2; ++i) { int R, C; stage_rc(tid * 16 + i * 8192, R, C); const int Rb = Epi::PERM ? ((R & ~31) + perm32(R & 31)) : R;
        voffA[i] = (unsigned)(R * g.lda + C) * 2u; voffB[i] = (unsigned)(Rb * g.ldb + C) * 2u; }
    const size_t kstep = (size_t)(BK * 2);
    const size_t hstepA = (size_t)HALF * g.lda * 2, hstepB = (size_t)HALF * g.ldb * 2;
    const unsigned ldsw = (unsigned)wid * 1024u;
    const int aoff = lds_byte(wr * 64 + fr, fq * 8), boff = lds_byte(wc * 32 + fr, fq * 8);
#define PG8_SA(b, h) (((b) * 2 + (h)) * HTB)
#define PG8_SB(b, h) ((4 + (b) * 2 + (h)) * HTB)
#define PG8_STAGE(bufoff, gbase, voff) do { _Pragma("unroll") for (int _i = 0; _i < 2; ++_i) \
        __builtin_amdgcn_global_load_lds((const unsigned*)((const char*)(gbase) + (voff)[_i]), (LAS unsigned*)(lds + (bufoff) + ldsw + _i * 8192), 16, 0, 0); } while (0)
#define PG8_LDA(dst, b, h) do { _Pragma("unroll") for (int m = 0; m < 4; ++m) _Pragma("unroll") for (int k = 0; k < 2; ++k) dst[m][k] = *(const LAS bf16x8*)(lds + PG8_SA(b, h) + aoff + m * 2048 + k * 1024); } while (0)
#define PG8_LDB(dst, b, h) do { _Pragma("unroll") for (int n = 0; n < 2; ++n) _Pragma("unroll") for (int k = 0; k < 2; ++k) dst[n][k] = *(const LAS bf16x8*)(lds + PG8_SB(b, h) + boff + n * 2048 + k * 1024); } while (0)
#define PG8_MMA(ai, bj, At, Bt) do { __builtin_amdgcn_s_setprio(1); _Pragma("unroll") for (int m = 0; m < 4; ++m) _Pragma("unroll") for (int n = 0; n < 2; ++n) _Pragma("unroll") for (int k = 0; k < 2; ++k) \
        acc[ai][bj][m][n] = __builtin_amdgcn_mfma_f32_16x16x32_bf16(Bt[n][k], At[m][k], acc[ai][bj][m][n], 0, 0, 0); __builtin_amdgcn_s_setprio(0); } while (0)
#define PG8_WAIT_V(n) asm volatile("s_waitcnt vmcnt(" #n ")" ::: "memory")
#define PG8_WAIT_L(n) asm volatile("s_waitcnt lgkmcnt(" #n ")" ::: "memory")
#define PG8_BAR __builtin_amdgcn_s_barrier()
#define PG8_SCHED __builtin_amdgcn_sched_barrier(0)
    Unit cur, nxt; int ui = 0;
    if (!S.next(0, cur)) return;
    f32x4 acc[2][2][4][2];
#pragma unroll
    for (int a = 0; a < 2; ++a)
#pragma unroll
        for (int b = 0; b < 2; ++b)
#pragma unroll
            for (int m = 0; m < 4; ++m)
#pragma unroll
                for (int n = 0; n < 2; ++n) acc[a][b][m][n] = (f32x4){0.f, 0.f, 0.f, 0.f};
    bf16x8 At[4][2], B0[2][2], B1[2][2];
    const char* cA = g.A + cur.aoff; const char* cB = g.Bt + cur.boff;
    PG8_STAGE(PG8_SB(0, 0), cB, voffB); PG8_STAGE(PG8_SA(0, 0), cA, voffA); PG8_STAGE(PG8_SB(0, 1), cB + hstepB, voffB); PG8_STAGE(PG8_SA(0, 1), cA + hstepA, voffA);
    if (wr == 1) PG8_BAR;
    PG8_WAIT_V(4); PG8_BAR;
    PG8_STAGE(PG8_SB(1, 0), cB + kstep, voffB); PG8_STAGE(PG8_SA(1, 0), cA + kstep, voffA); PG8_STAGE(PG8_SB(1, 1), cB + hstepB + kstep, voffB);
    PG8_WAIT_V(6); PG8_BAR;
    for (;;) {
        const bool has_next = S.next(ui + 1, nxt);
        const char* nA = has_next ? g.A + nxt.aoff : cA; const char* nB = has_next ? g.Bt + nxt.boff : cB;
        for (int t = 0; t < nt; t += 2) {
            const bool last = (t == nt - 2);
            const char* a1 = cA + (size_t)(t + 1) * kstep;
            const char* a2 = last ? nA : cA + (size_t)(t + 2) * kstep; const char* b2 = last ? nB : cB + (size_t)(t + 2) * kstep;
            const char* a3 = a2 + kstep; const char* b3 = b2 + kstep;
            PG8_LDB(B0, 0, 0); PG8_SCHED; PG8_LDA(At, 0, 0); PG8_STAGE(PG8_SA(1, 1), a1 + hstepA, voffA);
            PG8_WAIT_L(8); PG8_BAR; PG8_WAIT_L(0); PG8_MMA(0, 0, At, B0); PG8_BAR; PG8_SCHED;
            PG8_LDB(B1, 0, 1); PG8_STAGE(PG8_SB(0, 0), b2, voffB);
            PG8_BAR; PG8_WAIT_L(0); PG8_MMA(0, 1, At, B1); PG8_BAR;
            PG8_LDA(At, 0, 1); PG8_STAGE(PG8_SA(0, 0), a2, voffA);
            PG8_BAR; PG8_WAIT_L(0); PG8_MMA(1, 0, At, B0); PG8_BAR; PG8_SCHED;
            PG8_STAGE(PG8_SB(0, 1), b2 + hstepB, voffB);
            PG8_WAIT_V(6); PG8_BAR; PG8_MMA(1, 1, At, B1); PG8_BAR;
            PG8_LDB(B0, 1, 0); PG8_SCHED; PG8_LDA(At, 1, 0); PG8_STAGE(PG8_SA(0, 1), a2 + hstepA, voffA);
            PG8_WAIT_L(8); PG8_BAR; PG8_WAIT_L(0); PG8_MMA(0, 0, At, B0); PG8_BAR; PG8_SCHED;
            PG8_LDB(B1, 1, 1); PG8_STAGE(PG8_SB(1, 0), b3, voffB);
            PG8_BAR; PG8_WAIT_L(0); PG8_MMA(0, 1, At, B1); PG8_BAR;
            PG8_LDA(At, 1, 1); PG8_STAGE(PG8_SA(1, 0), a3, voffA);
            PG8_BAR; PG8_WAIT_L(0); PG8_MMA(1, 0, At, B0); PG8_BAR; PG8_SCHED;
            PG8_STAGE(PG8_SB(1, 1), b3 + hstepB, voffB);
            PG8_WAIT_V(6); PG8_BAR; PG8_MMA(1, 1, At, B1); PG8_BAR;
        }
        E(acc, cur, wr, wc, fr, fq);
        if (!has_next) break;
#pragma unroll
        for (int a = 0; a < 2; ++a)
#pragma unroll
            for (int b = 0; b < 2; ++b)
#pragma unroll
                for (int m = 0; m < 4; ++m)
#pragma unroll
                    for (int n = 0; n < 2; ++n) acc[a][b][m][n] = (f32x4){0.f, 0.f, 0.f, 0.f};
        cur = nxt; cA = nA; cB = nB; ++ui;
    }
    PG8_WAIT_V(0);
    if (wr == 0) PG8_BAR;
    PG8_BAR;
#undef PG8_SA
#undef PG8_SB
#undef PG8_STAGE
#undef PG8_LDA
#undef PG8_LDB
#undef PG8_MMA
#undef PG8_WAIT_V
#undef PG8_WAIT_L
#undef PG8_BAR
#undef PG8_SCHED
}
}

__device__ __forceinline__ void tr_item(const float* __restrict__ W, int ldw, int k0, int n0, const float* __restrict__ scale, bf16_t* __restrict__ dst, int ldd, float* scr, int lane) {
#pragma unroll 8
    for (int i = 0; i < 32; ++i) { const int kk = 2 * i + (lane >> 5); float v = W[(size_t)(k0 + kk) * ldw + n0 + (lane & 31)]; if (scale) v *= scale[k0 + kk]; scr[kk * 33 + (lane & 31)] = v; }
    LDS_WAIT();
    const int c = lane & 7;
#pragma unroll
    for (int j = 0; j < 4; ++j) { const int n = (lane >> 3) + 8 * j; const float* s = scr + (8 * c) * 33 + n;
        u32x4 o; o.x = pk2(s[0 * 33], s[1 * 33]); o.y = pk2(s[2 * 33], s[3 * 33]); o.z = pk2(s[4 * 33], s[5 * 33]); o.w = pk2(s[6 * 33], s[7 * 33]);
        *(u32x4*)(dst + (size_t)n * ldd + 8 * c) = o; }
    LDS_WAIT();
}

__device__ __forceinline__ void phase_prologue(const Params& p, float* ldsf) {
    int tid = threadIdx.x; asm volatile("" : "+v"(tid));
    const int wave = tid >> 6, lane = tid & 63;
    const int gw = blockIdx.x * 8 + wave, NGW = gridDim.x * 8;
    float* scr = ldsf + wave * 2304;
    unsigned char* ws = p.ws;
    constexpr int I0 = 32 * 353, I1 = 64 * 64, I2 = 32 * 352, I3 = 88 * 64, I4 = 32 * 384, I5 = I1, I6 = I2, I7 = I3, I8 = 256, I9 = 256;
    constexpr int NIT = I0 + I1 + I2 + I3 + I4 + I5 + I6 + I7 + I8 + I9;
    for (int it = gw; it < NIT; it += NGW) {
        int r = it;
        const float* W; int K, N; const float* sc = nullptr; bf16_t* WT;
        if (r < I0) { W = p.in[12 + p.z]; K = 2048; N = 11296; sc = p.in[9 + p.z]; WT = (bf16_t*)(ws + WS_WIN0); }
        else if ((r -= I0) < I1) { W = p.in[19 + p.z]; K = 4096; N = 2048; WT = (bf16_t*)(ws + WS_WOUT0); }
        else if ((r -= I1) < I2) { W = p.in[31 + p.z]; K = 2048; N = 11264; sc = p.in[10 + p.z]; WT = (bf16_t*)(ws + WS_WUP0); }
        else if ((r -= I2) < I3) { W = p.in[34 + p.z]; K = 5632; N = 2048; WT = (bf16_t*)(ws + WS_WDN0); }
        else if ((r -= I3) < I4) { W = p.in[20 + p.z]; K = 2048; N = 12288; sc = p.in[9 + p.z] + 2048; WT = (bf16_t*)(ws + WS_WIN1); }
        else if ((r -= I4) < I5) { W = p.in[30 + p.z]; K = 4096; N = 2048; WT = (bf16_t*)(ws + WS_WOUT1); }
        else if ((r -= I5) < I6) { W = p.in[31 + p.z] + (size_t)2048 * 11264; K = 2048; N = 11264; sc = p.in[10 + p.z] + 2048; WT = (bf16_t*)(ws + WS_WUP1); }
        else if ((r -= I6) < I7) { W = p.in[34 + p.z] + (size_t)5632 * 2048; K = 5632; N = 2048; WT = (bf16_t*)(ws + WS_WDN1); }
        else {
            r -= I7; const int which = r >> 8; r &= 255;
            const int blk = r >> 5, kb = (r >> 3) & 3, nb = r & 7, n0 = 32 * nb, k0 = 64 * kb;
            const float* Wl = (which ? p.in[27 + p.z] : p.in[25 + p.z]) + (size_t)blk * 65536;
            const int drow = (blk * 2 + (n0 >> 7)) * 256 + which * 128 + (n0 & 127);
            tr_item(Wl, 256, k0, n0, nullptr, (bf16_t*)(ws + WS_WLRU) + (size_t)drow * 256 + k0, 256, scr, lane);
            continue;
        }
        const int nblk = N / 32, kb = r / nblk, nb = r % nblk, k0 = 64 * kb, n0 = 32 * nb;
        tr_item(W, N, k0, n0, sc, WT + (size_t)n0 * K + k0, K, scr, lane);
    }
    {
        u32x4* z = (u32x4*)((bf16_t*)(ws + WS_WIN0) + (size_t)11296 * 2048);
        const int n16 = 224 * 2048 * 2 / 16;
        for (int i = blockIdx.x * 512 + tid; i < n16; i += gridDim.x * 512) z[i] = (u32x4){0u, 0u, 0u, 0u};
    }
    float* X = (float*)(ws + WS_X); bf16_t* XB = (bf16_t*)(ws + WS_XB); float* ss = (float*)(ws + WS_SS);
    for (int row = gw; row < MT; row += NGW) {
        const float* src = row < MP ? p.in[0 + p.z] + (size_t)row * 2048 : p.in[1 + p.z] + (size_t)(row - MP) * 2048;
        float s = 0.f;
#pragma unroll
        for (int j = 0; j < 8; ++j) {
            const f32x4 v = *(const f32x4*)(src + (lane + 64 * j) * 4);
            *(f32x4*)(X + (size_t)row * 2048 + (lane + 64 * j) * 4) = v;
            u32x2 w; w.x = pk2(v[0], v[1]); w.y = pk2(v[2], v[3]);
            *(u32x2*)(XB + (size_t)row * 2048 + (lane + 64 * j) * 4) = w;
            s += (v[0] * v[0] + v[1] * v[1]) + (v[2] * v[2] + v[3] * v[3]);
        }
        s = wave_sum(s);
        if (lane == 0) ss[row] = s;
    }
    for (int i = blockIdx.x * 512 + tid; i < 4 * MT; i += gridDim.x * 512) ss[MT + i] = 0.f;
    for (int i = blockIdx.x * 512 + tid; i < 2048; i += gridDim.x * 512) {
        ((float*)(ws + WS_SP))[i] = softplus(-p.in[29 + p.z][i]);
        ((float*)(ws + WS_LB))[i] = sigm(p.in[21 + p.z][2048 + i] - p.in[21 + p.z][i]);
    }
}

__device__ __forceinline__ int next_item(unsigned* ctr, float* ldsf) {
    __syncthreads();
    if (threadIdx.x == 0) ((volatile unsigned*)ldsf)[24576] = atomicAdd(ctr, 1u);
    __syncthreads();
    return (int)((volatile unsigned*)ldsf)[24576];
}

template <int TYPE, int VW>
__device__ __forceinline__ void rec_item(const Params& p, float* ldsf, int sample, int b, int h, int s) {
    constexpr int NV = VW / 16;
    typedef float VT __attribute__((ext_vector_type(NV)));
    int tid = threadIdx.x; asm volatile("" : "+v"(tid));
    const int w = tid >> 6, lane = tid & 63, kg = lane >> 4, vq = lane & 15, kb = 16 * w + 4 * kg;
    const int L = sample ? 4 : 2048, row0 = sample ? MP + 4 * b : 2048 * b, pos0 = sample ? 16384 : 0;
    constexpr int LDP = TYPE < 2 ? LD0 : LD1;
    const bf16_t* proj = (const bf16_t*)(p.ws + WS_PROJ) + (size_t)row0 * LDP;
    bf16_t* yz = (bf16_t*)(p.ws + WS_YZ) + (size_t)row0 * 4096;
    float* part = ldsf + 8192;
    int colA = -1, colB = -1, role = -1, didx = 0;
    float w0 = 0.f, w1 = 0.f, w2 = 0.f, w3 = 0.f, cbias = 0.f, c0 = 0.f, c1 = 0.f, c2 = 0.f, aux = 0.f, aux2 = 0.f;
    if constexpr (TYPE == 0) {
        if (tid < 320) {
            role = tid < 128 ? 0 : (tid < 256 ? 1 : 2);
            didx = tid < 128 ? tid : (tid < 256 ? tid - 128 : tid - 256);
            const int ch = tid < 128 ? 2560 + (h >> 3) * 128 + tid : (tid < 256 ? 2048 + (h >> 3) * 128 + (tid - 128) : h * 64 + (tid - 256));
            colA = 2048 + ch;
            const float* cw = p.in[13 + p.z];
            w0 = cw[ch]; w1 = cw[3072 + ch]; w2 = cw[2 * 3072 + ch]; w3 = cw[3 * 3072 + ch]; cbias = p.in[14 + p.z][ch];
            if (sample) { const float* st = p.in[3 + p.z] + (size_t)b * 3 * 3072; c0 = st[ch]; c1 = st[3072 + ch]; c2 = st[2 * 3072 + ch]; }
        } else if (tid < 328) { role = 3; didx = tid - 320; colA = 5120 + h; aux = p.in[15 + p.z][h]; aux2 = -__expf(p.in[16 + p.z][h]); }
    } else if constexpr (TYPE == 1) {
        if (tid < 128) { role = tid < 64 ? 0 : 1; didx = tid & 63; colA = (tid < 64 ? 5152 : 6176) + h * 128 + didx; colB = colA + 64;
            aux = exp2f(-(float)didx * 0.20762050593046014f); }
        else if (tid < 128 + VW) { role = 2; didx = tid - 128; colA = 7200 + h * 256 + s * VW + didx; }
    } else {
        if (tid < 128) { role = 0; didx = tid; colA = h * 128 + tid; }
        else if (tid < 256) { role = 1; didx = tid - 128; colA = 2048 + h * 128 + didx; aux = ((const float*)(p.ws + WS_LB))[h * 128 + didx]; }
        else if (tid < 256 + VW) { role = 2; didx = tid - 256; colA = 4096 + h * 128 + s * VW + didx; }
    }
    const float Dh = TYPE == 0 ? p.in[17 + p.z][h] : 0.f;
    const float gamma = TYPE == 1 ? 1.0f - exp2f(-5.0f - (float)h * (4.0f / 7.0f)) : 0.f;
    const int ldS = TYPE == 0 ? 64 : (TYPE == 1 ? 256 : 128);
    size_t soff;
    if constexpr (TYPE == 0) soff = ((size_t)(b * 32 + h) * 128) * 64;
    else if constexpr (TYPE == 1) soff = ((size_t)(b * 8 + h) * 128) * 256 + s * VW;
    else soff = ((size_t)(b * 16 + h) * 128) * 128 + s * VW;
    const float* S0 = TYPE == 0 ? p.in[2 + p.z] : (TYPE == 1 ? p.in[4 + p.z] : p.in[5 + p.z]);
    float* Sout = p.out + (TYPE == 0 ? (sample ? O_SSMS : O_SSMP) : (TYPE == 1 ? (sample ? O_RETS : O_RETP) : (sample ? O_HGS : O_HGP))) + soff;
    VT S[4];
#pragma unroll
    for (int i = 0; i < 4; ++i) { if (sample) S[i] = *(const VT*)(S0 + soff + (size_t)(kb + i) * ldS + NV * vq); else S[i] = (VT)(0.f); }
    unsigned short ra[8], rb[8]; unsigned short zr = 0;
    const int R = (L + 7) >> 3;
    auto load_raw = [&](int r) {
#pragma unroll
        for (int t = 0; t < 8; ++t) {
            const int tt = 8 * r + t;
            ra[t] = 0; rb[t] = 0;
            if (tt < L) {
                if (colA >= 0) ra[t] = proj[(size_t)tt * LDP + colA];
                if (TYPE == 1 && colB >= 0) rb[t] = proj[(size_t)tt * LDP + colB];
            }
        }
        if (TYPE == 0) { const int tt = 8 * r + w; if (tt < L) zr = proj[(size_t)tt * LDP + h * 64 + lane]; }
    };
    load_raw(0);
    for (int r = 0; r < R; ++r) {
        const int nv = (L - 8 * r) < 8 ? (L - 8 * r) : 8;
        float* stg = ldsf + (r & 1) * 4096;
        float* qs = stg; float* ks = stg + 1024; float* as = stg + 2048; float* vs = stg + 3072; float* ad = stg + 3584;
        if constexpr (TYPE == 0) {
            if (role >= 0 && role < 3) {
                float* dst = role == 0 ? qs : (role == 1 ? ks : vs); const int dstr = role == 2 ? 64 : 128;
#pragma unroll
                for (int t = 0; t < 8; ++t) {
                    const float x = bf2f(ra[t]);
                    const float y = cbias + w0 * c0 + w1 * c1 + w2 * c2 + w3 * x;
                    c0 = c1; c1 = c2; c2 = x;
                    dst[t * dstr + didx] = silu(y);
                }
            } else if (role == 3) {
                float xv = 0.f;
#pragma unroll
                for (int t = 0; t < 8; ++t) if (t == didx) xv = bf2f(ra[t]);
                const float dt = softplus(xv + aux);
                ad[2 * didx] = __expf(dt * aux2); ad[2 * didx + 1] = dt;
            }
        } else if constexpr (TYPE == 1) {
            if (role == 0 || role == 1) {
                float* dst = role == 0 ? qs : ks; const float sc = role == 0 ? 1.0f : 0.08838834764831845f;
#pragma unroll
                for (int t = 0; t < 8; ++t) {
                    const int pos = pos0 + 8 * r + t;
                    const double rev = (double)pos * (double)aux * 0.15915494309189535;
                    const float fr = (float)(rev - floor(rev));
                    const float sn = __builtin_amdgcn_sinf(fr), cs = __builtin_amdgcn_cosf(fr);
                    const float x1 = bf2f(ra[t]) * sc, x2 = bf2f(rb[t]) * sc;
                    dst[t * 128 + didx] = x1 * cs - x2 * sn;
                    dst[t * 128 + 64 + didx] = x1 * sn + x2 * cs;
                }
            } else if (role == 2) {
#pragma unroll
                for (int t = 0; t < 8; ++t) vs[t * VW + didx] = bf2f(ra[t]);
            }
        } else {
            if (role == 0) {
#pragma unroll
                for (int t = 0; t < 8; ++t) qs[t * 128 + didx] = silu(bf2f(ra[t]));
            } else if (role == 1) {
#pragma unroll
                for (int t = 0; t < 8; ++t) { const float f = aux + (1.0f - aux) * sigm(bf2f(ra[t])); as[t * 128 + didx] = f; ks[t * 128 + didx] = 1.0f - f; }
            } else if (role == 2) {
#pragma unroll
                for (int t = 0; t < 8; ++t) vs[t * VW + didx] = bf2f(ra[t]);
            }
        }
        const unsigned short zc = zr;
        __syncthreads();
        if (r + 1 < R) load_raw(r + 1);
        for (int t0 = 0; t0 < nv; t0 += 4) {
#pragma unroll
            for (int tt = 0; tt < 4; ++tt) {
                const int t = t0 + tt;
                const f32x4 q4 = *(const f32x4*)(qs + t * 128 + kb);
                f32x4 k4 = *(const f32x4*)(ks + t * 128 + kb);
                const VT v4 = *(const VT*)(vs + t * VW + NV * vq);
                f32x4 a4;
                if constexpr (TYPE == 0) { const f32x2 adv = *(const f32x2*)(ad + 2 * t); a4 = (f32x4){adv.x, adv.x, adv.x, adv.x}; k4 = k4 * adv.y; }
                else if constexpr (TYPE == 1) a4 = (f32x4){gamma, gamma, gamma, gamma};
                else a4 = *(const f32x4*)(as + t * 128 + kb);
                VT o = (VT)(0.f);
#pragma unroll
                for (int i = 0; i < 4; ++i) { S[i] = a4[i] * S[i] + k4[i] * v4; o += q4[i] * S[i]; }
                *(VT*)(part + ((t * 32 + w * 4 + kg) * VW + NV * vq)) = o;
            }
        }
        __syncthreads();
        const int rt = tid / VW, rv = tid % VW;
        if (tid < 8 * VW && rt < nv) {
            float o = 0.f;
#pragma unroll
            for (int pp = 0; pp < 32; ++pp) o += part[(rt * 32 + pp) * VW + rv];
            const size_t trow = (size_t)(8 * r + rt);
            if constexpr (TYPE == 0) {
                const float y = (o + Dh * vs[rt * 64 + rv]) * silu(bf2f(zc));
                yz[trow * 4096 + h * 64 + rv] = f2bf(y);
            } else if constexpr (TYPE == 1) {
                yz[trow * 4096 + 2048 + h * 256 + s * VW + rv] = f2bf(o);
            } else {
                yz[trow * 4096 + h * 128 + s * VW + rv] = f2bf(o);
            }
        }
    }
#pragma unroll
    for (int i = 0; i < 4; ++i) *(VT*)(Sout + (size_t)(kb + i) * ldS + NV * vq) = S[i];
}

__device__ __forceinline__ void lru_item(const Params& p, int sample, int b, int cb) {
    const int c = cb * 512 + threadIdx.x;
    const int L = sample ? 4 : 2048, row0 = sample ? MP + 4 * b : 2048 * b;
    const float* LA = (const float*)(p.ws + WS_LA) + (size_t)row0 * 2048 + c;
    const bf16_t* LBv = (const bf16_t*)(p.ws + WS_LBB) + (size_t)row0 * 2048 + c;
    const bf16_t* rg = (const bf16_t*)(p.ws + WS_PROJ) + (size_t)row0 * LD1 + 10240 + c;
    bf16_t* mixa = (bf16_t*)(p.ws + WS_ACT) + (size_t)row0 * 4096 + 2048 + c;
    float hst = sample ? p.in[6 + p.z][(size_t)b * 2048 + c] : 0.f;
    if (sample) {
#pragma unroll
        for (int t = 0; t < 4; ++t) {
            hst = LA[(size_t)t * 2048] * hst + bf2f(LBv[(size_t)t * 2048]);
            mixa[(size_t)t * 4096] = f2bf(hst * gelu_tanh(bf2f(rg[(size_t)t * LD1])));
        }
    } else {
        float a0[16]; unsigned short b0[16], g0[16];
#pragma unroll
        for (int t = 0; t < 16; ++t) { a0[t] = LA[(size_t)t * 2048]; b0[t] = LBv[(size_t)t * 2048]; g0[t] = rg[(size_t)t * LD1]; }
        for (int tb = 0; tb < 2048; tb += 16) {
            float a1[16]; unsigned short b1[16], g1[16];
            const int tn = (tb + 16 < 2048) ? tb + 16 : tb;
#pragma unroll
            for (int t = 0; t < 16; ++t) { a1[t] = LA[(size_t)(tn + t) * 2048]; b1[t] = LBv[(size_t)(tn + t) * 2048]; g1[t] = rg[(size_t)(tn + t) * LD1]; }
#pragma unroll
            for (int t = 0; t < 16; ++t) {
                hst = a0[t] * hst + bf2f(b0[t]);
                mixa[(size_t)(tb + t) * 4096] = f2bf(hst * gelu_tanh(bf2f(g0[t])));
            }
#pragma unroll
            for (int t = 0; t < 16; ++t) { a0[t] = a1[t]; b0[t] = b1[t]; g0[t] = g1[t]; }
        }
    }
    p.out[(sample ? O_LRUS : O_LRUP) + (size_t)b * 2048 + c] = hst;
}

__device__ __forceinline__ void phase_rec0(const Params& p, float* ldsf) {
    unsigned* ctr = (unsigned*)(p.ws + WS_CTL);
    const int total = 256 + 8192;
    for (;;) {
        const int it = next_item(ctr, ldsf);
        if (it >= total) break;
        int sample, j, type;
        if (it < 128) { sample = 0; j = it; type = 0; }
        else if (it < 256) { sample = 0; j = it - 128; type = 1; }
        else if (it < 256 + 4096) { sample = 1; j = it - 256; type = 0; }
        else { sample = 1; j = it - 256 - 4096; type = 1; }
        if (type == 0) rec_item<0, 64>(p, ldsf, sample, j >> 5, j & 31, 0);
        else rec_item<1, 64>(p, ldsf, sample, j >> 5, (j & 31) >> 2, j & 3);
    }
}
__device__ __forceinline__ void phase_rec1(const Params& p, float* ldsf) {
    unsigned* ctr = (unsigned*)(p.ws + WS_CTL) + 64;
    const int total = 256 + 16 + 4096 + 512;
    for (;;) {
        const int it = next_item(ctr, ldsf);
        if (it >= total) break;
        if (it < 256) rec_item<2, 32>(p, ldsf, 0, it >> 6, (it & 63) >> 2, it & 3);
        else if (it < 272) lru_item(p, 0, (it - 256) >> 2, (it - 256) & 3);
        else if (it < 272 + 4096) { const int j = it - 272; rec_item<2, 64>(p, ldsf, 1, j >> 5, (j & 31) >> 1, j & 1); }
        else { const int j = it - 272 - 4096; lru_item(p, 1, j >> 2, j & 3); }
    }
}

__device__ __forceinline__ void seq_of_row(int row, int& sample, int& b, int& t, int& L) {
    if (row < MP) { sample = 0; b = row >> 11; t = row & 2047; L = 2048; } else { sample = 1; b = (row - MP) >> 2; t = (row - MP) & 3; L = 4; }
}

__device__ __forceinline__ void phase_prep0(const Params& p) {
    int tid = threadIdx.x; asm volatile("" : "+v"(tid));
    const int wave = tid >> 6, lane = tid & 63;
    const int gw = blockIdx.x * 8 + wave, NGW = gridDim.x * 8;
    const bf16_t* YZ = (const bf16_t*)(p.ws + WS_YZ); const bf16_t* PR = (const bf16_t*)(p.ws + WS_PROJ);
    bf16_t* MX = (bf16_t*)(p.ws + WS_ACT);
    const float* nw = p.in[18 + p.z];
    for (int row = gw; row < MT; row += NGW) {
        const bf16_t* yz = YZ + (size_t)row * 4096; bf16_t* mx = MX + (size_t)row * 4096;
#pragma unroll 1
        for (int g = 0; g < 4; ++g) {
            const int c = g * 512 + lane * 8;
            float v[8]; unpack8(*(const u32x4*)(yz + c), v);
            float s = 0.f;
#pragma unroll
            for (int j = 0; j < 8; ++j) s += v[j] * v[j];
            s = wave_sum(s);
            const float rs = rsqrtf(s * (1.0f / 512.0f) + EPS);
            const f32x4 n0 = *(const f32x4*)(nw + c), n1 = *(const f32x4*)(nw + c + 4);
            u32x4 o; o.x = pk2(v[0] * rs * n0[0], v[1] * rs * n0[1]); o.y = pk2(v[2] * rs * n0[2], v[3] * rs * n0[3]);
            o.z = pk2(v[4] * rs * n1[0], v[5] * rs * n1[1]); o.w = pk2(v[6] * rs * n1[2], v[7] * rs * n1[3]);
            *(u32x4*)(mx + c) = o;
        }
#pragma unroll 2
        for (int hh = 0; hh < 8; ++hh) {
            const int c = hh * 256 + lane * 4;
            float v[4]; unpack4(*(const u32x2*)(yz + 2048 + c), v);
            float gt[4]; unpack4(*(const u32x2*)(PR + (size_t)row * LD0 + 9248 + c), gt);
            float s = (v[0] * v[0] + v[1] * v[1]) + (v[2] * v[2] + v[3] * v[3]);
            s = wave_sum(s);
            const float rs = rsqrtf(s * (1.0f / 256.0f) + EPS);
            u32x2 o; o.x = pk2(v[0] * rs * silu(gt[0]), v[1] * rs * silu(gt[1])); o.y = pk2(v[2] * rs * silu(gt[2]), v[3] * rs * silu(gt[3]));
            *(u32x2*)(mx + 2048 + c) = o;
        }
        int sample, b, t, L; seq_of_row(row, sample, b, t, L);
        if (t >= L - 3) {
            float* dst = p.out + (sample ? O_SCS : O_SCP) + ((size_t)b * 3 + (t - (L - 3))) * 3072;
            const bf16_t* src = PR + (size_t)row * LD0 + 2048;
#pragma unroll 4
            for (int c = lane; c < 3072; c += 64) dst[c] = bf2f(src[c]);
        }
    }
}

__device__ __forceinline__ void phase_prep1(const Params& p) {
    int tid = threadIdx.x; asm volatile("" : "+v"(tid));
    const int wave = tid >> 6, lane = tid & 63;
    const int gw = blockIdx.x * 8 + wave, NGW = gridDim.x * 8;
    const bf16_t* YZ = (const bf16_t*)(p.ws + WS_YZ); const bf16_t* PR = (const bf16_t*)(p.ws + WS_PROJ);
    bf16_t* MX = (bf16_t*)(p.ws + WS_ACT);
    const float* nw = p.in[22 + p.z];
    for (int row = gw; row < MT; row += NGW) {
#pragma unroll 1
        for (int it = 0; it < 4; ++it) {
            const int c = it * 512 + lane * 8;
            float v[8]; unpack8(*(const u32x4*)(YZ + (size_t)row * 4096 + c), v);
            float gt[8]; unpack8(*(const u32x4*)(PR + (size_t)row * LD1 + 6144 + c), gt);
            float s = 0.f;
#pragma unroll
            for (int j = 0; j < 8; ++j) s += v[j] * v[j];
            s += __shfl_xor(s, 1); s += __shfl_xor(s, 2); s += __shfl_xor(s, 4); s += __shfl_xor(s, 8);
            const float rs = rsqrtf(s * (1.0f / 128.0f) + EPS);
            const f32x4 n0 = *(const f32x4*)(nw + (c & 127)), n1 = *(const f32x4*)(nw + (c & 127) + 4);
            float o[8];
#pragma unroll
            for (int j = 0; j < 8; ++j) o[j] = v[j] * rs * (j < 4 ? n0[j] : n1[j - 4]) * silu(gt[j]);
            u32x4 ov; ov.x = pk2(o[0], o[1]); ov.y = pk2(o[2], o[3]); ov.z = pk2(o[4], o[5]); ov.w = pk2(o[6], o[7]);
            *(u32x4*)(MX + (size_t)row * 4096 + c) = ov;
        }
    }
}

__device__ __forceinline__ void phase_act(const Params& p, int l) {
    const bf16_t* PR = (const bf16_t*)(p.ws + WS_PROJ); bf16_t* ACT = (bf16_t*)(p.ws + WS_ACT);
    const float* cw = p.in[32 + p.z] + (size_t)l * 3 * DFF; const float* cbv = p.in[33 + p.z] + (size_t)l * DFF;
    const float* st = p.in[8 + p.z] + (size_t)l * 128 * 2 * DFF;
    const int total = MT * 704;
    for (int idx = blockIdx.x * 512 + threadIdx.x; idx < total; idx += gridDim.x * 512) {
        const int row = idx / 704, c = (idx - row * 704) * 8;
        int sample, b, t, L; seq_of_row(row, sample, b, t, L);
        float g2[8], g1[8], g0[8], uu[8];
        unpack8(*(const u32x4*)(PR + (size_t)row * LDU + c), g2);
        unpack8(*(const u32x4*)(PR + (size_t)row * LDU + DFF + c), uu);
        if (t >= 1) unpack8(*(const u32x4*)(PR + (size_t)(row - 1) * LDU + c), g1);
        else {
#pragma unroll
            for (int j = 0; j < 8; ++j) g1[j] = sample ? st[((size_t)b * 2 + 1) * DFF + c + j] : 0.f;
        }
        if (t >= 2) unpack8(*(const u32x4*)(PR + (size_t)(row - 2) * LDU + c), g0);
        else {
#pragma unroll
            for (int j = 0; j < 8; ++j) g0[j] = sample ? st[((size_t)b * 2 + t) * DFF + c + j] : 0.f;
        }
        float o[8];
#pragma unroll
        for (int j = 0; j < 8; ++j) {
            const float y = cbv[c + j] + cw[c + j] * g0[j] + cw[DFF + c + j] * g1[j] + cw[2 * DFF + c + j] * g2[j];
            o[j] = silu(y) * uu[j];
        }
        u32x4 ov; ov.x = pk2(o[0], o[1]); ov.y = pk2(o[2], o[3]); ov.z = pk2(o[4], o[5]); ov.w = pk2(o[6], o[7]);
        *(u32x4*)(ACT + (size_t)row * DFF + c) = ov;
        if (t >= L - 2) {
            float* dst = p.out + (sample ? O_FCS + (((size_t)l * 128 + b) * 2 + (t - (L - 2))) * DFF : O_FCP + (((size_t)l * 4 + b) * 2 + (t - (L - 2))) * DFF) + c;
            *(f32x4*)dst = (f32x4){g2[0], g2[1], g2[2], g2[3]}; *(f32x4*)(dst + 4) = (f32x4){g2[4], g2[5], g2[6], g2[7]};
        }
    }
}

__device__ __forceinline__ void phase_lruconv(const Params& p) {
    const bf16_t* PR = (const bf16_t*)(p.ws + WS_PROJ); bf16_t* XR = (bf16_t*)(p.ws + WS_XR);
    const float* cw = p.in[23 + p.z]; const float* cbv = p.in[24 + p.z]; const float* st = p.in[7 + p.z];
    const int total = MT * 256;
    for (int idx = blockIdx.x * 512 + threadIdx.x; idx < total; idx += gridDim.x * 512) {
        const int row = idx >> 8, c = (idx & 255) * 8;
        int sample, b, t, L; seq_of_row(row, sample, b, t, L);
        float x[4][8];
#pragma unroll
        for (int j = 0; j < 4; ++j) {
            const int tt = t + j - 3;
            if (tt >= 0) unpack8(*(const u32x4*)(PR + (size_t)(row + j - 3) * LD1 + 8192 + c), x[j]);
            else {
#pragma unroll
                for (int i = 0; i < 8; ++i) x[j][i] = sample ? st[((size_t)b * 3 + (t + j)) * 2048 + c + i] : 0.f;
            }
        }
        float o[8];
#pragma unroll
        for (int i = 0; i < 8; ++i) o[i] = cbv[c + i] + cw[c + i] * x[0][i] + cw[2048 + c + i] * x[1][i] + cw[4096 + c + i] * x[2][i] + cw[6144 + c + i] * x[3][i];
        u32x4 ov; ov.x = pk2(o[0], o[1]); ov.y = pk2(o[2], o[3]); ov.z = pk2(o[4], o[5]); ov.w = pk2(o[6], o[7]);
        *(u32x4*)(XR + (size_t)row * 2048 + c) = ov;
        if (t >= L - 3) {
            float* dst = p.out + (sample ? O_LCS : O_LCP) + ((size_t)b * 3 + (t - (L - 3))) * 2048 + c;
            *(f32x4*)dst = (f32x4){x[3][0], x[3][1], x[3][2], x[3][3]}; *(f32x4*)(dst + 4) = (f32x4){x[3][4], x[3][5], x[3][6], x[3][7]};
        }
    }
}

__device__ __forceinline__ void phase_final(const Params& p) {
    int tid = threadIdx.x; asm volatile("" : "+v"(tid));
    const int wave = tid >> 6, lane = tid & 63;
    const int gw = blockIdx.x * 8 + wave, NGW = gridDim.x * 8;
    const float* X = (const float*)(p.ws + WS_X); const float* ss = (const float*)(p.ws + WS_SS) + 4 * MT; const float* nf = p.in[11 + p.z];
    for (int row = gw; row < MT; row += NGW) {
        const float rs = rsqrtf(ss[row] * (1.0f / 2048.0f) + EPS);
        float* dst = p.out + (row < MP ? O_YP + (size_t)row * 2048 : O_YS + (size_t)(row - MP) * 2048);
#pragma unroll
        for (int j = 0; j < 8; ++j) {
            const int c = (lane + 64 * j) * 4;
            const f32x4 v = *(const f32x4*)(X + (size_t)row * 2048 + c), n = *(const f32x4*)(nf + c);
            *(f32x4*)(dst + c) = v * rs * n;
        }
    }
}

#define XB_TMO      128
#define XB_XCNT(j)  (256  + 64 * (j))
#define XB_XSUB(j)  (1280 + 64 * (j))
#define XB_XGEN(j)  (2304 + 64 * (j))
#define XB_TOP      3328
#define XB_TOPGEN   3392
#define XCD_BAR_WORDS 3456
#define XB_SPIN_CAP (1u << 22)
__device__ __forceinline__ unsigned xb_ld(unsigned* p)              { return __hip_atomic_load(p, __ATOMIC_RELAXED, __HIP_MEMORY_SCOPE_AGENT); }
__device__ __forceinline__ unsigned xb_add(unsigned* p, unsigned v) { return __hip_atomic_fetch_add(p, v, __ATOMIC_RELAXED, __HIP_MEMORY_SCOPE_AGENT); }
__device__ __forceinline__ unsigned xb_xcc_id() { return (unsigned)__builtin_amdgcn_s_getreg((3 << 11) | 20) & 0xFu; }
#define XB_SPIN(cond, bar) do { unsigned _sp = 0; while (cond) { __builtin_amdgcn_s_sleep(1); \
    if ((++_sp & 255u) == 0u) { if (xb_ld(&(bar)[XB_TMO])) break; if (_sp > XB_SPIN_CAP) { atomicAdd(&(bar)[XB_TMO], 1u); break; } } } } while (0)
struct XcdBarrier { unsigned* bar; unsigned x; volatile LAS unsigned* st; };
__device__ __forceinline__ XcdBarrier xcd_barrier_post(unsigned* bar, volatile LAS unsigned* st) {
    XcdBarrier b; b.bar = bar; b.x = xb_xcc_id(); b.st = st;
    if (threadIdx.x == 0) (void)xb_add(&bar[XB_XCNT(b.x)], 1u);
    return b;
}
__device__ __forceinline__ void xcd_barrier_complete(unsigned* bar, unsigned x, unsigned& nloc, unsigned& nx) {
    const unsigned G = gridDim.x * gridDim.y * gridDim.z;
    unsigned sum, cnt, mine, sp = 0u;
    for (;;) {
        sum = 0u; cnt = 0u; mine = 0u;
#pragma unroll
        for (unsigned j = 0; j < 16; ++j) { const unsigned c = xb_ld(&bar[XB_XCNT(j)]); sum += c; cnt += (c > 0u) ? 1u : 0u; mine = (j == x) ? c : mine; }
        if (sum == G) break;
        __builtin_amdgcn_s_sleep(1);
        if ((++sp & 255u) == 0u) { if (xb_ld(&bar[XB_TMO])) break; if (sp > XB_SPIN_CAP) { atomicAdd(&bar[XB_TMO], 1u); break; } }
    }
    nloc = mine > 0u ? mine : 1u; nx = cnt > 0u ? cnt : 1u;
}
__device__ __forceinline__ void xcd_barrier(const XcdBarrier& b) {
    asm volatile("s_waitcnt vmcnt(0)" ::: "memory");
    __syncthreads();
    if (threadIdx.x == 0) {
        unsigned* bar = b.bar;
        __builtin_amdgcn_s_waitcnt(0);
        unsigned nloc = b.st[0], nx = b.st[1];
        if (nloc == 0u) { xcd_barrier_complete(bar, b.x, nloc, nx); b.st[0] = nloc; b.st[1] = nx; }
        const unsigned old = xb_add(&bar[XB_XSUB(b.x)], 1u);
        const unsigned gen = old / nloc;
        if (old + 1u == (gen + 1u) * nloc) {
            __builtin_amdgcn_fence(__ATOMIC_RELEASE, "agent");
            asm volatile("s_waitcnt vmcnt(0)" ::: "memory");
            const unsigned og = xb_add(&bar[XB_TOP], 1u);
            const unsigned tg = og / nx;
            if (og + 1u == (tg + 1u) * nx) xb_add(&bar[XB_TOPGEN], 1u);
            else XB_SPIN(xb_ld(&bar[XB_TOPGEN]) == tg, bar);
            __builtin_amdgcn_fence(__ATOMIC_ACQUIRE, "agent");
            xb_add(&bar[XB_XGEN(b.x)], 1u);
            asm volatile("s_waitcnt vmcnt(0)" ::: "memory");
        } else {
            XB_SPIN(xb_ld(&bar[XB_XGEN(b.x)]) == gen, bar);
            __builtin_amdgcn_fence(__ATOMIC_ACQUIRE, "agent");
            asm volatile("s_waitcnt vmcnt(0)" ::: "memory");
        }
    }
    __syncthreads();
}

#ifndef PROBE_MASK
#define PROBE_MASK 0u
#endif
#ifndef PHMASK
#define PHMASK 0xFFFFFFFFu
#endif
#define EN(i) (((PHMASK) >> (i)) & 1u)
__global__ void __launch_bounds__(512, 2) fwd_megakernel(Params p) {
    extern __shared__ __attribute__((aligned(16))) unsigned char shm[];
    float* ldsf = (float*)shm;
    LAS unsigned char* ldsg = (LAS unsigned char*)shm;
    unsigned char* ws = p.ws;
    float* ssb = (float*)(ws + WS_SS);
    volatile LAS unsigned* xst = (volatile LAS unsigned*)(ldsg + 131072);
    if (threadIdx.x == 0) { xst[0] = 0u; xst[1] = 0u; }
    __syncthreads();
    const XcdBarrier xb = xcd_barrier_post((unsigned*)(ws + WS_CTL) + 256, xst);
#if PROBE_MASK
    unsigned long long tph = __builtin_amdgcn_s_memrealtime();
#endif
    for (int ph = p.ph_lo; ph < p.ph_hi; ++ph) {
        if (ph > p.ph_lo) {
            if (ph == 1) cg::this_grid().sync();
            else xcd_barrier(xb);
#if PROBE_MASK
            {
                const unsigned long long t1 = __builtin_amdgcn_s_memrealtime();
                if ((PROBE_MASK >> (ph - 1)) & 1u) { const unsigned long long dt = t1 - tph; while (__builtin_amdgcn_s_memrealtime() - t1 < dt) __builtin_amdgcn_s_sleep(8); }
                tph = __builtin_amdgcn_s_memrealtime();
            }
#endif
        }
        if (EN(0) && ph == 0) phase_prologue(p, ldsf);
        else if (EN(1) && (ph == 1 || ph == 5 || ph == 8 || ph == 14)) {
            pg8::Gemm g; pg8::EpiScaleBf16 E; int N;
            g.A = (const char*)(ws + WS_XB); g.lda = 2048; g.ldb = 2048; g.nt = 32;
            if (ph == 1) { g.Bt = (const char*)(ws + WS_WIN0); N = LD0; E.ss = ssb; }
            else if (ph == 5) { g.Bt = (const char*)(ws + WS_WUP0); N = LDU; E.ss = ssb + MT; }
            else if (ph == 8) { g.Bt = (const char*)(ws + WS_WIN1); N = LD1; E.ss = ssb + 2 * MT; }
            else { g.Bt = (const char*)(ws + WS_WUP1); N = LDU; E.ss = ssb + 3 * MT; }
            E.O = (bf16_t*)(ws + WS_PROJ); E.ldc = N;
            pg8::Order S; S.nM = MT / 256; S.nN = N / 256; S.nwg = S.nM * S.nN; S.G = gridDim.x; S.c = blockIdx.x;
            S.a_t = (size_t)256 * 2048 * 2; S.b_t = (size_t)256 * 2048 * 2; S.acol = 0;
            pg8::gemm_phase<pg8::EpiScaleBf16>(ldsg, g, S, E);
        }
        else if (EN(4) && (ph == 4 || ph == 7 || ph == 13 || ph == 16)) {
            pg8::Gemm g; pg8::EpiResid E;
            g.A = (const char*)(ws + WS_ACT);
            if (ph == 4) { g.Bt = (const char*)(ws + WS_WOUT0); g.lda = 4096; E.ssout = ssb + MT; }
            else if (ph == 7) { g.Bt = (const char*)(ws + WS_WDN0); g.lda = DFF; E.ssout = ssb + 2 * MT; }
            else if (ph == 13) { g.Bt = (const char*)(ws + WS_WOUT1); g.lda = 4096; E.ssout = ssb + 3 * MT; }
            else { g.Bt = (const char*)(ws + WS_WDN1); g.lda = DFF; E.ssout = ssb + 4 * MT; }
            g.ldb = g.lda; g.nt = g.lda / 64;
            E.X = (float*)(ws + WS_X); E.XB = (bf16_t*)(ws + WS_XB);
            pg8::Order S; S.nM = MT / 256; S.nN = 8; S.nwg = S.nM * 8; S.G = gridDim.x; S.c = blockIdx.x;
            S.a_t = (size_t)256 * g.lda * 2; S.b_t = (size_t)256 * g.ldb * 2; S.acol = 0;
            pg8::gemm_phase<pg8::EpiResid>(ldsg, g, S, E);
        }
        else if (EN(10) && ph == 10) {
            pg8::Gemm g; pg8::EpiLru E;
            g.A = (const char*)(ws + WS_XR); g.Bt = (const char*)(ws + WS_WLRU); g.lda = 2048; g.ldb = 256; g.nt = 4 + (p.ph_hi >> 8);
            E.br = p.in[26 + p.z]; E.bi = p.in[28 + p.z]; E.sp = (const float*)(ws + WS_SP); E.XR = (const bf16_t*)(ws + WS_XR);
            E.LA = (float*)(ws + WS_LA); E.LBv = (bf16_t*)(ws + WS_LBB);
            pg8::Order S; S.nM = MT / 256; S.nN = 16; S.nwg = S.nM * 16; S.G = gridDim.x; S.c = blockIdx.x;
            S.a_t = (size_t)256 * 2048 * 2; S.b_t = (size_t)256 * 256 * 2; S.acol = 512;
            pg8::gemm_phase<pg8::EpiLru>(ldsg, g, S, E);
        }
        else if (EN(2) && ph == 2) phase_rec0(p, ldsf);
        else if (EN(3) && ph == 3) phase_prep0(p);
        else if (EN(6) && ph == 6) phase_act(p, 0);
        else if (EN(9) && ph == 9) phase_lruconv(p);
        else if (EN(11) && ph == 11) phase_rec1(p, ldsf);
        else if (EN(12) && ph == 12) phase_prep1(p);
        else if (EN(15) && ph == 15) phase_act(p, 1);
        else if (EN(17) && ph == 17) phase_final(p);
    }
}

#ifndef N_LAUNCH_MODE
#define N_LAUNCH_MODE 0
#endif

extern "C" void kernel_launch(void* const* d_in, const int* in_sizes, int n_in, void* d_out, int out_size, void* d_ws, size_t ws_size, hipStream_t stream) {
    static int grid = 0;
    if (grid == 0) {
        if (n_in != 35 || (size_t)out_size != O_END || ws_size < WS_END) { fprintf(stderr, "kernel_launch: unexpected shapes: n_in %d out %d ws %zu (need %zu)\n", n_in, out_size, ws_size, (size_t)WS_END); grid = -1; return; }
        int dev = 0, cus = 0, per_cu = 0;
        hipGetDevice(&dev);
        hipDeviceGetAttribute(&cus, hipDeviceAttributeMultiprocessorCount, dev);
        if (hipFuncSetAttribute((const void*)fwd_megakernel, hipFuncAttributeMaxDynamicSharedMemorySize, LDS_BYTES) != hipSuccess) { fprintf(stderr, "kernel_launch: hipFuncSetAttribute failed\n"); grid = -1; return; }
        if (hipOccupancyMaxActiveBlocksPerMultiprocessor(&per_cu, (const void*)fwd_megakernel, 512, LDS_BYTES) != hipSuccess || per_cu < 1) { fprintf(stderr, "kernel_launch: occupancy query says %d\n", per_cu); per_cu = 1; }
        (void)hipGetLastError();
        grid = cus;
    }
    if (grid < 0) return;
    (void)hipMemsetAsync((char*)d_ws + WS_CTL, 0, 16384, stream);
    Params p{};
    for (int i = 0; i < 35; ++i) p.in[i] = (const float*)d_in[i];
    p.z = 0; p.pad = 0;
    p.out = (float*)d_out; p.ws = (unsigned char*)d_ws;
#if N_LAUNCH_MODE == 0
    p.ph_lo = 0; p.ph_hi = NPHASE;
    void* args[] = {&p};
    hipError_t e = hipLaunchCooperativeKernel((const void*)fwd_megakernel, dim3(grid), dim3(512), args, LDS_BYTES, stream);
    if (e != hipSuccess) fprintf(stderr, "cooperative launch failed: %s (grid %d)\n", hipGetErrorString(e), grid);
#else
    for (int ph = 0; ph < NPHASE; ++ph) {
        p.ph_lo = ph; p.ph_hi = ph + 1;
        hipLaunchKernelGGL(fwd_megakernel, dim3(grid), dim3(512), LDS_BYTES, stream, p);
    }
#endif
}
```

```cpp
#include <hip/hip_runtime.h>
#include <hip/hip_cooperative_groups.h>
#include <cstdio>
#include <cstdint>
namespace cg = cooperative_groups;

#define LAS __attribute__((address_space(3)))
typedef unsigned short bf16_t;
typedef short bf16x8 __attribute__((ext_vector_type(8)));
typedef float f32x4 __attribute__((ext_vector_type(4)));
typedef float f32x2 __attribute__((ext_vector_type(2)));
typedef unsigned u32x4 __attribute__((ext_vector_type(4)));
typedef unsigned u32x2 __attribute__((ext_vector_type(2)));

constexpr int D = 2048, MP = 8192, MS = 512, MT = 8704;
constexpr int LD0 = 11520, LD1 = 12288, LDU = 11264, DFF = 5632;
constexpr float EPS = 1e-6f;
constexpr size_t O_YP = 0;
constexpr size_t O_YS = O_YP + (size_t)4 * 2048 * 2048;
constexpr size_t O_SSMP = O_YS + (size_t)128 * 4 * 2048;
constexpr size_t O_SSMS = O_SSMP + (size_t)4 * 32 * 128 * 64;
constexpr size_t O_SCP = O_SSMS + (size_t)128 * 32 * 128 * 64;
constexpr size_t O_SCS = O_SCP + (size_t)4 * 3 * 3072;
constexpr size_t O_RETP = O_SCS + (size_t)128 * 3 * 3072;
constexpr size_t O_RETS = O_RETP + (size_t)4 * 8 * 128 * 256;
constexpr size_t O_HGP = O_RETS + (size_t)128 * 8 * 128 * 256;
constexpr size_t O_HGS = O_HGP + (size_t)4 * 16 * 128 * 128;
constexpr size_t O_LRUP = O_HGS + (size_t)128 * 16 * 128 * 128;
constexpr size_t O_LRUS = O_LRUP + (size_t)4 * 2048;
constexpr size_t O_LCP = O_LRUS + (size_t)128 * 2048;
constexpr size_t O_LCS = O_LCP + (size_t)4 * 3 * 2048;
constexpr size_t O_FCP = O_LCS + (size_t)128 * 3 * 2048;
constexpr size_t O_FCS = O_FCP + (size_t)2 * 4 * 2 * 5632;
constexpr size_t O_END = O_FCS + (size_t)2 * 128 * 2 * 5632;
constexpr size_t al256(size_t x) { return (x + 255) & ~(size_t)255; }
constexpr size_t WS_CTL = 0;
constexpr size_t WS_SS = 16384;
constexpr size_t WS_SP = al256(WS_SS + (size_t)5 * MT * 4);
constexpr size_t WS_LB = WS_SP + 8192;
constexpr size_t WS_WIN0 = WS_LB + 8192;
constexpr size_t WS_WOUT0 = WS_WIN0 + (size_t)LD0 * 2048 * 2;
constexpr size_t WS_WUP0 = WS_WOUT0 + (size_t)2048 * 4096 * 2;
constexpr size_t WS_WDN0 = WS_WUP0 + (size_t)LDU * 2048 * 2;
constexpr size_t WS_WIN1 = WS_WDN0 + (size_t)2048 * DFF * 2;
constexpr size_t WS_WOUT1 = WS_WIN1 + (size_t)LD1 * 2048 * 2;
constexpr size_t WS_WUP1 = WS_WOUT1 + (size_t)2048 * 4096 * 2;
constexpr size_t WS_WDN1 = WS_WUP1 + (size_t)LDU * 2048 * 2;
constexpr size_t WS_WLRU = WS_WDN1 + (size_t)2048 * DFF * 2;
constexpr size_t WS_X = WS_WLRU + (size_t)16 * 256 * 256 * 2;
constexpr size_t WS_XB = WS_X + (size_t)MT * 2048 * 4;
constexpr size_t WS_PROJ = WS_XB + (size_t)MT * 2048 * 2;
constexpr size_t WS_ACT = WS_PROJ + (size_t)MT * LD1 * 2;
constexpr size_t WS_YZ = WS_ACT + (size_t)MT * DFF * 2;
constexpr size_t WS_LA = WS_YZ + (size_t)MT * 4096 * 2;
constexpr size_t WS_LBB = WS_LA + (size_t)MT * 2048 * 4;
constexpr size_t WS_XR = WS_LBB + (size_t)MT * 2048 * 2;
constexpr size_t WS_END = WS_XR + (size_t)MT * 2048 * 2;

constexpr int LDS_BYTES = 133120 + 256;
constexpr int NPHASE = 18;

struct Params {
    const float* in[35];
    float* out;
    unsigned char* ws;
    int ph_lo, ph_hi;
    int z, pad;
};

__device__ __forceinline__ float bf2f(unsigned v) { return __uint_as_float(v << 16); }
__device__ __forceinline__ unsigned pk2(float lo, float hi) { unsigned r; asm volatile("v_cvt_pk_bf16_f32 %0, %1, %2" : "=v"(r) : "v"(lo), "v"(hi)); return r; }
__device__ __forceinline__ bf16_t f2bf(float x) { return (bf16_t)(pk2(x, 0.f) & 0xffffu); }
__device__ __forceinline__ float sigm(float x) { return __builtin_amdgcn_rcpf(1.f + __expf(-x)); }
__device__ __forceinline__ float silu(float x) { return x * __builtin_amdgcn_rcpf(1.f + __expf(-x)); }
__device__ __forceinline__ float softplus(float x) { return fmaxf(x, 0.f) + log1pf(__expf(-fabsf(x))); }
__device__ __forceinline__ float gelu_tanh(float x) { const float u = 0.7978845608f * (x + 0.044715f * x * x * x); const float t = 1.f - 2.f * __builtin_amdgcn_rcpf(1.f + __expf(2.f * u)); return 0.5f * x * (1.f + t); }
__device__ __forceinline__ float wave_sum(float v) {
#pragma unroll
    for (int o = 1; o < 64; o <<= 1) v += __shfl_xor(v, o);
    return v;
}
__device__ __forceinline__ void unpack8(u32x4 r, float* f) {
    f[0] = bf2f(r.x & 0xffffu); f[1] = __uint_as_float(r.x & 0xffff0000u); f[2] = bf2f(r.y & 0xffffu); f[3] = __uint_as_float(r.y & 0xffff0000u);
    f[4] = bf2f(r.z & 0xffffu); f[5] = __uint_as_float(r.z & 0xffff0000u); f[6] = bf2f(r.w & 0xffffu); f[7] = __uint_as_float(r.w & 0xffff0000u);
}
__device__ __forceinline__ void unpack4(u32x2 r, float* f) {
    f[0] = bf2f(r.x & 0xffffu); f[1] = __uint_as_float(r.x & 0xffff0000u); f[2] = bf2f(r.y & 0xffffu); f[3] = __uint_as_float(r.y & 0xffff0000u);
}
#define LDS_WAIT() asm volatile("s_waitcnt lgkmcnt(0)" ::: "memory")

namespace pg8 {
constexpr int BM = 256, BK = 64, HALF = 128, HTB = HALF * BK * 2, NXCD = 8, WGM = 8;
__device__ __forceinline__ int lds_byte(int r, int c) { const int st = (r >> 4) * 2 + (c >> 5), rr = r & 15, cc = c & 31, ob = rr * 64 + cc * 2; return st * 1024 + (ob ^ (((ob >> 9) & 1) << 5)); }
__device__ __forceinline__ void stage_rc(int b, int& R, int& C) { const int st = b / 1024, sb = b % 1024, swz = sb ^ (((sb >> 9) & 1) << 5); R = (st >> 1) * 16 + swz / 64; C = (st & 1) * 32 + (swz % 64) / 2; }
__device__ __forceinline__ int perm32(int rho) { const int n = rho >> 4, i = rho & 15; return 8 * (i >> 2) + 4 * n + (i & 3); }

struct Unit { int pm, pn, nt, kind, ks; size_t aoff, boff; };
struct Gemm { const char* A; const char* Bt; int lda, ldb; };
struct Order {
    int nMm, nN, n_main, n_tail, ksplit, nt_full, G, c; size_t a_t, b_t, acol;
    __device__ __forceinline__ bool next(int i, Unit& u) const {
        const long L = (long)i * G + c;
        if (L < n_main) {
            const int nwg = n_main;
            int wgid = (int)L; { const int q = nwg / NXCD, r = nwg % NXCD, xcd = wgid % NXCD, off = wgid / NXCD; wgid = (xcd < r ? xcd * (q + 1) : r * (q + 1) + (xcd - r) * q) + off; }
            const int nig = WGM * nN, gid = wgid / nig, fm = gid * WGM, gsz = (nMm - fm) < WGM ? (nMm - fm) : WGM;
            u.pm = fm + ((wgid % nig) % gsz); u.pn = (wgid % nig) / gsz; u.nt = nt_full; u.kind = 0; u.ks = 0;
            u.aoff = (size_t)u.pm * a_t + (size_t)(u.pn >> 1) * acol; u.boff = (size_t)u.pn * b_t; return true;
        }
        const int Lt = (int)(L - n_main); if (Lt >= n_tail) return false;
        const int ks = Lt % ksplit, r = Lt / ksplit;
        u.pm = nMm + (r & 1); u.pn = r >> 1; u.nt = nt_full / ksplit; u.kind = ksplit > 1 ? 1 : 0; u.ks = ks;
        const size_t kofs = (size_t)ks * u.nt * (BK * 2);
        u.aoff = (size_t)u.pm * a_t + (size_t)(u.pn >> 1) * acol + kofs; u.boff = (size_t)u.pn * b_t + kofs; return true;
    }
};

struct EpiScaleBf16 {
    static constexpr bool PERM = true;
    bf16_t* O; int ldc; const float* ss;
    __device__ __forceinline__ void operator()(const f32x4 (&acc)[2][2][4][2], const Unit& u, int wr, int wc, int fr, int fq) const {
        const int row0 = u.pm * BM + wr * 64 + fr, col0 = u.pn * BM + wc * 32 + 8 * fq;
#pragma unroll
        for (int ai = 0; ai < 2; ++ai)
#pragma unroll
            for (int m = 0; m < 4; ++m) {
                const int row = row0 + ai * HALF + m * 16;
                const float rs = rsqrtf(ss[row] * (1.0f / 2048.0f) + EPS);
                bf16_t* rowp = O + ((unsigned)row * (unsigned)ldc + (unsigned)col0);
#pragma unroll
                for (int bj = 0; bj < 2; ++bj) {
                    const f32x4 v0 = acc[ai][bj][m][0] * rs, v1 = acc[ai][bj][m][1] * rs;
                    u32x4 w; w.x = pk2(v0[0], v0[1]); w.y = pk2(v0[2], v0[3]); w.z = pk2(v1[0], v1[1]); w.w = pk2(v1[2], v1[3]);
                    *(u32x4*)(rowp + bj * HALF) = w;
                }
            }
    }
};
struct EpiResid {
    static constexpr bool PERM = false;
    float* X; bf16_t* XB; float* ssout; float* part;
    __device__ __forceinline__ void operator()(const f32x4 (&acc)[2][2][4][2], const Unit& u, int wr, int wc, int fr, int fq) const {
        const int row0 = u.pm * BM + wr * 64 + fr, col0 = u.pn * BM + wc * 32 + 4 * fq;
        if (u.kind == 1) {
            float* P = part + (size_t)u.ks * (512 * 2048);
#pragma unroll
            for (int ai = 0; ai < 2; ++ai)
#pragma unroll
                for (int m = 0; m < 4; ++m) {
                    const unsigned off = (unsigned)(row0 - MP + ai * HALF + m * 16) * 2048u + (unsigned)col0;
#pragma unroll
                    for (int bj = 0; bj < 2; ++bj)
#pragma unroll
                        for (int n = 0; n < 2; ++n) *(f32x4*)(P + off + bj * HALF + n * 16) = acc[ai][bj][m][n];
                }
            return;
        }
#pragma unroll
        for (int ai = 0; ai < 2; ++ai)
#pragma unroll
            for (int m = 0; m < 4; ++m) {
                const int row = row0 + ai * HALF + m * 16;
                const unsigned off = (unsigned)row * 2048u + (unsigned)col0;
                float sq = 0.f;
#pragma unroll
                for (int bj = 0; bj < 2; ++bj)
#pragma unroll
                    for (int n = 0; n < 2; ++n) {
                        const unsigned o = off + bj * HALF + n * 16;
                        f32x4 x = *(const f32x4*)(X + o) + acc[ai][bj][m][n];
                        *(f32x4*)(X + o) = x;
                        u32x2 w; w.x = pk2(x[0], x[1]); w.y = pk2(x[2], x[3]);
                        *(u32x2*)(XB + o) = w;
                        sq += (x[0] * x[0] + x[1] * x[1]) + (x[2] * x[2] + x[3] * x[3]);
                    }
                sq += __shfl_xor(sq, 16); sq += __shfl_xor(sq, 32);
                if (fq == 0) atomicAdd(ssout + row, sq);
                asm volatile("" ::: "memory");
            }
    }
};
struct EpiLru {
    static constexpr bool PERM = false;
    const float* br; const float* bi; const float* sp; const bf16_t* XR; float* LA; bf16_t* LBv;
    __device__ __forceinline__ void operator()(const f32x4 (&acc)[2][2][4][2], const Unit& u, int wr, int wc, int fr, int fq) const {
        const int row0 = u.pm * BM + wr * 64 + fr;
        const int cbase = (u.pn >> 1) * 256 + (u.pn & 1) * 128 + wc * 32 + 4 * fq;
#pragma unroll
        for (int ai = 0; ai < 2; ++ai)
#pragma unroll
            for (int m = 0; m < 4; ++m) {
                const int row = row0 + ai * HALF + m * 16;
                const bool first = (row < MP) && ((row & 2047) == 0);
#pragma unroll
                for (int n = 0; n < 2; ++n) {
                    const int c = cbase + n * 16;
                    const f32x4 br4 = *(const f32x4*)(br + c), bi4 = *(const f32x4*)(bi + c), sp4 = *(const f32x4*)(sp + c);
                    const unsigned o = (unsigned)row * 2048u + (unsigned)c;
                    float xr[4]; unpack4(*(const u32x2*)(XR + o), xr);
                    f32x4 av; float bb[4];
#pragma unroll
                    for (int j = 0; j < 4; ++j) {
                        const float r = sigm(acc[ai][0][m][n][j] + br4[j]), gi = sigm(acc[ai][1][m][n][j] + bi4[j]);
                        const float la = -8.0f * r * sp4[j];
                        const float a = __expf(la);
                        const float mult = first ? 1.0f : __builtin_amdgcn_sqrtf(fmaxf(1.0f - a * a, 0.f));
                        av[j] = a; bb[j] = mult * gi * xr[j];
                    }
                    *(f32x4*)(LA + o) = av;
                    u32x2 w; w.x = pk2(bb[0], bb[1]); w.y = pk2(bb[2], bb[3]);
                    *(u32x2*)(LBv + o) = w;
                    asm volatile("" ::: "memory");
                }
            }
    }
};

template <class Epi>
__device__ __forceinline__ void gemm_phase(LAS unsigned char* lds, const Gemm g, const Order& S, const Epi& E) {
    int tid = threadIdx.x; asm volatile("" : "+v"(tid));
    const int wid = __builtin_amdgcn_readfirstlane(tid >> 6), lane = tid & 63, wr = wid >> 2, wc = wid & 3, fr = lane & 15, fq = lane >> 4;
    unsigned voffA[2], voffB[2];
#pragma unroll
    for (int i = 0; i < 2; ++i) { int R, C; stage_rc(tid * 16 + i * 8192, R, C); const int Rb = Epi::PERM ? ((R & ~31) + perm32(R & 31)) : R;
        voffA[i] = (unsigned)(R * g.lda + C) * 2u; voffB[i] = (unsigned)(Rb * g.ldb + C) * 2u; }
    const size_t kstep = (size_t)(BK * 2);
    const size_t hstepA = (size_t)HALF * g.lda * 2, hstepB = (size_t)HALF * g.ldb * 2;
    const unsigned ldsw = (unsigned)wid * 1024u;
    const int aoff = lds_byte(wr * 64 + fr, fq * 8), boff = lds_byte(wc * 32 + fr, fq * 8);
#define PG8_SA(b, h) (((b) * 2 + (h)) * HTB)
#define PG8_SB(b, h) ((4 + (b) * 2 + (h)) * HTB)
#define PG8_STAGE(bufoff, gbase, voff) do { _Pragma("unroll") for (int _i = 0; _i < 2; ++_i) \
        __builtin_amdgcn_global_load_lds((const unsigned*)((const char*)(gbase) + (voff)[_i]), (LAS unsigned*)(lds + (bufoff) + ldsw + _i * 8192), 16, 0, 0); } while (0)
#define PG8_LDA(dst, b, h) do { _Pragma("unroll") for (int m = 0; m < 4; ++m) _Pragma("unroll") for (int k = 0; k < 2; ++k) dst[m][k] = *(const LAS bf16x8*)(lds + PG8_SA(b, h) + aoff + m * 2048 + k * 1024); } while (0)
#define PG8_LDB(dst, b, h) do { _Pragma("unroll") for (int n = 0; n < 2; ++n) _Pragma("unroll") for (int k = 0; k < 2; ++k) dst[n][k] = *(const LAS bf16x8*)(lds + PG8_SB(b, h) + boff + n * 2048 + k * 1024); } while (0)
#define PG8_MMA(ai, bj, At, Bt) do { __builtin_amdgcn_s_setprio(1); _Pragma("unroll") for (int m = 0; m < 4; ++m) _Pragma("unroll") for (int n = 0; n < 2; ++n) _Pragma("unroll") for (int k = 0; k < 2; ++k) \
        acc[ai][bj][m][n] = __builtin_amdgcn_mfma_f32_16x16x32_bf16(Bt[n][k], At[m][k], acc[ai][bj][m][n], 0, 0, 0); __builtin_amdgcn_s_setprio(0); } while (0)
#define PG8_WAIT_V(n) asm volatile("s_waitcnt vmcnt(" #n ")" ::: "memory")
#define PG8_WAIT_L(n) asm volatile("s_waitcnt lgkmcnt(" #n ")" ::: "memory")
#define PG8_BAR __builtin_amdgcn_s_barrier()
#define PG8_SCHED __builtin_amdgcn_sched_barrier(0)
    Unit cur, nxt; int ui = 0;
    if (!S.next(0, cur)) return;
    f32x4 acc[2][2][4][2];
#pragma unroll
    for (int a = 0; a < 2; ++a)
#pragma unroll
        for (int b = 0; b < 2; ++b)
#pragma unroll
            for (int m = 0; m < 4; ++m)
#pragma unroll
                for (int n = 0; n < 2; ++n) acc[a][b][m][n] = (f32x4){0.f, 0.f, 0.f, 0.f};
    bf16x8 At[4][2], B0[2][2], B1[2][2];
    const char* cA = g.A + cur.aoff; const char* cB = g.Bt + cur.boff;
    PG8_STAGE(PG8_SB(0, 0), cB, voffB); PG8_STAGE(PG8_SA(0, 0), cA, voffA); PG8_STAGE(PG8_SB(0, 1), cB + hstepB, voffB); PG8_STAGE(PG8_SA(0, 1), cA + hstepA, voffA);
    if (wr == 1) PG8_BAR;
    PG8_WAIT_V(4); PG8_BAR;
    PG8_STAGE(PG8_SB(1, 0), cB + kstep, voffB); PG8_STAGE(PG8_SA(1, 0), cA + kstep, voffA); PG8_STAGE(PG8_SB(1, 1), cB + hstepB + kstep, voffB);
    PG8_WAIT_V(6); PG8_BAR;
    for (;;) {
        const bool has_next = S.next(ui + 1, nxt);
        const char* nA = has_next ? g.A + nxt.aoff : cA; const char* nB = has_next ? g.Bt + nxt.boff : cB;
        const int nt = cur.nt;
        for (int t = 0; t < nt; t += 2) {
            const bool last = (t == nt - 2);
            const char* a1 = cA + (size_t)(t + 1) * kstep;
            const char* a2 = last ? nA : cA + (size_t)(t + 2) * kstep; const char* b2 = last ? nB : cB + (size_t)(t + 2) * kstep;
            const char* a3 = a2 + kstep; const char* b3 = b2 + kstep;
            PG8_LDB(B0, 0, 0); PG8_SCHED; PG8_LDA(At, 0, 0); PG8_STAGE(PG8_SA(1, 1), a1 + hstepA, voffA);
            PG8_WAIT_L(8); PG8_BAR; PG8_WAIT_L(0); PG8_MMA(0, 0, At, B0); PG8_BAR; PG8_SCHED;
            PG8_LDB(B1, 0, 1); PG8_STAGE(PG8_SB(0, 0), b2, voffB);
            PG8_BAR; PG8_WAIT_L(0); PG8_MMA(0, 1, At, B1); PG8_BAR;
            PG8_LDA(At, 0, 1); PG8_STAGE(PG8_SA(0, 0), a2, voffA);
            PG8_BAR; PG8_WAIT_L(0); PG8_MMA(1, 0, At, B0); PG8_BAR; PG8_SCHED;
            PG8_STAGE(PG8_SB(0, 1), b2 + hstepB, voffB);
            PG8_WAIT_V(6); PG8_BAR; PG8_MMA(1, 1, At, B1); PG8_BAR;
            PG8_LDB(B0, 1, 0); PG8_SCHED; PG8_LDA(At, 1, 0); PG8_STAGE(PG8_SA(0, 1), a2 + hstepA, voffA);
            PG8_WAIT_L(8); PG8_BAR; PG8_WAIT_L(0); PG8_MMA(0, 0, At, B0); PG8_BAR; PG8_SCHED;
            PG8_LDB(B1, 1, 1); PG8_STAGE(PG8_SB(1, 0), b3, voffB);
            PG8_BAR; PG8_WAIT_L(0); PG8_MMA(0, 1, At, B1); PG8_BAR;
            PG8_LDA(At, 1, 1); PG8_STAGE(PG8_SA(1, 0), a3, voffA);
            PG8_BAR; PG8_WAIT_L(0); PG8_MMA(1, 0, At, B0); PG8_BAR; PG8_SCHED;
            PG8_STAGE(PG8_SB(1, 1), b3 + hstepB, voffB);
            PG8_WAIT_V(6); PG8_BAR; PG8_MMA(1, 1, At, B1); PG8_BAR;
        }
        E(acc, cur, wr, wc, fr, fq);
        if (!has_next) break;
#pragma unroll
        for (int a = 0; a < 2; ++a)
#pragma unroll
            for (int b = 0; b < 2; ++b)
#pragma unroll
                for (int m = 0; m < 4; ++m)
#pragma unroll
                    for (int n = 0; n < 2; ++n) acc[a][b][m][n] = (f32x4){0.f, 0.f, 0.f, 0.f};
        cur = nxt; cA = nA; cB = nB; ++ui;
    }
    PG8_WAIT_V(0);
    if (wr == 0) PG8_BAR;
    PG8_BAR;
#undef PG8_SA
#undef PG8_SB
#undef PG8_STAGE
#undef PG8_LDA
#undef PG8_LDB
#undef PG8_MMA
#undef PG8_WAIT_V
#undef PG8_WAIT_L
#undef PG8_BAR
#undef PG8_SCHED
}
}

__device__ __forceinline__ void tr_item(const float* __restrict__ W, int ldw, int N, int k0, int n0, const float* __restrict__ scale, bf16_t* __restrict__ dst, int ldd, float* scr, int lane) {
    const int r4 = lane >> 4, c4 = (lane & 15) * 4;
    const bool inb = (n0 + c4) < N;
    f32x4 v[16];
#pragma unroll
    for (int i = 0; i < 16; ++i) v[i] = inb ? *(const f32x4*)(W + (size_t)(k0 + 4 * i + r4) * ldw + n0 + c4) : (f32x4){0.f, 0.f, 0.f, 0.f};
#pragma unroll
    for (int i = 0; i < 16; ++i) { float* d = scr + (4 * i + r4) * 65 + c4; d[0] = v[i][0]; d[1] = v[i][1]; d[2] = v[i][2]; d[3] = v[i][3]; }
    LDS_WAIT();
    const int c = lane & 7;
    f32x4 s0 = (f32x4){1.f, 1.f, 1.f, 1.f}, s1 = s0;
    if (scale) { s0 = *(const f32x4*)(scale + k0 + 8 * c); s1 = *(const f32x4*)(scale + k0 + 8 * c + 4); }
#pragma unroll
    for (int j = 0; j < 8; ++j) { const int n = (lane >> 3) + 8 * j; const float* sp = scr + (8 * c) * 65 + n;
        u32x4 o; o.x = pk2(sp[0 * 65] * s0[0], sp[1 * 65] * s0[1]); o.y = pk2(sp[2 * 65] * s0[2], sp[3 * 65] * s0[3]); o.z = pk2(sp[4 * 65] * s1[0], sp[5 * 65] * s1[1]); o.w = pk2(sp[6 * 65] * s1[2], sp[7 * 65] * s1[3]);
        *(u32x4*)(dst + (size_t)n * ldd + 8 * c) = o; }
    LDS_WAIT();
}

__device__ __forceinline__ void phase_prologue(const Params& p, float* ldsf) {
    int tid = threadIdx.x; asm volatile("" : "+v"(tid));
    const int wave = tid >> 6, lane = tid & 63;
    const int gw = blockIdx.x * 8 + wave, NGW = gridDim.x * 8;
    float* scr = ldsf + wave * 4160;
    unsigned char* ws = p.ws;
    constexpr int I0 = 32 * 177, I1 = 64 * 32, I2 = 32 * 176, I3 = 88 * 32, I4 = 32 * 192, I5 = I1, I6 = I2, I7 = I3, I8 = 128, I9 = 128;
    constexpr int NIT = I0 + I1 + I2 + I3 + I4 + I5 + I6 + I7 + I8 + I9;
    for (int it = gw; it < NIT; it += NGW) {
        int r = it;
        const float* W; int K, N; const float* sc = nullptr; bf16_t* WT;
        if (r < I0) { W = p.in[12 + p.z]; K = 2048; N = 11296; sc = p.in[9 + p.z]; WT = (bf16_t*)(ws + WS_WIN0); }
        else if ((r -= I0) < I1) { W = p.in[19 + p.z]; K = 4096; N = 2048; WT = (bf16_t*)(ws + WS_WOUT0); }
        else if ((r -= I1) < I2) { W = p.in[31 + p.z]; K = 2048; N = 11264; sc = p.in[10 + p.z]; WT = (bf16_t*)(ws + WS_WUP0); }
        else if ((r -= I2) < I3) { W = p.in[34 + p.z]; K = 5632; N = 2048; WT = (bf16_t*)(ws + WS_WDN0); }
        else if ((r -= I3) < I4) { W = p.in[20 + p.z]; K = 2048; N = 12288; sc = p.in[9 + p.z] + 2048; WT = (bf16_t*)(ws + WS_WIN1); }
        else if ((r -= I4) < I5) { W = p.in[30 + p.z]; K = 4096; N = 2048; WT = (bf16_t*)(ws + WS_WOUT1); }
        else if ((r -= I5) < I6) { W = p.in[31 + p.z] + (size_t)2048 * 11264; K = 2048; N = 11264; sc = p.in[10 + p.z] + 2048; WT = (bf16_t*)(ws + WS_WUP1); }
        else if ((r -= I6) < I7) { W = p.in[34 + p.z] + (size_t)5632 * 2048; K = 5632; N = 2048; WT = (bf16_t*)(ws + WS_WDN1); }
        else {
            r -= I7; const int which = r >> 7; r &= 127;
            const int blk = r >> 4, kb = (r >> 2) & 3, nb = r & 3, n0 = 64 * nb, k0 = 64 * kb;
            const float* Wl = (which ? p.in[27 + p.z] : p.in[25 + p.z]) + (size_t)blk * 65536;
            const int drow = (blk * 2 + (n0 >> 7)) * 256 + which * 128 + (n0 & 127);
            tr_item(Wl, 256, 256, k0, n0, nullptr, (bf16_t*)(ws + WS_WLRU) + (size_t)drow * 256 + k0, 256, scr, lane);
            continue;
        }
        const int nblk = (N + 63) / 64, kb = r / nblk, nb = r % nblk, k0 = 64 * kb, n0 = 64 * nb;
        tr_item(W, N, N, k0, n0, sc, WT + (size_t)n0 * K + k0, K, scr, lane);
    }
    {
        u32x4* z = (u32x4*)((bf16_t*)(ws + WS_WIN0) + (size_t)11296 * 2048);
        const int n16 = 224 * 2048 * 2 / 16;
        for (int i = blockIdx.x * 512 + tid; i < n16; i += gridDim.x * 512) z[i] = (u32x4){0u, 0u, 0u, 0u};
    }
    float* X = (float*)(ws + WS_X); bf16_t* XB = (bf16_t*)(ws + WS_XB); float* ss = (float*)(ws + WS_SS);
    for (int row = gw; row < MT; row += NGW) {
        const float* src = row < MP ? p.in[0 + p.z] + (size_t)row * 2048 : p.in[1 + p.z] + (size_t)(row - MP) * 2048;
        float s = 0.f;
#pragma unroll
        for (int j = 0; j < 8; ++j) {
            const f32x4 v = *(const f32x4*)(src + (lane + 64 * j) * 4);
            *(f32x4*)(X + (size_t)row * 2048 + (lane + 64 * j) * 4) = v;
            u32x2 w; w.x = pk2(v[0], v[1]); w.y = pk2(v[2], v[3]);
            *(u32x2*)(XB + (size_t)row * 2048 + (lane + 64 * j) * 4) = w;
            s += (v[0] * v[0] + v[1] * v[1]) + (v[2] * v[2] + v[3] * v[3]);
        }
        s = wave_sum(s);
        if (lane == 0) ss[row] = s;
    }
    for (int i = blockIdx.x * 512 + tid; i < 4 * MT; i += gridDim.x * 512) ss[MT + i] = 0.f;
    for (int i = blockIdx.x * 512 + tid; i < 2048; i += gridDim.x * 512) {
        ((float*)(ws + WS_SP))[i] = softplus(-p.in[29 + p.z][i]);
        ((float*)(ws + WS_LB))[i] = sigm(p.in[21 + p.z][2048 + i] - p.in[21 + p.z][i]);
    }
}

__device__ __forceinline__ int next_item(unsigned* ctr, float* ldsf) {
    __syncthreads();
    if (threadIdx.x == 0) ((volatile unsigned*)ldsf)[24576] = atomicAdd(ctr, 1u);
    __syncthreads();
    return (int)((volatile unsigned*)ldsf)[24576];
}

template <int TYPE, int VW>
__device__ __forceinline__ void rec_item(const Params& p, float* ldsf, int sample, int b, int h, int s) {
    constexpr int NV = VW / 16;
    typedef float VT __attribute__((ext_vector_type(NV)));
    int tid = threadIdx.x; asm volatile("" : "+v"(tid));
    const int w = tid >> 6, lane = tid & 63, kg = lane >> 4, vq = lane & 15, kb = 16 * w + 4 * kg;
    const int L = sample ? 4 : 2048, row0 = sample ? MP + 4 * b : 2048 * b, pos0 = sample ? 16384 : 0;
    constexpr int LDP = TYPE < 2 ? LD0 : LD1;
    const bf16_t* proj = (const bf16_t*)(p.ws + WS_PROJ) + (size_t)row0 * LDP;
    bf16_t* yz = (bf16_t*)(p.ws + WS_YZ) + (size_t)row0 * 4096;
    float* part = ldsf + 8192;
    int colA = -1, colB = -1, role = -1, didx = 0;
    float w0 = 0.f, w1 = 0.f, w2 = 0.f, w3 = 0.f, cbias = 0.f, c0 = 0.f, c1 = 0.f, c2 = 0.f, aux = 0.f, aux2 = 0.f;
    if constexpr (TYPE == 0) {
        if (tid < 320) {
            role = tid < 128 ? 0 : (tid < 256 ? 1 : 2);
            didx = tid < 128 ? tid : (tid < 256 ? tid - 128 : tid - 256);
            const int ch = tid < 128 ? 2560 + (h >> 3) * 128 + tid : (tid < 256 ? 2048 + (h >> 3) * 128 + (tid - 128) : h * 64 + (tid - 256));
            colA = 2048 + ch;
            const float* cw = p.in[13 + p.z];
            w0 = cw[ch]; w1 = cw[3072 + ch]; w2 = cw[2 * 3072 + ch]; w3 = cw[3 * 3072 + ch]; cbias = p.in[14 + p.z][ch];
            if (sample) { const float* st = p.in[3 + p.z] + (size_t)b * 3 * 3072; c0 = st[ch]; c1 = st[3072 + ch]; c2 = st[2 * 3072 + ch]; }
        } else if (tid < 328) { role = 3; didx = tid - 320; colA = 5120 + h; aux = p.in[15 + p.z][h]; aux2 = -__expf(p.in[16 + p.z][h]); }
    } else if constexpr (TYPE == 1) {
        if (tid < 128) { role = tid < 64 ? 0 : 1; didx = tid & 63; colA = (tid < 64 ? 5152 : 6176) + h * 128 + didx; colB = colA + 64;
            aux = exp2f(-(float)didx * 0.20762050593046014f); }
        else if (tid < 128 + VW) { role = 2; didx = tid - 128; colA = 7200 + h * 256 + s * VW + didx; }
    } else {
        if (tid < 128) { role = 0; didx = tid; colA = h * 128 + tid; }
        else if (tid < 256) { role = 1; didx = tid - 128; colA = 2048 + h * 128 + didx; aux = ((const float*)(p.ws + WS_LB))[h * 128 + didx]; }
        else if (tid < 256 + VW) { role = 2; didx = tid - 256; colA = 4096 + h * 128 + s * VW + didx; }
    }
    const float Dh = TYPE == 0 ? p.in[17 + p.z][h] : 0.f;
    const float gamma = TYPE == 1 ? 1.0f - exp2f(-5.0f - (float)h * (4.0f / 7.0f)) : 0.f;
    const int ldS = TYPE == 0 ? 64 : (TYPE == 1 ? 256 : 128);
    size_t soff;
    if constexpr (TYPE == 0) soff = ((size_t)(b * 32 + h) * 128) * 64;
    else if constexpr (TYPE == 1) soff = ((size_t)(b * 8 + h) * 128) * 256 + s * VW;
    else soff = ((size_t)(b * 16 + h) * 128) * 128 + s * VW;
    const float* S0 = TYPE == 0 ? p.in[2 + p.z] : (TYPE == 1 ? p.in[4 + p.z] : p.in[5 + p.z]);
    float* Sout = p.out + (TYPE == 0 ? (sample ? O_SSMS : O_SSMP) : (TYPE == 1 ? (sample ? O_RETS : O_RETP) : (sample ? O_HGS : O_HGP))) + soff;
    VT S[4];
#pragma unroll
    for (int i = 0; i < 4; ++i) { if (sample) S[i] = *(const VT*)(S0 + soff + (size_t)(kb + i) * ldS + NV * vq); else S[i] = (VT)(0.f); }
    unsigned short ra[8], rb[8]; unsigned short zr = 0;
    const int R = (L + 7) >> 3;
    auto load_raw = [&](int r) {
#pragma unroll
        for (int t = 0; t < 8; ++t) {
            const int tt = 8 * r + t;
            ra[t] = 0; rb[t] = 0;
            if (tt < L) {
                if (colA >= 0) ra[t] = proj[(size_t)tt * LDP + colA];
                if (TYPE == 1 && colB >= 0) rb[t] = proj[(size_t)tt * LDP + colB];
            }
        }
        if (TYPE == 0) { const int tt = 8 * r + w; if (tt < L) zr = proj[(size_t)tt * LDP + h * 64 + lane]; }
    };
    load_raw(0);
    for (int r = 0; r < R; ++r) {
        const int nv = (L - 8 * r) < 8 ? (L - 8 * r) : 8;
        float* stg = ldsf + (r & 1) * 4096;
        float* qs = stg; float* ks = stg + 1024; float* as = stg + 2048; float* vs = stg + 3072; float* ad = stg + 3584;
        if constexpr (TYPE == 0) {
            if (role >= 0 && role < 3) {
                float* dst = role == 0 ? qs : (role == 1 ? ks : vs); const int dstr = role == 2 ? 64 : 128;
#pragma unroll
                for (int t = 0; t < 8; ++t) {
                    const float x = bf2f(ra[t]);
                    const float y = cbias + w0 * c0 + w1 * c1 + w2 * c2 + w3 * x;
                    c0 = c1; c1 = c2; c2 = x;
                    dst[t * dstr + didx] = silu(y);
                }
            } else if (role == 3) {
                float xv = 0.f;
#pragma unroll
                for (int t = 0; t < 8; ++t) if (t == didx) xv = bf2f(ra[t]);
                const float dt = softplus(xv + aux);
                ad[2 * didx] = __expf(dt * aux2); ad[2 * didx + 1] = dt;
            }
        } else if constexpr (TYPE == 1) {
            if (role == 0 || role == 1) {
                float* dst = role == 0 ? qs : ks; const float sc = role == 0 ? 1.0f : 0.08838834764831845f;
#pragma unroll
                for (int t = 0; t < 8; ++t) {
                    const int pos = pos0 + 8 * r + t;
                    const double rev = (double)pos * (double)aux * 0.15915494309189535;
                    const float fr = (float)(rev - floor(rev));
                    const float sn = __builtin_amdgcn_sinf(fr), cs = __builtin_amdgcn_cosf(fr);
                    const float x1 = bf2f(ra[t]) * sc, x2 = bf2f(rb[t]) * sc;
                    dst[t * 128 + didx] = x1 * cs - x2 * sn;
                    dst[t * 128 + 64 + didx] = x1 * sn + x2 * cs;
                }
            } else if (role == 2) {
#pragma unroll
                for (int t = 0; t < 8; ++t) vs[t * VW + didx] = bf2f(ra[t]);
            }
        } else {
            if (role == 0) {
#pragma unroll
                for (int t = 0; t < 8; ++t) qs[t * 128 + didx] = silu(bf2f(ra[t]));
            } else if (role == 1) {
#pragma unroll
                for (int t = 0; t < 8; ++t) { const float f = aux + (1.0f - aux) * sigm(bf2f(ra[t])); as[t * 128 + didx] = f; ks[t * 128 + didx] = 1.0f - f; }
            } else if (role == 2) {
#pragma unroll
                for (int t = 0; t < 8; ++t) vs[t * VW + didx] = bf2f(ra[t]);
            }
        }
        const unsigned short zc = zr;
        __syncthreads();
        if (r + 1 < R) load_raw(r + 1);
        for (int t0 = 0; t0 < nv; t0 += 4) {
#pragma unroll
            for (int tt = 0; tt < 4; ++tt) {
                const int t = t0 + tt;
                const f32x4 q4 = *(const f32x4*)(qs + t * 128 + kb);
                f32x4 k4 = *(const f32x4*)(ks + t * 128 + kb);
                const VT v4 = *(const VT*)(vs + t * VW + NV * vq);
                f32x4 a4;
                if constexpr (TYPE == 0) { const f32x2 adv = *(const f32x2*)(ad + 2 * t); a4 = (f32x4){adv.x, adv.x, adv.x, adv.x}; k4 = k4 * adv.y; }
                else if constexpr (TYPE == 1) a4 = (f32x4){gamma, gamma, gamma, gamma};
                else a4 = *(const f32x4*)(as + t * 128 + kb);
                VT o = (VT)(0.f);
#pragma unroll
                for (int i = 0; i < 4; ++i) { S[i] = a4[i] * S[i] + k4[i] * v4; o += q4[i] * S[i]; }
                *(VT*)(part + ((t * 32 + w * 4 + kg) * VW + NV * vq)) = o;
            }
        }
        __syncthreads();
        const int rt = tid / VW, rv = tid % VW;
        if (tid < 8 * VW && rt < nv) {
            float o = 0.f;
#pragma unroll
            for (int pp = 0; pp < 32; ++pp) o += part[(rt * 32 + pp) * VW + rv];
            const size_t trow = (size_t)(8 * r + rt);
            if constexpr (TYPE == 0) {
                const float y = (o + Dh * vs[rt * 64 + rv]) * silu(bf2f(zc));
                yz[trow * 4096 + h * 64 + rv] = f2bf(y);
            } else if constexpr (TYPE == 1) {
                yz[trow * 4096 + 2048 + h * 256 + s * VW + rv] = f2bf(o);
            } else {
                yz[trow * 4096 + h * 128 + s * VW + rv] = f2bf(o);
            }
        }
    }
#pragma unroll
    for (int i = 0; i < 4; ++i) *(VT*)(Sout + (size_t)(kb + i) * ldS + NV * vq) = S[i];
}

__device__ __forceinline__ void lru_item(const Params& p, int sample, int b, int cb) {
    const int c = cb * 512 + threadIdx.x;
    const int L = sample ? 4 : 2048, row0 = sample ? MP + 4 * b : 2048 * b;
    const float* LA = (const float*)(p.ws + WS_LA) + (size_t)row0 * 2048 + c;
    const bf16_t* LBv = (const bf16_t*)(p.ws + WS_LBB) + (size_t)row0 * 2048 + c;
    const bf16_t* rg = (const bf16_t*)(p.ws + WS_PROJ) + (size_t)row0 * LD1 + 10240 + c;
    bf16_t* mixa = (bf16_t*)(p.ws + WS_ACT) + (size_t)row0 * 4096 + 2048 + c;
    float hst = sample ? p.in[6 + p.z][(size_t)b * 2048 + c] : 0.f;
    if (sample) {
#pragma unroll
        for (int t = 0; t < 4; ++t) {
            hst = LA[(size_t)t * 2048] * hst + bf2f(LBv[(size_t)t * 2048]);
            mixa[(size_t)t * 4096] = f2bf(hst * gelu_tanh(bf2f(rg[(size_t)t * LD1])));
        }
    } else {
        float a0[16]; unsigned short b0[16], g0[16];
#pragma unroll
        for (int t = 0; t < 16; ++t) { a0[t] = LA[(size_t)t * 2048]; b0[t] = LBv[(size_t)t * 2048]; g0[t] = rg[(size_t)t * LD1]; }
        for (int tb = 0; tb < 2048; tb += 16) {
            float a1[16]; unsigned short b1[16], g1[16];
            const int tn = (tb + 16 < 2048) ? tb + 16 : tb;
#pragma unroll
            for (int t = 0; t < 16; ++t) { a1[t] = LA[(size_t)(tn + t) * 2048]; b1[t] = LBv[(size_t)(tn + t) * 2048]; g1[t] = rg[(size_t)(tn + t) * LD1]; }
#pragma unroll
            for (int t = 0; t < 16; ++t) {
                hst = a0[t] * hst + bf2f(b0[t]);
                mixa[(size_t)(tb + t) * 4096] = f2bf(hst * gelu_tanh(bf2f(g0[t])));
            }
#pragma unroll
            for (int t = 0; t < 16; ++t) { a0[t] = a1[t]; b0[t] = b1[t]; g0[t] = g1[t]; }
        }
    }
    p.out[(sample ? O_LRUS : O_LRUP) + (size_t)b * 2048 + c] = hst;
}

__device__ __forceinline__ void phase_rec0(const Params& p, float* ldsf) {
    unsigned* ctr = (unsigned*)(p.ws + WS_CTL);
    const int total = 256 + 8192;
    for (;;) {
        const int it = next_item(ctr, ldsf);
        if (it >= total) break;
        int sample, j, type;
        if (it < 128) { sample = 0; j = it; type = 0; }
        else if (it < 256) { sample = 0; j = it - 128; type = 1; }
        else if (it < 256 + 4096) { sample = 1; j = it - 256; type = 0; }
        else { sample = 1; j = it - 256 - 4096; type = 1; }
        if (type == 0) rec_item<0, 64>(p, ldsf, sample, j >> 5, j & 31, 0);
        else rec_item<1, 64>(p, ldsf, sample, j >> 5, (j & 31) >> 2, j & 3);
    }
}
__device__ __forceinline__ void phase_rec1(const Params& p, float* ldsf) {
    unsigned* ctr = (unsigned*)(p.ws + WS_CTL) + 64;
    const int total = 256 + 16 + 4096 + 512;
    for (;;) {
        const int it = next_item(ctr, ldsf);
        if (it >= total) break;
        if (it < 256) rec_item<2, 32>(p, ldsf, 0, it >> 6, (it & 63) >> 2, it & 3);
        else if (it < 272) lru_item(p, 0, (it - 256) >> 2, (it - 256) & 3);
        else if (it < 272 + 4096) { const int j = it - 272; rec_item<2, 64>(p, ldsf, 1, j >> 5, (j & 31) >> 1, j & 1); }
        else { const int j = it - 272 - 4096; lru_item(p, 1, j >> 2, j & 3); }
    }
}

__device__ __forceinline__ void seq_of_row(int row, int& sample, int& b, int& t, int& L) {
    if (row < MP) { sample = 0; b = row >> 11; t = row & 2047; L = 2048; } else { sample = 1; b = (row - MP) >> 2; t = (row - MP) & 3; L = 4; }
}

__device__ __forceinline__ void phase_prep0(const Params& p) {
    int tid = threadIdx.x; asm volatile("" : "+v"(tid));
    const int wave = tid >> 6, lane = tid & 63;
    const int gw = blockIdx.x * 8 + wave, NGW = gridDim.x * 8;
    const bf16_t* YZ = (const bf16_t*)(p.ws + WS_YZ); const bf16_t* PR = (const bf16_t*)(p.ws + WS_PROJ);
    bf16_t* MX = (bf16_t*)(p.ws + WS_ACT);
    const float* nw = p.in[18 + p.z];
    for (int row = gw; row < MT; row += NGW) {
        const bf16_t* yz = YZ + (size_t)row * 4096; bf16_t* mx = MX + (size_t)row * 4096;
#pragma unroll 1
        for (int g = 0; g < 4; ++g) {
            const int c = g * 512 + lane * 8;
            float v[8]; unpack8(*(const u32x4*)(yz + c), v);
            float s = 0.f;
#pragma unroll
            for (int j = 0; j < 8; ++j) s += v[j] * v[j];
            s = wave_sum(s);
            const float rs = rsqrtf(s * (1.0f / 512.0f) + EPS);
            const f32x4 n0 = *(const f32x4*)(nw + c), n1 = *(const f32x4*)(nw + c + 4);
            u32x4 o; o.x = pk2(v[0] * rs * n0[0], v[1] * rs * n0[1]); o.y = pk2(v[2] * rs * n0[2], v[3] * rs * n0[3]);
            o.z = pk2(v[4] * rs * n1[0], v[5] * rs * n1[1]); o.w = pk2(v[6] * rs * n1[2], v[7] * rs * n1[3]);
            *(u32x4*)(mx + c) = o;
        }
#pragma unroll 2
        for (int hh = 0; hh < 8; ++hh) {
            const int c = hh * 256 + lane * 4;
            float v[4]; unpack4(*(const u32x2*)(yz + 2048 + c), v);
            float gt[4]; unpack4(*(const u32x2*)(PR + (size_t)row * LD0 + 9248 + c), gt);
            float s = (v[0] * v[0] + v[1] * v[1]) + (v[2] * v[2] + v[3] * v[3]);
            s = wave_sum(s);
            const float rs = rsqrtf(s * (1.0f / 256.0f) + EPS);
            u32x2 o; o.x = pk2(v[0] * rs * silu(gt[0]), v[1] * rs * silu(gt[1])); o.y = pk2(v[2] * rs * silu(gt[2]), v[3] * rs * silu(gt[3]));
            *(u32x2*)(mx + 2048 + c) = o;
        }
        int sample, b, t, L; seq_of_row(row, sample, b, t, L);
        if (t >= L - 3) {
            float* dst = p.out + (sample ? O_SCS : O_SCP) + ((size_t)b * 3 + (t - (L - 3))) * 3072;
            const bf16_t* src = PR + (size_t)row * LD0 + 2048;
#pragma unroll 4
            for (int c = lane; c < 3072; c += 64) dst[c] = bf2f(src[c]);
        }
    }
}

__device__ __forceinline__ void phase_prep1(const Params& p) {
    int tid = threadIdx.x; asm volatile("" : "+v"(tid));
    const int wave = tid >> 6, lane = tid & 63;
    const int gw = blockIdx.x * 8 + wave, NGW = gridDim.x * 8;
    const bf16_t* YZ = (const bf16_t*)(p.ws + WS_YZ); const bf16_t* PR = (const bf16_t*)(p.ws + WS_PROJ);
    bf16_t* MX = (bf16_t*)(p.ws + WS_ACT);
    const float* nw = p.in[22 + p.z];
    for (int row = gw; row < MT; row += NGW) {
#pragma unroll 1
        for (int it = 0; it < 4; ++it) {
            const int c = it * 512 + lane * 8;
            float v[8]; unpack8(*(const u32x4*)(YZ + (size_t)row * 4096 + c), v);
            float gt[8]; unpack8(*(const u32x4*)(PR + (size_t)row * LD1 + 6144 + c), gt);
            float s = 0.f;
#pragma unroll
            for (int j = 0; j < 8; ++j) s += v[j] * v[j];
            s += __shfl_xor(s, 1); s += __shfl_xor(s, 2); s += __shfl_xor(s, 4); s += __shfl_xor(s, 8);
            const float rs = rsqrtf(s * (1.0f / 128.0f) + EPS);
            const f32x4 n0 = *(const f32x4*)(nw + (c & 127)), n1 = *(const f32x4*)(nw + (c & 127) + 4);
            float o[8];
#pragma unroll
            for (int j = 0; j < 8; ++j) o[j] = v[j] * rs * (j < 4 ? n0[j] : n1[j - 4]) * silu(gt[j]);
            u32x4 ov; ov.x = pk2(o[0], o[1]); ov.y = pk2(o[2], o[3]); ov.z = pk2(o[4], o[5]); ov.w = pk2(o[6], o[7]);
            *(u32x4*)(MX + (size_t)row * 4096 + c) = ov;
        }
    }
}

__device__ __forceinline__ void phase_act(const Params& p, int l) {
    const bf16_t* PR = (const bf16_t*)(p.ws + WS_PROJ); bf16_t* ACT = (bf16_t*)(p.ws + WS_ACT);
    const float* cw = p.in[32 + p.z] + (size_t)l * 3 * DFF; const float* cbv = p.in[33 + p.z] + (size_t)l * DFF;
    const float* st = p.in[8 + p.z] + (size_t)l * 128 * 2 * DFF;
    const int total = MT * 704;
    for (int idx = blockIdx.x * 512 + threadIdx.x; idx < total; idx += gridDim.x * 512) {
        const int row = idx / 704, c = (idx - row * 704) * 8;
        int sample, b, t, L; seq_of_row(row, sample, b, t, L);
        float g2[8], g1[8], g0[8], uu[8];
        unpack8(*(const u32x4*)(PR + (size_t)row * LDU + c), g2);
        unpack8(*(const u32x4*)(PR + (size_t)row * LDU + DFF + c), uu);
        if (t >= 1) unpack8(*(const u32x4*)(PR + (size_t)(row - 1) * LDU + c), g1);
        else {
#pragma unroll
            for (int j = 0; j < 8; ++j) g1[j] = sample ? st[((size_t)b * 2 + 1) * DFF + c + j] : 0.f;
        }
        if (t >= 2) unpack8(*(const u32x4*)(PR + (size_t)(row - 2) * LDU + c), g0);
        else {
#pragma unroll
            for (int j = 0; j < 8; ++j) g0[j] = sample ? st[((size_t)b * 2 + t) * DFF + c + j] : 0.f;
        }
        float o[8];
#pragma unroll
        for (int j = 0; j < 8; ++j) {
            const float y = cbv[c + j] + cw[c + j] * g0[j] + cw[DFF + c + j] * g1[j] + cw[2 * DFF + c + j] * g2[j];
            o[j] = silu(y) * uu[j];
        }
        u32x4 ov; ov.x = pk2(o[0], o[1]); ov.y = pk2(o[2], o[3]); ov.z = pk2(o[4], o[5]); ov.w = pk2(o[6], o[7]);
        *(u32x4*)(ACT + (size_t)row * DFF + c) = ov;
        if (t >= L - 2) {
            float* dst = p.out + (sample ? O_FCS + (((size_t)l * 128 + b) * 2 + (t - (L - 2))) * DFF : O_FCP + (((size_t)l * 4 + b) * 2 + (t - (L - 2))) * DFF) + c;
            *(f32x4*)dst = (f32x4){g2[0], g2[1], g2[2], g2[3]}; *(f32x4*)(dst + 4) = (f32x4){g2[4], g2[5], g2[6], g2[7]};
        }
    }
}

__device__ __forceinline__ void phase_lruconv(const Params& p) {
    const bf16_t* PR = (const bf16_t*)(p.ws + WS_PROJ); bf16_t* XR = (bf16_t*)(p.ws + WS_XR);
    const float* cw = p.in[23 + p.z]; const float* cbv = p.in[24 + p.z]; const float* st = p.in[7 + p.z];
    const int total = MT * 256;
    for (int idx = blockIdx.x * 512 + threadIdx.x; idx < total; idx += gridDim.x * 512) {
        const int row = idx >> 8, c = (idx & 255) * 8;
        int sample, b, t, L; seq_of_row(row, sample, b, t, L);
        float x[4][8];
#pragma unroll
        for (int j = 0; j < 4; ++j) {
            const int tt = t + j - 3;
            if (tt >= 0) unpack8(*(const u32x4*)(PR + (size_t)(row + j - 3) * LD1 + 8192 + c), x[j]);
            else {
#pragma unroll
                for (int i = 0; i < 8; ++i) x[j][i] = sample ? st[((size_t)b * 3 + (t + j)) * 2048 + c + i] : 0.f;
            }
        }
        float o[8];
#pragma unroll
        for (int i = 0; i < 8; ++i) o[i] = cbv[c + i] + cw[c + i] * x[0][i] + cw[2048 + c + i] * x[1][i] + cw[4096 + c + i] * x[2][i] + cw[6144 + c + i] * x[3][i];
        u32x4 ov; ov.x = pk2(o[0], o[1]); ov.y = pk2(o[2], o[3]); ov.z = pk2(o[4], o[5]); ov.w = pk2(o[6], o[7]);
        *(u32x4*)(XR + (size_t)row * 2048 + c) = ov;
        if (t >= L - 3) {
            float* dst = p.out + (sample ? O_LCS : O_LCP) + ((size_t)b * 3 + (t - (L - 3))) * 2048 + c;
            *(f32x4*)dst = (f32x4){x[3][0], x[3][1], x[3][2], x[3][3]}; *(f32x4*)(dst + 4) = (f32x4){x[3][4], x[3][5], x[3][6], x[3][7]};
        }
    }
}

__device__ __forceinline__ void finalize_sample_rows(const Params& p, float* ssdst, int nsplit) {
    int tid = threadIdx.x; asm volatile("" : "+v"(tid));
    const int wave = tid >> 6, lane = tid & 63;
    const int gw = blockIdx.x * 8 + wave, NGW = gridDim.x * 8;
    float* X = (float*)(p.ws + WS_X); bf16_t* XB = (bf16_t*)(p.ws + WS_XB); const float* PT = (const float*)(p.ws + WS_PROJ);
    for (int row = MP + gw; row < MT; row += NGW) {
        float s = 0.f;
#pragma unroll 2
        for (int j = 0; j < 8; ++j) {
            const unsigned o = (unsigned)row * 2048u + (unsigned)(lane + 64 * j) * 4u;
            f32x4 v = *(const f32x4*)(X + o);
            for (int ks = 0; ks < nsplit; ++ks) v += *(const f32x4*)(PT + (size_t)ks * (512 * 2048) + (o - (unsigned)MP * 2048u));
            *(f32x4*)(X + o) = v;
            u32x2 w; w.x = pk2(v[0], v[1]); w.y = pk2(v[2], v[3]);
            *(u32x2*)(XB + o) = w;
            s += (v[0] * v[0] + v[1] * v[1]) + (v[2] * v[2] + v[3] * v[3]);
        }
        s = wave_sum(s);
        if (lane == 0) ssdst[row] = s;
    }
}

__device__ __forceinline__ void phase_final(const Params& p) {
    int tid = threadIdx.x; asm volatile("" : "+v"(tid));
    const int wave = tid >> 6, lane = tid & 63;
    const int gw = blockIdx.x * 8 + wave, NGW = gridDim.x * 8;
    const float* X = (const float*)(p.ws + WS_X); const float* nf = p.in[11 + p.z];
    for (int row = gw; row < MT; row += NGW) {
        f32x4 v[8]; float sq = 0.f;
#pragma unroll
        for (int j = 0; j < 8; ++j) { v[j] = *(const f32x4*)(X + (size_t)row * 2048 + (lane + 64 * j) * 4);
            if (row >= MP) { for (int ks = 0; ks < 11; ++ks) v[j] += *(const f32x4*)((const float*)(p.ws + WS_PROJ) + (size_t)ks * (512 * 2048) + (size_t)(row - MP) * 2048 + (lane + 64 * j) * 4); }
            sq += (v[j][0] * v[j][0] + v[j][1] * v[j][1]) + (v[j][2] * v[j][2] + v[j][3] * v[j][3]); }
        sq = wave_sum(sq);
        const float rs = rsqrtf(sq * (1.0f / 2048.0f) + EPS);
        float* dst = p.out + (row < MP ? O_YP + (size_t)row * 2048 : O_YS + (size_t)(row - MP) * 2048);
#pragma unroll
        for (int j = 0; j < 8; ++j) {
            const int c = (lane + 64 * j) * 4;
            *(f32x4*)(dst + c) = v[j] * rs * *(const f32x4*)(nf + c);
        }
    }
}

#define XB_TMO      128
#define XB_XCNT(j)  (256  + 64 * (j))
#define XB_XSUB(j)  (1280 + 64 * (j))
#define XB_XGEN(j)  (2304 + 64 * (j))
#define XB_TOP      3328
#define XB_TOPGEN   3392
#define XCD_BAR_WORDS 3456
#define XB_SPIN_CAP (1u << 22)
__device__ __forceinline__ unsigned xb_ld(unsigned* p)              { return __hip_atomic_load(p, __ATOMIC_RELAXED, __HIP_MEMORY_SCOPE_AGENT); }
__device__ __forceinline__ unsigned xb_add(unsigned* p, unsigned v) { return __hip_atomic_fetch_add(p, v, __ATOMIC_RELAXED, __HIP_MEMORY_SCOPE_AGENT); }
__device__ __forceinline__ unsigned xb_xcc_id() { return (unsigned)__builtin_amdgcn_s_getreg((3 << 11) | 20) & 0xFu; }
#define XB_SPIN(cond, bar) do { unsigned _sp = 0; while (cond) { __builtin_amdgcn_s_sleep(1); \
    if ((++_sp & 255u) == 0u) { if (xb_ld(&(bar)[XB_TMO])) break; if (_sp > XB_SPIN_CAP) { atomicAdd(&(bar)[XB_TMO], 1u); break; } } } } while (0)
struct XcdBarrier { unsigned* bar; unsigned x; volatile LAS unsigned* st; };
__device__ __forceinline__ XcdBarrier xcd_barrier_post(unsigned* bar, volatile LAS unsigned* st) {
    XcdBarrier b; b.bar = bar; b.x = xb_xcc_id(); b.st = st;
    if (threadIdx.x == 0) (void)xb_add(&bar[XB_XCNT(b.x)], 1u);
    return b;
}
__device__ __forceinline__ void xcd_barrier_complete(unsigned* bar, unsigned x, unsigned& nloc, unsigned& nx) {
    const unsigned G = gridDim.x * gridDim.y * gridDim.z;
    unsigned sum, cnt, mine, sp = 0u;
    for (;;) {
        sum = 0u; cnt = 0u; mine = 0u;
#pragma unroll
        for (unsigned j = 0; j < 16; ++j) { const unsigned c = xb_ld(&bar[XB_XCNT(j)]); sum += c; cnt += (c > 0u) ? 1u : 0u; mine = (j == x) ? c : mine; }
        if (sum == G) break;
        __builtin_amdgcn_s_sleep(1);
        if ((++sp & 255u) == 0u) { if (xb_ld(&bar[XB_TMO])) break; if (sp > XB_SPIN_CAP) { atomicAdd(&bar[XB_TMO], 1u); break; } }
    }
    nloc = mine > 0u ? mine : 1u; nx = cnt > 0u ? cnt : 1u;
}
__device__ __forceinline__ void xcd_barrier(const XcdBarrier& b) {
    asm volatile("s_waitcnt vmcnt(0)" ::: "memory");
    __syncthreads();
    if (threadIdx.x == 0) {
        unsigned* bar = b.bar;
        __builtin_amdgcn_s_waitcnt(0);
        unsigned nloc = b.st[0], nx = b.st[1];
        if (nloc == 0u) { xcd_barrier_complete(bar, b.x, nloc, nx); b.st[0] = nloc; b.st[1] = nx; }
        const unsigned old = xb_add(&bar[XB_XSUB(b.x)], 1u);
        const unsigned gen = old / nloc;
        if (old + 1u == (gen + 1u) * nloc) {
            __builtin_amdgcn_fence(__ATOMIC_RELEASE, "agent");
            asm volatile("s_waitcnt vmcnt(0)" ::: "memory");
            const unsigned og = xb_add(&bar[XB_TOP], 1u);
            const unsigned tg = og / nx;
            if (og + 1u == (tg + 1u) * nx) xb_add(&bar[XB_TOPGEN], 1u);
            else XB_SPIN(xb_ld(&bar[XB_TOPGEN]) == tg, bar);
            __builtin_amdgcn_fence(__ATOMIC_ACQUIRE, "agent");
            xb_add(&bar[XB_XGEN(b.x)], 1u);
            asm volatile("s_waitcnt vmcnt(0)" ::: "memory");
        } else {
            XB_SPIN(xb_ld(&bar[XB_XGEN(b.x)]) == gen, bar);
            __builtin_amdgcn_fence(__ATOMIC_ACQUIRE, "agent");
            asm volatile("s_waitcnt vmcnt(0)" ::: "memory");
        }
    }
    __syncthreads();
}

#ifndef PROBE_MASK
#define PROBE_MASK 0u
#endif
#ifndef PHMASK
#define PHMASK 0xFFFFFFFFu
#endif
#define EN(i) (((PHMASK) >> (i)) & 1u)
__global__ void __launch_bounds__(512, 2) fwd_megakernel(Params p) {
    extern __shared__ __attribute__((aligned(16))) unsigned char shm[];
    float* ldsf = (float*)shm;
    LAS unsigned char* ldsg = (LAS unsigned char*)shm;
    unsigned char* ws = p.ws;
    float* ssb = (float*)(ws + WS_SS);
    volatile LAS unsigned* xst = (volatile LAS unsigned*)(ldsg + 133120);
    if (threadIdx.x == 0) { xst[0] = 0u; xst[1] = 0u; }
    __syncthreads();
    const XcdBarrier xb = xcd_barrier_post((unsigned*)(ws + WS_CTL) + 256, xst);
#if PROBE_MASK
    unsigned long long tph = __builtin_amdgcn_s_memrealtime();
#endif
    for (int ph = p.ph_lo; ph < p.ph_hi; ++ph) {
        if (ph > p.ph_lo) {
            if (ph == 1) cg::this_grid().sync();
            else xcd_barrier(xb);
#if PROBE_MASK
            {
                const unsigned long long t1 = __builtin_amdgcn_s_memrealtime();
                if ((PROBE_MASK >> (ph - 1)) & 1u) { const unsigned long long dt = t1 - tph; while (__builtin_amdgcn_s_memrealtime() - t1 < dt) __builtin_amdgcn_s_sleep(8); }
                tph = __builtin_amdgcn_s_memrealtime();
            }
#endif
        }
        if (EN(0) && ph == 0) phase_prologue(p, ldsf);
        else if (EN(1) && (ph == 1 || ph == 5 || ph == 8 || ph == 14)) {
            pg8::Gemm g; pg8::EpiScaleBf16 E; int N;
            if (ph != 1) { finalize_sample_rows(p, ssb + (ph == 5 ? 1 : (ph == 8 ? 2 : 3)) * MT, ph == 8 ? 11 : 16); xcd_barrier(xb); }
            g.A = (const char*)(ws + WS_XB); g.lda = 2048; g.ldb = 2048;
            if (ph == 1) { g.Bt = (const char*)(ws + WS_WIN0); N = LD0; E.ss = ssb; }
            else if (ph == 5) { g.Bt = (const char*)(ws + WS_WUP0); N = LDU; E.ss = ssb + MT; }
            else if (ph == 8) { g.Bt = (const char*)(ws + WS_WIN1); N = LD1; E.ss = ssb + 2 * MT; }
            else { g.Bt = (const char*)(ws + WS_WUP1); N = LDU; E.ss = ssb + 3 * MT; }
            E.O = (bf16_t*)(ws + WS_PROJ); E.ldc = N;
            pg8::Order S; S.nMm = 32; S.nN = N / 256; S.n_main = 32 * S.nN; S.n_tail = 2 * S.nN; S.ksplit = 1; S.nt_full = 32; S.G = gridDim.x; S.c = blockIdx.x;
            S.a_t = (size_t)256 * 2048 * 2; S.b_t = (size_t)256 * 2048 * 2; S.acol = 0;
            pg8::gemm_phase<pg8::EpiScaleBf16>(ldsg, g, S, E);
        }
        else if (EN(4) && (ph == 4 || ph == 7 || ph == 13 || ph == 16)) {
            pg8::Gemm g; pg8::EpiResid E;
            g.A = (const char*)(ws + WS_ACT);
            if (ph == 4) { g.Bt = (const char*)(ws + WS_WOUT0); g.lda = 4096; E.ssout = ssb + MT; }
            else if (ph == 7) { g.Bt = (const char*)(ws + WS_WDN0); g.lda = DFF; E.ssout = ssb + 2 * MT; }
            else if (ph == 13) { g.Bt = (const char*)(ws + WS_WOUT1); g.lda = 4096; E.ssout = ssb + 3 * MT; }
            else { g.Bt = (const char*)(ws + WS_WDN1); g.lda = DFF; E.ssout = ssb + 4 * MT; }
            g.ldb = g.lda;
            E.X = (float*)(ws + WS_X); E.XB = (bf16_t*)(ws + WS_XB); E.part = (float*)(ws + WS_PROJ);
            pg8::Order S; S.nMm = 32; S.nN = 8; S.n_main = 256; S.nt_full = g.lda / 64; S.ksplit = (g.lda == 4096) ? 16 : 11; S.n_tail = 16 * S.ksplit; S.G = gridDim.x; S.c = blockIdx.x;
            S.a_t = (size_t)256 * g.lda * 2; S.b_t = (size_t)256 * g.ldb * 2; S.acol = 0;
            pg8::gemm_phase<pg8::EpiResid>(ldsg, g, S, E);
        }
        else if (EN(10) && ph == 10) {
            pg8::Gemm g; pg8::EpiLru E;
            g.A = (const char*)(ws + WS_XR); g.Bt = (const char*)(ws + WS_WLRU); g.lda = 2048; g.ldb = 256;
            E.br = p.in[26 + p.z]; E.bi = p.in[28 + p.z]; E.sp = (const float*)(ws + WS_SP); E.XR = (const bf16_t*)(ws + WS_XR);
            E.LA = (float*)(ws + WS_LA); E.LBv = (bf16_t*)(ws + WS_LBB);
            pg8::Order S; S.nMm = 34; S.nN = 16; S.n_main = 34 * 16; S.n_tail = 0; S.ksplit = 1; S.nt_full = 4 + p.z; S.G = gridDim.x; S.c = blockIdx.x;
            S.a_t = (size_t)256 * 2048 * 2; S.b_t = (size_t)256 * 256 * 2; S.acol = 512;
            pg8::gemm_phase<pg8::EpiLru>(ldsg, g, S, E);
        }
        else if (EN(2) && ph == 2) phase_rec0(p, ldsf);
        else if (EN(3) && ph == 3) phase_prep0(p);
        else if (EN(6) && ph == 6) phase_act(p, 0);
        else if (EN(9) && ph == 9) phase_lruconv(p);
        else if (EN(11) && ph == 11) phase_rec1(p, ldsf);
        else if (EN(12) && ph == 12) phase_prep1(p);
        else if (EN(15) && ph == 15) phase_act(p, 1);
        else if (EN(17) && ph == 17) phase_final(p);
    }
}

#ifndef N_LAUNCH_MODE
#define N_LAUNCH_MODE 0
#endif

extern "C" void kernel_launch(void* const* d_in, const int* in_sizes, int n_in, void* d_out, int out_size, void* d_ws, size_t ws_size, hipStream_t stream) {
    static int grid = 0;
    if (grid == 0) {
        if (n_in != 35 || (size_t)out_size != O_END || ws_size < WS_END) { fprintf(stderr, "kernel_launch: unexpected shapes: n_in %d out %d ws %zu (need %zu)\n", n_in, out_size, ws_size, (size_t)WS_END); grid = -1; return; }
        int dev = 0, cus = 0, per_cu = 0;
        hipGetDevice(&dev);
        hipDeviceGetAttribute(&cus, hipDeviceAttributeMultiprocessorCount, dev);
        if (hipFuncSetAttribute((const void*)fwd_megakernel, hipFuncAttributeMaxDynamicSharedMemorySize, LDS_BYTES) != hipSuccess) { fprintf(stderr, "kernel_launch: hipFuncSetAttribute failed\n"); grid = -1; return; }
        if (hipOccupancyMaxActiveBlocksPerMultiprocessor(&per_cu, (const void*)fwd_megakernel, 512, LDS_BYTES) != hipSuccess || per_cu < 1) { fprintf(stderr, "kernel_launch: occupancy query says %d\n", per_cu); per_cu = 1; }
        (void)hipGetLastError();
        grid = cus;
    }
    if (grid < 0) return;
    (void)hipMemsetAsync((char*)d_ws + WS_CTL, 0, 16384, stream);
    Params p{};
    for (int i = 0; i < 35; ++i) p.in[i] = (const float*)d_in[i];
    p.z = 0; p.pad = 0;
    p.out = (float*)d_out; p.ws = (unsigned char*)d_ws;
#if N_LAUNCH_MODE == 0
    p.ph_lo = 0; p.ph_hi = NPHASE;
    void* args[] = {&p};
    hipError_t e = hipLaunchCooperativeKernel((const void*)fwd_megakernel, dim3(grid), dim3(512), args, LDS_BYTES, stream);
    if (e != hipSuccess) fprintf(stderr, "cooperative launch failed: %s (grid %d)\n", hipGetErrorString(e), grid);
#else
    for (int ph = 0; ph < NPHASE; ++ph) {
        p.ph_lo = ph; p.ph_hi = ph + 1;
        hipLaunchKernelGGL(fwd_megakernel, dim3(grid), dim3(512), LDS_BYTES, stream, p);
    }
#endif
}
```

```cpp
#include <hip/hip_runtime.h>
#include <hip/hip_cooperative_groups.h>
#include <cstdio>
#include <cstdint>
namespace cg = cooperative_groups;

#define LAS __attribute__((address_space(3)))
typedef unsigned short bf16_t;
typedef short bf16x8 __attribute__((ext_vector_type(8)));
typedef float f32x4 __attribute__((ext_vector_type(4)));
typedef float f32x2 __attribute__((ext_vector_type(2)));
typedef unsigned u32x4 __attribute__((ext_vector_type(4)));
typedef unsigned u32x2 __attribute__((ext_vector_type(2)));

constexpr int D = 2048, MP = 8192, MS = 512, MT = 8704;
constexpr int LD0 = 11520, LD1 = 12288, LDU = 11264, DFF = 5632;
constexpr float EPS = 1e-6f;
constexpr size_t O_YP = 0;
constexpr size_t O_YS = O_YP + (size_t)4 * 2048 * 2048;
constexpr size_t O_SSMP = O_YS + (size_t)128 * 4 * 2048;
constexpr size_t O_SSMS = O_SSMP + (size_t)4 * 32 * 128 * 64;
constexpr size_t O_SCP = O_SSMS + (size_t)128 * 32 * 128 * 64;
constexpr size_t O_SCS = O_SCP + (size_t)4 * 3 * 3072;
constexpr size_t O_RETP = O_SCS + (size_t)128 * 3 * 3072;
constexpr size_t O_RETS = O_RETP + (size_t)4 * 8 * 128 * 256;
constexpr size_t O_HGP = O_RETS + (size_t)128 * 8 * 128 * 256;
constexpr size_t O_HGS = O_HGP + (size_t)4 * 16 * 128 * 128;
constexpr size_t O_LRUP = O_HGS + (size_t)128 * 16 * 128 * 128;
constexpr size_t O_LRUS = O_LRUP + (size_t)4 * 2048;
constexpr size_t O_LCP = O_LRUS + (size_t)128 * 2048;
constexpr size_t O_LCS = O_LCP + (size_t)4 * 3 * 2048;
constexpr size_t O_FCP = O_LCS + (size_t)128 * 3 * 2048;
constexpr size_t O_FCS = O_FCP + (size_t)2 * 4 * 2 * 5632;
constexpr size_t O_END = O_FCS + (size_t)2 * 128 * 2 * 5632;
constexpr size_t al256(size_t x) { return (x + 255) & ~(size_t)255; }
constexpr size_t WS_CTL = 0;
constexpr size_t WS_SS = 16384;
constexpr size_t WS_SP = al256(WS_SS + (size_t)5 * MT * 4);
constexpr size_t WS_LB = WS_SP + 8192;
constexpr size_t WS_WIN0 = WS_LB + 8192;
constexpr size_t WS_WOUT0 = WS_WIN0 + (size_t)LD0 * 2048 * 2;
constexpr size_t WS_WUP0 = WS_WOUT0 + (size_t)2048 * 4096 * 2;
constexpr size_t WS_WDN0 = WS_WUP0 + (size_t)LDU * 2048 * 2;
constexpr size_t WS_WIN1 = WS_WDN0 + (size_t)2048 * DFF * 2;
constexpr size_t WS_WOUT1 = WS_WIN1 + (size_t)LD1 * 2048 * 2;
constexpr size_t WS_WUP1 = WS_WOUT1 + (size_t)2048 * 4096 * 2;
constexpr size_t WS_WDN1 = WS_WUP1 + (size_t)LDU * 2048 * 2;
constexpr size_t WS_WLRU = WS_WDN1 + (size_t)2048 * DFF * 2;
constexpr size_t WS_X = WS_WLRU + (size_t)16 * 256 * 256 * 2;
constexpr size_t WS_XB = WS_X + (size_t)MT * 2048 * 4;
constexpr size_t WS_PROJ = WS_XB + (size_t)MT * 2048 * 2;
constexpr size_t WS_ACT = WS_PROJ + (size_t)MT * LD1 * 2;
constexpr size_t WS_YZ = WS_ACT + (size_t)MT * DFF * 2;
constexpr size_t WS_LA = WS_YZ + (size_t)MT * 4096 * 2;
constexpr size_t WS_LBB = WS_LA + (size_t)MT * 2048 * 4;
constexpr size_t WS_XR = WS_LBB + (size_t)MT * 2048 * 2;
constexpr size_t WS_END = WS_XR + (size_t)MT * 2048 * 2;

constexpr int LDS_BYTES = 133120 + 256;
constexpr int NPHASE = 18;

struct Params {
    const float* in[35];
    float* out;
    unsigned char* ws;
    int ph_lo, ph_hi;
    int z, pad;
};

__device__ __forceinline__ float bf2f(unsigned v) { return __uint_as_float(v << 16); }
__device__ __forceinline__ unsigned pk2(float lo, float hi) { unsigned r; asm volatile("v_cvt_pk_bf16_f32 %0, %1, %2" : "=v"(r) : "v"(lo), "v"(hi)); return r; }
__device__ __forceinline__ bf16_t f2bf(float x) { return (bf16_t)(pk2(x, 0.f) & 0xffffu); }
__device__ __forceinline__ float sigm(float x) { return __builtin_amdgcn_rcpf(1.f + __expf(-x)); }
__device__ __forceinline__ float silu(float x) { return x * __builtin_amdgcn_rcpf(1.f + __expf(-x)); }
__device__ __forceinline__ float softplus(float x) { return fmaxf(x, 0.f) + log1pf(__expf(-fabsf(x))); }
__device__ __forceinline__ float gelu_tanh(float x) { const float u = 0.7978845608f * (x + 0.044715f * x * x * x); const float t = 1.f - 2.f * __builtin_amdgcn_rcpf(1.f + __expf(2.f * u)); return 0.5f * x * (1.f + t); }
__device__ __forceinline__ float wave_sum(float v) {
#pragma unroll
    for (int o = 1; o < 64; o <<= 1) v += __shfl_xor(v, o);
    return v;
}
__device__ __forceinline__ void unpack8(u32x4 r, float* f) {
    f[0] = bf2f(r.x & 0xffffu); f[1] = __uint_as_float(r.x & 0xffff0000u); f[2] = bf2f(r.y & 0xffffu); f[3] = __uint_as_float(r.y & 0xffff0000u);
    f[4] = bf2f(r.z & 0xffffu); f[5] = __uint_as_float(r.z & 0xffff0000u); f[6] = bf2f(r.w & 0xffffu); f[7] = __uint_as_float(r.w & 0xffff0000u);
}
__device__ __forceinline__ void unpack4(u32x2 r, float* f) {
    f[0] = bf2f(r.x & 0xffffu); f[1] = __uint_as_float(r.x & 0xffff0000u); f[2] = bf2f(r.y & 0xffffu); f[3] = __uint_as_float(r.y & 0xffff0000u);
}
#define LDS_WAIT() asm volatile("s_waitcnt lgkmcnt(0)" ::: "memory")

namespace pg8 {
constexpr int BM = 256, BK = 64, HALF = 128, HTB = HALF * BK * 2, NXCD = 8, WGM = 8;
__device__ __forceinline__ int lds_byte(int r, int c) { const int st = (r >> 4) * 2 + (c >> 5), rr = r & 15, cc = c & 31, ob = rr * 64 + cc * 2; return st * 1024 + (ob ^ (((ob >> 9) & 1) << 5)); }
__device__ __forceinline__ void stage_rc(int b, int& R, int& C) { const int st = b / 1024, sb = b % 1024, swz = sb ^ (((sb >> 9) & 1) << 5); R = (st >> 1) * 16 + swz / 64; C = (st & 1) * 32 + (swz % 64) / 2; }
__device__ __forceinline__ int perm32(int rho) { const int n = rho >> 4, i = rho & 15; return 8 * (i >> 2) + 4 * n + (i & 3); }

struct Unit { int pm, pn, nt, kind, ks; size_t aoff, boff; };
struct Gemm { const char* A; const char* Bt; int lda, ldb; };
struct Order {
    int nMm, nN, n_main, n_tail, ksplit, nt_full, G, c; size_t a_t, b_t, acol;
    __device__ __forceinline__ bool next(int i, Unit& u) const {
        const long L = (long)i * G + c;
        if (L < n_main) {
            const int nwg = n_main;
            int wgid = (int)L; { const int q = nwg / NXCD, r = nwg % NXCD, xcd = wgid % NXCD, off = wgid / NXCD; wgid = (xcd < r ? xcd * (q + 1) : r * (q + 1) + (xcd - r) * q) + off; }
            const int nig = WGM * nN, gid = wgid / nig, fm = gid * WGM, gsz = (nMm - fm) < WGM ? (nMm - fm) : WGM;
            u.pm = fm + ((wgid % nig) % gsz); u.pn = (wgid % nig) / gsz; u.nt = nt_full; u.kind = 0; u.ks = 0;
            u.aoff = (size_t)u.pm * a_t + (size_t)(u.pn >> 1) * acol; u.boff = (size_t)u.pn * b_t; return true;
        }
        const int Lt = (int)(L - n_main); if (Lt >= n_tail) return false;
        const int ks = Lt % ksplit, r = Lt / ksplit;
        u.pm = nMm + (r & 1); u.pn = r >> 1; u.nt = nt_full / ksplit; u.kind = ksplit > 1 ? 1 : 0; u.ks = ks;
        const size_t kofs = (size_t)ks * u.nt * (BK * 2);
        u.aoff = (size_t)u.pm * a_t + (size_t)(u.pn >> 1) * acol + kofs; u.boff = (size_t)u.pn * b_t + kofs; return true;
    }
};

struct EpiScaleBf16 {
    static constexpr bool PERM = true;
    bf16_t* O; int ldc; const float* ss;
    __device__ __forceinline__ void operator()(const f32x4 (&acc)[2][2][4][2], const Unit& u, int wr, int wc, int fr, int fq) const {
        const int row0 = u.pm * BM + wr * 64 + fr, col0 = u.pn * BM + wc * 32 + 8 * fq;
#pragma unroll
        for (int ai = 0; ai < 2; ++ai)
#pragma unroll
            for (int m = 0; m < 4; ++m) {
                const int row = row0 + ai * HALF + m * 16;
                const float rs = rsqrtf(ss[row] * (1.0f / 2048.0f) + EPS);
                bf16_t* rowp = O + ((unsigned)row * (unsigned)ldc + (unsigned)col0);
#pragma unroll
                for (int bj = 0; bj < 2; ++bj) {
                    const f32x4 v0 = acc[ai][bj][m][0] * rs, v1 = acc[ai][bj][m][1] * rs;
                    u32x4 w; w.x = pk2(v0[0], v0[1]); w.y = pk2(v0[2], v0[3]); w.z = pk2(v1[0], v1[1]); w.w = pk2(v1[2], v1[3]);
                    *(u32x4*)(rowp + bj * HALF) = w;
                }
            }
    }
};
struct EpiResid {
    static constexpr bool PERM = false;
    float* X; bf16_t* XB; float* ssout; float* part;
    __device__ __forceinline__ void operator()(const f32x4 (&acc)[2][2][4][2], const Unit& u, int wr, int wc, int fr, int fq) const {
        const int row0 = u.pm * BM + wr * 64 + fr, col0 = u.pn * BM + wc * 32 + 4 * fq;
        if (u.kind == 1) {
            float* P = part + (size_t)u.ks * (512 * 2048);
#pragma unroll
            for (int ai = 0; ai < 2; ++ai)
#pragma unroll
                for (int m = 0; m < 4; ++m) {
                    const unsigned off = (unsigned)(row0 - MP + ai * HALF + m * 16) * 2048u + (unsigned)col0;
#pragma unroll
                    for (int bj = 0; bj < 2; ++bj)
#pragma unroll
                        for (int n = 0; n < 2; ++n) *(f32x4*)(P + off + bj * HALF + n * 16) = acc[ai][bj][m][n];
                }
            return;
        }
#pragma unroll
        for (int ai = 0; ai < 2; ++ai)
#pragma unroll
            for (int m = 0; m < 4; ++m) {
                const int row = row0 + ai * HALF + m * 16;
                const unsigned off = (unsigned)row * 2048u + (unsigned)col0;
                float sq = 0.f;
#pragma unroll
                for (int bj = 0; bj < 2; ++bj)
#pragma unroll
                    for (int n = 0; n < 2; ++n) {
                        const unsigned o = off + bj * HALF + n * 16;
                        f32x4 x = *(const f32x4*)(X + o) + acc[ai][bj][m][n];
                        *(f32x4*)(X + o) = x;
                        u32x2 w; w.x = pk2(x[0], x[1]); w.y = pk2(x[2], x[3]);
                        *(u32x2*)(XB + o) = w;
                        sq += (x[0] * x[0] + x[1] * x[1]) + (x[2] * x[2] + x[3] * x[3]);
                    }
                sq += __shfl_xor(sq, 16); sq += __shfl_xor(sq, 32);
                if (fq == 0) atomicAdd(ssout + row, sq);
                asm volatile("" ::: "memory");
            }
    }
};
struct EpiLru {
    static constexpr bool PERM = false;
    const float* br; const float* bi; const float* sp; const bf16_t* XR; float* LA; bf16_t* LBv;
    __device__ __forceinline__ void operator()(const f32x4 (&acc)[2][2][4][2], const Unit& u, int wr, int wc, int fr, int fq) const {
        const int row0 = u.pm * BM + wr * 64 + fr;
        const int cbase = (u.pn >> 1) * 256 + (u.pn & 1) * 128 + wc * 32 + 4 * fq;
#pragma unroll
        for (int ai = 0; ai < 2; ++ai)
#pragma unroll
            for (int m = 0; m < 4; ++m) {
                const int row = row0 + ai * HALF + m * 16;
                const bool first = (row < MP) && ((row & 2047) == 0);
#pragma unroll
                for (int n = 0; n < 2; ++n) {
                    const int c = cbase + n * 16;
                    const f32x4 br4 = *(const f32x4*)(br + c), bi4 = *(const f32x4*)(bi + c), sp4 = *(const f32x4*)(sp + c);
                    const unsigned o = (unsigned)row * 2048u + (unsigned)c;
                    float xr[4]; unpack4(*(const u32x2*)(XR + o), xr);
                    f32x4 av; float bb[4];
#pragma unroll
                    for (int j = 0; j < 4; ++j) {
                        const float r = sigm(acc[ai][0][m][n][j] + br4[j]), gi = sigm(acc[ai][1][m][n][j] + bi4[j]);
                        const float la = -8.0f * r * sp4[j];
                        const float a = __expf(la);
                        const float mult = first ? 1.0f : __builtin_amdgcn_sqrtf(fmaxf(1.0f - a * a, 0.f));
                        av[j] = a; bb[j] = mult * gi * xr[j];
                    }
                    *(f32x4*)(LA + o) = av;
                    u32x2 w; w.x = pk2(bb[0], bb[1]); w.y = pk2(bb[2], bb[3]);
                    *(u32x2*)(LBv + o) = w;
                    asm volatile("" ::: "memory");
                }
            }
    }
};

template <class Epi>
__device__ __forceinline__ void gemm_phase(LAS unsigned char* lds, const Gemm g, const Order& S, const Epi& E) {
    int tid = threadIdx.x; asm volatile("" : "+v"(tid));
    const int wid = __builtin_amdgcn_readfirstlane(tid >> 6), lane = tid & 63, wr = wid >> 2, wc = wid & 3, fr = lane & 15, fq = lane >> 4;
    unsigned voffA[2], voffB[2];
#pragma unroll
    for (int i = 0; i < 2; ++i) { int R, C; stage_rc(tid * 16 + i * 8192, R, C); const int Rb = Epi::PERM ? ((R & ~31) + perm32(R & 31)) : R;
        voffA[i] = (unsigned)(R * g.lda + C) * 2u; voffB[i] = (unsigned)(Rb * g.ldb + C) * 2u; }
    const size_t kstep = (size_t)(BK * 2);
    const size_t hstepA = (size_t)HALF * g.lda * 2, hstepB = (size_t)HALF * g.ldb * 2;
    const unsigned ldsw = (unsigned)wid * 1024u;
    const int aoff = lds_byte(wr * 64 + fr, fq * 8), boff = lds_byte(wc * 32 + fr, fq * 8);
#define PG8_SA(b, h) (((b) * 2 + (h)) * HTB)
#define PG8_SB(b, h) ((4 + (b) * 2 + (h)) * HTB)
#define PG8_STAGE(bufoff, gbase, voff) do { _Pragma("unroll") for (int _i = 0; _i < 2; ++_i) \
        __builtin_amdgcn_global_load_lds((const unsigned*)((const char*)(gbase) + (voff)[_i]), (LAS unsigned*)(lds + (bufoff) + ldsw + _i * 8192), 16, 0, 0); } while (0)
#define PG8_LDA(dst, b, h) do { _Pragma("unroll") for (int m = 0; m < 4; ++m) _Pragma("unroll") for (int k = 0; k < 2; ++k) dst[m][k] = *(const LAS bf16x8*)(lds + PG8_SA(b, h) + aoff + m * 2048 + k * 1024); } while (0)
#define PG8_LDB(dst, b, h) do { _Pragma("unroll") for (int n = 0; n < 2; ++n) _Pragma("unroll") for (int k = 0; k < 2; ++k) dst[n][k] = *(const LAS bf16x8*)(lds + PG8_SB(b, h) + boff + n * 2048 + k * 1024); } while (0)
#define PG8_MMA(ai, bj, At, Bt) do { __builtin_amdgcn_s_setprio(1); _Pragma("unroll") for (int m = 0; m < 4; ++m) _Pragma("unroll") for (int n = 0; n < 2; ++n) _Pragma("unroll") for (int k = 0; k < 2; ++k) \
        acc[ai][bj][m][n] = __builtin_amdgcn_mfma_f32_16x16x32_bf16(Bt[n][k], At[m][k], acc[ai][bj][m][n], 0, 0, 0); __builtin_amdgcn_s_setprio(0); } while (0)
#define PG8_WAIT_V(n) asm volatile("s_waitcnt vmcnt(" #n ")" ::: "memory")
#define PG8_WAIT_L(n) asm volatile("s_waitcnt lgkmcnt(" #n ")" ::: "memory")
#define PG8_BAR __builtin_amdgcn_s_barrier()
#define PG8_SCHED __builtin_amdgcn_sched_barrier(0)
    Unit cur, nxt; int ui = 0;
    if (!S.next(0, cur)) return;
    f32x4 acc[2][2][4][2];
#pragma unroll
    for (int a = 0; a < 2; ++a)
#pragma unroll
        for (int b = 0; b < 2; ++b)
#pragma unroll
            for (int m = 0; m < 4; ++m)
#pragma unroll
                for (int n = 0; n < 2; ++n) acc[a][b][m][n] = (f32x4){0.f, 0.f, 0.f, 0.f};
    bf16x8 At[4][2], B0[2][2], B1[2][2];
    const char* cA = g.A + cur.aoff; const char* cB = g.Bt + cur.boff;
    PG8_STAGE(PG8_SB(0, 0), cB, voffB); PG8_STAGE(PG8_SA(0, 0), cA, voffA); PG8_STAGE(PG8_SB(0, 1), cB + hstepB, voffB); PG8_STAGE(PG8_SA(0, 1), cA + hstepA, voffA);
    if (wr == 1) PG8_BAR;
    PG8_WAIT_V(4); PG8_BAR;
    PG8_STAGE(PG8_SB(1, 0), cB + kstep, voffB); PG8_STAGE(PG8_SA(1, 0), cA + kstep, voffA); PG8_STAGE(PG8_SB(1, 1), cB + hstepB + kstep, voffB);
    PG8_WAIT_V(6); PG8_BAR;
    for (;;) {
        const bool has_next = S.next(ui + 1, nxt);
        const char* nA = has_next ? g.A + nxt.aoff : cA; const char* nB = has_next ? g.Bt + nxt.boff : cB;
        const int nt = cur.nt;
        for (int t = 0; t < nt; t += 2) {
            const bool last = (t == nt - 2);
            const char* a1 = cA + (size_t)(t + 1) * kstep;
            const char* a2 = last ? nA : cA + (size_t)(t + 2) * kstep; const char* b2 = last ? nB : cB + (size_t)(t + 2) * kstep;
            const char* a3 = a2 + kstep; const char* b3 = b2 + kstep;
            PG8_LDB(B0, 0, 0); PG8_SCHED; PG8_LDA(At, 0, 0); PG8_STAGE(PG8_SA(1, 1), a1 + hstepA, voffA);
            PG8_WAIT_L(8); PG8_BAR; PG8_WAIT_L(0); PG8_MMA(0, 0, At, B0); PG8_BAR; PG8_SCHED;
            PG8_LDB(B1, 0, 1); PG8_STAGE(PG8_SB(0, 0), b2, voffB);
            PG8_BAR; PG8_WAIT_L(0); PG8_MMA(0, 1, At, B1); PG8_BAR;
            PG8_LDA(At, 0, 1); PG8_STAGE(PG8_SA(0, 0), a2, voffA);
            PG8_BAR; PG8_WAIT_L(0); PG8_MMA(1, 0, At, B0); PG8_BAR; PG8_SCHED;
            PG8_STAGE(PG8_SB(0, 1), b2 + hstepB, voffB);
            PG8_WAIT_V(6); PG8_BAR; PG8_MMA(1, 1, At, B1); PG8_BAR;
            PG8_LDB(B0, 1, 0); PG8_SCHED; PG8_LDA(At, 1, 0); PG8_STAGE(PG8_SA(0, 1), a2 + hstepA, voffA);
            PG8_WAIT_L(8); PG8_BAR; PG8_WAIT_L(0); PG8_MMA(0, 0, At, B0); PG8_BAR; PG8_SCHED;
            PG8_LDB(B1, 1, 1); PG8_STAGE(PG8_SB(1, 0), b3, voffB);
            PG8_BAR; PG8_WAIT_L(0); PG8_MMA(0, 1, At, B1); PG8_BAR;
            PG8_LDA(At, 1, 1); PG8_STAGE(PG8_SA(1, 0), a3, voffA);
            PG8_BAR; PG8_WAIT_L(0); PG8_MMA(1, 0, At, B0); PG8_BAR; PG8_SCHED;
            PG8_STAGE(PG8_SB(1, 1), b3 + hstepB, voffB);
            PG8_WAIT_V(6); PG8_BAR; PG8_MMA(1, 1, At, B1); PG8_BAR;
        }
        E(acc, cur, wr, wc, fr, fq);
        if (!has_next) break;
#pragma unroll
        for (int a = 0; a < 2; ++a)
#pragma unroll
            for (int b = 0; b < 2; ++b)
#pragma unroll
                for (int m = 0; m < 4; ++m)
#pragma unroll
                    for (int n = 0; n < 2; ++n) acc[a][b][m][n] = (f32x4){0.f, 0.f, 0.f, 0.f};
        cur = nxt; cA = nA; cB = nB; ++ui;
    }
    PG8_WAIT_V(0);
    if (wr == 0) PG8_BAR;
    PG8_BAR;
#undef PG8_SA
#undef PG8_SB
#undef PG8_STAGE
#undef PG8_LDA
#undef PG8_LDB
#undef PG8_MMA
#undef PG8_WAIT_V
#undef PG8_WAIT_L
#undef PG8_BAR
#undef PG8_SCHED
}
}

__device__ __forceinline__ void tr_item(const float* __restrict__ W, int ldw, int N, int k0, int n0, const float* __restrict__ scale, bf16_t* __restrict__ dst, int ldd, float* scr, int lane) {
    const int r4 = lane >> 4, c4 = (lane & 15) * 4;
    const bool inb = (n0 + c4) < N;
    f32x4 v[16];
#pragma unroll
    for (int i = 0; i < 16; ++i) v[i] = inb ? *(const f32x4*)(W + (size_t)(k0 + 4 * i + r4) * ldw + n0 + c4) : (f32x4){0.f, 0.f, 0.f, 0.f};
#pragma unroll
    for (int i = 0; i < 16; ++i) { float* d = scr + (4 * i + r4) * 65 + c4; d[0] = v[i][0]; d[1] = v[i][1]; d[2] = v[i][2]; d[3] = v[i][3]; }
    LDS_WAIT();
    const int c = lane & 7;
    f32x4 s0 = (f32x4){1.f, 1.f, 1.f, 1.f}, s1 = s0;
    if (scale) { s0 = *(const f32x4*)(scale + k0 + 8 * c); s1 = *(const f32x4*)(scale + k0 + 8 * c + 4); }
#pragma unroll
    for (int j = 0; j < 8; ++j) { const int n = (lane >> 3) + 8 * j; const float* sp = scr + (8 * c) * 65 + n;
        u32x4 o; o.x = pk2(sp[0 * 65] * s0[0], sp[1 * 65] * s0[1]); o.y = pk2(sp[2 * 65] * s0[2], sp[3 * 65] * s0[3]); o.z = pk2(sp[4 * 65] * s1[0], sp[5 * 65] * s1[1]); o.w = pk2(sp[6 * 65] * s1[2], sp[7 * 65] * s1[3]);
        *(u32x4*)(dst + (size_t)n * ldd + 8 * c) = o; }
    LDS_WAIT();
}

__device__ __forceinline__ void phase_prologue(const Params& p, float* ldsf) {
    int tid = threadIdx.x; asm volatile("" : "+v"(tid));
    const int wave = tid >> 6, lane = tid & 63;
    const int gw = blockIdx.x * 8 + wave, NGW = gridDim.x * 8;
    float* scr = ldsf + wave * 4160;
    unsigned char* ws = p.ws;
    constexpr int I0 = 32 * 177, I1 = 64 * 32, I2 = 32 * 176, I3 = 88 * 32, I4 = 32 * 192, I5 = I1, I6 = I2, I7 = I3, I8 = 128, I9 = 128;
    constexpr int NIT = I0 + I1 + I2 + I3 + I4 + I5 + I6 + I7 + I8 + I9;
    for (int it = gw; it < NIT; it += NGW) {
        int r = it;
        const float* W; int K, N; const float* sc = nullptr; bf16_t* WT;
        if (r < I0) { W = p.in[12 + p.z]; K = 2048; N = 11296; sc = p.in[9 + p.z]; WT = (bf16_t*)(ws + WS_WIN0); }
        else if ((r -= I0) < I1) { W = p.in[19 + p.z]; K = 4096; N = 2048; WT = (bf16_t*)(ws + WS_WOUT0); }
        else if ((r -= I1) < I2) { W = p.in[31 + p.z]; K = 2048; N = 11264; sc = p.in[10 + p.z]; WT = (bf16_t*)(ws + WS_WUP0); }
        else if ((r -= I2) < I3) { W = p.in[34 + p.z]; K = 5632; N = 2048; WT = (bf16_t*)(ws + WS_WDN0); }
        else if ((r -= I3) < I4) { W = p.in[20 + p.z]; K = 2048; N = 12288; sc = p.in[9 + p.z] + 2048; WT = (bf16_t*)(ws + WS_WIN1); }
        else if ((r -= I4) < I5) { W = p.in[30 + p.z]; K = 4096; N = 2048; WT = (bf16_t*)(ws + WS_WOUT1); }
        else if ((r -= I5) < I6) { W = p.in[31 + p.z] + (size_t)2048 * 11264; K = 2048; N = 11264; sc = p.in[10 + p.z] + 2048; WT = (bf16_t*)(ws + WS_WUP1); }
        else if ((r -= I6) < I7) { W = p.in[34 + p.z] + (size_t)5632 * 2048; K = 5632; N = 2048; WT = (bf16_t*)(ws + WS_WDN1); }
        else {
            r -= I7; const int which = r >> 7; r &= 127;
            const int blk = r >> 4, kb = (r >> 2) & 3, nb = r & 3, n0 = 64 * nb, k0 = 64 * kb;
            const float* Wl = (which ? p.in[27 + p.z] : p.in[25 + p.z]) + (size_t)blk * 65536;
            const int drow = (blk * 2 + (n0 >> 7)) * 256 + which * 128 + (n0 & 127);
            tr_item(Wl, 256, 256, k0, n0, nullptr, (bf16_t*)(ws + WS_WLRU) + (size_t)drow * 256 + k0, 256, scr, lane);
            continue;
        }
        const int nblk = (N + 63) / 64, kb = r / nblk, nb = r % nblk, k0 = 64 * kb, n0 = 64 * nb;
        tr_item(W, N, N, k0, n0, sc, WT + (size_t)n0 * K + k0, K, scr, lane);
    }
    {
        u32x4* z = (u32x4*)((bf16_t*)(ws + WS_WIN0) + (size_t)11296 * 2048);
        const int n16 = 224 * 2048 * 2 / 16;
        for (int i = blockIdx.x * 512 + tid; i < n16; i += gridDim.x * 512) z[i] = (u32x4){0u, 0u, 0u, 0u};
    }
    float* X = (float*)(ws + WS_X); bf16_t* XB = (bf16_t*)(ws + WS_XB); float* ss = (float*)(ws + WS_SS);
    for (int row = gw; row < MT; row += NGW) {
        const float* src = row < MP ? p.in[0 + p.z] + (size_t)row * 2048 : p.in[1 + p.z] + (size_t)(row - MP) * 2048;
        float s = 0.f;
#pragma unroll
        for (int j = 0; j < 8; ++j) {
            const f32x4 v = *(const f32x4*)(src + (lane + 64 * j) * 4);
            *(f32x4*)(X + (size_t)row * 2048 + (lane + 64 * j) * 4) = v;
            u32x2 w; w.x = pk2(v[0], v[1]); w.y = pk2(v[2], v[3]);
            *(u32x2*)(XB + (size_t)row * 2048 + (lane + 64 * j) * 4) = w;
            s += (v[0] * v[0] + v[1] * v[1]) + (v[2] * v[2] + v[3] * v[3]);
        }
        s = wave_sum(s);
        if (lane == 0) ss[row] = s;
    }
    for (int i = blockIdx.x * 512 + tid; i < 4 * MT; i += gridDim.x * 512) ss[MT + i] = 0.f;
    for (int i = blockIdx.x * 512 + tid; i < 2048; i += gridDim.x * 512) {
        ((float*)(ws + WS_SP))[i] = softplus(-p.in[29 + p.z][i]);
        ((float*)(ws + WS_LB))[i] = sigm(p.in[21 + p.z][2048 + i] - p.in[21 + p.z][i]);
    }
}

__device__ __forceinline__ int next_item(unsigned* ctr, float* ldsf) {
    __syncthreads();
    if (threadIdx.x == 0) ((volatile unsigned*)ldsf)[24576] = atomicAdd(ctr, 1u);
    __syncthreads();
    return (int)((volatile unsigned*)ldsf)[24576];
}

template <int TYPE, int VW>
__device__ __forceinline__ void rec_item(const Params& p, float* ldsf, int sample, int b, int h, int s) {
    constexpr int NV = VW / 16;
    typedef float VT __attribute__((ext_vector_type(NV)));
    int tid = threadIdx.x; asm volatile("" : "+v"(tid));
    const int w = tid >> 6, lane = tid & 63, kg = lane >> 4, vq = lane & 15, kb = 16 * w + 4 * kg;
    const int L = sample ? 4 : 2048, row0 = sample ? MP + 4 * b : 2048 * b, pos0 = sample ? 16384 : 0;
    constexpr int LDP = TYPE < 2 ? LD0 : LD1;
    const bf16_t* proj = (const bf16_t*)(p.ws + WS_PROJ) + (size_t)row0 * LDP;
    bf16_t* yz = (bf16_t*)(p.ws + WS_YZ) + (size_t)row0 * 4096;
    float* part = ldsf + 8192;
    int colA = -1, colB = -1, role = -1, didx = 0;
    float w0 = 0.f, w1 = 0.f, w2 = 0.f, w3 = 0.f, cbias = 0.f, c0 = 0.f, c1 = 0.f, c2 = 0.f, aux = 0.f, aux2 = 0.f;
    if constexpr (TYPE == 0) {
        if (tid < 320) {
            role = tid < 128 ? 0 : (tid < 256 ? 1 : 2);
            didx = tid < 128 ? tid : (tid < 256 ? tid - 128 : tid - 256);
            const int ch = tid < 128 ? 2560 + (h >> 3) * 128 + tid : (tid < 256 ? 2048 + (h >> 3) * 128 + (tid - 128) : h * 64 + (tid - 256));
            colA = 2048 + ch;
            const float* cw = p.in[13 + p.z];
            w0 = cw[ch]; w1 = cw[3072 + ch]; w2 = cw[2 * 3072 + ch]; w3 = cw[3 * 3072 + ch]; cbias = p.in[14 + p.z][ch];
            if (sample) { const float* st = p.in[3 + p.z] + (size_t)b * 3 * 3072; c0 = st[ch]; c1 = st[3072 + ch]; c2 = st[2 * 3072 + ch]; }
        } else if (tid < 328) { role = 3; didx = tid - 320; colA = 5120 + h; aux = p.in[15 + p.z][h]; aux2 = -__expf(p.in[16 + p.z][h]); }
    } else if constexpr (TYPE == 1) {
        if (tid < 128) { role = tid < 64 ? 0 : 1; didx = tid & 63; colA = (tid < 64 ? 5152 : 6176) + h * 128 + didx; colB = colA + 64;
            aux = exp2f(-(float)didx * 0.20762050593046014f); }
        else if (tid < 128 + VW) { role = 2; didx = tid - 128; colA = 7200 + h * 256 + s * VW + didx; }
    } else {
        if (tid < 128) { role = 0; didx = tid; colA = h * 128 + tid; }
        else if (tid < 256) { role = 1; didx = tid - 128; colA = 2048 + h * 128 + didx; aux = ((const float*)(p.ws + WS_LB))[h * 128 + didx]; }
        else if (tid < 256 + VW) { role = 2; didx = tid - 256; colA = 4096 + h * 128 + s * VW + didx; }
    }
    const float Dh = TYPE == 0 ? p.in[17 + p.z][h] : 0.f;
    const float gamma = TYPE == 1 ? 1.0f - exp2f(-5.0f - (float)h * (4.0f / 7.0f)) : 0.f;
    const int ldS = TYPE == 0 ? 64 : (TYPE == 1 ? 256 : 128);
    size_t soff;
    if constexpr (TYPE == 0) soff = ((size_t)(b * 32 + h) * 128) * 64;
    else if constexpr (TYPE == 1) soff = ((size_t)(b * 8 + h) * 128) * 256 + s * VW;
    else soff = ((size_t)(b * 16 + h) * 128) * 128 + s * VW;
    const float* S0 = TYPE == 0 ? p.in[2 + p.z] : (TYPE == 1 ? p.in[4 + p.z] : p.in[5 + p.z]);
    float* Sout = p.out + (TYPE == 0 ? (sample ? O_SSMS : O_SSMP) : (TYPE == 1 ? (sample ? O_RETS : O_RETP) : (sample ? O_HGS : O_HGP))) + soff;
    VT S[4];
#pragma unroll
    for (int i = 0; i < 4; ++i) { if (sample) S[i] = *(const VT*)(S0 + soff + (size_t)(kb + i) * ldS + NV * vq); else S[i] = (VT)(0.f); }
    unsigned short ra[8], rb[8]; unsigned short zr = 0;
    const int R = (L + 7) >> 3;
    auto load_raw = [&](int r) {
#pragma unroll
        for (int t = 0; t < 8; ++t) {
            const int tt = 8 * r + t;
            ra[t] = 0; rb[t] = 0;
            if (tt < L) {
                if (colA >= 0) ra[t] = proj[(size_t)tt * LDP + colA];
                if (TYPE == 1 && colB >= 0) rb[t] = proj[(size_t)tt * LDP + colB];
            }
        }
        if (TYPE == 0) { const int tt = 8 * r + w; if (tt < L) zr = proj[(size_t)tt * LDP + h * 64 + lane]; }
    };
    load_raw(0);
    for (int r = 0; r < R; ++r) {
        const int nv = (L - 8 * r) < 8 ? (L - 8 * r) : 8;
        float* stg = ldsf + (r & 1) * 4096;
        float* qs = stg; float* ks = stg + 1024; float* as = stg + 2048; float* vs = stg + 3072; float* ad = stg + 3584;
        if constexpr (TYPE == 0) {
            if (role >= 0 && role < 3) {
                float* dst = role == 0 ? qs : (role == 1 ? ks : vs); const int dstr = role == 2 ? 64 : 128;
#pragma unroll
                for (int t = 0; t < 8; ++t) {
                    const float x = bf2f(ra[t]);
                    const float y = cbias + w0 * c0 + w1 * c1 + w2 * c2 + w3 * x;
                    c0 = c1; c1 = c2; c2 = x;
                    dst[t * dstr + didx] = silu(y);
                }
            } else if (role == 3) {
                float xv = 0.f;
#pragma unroll
                for (int t = 0; t < 8; ++t) if (t == didx) xv = bf2f(ra[t]);
                const float dt = softplus(xv + aux);
                ad[2 * didx] = __expf(dt * aux2); ad[2 * didx + 1] = dt;
            }
        } else if constexpr (TYPE == 1) {
            if (role == 0 || role == 1) {
                float* dst = role == 0 ? qs : ks; const float sc = role == 0 ? 1.0f : 0.08838834764831845f;
#pragma unroll
                for (int t = 0; t < 8; ++t) {
                    const int pos = pos0 + 8 * r + t;
                    const double rev = (double)pos * (double)aux * 0.15915494309189535;
                    const float fr = (float)(rev - floor(rev));
                    const float sn = __builtin_amdgcn_sinf(fr), cs = __builtin_amdgcn_cosf(fr);
                    const float x1 = bf2f(ra[t]) * sc, x2 = bf2f(rb[t]) * sc;
                    dst[t * 128 + didx] = x1 * cs - x2 * sn;
                    dst[t * 128 + 64 + didx] = x1 * sn + x2 * cs;
                }
            } else if (role == 2) {
#pragma unroll
                for (int t = 0; t < 8; ++t) vs[t * VW + didx] = bf2f(ra[t]);
            }
        } else {
            if (role == 0) {
#pragma unroll
                for (int t = 0; t < 8; ++t) qs[t * 128 + didx] = silu(bf2f(ra[t]));
            } else if (role == 1) {
#pragma unroll
                for (int t = 0; t < 8; ++t) { const float f = aux + (1.0f - aux) * sigm(bf2f(ra[t])); as[t * 128 + didx] = f; ks[t * 128 + didx] = 1.0f - f; }
            } else if (role == 2) {
#pragma unroll
                for (int t = 0; t < 8; ++t) vs[t * VW + didx] = bf2f(ra[t]);
            }
        }
        const unsigned short zc = zr;
        __syncthreads();
        if (r + 1 < R) load_raw(r + 1);
        for (int t0 = 0; t0 < nv; t0 += 4) {
#pragma unroll
            for (int tt = 0; tt < 4; ++tt) {
                const int t = t0 + tt;
                const f32x4 q4 = *(const f32x4*)(qs + t * 128 + kb);
                f32x4 k4 = *(const f32x4*)(ks + t * 128 + kb);
                const VT v4 = *(const VT*)(vs + t * VW + NV * vq);
                f32x4 a4;
                if constexpr (TYPE == 0) { const f32x2 adv = *(const f32x2*)(ad + 2 * t); a4 = (f32x4){adv.x, adv.x, adv.x, adv.x}; k4 = k4 * adv.y; }
                else if constexpr (TYPE == 1) a4 = (f32x4){gamma, gamma, gamma, gamma};
                else a4 = *(const f32x4*)(as + t * 128 + kb);
                VT o = (VT)(0.f);
#pragma unroll
                for (int i = 0; i < 4; ++i) { S[i] = a4[i] * S[i] + k4[i] * v4; o += q4[i] * S[i]; }
                *(VT*)(part + ((t * 32 + w * 4 + kg) * VW + NV * vq)) = o;
            }
        }
        __syncthreads();
        const int rt = tid / VW, rv = tid % VW;
        if (tid < 8 * VW && rt < nv) {
            float o = 0.f;
#pragma unroll
            for (int pp = 0; pp < 32; ++pp) o += part[(rt * 32 + pp) * VW + rv];
            const size_t trow = (size_t)(8 * r + rt);
            if constexpr (TYPE == 0) {
                const float y = (o + Dh * vs[rt * 64 + rv]) * silu(bf2f(zc));
                yz[trow * 4096 + h * 64 + rv] = f2bf(y);
            } else if constexpr (TYPE == 1) {
                yz[trow * 4096 + 2048 + h * 256 + s * VW + rv] = f2bf(o);
            } else {
                yz[trow * 4096 + h * 128 + s * VW + rv] = f2bf(o);
            }
        }
    }
#pragma unroll
    for (int i = 0; i < 4; ++i) *(VT*)(Sout + (size_t)(kb + i) * ldS + NV * vq) = S[i];
}

template <int TYPE>
__device__ __forceinline__ void dec_unit(const Params& p, float* ldsf, int b, int u) {
    int tid = threadIdx.x; asm volatile("" : "+v"(tid));
    const int w = tid >> 6, lane = tid & 63, kg = lane >> 4, vq = lane & 15;
    const int row0 = MP + 4 * b;
    constexpr int LDP = TYPE < 2 ? LD0 : LD1;
    const bf16_t* proj = (const bf16_t*)(p.ws + WS_PROJ) + (size_t)row0 * LDP;
    bf16_t* yz = (bf16_t*)(p.ws + WS_YZ) + (size_t)row0 * 4096;
    int h, sl; size_t soff; int ldS;
    if constexpr (TYPE == 0) { h = 8 * u + w; sl = 0; ldS = 64; soff = ((size_t)(b * 32 + h) * 128) * 64; }
    else if constexpr (TYPE == 1) { h = 2 * u + (w >> 2); sl = w & 3; ldS = 256; soff = ((size_t)(b * 8 + h) * 128) * 256 + sl * 64; }
    else { h = 4 * u + (w >> 1); sl = w & 1; ldS = 128; soff = ((size_t)(b * 16 + h) * 128) * 128 + sl * 64; }
    const float* S0 = (TYPE == 0 ? p.in[2 + p.z] : (TYPE == 1 ? p.in[4 + p.z] : p.in[5 + p.z])) + soff + (size_t)(32 * kg) * ldS + 4 * vq;
    float* Sout = p.out + (TYPE == 0 ? O_SSMS : (TYPE == 1 ? O_RETS : O_HGS)) + soff + (size_t)(32 * kg) * ldS + 4 * vq;
    if constexpr (TYPE == 0) {
        float* qs = ldsf; float* ks = ldsf + 512; float* xs = ldsf + 1024; float* zs = ldsf + 3072; float* ad = ldsf + 5120;
        unsigned short xr[2][4]; float cw[2][4], cb[2], st[2][3]; unsigned short zr[4]; unsigned short dr = 0;
#pragma unroll
        for (int q = 0; q < 2; ++q) {
            const int idx = tid + 512 * q;
            if (idx < 768) {
                const int ch = idx < 128 ? 2560 + u * 128 + idx : (idx < 256 ? 2048 + u * 128 + (idx - 128) : u * 512 + (idx - 256));
#pragma unroll
                for (int t = 0; t < 4; ++t) xr[q][t] = proj[(size_t)t * LDP + 2048 + ch];
#pragma unroll
                for (int j = 0; j < 4; ++j) cw[q][j] = p.in[13 + p.z][j * 3072 + ch];
                cb[q] = p.in[14 + p.z][ch];
#pragma unroll
                for (int j = 0; j < 3; ++j) st[q][j] = p.in[3 + p.z][((size_t)b * 3 + j) * 3072 + ch];
            }
        }
#pragma unroll
        for (int t = 0; t < 4; ++t) zr[t] = proj[(size_t)t * LDP + u * 512 + tid];
        if (tid < 32) dr = proj[(size_t)(tid >> 3) * LDP + 5120 + 8 * u + (tid & 7)];
        f32x4 S[32];
#pragma unroll
        for (int i = 0; i < 32; ++i) S[i] = *(const f32x4*)(S0 + (size_t)i * ldS);
#pragma unroll
        for (int q = 0; q < 2; ++q) {
            const int idx = tid + 512 * q;
            if (idx < 768) {
                float* dst = idx < 128 ? qs + idx : (idx < 256 ? ks + (idx - 128) : xs + (idx - 256));
                const int dstr = idx < 256 ? 128 : 512;
                float c0 = st[q][0], c1 = st[q][1], c2 = st[q][2];
#pragma unroll
                for (int t = 0; t < 4; ++t) {
                    const float x = bf2f(xr[q][t]);
                    const float y = cb[q] + cw[q][0] * c0 + cw[q][1] * c1 + cw[q][2] * c2 + cw[q][3] * x;
                    c0 = c1; c1 = c2; c2 = x;
                    dst[t * dstr] = silu(y);
                }
            }
        }
#pragma unroll
        for (int t = 0; t < 4; ++t) zs[t * 512 + tid] = silu(bf2f(zr[t]));
        if (tid < 32) {
            const int hh = 8 * u + (tid & 7);
            const float dt = softplus(bf2f(dr) + p.in[15 + p.z][hh]);
            ad[2 * tid] = __expf(-dt * __expf(p.in[16 + p.z][hh])); ad[2 * tid + 1] = dt;
        }
        __syncthreads();
        const float Dh = p.in[17 + p.z][h];
#pragma unroll 1
        for (int t = 0; t < 4; ++t) {
            const f32x2 adv = *(const f32x2*)(ad + 2 * (t * 8 + w));
            const f32x4 v4 = *(const f32x4*)(xs + t * 512 + w * 64 + 4 * vq);
            f32x4 o = (f32x4){0.f, 0.f, 0.f, 0.f};
#pragma unroll
            for (int i4 = 0; i4 < 8; ++i4) {
                const f32x4 q4 = *(const f32x4*)(qs + t * 128 + 32 * kg + 4 * i4);
                const f32x4 k4 = *(const f32x4*)(ks + t * 128 + 32 * kg + 4 * i4) * adv.y;
#pragma unroll
                for (int ii = 0; ii < 4; ++ii) { S[4 * i4 + ii] = adv.x * S[4 * i4 + ii] + k4[ii] * v4; o += q4[ii] * S[4 * i4 + ii]; }
            }
#pragma unroll
            for (int j = 0; j < 4; ++j) { o[j] += __shfl_xor(o[j], 16); o[j] += __shfl_xor(o[j], 32); }
            if (kg == 0) {
                const f32x4 z4 = *(const f32x4*)(zs + t * 512 + w * 64 + 4 * vq);
                const f32x4 y = (o + Dh * v4) * z4;
                u32x2 ov; ov.x = pk2(y[0], y[1]); ov.y = pk2(y[2], y[3]);
                *(u32x2*)(yz + (size_t)t * 4096 + h * 64 + 4 * vq) = ov;
            }
        }
#pragma unroll
        for (int i = 0; i < 32; ++i) *(f32x4*)(Sout + (size_t)i * ldS) = S[i];
    } else if constexpr (TYPE == 1) {
        float* qs = ldsf; float* ks = ldsf + 1024; float* vs = ldsf + 2048;
        unsigned short x1[4], x2[4], vr[4];
        const int hl = tid >> 7, isk = (tid >> 6) & 1, jf = tid & 63;
        if (tid < 256) {
            const int col = (isk ? 6176 : 5152) + (2 * u + hl) * 128 + jf;
#pragma unroll
            for (int t = 0; t < 4; ++t) { x1[t] = proj[(size_t)t * LDP + col]; x2[t] = proj[(size_t)t * LDP + col + 64]; }
        }
#pragma unroll
        for (int t = 0; t < 4; ++t) vr[t] = proj[(size_t)t * LDP + 7200 + (2 * u + (tid >> 8)) * 256 + (tid & 255)];
        f32x4 S[32];
#pragma unroll
        for (int i = 0; i < 32; ++i) S[i] = *(const f32x4*)(S0 + (size_t)i * ldS);
        if (tid < 256) {
            const float inv = exp2f(-(float)jf * 0.20762050593046014f);
            float* dst = isk ? ks : qs; const float sc = isk ? 0.08838834764831845f : 1.0f;
#pragma unroll
            for (int t = 0; t < 4; ++t) {
                const double rev = (double)(16384 + t) * (double)inv * 0.15915494309189535;
                const float fr = (float)(rev - floor(rev));
                const float sn = __builtin_amdgcn_sinf(fr), cs = __builtin_amdgcn_cosf(fr);
                const float a1 = bf2f(x1[t]) * sc, a2 = bf2f(x2[t]) * sc;
                dst[(t * 2 + hl) * 128 + jf] = a1 * cs - a2 * sn;
                dst[(t * 2 + hl) * 128 + 64 + jf] = a1 * sn + a2 * cs;
            }
        }
#pragma unroll
        for (int t = 0; t < 4; ++t) vs[(t * 2 + (tid >> 8)) * 256 + (tid & 255)] = bf2f(vr[t]);
        __syncthreads();
        const float gamma = 1.0f - exp2f(-5.0f - (float)h * (4.0f / 7.0f));
        const int hw = w >> 2;
#pragma unroll 1
        for (int t = 0; t < 4; ++t) {
            const f32x4 v4 = *(const f32x4*)(vs + (t * 2 + hw) * 256 + sl * 64 + 4 * vq);
            f32x4 o = (f32x4){0.f, 0.f, 0.f, 0.f};
#pragma unroll
            for (int i4 = 0; i4 < 8; ++i4) {
                const f32x4 q4 = *(const f32x4*)(qs + (t * 2 + hw) * 128 + 32 * kg + 4 * i4);
                const f32x4 k4 = *(const f32x4*)(ks + (t * 2 + hw) * 128 + 32 * kg + 4 * i4);
#pragma unroll
                for (int ii = 0; ii < 4; ++ii) { S[4 * i4 + ii] = gamma * S[4 * i4 + ii] + k4[ii] * v4; o += q4[ii] * S[4 * i4 + ii]; }
            }
#pragma unroll
            for (int j = 0; j < 4; ++j) { o[j] += __shfl_xor(o[j], 16); o[j] += __shfl_xor(o[j], 32); }
            if (kg == 0) {
                u32x2 ov; ov.x = pk2(o[0], o[1]); ov.y = pk2(o[2], o[3]);
                *(u32x2*)(yz + (size_t)t * 4096 + 2048 + h * 256 + sl * 64 + 4 * vq) = ov;
            }
        }
#pragma unroll
        for (int i = 0; i < 32; ++i) *(f32x4*)(Sout + (size_t)i * ldS) = S[i];
    } else {
        float* qs = ldsf; float* ks = ldsf + 2048; float* as = ldsf + 4096; float* vs = ldsf + 6144;
        unsigned short qr[4], fr_[4], vr[4];
        const int hl = tid >> 7, kk = tid & 127, col = (4 * u + hl) * 128 + kk;
#pragma unroll
        for (int t = 0; t < 4; ++t) { qr[t] = proj[(size_t)t * LDP + col]; fr_[t] = proj[(size_t)t * LDP + 2048 + col]; vr[t] = proj[(size_t)t * LDP + 4096 + col]; }
        const float lb = ((const float*)(p.ws + WS_LB))[col];
        f32x4 S[32];
#pragma unroll
        for (int i = 0; i < 32; ++i) S[i] = *(const f32x4*)(S0 + (size_t)i * ldS);
#pragma unroll
        for (int t = 0; t < 4; ++t) {
            const int o = (t * 4 + hl) * 128 + kk;
            qs[o] = silu(bf2f(qr[t]));
            const float f = lb + (1.0f - lb) * sigm(bf2f(fr_[t]));
            as[o] = f; ks[o] = 1.0f - f; vs[o] = bf2f(vr[t]);
        }
        __syncthreads();
        const int hw = w >> 1;
#pragma unroll 1
        for (int t = 0; t < 4; ++t) {
            const f32x4 v4 = *(const f32x4*)(vs + (t * 4 + hw) * 128 + sl * 64 + 4 * vq);
            f32x4 o = (f32x4){0.f, 0.f, 0.f, 0.f};
#pragma unroll
            for (int i4 = 0; i4 < 8; ++i4) {
                const int off = (t * 4 + hw) * 128 + 32 * kg + 4 * i4;
                const f32x4 q4 = *(const f32x4*)(qs + off), k4 = *(const f32x4*)(ks + off), a4 = *(const f32x4*)(as + off);
#pragma unroll
                for (int ii = 0; ii < 4; ++ii) { S[4 * i4 + ii] = a4[ii] * S[4 * i4 + ii] + k4[ii] * v4; o += q4[ii] * S[4 * i4 + ii]; }
            }
#pragma unroll
            for (int j = 0; j < 4; ++j) { o[j] += __shfl_xor(o[j], 16); o[j] += __shfl_xor(o[j], 32); }
            if (kg == 0) {
                u32x2 ov; ov.x = pk2(o[0], o[1]); ov.y = pk2(o[2], o[3]);
                *(u32x2*)(yz + (size_t)t * 4096 + h * 128 + sl * 64 + 4 * vq) = ov;
            }
        }
#pragma unroll
        for (int i = 0; i < 32; ++i) *(f32x4*)(Sout + (size_t)i * ldS) = S[i];
    }
}

__device__ __forceinline__ void lru_dec_unit(const Params& p, int b) {
    int tid = threadIdx.x; asm volatile("" : "+v"(tid));
    const int c = tid * 4;
    const int row0 = MP + 4 * b;
    const float* LA = (const float*)(p.ws + WS_LA) + (size_t)row0 * 2048 + c;
    const bf16_t* LBv = (const bf16_t*)(p.ws + WS_LBB) + (size_t)row0 * 2048 + c;
    const bf16_t* rg = (const bf16_t*)(p.ws + WS_PROJ) + (size_t)row0 * LD1 + 10240 + c;
    bf16_t* mixa = (bf16_t*)(p.ws + WS_ACT) + (size_t)row0 * 4096 + 2048 + c;
    f32x4 hst = *(const f32x4*)(p.in[6 + p.z] + (size_t)b * 2048 + c);
#pragma unroll
    for (int t = 0; t < 4; ++t) {
        const f32x4 a = *(const f32x4*)(LA + (size_t)t * 2048);
        float bb[4], gg[4]; unpack4(*(const u32x2*)(LBv + (size_t)t * 2048), bb); unpack4(*(const u32x2*)(rg + (size_t)t * LD1), gg);
        float y[4];
#pragma unroll
        for (int j = 0; j < 4; ++j) { hst[j] = a[j] * hst[j] + bb[j]; y[j] = hst[j] * gelu_tanh(gg[j]); }
        u32x2 ov; ov.x = pk2(y[0], y[1]); ov.y = pk2(y[2], y[3]);
        *(u32x2*)(mixa + (size_t)t * 4096) = ov;
    }
    *(f32x4*)(p.out + O_LRUS + (size_t)b * 2048 + c) = hst;
}

__device__ __forceinline__ void lru_scan_item(const Params& p, float* ldsf, int b, int cg) {
    int tid = threadIdx.x; asm volatile("" : "+v"(tid));
    const int w = tid >> 6, lane = tid & 63, c = cg * 64 + lane;
    const size_t row0 = (size_t)2048 * b + 256 * w;
    const float* LA = (const float*)(p.ws + WS_LA) + row0 * 2048 + c;
    const bf16_t* LBv = (const bf16_t*)(p.ws + WS_LBB) + row0 * 2048 + c;
    const bf16_t* rg = (const bf16_t*)(p.ws + WS_PROJ) + row0 * LD1 + 10240 + c;
    bf16_t* mixa = (bf16_t*)(p.ws + WS_ACT) + row0 * 4096 + 2048 + c;
    float hl = 0.f, pr = 1.f;
    for (int tb = 0; tb < 256; tb += 16) {
        float a0[16]; unsigned short b0[16];
#pragma unroll
        for (int t = 0; t < 16; ++t) { a0[t] = LA[(size_t)(tb + t) * 2048]; b0[t] = LBv[(size_t)(tb + t) * 2048]; }
#pragma unroll
        for (int t = 0; t < 16; ++t) { hl = a0[t] * hl + bf2f(b0[t]); pr *= a0[t]; }
    }
    ldsf[w * 128 + lane] = pr; ldsf[w * 128 + 64 + lane] = hl;
    __syncthreads();
    float hst = 0.f;
    for (int ww = 0; ww < w; ++ww) hst = ldsf[ww * 128 + lane] * hst + ldsf[ww * 128 + 64 + lane];
    for (int tb = 0; tb < 256; tb += 16) {
        float a0[16]; unsigned short b0[16], g0[16];
#pragma unroll
        for (int t = 0; t < 16; ++t) { a0[t] = LA[(size_t)(tb + t) * 2048]; b0[t] = LBv[(size_t)(tb + t) * 2048]; g0[t] = rg[(size_t)(tb + t) * LD1]; }
#pragma unroll
        for (int t = 0; t < 16; ++t) {
            hst = a0[t] * hst + bf2f(b0[t]);
            mixa[(size_t)(tb + t) * 4096] = f2bf(hst * gelu_tanh(bf2f(g0[t])));
        }
    }
    if (w == 7) p.out[O_LRUP + (size_t)b * 2048 + c] = hst;
}

__device__ __forceinline__ void phase_rec0(const Params& p, float* ldsf) {
    unsigned* ctr = (unsigned*)(p.ws + WS_CTL);
    const int total = 256 + 512 + 512;
    for (;;) {
        const int it = next_item(ctr, ldsf);
        if (it >= total) break;
        if (it < 128) rec_item<0, 64>(p, ldsf, 0, it >> 5, it & 31, 0);
        else if (it < 256) { const int j = it - 128; rec_item<1, 64>(p, ldsf, 0, j >> 5, (j & 31) >> 2, j & 3); }
        else if (it < 768) { const int j = it - 256; dec_unit<0>(p, ldsf, j >> 2, j & 3); }
        else { const int j = it - 768; dec_unit<1>(p, ldsf, j >> 2, j & 3); }
    }
}
__device__ __forceinline__ void phase_rec1(const Params& p, float* ldsf) {
    unsigned* ctr = (unsigned*)(p.ws + WS_CTL) + 64;
    const int total = 128 + 128 + 512 + 128;
    for (;;) {
        const int it = next_item(ctr, ldsf);
        if (it >= total) break;
        if (it < 128) rec_item<2, 64>(p, ldsf, 0, it >> 5, (it & 31) >> 1, it & 1);
        else if (it < 256) { const int j = it - 128; lru_scan_item(p, ldsf, j >> 5, j & 31); }
        else if (it < 768) { const int j = it - 256; dec_unit<2>(p, ldsf, j >> 2, j & 3); }
        else lru_dec_unit(p, it - 768);
    }
}

__device__ __forceinline__ void seq_of_row(int row, int& sample, int& b, int& t, int& L) {
    if (row < MP) { sample = 0; b = row >> 11; t = row & 2047; L = 2048; } else { sample = 1; b = (row - MP) >> 2; t = (row - MP) & 3; L = 4; }
}

__device__ __forceinline__ void phase_prep0(const Params& p) {
    int tid = threadIdx.x; asm volatile("" : "+v"(tid));
    const int wave = tid >> 6, lane = tid & 63;
    const int gw = blockIdx.x * 8 + wave, NGW = gridDim.x * 8;
    const bf16_t* YZ = (const bf16_t*)(p.ws + WS_YZ); const bf16_t* PR = (const bf16_t*)(p.ws + WS_PROJ);
    bf16_t* MX = (bf16_t*)(p.ws + WS_ACT);
    const float* nw = p.in[18 + p.z];
    for (int row = gw; row < MT; row += NGW) {
        const bf16_t* yz = YZ + (size_t)row * 4096; bf16_t* mx = MX + (size_t)row * 4096;
#pragma unroll 1
        for (int g = 0; g < 4; ++g) {
            const int c = g * 512 + lane * 8;
            float v[8]; unpack8(*(const u32x4*)(yz + c), v);
            float s = 0.f;
#pragma unroll
            for (int j = 0; j < 8; ++j) s += v[j] * v[j];
            s = wave_sum(s);
            const float rs = rsqrtf(s * (1.0f / 512.0f) + EPS);
            const f32x4 n0 = *(const f32x4*)(nw + c), n1 = *(const f32x4*)(nw + c + 4);
            u32x4 o; o.x = pk2(v[0] * rs * n0[0], v[1] * rs * n0[1]); o.y = pk2(v[2] * rs * n0[2], v[3] * rs * n0[3]);
            o.z = pk2(v[4] * rs * n1[0], v[5] * rs * n1[1]); o.w = pk2(v[6] * rs * n1[2], v[7] * rs * n1[3]);
            *(u32x4*)(mx + c) = o;
        }
#pragma unroll 2
        for (int hh = 0; hh < 8; ++hh) {
            const int c = hh * 256 + lane * 4;
            float v[4]; unpack4(*(const u32x2*)(yz + 2048 + c), v);
            float gt[4]; unpack4(*(const u32x2*)(PR + (size_t)row * LD0 + 9248 + c), gt);
            float s = (v[0] * v[0] + v[1] * v[1]) + (v[2] * v[2] + v[3] * v[3]);
            s = wave_sum(s);
            const float rs = rsqrtf(s * (1.0f / 256.0f) + EPS);
            u32x2 o; o.x = pk2(v[0] * rs * silu(gt[0]), v[1] * rs * silu(gt[1])); o.y = pk2(v[2] * rs * silu(gt[2]), v[3] * rs * silu(gt[3]));
            *(u32x2*)(mx + 2048 + c) = o;
        }
        int sample, b, t, L; seq_of_row(row, sample, b, t, L);
        if (t >= L - 3) {
            float* dst = p.out + (sample ? O_SCS : O_SCP) + ((size_t)b * 3 + (t - (L - 3))) * 3072;
            const bf16_t* src = PR + (size_t)row * LD0 + 2048;
#pragma unroll 4
            for (int c = lane; c < 3072; c += 64) dst[c] = bf2f(src[c]);
        }
    }
}

__device__ __forceinline__ void phase_prep1(const Params& p) {
    int tid = threadIdx.x; asm volatile("" : "+v"(tid));
    const int wave = tid >> 6, lane = tid & 63;
    const int gw = blockIdx.x * 8 + wave, NGW = gridDim.x * 8;
    const bf16_t* YZ = (const bf16_t*)(p.ws + WS_YZ); const bf16_t* PR = (const bf16_t*)(p.ws + WS_PROJ);
    bf16_t* MX = (bf16_t*)(p.ws + WS_ACT);
    const float* nw = p.in[22 + p.z];
    for (int row = gw; row < MT; row += NGW) {
#pragma unroll 1
        for (int it = 0; it < 4; ++it) {
            const int c = it * 512 + lane * 8;
            float v[8]; unpack8(*(const u32x4*)(YZ + (size_t)row * 4096 + c), v);
            float gt[8]; unpack8(*(const u32x4*)(PR + (size_t)row * LD1 + 6144 + c), gt);
            float s = 0.f;
#pragma unroll
            for (int j = 0; j < 8; ++j) s += v[j] * v[j];
            s += __shfl_xor(s, 1); s += __shfl_xor(s, 2); s += __shfl_xor(s, 4); s += __shfl_xor(s, 8);
            const float rs = rsqrtf(s * (1.0f / 128.0f) + EPS);
            const f32x4 n0 = *(const f32x4*)(nw + (c & 127)), n1 = *(const f32x4*)(nw + (c & 127) + 4);
            float o[8];
#pragma unroll
            for (int j = 0; j < 8; ++j) o[j] = v[j] * rs * (j < 4 ? n0[j] : n1[j - 4]) * silu(gt[j]);
            u32x4 ov; ov.x = pk2(o[0], o[1]); ov.y = pk2(o[2], o[3]); ov.z = pk2(o[4], o[5]); ov.w = pk2(o[6], o[7]);
            *(u32x4*)(MX + (size_t)row * 4096 + c) = ov;
        }
    }
}

__device__ __forceinline__ void phase_act(const Params& p, int l) {
    const bf16_t* PR = (const bf16_t*)(p.ws + WS_PROJ); bf16_t* ACT = (bf16_t*)(p.ws + WS_ACT);
    const float* cw = p.in[32 + p.z] + (size_t)l * 3 * DFF; const float* cbv = p.in[33 + p.z] + (size_t)l * DFF;
    const float* st = p.in[8 + p.z] + (size_t)l * 128 * 2 * DFF;
    const int total = MT * 704;
    for (int idx = blockIdx.x * 512 + threadIdx.x; idx < total; idx += gridDim.x * 512) {
        const int row = idx / 704, c = (idx - row * 704) * 8;
        int sample, b, t, L; seq_of_row(row, sample, b, t, L);
        float g2[8], g1[8], g0[8], uu[8];
        unpack8(*(const u32x4*)(PR + (size_t)row * LDU + c), g2);
        unpack8(*(const u32x4*)(PR + (size_t)row * LDU + DFF + c), uu);
        if (t >= 1) unpack8(*(const u32x4*)(PR + (size_t)(row - 1) * LDU + c), g1);
        else {
#pragma unroll
            for (int j = 0; j < 8; ++j) g1[j] = sample ? st[((size_t)b * 2 + 1) * DFF + c + j] : 0.f;
        }
        if (t >= 2) unpack8(*(const u32x4*)(PR + (size_t)(row - 2) * LDU + c), g0);
        else {
#pragma unroll
            for (int j = 0; j < 8; ++j) g0[j] = sample ? st[((size_t)b * 2 + t) * DFF + c + j] : 0.f;
        }
        float o[8];
#pragma unroll
        for (int j = 0; j < 8; ++j) {
            const float y = cbv[c + j] + cw[c + j] * g0[j] + cw[DFF + c + j] * g1[j] + cw[2 * DFF + c + j] * g2[j];
            o[j] = silu(y) * uu[j];
        }
        u32x4 ov; ov.x = pk2(o[0], o[1]); ov.y = pk2(o[2], o[3]); ov.z = pk2(o[4], o[5]); ov.w = pk2(o[6], o[7]);
        *(u32x4*)(ACT + (size_t)row * DFF + c) = ov;
        if (t >= L - 2) {
            float* dst = p.out + (sample ? O_FCS + (((size_t)l * 128 + b) * 2 + (t - (L - 2))) * DFF : O_FCP + (((size_t)l * 4 + b) * 2 + (t - (L - 2))) * DFF) + c;
            *(f32x4*)dst = (f32x4){g2[0], g2[1], g2[2], g2[3]}; *(f32x4*)(dst + 4) = (f32x4){g2[4], g2[5], g2[6], g2[7]};
        }
    }
}

__device__ __forceinline__ void phase_lruconv(const Params& p) {
    const bf16_t* PR = (const bf16_t*)(p.ws + WS_PROJ); bf16_t* XR = (bf16_t*)(p.ws + WS_XR);
    const float* cw = p.in[23 + p.z]; const float* cbv = p.in[24 + p.z]; const float* st = p.in[7 + p.z];
    const int total = MT * 256;
    for (int idx = blockIdx.x * 512 + threadIdx.x; idx < total; idx += gridDim.x * 512) {
        const int row = idx >> 8, c = (idx & 255) * 8;
        int sample, b, t, L; seq_of_row(row, sample, b, t, L);
        float x[4][8];
#pragma unroll
        for (int j = 0; j < 4; ++j) {
            const int tt = t + j - 3;
            if (tt >= 0) unpack8(*(const u32x4*)(PR + (size_t)(row + j - 3) * LD1 + 8192 + c), x[j]);
            else {
#pragma unroll
                for (int i = 0; i < 8; ++i) x[j][i] = sample ? st[((size_t)b * 3 + (t + j)) * 2048 + c + i] : 0.f;
            }
        }
        float o[8];
#pragma unroll
        for (int i = 0; i < 8; ++i) o[i] = cbv[c + i] + cw[c + i] * x[0][i] + cw[2048 + c + i] * x[1][i] + cw[4096 + c + i] * x[2][i] + cw[6144 + c + i] * x[3][i];
        u32x4 ov; ov.x = pk2(o[0], o[1]); ov.y = pk2(o[2], o[3]); ov.z = pk2(o[4], o[5]); ov.w = pk2(o[6], o[7]);
        *(u32x4*)(XR + (size_t)row * 2048 + c) = ov;
        if (t >= L - 3) {
            float* dst = p.out + (sample ? O_LCS : O_LCP) + ((size_t)b * 3 + (t - (L - 3))) * 2048 + c;
            *(f32x4*)dst = (f32x4){x[3][0], x[3][1], x[3][2], x[3][3]}; *(f32x4*)(dst + 4) = (f32x4){x[3][4], x[3][5], x[3][6], x[3][7]};
        }
    }
}

__device__ __forceinline__ void finalize_sample_rows(const Params& p, float* ssdst, int nsplit) {
    int tid = threadIdx.x; asm volatile("" : "+v"(tid));
    const int wave = tid >> 6, lane = tid & 63;
    const int gw = blockIdx.x * 8 + wave, NGW = gridDim.x * 8;
    float* X = (float*)(p.ws + WS_X); bf16_t* XB = (bf16_t*)(p.ws + WS_XB); const float* PT = (const float*)(p.ws + WS_PROJ);
    for (int row = MP + gw; row < MT; row += NGW) {
        float s = 0.f;
#pragma unroll 2
        for (int j = 0; j < 8; ++j) {
            const unsigned o = (unsigned)row * 2048u + (unsigned)(lane + 64 * j) * 4u;
            f32x4 v = *(const f32x4*)(X + o);
            for (int ks = 0; ks < nsplit; ++ks) v += *(const f32x4*)(PT + (size_t)ks * (512 * 2048) + (o - (unsigned)MP * 2048u));
            *(f32x4*)(X + o) = v;
            u32x2 w; w.x = pk2(v[0], v[1]); w.y = pk2(v[2], v[3]);
            *(u32x2*)(XB + o) = w;
            s += (v[0] * v[0] + v[1] * v[1]) + (v[2] * v[2] + v[3] * v[3]);
        }
        s = wave_sum(s);
        if (lane == 0) ssdst[row] = s;
    }
}

__device__ __forceinline__ void phase_final(const Params& p) {
    int tid = threadIdx.x; asm volatile("" : "+v"(tid));
    const int wave = tid >> 6, lane = tid & 63;
    const int gw = blockIdx.x * 8 + wave, NGW = gridDim.x * 8;
    const float* X = (const float*)(p.ws + WS_X); const float* nf = p.in[11 + p.z];
    for (int row = gw; row < MT; row += NGW) {
        f32x4 v[8]; float sq = 0.f;
#pragma unroll
        for (int j = 0; j < 8; ++j) { v[j] = *(const f32x4*)(X + (size_t)row * 2048 + (lane + 64 * j) * 4);
            if (row >= MP) { for (int ks = 0; ks < 11; ++ks) v[j] += *(const f32x4*)((const float*)(p.ws + WS_PROJ) + (size_t)ks * (512 * 2048) + (size_t)(row - MP) * 2048 + (lane + 64 * j) * 4); }
            sq += (v[j][0] * v[j][0] + v[j][1] * v[j][1]) + (v[j][2] * v[j][2] + v[j][3] * v[j][3]); }
        sq = wave_sum(sq);
        const float rs = rsqrtf(sq * (1.0f / 2048.0f) + EPS);
        float* dst = p.out + (row < MP ? O_YP + (size_t)row * 2048 : O_YS + (size_t)(row - MP) * 2048);
#pragma unroll
        for (int j = 0; j < 8; ++j) {
            const int c = (lane + 64 * j) * 4;
            *(f32x4*)(dst + c) = v[j] * rs * *(const f32x4*)(nf + c);
        }
    }
}

#define XB_TMO      128
#define XB_XCNT(j)  (256  + 64 * (j))
#define XB_XSUB(j)  (1280 + 64 * (j))
#define XB_XGEN(j)  (2304 + 64 * (j))
#define XB_TOP      3328
#define XB_TOPGEN   3392
#define XCD_BAR_WORDS 3456
#define XB_SPIN_CAP (1u << 22)
__device__ __forceinline__ unsigned xb_ld(unsigned* p)              { return __hip_atomic_load(p, __ATOMIC_RELAXED, __HIP_MEMORY_SCOPE_AGENT); }
__device__ __forceinline__ unsigned xb_add(unsigned* p, unsigned v) { return __hip_atomic_fetch_add(p, v, __ATOMIC_RELAXED, __HIP_MEMORY_SCOPE_AGENT); }
__device__ __forceinline__ unsigned xb_xcc_id() { return (unsigned)__builtin_amdgcn_s_getreg((3 << 11) | 20) & 0xFu; }
#define XB_SPIN(cond, bar) do { unsigned _sp = 0; while (cond) { __builtin_amdgcn_s_sleep(1); \
    if ((++_sp & 255u) == 0u) { if (xb_ld(&(bar)[XB_TMO])) break; if (_sp > XB_SPIN_CAP) { atomicAdd(&(bar)[XB_TMO], 1u); break; } } } } while (0)
struct XcdBarrier { unsigned* bar; unsigned x; volatile LAS unsigned* st; };
__device__ __forceinline__ XcdBarrier xcd_barrier_post(unsigned* bar, volatile LAS unsigned* st) {
    XcdBarrier b; b.bar = bar; b.x = xb_xcc_id(); b.st = st;
    if (threadIdx.x == 0) (void)xb_add(&bar[XB_XCNT(b.x)], 1u);
    return b;
}
__device__ __forceinline__ void xcd_barrier_complete(unsigned* bar, unsigned x, unsigned& nloc, unsigned& nx) {
    const unsigned G = gridDim.x * gridDim.y * gridDim.z;
    unsigned sum, cnt, mine, sp = 0u;
    for (;;) {
        sum = 0u; cnt = 0u; mine = 0u;
#pragma unroll
        for (unsigned j = 0; j < 16; ++j) { const unsigned c = xb_ld(&bar[XB_XCNT(j)]); sum += c; cnt += (c > 0u) ? 1u : 0u; mine = (j == x) ? c : mine; }
        if (sum == G) break;
        __builtin_amdgcn_s_sleep(1);
        if ((++sp & 255u) == 0u) { if (xb_ld(&bar[XB_TMO])) break; if (sp > XB_SPIN_CAP) { atomicAdd(&bar[XB_TMO], 1u); break; } }
    }
    nloc = mine > 0u ? mine : 1u; nx = cnt > 0u ? cnt : 1u;
}
__device__ __forceinline__ void xcd_barrier(const XcdBarrier& b) {
    asm volatile("s_waitcnt vmcnt(0)" ::: "memory");
    __syncthreads();
    if (threadIdx.x == 0) {
        unsigned* bar = b.bar;
        __builtin_amdgcn_s_waitcnt(0);
        unsigned nloc = b.st[0], nx = b.st[1];
        if (nloc == 0u) { xcd_barrier_complete(bar, b.x, nloc, nx); b.st[0] = nloc; b.st[1] = nx; }
        const unsigned old = xb_add(&bar[XB_XSUB(b.x)], 1u);
        const unsigned gen = old / nloc;
        if (old + 1u == (gen + 1u) * nloc) {
            __builtin_amdgcn_fence(__ATOMIC_RELEASE, "agent");
            asm volatile("s_waitcnt vmcnt(0)" ::: "memory");
            const unsigned og = xb_add(&bar[XB_TOP], 1u);
            const unsigned tg = og / nx;
            if (og + 1u == (tg + 1u) * nx) xb_add(&bar[XB_TOPGEN], 1u);
            else XB_SPIN(xb_ld(&bar[XB_TOPGEN]) == tg, bar);
            __builtin_amdgcn_fence(__ATOMIC_ACQUIRE, "agent");
            xb_add(&bar[XB_XGEN(b.x)], 1u);
            asm volatile("s_waitcnt vmcnt(0)" ::: "memory");
        } else {
            XB_SPIN(xb_ld(&bar[XB_XGEN(b.x)]) == gen, bar);
            __builtin_amdgcn_fence(__ATOMIC_ACQUIRE, "agent");
            asm volatile("s_waitcnt vmcnt(0)" ::: "memory");
        }
    }
    __syncthreads();
}

#ifndef PROBE_MASK
#define PROBE_MASK 0u
#endif
#ifndef PHMASK
#define PHMASK 0xFFFFFFFFu
#endif
#define EN(i) (((PHMASK) >> (i)) & 1u)
__global__ void __launch_bounds__(512, 2) fwd_megakernel(Params p) {
    extern __shared__ __attribute__((aligned(16))) unsigned char shm[];
    float* ldsf = (float*)shm;
    LAS unsigned char* ldsg = (LAS unsigned char*)shm;
    unsigned char* ws = p.ws;
    float* ssb = (float*)(ws + WS_SS);
    volatile LAS unsigned* xst = (volatile LAS unsigned*)(ldsg + 133120);
    if (threadIdx.x == 0) { xst[0] = 0u; xst[1] = 0u; }
    __syncthreads();
    (void)xcd_barrier_post((unsigned*)(ws + WS_CTL) + 256, xst);
#define XBAR() do { XcdBarrier _b; _b.bar = (unsigned*)(p.ws + WS_CTL) + 256; _b.x = xb_xcc_id(); _b.st = (volatile LAS unsigned*)((LAS unsigned char*)shm + 133120); xcd_barrier(_b); } while (0)
#if PROBE_MASK
    unsigned long long tph = __builtin_amdgcn_s_memrealtime();
#endif
    for (int ph = p.ph_lo; ph < p.ph_hi; ++ph) {
        if (ph > p.ph_lo) {
            if (ph == 1) cg::this_grid().sync();
            else XBAR();
#if PROBE_MASK
            {
                const unsigned long long t1 = __builtin_amdgcn_s_memrealtime();
                if ((PROBE_MASK >> (ph - 1)) & 1u) { const unsigned long long dt = t1 - tph; while (__builtin_amdgcn_s_memrealtime() - t1 < dt) __builtin_amdgcn_s_sleep(8); }
                tph = __builtin_amdgcn_s_memrealtime();
            }
#endif
        }
        if (EN(0) && ph == 0) phase_prologue(p, ldsf);
        else if (EN(1) && (ph == 1 || ph == 5 || ph == 8 || ph == 14)) {
            pg8::Gemm g; pg8::EpiScaleBf16 E; int N;
            if (ph != 1) { finalize_sample_rows(p, ssb + (ph == 5 ? 1 : (ph == 8 ? 2 : 3)) * MT, ph == 8 ? 11 : 16); XBAR(); }
            g.A = (const char*)(ws + WS_XB); g.lda = 2048; g.ldb = 2048;
            if (ph == 1) { g.Bt = (const char*)(ws + WS_WIN0); N = LD0; E.ss = ssb; }
            else if (ph == 5) { g.Bt = (const char*)(ws + WS_WUP0); N = LDU; E.ss = ssb + MT; }
            else if (ph == 8) { g.Bt = (const char*)(ws + WS_WIN1); N = LD1; E.ss = ssb + 2 * MT; }
            else { g.Bt = (const char*)(ws + WS_WUP1); N = LDU; E.ss = ssb + 3 * MT; }
            E.O = (bf16_t*)(ws + WS_PROJ); E.ldc = N;
            pg8::Order S; S.nMm = 32; S.nN = N / 256; S.n_main = 32 * S.nN; S.n_tail = 2 * S.nN; S.ksplit = 1; S.nt_full = 32; S.G = gridDim.x; S.c = blockIdx.x;
            S.a_t = (size_t)256 * 2048 * 2; S.b_t = (size_t)256 * 2048 * 2; S.acol = 0;
            pg8::gemm_phase<pg8::EpiScaleBf16>(ldsg, g, S, E);
        }
        else if (EN(4) && (ph == 4 || ph == 7 || ph == 13 || ph == 16)) {
            pg8::Gemm g; pg8::EpiResid E;
            g.A = (const char*)(ws + WS_ACT);
            if (ph == 4) { g.Bt = (const char*)(ws + WS_WOUT0); g.lda = 4096; E.ssout = ssb + MT; }
            else if (ph == 7) { g.Bt = (const char*)(ws + WS_WDN0); g.lda = DFF; E.ssout = ssb + 2 * MT; }
            else if (ph == 13) { g.Bt = (const char*)(ws + WS_WOUT1); g.lda = 4096; E.ssout = ssb + 3 * MT; }
            else { g.Bt = (const char*)(ws + WS_WDN1); g.lda = DFF; E.ssout = ssb + 4 * MT; }
            g.ldb = g.lda;
            E.X = (float*)(ws + WS_X); E.XB = (bf16_t*)(ws + WS_XB); E.part = (float*)(ws + WS_PROJ);
            pg8::Order S; S.nMm = 32; S.nN = 8; S.n_main = 256; S.nt_full = g.lda / 64; S.ksplit = (g.lda == 4096) ? 16 : 11; S.n_tail = 16 * S.ksplit; S.G = gridDim.x; S.c = blockIdx.x;
            S.a_t = (size_t)256 * g.lda * 2; S.b_t = (size_t)256 * g.ldb * 2; S.acol = 0;
            pg8::gemm_phase<pg8::EpiResid>(ldsg, g, S, E);
        }
        else if (EN(10) && ph == 10) {
            pg8::Gemm g; pg8::EpiLru E;
            g.A = (const char*)(ws + WS_XR); g.Bt = (const char*)(ws + WS_WLRU); g.lda = 2048; g.ldb = 256;
            E.br = p.in[26 + p.z]; E.bi = p.in[28 + p.z]; E.sp = (const float*)(ws + WS_SP); E.XR = (const bf16_t*)(ws + WS_XR);
            E.LA = (float*)(ws + WS_LA); E.LBv = (bf16_t*)(ws + WS_LBB);
            pg8::Order S; S.nMm = 34; S.nN = 16; S.n_main = 34 * 16; S.n_tail = 0; S.ksplit = 1; S.nt_full = 4 + p.z; S.G = gridDim.x; S.c = blockIdx.x;
            S.a_t = (size_t)256 * 2048 * 2; S.b_t = (size_t)256 * 256 * 2; S.acol = 512;
            pg8::gemm_phase<pg8::EpiLru>(ldsg, g, S, E);
        }
        else if (EN(2) && ph == 2) phase_rec0(p, ldsf);
        else if (EN(3) && ph == 3) phase_prep0(p);
        else if (EN(6) && ph == 6) phase_act(p, 0);
        else if (EN(9) && ph == 9) phase_lruconv(p);
        else if (EN(11) && ph == 11) phase_rec1(p, ldsf);
        else if (EN(12) && ph == 12) phase_prep1(p);
        else if (EN(15) && ph == 15) phase_act(p, 1);
        else if (EN(17) && ph == 17) phase_final(p);
    }
}

#ifndef N_LAUNCH_MODE
#define N_LAUNCH_MODE 0
#endif

extern "C" void kernel_launch(void* const* d_in, const int* in_sizes, int n_in, void* d_out, int out_size, void* d_ws, size_t ws_size, hipStream_t stream) {
    static int grid = 0;
    if (grid == 0) {
        if (n_in != 35 || (size_t)out_size != O_END || ws_size < WS_END) { fprintf(stderr, "kernel_launch: unexpected shapes: n_in %d out %d ws %zu (need %zu)\n", n_in, out_size, ws_size, (size_t)WS_END); grid = -1; return; }
        int dev = 0, cus = 0, per_cu = 0;
        hipGetDevice(&dev);
        hipDeviceGetAttribute(&cus, hipDeviceAttributeMultiprocessorCount, dev);
        if (hipFuncSetAttribute((const void*)fwd_megakernel, hipFuncAttributeMaxDynamicSharedMemorySize, LDS_BYTES) != hipSuccess) { fprintf(stderr, "kernel_launch: hipFuncSetAttribute failed\n"); grid = -1; return; }
        if (hipOccupancyMaxActiveBlocksPerMultiprocessor(&per_cu, (const void*)fwd_megakernel, 512, LDS_BYTES) != hipSuccess || per_cu < 1) { fprintf(stderr, "kernel_launch: occupancy query says %d\n", per_cu); per_cu = 1; }
        (void)hipGetLastError();
        grid = cus;
    }
    if (grid < 0) return;
    (void)hipMemsetAsync((char*)d_ws + WS_CTL, 0, 16384, stream);
    Params p{};
    for (int i = 0; i < 35; ++i) p.in[i] = (const float*)d_in[i];
    p.z = 0; p.pad = 0;
    p.out = (float*)d_out; p.ws = (unsigned char*)d_ws;
#if N_LAUNCH_MODE == 0
    p.ph_lo = 0; p.ph_hi = NPHASE;
    void* args[] = {&p};
    hipError_t e = hipLaunchCooperativeKernel((const void*)fwd_megakernel, dim3(grid), dim3(512), args, LDS_BYTES, stream);
    if (e != hipSuccess) fprintf(stderr, "cooperative launch failed: %s (grid %d)\n", hipGetErrorString(e), grid);
#else
    for (int ph = 0; ph < NPHASE; ++ph) {
        p.ph_lo = ph; p.ph_hi = ph + 1;
        hipLaunchKernelGGL(fwd_megakernel, dim3(grid), dim3(512), LDS_BYTES, stream, p);
    }
#endif
}
```

```cpp
#include <hip/hip_runtime.h>
#include <hip/hip_cooperative_groups.h>
#include <cstdio>
#include <cstdint>
namespace cg = cooperative_groups;

#define LAS __attribute__((address_space(3)))
typedef unsigned short bf16_t;
typedef short bf16x8 __attribute__((ext_vector_type(8)));
typedef float f32x4 __attribute__((ext_vector_type(4)));
typedef float f32x2 __attribute__((ext_vector_type(2)));
typedef unsigned u32x4 __attribute__((ext_vector_type(4)));
typedef unsigned u32x2 __attribute__((ext_vector_type(2)));

constexpr int D = 2048, MP = 8192, MS = 512, MT = 8704;
constexpr int LD0 = 11520, LD1 = 12288, LDU = 11264, DFF = 5632;
constexpr float EPS = 1e-6f;
constexpr size_t O_YP = 0;
constexpr size_t O_YS = O_YP + (size_t)4 * 2048 * 2048;
constexpr size_t O_SSMP = O_YS + (size_t)128 * 4 * 2048;
constexpr size_t O_SSMS = O_SSMP + (size_t)4 * 32 * 128 * 64;
constexpr size_t O_SCP = O_SSMS + (size_t)128 * 32 * 128 * 64;
constexpr size_t O_SCS = O_SCP + (size_t)4 * 3 * 3072;
constexpr size_t O_RETP = O_SCS + (size_t)128 * 3 * 3072;
constexpr size_t O_RETS = O_RETP + (size_t)4 * 8 * 128 * 256;
constexpr size_t O_HGP = O_RETS + (size_t)128 * 8 * 128 * 256;
constexpr size_t O_HGS = O_HGP + (size_t)4 * 16 * 128 * 128;
constexpr size_t O_LRUP = O_HGS + (size_t)128 * 16 * 128 * 128;
constexpr size_t O_LRUS = O_LRUP + (size_t)4 * 2048;
constexpr size_t O_LCP = O_LRUS + (size_t)128 * 2048;
constexpr size_t O_LCS = O_LCP + (size_t)4 * 3 * 2048;
constexpr size_t O_FCP = O_LCS + (size_t)128 * 3 * 2048;
constexpr size_t O_FCS = O_FCP + (size_t)2 * 4 * 2 * 5632;
constexpr size_t O_END = O_FCS + (size_t)2 * 128 * 2 * 5632;
constexpr size_t al256(size_t x) { return (x + 255) & ~(size_t)255; }
constexpr size_t WS_CTL = 0;
constexpr size_t WS_SS = 16384;
constexpr size_t WS_SP = al256(WS_SS + (size_t)5 * MT * 4);
constexpr size_t WS_LB = WS_SP + 8192;
constexpr size_t WS_WIN0 = WS_LB + 8192;
constexpr size_t WS_WOUT0 = WS_WIN0 + (size_t)LD0 * 2048 * 2;
constexpr size_t WS_WUP0 = WS_WOUT0 + (size_t)2048 * 4096 * 2;
constexpr size_t WS_WDN0 = WS_WUP0 + (size_t)LDU * 2048 * 2;
constexpr size_t WS_WIN1 = WS_WDN0 + (size_t)2048 * DFF * 2;
constexpr size_t WS_WOUT1 = WS_WIN1 + (size_t)LD1 * 2048 * 2;
constexpr size_t WS_WUP1 = WS_WOUT1 + (size_t)2048 * 4096 * 2;
constexpr size_t WS_WDN1 = WS_WUP1 + (size_t)LDU * 2048 * 2;
constexpr size_t WS_WLRU = WS_WDN1 + (size_t)2048 * DFF * 2;
constexpr size_t WS_X = WS_WLRU + (size_t)16 * 256 * 256 * 2;
constexpr size_t WS_XB = WS_X + (size_t)MT * 2048 * 4;
constexpr size_t WS_PROJ = WS_XB + (size_t)MT * 2048 * 2;
constexpr size_t WS_ACT = WS_PROJ + (size_t)MT * LD1 * 2;
constexpr size_t WS_YZ = WS_ACT + (size_t)MT * DFF * 2;
constexpr size_t WS_LA = WS_YZ + (size_t)MT * 4096 * 2;
constexpr size_t WS_LBB = WS_LA + (size_t)MT * 2048 * 4;
constexpr size_t WS_XR = WS_LBB + (size_t)MT * 2048 * 2;
constexpr size_t WS_END = WS_XR + (size_t)MT * 2048 * 2;

constexpr int LDS_BYTES = 133120 + 256;
constexpr int NPHASE = 18;

struct Params {
    const float* in[35];
    float* out;
    unsigned char* ws;
    int ph_lo, ph_hi;
    int z, pad;
};

__device__ __forceinline__ float bf2f(unsigned v) { return __uint_as_float(v << 16); }
__device__ __forceinline__ unsigned pk2(float lo, float hi) { unsigned r; asm volatile("v_cvt_pk_bf16_f32 %0, %1, %2" : "=v"(r) : "v"(lo), "v"(hi)); return r; }
__device__ __forceinline__ unsigned pk2_sw(float lo, float hi) {
    unsigned a = __float_as_uint(lo), b = __float_as_uint(hi); a += 0x7fffu + ((a >> 16) & 1u); b += 0x7fffu + ((b >> 16) & 1u); return (a >> 16) | (b & 0xffff0000u); }
__device__ __forceinline__ bf16_t f2bf(float x) { return (bf16_t)(pk2(x, 0.f) & 0xffffu); }
__device__ __forceinline__ float sigm(float x) { return __builtin_amdgcn_rcpf(1.f + __expf(-x)); }
__device__ __forceinline__ float silu(float x) { return x * __builtin_amdgcn_rcpf(1.f + __expf(-x)); }
__device__ __forceinline__ float softplus(float x) { return fmaxf(x, 0.f) + log1pf(__expf(-fabsf(x))); }
__device__ __forceinline__ float gelu_tanh(float x) { const float u = 0.7978845608f * (x + 0.044715f * x * x * x); const float t = 1.f - 2.f * __builtin_amdgcn_rcpf(1.f + __expf(2.f * u)); return 0.5f * x * (1.f + t); }
__device__ __forceinline__ float wave_sum(float v) {
#pragma unroll
    for (int o = 1; o < 64; o <<= 1) v += __shfl_xor(v, o);
    return v;
}
__device__ __forceinline__ void unpack8(u32x4 r, float* f) {
    f[0] = bf2f(r.x & 0xffffu); f[1] = __uint_as_float(r.x & 0xffff0000u); f[2] = bf2f(r.y & 0xffffu); f[3] = __uint_as_float(r.y & 0xffff0000u);
    f[4] = bf2f(r.z & 0xffffu); f[5] = __uint_as_float(r.z & 0xffff0000u); f[6] = bf2f(r.w & 0xffffu); f[7] = __uint_as_float(r.w & 0xffff0000u);
}
__device__ __forceinline__ void unpack4(u32x2 r, float* f) {
    f[0] = bf2f(r.x & 0xffffu); f[1] = __uint_as_float(r.x & 0xffff0000u); f[2] = bf2f(r.y & 0xffffu); f[3] = __uint_as_float(r.y & 0xffff0000u);
}
#define LDS_WAIT() asm volatile("s_waitcnt lgkmcnt(0)" ::: "memory")

namespace pg8 {
constexpr int BM = 256, BK = 64, HALF = 128, HTB = HALF * BK * 2, NXCD = 8, WGM = 8;
__device__ __forceinline__ int lds_byte(int r, int c) { const int st = (r >> 4) * 2 + (c >> 5), rr = r & 15, cc = c & 31, ob = rr * 64 + cc * 2; return st * 1024 + (ob ^ (((ob >> 9) & 1) << 5)); }
__device__ __forceinline__ void stage_rc(int b, int& R, int& C) { const int st = b / 1024, sb = b % 1024, swz = sb ^ (((sb >> 9) & 1) << 5); R = (st >> 1) * 16 + swz / 64; C = (st & 1) * 32 + (swz % 64) / 2; }
__device__ __forceinline__ int perm32(int rho) { const int n = rho >> 4, i = rho & 15; return 8 * (i >> 2) + 4 * n + (i & 3); }

struct Unit { int pm, pn, nt, kind, ks; size_t aoff, boff; };
struct Gemm { const char* A; const char* Bt; int lda, ldb; };
struct Order {
    int nMm, nN, n_main, n_tail, ksplit, nt_full, G, c; size_t a_t, b_t, acol;
    __device__ __forceinline__ bool next(int i, Unit& u) const {
        const long L = (long)i * G + c;
        if (L < n_main) {
            const int nwg = n_main;
            int wgid = (int)L; { const int q = nwg / NXCD, r = nwg % NXCD, xcd = wgid % NXCD, off = wgid / NXCD; wgid = (xcd < r ? xcd * (q + 1) : r * (q + 1) + (xcd - r) * q) + off; }
            const int nig = WGM * nN, gid = wgid / nig, fm = gid * WGM, gsz = (nMm - fm) < WGM ? (nMm - fm) : WGM;
            u.pm = fm + ((wgid % nig) % gsz); u.pn = (wgid % nig) / gsz; u.nt = nt_full; u.kind = 0; u.ks = 0;
            u.aoff = (size_t)u.pm * a_t + (size_t)(u.pn >> 1) * acol; u.boff = (size_t)u.pn * b_t; return true;
        }
        const int Lt = (int)(L - n_main); if (Lt >= n_tail) return false;
        const int ks = Lt % ksplit, r = Lt / ksplit;
        u.pm = nMm + (r & 1); u.pn = r >> 1; u.nt = nt_full / ksplit; u.kind = ksplit > 1 ? 1 : 0; u.ks = ks;
        const size_t kofs = (size_t)ks * u.nt * (BK * 2);
        u.aoff = (size_t)u.pm * a_t + (size_t)(u.pn >> 1) * acol + kofs; u.boff = (size_t)u.pn * b_t + kofs; return true;
    }
};

struct EpiScaleBf16 {
    static constexpr bool PERM = true;
    bf16_t* O; int ldc; const float* ss;
    __device__ __forceinline__ void operator()(const f32x4 (&acc)[2][2][4][2], const Unit& u, int wr, int wc, int fr, int fq) const {
        const int row0 = u.pm * BM + wr * 64 + fr, col0 = u.pn * BM + wc * 32 + 8 * fq;
#pragma unroll
        for (int ai = 0; ai < 2; ++ai)
#pragma unroll
            for (int m = 0; m < 4; ++m) {
                const int row = row0 + ai * HALF + m * 16;
                const float rs = rsqrtf(ss[row] * (1.0f / 2048.0f) + EPS);
                bf16_t* rowp = O + ((unsigned)row * (unsigned)ldc + (unsigned)col0);
#pragma unroll
                for (int bj = 0; bj < 2; ++bj) {
                    const f32x4 v0 = acc[ai][bj][m][0] * rs, v1 = acc[ai][bj][m][1] * rs;
                    u32x4 w; w.x = pk2(v0[0], v0[1]); w.y = pk2(v0[2], v0[3]); w.z = pk2(v1[0], v1[1]); w.w = pk2(v1[2], v1[3]);
                    *(u32x4*)(rowp + bj * HALF) = w;
                }
            }
    }
};
struct EpiResid {
    static constexpr bool PERM = false;
    float* X; bf16_t* XB; float* ssout; float* part;
    __device__ __forceinline__ void operator()(const f32x4 (&acc)[2][2][4][2], const Unit& u, int wr, int wc, int fr, int fq) const {
        const int row0 = u.pm * BM + wr * 64 + fr, col0 = u.pn * BM + wc * 32 + 4 * fq;
        if (u.kind == 1) {
            float* P = part + (size_t)u.ks * (512 * 2048);
#pragma unroll
            for (int ai = 0; ai < 2; ++ai)
#pragma unroll
                for (int m = 0; m < 4; ++m) {
                    const unsigned off = (unsigned)(row0 - MP + ai * HALF + m * 16) * 2048u + (unsigned)col0;
#pragma unroll
                    for (int bj = 0; bj < 2; ++bj)
#pragma unroll
                        for (int n = 0; n < 2; ++n) *(f32x4*)(P + off + bj * HALF + n * 16) = acc[ai][bj][m][n];
                }
            return;
        }
#pragma unroll
        for (int ai = 0; ai < 2; ++ai)
#pragma unroll
            for (int m = 0; m < 4; ++m) {
                const int row = row0 + ai * HALF + m * 16;
                const unsigned off = (unsigned)row * 2048u + (unsigned)col0;
                float sq = 0.f;
#pragma unroll
                for (int bj = 0; bj < 2; ++bj)
#pragma unroll
                    for (int n = 0; n < 2; ++n) {
                        const unsigned o = off + bj * HALF + n * 16;
                        f32x4 x = *(const f32x4*)(X + o) + acc[ai][bj][m][n];
                        *(f32x4*)(X + o) = x;
                        u32x2 w; w.x = pk2(x[0], x[1]); w.y = pk2(x[2], x[3]);
                        *(u32x2*)(XB + o) = w;
                        sq += (x[0] * x[0] + x[1] * x[1]) + (x[2] * x[2] + x[3] * x[3]);
                    }
                sq += __shfl_xor(sq, 16); sq += __shfl_xor(sq, 32);
                if (fq == 0) atomicAdd(ssout + row, sq);
                asm volatile("" ::: "memory");
            }
    }
};
struct EpiLru {
    static constexpr bool PERM = false;
    const float* br; const float* bi; const float* sp; const bf16_t* XR; float* LA; bf16_t* LBv;
    __device__ __forceinline__ void operator()(const f32x4 (&acc)[2][2][4][2], const Unit& u, int wr, int wc, int fr, int fq) const {
        const int row0 = u.pm * BM + wr * 64 + fr;
        const int cbase = (u.pn >> 1) * 256 + (u.pn & 1) * 128 + wc * 32 + 4 * fq;
#pragma unroll
        for (int ai = 0; ai < 2; ++ai)
#pragma unroll
            for (int m = 0; m < 4; ++m) {
                const int row = row0 + ai * HALF + m * 16;
                const bool first = (row < MP) && ((row & 2047) == 0);
#pragma unroll
                for (int n = 0; n < 2; ++n) {
                    const int c = cbase + n * 16;
                    const f32x4 br4 = *(const f32x4*)(br + c), bi4 = *(const f32x4*)(bi + c), sp4 = *(const f32x4*)(sp + c);
                    const unsigned o = (unsigned)row * 2048u + (unsigned)c;
                    float xr[4]; unpack4(*(const u32x2*)(XR + o), xr);
                    f32x4 av; float bb[4];
#pragma unroll
                    for (int j = 0; j < 4; ++j) {
                        const float r = sigm(acc[ai][0][m][n][j] + br4[j]), gi = sigm(acc[ai][1][m][n][j] + bi4[j]);
                        const float la = -8.0f * r * sp4[j];
                        const float a = __expf(la);
                        const float mult = first ? 1.0f : __builtin_amdgcn_sqrtf(fmaxf(1.0f - a * a, 0.f));
                        av[j] = a; bb[j] = mult * gi * xr[j];
                    }
                    *(f32x4*)(LA + o) = av;
                    u32x2 w; w.x = pk2(bb[0], bb[1]); w.y = pk2(bb[2], bb[3]);
                    *(u32x2*)(LBv + o) = w;
                    asm volatile("" ::: "memory");
                }
            }
    }
};

template <class Epi>
__device__ __forceinline__ void gemm_phase(LAS unsigned char* lds, const Gemm g, const Order& S, const Epi& E) {
    int tid = threadIdx.x; asm volatile("" : "+v"(tid));
    const int wid = __builtin_amdgcn_readfirstlane(tid >> 6), lane = tid & 63, wr = wid >> 2, wc = wid & 3, fr = lane & 15, fq = lane >> 4;
    unsigned voffA[2], voffB[2];
#pragma unroll
    for (int i = 0; i < 2; ++i) { int R, C; stage_rc(tid * 16 + i * 8192, R, C); const int Rb = Epi::PERM ? ((R & ~31) + perm32(R & 31)) : R;
        voffA[i] = (unsigned)(R * g.lda + C) * 2u; voffB[i] = (unsigned)(Rb * g.ldb + C) * 2u; }
    const size_t kstep = (size_t)(BK * 2);
    const size_t hstepA = (size_t)HALF * g.lda * 2, hstepB = (size_t)HALF * g.ldb * 2;
    const unsigned ldsw = (unsigned)wid * 1024u;
    const int aoff = lds_byte(wr * 64 + fr, fq * 8), boff = lds_byte(wc * 32 + fr, fq * 8);
#define PG8_SA(b, h) (((b) * 2 + (h)) * HTB)
#define PG8_SB(b, h) ((4 + (b) * 2 + (h)) * HTB)
#define PG8_STAGE(bufoff, gbase, voff) do { _Pragma("unroll") for (int _i = 0; _i < 2; ++_i) \
        __builtin_amdgcn_global_load_lds((const unsigned*)((const char*)(gbase) + (voff)[_i]), (LAS unsigned*)(lds + (bufoff) + ldsw + _i * 8192), 16, 0, 0); } while (0)
#define PG8_LDA(dst, b, h) do { _Pragma("unroll") for (int m = 0; m < 4; ++m) _Pragma("unroll") for (int k = 0; k < 2; ++k) dst[m][k] = *(const LAS bf16x8*)(lds + PG8_SA(b, h) + aoff + m * 2048 + k * 1024); } while (0)
#define PG8_LDB(dst, b, h) do { _Pragma("unroll") for (int n = 0; n < 2; ++n) _Pragma("unroll") for (int k = 0; k < 2; ++k) dst[n][k] = *(const LAS bf16x8*)(lds + PG8_SB(b, h) + boff + n * 2048 + k * 1024); } while (0)
#define PG8_MMA(ai, bj, At, Bt) do { __builtin_amdgcn_s_setprio(1); _Pragma("unroll") for (int m = 0; m < 4; ++m) _Pragma("unroll") for (int n = 0; n < 2; ++n) _Pragma("unroll") for (int k = 0; k < 2; ++k) \
        acc[ai][bj][m][n] = __builtin_amdgcn_mfma_f32_16x16x32_bf16(Bt[n][k], At[m][k], acc[ai][bj][m][n], 0, 0, 0); __builtin_amdgcn_s_setprio(0); } while (0)
#define PG8_WAIT_V(n) asm volatile("s_waitcnt vmcnt(" #n ")" ::: "memory")
#define PG8_WAIT_L(n) asm volatile("s_waitcnt lgkmcnt(" #n ")" ::: "memory")
#define PG8_BAR __builtin_amdgcn_s_barrier()
#define PG8_SCHED __builtin_amdgcn_sched_barrier(0)
    Unit cur, nxt; int ui = 0;
    if (!S.next(0, cur)) return;
    f32x4 acc[2][2][4][2];
#pragma unroll
    for (int a = 0; a < 2; ++a)
#pragma unroll
        for (int b = 0; b < 2; ++b)
#pragma unroll
            for (int m = 0; m < 4; ++m)
#pragma unroll
                for (int n = 0; n < 2; ++n) acc[a][b][m][n] = (f32x4){0.f, 0.f, 0.f, 0.f};
    bf16x8 At[4][2], B0[2][2], B1[2][2];
    const char* cA = g.A + cur.aoff; const char* cB = g.Bt + cur.boff;
    PG8_STAGE(PG8_SB(0, 0), cB, voffB); PG8_STAGE(PG8_SA(0, 0), cA, voffA); PG8_STAGE(PG8_SB(0, 1), cB + hstepB, voffB); PG8_STAGE(PG8_SA(0, 1), cA + hstepA, voffA);
    if (wr == 1) PG8_BAR;
    PG8_WAIT_V(4); PG8_BAR;
    PG8_STAGE(PG8_SB(1, 0), cB + kstep, voffB); PG8_STAGE(PG8_SA(1, 0), cA + kstep, voffA); PG8_STAGE(PG8_SB(1, 1), cB + hstepB + kstep, voffB);
    PG8_WAIT_V(6); PG8_BAR;
    for (;;) {
        const bool has_next = S.next(ui + 1, nxt);
        const char* nA = has_next ? g.A + nxt.aoff : cA; const char* nB = has_next ? g.Bt + nxt.boff : cB;
        const int nt = cur.nt;
        for (int t = 0; t < nt; t += 2) {
            const bool last = (t == nt - 2);
            const char* a1 = cA + (size_t)(t + 1) * kstep;
            const char* a2 = last ? nA : cA + (size_t)(t + 2) * kstep; const char* b2 = last ? nB : cB + (size_t)(t + 2) * kstep;
            const char* a3 = a2 + kstep; const char* b3 = b2 + kstep;
            PG8_LDB(B0, 0, 0); PG8_SCHED; PG8_LDA(At, 0, 0); PG8_STAGE(PG8_SA(1, 1), a1 + hstepA, voffA);
            PG8_WAIT_L(8); PG8_BAR; PG8_WAIT_L(0); PG8_MMA(0, 0, At, B0); PG8_BAR; PG8_SCHED;
            PG8_LDB(B1, 0, 1); PG8_STAGE(PG8_SB(0, 0), b2, voffB);
            PG8_BAR; PG8_WAIT_L(0); PG8_MMA(0, 1, At, B1); PG8_BAR;
            PG8_LDA(At, 0, 1); PG8_STAGE(PG8_SA(0, 0), a2, voffA);
            PG8_BAR; PG8_WAIT_L(0); PG8_MMA(1, 0, At, B0); PG8_BAR; PG8_SCHED;
            PG8_STAGE(PG8_SB(0, 1), b2 + hstepB, voffB);
            PG8_WAIT_V(6); PG8_BAR; PG8_MMA(1, 1, At, B1); PG8_BAR;
            PG8_LDB(B0, 1, 0); PG8_SCHED; PG8_LDA(At, 1, 0); PG8_STAGE(PG8_SA(0, 1), a2 + hstepA, voffA);
            PG8_WAIT_L(8); PG8_BAR; PG8_WAIT_L(0); PG8_MMA(0, 0, At, B0); PG8_BAR; PG8_SCHED;
            PG8_LDB(B1, 1, 1); PG8_STAGE(PG8_SB(1, 0), b3, voffB);
            PG8_BAR; PG8_WAIT_L(0); PG8_MMA(0, 1, At, B1); PG8_BAR;
            PG8_LDA(At, 1, 1); PG8_STAGE(PG8_SA(1, 0), a3, voffA);
            PG8_BAR; PG8_WAIT_L(0); PG8_MMA(1, 0, At, B0); PG8_BAR; PG8_SCHED;
            PG8_STAGE(PG8_SB(1, 1), b3 + hstepB, voffB);
            PG8_WAIT_V(6); PG8_BAR; PG8_MMA(1, 1, At, B1); PG8_BAR;
        }
        E(acc, cur, wr, wc, fr, fq);
        if (!has_next) break;
#pragma unroll
        for (int a = 0; a < 2; ++a)
#pragma unroll
            for (int b = 0; b < 2; ++b)
#pragma unroll
                for (int m = 0; m < 4; ++m)
#pragma unroll
                    for (int n = 0; n < 2; ++n) acc[a][b][m][n] = (f32x4){0.f, 0.f, 0.f, 0.f};
        cur = nxt; cA = nA; cB = nB; ++ui;
    }
    PG8_WAIT_V(0);
    if (wr == 0) PG8_BAR;
    PG8_BAR;
#undef PG8_SA
#undef PG8_SB
#undef PG8_STAGE
#undef PG8_LDA
#undef PG8_LDB
#undef PG8_MMA
#undef PG8_WAIT_V
#undef PG8_WAIT_L
#undef PG8_BAR
#undef PG8_SCHED
}
}

__device__ __forceinline__ void tr_item(const float* __restrict__ W, int ldw, int N, int k0, int n0, const float* __restrict__ scale, bf16_t* __restrict__ dst, int ldd, float* scr, int lane) {
    const int r4 = lane >> 4, c4 = (lane & 15) * 4;
    const bool inb = (n0 + c4) < N;
    f32x4 v[16];
#pragma unroll
    for (int i = 0; i < 16; ++i) v[i] = inb ? *(const f32x4*)(W + (size_t)(k0 + 4 * i + r4) * ldw + n0 + c4) : (f32x4){0.f, 0.f, 0.f, 0.f};
#pragma unroll
    for (int i = 0; i < 16; ++i) { float* d = scr + (4 * i + r4) * 65 + c4; d[0] = v[i][0]; d[1] = v[i][1]; d[2] = v[i][2]; d[3] = v[i][3]; }
    LDS_WAIT();
    const int c = lane & 7;
    f32x4 s0 = (f32x4){1.f, 1.f, 1.f, 1.f}, s1 = s0;
    if (scale) { s0 = *(const f32x4*)(scale + k0 + 8 * c); s1 = *(const f32x4*)(scale + k0 + 8 * c + 4); }
#pragma unroll
    for (int j = 0; j < 8; ++j) { const int n = (lane >> 3) + 8 * j; const float* sp = scr + (8 * c) * 65 + n;
        u32x4 o; o.x = pk2(sp[0 * 65] * s0[0], sp[1 * 65] * s0[1]); o.y = pk2(sp[2 * 65] * s0[2], sp[3 * 65] * s0[3]); o.z = pk2(sp[4 * 65] * s1[0], sp[5 * 65] * s1[1]); o.w = pk2(sp[6 * 65] * s1[2], sp[7 * 65] * s1[3]);
        *(u32x4*)(dst + (size_t)n * ldd + 8 * c) = o; }
    LDS_WAIT();
}

__device__ __forceinline__ void phase_prologue(const Params& p, float* ldsf) {
    int tid = threadIdx.x; asm volatile("" : "+v"(tid));
    const int wave = tid >> 6, lane = tid & 63;
    const int gw = blockIdx.x * 8 + wave, NGW = gridDim.x * 8;
    float* scr = ldsf + wave * 4160;
    unsigned char* ws = p.ws;
    constexpr int I0 = 32 * 177, I1 = 64 * 32, I2 = 32 * 176, I3 = 88 * 32, I4 = 32 * 192, I5 = I1, I6 = I2, I7 = I3, I8 = 128, I9 = 128;
    constexpr int NIT = I0 + I1 + I2 + I3 + I4 + I5 + I6 + I7 + I8 + I9;
    for (int it = gw; it < NIT; it += NGW) {
        int r = it;
        const float* W; int K, N; const float* sc = nullptr; bf16_t* WT;
        if (r < I0) { W = p.in[12 + p.z]; K = 2048; N = 11296; sc = p.in[9 + p.z]; WT = (bf16_t*)(ws + WS_WIN0); }
        else if ((r -= I0) < I1) { W = p.in[19 + p.z]; K = 4096; N = 2048; WT = (bf16_t*)(ws + WS_WOUT0); }
        else if ((r -= I1) < I2) { W = p.in[31 + p.z]; K = 2048; N = 11264; sc = p.in[10 + p.z]; WT = (bf16_t*)(ws + WS_WUP0); }
        else if ((r -= I2) < I3) { W = p.in[34 + p.z]; K = 5632; N = 2048; WT = (bf16_t*)(ws + WS_WDN0); }
        else if ((r -= I3) < I4) { W = p.in[20 + p.z]; K = 2048; N = 12288; sc = p.in[9 + p.z] + 2048; WT = (bf16_t*)(ws + WS_WIN1); }
        else if ((r -= I4) < I5) { W = p.in[30 + p.z]; K = 4096; N = 2048; WT = (bf16_t*)(ws + WS_WOUT1); }
        else if ((r -= I5) < I6) { W = p.in[31 + p.z] + (size_t)2048 * 11264; K = 2048; N = 11264; sc = p.in[10 + p.z] + 2048; WT = (bf16_t*)(ws + WS_WUP1); }
        else if ((r -= I6) < I7) { W = p.in[34 + p.z] + (size_t)5632 * 2048; K = 5632; N = 2048; WT = (bf16_t*)(ws + WS_WDN1); }
        else {
            r -= I7; const int which = r >> 7; r &= 127;
            const int blk = r >> 4, kb = (r >> 2) & 3, nb = r & 3, n0 = 64 * nb, k0 = 64 * kb;
            const float* Wl = (which ? p.in[27 + p.z] : p.in[25 + p.z]) + (size_t)blk * 65536;
            const int drow = (blk * 2 + (n0 >> 7)) * 256 + which * 128 + (n0 & 127);
            tr_item(Wl, 256, 256, k0, n0, nullptr, (bf16_t*)(ws + WS_WLRU) + (size_t)drow * 256 + k0, 256, scr, lane);
            continue;
        }
        const int nblk = (N + 63) / 64, kb = r / nblk, nb = r % nblk, k0 = 64 * kb, n0 = 64 * nb;
        tr_item(W, N, N, k0, n0, sc, WT + (size_t)n0 * K + k0, K, scr, lane);
    }
    {
        u32x4* z = (u32x4*)((bf16_t*)(ws + WS_WIN0) + (size_t)11296 * 2048);
        const int n16 = 224 * 2048 * 2 / 16;
        for (int i = blockIdx.x * 512 + tid; i < n16; i += gridDim.x * 512) z[i] = (u32x4){0u, 0u, 0u, 0u};
    }
    float* X = (float*)(ws + WS_X); bf16_t* XB = (bf16_t*)(ws + WS_XB); float* ss = (float*)(ws + WS_SS);
    for (int row = gw; row < MT; row += NGW) {
        const float* src = row < MP ? p.in[0 + p.z] + (size_t)row * 2048 : p.in[1 + p.z] + (size_t)(row - MP) * 2048;
        float s = 0.f;
#pragma unroll
        for (int j = 0; j < 8; ++j) {
            const f32x4 v = *(const f32x4*)(src + (lane + 64 * j) * 4);
            *(f32x4*)(X + (size_t)row * 2048 + (lane + 64 * j) * 4) = v;
            u32x2 w; w.x = pk2(v[0], v[1]); w.y = pk2(v[2], v[3]);
            *(u32x2*)(XB + (size_t)row * 2048 + (lane + 64 * j) * 4) = w;
            s += (v[0] * v[0] + v[1] * v[1]) + (v[2] * v[2] + v[3] * v[3]);
        }
        s = wave_sum(s);
        if (lane == 0) ss[row] = s;
    }
    for (int i = blockIdx.x * 512 + tid; i < 4 * MT; i += gridDim.x * 512) ss[MT + i] = 0.f;
    for (int i = blockIdx.x * 512 + tid; i < 2048; i += gridDim.x * 512) {
        ((float*)(ws + WS_SP))[i] = softplus(-p.in[29 + p.z][i]);
        ((float*)(ws + WS_LB))[i] = sigm(p.in[21 + p.z][2048 + i] - p.in[21 + p.z][i]);
    }
}

__device__ __forceinline__ int next_item(unsigned* ctr, float* ldsf) {
    __syncthreads();
    if (threadIdx.x == 0) ((volatile unsigned*)ldsf)[24576] = atomicAdd(ctr, 1u);
    __syncthreads();
    return (int)((volatile unsigned*)ldsf)[24576];
}

template <int TYPE, int VW>
__device__ __forceinline__ void rec_item(const Params& p, float* ldsf, int sample, int b, int h, int s) {
    constexpr int NV = VW / 16;
    typedef float VT __attribute__((ext_vector_type(NV)));
    int tid = threadIdx.x; asm volatile("" : "+v"(tid));
    const int w = tid >> 6, lane = tid & 63, kg = lane >> 4, vq = lane & 15, kb = 16 * w + 4 * kg;
    const int L = sample ? 4 : 2048, row0 = sample ? MP + 4 * b : 2048 * b, pos0 = sample ? 16384 : 0;
    constexpr int LDP = TYPE < 2 ? LD0 : LD1;
    const bf16_t* proj = (const bf16_t*)(p.ws + WS_PROJ) + (size_t)row0 * LDP;
    bf16_t* yz = (bf16_t*)(p.ws + WS_YZ) + (size_t)row0 * 4096;
    float* part = ldsf + 8192;
    int colA = -1, colB = -1, role = -1, didx = 0;
    float w0 = 0.f, w1 = 0.f, w2 = 0.f, w3 = 0.f, cbias = 0.f, c0 = 0.f, c1 = 0.f, c2 = 0.f, aux = 0.f, aux2 = 0.f;
    if constexpr (TYPE == 0) {
        if (tid < 320) {
            role = tid < 128 ? 0 : (tid < 256 ? 1 : 2);
            didx = tid < 128 ? tid : (tid < 256 ? tid - 128 : tid - 256);
            const int ch = tid < 128 ? 2560 + (h >> 3) * 128 + tid : (tid < 256 ? 2048 + (h >> 3) * 128 + (tid - 128) : h * 64 + (tid - 256));
            colA = 2048 + ch;
            const float* cw = p.in[13 + p.z];
            w0 = cw[ch]; w1 = cw[3072 + ch]; w2 = cw[2 * 3072 + ch]; w3 = cw[3 * 3072 + ch]; cbias = p.in[14 + p.z][ch];
            if (sample) { const float* st = p.in[3 + p.z] + (size_t)b * 3 * 3072; c0 = st[ch]; c1 = st[3072 + ch]; c2 = st[2 * 3072 + ch]; }
        } else if (tid < 328) { role = 3; didx = tid - 320; colA = 5120 + h; aux = p.in[15 + p.z][h]; aux2 = -__expf(p.in[16 + p.z][h]); }
    } else if constexpr (TYPE == 1) {
        if (tid < 128) { role = tid < 64 ? 0 : 1; didx = tid & 63; colA = (tid < 64 ? 5152 : 6176) + h * 128 + didx; colB = colA + 64;
            aux = exp2f(-(float)didx * 0.20762050593046014f); }
        else if (tid < 128 + VW) { role = 2; didx = tid - 128; colA = 7200 + h * 256 + s * VW + didx; }
    } else {
        if (tid < 128) { role = 0; didx = tid; colA = h * 128 + tid; }
        else if (tid < 256) { role = 1; didx = tid - 128; colA = 2048 + h * 128 + didx; aux = ((const float*)(p.ws + WS_LB))[h * 128 + didx]; }
        else if (tid < 256 + VW) { role = 2; didx = tid - 256; colA = 4096 + h * 128 + s * VW + didx; }
    }
    const float Dh = TYPE == 0 ? p.in[17 + p.z][h] : 0.f;
    const float gamma = TYPE == 1 ? 1.0f - exp2f(-5.0f - (float)h * (4.0f / 7.0f)) : 0.f;
    const int ldS = TYPE == 0 ? 64 : (TYPE == 1 ? 256 : 128);
    size_t soff;
    if constexpr (TYPE == 0) soff = ((size_t)(b * 32 + h) * 128) * 64;
    else if constexpr (TYPE == 1) soff = ((size_t)(b * 8 + h) * 128) * 256 + s * VW;
    else soff = ((size_t)(b * 16 + h) * 128) * 128 + s * VW;
    const float* S0 = TYPE == 0 ? p.in[2 + p.z] : (TYPE == 1 ? p.in[4 + p.z] : p.in[5 + p.z]);
    float* Sout = p.out + (TYPE == 0 ? (sample ? O_SSMS : O_SSMP) : (TYPE == 1 ? (sample ? O_RETS : O_RETP) : (sample ? O_HGS : O_HGP))) + soff;
    VT S[4];
#pragma unroll
    for (int i = 0; i < 4; ++i) { if (sample) S[i] = *(const VT*)(S0 + soff + (size_t)(kb + i) * ldS + NV * vq); else S[i] = (VT)(0.f); }
    unsigned short ra[8], rb[8]; unsigned short zr = 0;
    const int R = (L + 7) >> 3;
    auto load_raw = [&](int r) {
#pragma unroll
        for (int t = 0; t < 8; ++t) {
            const int tt = 8 * r + t;
            ra[t] = 0; rb[t] = 0;
            if (tt < L) {
                if (colA >= 0) ra[t] = proj[(size_t)tt * LDP + colA];
                if (TYPE == 1 && colB >= 0) rb[t] = proj[(size_t)tt * LDP + colB];
            }
        }
        if (TYPE == 0) { const int tt = 8 * r + w; if (tt < L) zr = proj[(size_t)tt * LDP + h * 64 + lane]; }
    };
    load_raw(0);
    for (int r = 0; r < R; ++r) {
        const int nv = (L - 8 * r) < 8 ? (L - 8 * r) : 8;
        float* stg = ldsf + (r & 1) * 4096;
        float* qs = stg; float* ks = stg + 1024; float* as = stg + 2048; float* vs = stg + 3072; float* ad = stg + 3584;
        if constexpr (TYPE == 0) {
            if (role >= 0 && role < 3) {
                float* dst = role == 0 ? qs : (role == 1 ? ks : vs); const int dstr = role == 2 ? 64 : 128;
#pragma unroll
                for (int t = 0; t < 8; ++t) {
                    const float x = bf2f(ra[t]);
                    const float y = cbias + w0 * c0 + w1 * c1 + w2 * c2 + w3 * x;
                    c0 = c1; c1 = c2; c2 = x;
                    dst[t * dstr + didx] = silu(y);
                }
            } else if (role == 3) {
                float xv = 0.f;
#pragma unroll
                for (int t = 0; t < 8; ++t) if (t == didx) xv = bf2f(ra[t]);
                const float dt = softplus(xv + aux);
                ad[2 * didx] = __expf(dt * aux2); ad[2 * didx + 1] = dt;
            }
        } else if constexpr (TYPE == 1) {
            if (role == 0 || role == 1) {
                float* dst = role == 0 ? qs : ks; const float sc = role == 0 ? 1.0f : 0.08838834764831845f;
#pragma unroll
                for (int t = 0; t < 8; ++t) {
                    const int pos = pos0 + 8 * r + t;
                    const double rev = (double)pos * (double)aux * 0.15915494309189535;
                    const float fr = (float)(rev - floor(rev));
                    const float sn = __builtin_amdgcn_sinf(fr), cs = __builtin_amdgcn_cosf(fr);
                    const float x1 = bf2f(ra[t]) * sc, x2 = bf2f(rb[t]) * sc;
                    dst[t * 128 + didx] = x1 * cs - x2 * sn;
                    dst[t * 128 + 64 + didx] = x1 * sn + x2 * cs;
                }
            } else if (role == 2) {
#pragma unroll
                for (int t = 0; t < 8; ++t) vs[t * VW + didx] = bf2f(ra[t]);
            }
        } else {
            if (role == 0) {
#pragma unroll
                for (int t = 0; t < 8; ++t) qs[t * 128 + didx] = silu(bf2f(ra[t]));
            } else if (role == 1) {
#pragma unroll
                for (int t = 0; t < 8; ++t) { const float f = aux + (1.0f - aux) * sigm(bf2f(ra[t])); as[t * 128 + didx] = f; ks[t * 128 + didx] = 1.0f - f; }
            } else if (role == 2) {
#pragma unroll
                for (int t = 0; t < 8; ++t) vs[t * VW + didx] = bf2f(ra[t]);
            }
        }
        const unsigned short zc = zr;
        __syncthreads();
        if (r + 1 < R) load_raw(r + 1);
        for (int t0 = 0; t0 < nv; t0 += 4) {
#pragma unroll
            for (int tt = 0; tt < 4; ++tt) {
                const int t = t0 + tt;
                const f32x4 q4 = *(const f32x4*)(qs + t * 128 + kb);
                f32x4 k4 = *(const f32x4*)(ks + t * 128 + kb);
                const VT v4 = *(const VT*)(vs + t * VW + NV * vq);
                f32x4 a4;
                if constexpr (TYPE == 0) { const f32x2 adv = *(const f32x2*)(ad + 2 * t); a4 = (f32x4){adv.x, adv.x, adv.x, adv.x}; k4 = k4 * adv.y; }
                else if constexpr (TYPE == 1) a4 = (f32x4){gamma, gamma, gamma, gamma};
                else a4 = *(const f32x4*)(as + t * 128 + kb);
                VT o = (VT)(0.f);
#pragma unroll
                for (int i = 0; i < 4; ++i) { S[i] = a4[i] * S[i] + k4[i] * v4; o += q4[i] * S[i]; }
                *(VT*)(part + ((t * 32 + w * 4 + kg) * VW + NV * vq)) = o;
            }
        }
        __syncthreads();
        const int rt = tid / VW, rv = tid % VW;
        if (tid < 8 * VW && rt < nv) {
            float o = 0.f;
#pragma unroll
            for (int pp = 0; pp < 32; ++pp) o += part[(rt * 32 + pp) * VW + rv];
            const size_t trow = (size_t)(8 * r + rt);
            if constexpr (TYPE == 0) {
                const float y = (o + Dh * vs[rt * 64 + rv]) * silu(bf2f(zc));
                yz[trow * 4096 + h * 64 + rv] = f2bf(y);
            } else if constexpr (TYPE == 1) {
                yz[trow * 4096 + 2048 + h * 256 + s * VW + rv] = f2bf(o);
            } else {
                yz[trow * 4096 + h * 128 + s * VW + rv] = f2bf(o);
            }
        }
    }
#pragma unroll
    for (int i = 0; i < 4; ++i) *(VT*)(Sout + (size_t)(kb + i) * ldS + NV * vq) = S[i];
}

template <int TYPE>
__device__ __forceinline__ void dec_unit(const Params& p, float* ldsf, int b, int u) {
    int tid = threadIdx.x; asm volatile("" : "+v"(tid));
    const int w = tid >> 6, lane = tid & 63, kg = lane >> 4, vq = lane & 15;
    const int row0 = MP + 4 * b;
    constexpr int LDP = TYPE < 2 ? LD0 : LD1;
    const bf16_t* proj = (const bf16_t*)(p.ws + WS_PROJ) + (size_t)row0 * LDP;
    bf16_t* yz = (bf16_t*)(p.ws + WS_YZ) + (size_t)row0 * 4096;
    int h, sl; size_t soff; int ldS;
    if constexpr (TYPE == 0) { h = 8 * u + w; sl = 0; ldS = 64; soff = ((size_t)(b * 32 + h) * 128) * 64; }
    else if constexpr (TYPE == 1) { h = 2 * u + (w >> 2); sl = w & 3; ldS = 256; soff = ((size_t)(b * 8 + h) * 128) * 256 + sl * 64; }
    else { h = 4 * u + (w >> 1); sl = w & 1; ldS = 128; soff = ((size_t)(b * 16 + h) * 128) * 128 + sl * 64; }
    const float* S0 = (TYPE == 0 ? p.in[2 + p.z] : (TYPE == 1 ? p.in[4 + p.z] : p.in[5 + p.z])) + soff + (size_t)(32 * kg) * ldS + 4 * vq;
    float* Sout = p.out + (TYPE == 0 ? O_SSMS : (TYPE == 1 ? O_RETS : O_HGS)) + soff + (size_t)(32 * kg) * ldS + 4 * vq;
    if constexpr (TYPE == 0) {
        float* qs = ldsf; float* ks = ldsf + 512; float* xs = ldsf + 1024; float* zs = ldsf + 3072; float* ad = ldsf + 5120;
        unsigned short xr[2][4]; float cw[2][4], cb[2], st[2][3]; unsigned short zr[4]; unsigned short dr = 0;
#pragma unroll
        for (int q = 0; q < 2; ++q) {
            const int idx = tid + 512 * q;
            if (idx < 768) {
                const int ch = idx < 128 ? 2560 + u * 128 + idx : (idx < 256 ? 2048 + u * 128 + (idx - 128) : u * 512 + (idx - 256));
#pragma unroll
                for (int t = 0; t < 4; ++t) xr[q][t] = proj[(size_t)t * LDP + 2048 + ch];
#pragma unroll
                for (int j = 0; j < 4; ++j) cw[q][j] = p.in[13 + p.z][j * 3072 + ch];
                cb[q] = p.in[14 + p.z][ch];
#pragma unroll
                for (int j = 0; j < 3; ++j) st[q][j] = p.in[3 + p.z][((size_t)b * 3 + j) * 3072 + ch];
            }
        }
#pragma unroll
        for (int t = 0; t < 4; ++t) zr[t] = proj[(size_t)t * LDP + u * 512 + tid];
        if (tid < 32) dr = proj[(size_t)(tid >> 3) * LDP + 5120 + 8 * u + (tid & 7)];
        f32x4 S[32];
#pragma unroll
        for (int i = 0; i < 32; ++i) S[i] = *(const f32x4*)(S0 + (size_t)i * ldS);
#pragma unroll
        for (int q = 0; q < 2; ++q) {
            const int idx = tid + 512 * q;
            if (idx < 768) {
                float* dst = idx < 128 ? qs + idx : (idx < 256 ? ks + (idx - 128) : xs + (idx - 256));
                const int dstr = idx < 256 ? 128 : 512;
                float c0 = st[q][0], c1 = st[q][1], c2 = st[q][2];
#pragma unroll
                for (int t = 0; t < 4; ++t) {
                    const float x = bf2f(xr[q][t]);
                    const float y = cb[q] + cw[q][0] * c0 + cw[q][1] * c1 + cw[q][2] * c2 + cw[q][3] * x;
                    c0 = c1; c1 = c2; c2 = x;
                    dst[t * dstr] = silu(y);
                }
            }
        }
#pragma unroll
        for (int t = 0; t < 4; ++t) zs[t * 512 + tid] = silu(bf2f(zr[t]));
        if (tid < 32) {
            const int hh = 8 * u + (tid & 7);
            const float dt = softplus(bf2f(dr) + p.in[15 + p.z][hh]);
            ad[2 * tid] = __expf(-dt * __expf(p.in[16 + p.z][hh])); ad[2 * tid + 1] = dt;
        }
        __syncthreads();
        const float Dh = p.in[17 + p.z][h];
#pragma unroll 1
        for (int t = 0; t < 4; ++t) {
            const f32x2 adv = *(const f32x2*)(ad + 2 * (t * 8 + w));
            const f32x4 v4 = *(const f32x4*)(xs + t * 512 + w * 64 + 4 * vq);
            f32x4 o = (f32x4){0.f, 0.f, 0.f, 0.f};
#pragma unroll
            for (int i4 = 0; i4 < 8; ++i4) {
                const f32x4 q4 = *(const f32x4*)(qs + t * 128 + 32 * kg + 4 * i4);
                const f32x4 k4 = *(const f32x4*)(ks + t * 128 + 32 * kg + 4 * i4) * adv.y;
#pragma unroll
                for (int ii = 0; ii < 4; ++ii) { S[4 * i4 + ii] = adv.x * S[4 * i4 + ii] + k4[ii] * v4; o += q4[ii] * S[4 * i4 + ii]; }
            }
#pragma unroll
            for (int j = 0; j < 4; ++j) { o[j] += __shfl_xor(o[j], 16); o[j] += __shfl_xor(o[j], 32); }
            if (kg == 0) {
                const f32x4 z4 = *(const f32x4*)(zs + t * 512 + w * 64 + 4 * vq);
                const f32x4 y = (o + Dh * v4) * z4;
                u32x2 ov; ov.x = pk2(y[0], y[1]); ov.y = pk2(y[2], y[3]);
                *(u32x2*)(yz + (size_t)t * 4096 + h * 64 + 4 * vq) = ov;
            }
        }
#pragma unroll
        for (int i = 0; i < 32; ++i) *(f32x4*)(Sout + (size_t)i * ldS) = S[i];
    } else if constexpr (TYPE == 1) {
        float* qs = ldsf; float* ks = ldsf + 1024; float* vs = ldsf + 2048;
        unsigned short x1[4], x2[4], vr[4];
        const int hl = tid >> 7, isk = (tid >> 6) & 1, jf = tid & 63;
        if (tid < 256) {
            const int col = (isk ? 6176 : 5152) + (2 * u + hl) * 128 + jf;
#pragma unroll
            for (int t = 0; t < 4; ++t) { x1[t] = proj[(size_t)t * LDP + col]; x2[t] = proj[(size_t)t * LDP + col + 64]; }
        }
#pragma unroll
        for (int t = 0; t < 4; ++t) vr[t] = proj[(size_t)t * LDP + 7200 + (2 * u + (tid >> 8)) * 256 + (tid & 255)];
        f32x4 S[32];
#pragma unroll
        for (int i = 0; i < 32; ++i) S[i] = *(const f32x4*)(S0 + (size_t)i * ldS);
        if (tid < 256) {
            const float inv = exp2f(-(float)jf * 0.20762050593046014f);
            float* dst = isk ? ks : qs; const float sc = isk ? 0.08838834764831845f : 1.0f;
#pragma unroll
            for (int t = 0; t < 4; ++t) {
                const double rev = (double)(16384 + t) * (double)inv * 0.15915494309189535;
                const float fr = (float)(rev - floor(rev));
                const float sn = __builtin_amdgcn_sinf(fr), cs = __builtin_amdgcn_cosf(fr);
                const float a1 = bf2f(x1[t]) * sc, a2 = bf2f(x2[t]) * sc;
                dst[(t * 2 + hl) * 128 + jf] = a1 * cs - a2 * sn;
                dst[(t * 2 + hl) * 128 + 64 + jf] = a1 * sn + a2 * cs;
            }
        }
#pragma unroll
        for (int t = 0; t < 4; ++t) vs[(t * 2 + (tid >> 8)) * 256 + (tid & 255)] = bf2f(vr[t]);
        __syncthreads();
        const float gamma = 1.0f - exp2f(-5.0f - (float)h * (4.0f / 7.0f));
        const int hw = w >> 2;
#pragma unroll 1
        for (int t = 0; t < 4; ++t) {
            const f32x4 v4 = *(const f32x4*)(vs + (t * 2 + hw) * 256 + sl * 64 + 4 * vq);
            f32x4 o = (f32x4){0.f, 0.f, 0.f, 0.f};
#pragma unroll
            for (int i4 = 0; i4 < 8; ++i4) {
                const f32x4 q4 = *(const f32x4*)(qs + (t * 2 + hw) * 128 + 32 * kg + 4 * i4);
                const f32x4 k4 = *(const f32x4*)(ks + (t * 2 + hw) * 128 + 32 * kg + 4 * i4);
#pragma unroll
                for (int ii = 0; ii < 4; ++ii) { S[4 * i4 + ii] = gamma * S[4 * i4 + ii] + k4[ii] * v4; o += q4[ii] * S[4 * i4 + ii]; }
            }
#pragma unroll
            for (int j = 0; j < 4; ++j) { o[j] += __shfl_xor(o[j], 16); o[j] += __shfl_xor(o[j], 32); }
            if (kg == 0) {
                u32x2 ov; ov.x = pk2(o[0], o[1]); ov.y = pk2(o[2], o[3]);
                *(u32x2*)(yz + (size_t)t * 4096 + 2048 + h * 256 + sl * 64 + 4 * vq) = ov;
            }
        }
#pragma unroll
        for (int i = 0; i < 32; ++i) *(f32x4*)(Sout + (size_t)i * ldS) = S[i];
    } else {
        float* qs = ldsf; float* ks = ldsf + 2048; float* as = ldsf + 4096; float* vs = ldsf + 6144;
        unsigned short qr[4], fr_[4], vr[4];
        const int hl = tid >> 7, kk = tid & 127, col = (4 * u + hl) * 128 + kk;
#pragma unroll
        for (int t = 0; t < 4; ++t) { qr[t] = proj[(size_t)t * LDP + col]; fr_[t] = proj[(size_t)t * LDP + 2048 + col]; vr[t] = proj[(size_t)t * LDP + 4096 + col]; }
        const float lb = ((const float*)(p.ws + WS_LB))[col];
        f32x4 S[32];
#pragma unroll
        for (int i = 0; i < 32; ++i) S[i] = *(const f32x4*)(S0 + (size_t)i * ldS);
#pragma unroll
        for (int t = 0; t < 4; ++t) {
            const int o = (t * 4 + hl) * 128 + kk;
            qs[o] = silu(bf2f(qr[t]));
            const float f = lb + (1.0f - lb) * sigm(bf2f(fr_[t]));
            as[o] = f; ks[o] = 1.0f - f; vs[o] = bf2f(vr[t]);
        }
        __syncthreads();
        const int hw = w >> 1;
#pragma unroll 1
        for (int t = 0; t < 4; ++t) {
            const f32x4 v4 = *(const f32x4*)(vs + (t * 4 + hw) * 128 + sl * 64 + 4 * vq);
            f32x4 o = (f32x4){0.f, 0.f, 0.f, 0.f};
#pragma unroll
            for (int i4 = 0; i4 < 8; ++i4) {
                const int off = (t * 4 + hw) * 128 + 32 * kg + 4 * i4;
                const f32x4 q4 = *(const f32x4*)(qs + off), k4 = *(const f32x4*)(ks + off), a4 = *(const f32x4*)(as + off);
#pragma unroll
                for (int ii = 0; ii < 4; ++ii) { S[4 * i4 + ii] = a4[ii] * S[4 * i4 + ii] + k4[ii] * v4; o += q4[ii] * S[4 * i4 + ii]; }
            }
#pragma unroll
            for (int j = 0; j < 4; ++j) { o[j] += __shfl_xor(o[j], 16); o[j] += __shfl_xor(o[j], 32); }
            if (kg == 0) {
                u32x2 ov; ov.x = pk2(o[0], o[1]); ov.y = pk2(o[2], o[3]);
                *(u32x2*)(yz + (size_t)t * 4096 + h * 128 + sl * 64 + 4 * vq) = ov;
            }
        }
#pragma unroll
        for (int i = 0; i < 32; ++i) *(f32x4*)(Sout + (size_t)i * ldS) = S[i];
    }
}

#define CK_QS 0
#define CK_KS 17408
#define CK_KT 34816
#define CK_VT 53248
#define CK_PS 62464
#define CK_ST 71680
#define CK_CUM 89088
__device__ __forceinline__ bf16x8 ck_frag(const unsigned char* lds, int base, int pitch, int row, int kb, int q) {
    return *(const bf16x8*)(lds + base + row * pitch + (32 * kb + 8 * q) * 2);
}
template <int TYPE>
__device__ __forceinline__ void chunk_item(const Params& p, unsigned char* lds, int b, int h, int s) {
    int tid = threadIdx.x; asm volatile("" : "+v"(tid));
    const int w = tid >> 6, lane = tid & 63, r = lane & 15, q = lane >> 4;
    const bf16_t* proj = (const bf16_t*)(p.ws + WS_PROJ) + (size_t)(2048 * b) * LD0;
    bf16_t* yz = (bf16_t*)(p.ws + WS_YZ) + (size_t)(2048 * b) * 4096;
    const int I = w >> 1, Vn0 = 2 * (w & 1);
    const int c1 = tid & 127, tq = tid >> 7;
    const int cx = tid & 63, tx = tid >> 6;
    const int g = h >> 3;
    float cwC[4], cwB[4], cwX[4], cbC = 0.f, cbB = 0.f, cbX = 0.f, inv = 0.f, dtb = 0.f, Aneg = 0.f, Dh = 0.f;
    int colC = 0, colB = 0, colX = 0;
    if constexpr (TYPE == 0) {
        const int chC = 2560 + g * 128 + c1, chB = 2048 + g * 128 + c1, chX = h * 64 + cx;
        colC = 2048 + chC; colB = 2048 + chB; colX = 2048 + chX;
#pragma unroll
        for (int j = 0; j < 4; ++j) { cwC[j] = p.in[13 + p.z][j * 3072 + chC]; cwB[j] = p.in[13 + p.z][j * 3072 + chB]; cwX[j] = p.in[13 + p.z][j * 3072 + chX]; }
        cbC = p.in[14 + p.z][chC]; cbB = p.in[14 + p.z][chB]; cbX = p.in[14 + p.z][chX];
        dtb = p.in[15 + p.z][h]; Aneg = -__expf(p.in[16 + p.z][h]); Dh = p.in[17 + p.z][h];
    } else {
        const int isk = c1 >> 6, jf = c1 & 63;
        colC = (isk ? 6176 : 5152) + h * 128 + jf; colB = colC + 64; colX = 7200 + h * 256 + s * 64 + cx;
        inv = exp2f(-(float)jf * 0.20762050593046014f);
    }
    float* cumb = (float*)(lds + CK_CUM);
    if constexpr (TYPE == 1) {
        const float lg = __logf(1.0f - exp2f(-5.0f - (float)h * (4.0f / 7.0f)));
        if (tid < 64) {
#pragma unroll
            for (int bfi = 0; bfi < 2; ++bfi) { float* cb = cumb + bfi * 320; cb[tid] = (tid + 1) * lg; cb[64 + tid] = __expf((tid + 1) * lg); cb[128 + tid] = __expf((63 - tid) * lg); cb[192 + tid] = 1.0f; if (tid == 0) cb[256] = __expf(64.0f * lg); }
        }
    }
    for (int i = tid; i < 17408 / 4; i += 512) ((unsigned*)(lds + CK_ST))[i] = 0u;
    f32x4 Sacc[4];
#pragma unroll
    for (int i = 0; i < 4; ++i) Sacc[i] = (f32x4){0.f, 0.f, 0.f, 0.f};
    unsigned short xc[19], xb[19], xx[11], zr[8], dr = 0;
    auto load_raw = [&](int c) {
        const int t0 = 64 * c;
        if constexpr (TYPE == 0) {
#pragma unroll
            for (int i = 0; i < 19; ++i) { const int t = t0 + 16 * tq - 3 + i; xc[i] = 0; xb[i] = 0; if (t >= 0) { xc[i] = proj[(size_t)t * LD0 + colC]; xb[i] = proj[(size_t)t * LD0 + colB]; } }
#pragma unroll
            for (int i = 0; i < 11; ++i) { const int t = t0 + 8 * tx - 3 + i; xx[i] = 0; if (t >= 0) xx[i] = proj[(size_t)t * LD0 + colX]; }
            if (w == 7) dr = proj[(size_t)(t0 + lane) * LD0 + 5120 + h];
#pragma unroll
            for (int vv = 0; vv < 2; ++vv)
#pragma unroll
                for (int jx = 0; jx < 4; ++jx) zr[vv * 4 + jx] = proj[(size_t)(t0 + 16 * I + 4 * q + jx) * LD0 + h * 64 + 16 * (Vn0 + vv) + r];
        } else {
#pragma unroll
            for (int i = 0; i < 16; ++i) { const int t = t0 + 16 * tq + i; xc[i] = proj[(size_t)t * LD0 + colC]; xb[i] = proj[(size_t)t * LD0 + colB]; }
#pragma unroll
            for (int i = 0; i < 8; ++i) xx[i] = proj[(size_t)(t0 + 8 * tx + i) * LD0 + colX];
        }
    };
    load_raw(0);
    for (int c = 0; c < 32; ++c) {
        const int t0 = 64 * c;
        float* cum = cumb + (TYPE == 0 ? (c & 1) * 320 : 0);
        float vq_[16], vk_[16], vx_[8];
        if constexpr (TYPE == 0) {
#pragma unroll
            for (int i = 0; i < 16; ++i) {
                vq_[i] = silu(cbC + cwC[0] * bf2f(xc[i]) + cwC[1] * bf2f(xc[i + 1]) + cwC[2] * bf2f(xc[i + 2]) + cwC[3] * bf2f(xc[i + 3]));
                vk_[i] = silu(cbB + cwB[0] * bf2f(xb[i]) + cwB[1] * bf2f(xb[i + 1]) + cwB[2] * bf2f(xb[i + 2]) + cwB[3] * bf2f(xb[i + 3]));
            }
#pragma unroll
            for (int i = 0; i < 8; ++i) vx_[i] = silu(cbX + cwX[0] * bf2f(xx[i]) + cwX[1] * bf2f(xx[i + 1]) + cwX[2] * bf2f(xx[i + 2]) + cwX[3] * bf2f(xx[i + 3]));
            if (w == 7) {
                const float dt = softplus(bf2f(dr) + dtb);
                float cs = dt * Aneg;
#pragma unroll
                for (int o = 1; o < 64; o <<= 1) { const float t = __shfl_up(cs, o); if (lane >= o) cs += t; }
                const float last = __shfl(cs, 63);
                cum[lane] = cs; cum[64 + lane] = __expf(cs); cum[128 + lane] = __expf(last - cs); cum[192 + lane] = dt;
                if (lane == 0) cum[256] = __expf(last);
            }
        } else {
#pragma unroll
            for (int i = 0; i < 16; ++i) {
                const double rev = (double)(t0 + 16 * tq + i) * (double)inv * 0.15915494309189535;
                const float fr = (float)(rev - floor(rev));
                const float sn = __builtin_amdgcn_sinf(fr), cs = __builtin_amdgcn_cosf(fr);
                const float a1 = bf2f(xc[i]), a2 = bf2f(xb[i]);
                vq_[i] = a1 * cs - a2 * sn; vk_[i] = a1 * sn + a2 * cs;
            }
#pragma unroll
            for (int i = 0; i < 8; ++i) vx_[i] = bf2f(xx[i]);
        }
        unsigned short zc[8];
#pragma unroll
        for (int i = 0; i < 8; ++i) zc[i] = zr[i];
        __syncthreads();
        if constexpr (TYPE == 0) {
            unsigned kt[8];
#pragma unroll
            for (int i = 0; i < 16; i += 2) {
                const int t = 16 * tq + i;
                const float k0 = vk_[i] * cum[192 + t], k1 = vk_[i + 1] * cum[192 + t + 1];
                *(bf16_t*)(lds + CK_QS + t * 272 + c1 * 2) = f2bf(vq_[i]); *(bf16_t*)(lds + CK_QS + (t + 1) * 272 + c1 * 2) = f2bf(vq_[i + 1]);
                *(bf16_t*)(lds + CK_KS + t * 272 + c1 * 2) = f2bf(k0); *(bf16_t*)(lds + CK_KS + (t + 1) * 272 + c1 * 2) = f2bf(k1);
                kt[i >> 1] = pk2(k0 * cum[128 + t], k1 * cum[128 + t + 1]);
            }
            *(u32x4*)(lds + CK_KT + c1 * 144 + 32 * tq) = (u32x4){kt[0], kt[1], kt[2], kt[3]};
            *(u32x4*)(lds + CK_KT + c1 * 144 + 32 * tq + 16) = (u32x4){kt[4], kt[5], kt[6], kt[7]};
        } else {
            const int isk = c1 >> 6, jf = c1 & 63;
            if (isk == 0) {
#pragma unroll
                for (int i = 0; i < 16; ++i) { const int t = 16 * tq + i; *(bf16_t*)(lds + CK_QS + t * 272 + jf * 2) = f2bf(vq_[i]); *(bf16_t*)(lds + CK_QS + t * 272 + (jf + 64) * 2) = f2bf(vk_[i]); }
            } else {
                unsigned kta[8], ktb[8];
#pragma unroll
                for (int i = 0; i < 16; i += 2) {
                    const int t = 16 * tq + i;
                    const float a0 = vq_[i] * 0.08838834764831845f, a1 = vq_[i + 1] * 0.08838834764831845f, b0 = vk_[i] * 0.08838834764831845f, b1 = vk_[i + 1] * 0.08838834764831845f;
                    *(bf16_t*)(lds + CK_KS + t * 272 + jf * 2) = f2bf(a0); *(bf16_t*)(lds + CK_KS + (t + 1) * 272 + jf * 2) = f2bf(a1);
                    *(bf16_t*)(lds + CK_KS + t * 272 + (jf + 64) * 2) = f2bf(b0); *(bf16_t*)(lds + CK_KS + (t + 1) * 272 + (jf + 64) * 2) = f2bf(b1);
                    kta[i >> 1] = pk2(a0 * cum[128 + t], a1 * cum[128 + t + 1]); ktb[i >> 1] = pk2(b0 * cum[128 + t], b1 * cum[128 + t + 1]);
                }
                *(u32x4*)(lds + CK_KT + jf * 144 + 32 * tq) = (u32x4){kta[0], kta[1], kta[2], kta[3]};
                *(u32x4*)(lds + CK_KT + jf * 144 + 32 * tq + 16) = (u32x4){kta[4], kta[5], kta[6], kta[7]};
                *(u32x4*)(lds + CK_KT + (jf + 64) * 144 + 32 * tq) = (u32x4){ktb[0], ktb[1], ktb[2], ktb[3]};
                *(u32x4*)(lds + CK_KT + (jf + 64) * 144 + 32 * tq + 16) = (u32x4){ktb[4], ktb[5], ktb[6], ktb[7]};
            }
        }
        *(u32x4*)(lds + CK_VT + cx * 144 + 16 * tx) = (u32x4){pk2(vx_[0], vx_[1]), pk2(vx_[2], vx_[3]), pk2(vx_[4], vx_[5]), pk2(vx_[6], vx_[7])};
        __syncthreads();
        if (c + 1 < 32) load_raw(c + 1);
        bf16x8 aQ[4];
#pragma unroll
        for (int kb = 0; kb < 4; ++kb) aQ[kb] = ck_frag(lds, CK_QS, 272, 16 * I + r, kb, q);
        float cumi[4];
#pragma unroll
        for (int jx = 0; jx < 4; ++jx) cumi[jx] = cum[16 * I + 4 * q + jx];
#pragma unroll
        for (int jj = 0; jj < 2; ++jj) {
            const int J = Vn0 + jj;
            f32x4 acc = (f32x4){0.f, 0.f, 0.f, 0.f};
#pragma unroll
            for (int kb = 0; kb < 4; ++kb) acc = __builtin_amdgcn_mfma_f32_16x16x32_bf16(aQ[kb], ck_frag(lds, CK_KS, 272, 16 * J + r, kb, q), acc, 0, 0, 0);
            const int jcol = 16 * J + r; const float cumj = cum[jcol];
#pragma unroll
            for (int jx = 0; jx < 4; ++jx) {
                const int i = 16 * I + 4 * q + jx;
                const float v = (jcol <= i) ? acc[jx] * __expf(fminf(cumi[jx] - cumj, 0.f)) : 0.f;
                *(bf16_t*)(lds + CK_PS + i * 144 + jcol * 2) = f2bf(v);
            }
        }
        __syncthreads();
#pragma unroll
        for (int vv = 0; vv < 2; ++vv) {
            const int Vn = Vn0 + vv;
            f32x4 aPV = (f32x4){0.f, 0.f, 0.f, 0.f}, aQS = (f32x4){0.f, 0.f, 0.f, 0.f};
#pragma unroll
            for (int jb = 0; jb < 2; ++jb) aPV = __builtin_amdgcn_mfma_f32_16x16x32_bf16(ck_frag(lds, CK_PS, 144, 16 * I + r, jb, q), ck_frag(lds, CK_VT, 144, 16 * Vn + r, jb, q), aPV, 0, 0, 0);
#pragma unroll
            for (int kb = 0; kb < 4; ++kb) aQS = __builtin_amdgcn_mfma_f32_16x16x32_bf16(aQ[kb], ck_frag(lds, CK_ST, 272, 16 * Vn + r, kb, q), aQS, 0, 0, 0);
#pragma unroll
            for (int jx = 0; jx < 4; ++jx) {
                const int i = 16 * I + 4 * q + jx, v = 16 * Vn + r;
                const float o = aPV[jx] + cum[64 + i] * aQS[jx];
                if constexpr (TYPE == 0) {
                    const float xsv = bf2f(*(const bf16_t*)(lds + CK_VT + v * 144 + i * 2));
                    yz[(size_t)(t0 + i) * 4096 + h * 64 + v] = f2bf((o + Dh * xsv) * silu(bf2f(zc[vv * 4 + jx])));
                } else {
                    yz[(size_t)(t0 + i) * 4096 + 2048 + h * 256 + s * 64 + v] = f2bf(o);
                }
            }
        }
        __syncthreads();
        const float elast = cum[256];
#pragma unroll
        for (int Vn = 0; Vn < 4; ++Vn) {
            Sacc[Vn] = Sacc[Vn] * elast;
#pragma unroll
            for (int tb = 0; tb < 2; ++tb) Sacc[Vn] = __builtin_amdgcn_mfma_f32_16x16x32_bf16(ck_frag(lds, CK_KT, 144, 16 * w + r, tb, q), ck_frag(lds, CK_VT, 144, 16 * Vn + r, tb, q), Sacc[Vn], 0, 0, 0);
            *(u32x2*)(lds + CK_ST + (16 * Vn + r) * 272 + (16 * w + 4 * q) * 2) = (u32x2){pk2_sw(Sacc[Vn][0], Sacc[Vn][1]), pk2_sw(Sacc[Vn][2], Sacc[Vn][3])};
        }
    }
    const int ldS = TYPE == 0 ? 64 : 256;
    float* Sout = p.out + (TYPE == 0 ? O_SSMP + ((size_t)(b * 32 + h) * 128) * 64 : O_RETP + ((size_t)(b * 8 + h) * 128) * 256 + s * 64);
#pragma unroll
    for (int Vn = 0; Vn < 4; ++Vn)
#pragma unroll
        for (int jx = 0; jx < 4; ++jx) Sout[(size_t)(16 * w + 4 * q + jx) * ldS + 16 * Vn + r] = Sacc[Vn][jx];
}

__device__ __forceinline__ void lru_dec_unit(const Params& p, int b) {
    int tid = threadIdx.x; asm volatile("" : "+v"(tid));
    const int c = tid * 4;
    const int row0 = MP + 4 * b;
    const float* LA = (const float*)(p.ws + WS_LA) + (size_t)row0 * 2048 + c;
    const bf16_t* LBv = (const bf16_t*)(p.ws + WS_LBB) + (size_t)row0 * 2048 + c;
    const bf16_t* rg = (const bf16_t*)(p.ws + WS_PROJ) + (size_t)row0 * LD1 + 10240 + c;
    bf16_t* mixa = (bf16_t*)(p.ws + WS_ACT) + (size_t)row0 * 4096 + 2048 + c;
    f32x4 hst = *(const f32x4*)(p.in[6 + p.z] + (size_t)b * 2048 + c);
#pragma unroll
    for (int t = 0; t < 4; ++t) {
        const f32x4 a = *(const f32x4*)(LA + (size_t)t * 2048);
        float bb[4], gg[4]; unpack4(*(const u32x2*)(LBv + (size_t)t * 2048), bb); unpack4(*(const u32x2*)(rg + (size_t)t * LD1), gg);
        float y[4];
#pragma unroll
        for (int j = 0; j < 4; ++j) { hst[j] = a[j] * hst[j] + bb[j]; y[j] = hst[j] * gelu_tanh(gg[j]); }
        u32x2 ov; ov.x = pk2(y[0], y[1]); ov.y = pk2(y[2], y[3]);
        *(u32x2*)(mixa + (size_t)t * 4096) = ov;
    }
    *(f32x4*)(p.out + O_LRUS + (size_t)b * 2048 + c) = hst;
}

__device__ __forceinline__ void lru_scan_item(const Params& p, float* ldsf, int b, int cg) {
    int tid = threadIdx.x; asm volatile("" : "+v"(tid));
    const int w = tid >> 6, lane = tid & 63, c = cg * 64 + lane;
    const size_t row0 = (size_t)2048 * b + 256 * w;
    const float* LA = (const float*)(p.ws + WS_LA) + row0 * 2048 + c;
    const bf16_t* LBv = (const bf16_t*)(p.ws + WS_LBB) + row0 * 2048 + c;
    const bf16_t* rg = (const bf16_t*)(p.ws + WS_PROJ) + row0 * LD1 + 10240 + c;
    bf16_t* mixa = (bf16_t*)(p.ws + WS_ACT) + row0 * 4096 + 2048 + c;
    float hl = 0.f, pr = 1.f;
    for (int tb = 0; tb < 256; tb += 16) {
        float a0[16]; unsigned short b0[16];
#pragma unroll
        for (int t = 0; t < 16; ++t) { a0[t] = LA[(size_t)(tb + t) * 2048]; b0[t] = LBv[(size_t)(tb + t) * 2048]; }
#pragma unroll
        for (int t = 0; t < 16; ++t) { hl = a0[t] * hl + bf2f(b0[t]); pr *= a0[t]; }
    }
    ldsf[w * 128 + lane] = pr; ldsf[w * 128 + 64 + lane] = hl;
    __syncthreads();
    float hst = 0.f;
    for (int ww = 0; ww < w; ++ww) hst = ldsf[ww * 128 + lane] * hst + ldsf[ww * 128 + 64 + lane];
    for (int tb = 0; tb < 256; tb += 16) {
        float a0[16]; unsigned short b0[16], g0[16];
#pragma unroll
        for (int t = 0; t < 16; ++t) { a0[t] = LA[(size_t)(tb + t) * 2048]; b0[t] = LBv[(size_t)(tb + t) * 2048]; g0[t] = rg[(size_t)(tb + t) * LD1]; }
#pragma unroll
        for (int t = 0; t < 16; ++t) {
            hst = a0[t] * hst + bf2f(b0[t]);
            mixa[(size_t)(tb + t) * 4096] = f2bf(hst * gelu_tanh(bf2f(g0[t])));
        }
    }
    if (w == 7) p.out[O_LRUP + (size_t)b * 2048 + c] = hst;
}

__device__ __forceinline__ void phase_rec0(const Params& p, float* ldsf) {
    unsigned* ctr = (unsigned*)(p.ws + WS_CTL);
    const int total = 256 + 512 + 512;
    for (;;) {
        const int it = next_item(ctr, ldsf);
        if (it >= total) break;
        if (it < 128) chunk_item<0>(p, (unsigned char*)ldsf, it >> 5, it & 31, 0);
        else if (it < 256) { const int j = it - 128; chunk_item<1>(p, (unsigned char*)ldsf, j >> 5, (j & 31) >> 2, j & 3); }
        else if (it < 768) { const int j = it - 256; dec_unit<0>(p, ldsf, j >> 2, j & 3); }
        else { const int j = it - 768; dec_unit<1>(p, ldsf, j >> 2, j & 3); }
    }
}
__device__ __forceinline__ void phase_rec1(const Params& p, float* ldsf) {
    unsigned* ctr = (unsigned*)(p.ws + WS_CTL) + 64;
    const int total = 128 + 128 + 512 + 128;
    for (;;) {
        const int it = next_item(ctr, ldsf);
        if (it >= total) break;
        if (it < 128) rec_item<2, 64>(p, ldsf, 0, it >> 5, (it & 31) >> 1, it & 1);
        else if (it < 256) { const int j = it - 128; lru_scan_item(p, ldsf, j >> 5, j & 31); }
        else if (it < 768) { const int j = it - 256; dec_unit<2>(p, ldsf, j >> 2, j & 3); }
        else lru_dec_unit(p, it - 768);
    }
}

__device__ __forceinline__ void seq_of_row(int row, int& sample, int& b, int& t, int& L) {
    if (row < MP) { sample = 0; b = row >> 11; t = row & 2047; L = 2048; } else { sample = 1; b = (row - MP) >> 2; t = (row - MP) & 3; L = 4; }
}

__device__ __forceinline__ void phase_prep0(const Params& p) {
    int tid = threadIdx.x; asm volatile("" : "+v"(tid));
    const int wave = tid >> 6, lane = tid & 63;
    const int gw = blockIdx.x * 8 + wave, NGW = gridDim.x * 8;
    const bf16_t* YZ = (const bf16_t*)(p.ws + WS_YZ); const bf16_t* PR = (const bf16_t*)(p.ws + WS_PROJ);
    bf16_t* MX = (bf16_t*)(p.ws + WS_ACT);
    const float* nw = p.in[18 + p.z];
    for (int row = gw; row < MT; row += NGW) {
        const bf16_t* yz = YZ + (size_t)row * 4096; bf16_t* mx = MX + (size_t)row * 4096;
#pragma unroll 1
        for (int g = 0; g < 4; ++g) {
            const int c = g * 512 + lane * 8;
            float v[8]; unpack8(*(const u32x4*)(yz + c), v);
            float s = 0.f;
#pragma unroll
            for (int j = 0; j < 8; ++j) s += v[j] * v[j];
            s = wave_sum(s);
            const float rs = rsqrtf(s * (1.0f / 512.0f) + EPS);
            const f32x4 n0 = *(const f32x4*)(nw + c), n1 = *(const f32x4*)(nw + c + 4);
            u32x4 o; o.x = pk2(v[0] * rs * n0[0], v[1] * rs * n0[1]); o.y = pk2(v[2] * rs * n0[2], v[3] * rs * n0[3]);
            o.z = pk2(v[4] * rs * n1[0], v[5] * rs * n1[1]); o.w = pk2(v[6] * rs * n1[2], v[7] * rs * n1[3]);
            *(u32x4*)(mx + c) = o;
        }
#pragma unroll 2
        for (int hh = 0; hh < 8; ++hh) {
            const int c = hh * 256 + lane * 4;
            float v[4]; unpack4(*(const u32x2*)(yz + 2048 + c), v);
            float gt[4]; unpack4(*(const u32x2*)(PR + (size_t)row * LD0 + 9248 + c), gt);
            float s = (v[0] * v[0] + v[1] * v[1]) + (v[2] * v[2] + v[3] * v[3]);
            s = wave_sum(s);
            const float rs = rsqrtf(s * (1.0f / 256.0f) + EPS);
            u32x2 o; o.x = pk2(v[0] * rs * silu(gt[0]), v[1] * rs * silu(gt[1])); o.y = pk2(v[2] * rs * silu(gt[2]), v[3] * rs * silu(gt[3]));
            *(u32x2*)(mx + 2048 + c) = o;
        }
        int sample, b, t, L; seq_of_row(row, sample, b, t, L);
        if (t >= L - 3) {
            float* dst = p.out + (sample ? O_SCS : O_SCP) + ((size_t)b * 3 + (t - (L - 3))) * 3072;
            const bf16_t* src = PR + (size_t)row * LD0 + 2048;
#pragma unroll 4
            for (int c = lane; c < 3072; c += 64) dst[c] = bf2f(src[c]);
        }
    }
}

__device__ __forceinline__ void phase_prep1(const Params& p) {
    int tid = threadIdx.x; asm volatile("" : "+v"(tid));
    const int wave = tid >> 6, lane = tid & 63;
    const int gw = blockIdx.x * 8 + wave, NGW = gridDim.x * 8;
    const bf16_t* YZ = (const bf16_t*)(p.ws + WS_YZ); const bf16_t* PR = (const bf16_t*)(p.ws + WS_PROJ);
    bf16_t* MX = (bf16_t*)(p.ws + WS_ACT);
    const float* nw = p.in[22 + p.z];
    for (int row = gw; row < MT; row += NGW) {
#pragma unroll 1
        for (int it = 0; it < 4; ++it) {
            const int c = it * 512 + lane * 8;
            float v[8]; unpack8(*(const u32x4*)(YZ + (size_t)row * 4096 + c), v);
            float gt[8]; unpack8(*(const u32x4*)(PR + (size_t)row * LD1 + 6144 + c), gt);
            float s = 0.f;
#pragma unroll
            for (int j = 0; j < 8; ++j) s += v[j] * v[j];
            s += __shfl_xor(s, 1); s += __shfl_xor(s, 2); s += __shfl_xor(s, 4); s += __shfl_xor(s, 8);
            const float rs = rsqrtf(s * (1.0f / 128.0f) + EPS);
            const f32x4 n0 = *(const f32x4*)(nw + (c & 127)), n1 = *(const f32x4*)(nw + (c & 127) + 4);
            float o[8];
#pragma unroll
            for (int j = 0; j < 8; ++j) o[j] = v[j] * rs * (j < 4 ? n0[j] : n1[j - 4]) * silu(gt[j]);
            u32x4 ov; ov.x = pk2(o[0], o[1]); ov.y = pk2(o[2], o[3]); ov.z = pk2(o[4], o[5]); ov.w = pk2(o[6], o[7]);
            *(u32x4*)(MX + (size_t)row * 4096 + c) = ov;
        }
    }
}

__device__ __forceinline__ void phase_act(const Params& p, int l) {
    const bf16_t* PR = (const bf16_t*)(p.ws + WS_PROJ); bf16_t* ACT = (bf16_t*)(p.ws + WS_ACT);
    const float* cw = p.in[32 + p.z] + (size_t)l * 3 * DFF; const float* cbv = p.in[33 + p.z] + (size_t)l * DFF;
    const float* st = p.in[8 + p.z] + (size_t)l * 128 * 2 * DFF;
    const int total = MT * 704;
    for (int idx = blockIdx.x * 512 + threadIdx.x; idx < total; idx += gridDim.x * 512) {
        const int row = idx / 704, c = (idx - row * 704) * 8;
        int sample, b, t, L; seq_of_row(row, sample, b, t, L);
        float g2[8], g1[8], g0[8], uu[8];
        unpack8(*(const u32x4*)(PR + (size_t)row * LDU + c), g2);
        unpack8(*(const u32x4*)(PR + (size_t)row * LDU + DFF + c), uu);
        if (t >= 1) unpack8(*(const u32x4*)(PR + (size_t)(row - 1) * LDU + c), g1);
        else {
#pragma unroll
            for (int j = 0; j < 8; ++j) g1[j] = sample ? st[((size_t)b * 2 + 1) * DFF + c + j] : 0.f;
        }
        if (t >= 2) unpack8(*(const u32x4*)(PR + (size_t)(row - 2) * LDU + c), g0);
        else {
#pragma unroll
            for (int j = 0; j < 8; ++j) g0[j] = sample ? st[((size_t)b * 2 + t) * DFF + c + j] : 0.f;
        }
        float o[8];
#pragma unroll
        for (int j = 0; j < 8; ++j) {
            const float y = cbv[c + j] + cw[c + j] * g0[j] + cw[DFF + c + j] * g1[j] + cw[2 * DFF + c + j] * g2[j];
            o[j] = silu(y) * uu[j];
        }
        u32x4 ov; ov.x = pk2(o[0], o[1]); ov.y = pk2(o[2], o[3]); ov.z = pk2(o[4], o[5]); ov.w = pk2(o[6], o[7]);
        *(u32x4*)(ACT + (size_t)row * DFF + c) = ov;
        if (t >= L - 2) {
            float* dst = p.out + (sample ? O_FCS + (((size_t)l * 128 + b) * 2 + (t - (L - 2))) * DFF : O_FCP + (((size_t)l * 4 + b) * 2 + (t - (L - 2))) * DFF) + c;
            *(f32x4*)dst = (f32x4){g2[0], g2[1], g2[2], g2[3]}; *(f32x4*)(dst + 4) = (f32x4){g2[4], g2[5], g2[6], g2[7]};
        }
    }
}

__device__ __forceinline__ void phase_lruconv(const Params& p) {
    const bf16_t* PR = (const bf16_t*)(p.ws + WS_PROJ); bf16_t* XR = (bf16_t*)(p.ws + WS_XR);
    const float* cw = p.in[23 + p.z]; const float* cbv = p.in[24 + p.z]; const float* st = p.in[7 + p.z];
    const int total = MT * 256;
    for (int idx = blockIdx.x * 512 + threadIdx.x; idx < total; idx += gridDim.x * 512) {
        const int row = idx >> 8, c = (idx & 255) * 8;
        int sample, b, t, L; seq_of_row(row, sample, b, t, L);
        float x[4][8];
#pragma unroll
        for (int j = 0; j < 4; ++j) {
            const int tt = t + j - 3;
            if (tt >= 0) unpack8(*(const u32x4*)(PR + (size_t)(row + j - 3) * LD1 + 8192 + c), x[j]);
            else {
#pragma unroll
                for (int i = 0; i < 8; ++i) x[j][i] = sample ? st[((size_t)b * 3 + (t + j)) * 2048 + c + i] : 0.f;
            }
        }
        float o[8];
#pragma unroll
        for (int i = 0; i < 8; ++i) o[i] = cbv[c + i] + cw[c + i] * x[0][i] + cw[2048 + c + i] * x[1][i] + cw[4096 + c + i] * x[2][i] + cw[6144 + c + i] * x[3][i];
        u32x4 ov; ov.x = pk2(o[0], o[1]); ov.y = pk2(o[2], o[3]); ov.z = pk2(o[4], o[5]); ov.w = pk2(o[6], o[7]);
        *(u32x4*)(XR + (size_t)row * 2048 + c) = ov;
        if (t >= L - 3) {
            float* dst = p.out + (sample ? O_LCS : O_LCP) + ((size_t)b * 3 + (t - (L - 3))) * 2048 + c;
            *(f32x4*)dst = (f32x4){x[3][0], x[3][1], x[3][2], x[3][3]}; *(f32x4*)(dst + 4) = (f32x4){x[3][4], x[3][5], x[3][6], x[3][7]};
        }
    }
}

__device__ __forceinline__ void finalize_sample_rows(const Params& p, float* ssdst, int nsplit) {
    int tid = threadIdx.x; asm volatile("" : "+v"(tid));
    const int wave = tid >> 6, lane = tid & 63;
    const int gw = blockIdx.x * 8 + wave, NGW = gridDim.x * 8;
    float* X = (float*)(p.ws + WS_X); bf16_t* XB = (bf16_t*)(p.ws + WS_XB); const float* PT = (const float*)(p.ws + WS_PROJ);
    for (int row = MP + gw; row < MT; row += NGW) {
        float s = 0.f;
#pragma unroll 2
        for (int j = 0; j < 8; ++j) {
            const unsigned o = (unsigned)row * 2048u + (unsigned)(lane + 64 * j) * 4u;
            f32x4 v = *(const f32x4*)(X + o);
            for (int ks = 0; ks < nsplit; ++ks) v += *(const f32x4*)(PT + (size_t)ks * (512 * 2048) + (o - (unsigned)MP * 2048u));
            *(f32x4*)(X + o) = v;
            u32x2 w; w.x = pk2(v[0], v[1]); w.y = pk2(v[2], v[3]);
            *(u32x2*)(XB + o) = w;
            s += (v[0] * v[0] + v[1] * v[1]) + (v[2] * v[2] + v[3] * v[3]);
        }
        s = wave_sum(s);
        if (lane == 0) ssdst[row] = s;
    }
}

__device__ __forceinline__ void phase_final(const Params& p) {
    int tid = threadIdx.x; asm volatile("" : "+v"(tid));
    const int wave = tid >> 6, lane = tid & 63;
    const int gw = blockIdx.x * 8 + wave, NGW = gridDim.x * 8;
    const float* X = (const float*)(p.ws + WS_X); const float* nf = p.in[11 + p.z];
    for (int row = gw; row < MT; row += NGW) {
        f32x4 v[8]; float sq = 0.f;
#pragma unroll
        for (int j = 0; j < 8; ++j) { v[j] = *(const f32x4*)(X + (size_t)row * 2048 + (lane + 64 * j) * 4);
            if (row >= MP) { for (int ks = 0; ks < 11; ++ks) v[j] += *(const f32x4*)((const float*)(p.ws + WS_PROJ) + (size_t)ks * (512 * 2048) + (size_t)(row - MP) * 2048 + (lane + 64 * j) * 4); }
            sq += (v[j][0] * v[j][0] + v[j][1] * v[j][1]) + (v[j][2] * v[j][2] + v[j][3] * v[j][3]); }
        sq = wave_sum(sq);
        const float rs = rsqrtf(sq * (1.0f / 2048.0f) + EPS);
        float* dst = p.out + (row < MP ? O_YP + (size_t)row * 2048 : O_YS + (size_t)(row - MP) * 2048);
#pragma unroll
        for (int j = 0; j < 8; ++j) {
            const int c = (lane + 64 * j) * 4;
            *(f32x4*)(dst + c) = v[j] * rs * *(const f32x4*)(nf + c);
        }
    }
}

#define XB_TMO      128
#define XB_XCNT(j)  (256  + 64 * (j))
#define XB_XSUB(j)  (1280 + 64 * (j))
#define XB_XGEN(j)  (2304 + 64 * (j))
#define XB_TOP      3328
#define XB_TOPGEN   3392
#define XCD_BAR_WORDS 3456
#define XB_SPIN_CAP (1u << 22)
__device__ __forceinline__ unsigned xb_ld(unsigned* p)              { return __hip_atomic_load(p, __ATOMIC_RELAXED, __HIP_MEMORY_SCOPE_AGENT); }
__device__ __forceinline__ unsigned xb_add(unsigned* p, unsigned v) { return __hip_atomic_fetch_add(p, v, __ATOMIC_RELAXED, __HIP_MEMORY_SCOPE_AGENT); }
__device__ __forceinline__ unsigned xb_xcc_id() { return (unsigned)__builtin_amdgcn_s_getreg((3 << 11) | 20) & 0xFu; }
#define XB_SPIN(cond, bar) do { unsigned _sp = 0; while (cond) { __builtin_amdgcn_s_sleep(1); \
    if ((++_sp & 255u) == 0u) { if (xb_ld(&(bar)[XB_TMO])) break; if (_sp > XB_SPIN_CAP) { atomicAdd(&(bar)[XB_TMO], 1u); break; } } } } while (0)
struct XcdBarrier { unsigned* bar; unsigned x; volatile LAS unsigned* st; };
__device__ __forceinline__ XcdBarrier xcd_barrier_post(unsigned* bar, volatile LAS unsigned* st) {
    XcdBarrier b; b.bar = bar; b.x = xb_xcc_id(); b.st = st;
    if (threadIdx.x == 0) (void)xb_add(&bar[XB_XCNT(b.x)], 1u);
    return b;
}
__device__ __forceinline__ void xcd_barrier_complete(unsigned* bar, unsigned x, unsigned& nloc, unsigned& nx) {
    const unsigned G = gridDim.x * gridDim.y * gridDim.z;
    unsigned sum, cnt, mine, sp = 0u;
    for (;;) {
        sum = 0u; cnt = 0u; mine = 0u;
#pragma unroll
        for (unsigned j = 0; j < 16; ++j) { const unsigned c = xb_ld(&bar[XB_XCNT(j)]); sum += c; cnt += (c > 0u) ? 1u : 0u; mine = (j == x) ? c : mine; }
        if (sum == G) break;
        __builtin_amdgcn_s_sleep(1);
        if ((++sp & 255u) == 0u) { if (xb_ld(&bar[XB_TMO])) break; if (sp > XB_SPIN_CAP) { atomicAdd(&bar[XB_TMO], 1u); break; } }
    }
    nloc = mine > 0u ? mine : 1u; nx = cnt > 0u ? cnt : 1u;
}
__device__ __forceinline__ void xcd_barrier(const XcdBarrier& b) {
    asm volatile("s_waitcnt vmcnt(0)" ::: "memory");
    __syncthreads();
    if (threadIdx.x == 0) {
        unsigned* bar = b.bar;
        __builtin_amdgcn_s_waitcnt(0);
        unsigned nloc = b.st[0], nx = b.st[1];
        if (nloc == 0u) { xcd_barrier_complete(bar, b.x, nloc, nx); b.st[0] = nloc; b.st[1] = nx; }
        const unsigned old = xb_add(&bar[XB_XSUB(b.x)], 1u);
        const unsigned gen = old / nloc;
        if (old + 1u == (gen + 1u) * nloc) {
            __builtin_amdgcn_fence(__ATOMIC_RELEASE, "agent");
            asm volatile("s_waitcnt vmcnt(0)" ::: "memory");
            const unsigned og = xb_add(&bar[XB_TOP], 1u);
            const unsigned tg = og / nx;
            if (og + 1u == (tg + 1u) * nx) xb_add(&bar[XB_TOPGEN], 1u);
            else XB_SPIN(xb_ld(&bar[XB_TOPGEN]) == tg, bar);
            __builtin_amdgcn_fence(__ATOMIC_ACQUIRE, "agent");
            xb_add(&bar[XB_XGEN(b.x)], 1u);
            asm volatile("s_waitcnt vmcnt(0)" ::: "memory");
        } else {
            XB_SPIN(xb_ld(&bar[XB_XGEN(b.x)]) == gen, bar);
            __builtin_amdgcn_fence(__ATOMIC_ACQUIRE, "agent");
            asm volatile("s_waitcnt vmcnt(0)" ::: "memory");
        }
    }
    __syncthreads();
}

#ifndef PROBE_MASK
#define PROBE_MASK 0u
#endif
#ifndef PHMASK
#define PHMASK 0xFFFFFFFFu
#endif
#define EN(i) (((PHMASK) >> (i)) & 1u)
__global__ void __launch_bounds__(512, 2) fwd_megakernel(Params p) {
    extern __shared__ __attribute__((aligned(16))) unsigned char shm[];
    float* ldsf = (float*)shm;
    LAS unsigned char* ldsg = (LAS unsigned char*)shm;
    unsigned char* ws = p.ws;
    float* ssb = (float*)(ws + WS_SS);
    volatile LAS unsigned* xst = (volatile LAS unsigned*)(ldsg + 133120);
    if (threadIdx.x == 0) { xst[0] = 0u; xst[1] = 0u; }
    __syncthreads();
    (void)xcd_barrier_post((unsigned*)(ws + WS_CTL) + 256, xst);
#define XBAR() do { XcdBarrier _b; _b.bar = (unsigned*)(p.ws + WS_CTL) + 256; _b.x = xb_xcc_id(); _b.st = (volatile LAS unsigned*)((LAS unsigned char*)shm + 133120); xcd_barrier(_b); } while (0)
#if PROBE_MASK
    unsigned long long tph = __builtin_amdgcn_s_memrealtime();
#endif
    for (int ph = p.ph_lo; ph < p.ph_hi; ++ph) {
        if (ph > p.ph_lo) {
            if (ph == 1) cg::this_grid().sync();
            else XBAR();
#if PROBE_MASK
            {
                const unsigned long long t1 = __builtin_amdgcn_s_memrealtime();
                if ((PROBE_MASK >> (ph - 1)) & 1u) { const unsigned long long dt = t1 - tph; while (__builtin_amdgcn_s_memrealtime() - t1 < dt) __builtin_amdgcn_s_sleep(8); }
                tph = __builtin_amdgcn_s_memrealtime();
            }
#endif
        }
        if (EN(0) && ph == 0) phase_prologue(p, ldsf);
        else if (EN(1) && (ph == 1 || ph == 5 || ph == 8 || ph == 14)) {
            pg8::Gemm g; pg8::EpiScaleBf16 E; int N;
            if (ph != 1) { finalize_sample_rows(p, ssb + (ph == 5 ? 1 : (ph == 8 ? 2 : 3)) * MT, ph == 8 ? 11 : 16); XBAR(); }
            g.A = (const char*)(ws + WS_XB); g.lda = 2048; g.ldb = 2048;
            if (ph == 1) { g.Bt = (const char*)(ws + WS_WIN0); N = LD0; E.ss = ssb; }
            else if (ph == 5) { g.Bt = (const char*)(ws + WS_WUP0); N = LDU; E.ss = ssb + MT; }
            else if (ph == 8) { g.Bt = (const char*)(ws + WS_WIN1); N = LD1; E.ss = ssb + 2 * MT; }
            else { g.Bt = (const char*)(ws + WS_WUP1); N = LDU; E.ss = ssb + 3 * MT; }
            E.O = (bf16_t*)(ws + WS_PROJ); E.ldc = N;
            pg8::Order S; S.nMm = 32; S.nN = N / 256; S.n_main = 32 * S.nN; S.n_tail = 2 * S.nN; S.ksplit = 1; S.nt_full = 32; S.G = gridDim.x; S.c = blockIdx.x;
            S.a_t = (size_t)256 * 2048 * 2; S.b_t = (size_t)256 * 2048 * 2; S.acol = 0;
            pg8::gemm_phase<pg8::EpiScaleBf16>(ldsg, g, S, E);
        }
        else if (EN(4) && (ph == 4 || ph == 7 || ph == 13 || ph == 16)) {
            pg8::Gemm g; pg8::EpiResid E;
            g.A = (const char*)(ws + WS_ACT);
            if (ph == 4) { g.Bt = (const char*)(ws + WS_WOUT0); g.lda = 4096; E.ssout = ssb + MT; }
            else if (ph == 7) { g.Bt = (const char*)(ws + WS_WDN0); g.lda = DFF; E.ssout = ssb + 2 * MT; }
            else if (ph == 13) { g.Bt = (const char*)(ws + WS_WOUT1); g.lda = 4096; E.ssout = ssb + 3 * MT; }
            else { g.Bt = (const char*)(ws + WS_WDN1); g.lda = DFF; E.ssout = ssb + 4 * MT; }
            g.ldb = g.lda;
            E.X = (float*)(ws + WS_X); E.XB = (bf16_t*)(ws + WS_XB); E.part = (float*)(ws + WS_PROJ);
            pg8::Order S; S.nMm = 32; S.nN = 8; S.n_main = 256; S.nt_full = g.lda / 64; S.ksplit = (g.lda == 4096) ? 16 : 11; S.n_tail = 16 * S.ksplit; S.G = gridDim.x; S.c = blockIdx.x;
            S.a_t = (size_t)256 * g.lda * 2; S.b_t = (size_t)256 * g.ldb * 2; S.acol = 0;
            pg8::gemm_phase<pg8::EpiResid>(ldsg, g, S, E);
        }
        else if (EN(10) && ph == 10) {
            pg8::Gemm g; pg8::EpiLru E;
            g.A = (const char*)(ws + WS_XR); g.Bt = (const char*)(ws + WS_WLRU); g.lda = 2048; g.ldb = 256;
            E.br = p.in[26 + p.z]; E.bi = p.in[28 + p.z]; E.sp = (const float*)(ws + WS_SP); E.XR = (const bf16_t*)(ws + WS_XR);
            E.LA = (float*)(ws + WS_LA); E.LBv = (bf16_t*)(ws + WS_LBB);
            pg8::Order S; S.nMm = 34; S.nN = 16; S.n_main = 34 * 16; S.n_tail = 0; S.ksplit = 1; S.nt_full = 4 + p.z; S.G = gridDim.x; S.c = blockIdx.x;
            S.a_t = (size_t)256 * 2048 * 2; S.b_t = (size_t)256 * 256 * 2; S.acol = 512;
            pg8::gemm_phase<pg8::EpiLru>(ldsg, g, S, E);
        }
        else if (EN(2) && ph == 2) phase_rec0(p, ldsf);
        else if (EN(3) && ph == 3) phase_prep0(p);
        else if (EN(6) && ph == 6) phase_act(p, 0);
        else if (EN(9) && ph == 9) phase_lruconv(p);
        else if (EN(11) && ph == 11) phase_rec1(p, ldsf);
        else if (EN(12) && ph == 12) phase_prep1(p);
        else if (EN(15) && ph == 15) phase_act(p, 1);
        else if (EN(17) && ph == 17) phase_final(p);
    }
}

#ifndef N_LAUNCH_MODE
#define N_LAUNCH_MODE 0
#endif

extern "C" void kernel_launch(void* const* d_in, const int* in_sizes, int n_in, void* d_out, int out_size, void* d_ws, size_t ws_size, hipStream_t stream) {
    static int grid = 0;
    if (grid == 0) {
        if (n_in != 35 || (size_t)out_size != O_END || ws_size < WS_END) { fprintf(stderr, "kernel_launch: unexpected shapes: n_in %d out %d ws %zu (need %zu)\n", n_in, out_size, ws_size, (size_t)WS_END); grid = -1; return; }
        int dev = 0, cus = 0, per_cu = 0;
        hipGetDevice(&dev);
        hipDeviceGetAttribute(&cus, hipDeviceAttributeMultiprocessorCount, dev);
        if (hipFuncSetAttribute((const void*)fwd_megakernel, hipFuncAttributeMaxDynamicSharedMemorySize, LDS_BYTES) != hipSuccess) { fprintf(stderr, "kernel_launch: hipFuncSetAttribute failed\n"); grid = -1; return; }
        if (hipOccupancyMaxActiveBlocksPerMultiprocessor(&per_cu, (const void*)fwd_megakernel, 512, LDS_BYTES) != hipSuccess || per_cu < 1) { fprintf(stderr, "kernel_launch: occupancy query says %d\n", per_cu); per_cu = 1; }
        (void)hipGetLastError();
        grid = cus;
    }
    if (grid < 0) return;
    (void)hipMemsetAsync((char*)d_ws + WS_CTL, 0, 16384, stream);
    Params p{};
    for (int i = 0; i < 35; ++i) p.in[i] = (const float*)d_in[i];
    p.z = 0; p.pad = 0;
    p.out = (float*)d_out; p.ws = (unsigned char*)d_ws;
#if N_LAUNCH_MODE == 0
    p.ph_lo = 0; p.ph_hi = NPHASE;
    void* args[] = {&p};
    hipError_t e = hipLaunchCooperativeKernel((const void*)fwd_megakernel, dim3(grid), dim3(512), args, LDS_BYTES, stream);
    if (e != hipSuccess) fprintf(stderr, "cooperative launch failed: %s (grid %d)\n", hipGetErrorString(e), grid);
#else
    for (int ph = 0; ph < NPHASE; ++ph) {
        p.ph_lo = ph; p.ph_hi = ph + 1;
        hipLaunchKernelGGL(fwd_megakernel, dim3(grid), dim3(512), LDS_BYTES, stream, p);
    }
#endif
}
```

```cpp
#include <hip/hip_runtime.h>
#include <hip/hip_cooperative_groups.h>
#include <cstdio>
#include <cstdint>
namespace cg = cooperative_groups;

#define LAS __attribute__((address_space(3)))
typedef unsigned short bf16_t;
typedef short bf16x8 __attribute__((ext_vector_type(8)));
typedef float f32x4 __attribute__((ext_vector_type(4)));
typedef float f32x2 __attribute__((ext_vector_type(2)));
typedef unsigned u32x4 __attribute__((ext_vector_type(4)));
typedef unsigned u32x2 __attribute__((ext_vector_type(2)));

constexpr int D = 2048, MP = 8192, MS = 512, MT = 8704;
constexpr int LD0 = 11520, LD1 = 12288, LDU = 11264, DFF = 5632;
constexpr float EPS = 1e-6f;
constexpr size_t O_YP = 0;
constexpr size_t O_YS = O_YP + (size_t)4 * 2048 * 2048;
constexpr size_t O_SSMP = O_YS + (size_t)128 * 4 * 2048;
constexpr size_t O_SSMS = O_SSMP + (size_t)4 * 32 * 128 * 64;
constexpr size_t O_SCP = O_SSMS + (size_t)128 * 32 * 128 * 64;
constexpr size_t O_SCS = O_SCP + (size_t)4 * 3 * 3072;
constexpr size_t O_RETP = O_SCS + (size_t)128 * 3 * 3072;
constexpr size_t O_RETS = O_RETP + (size_t)4 * 8 * 128 * 256;
constexpr size_t O_HGP = O_RETS + (size_t)128 * 8 * 128 * 256;
constexpr size_t O_HGS = O_HGP + (size_t)4 * 16 * 128 * 128;
constexpr size_t O_LRUP = O_HGS + (size_t)128 * 16 * 128 * 128;
constexpr size_t O_LRUS = O_LRUP + (size_t)4 * 2048;
constexpr size_t O_LCP = O_LRUS + (size_t)128 * 2048;
constexpr size_t O_LCS = O_LCP + (size_t)4 * 3 * 2048;
constexpr size_t O_FCP = O_LCS + (size_t)128 * 3 * 2048;
constexpr size_t O_FCS = O_FCP + (size_t)2 * 4 * 2 * 5632;
constexpr size_t O_END = O_FCS + (size_t)2 * 128 * 2 * 5632;
constexpr size_t al256(size_t x) { return (x + 255) & ~(size_t)255; }
constexpr size_t WS_CTL = 0;
constexpr size_t WS_SS = 16384;
constexpr size_t WS_SP = al256(WS_SS + (size_t)5 * MT * 4);
constexpr size_t WS_LB = WS_SP + 8192;
constexpr size_t WS_WIN0 = WS_LB + 8192;
constexpr size_t WS_WOUT0 = WS_WIN0 + (size_t)LD0 * 2048 * 2;
constexpr size_t WS_WUP0 = WS_WOUT0 + (size_t)2048 * 4096 * 2;
constexpr size_t WS_WDN0 = WS_WUP0 + (size_t)LDU * 2048 * 2;
constexpr size_t WS_WIN1 = WS_WDN0 + (size_t)2048 * DFF * 2;
constexpr size_t WS_WOUT1 = WS_WIN1 + (size_t)LD1 * 2048 * 2;
constexpr size_t WS_WUP1 = WS_WOUT1 + (size_t)2048 * 4096 * 2;
constexpr size_t WS_WDN1 = WS_WUP1 + (size_t)LDU * 2048 * 2;
constexpr size_t WS_WLRU = WS_WDN1 + (size_t)2048 * DFF * 2;
constexpr size_t WS_X = WS_WLRU + (size_t)16 * 256 * 256 * 2;
constexpr size_t WS_XB = WS_X + (size_t)MT * 2048 * 4;
constexpr size_t WS_PROJ = WS_XB + (size_t)MT * 2048 * 2;
constexpr size_t WS_ACT = WS_PROJ + (size_t)MT * LD1 * 2;
constexpr size_t WS_YZ = WS_ACT + (size_t)MT * DFF * 2;
constexpr size_t WS_LA = WS_YZ + (size_t)MT * 4096 * 2;
constexpr size_t WS_LBB = WS_LA + (size_t)MT * 2048 * 4;
constexpr size_t WS_XR = WS_LBB + (size_t)MT * 2048 * 2;
constexpr size_t WS_END = WS_XR + (size_t)MT * 2048 * 2;

constexpr int LDS_BYTES = 133120 + 256;
constexpr int NPHASE = 18;

struct Params {
    const float* in[35];
    float* out;
    unsigned char* ws;
    int ph_lo, ph_hi;
    int z, pad;
};

__device__ __forceinline__ float bf2f(unsigned v) { return __uint_as_float(v << 16); }
__device__ __forceinline__ unsigned pk2(float lo, float hi) { unsigned r; asm volatile("v_cvt_pk_bf16_f32 %0, %1, %2" : "=v"(r) : "v"(lo), "v"(hi)); return r; }
__device__ __forceinline__ unsigned pk2_sw(float lo, float hi) {
    unsigned a = __float_as_uint(lo), b = __float_as_uint(hi); a += 0x7fffu + ((a >> 16) & 1u); b += 0x7fffu + ((b >> 16) & 1u); return (a >> 16) | (b & 0xffff0000u); }
__device__ __forceinline__ bf16_t f2bf(float x) { return (bf16_t)(pk2(x, 0.f) & 0xffffu); }
__device__ __forceinline__ float sigm(float x) { return __builtin_amdgcn_rcpf(1.f + __expf(-x)); }
__device__ __forceinline__ float silu(float x) { return x * __builtin_amdgcn_rcpf(1.f + __expf(-x)); }
__device__ __forceinline__ float softplus(float x) { return fmaxf(x, 0.f) + log1pf(__expf(-fabsf(x))); }
__device__ __forceinline__ float gelu_tanh(float x) { const float u = 0.7978845608f * (x + 0.044715f * x * x * x); const float t = 1.f - 2.f * __builtin_amdgcn_rcpf(1.f + __expf(2.f * u)); return 0.5f * x * (1.f + t); }
__device__ __forceinline__ float wave_sum(float v) {
#pragma unroll
    for (int o = 1; o < 64; o <<= 1) v += __shfl_xor(v, o);
    return v;
}
__device__ __forceinline__ void unpack8(u32x4 r, float* f) {
    f[0] = bf2f(r.x & 0xffffu); f[1] = __uint_as_float(r.x & 0xffff0000u); f[2] = bf2f(r.y & 0xffffu); f[3] = __uint_as_float(r.y & 0xffff0000u);
    f[4] = bf2f(r.z & 0xffffu); f[5] = __uint_as_float(r.z & 0xffff0000u); f[6] = bf2f(r.w & 0xffffu); f[7] = __uint_as_float(r.w & 0xffff0000u);
}
__device__ __forceinline__ void unpack4(u32x2 r, float* f) {
    f[0] = bf2f(r.x & 0xffffu); f[1] = __uint_as_float(r.x & 0xffff0000u); f[2] = bf2f(r.y & 0xffffu); f[3] = __uint_as_float(r.y & 0xffff0000u);
}
#define LDS_WAIT() asm volatile("s_waitcnt lgkmcnt(0)" ::: "memory")

namespace pg8 {
constexpr int BM = 256, BK = 64, HALF = 128, HTB = HALF * BK * 2, NXCD = 8, WGM = 8;
__device__ __forceinline__ int lds_byte(int r, int c) { const int st = (r >> 4) * 2 + (c >> 5), rr = r & 15, cc = c & 31, ob = rr * 64 + cc * 2; return st * 1024 + (ob ^ (((ob >> 9) & 1) << 5)); }
__device__ __forceinline__ void stage_rc(int b, int& R, int& C) { const int st = b / 1024, sb = b % 1024, swz = sb ^ (((sb >> 9) & 1) << 5); R = (st >> 1) * 16 + swz / 64; C = (st & 1) * 32 + (swz % 64) / 2; }
__device__ __forceinline__ int perm32(int rho) { const int n = rho >> 4, i = rho & 15; return 8 * (i >> 2) + 4 * n + (i & 3); }

struct Unit { int pm, pn, nt, kind, ks; size_t aoff, boff; };
struct Gemm { const char* A; const char* Bt; int lda, ldb; };
struct Order {
    int nMm, nN, n_main, n_tail, ksplit, nt_full, G, c; size_t a_t, b_t, acol;
    __device__ __forceinline__ bool next(int i, Unit& u) const {
        const long L = (long)i * G + c;
        if (L < n_main) {
            const int nwg = n_main;
            int wgid = (int)L; { const int q = nwg / NXCD, r = nwg % NXCD, xcd = wgid % NXCD, off = wgid / NXCD; wgid = (xcd < r ? xcd * (q + 1) : r * (q + 1) + (xcd - r) * q) + off; }
            const int nig = WGM * nN, gid = wgid / nig, fm = gid * WGM, gsz = (nMm - fm) < WGM ? (nMm - fm) : WGM;
            u.pm = fm + ((wgid % nig) % gsz); u.pn = (wgid % nig) / gsz; u.nt = nt_full; u.kind = 0; u.ks = 0;
            u.aoff = (size_t)u.pm * a_t + (size_t)(u.pn >> 1) * acol; u.boff = (size_t)u.pn * b_t; return true;
        }
        const int Lt = (int)(L - n_main); if (Lt >= n_tail) return false;
        const int ks = Lt % ksplit, r = Lt / ksplit;
        u.pm = nMm + (r & 1); u.pn = r >> 1; u.nt = nt_full / ksplit; u.kind = ksplit > 1 ? 1 : 0; u.ks = ks;
        const size_t kofs = (size_t)ks * u.nt * (BK * 2);
        u.aoff = (size_t)u.pm * a_t + (size_t)(u.pn >> 1) * acol + kofs; u.boff = (size_t)u.pn * b_t + kofs; return true;
    }
};

struct EpiScaleBf16 {
    static constexpr bool PERM = true;
    bf16_t* O; int ldc; const float* ss;
    __device__ __forceinline__ void operator()(const f32x4 (&acc)[2][2][4][2], const Unit& u, int wr, int wc, int fr, int fq) const {
        const int row0 = u.pm * BM + wr * 64 + fr, col0 = u.pn * BM + wc * 32 + 8 * fq;
#pragma unroll
        for (int ai = 0; ai < 2; ++ai)
#pragma unroll
            for (int m = 0; m < 4; ++m) {
                const int row = row0 + ai * HALF + m * 16;
                const float rs = rsqrtf(ss[row] * (1.0f / 2048.0f) + EPS);
                bf16_t* rowp = O + ((unsigned)row * (unsigned)ldc + (unsigned)col0);
#pragma unroll
                for (int bj = 0; bj < 2; ++bj) {
                    const f32x4 v0 = acc[ai][bj][m][0] * rs, v1 = acc[ai][bj][m][1] * rs;
                    u32x4 w; w.x = pk2(v0[0], v0[1]); w.y = pk2(v0[2], v0[3]); w.z = pk2(v1[0], v1[1]); w.w = pk2(v1[2], v1[3]);
                    *(u32x4*)(rowp + bj * HALF) = w;
                }
            }
    }
};
struct EpiResid {
    static constexpr bool PERM = false;
    float* X; bf16_t* XB; float* ssout; float* part;
    __device__ __forceinline__ void operator()(const f32x4 (&acc)[2][2][4][2], const Unit& u, int wr, int wc, int fr, int fq) const {
        const int row0 = u.pm * BM + wr * 64 + fr, col0 = u.pn * BM + wc * 32 + 4 * fq;
        if (u.kind == 1) {
            float* P = part + (size_t)u.ks * (512 * 2048);
#pragma unroll
            for (int ai = 0; ai < 2; ++ai)
#pragma unroll
                for (int m = 0; m < 4; ++m) {
                    const unsigned off = (unsigned)(row0 - MP + ai * HALF + m * 16) * 2048u + (unsigned)col0;
#pragma unroll
                    for (int bj = 0; bj < 2; ++bj)
#pragma unroll
                        for (int n = 0; n < 2; ++n) *(f32x4*)(P + off + bj * HALF + n * 16) = acc[ai][bj][m][n];
                }
            return;
        }
#pragma unroll
        for (int ai = 0; ai < 2; ++ai)
#pragma unroll
            for (int m = 0; m < 4; ++m) {
                const int row = row0 + ai * HALF + m * 16;
                const unsigned off = (unsigned)row * 2048u + (unsigned)col0;
                float sq = 0.f;
#pragma unroll
                for (int bj = 0; bj < 2; ++bj)
#pragma unroll
                    for (int n = 0; n < 2; ++n) {
                        const unsigned o = off + bj * HALF + n * 16;
                        f32x4 x = *(const f32x4*)(X + o) + acc[ai][bj][m][n];
                        *(f32x4*)(X + o) = x;
                        u32x2 w; w.x = pk2(x[0], x[1]); w.y = pk2(x[2], x[3]);
                        *(u32x2*)(XB + o) = w;
                        sq += (x[0] * x[0] + x[1] * x[1]) + (x[2] * x[2] + x[3] * x[3]);
                    }
                sq += __shfl_xor(sq, 16); sq += __shfl_xor(sq, 32);
                if (fq == 0) atomicAdd(ssout + row, sq);
                asm volatile("" ::: "memory");
            }
    }
};
struct EpiLru {
    static constexpr bool PERM = false;
    const float* br; const float* bi; const float* sp; const bf16_t* XR; float* LA; bf16_t* LBv;
    __device__ __forceinline__ void operator()(const f32x4 (&acc)[2][2][4][2], const Unit& u, int wr, int wc, int fr, int fq) const {
        const int row0 = u.pm * BM + wr * 64 + fr;
        const int cbase = (u.pn >> 1) * 256 + (u.pn & 1) * 128 + wc * 32 + 4 * fq;
#pragma unroll
        for (int ai = 0; ai < 2; ++ai)
#pragma unroll
            for (int m = 0; m < 4; ++m) {
                const int row = row0 + ai * HALF + m * 16;
                const bool first = (row < MP) && ((row & 2047) == 0);
#pragma unroll
                for (int n = 0; n < 2; ++n) {
                    const int c = cbase + n * 16;
                    const f32x4 br4 = *(const f32x4*)(br + c), bi4 = *(const f32x4*)(bi + c), sp4 = *(const f32x4*)(sp + c);
                    const unsigned o = (unsigned)row * 2048u + (unsigned)c;
                    float xr[4]; unpack4(*(const u32x2*)(XR + o), xr);
                    f32x4 av; float bb[4];
#pragma unroll
                    for (int j = 0; j < 4; ++j) {
                        const float r = sigm(acc[ai][0][m][n][j] + br4[j]), gi = sigm(acc[ai][1][m][n][j] + bi4[j]);
                        const float la = -8.0f * r * sp4[j];
                        const float a = __expf(la);
                        const float mult = first ? 1.0f : __builtin_amdgcn_sqrtf(fmaxf(1.0f - a * a, 0.f));
                        av[j] = a; bb[j] = mult * gi * xr[j];
                    }
                    *(f32x4*)(LA + o) = av;
                    u32x2 w; w.x = pk2(bb[0], bb[1]); w.y = pk2(bb[2], bb[3]);
                    *(u32x2*)(LBv + o) = w;
                    asm volatile("" ::: "memory");
                }
            }
    }
};

template <class Epi>
__device__ __forceinline__ void gemm_phase(LAS unsigned char* lds, const Gemm g, const Order& S, const Epi& E) {
    int tid = threadIdx.x; asm volatile("" : "+v"(tid));
    const int wid = __builtin_amdgcn_readfirstlane(tid >> 6), lane = tid & 63, wr = wid >> 2, wc = wid & 3, fr = lane & 15, fq = lane >> 4;
    unsigned voffA[2], voffB[2];
#pragma unroll
    for (int i = 0; i < 2; ++i) { int R, C; stage_rc(tid * 16 + i * 8192, R, C); const int Rb = Epi::PERM ? ((R & ~31) + perm32(R & 31)) : R;
        voffA[i] = (unsigned)(R * g.lda + C) * 2u; voffB[i] = (unsigned)(Rb * g.ldb + C) * 2u; }
    const size_t kstep = (size_t)(BK * 2);
    const size_t hstepA = (size_t)HALF * g.lda * 2, hstepB = (size_t)HALF * g.ldb * 2;
    const unsigned ldsw = (unsigned)wid * 1024u;
    const int aoff = lds_byte(wr * 64 + fr, fq * 8), boff = lds_byte(wc * 32 + fr, fq * 8);
#define PG8_SA(b, h) (((b) * 2 + (h)) * HTB)
#define PG8_SB(b, h) ((4 + (b) * 2 + (h)) * HTB)
#define PG8_STAGE(bufoff, gbase, voff) do { _Pragma("unroll") for (int _i = 0; _i < 2; ++_i) \
        __builtin_amdgcn_global_load_lds((const unsigned*)((const char*)(gbase) + (voff)[_i]), (LAS unsigned*)(lds + (bufoff) + ldsw + _i * 8192), 16, 0, 0); } while (0)
#define PG8_LDA(dst, b, h) do { _Pragma("unroll") for (int m = 0; m < 4; ++m) _Pragma("unroll") for (int k = 0; k < 2; ++k) dst[m][k] = *(const LAS bf16x8*)(lds + PG8_SA(b, h) + aoff + m * 2048 + k * 1024); } while (0)
#define PG8_LDB(dst, b, h) do { _Pragma("unroll") for (int n = 0; n < 2; ++n) _Pragma("unroll") for (int k = 0; k < 2; ++k) dst[n][k] = *(const LAS bf16x8*)(lds + PG8_SB(b, h) + boff + n * 2048 + k * 1024); } while (0)
#define PG8_MMA(ai, bj, At, Bt) do { __builtin_amdgcn_s_setprio(1); _Pragma("unroll") for (int m = 0; m < 4; ++m) _Pragma("unroll") for (int n = 0; n < 2; ++n) _Pragma("unroll") for (int k = 0; k < 2; ++k) \
        acc[ai][bj][m][n] = __builtin_amdgcn_mfma_f32_16x16x32_bf16(Bt[n][k], At[m][k], acc[ai][bj][m][n], 0, 0, 0); __builtin_amdgcn_s_setprio(0); } while (0)
#define PG8_WAIT_V(n) asm volatile("s_waitcnt vmcnt(" #n ")" ::: "memory")
#define PG8_WAIT_L(n) asm volatile("s_waitcnt lgkmcnt(" #n ")" ::: "memory")
#define PG8_BAR __builtin_amdgcn_s_barrier()
#define PG8_SCHED __builtin_amdgcn_sched_barrier(0)
    Unit cur, nxt; int ui = 0;
    if (!S.next(0, cur)) return;
    f32x4 acc[2][2][4][2];
#pragma unroll
    for (int a = 0; a < 2; ++a)
#pragma unroll
        for (int b = 0; b < 2; ++b)
#pragma unroll
            for (int m = 0; m < 4; ++m)
#pragma unroll
                for (int n = 0; n < 2; ++n) acc[a][b][m][n] = (f32x4){0.f, 0.f, 0.f, 0.f};
    bf16x8 At[4][2], B0[2][2], B1[2][2];
    const char* cA = g.A + cur.aoff; const char* cB = g.Bt + cur.boff;
    PG8_STAGE(PG8_SB(0, 0), cB, voffB); PG8_STAGE(PG8_SA(0, 0), cA, voffA); PG8_STAGE(PG8_SB(0, 1), cB + hstepB, voffB); PG8_STAGE(PG8_SA(0, 1), cA + hstepA, voffA);
    if (wr == 1) PG8_BAR;
    PG8_WAIT_V(4); PG8_BAR;
    PG8_STAGE(PG8_SB(1, 0), cB + kstep, voffB); PG8_STAGE(PG8_SA(1, 0), cA + kstep, voffA); PG8_STAGE(PG8_SB(1, 1), cB + hstepB + kstep, voffB);
    PG8_WAIT_V(6); PG8_BAR;
    for (;;) {
        const bool has_next = S.next(ui + 1, nxt);
        const char* nA = has_next ? g.A + nxt.aoff : cA; const char* nB = has_next ? g.Bt + nxt.boff : cB;
        const int nt = cur.nt;
        for (int t = 0; t < nt; t += 2) {
            const bool last = (t == nt - 2);
            const char* a1 = cA + (size_t)(t + 1) * kstep;
            const char* a2 = last ? nA : cA + (size_t)(t + 2) * kstep; const char* b2 = last ? nB : cB + (size_t)(t + 2) * kstep;
            const char* a3 = a2 + kstep; const char* b3 = b2 + kstep;
            PG8_LDB(B0, 0, 0); PG8_SCHED; PG8_LDA(At, 0, 0); PG8_STAGE(PG8_SA(1, 1), a1 + hstepA, voffA);
            PG8_WAIT_L(8); PG8_BAR; PG8_WAIT_L(0); PG8_MMA(0, 0, At, B0); PG8_BAR; PG8_SCHED;
            PG8_LDB(B1, 0, 1); PG8_STAGE(PG8_SB(0, 0), b2, voffB);
            PG8_BAR; PG8_WAIT_L(0); PG8_MMA(0, 1, At, B1); PG8_BAR;
            PG8_LDA(At, 0, 1); PG8_STAGE(PG8_SA(0, 0), a2, voffA);
            PG8_BAR; PG8_WAIT_L(0); PG8_MMA(1, 0, At, B0); PG8_BAR; PG8_SCHED;
            PG8_STAGE(PG8_SB(0, 1), b2 + hstepB, voffB);
            PG8_WAIT_V(6); PG8_BAR; PG8_MMA(1, 1, At, B1); PG8_BAR;
            PG8_LDB(B0, 1, 0); PG8_SCHED; PG8_LDA(At, 1, 0); PG8_STAGE(PG8_SA(0, 1), a2 + hstepA, voffA);
            PG8_WAIT_L(8); PG8_BAR; PG8_WAIT_L(0); PG8_MMA(0, 0, At, B0); PG8_BAR; PG8_SCHED;
            PG8_LDB(B1, 1, 1); PG8_STAGE(PG8_SB(1, 0), b3, voffB);
            PG8_BAR; PG8_WAIT_L(0); PG8_MMA(0, 1, At, B1); PG8_BAR;
            PG8_LDA(At, 1, 1); PG8_STAGE(PG8_SA(1, 0), a3, voffA);
            PG8_BAR; PG8_WAIT_L(0); PG8_MMA(1, 0, At, B0); PG8_BAR; PG8_SCHED;
            PG8_STAGE(PG8_SB(1, 1), b3 + hstepB, voffB);
            PG8_WAIT_V(6); PG8_BAR; PG8_MMA(1, 1, At, B1); PG8_BAR;
        }
        E(acc, cur, wr, wc, fr, fq);
        if (!has_next) break;
#pragma unroll
        for (int a = 0; a < 2; ++a)
#pragma unroll
            for (int b = 0; b < 2; ++b)
#pragma unroll
                for (int m = 0; m < 4; ++m)
#pragma unroll
                    for (int n = 0; n < 2; ++n) acc[a][b][m][n] = (f32x4){0.f, 0.f, 0.f, 0.f};
        cur = nxt; cA = nA; cB = nB; ++ui;
    }
    PG8_WAIT_V(0);
    if (wr == 0) PG8_BAR;
    PG8_BAR;
#undef PG8_SA
#undef PG8_SB
#undef PG8_STAGE
#undef PG8_LDA
#undef PG8_LDB
#undef PG8_MMA
#undef PG8_WAIT_V
#undef PG8_WAIT_L
#undef PG8_BAR
#undef PG8_SCHED
}
}

__device__ __forceinline__ void tr_item(const float* __restrict__ W, int ldw, int N, int k0, int n0, const float* __restrict__ scale, bf16_t* __restrict__ dst, int ldd, float* scr, int lane) {
    const int r4 = lane >> 4, c4 = (lane & 15) * 4;
    const bool inb = (n0 + c4) < N;
    f32x4 v[16];
#pragma unroll
    for (int i = 0; i < 16; ++i) v[i] = inb ? *(const f32x4*)(W + (size_t)(k0 + 4 * i + r4) * ldw + n0 + c4) : (f32x4){0.f, 0.f, 0.f, 0.f};
#pragma unroll
    for (int i = 0; i < 16; ++i) { float* d = scr + (4 * i + r4) * 65 + c4; d[0] = v[i][0]; d[1] = v[i][1]; d[2] = v[i][2]; d[3] = v[i][3]; }
    LDS_WAIT();
    const int c = lane & 7;
    f32x4 s0 = (f32x4){1.f, 1.f, 1.f, 1.f}, s1 = s0;
    if (scale) { s0 = *(const f32x4*)(scale + k0 + 8 * c); s1 = *(const f32x4*)(scale + k0 + 8 * c + 4); }
#pragma unroll
    for (int j = 0; j < 8; ++j) { const int n = (lane >> 3) + 8 * j; const float* sp = scr + (8 * c) * 65 + n;
        u32x4 o; o.x = pk2(sp[0 * 65] * s0[0], sp[1 * 65] * s0[1]); o.y = pk2(sp[2 * 65] * s0[2], sp[3 * 65] * s0[3]); o.z = pk2(sp[4 * 65] * s1[0], sp[5 * 65] * s1[1]); o.w = pk2(sp[6 * 65] * s1[2], sp[7 * 65] * s1[3]);
        *(u32x4*)(dst + (size_t)n * ldd + 8 * c) = o; }
    LDS_WAIT();
}

__device__ __forceinline__ void phase_prologue(const Params& p, float* ldsf) {
    int tid = threadIdx.x; asm volatile("" : "+v"(tid));
    const int wave = tid >> 6, lane = tid & 63;
    const int gw = blockIdx.x * 8 + wave, NGW = gridDim.x * 8;
    float* scr = ldsf + wave * 4160;
    unsigned char* ws = p.ws;
    constexpr int I0 = 32 * 177, I1 = 64 * 32, I2 = 32 * 176, I3 = 88 * 32, I4 = 32 * 192, I5 = I1, I6 = I2, I7 = I3, I8 = 128, I9 = 128;
    constexpr int NIT = I0 + I1 + I2 + I3 + I4 + I5 + I6 + I7 + I8 + I9;
    for (int it = gw; it < NIT; it += NGW) {
        int r = it;
        const float* W; int K, N; const float* sc = nullptr; bf16_t* WT;
        if (r < I0) { W = p.in[12 + p.z]; K = 2048; N = 11296; sc = p.in[9 + p.z]; WT = (bf16_t*)(ws + WS_WIN0); }
        else if ((r -= I0) < I1) { W = p.in[19 + p.z]; K = 4096; N = 2048; WT = (bf16_t*)(ws + WS_WOUT0); }
        else if ((r -= I1) < I2) { W = p.in[31 + p.z]; K = 2048; N = 11264; sc = p.in[10 + p.z]; WT = (bf16_t*)(ws + WS_WUP0); }
        else if ((r -= I2) < I3) { W = p.in[34 + p.z]; K = 5632; N = 2048; WT = (bf16_t*)(ws + WS_WDN0); }
        else if ((r -= I3) < I4) { W = p.in[20 + p.z]; K = 2048; N = 12288; sc = p.in[9 + p.z] + 2048; WT = (bf16_t*)(ws + WS_WIN1); }
        else if ((r -= I4) < I5) { W = p.in[30 + p.z]; K = 4096; N = 2048; WT = (bf16_t*)(ws + WS_WOUT1); }
        else if ((r -= I5) < I6) { W = p.in[31 + p.z] + (size_t)2048 * 11264; K = 2048; N = 11264; sc = p.in[10 + p.z] + 2048; WT = (bf16_t*)(ws + WS_WUP1); }
        else if ((r -= I6) < I7) { W = p.in[34 + p.z] + (size_t)5632 * 2048; K = 5632; N = 2048; WT = (bf16_t*)(ws + WS_WDN1); }
        else {
            r -= I7; const int which = r >> 7; r &= 127;
            const int blk = r >> 4, kb = (r >> 2) & 3, nb = r & 3, n0 = 64 * nb, k0 = 64 * kb;
            const float* Wl = (which ? p.in[27 + p.z] : p.in[25 + p.z]) + (size_t)blk * 65536;
            const int drow = (blk * 2 + (n0 >> 7)) * 256 + which * 128 + (n0 & 127);
            tr_item(Wl, 256, 256, k0, n0, nullptr, (bf16_t*)(ws + WS_WLRU) + (size_t)drow * 256 + k0, 256, scr, lane);
            continue;
        }
        const int nblk = (N + 63) / 64, kb = r / nblk, nb = r % nblk, k0 = 64 * kb, n0 = 64 * nb;
        tr_item(W, N, N, k0, n0, sc, WT + (size_t)n0 * K + k0, K, scr, lane);
    }
    {
        u32x4* z = (u32x4*)((bf16_t*)(ws + WS_WIN0) + (size_t)11296 * 2048);
        const int n16 = 224 * 2048 * 2 / 16;
        for (int i = blockIdx.x * 512 + tid; i < n16; i += gridDim.x * 512) z[i] = (u32x4){0u, 0u, 0u, 0u};
    }
    float* X = (float*)(ws + WS_X); bf16_t* XB = (bf16_t*)(ws + WS_XB); float* ss = (float*)(ws + WS_SS);
    for (int row = gw; row < MT; row += NGW) {
        const float* src = row < MP ? p.in[0 + p.z] + (size_t)row * 2048 : p.in[1 + p.z] + (size_t)(row - MP) * 2048;
        float s = 0.f;
#pragma unroll
        for (int j = 0; j < 8; ++j) {
            const f32x4 v = *(const f32x4*)(src + (lane + 64 * j) * 4);
            *(f32x4*)(X + (size_t)row * 2048 + (lane + 64 * j) * 4) = v;
            u32x2 w; w.x = pk2(v[0], v[1]); w.y = pk2(v[2], v[3]);
            *(u32x2*)(XB + (size_t)row * 2048 + (lane + 64 * j) * 4) = w;
            s += (v[0] * v[0] + v[1] * v[1]) + (v[2] * v[2] + v[3] * v[3]);
        }
        s = wave_sum(s);
        if (lane == 0) ss[row] = s;
    }
    for (int i = blockIdx.x * 512 + tid; i < 4 * MT; i += gridDim.x * 512) ss[MT + i] = 0.f;
    for (int i = blockIdx.x * 512 + tid; i < 2048; i += gridDim.x * 512) {
        ((float*)(ws + WS_SP))[i] = softplus(-p.in[29 + p.z][i]);
        ((float*)(ws + WS_LB))[i] = sigm(p.in[21 + p.z][2048 + i] - p.in[21 + p.z][i]);
    }
}

__device__ __forceinline__ int next_item(unsigned* ctr, float* ldsf) {
    __syncthreads();
    if (threadIdx.x == 0) ((volatile unsigned*)ldsf)[24576] = atomicAdd(ctr, 1u);
    __syncthreads();
    return (int)((volatile unsigned*)ldsf)[24576];
}

template <int TYPE, int VW>
__device__ __forceinline__ void rec_item(const Params& p, float* ldsf, int sample, int b, int h, int s) {
    constexpr int NV = VW / 16;
    typedef float VT __attribute__((ext_vector_type(NV)));
    int tid = threadIdx.x; asm volatile("" : "+v"(tid));
    const int w = tid >> 6, lane = tid & 63, kg = lane >> 4, vq = lane & 15, kb = 16 * w + 4 * kg;
    const int L = sample ? 4 : 2048, row0 = sample ? MP + 4 * b : 2048 * b, pos0 = sample ? 16384 : 0;
    constexpr int LDP = TYPE < 2 ? LD0 : LD1;
    const bf16_t* proj = (const bf16_t*)(p.ws + WS_PROJ) + (size_t)row0 * LDP;
    bf16_t* yz = (bf16_t*)(p.ws + WS_YZ) + (size_t)row0 * 4096;
    float* part = ldsf + 8192;
    int colA = -1, colB = -1, role = -1, didx = 0;
    float w0 = 0.f, w1 = 0.f, w2 = 0.f, w3 = 0.f, cbias = 0.f, c0 = 0.f, c1 = 0.f, c2 = 0.f, aux = 0.f, aux2 = 0.f;
    if constexpr (TYPE == 0) {
        if (tid < 320) {
            role = tid < 128 ? 0 : (tid < 256 ? 1 : 2);
            didx = tid < 128 ? tid : (tid < 256 ? tid - 128 : tid - 256);
            const int ch = tid < 128 ? 2560 + (h >> 3) * 128 + tid : (tid < 256 ? 2048 + (h >> 3) * 128 + (tid - 128) : h * 64 + (tid - 256));
            colA = 2048 + ch;
            const float* cw = p.in[13 + p.z];
            w0 = cw[ch]; w1 = cw[3072 + ch]; w2 = cw[2 * 3072 + ch]; w3 = cw[3 * 3072 + ch]; cbias = p.in[14 + p.z][ch];
            if (sample) { const float* st = p.in[3 + p.z] + (size_t)b * 3 * 3072; c0 = st[ch]; c1 = st[3072 + ch]; c2 = st[2 * 3072 + ch]; }
        } else if (tid < 328) { role = 3; didx = tid - 320; colA = 5120 + h; aux = p.in[15 + p.z][h]; aux2 = -__expf(p.in[16 + p.z][h]); }
    } else if constexpr (TYPE == 1) {
        if (tid < 128) { role = tid < 64 ? 0 : 1; didx = tid & 63; colA = (tid < 64 ? 5152 : 6176) + h * 128 + didx; colB = colA + 64;
            aux = exp2f(-(float)didx * 0.20762050593046014f); }
        else if (tid < 128 + VW) { role = 2; didx = tid - 128; colA = 7200 + h * 256 + s * VW + didx; }
    } else {
        if (tid < 128) { role = 0; didx = tid; colA = h * 128 + tid; }
        else if (tid < 256) { role = 1; didx = tid - 128; colA = 2048 + h * 128 + didx; aux = ((const float*)(p.ws + WS_LB))[h * 128 + didx]; }
        else if (tid < 256 + VW) { role = 2; didx = tid - 256; colA = 4096 + h * 128 + s * VW + didx; }
    }
    const float Dh = TYPE == 0 ? p.in[17 + p.z][h] : 0.f;
    const float gamma = TYPE == 1 ? 1.0f - exp2f(-5.0f - (float)h * (4.0f / 7.0f)) : 0.f;
    const int ldS = TYPE == 0 ? 64 : (TYPE == 1 ? 256 : 128);
    size_t soff;
    if constexpr (TYPE == 0) soff = ((size_t)(b * 32 + h) * 128) * 64;
    else if constexpr (TYPE == 1) soff = ((size_t)(b * 8 + h) * 128) * 256 + s * VW;
    else soff = ((size_t)(b * 16 + h) * 128) * 128 + s * VW;
    const float* S0 = TYPE == 0 ? p.in[2 + p.z] : (TYPE == 1 ? p.in[4 + p.z] : p.in[5 + p.z]);
    float* Sout = p.out + (TYPE == 0 ? (sample ? O_SSMS : O_SSMP) : (TYPE == 1 ? (sample ? O_RETS : O_RETP) : (sample ? O_HGS : O_HGP))) + soff;
    VT S[4];
#pragma unroll
    for (int i = 0; i < 4; ++i) { if (sample) S[i] = *(const VT*)(S0 + soff + (size_t)(kb + i) * ldS + NV * vq); else S[i] = (VT)(0.f); }
    unsigned short ra[8], rb[8]; unsigned short zr = 0;
    const int R = (L + 7) >> 3;
    auto load_raw = [&](int r) {
#pragma unroll
        for (int t = 0; t < 8; ++t) {
            const int tt = 8 * r + t;
            ra[t] = 0; rb[t] = 0;
            if (tt < L) {
                if (colA >= 0) ra[t] = proj[(size_t)tt * LDP + colA];
                if (TYPE == 1 && colB >= 0) rb[t] = proj[(size_t)tt * LDP + colB];
            }
        }
        if (TYPE == 0) { const int tt = 8 * r + w; if (tt < L) zr = proj[(size_t)tt * LDP + h * 64 + lane]; }
    };
    load_raw(0);
    for (int r = 0; r < R; ++r) {
        const int nv = (L - 8 * r) < 8 ? (L - 8 * r) : 8;
        float* stg = ldsf + (r & 1) * 4096;
        float* qs = stg; float* ks = stg + 1024; float* as = stg + 2048; float* vs = stg + 3072; float* ad = stg + 3584;
        if constexpr (TYPE == 0) {
            if (role >= 0 && role < 3) {
                float* dst = role == 0 ? qs : (role == 1 ? ks : vs); const int dstr = role == 2 ? 64 : 128;
#pragma unroll
                for (int t = 0; t < 8; ++t) {
                    const float x = bf2f(ra[t]);
                    const float y = cbias + w0 * c0 + w1 * c1 + w2 * c2 + w3 * x;
                    c0 = c1; c1 = c2; c2 = x;
                    dst[t * dstr + didx] = silu(y);
                }
            } else if (role == 3) {
                float xv = 0.f;
#pragma unroll
                for (int t = 0; t < 8; ++t) if (t == didx) xv = bf2f(ra[t]);
                const float dt = softplus(xv + aux);
                ad[2 * didx] = __expf(dt * aux2); ad[2 * didx + 1] = dt;
            }
        } else if constexpr (TYPE == 1) {
            if (role == 0 || role == 1) {
                float* dst = role == 0 ? qs : ks; const float sc = role == 0 ? 1.0f : 0.08838834764831845f;
#pragma unroll
                for (int t = 0; t < 8; ++t) {
                    const int pos = pos0 + 8 * r + t;
                    const double rev = (double)pos * (double)aux * 0.15915494309189535;
                    const float fr = (float)(rev - floor(rev));
                    const float sn = __builtin_amdgcn_sinf(fr), cs = __builtin_amdgcn_cosf(fr);
                    const float x1 = bf2f(ra[t]) * sc, x2 = bf2f(rb[t]) * sc;
                    dst[t * 128 + didx] = x1 * cs - x2 * sn;
                    dst[t * 128 + 64 + didx] = x1 * sn + x2 * cs;
                }
            } else if (role == 2) {
#pragma unroll
                for (int t = 0; t < 8; ++t) vs[t * VW + didx] = bf2f(ra[t]);
            }
        } else {
            if (role == 0) {
#pragma unroll
                for (int t = 0; t < 8; ++t) qs[t * 128 + didx] = silu(bf2f(ra[t]));
            } else if (role == 1) {
#pragma unroll
                for (int t = 0; t < 8; ++t) { const float f = aux + (1.0f - aux) * sigm(bf2f(ra[t])); as[t * 128 + didx] = f; ks[t * 128 + didx] = 1.0f - f; }
            } else if (role == 2) {
#pragma unroll
                for (int t = 0; t < 8; ++t) vs[t * VW + didx] = bf2f(ra[t]);
            }
        }
        const unsigned short zc = zr;
        __syncthreads();
        if (r + 1 < R) load_raw(r + 1);
        for (int t0 = 0; t0 < nv; t0 += 4) {
#pragma unroll
            for (int tt = 0; tt < 4; ++tt) {
                const int t = t0 + tt;
                const f32x4 q4 = *(const f32x4*)(qs + t * 128 + kb);
                f32x4 k4 = *(const f32x4*)(ks + t * 128 + kb);
                const VT v4 = *(const VT*)(vs + t * VW + NV * vq);
                f32x4 a4;
                if constexpr (TYPE == 0) { const f32x2 adv = *(const f32x2*)(ad + 2 * t); a4 = (f32x4){adv.x, adv.x, adv.x, adv.x}; k4 = k4 * adv.y; }
                else if constexpr (TYPE == 1) a4 = (f32x4){gamma, gamma, gamma, gamma};
                else a4 = *(const f32x4*)(as + t * 128 + kb);
                VT o = (VT)(0.f);
#pragma unroll
                for (int i = 0; i < 4; ++i) { S[i] = a4[i] * S[i] + k4[i] * v4; o += q4[i] * S[i]; }
                *(VT*)(part + ((t * 32 + w * 4 + kg) * VW + NV * vq)) = o;
            }
        }
        __syncthreads();
        const int rt = tid / VW, rv = tid % VW;
        if (tid < 8 * VW && rt < nv) {
            float o = 0.f;
#pragma unroll
            for (int pp = 0; pp < 32; ++pp) o += part[(rt * 32 + pp) * VW + rv];
            const size_t trow = (size_t)(8 * r + rt);
            if constexpr (TYPE == 0) {
                const float y = (o + Dh * vs[rt * 64 + rv]) * silu(bf2f(zc));
                yz[trow * 4096 + h * 64 + rv] = f2bf(y);
            } else if constexpr (TYPE == 1) {
                yz[trow * 4096 + 2048 + h * 256 + s * VW + rv] = f2bf(o);
            } else {
                yz[trow * 4096 + h * 128 + s * VW + rv] = f2bf(o);
            }
        }
    }
#pragma unroll
    for (int i = 0; i < 4; ++i) *(VT*)(Sout + (size_t)(kb + i) * ldS + NV * vq) = S[i];
}

template <int TYPE>
__device__ __forceinline__ void dec_unit(const Params& p, float* ldsf, int b, int u) {
    int tid = threadIdx.x; asm volatile("" : "+v"(tid));
    const int w = tid >> 6, lane = tid & 63, kg = lane >> 4, vq = lane & 15;
    const int row0 = MP + 4 * b;
    constexpr int LDP = TYPE < 2 ? LD0 : LD1;
    const bf16_t* proj = (const bf16_t*)(p.ws + WS_PROJ) + (size_t)row0 * LDP;
    bf16_t* yz = (bf16_t*)(p.ws + WS_YZ) + (size_t)row0 * 4096;
    int h, sl; size_t soff; int ldS;
    if constexpr (TYPE == 0) { h = 8 * u + w; sl = 0; ldS = 64; soff = ((size_t)(b * 32 + h) * 128) * 64; }
    else if constexpr (TYPE == 1) { h = 2 * u + (w >> 2); sl = w & 3; ldS = 256; soff = ((size_t)(b * 8 + h) * 128) * 256 + sl * 64; }
    else { h = 4 * u + (w >> 1); sl = w & 1; ldS = 128; soff = ((size_t)(b * 16 + h) * 128) * 128 + sl * 64; }
    const float* S0 = (TYPE == 0 ? p.in[2 + p.z] : (TYPE == 1 ? p.in[4 + p.z] : p.in[5 + p.z])) + soff + (size_t)(32 * kg) * ldS + 4 * vq;
    float* Sout = p.out + (TYPE == 0 ? O_SSMS : (TYPE == 1 ? O_RETS : O_HGS)) + soff + (size_t)(32 * kg) * ldS + 4 * vq;
    if constexpr (TYPE == 0) {
        float* qs = ldsf; float* ks = ldsf + 512; float* xs = ldsf + 1024; float* zs = ldsf + 3072; float* ad = ldsf + 5120;
        unsigned short xr[2][4]; float cw[2][4], cb[2], st[2][3]; unsigned short zr[4]; unsigned short dr = 0;
#pragma unroll
        for (int q = 0; q < 2; ++q) {
            const int idx = tid + 512 * q;
            if (idx < 768) {
                const int ch = idx < 128 ? 2560 + u * 128 + idx : (idx < 256 ? 2048 + u * 128 + (idx - 128) : u * 512 + (idx - 256));
#pragma unroll
                for (int t = 0; t < 4; ++t) xr[q][t] = proj[(size_t)t * LDP + 2048 + ch];
#pragma unroll
                for (int j = 0; j < 4; ++j) cw[q][j] = p.in[13 + p.z][j * 3072 + ch];
                cb[q] = p.in[14 + p.z][ch];
#pragma unroll
                for (int j = 0; j < 3; ++j) st[q][j] = p.in[3 + p.z][((size_t)b * 3 + j) * 3072 + ch];
            }
        }
#pragma unroll
        for (int t = 0; t < 4; ++t) zr[t] = proj[(size_t)t * LDP + u * 512 + tid];
        if (tid < 32) dr = proj[(size_t)(tid >> 3) * LDP + 5120 + 8 * u + (tid & 7)];
        f32x4 S[32];
#pragma unroll
        for (int i = 0; i < 32; ++i) S[i] = *(const f32x4*)(S0 + (size_t)i * ldS);
#pragma unroll
        for (int q = 0; q < 2; ++q) {
            const int idx = tid + 512 * q;
            if (idx < 768) {
                float* dst = idx < 128 ? qs + idx : (idx < 256 ? ks + (idx - 128) : xs + (idx - 256));
                const int dstr = idx < 256 ? 128 : 512;
                float c0 = st[q][0], c1 = st[q][1], c2 = st[q][2];
#pragma unroll
                for (int t = 0; t < 4; ++t) {
                    const float x = bf2f(xr[q][t]);
                    const float y = cb[q] + cw[q][0] * c0 + cw[q][1] * c1 + cw[q][2] * c2 + cw[q][3] * x;
                    c0 = c1; c1 = c2; c2 = x;
                    dst[t * dstr] = silu(y);
                }
            }
        }
#pragma unroll
        for (int t = 0; t < 4; ++t) zs[t * 512 + tid] = silu(bf2f(zr[t]));
        if (tid < 32) {
            const int hh = 8 * u + (tid & 7);
            const float dt = softplus(bf2f(dr) + p.in[15 + p.z][hh]);
            ad[2 * tid] = __expf(-dt * __expf(p.in[16 + p.z][hh])); ad[2 * tid + 1] = dt;
        }
        __syncthreads();
        const float Dh = p.in[17 + p.z][h];
#pragma unroll 1
        for (int t = 0; t < 4; ++t) {
            const f32x2 adv = *(const f32x2*)(ad + 2 * (t * 8 + w));
            const f32x4 v4 = *(const f32x4*)(xs + t * 512 + w * 64 + 4 * vq);
            f32x4 o = (f32x4){0.f, 0.f, 0.f, 0.f};
#pragma unroll
            for (int i4 = 0; i4 < 8; ++i4) {
                const f32x4 q4 = *(const f32x4*)(qs + t * 128 + 32 * kg + 4 * i4);
                const f32x4 k4 = *(const f32x4*)(ks + t * 128 + 32 * kg + 4 * i4) * adv.y;
#pragma unroll
                for (int ii = 0; ii < 4; ++ii) { S[4 * i4 + ii] = adv.x * S[4 * i4 + ii] + k4[ii] * v4; o += q4[ii] * S[4 * i4 + ii]; }
            }
#pragma unroll
            for (int j = 0; j < 4; ++j) { o[j] += __shfl_xor(o[j], 16); o[j] += __shfl_xor(o[j], 32); }
            if (kg == 0) {
                const f32x4 z4 = *(const f32x4*)(zs + t * 512 + w * 64 + 4 * vq);
                const f32x4 y = (o + Dh * v4) * z4;
                u32x2 ov; ov.x = pk2(y[0], y[1]); ov.y = pk2(y[2], y[3]);
                *(u32x2*)(yz + (size_t)t * 4096 + h * 64 + 4 * vq) = ov;
            }
        }
#pragma unroll
        for (int i = 0; i < 32; ++i) *(f32x4*)(Sout + (size_t)i * ldS) = S[i];
    } else if constexpr (TYPE == 1) {
        float* qs = ldsf; float* ks = ldsf + 1024; float* vs = ldsf + 2048;
        unsigned short x1[4], x2[4], vr[4];
        const int hl = tid >> 7, isk = (tid >> 6) & 1, jf = tid & 63;
        if (tid < 256) {
            const int col = (isk ? 6176 : 5152) + (2 * u + hl) * 128 + jf;
#pragma unroll
            for (int t = 0; t < 4; ++t) { x1[t] = proj[(size_t)t * LDP + col]; x2[t] = proj[(size_t)t * LDP + col + 64]; }
        }
#pragma unroll
        for (int t = 0; t < 4; ++t) vr[t] = proj[(size_t)t * LDP + 7200 + (2 * u + (tid >> 8)) * 256 + (tid & 255)];
        f32x4 S[32];
#pragma unroll
        for (int i = 0; i < 32; ++i) S[i] = *(const f32x4*)(S0 + (size_t)i * ldS);
        if (tid < 256) {
            const float inv = exp2f(-(float)jf * 0.20762050593046014f);
            float* dst = isk ? ks : qs; const float sc = isk ? 0.08838834764831845f : 1.0f;
#pragma unroll
            for (int t = 0; t < 4; ++t) {
                const double rev = (double)(16384 + t) * (double)inv * 0.15915494309189535;
                const float fr = (float)(rev - floor(rev));
                const float sn = __builtin_amdgcn_sinf(fr), cs = __builtin_amdgcn_cosf(fr);
                const float a1 = bf2f(x1[t]) * sc, a2 = bf2f(x2[t]) * sc;
                dst[(t * 2 + hl) * 128 + jf] = a1 * cs - a2 * sn;
                dst[(t * 2 + hl) * 128 + 64 + jf] = a1 * sn + a2 * cs;
            }
        }
#pragma unroll
        for (int t = 0; t < 4; ++t) vs[(t * 2 + (tid >> 8)) * 256 + (tid & 255)] = bf2f(vr[t]);
        __syncthreads();
        const float gamma = 1.0f - exp2f(-5.0f - (float)h * (4.0f / 7.0f));
        const int hw = w >> 2;
#pragma unroll 1
        for (int t = 0; t < 4; ++t) {
            const f32x4 v4 = *(const f32x4*)(vs + (t * 2 + hw) * 256 + sl * 64 + 4 * vq);
            f32x4 o = (f32x4){0.f, 0.f, 0.f, 0.f};
#pragma unroll
            for (int i4 = 0; i4 < 8; ++i4) {
                const f32x4 q4 = *(const f32x4*)(qs + (t * 2 + hw) * 128 + 32 * kg + 4 * i4);
                const f32x4 k4 = *(const f32x4*)(ks + (t * 2 + hw) * 128 + 32 * kg + 4 * i4);
#pragma unroll
                for (int ii = 0; ii < 4; ++ii) { S[4 * i4 + ii] = gamma * S[4 * i4 + ii] + k4[ii] * v4; o += q4[ii] * S[4 * i4 + ii]; }
            }
#pragma unroll
            for (int j = 0; j < 4; ++j) { o[j] += __shfl_xor(o[j], 16); o[j] += __shfl_xor(o[j], 32); }
            if (kg == 0) {
                u32x2 ov; ov.x = pk2(o[0], o[1]); ov.y = pk2(o[2], o[3]);
                *(u32x2*)(yz + (size_t)t * 4096 + 2048 + h * 256 + sl * 64 + 4 * vq) = ov;
            }
        }
#pragma unroll
        for (int i = 0; i < 32; ++i) *(f32x4*)(Sout + (size_t)i * ldS) = S[i];
    } else {
        float* qs = ldsf; float* ks = ldsf + 2048; float* as = ldsf + 4096; float* vs = ldsf + 6144;
        unsigned short qr[4], fr_[4], vr[4];
        const int hl = tid >> 7, kk = tid & 127, col = (4 * u + hl) * 128 + kk;
#pragma unroll
        for (int t = 0; t < 4; ++t) { qr[t] = proj[(size_t)t * LDP + col]; fr_[t] = proj[(size_t)t * LDP + 2048 + col]; vr[t] = proj[(size_t)t * LDP + 4096 + col]; }
        const float lb = ((const float*)(p.ws + WS_LB))[col];
        f32x4 S[32];
#pragma unroll
        for (int i = 0; i < 32; ++i) S[i] = *(const f32x4*)(S0 + (size_t)i * ldS);
#pragma unroll
        for (int t = 0; t < 4; ++t) {
            const int o = (t * 4 + hl) * 128 + kk;
            qs[o] = silu(bf2f(qr[t]));
            const float f = lb + (1.0f - lb) * sigm(bf2f(fr_[t]));
            as[o] = f; ks[o] = 1.0f - f; vs[o] = bf2f(vr[t]);
        }
        __syncthreads();
        const int hw = w >> 1;
#pragma unroll 1
        for (int t = 0; t < 4; ++t) {
            const f32x4 v4 = *(const f32x4*)(vs + (t * 4 + hw) * 128 + sl * 64 + 4 * vq);
            f32x4 o = (f32x4){0.f, 0.f, 0.f, 0.f};
#pragma unroll
            for (int i4 = 0; i4 < 8; ++i4) {
                const int off = (t * 4 + hw) * 128 + 32 * kg + 4 * i4;
                const f32x4 q4 = *(const f32x4*)(qs + off), k4 = *(const f32x4*)(ks + off), a4 = *(const f32x4*)(as + off);
#pragma unroll
                for (int ii = 0; ii < 4; ++ii) { S[4 * i4 + ii] = a4[ii] * S[4 * i4 + ii] + k4[ii] * v4; o += q4[ii] * S[4 * i4 + ii]; }
            }
#pragma unroll
            for (int j = 0; j < 4; ++j) { o[j] += __shfl_xor(o[j], 16); o[j] += __shfl_xor(o[j], 32); }
            if (kg == 0) {
                u32x2 ov; ov.x = pk2(o[0], o[1]); ov.y = pk2(o[2], o[3]);
                *(u32x2*)(yz + (size_t)t * 4096 + h * 128 + sl * 64 + 4 * vq) = ov;
            }
        }
#pragma unroll
        for (int i = 0; i < 32; ++i) *(f32x4*)(Sout + (size_t)i * ldS) = S[i];
    }
}

#define CK_QS 0
#define CK_KS 17408
#define CK_KT 34816
#define CK_VT 53248
#define CK_PS 62464
#define CK_ST 71680
#define CK_CUM 89088
__device__ __forceinline__ bf16x8 ck_frag(const unsigned char* lds, int base, int pitch, int row, int kb, int q) {
    return *(const bf16x8*)(lds + base + row * pitch + (32 * kb + 8 * q) * 2);
}
template <int TYPE>
__device__ __forceinline__ void chunk_item(const Params& p, unsigned char* lds, int b, int h, int s) {
    int tid = threadIdx.x; asm volatile("" : "+v"(tid));
    const int w = tid >> 6, lane = tid & 63, r = lane & 15, q = lane >> 4;
    constexpr int LDP = TYPE < 2 ? LD0 : LD1;
    const bf16_t* proj = (const bf16_t*)(p.ws + WS_PROJ) + (size_t)(2048 * b) * LDP;
    bf16_t* yz = (bf16_t*)(p.ws + WS_YZ) + (size_t)(2048 * b) * 4096;
    const int I = w >> 1, Vn0 = 2 * (w & 1);
    const int c1 = tid & 127, tq = tid >> 7;
    const int cx = tid & 63, tx = tid >> 6;
    const int g = h >> 3;
    float cwC[4], cwB[4], cwX[4], cbC = 0.f, cbB = 0.f, cbX = 0.f, inv = 0.f, dtb = 0.f, Aneg = 0.f, Dh = 0.f;
    int colC = 0, colB = 0, colX = 0;
    if constexpr (TYPE == 0) {
        const int chC = 2560 + g * 128 + c1, chB = 2048 + g * 128 + c1, chX = h * 64 + cx;
        colC = 2048 + chC; colB = 2048 + chB; colX = 2048 + chX;
#pragma unroll
        for (int j = 0; j < 4; ++j) { cwC[j] = p.in[13 + p.z][j * 3072 + chC]; cwB[j] = p.in[13 + p.z][j * 3072 + chB]; cwX[j] = p.in[13 + p.z][j * 3072 + chX]; }
        cbC = p.in[14 + p.z][chC]; cbB = p.in[14 + p.z][chB]; cbX = p.in[14 + p.z][chX];
        dtb = p.in[15 + p.z][h]; Aneg = -__expf(p.in[16 + p.z][h]); Dh = p.in[17 + p.z][h];
    } else if constexpr (TYPE == 1) {
        const int isk = c1 >> 6, jf = c1 & 63;
        colC = (isk ? 6176 : 5152) + h * 128 + jf; colB = colC + 64; colX = 7200 + h * 256 + s * 64 + cx;
        inv = exp2f(-(float)jf * 0.20762050593046014f);
    } else {
        colC = h * 128 + c1; colB = 2048 + h * 128 + c1; colX = 4096 + h * 128 + s * 64 + cx;
        inv = ((const float*)(p.ws + WS_LB))[h * 128 + c1];
    }
    float* cumb = (float*)(lds + CK_CUM);
    if constexpr (TYPE == 1) {
        const float lg = __logf(1.0f - exp2f(-5.0f - (float)h * (4.0f / 7.0f)));
        if (tid < 64) {
#pragma unroll
            for (int bfi = 0; bfi < 2; ++bfi) { float* cb = cumb + bfi * 320; cb[tid] = (tid + 1) * lg; cb[64 + tid] = __expf((tid + 1) * lg); cb[128 + tid] = __expf((63 - tid) * lg); cb[192 + tid] = 1.0f; if (tid == 0) cb[256] = __expf(64.0f * lg); }
        }
    }
    for (int i = tid; i < 17408 / 4; i += 512) ((unsigned*)(lds + CK_ST))[i] = 0u;
    f32x4 Sacc[4];
#pragma unroll
    for (int i = 0; i < 4; ++i) Sacc[i] = (f32x4){0.f, 0.f, 0.f, 0.f};
    unsigned short xc[19], xb[19], xx[11], zr[8], dr = 0;
    auto load_raw = [&](int c) {
        const int t0 = 64 * c;
        if constexpr (TYPE == 0) {
#pragma unroll
            for (int i = 0; i < 19; ++i) { const int t = t0 + 16 * tq - 3 + i; xc[i] = 0; xb[i] = 0; if (t >= 0) { xc[i] = proj[(size_t)t * LDP + colC]; xb[i] = proj[(size_t)t * LDP + colB]; } }
#pragma unroll
            for (int i = 0; i < 11; ++i) { const int t = t0 + 8 * tx - 3 + i; xx[i] = 0; if (t >= 0) xx[i] = proj[(size_t)t * LDP + colX]; }
            if (w == 7) dr = proj[(size_t)(t0 + lane) * LDP + 5120 + h];
#pragma unroll
            for (int vv = 0; vv < 2; ++vv)
#pragma unroll
                for (int jx = 0; jx < 4; ++jx) zr[vv * 4 + jx] = proj[(size_t)(t0 + 16 * I + 4 * q + jx) * LDP + h * 64 + 16 * (Vn0 + vv) + r];
        } else {
#pragma unroll
            for (int i = 0; i < 16; ++i) { const int t = t0 + 16 * tq + i; xc[i] = proj[(size_t)t * LDP + colC]; xb[i] = proj[(size_t)t * LDP + colB]; }
#pragma unroll
            for (int i = 0; i < 8; ++i) xx[i] = proj[(size_t)(t0 + 8 * tx + i) * LDP + colX];
        }
    };
    load_raw(0);
    for (int c = 0; c < 32; ++c) {
        const int t0 = 64 * c;
        float* cum = cumb + (TYPE == 0 ? (c & 1) * 320 : 0);
        float vq_[16], vk_[16], vx_[8], kt_[16], Eval = 0.f;
        (void)kt_; (void)Eval;
        if constexpr (TYPE == 0) {
#pragma unroll
            for (int i = 0; i < 16; ++i) {
                vq_[i] = silu(cbC + cwC[0] * bf2f(xc[i]) + cwC[1] * bf2f(xc[i + 1]) + cwC[2] * bf2f(xc[i + 2]) + cwC[3] * bf2f(xc[i + 3]));
                vk_[i] = silu(cbB + cwB[0] * bf2f(xb[i]) + cwB[1] * bf2f(xb[i + 1]) + cwB[2] * bf2f(xb[i + 2]) + cwB[3] * bf2f(xb[i + 3]));
            }
#pragma unroll
            for (int i = 0; i < 8; ++i) vx_[i] = silu(cbX + cwX[0] * bf2f(xx[i]) + cwX[1] * bf2f(xx[i + 1]) + cwX[2] * bf2f(xx[i + 2]) + cwX[3] * bf2f(xx[i + 3]));
            if (w == 7) {
                const float dt = softplus(bf2f(dr) + dtb);
                float cs = dt * Aneg;
#pragma unroll
                for (int o = 1; o < 64; o <<= 1) { const float t = __shfl_up(cs, o); if (lane >= o) cs += t; }
                const float last = __shfl(cs, 63);
                cum[lane] = cs; cum[64 + lane] = __expf(cs); cum[128 + lane] = __expf(last - cs); cum[192 + lane] = dt;
                if (lane == 0) cum[256] = __expf(last);
            }
        } else if constexpr (TYPE == 2) {
            float lc[16], om[16];
            float run = 0.f;
#pragma unroll
            for (int i = 0; i < 16; ++i) { const float f = inv + (1.0f - inv) * sigm(bf2f(xb[i])); run += __logf(f); lc[i] = run; om[i] = 1.0f - f; }
#pragma unroll
            for (int i = 0; i < 16; ++i) { vq_[i] = silu(bf2f(xc[i])) * __expf(lc[i]); vk_[i] = om[i] * __expf(-lc[i]); kt_[i] = om[i] * __expf(run - lc[i]); }
            Eval = __expf(run);
#pragma unroll
            for (int i = 0; i < 8; ++i) vx_[i] = bf2f(xx[i]);
        } else {
#pragma unroll
            for (int i = 0; i < 16; ++i) {
                const double rev = (double)(t0 + 16 * tq + i) * (double)inv * 0.15915494309189535;
                const float fr = (float)(rev - floor(rev));
                const float sn = __builtin_amdgcn_sinf(fr), cs = __builtin_amdgcn_cosf(fr);
                const float a1 = bf2f(xc[i]), a2 = bf2f(xb[i]);
                vq_[i] = a1 * cs - a2 * sn; vk_[i] = a1 * sn + a2 * cs;
            }
#pragma unroll
            for (int i = 0; i < 8; ++i) vx_[i] = bf2f(xx[i]);
        }
        unsigned short zc[8];
#pragma unroll
        for (int i = 0; i < 8; ++i) zc[i] = zr[i];
        __syncthreads();
        if constexpr (TYPE == 0) {
            unsigned kt[8];
#pragma unroll
            for (int i = 0; i < 16; i += 2) {
                const int t = 16 * tq + i;
                const float k0 = vk_[i] * cum[192 + t], k1 = vk_[i + 1] * cum[192 + t + 1];
                *(bf16_t*)(lds + CK_QS + t * 272 + c1 * 2) = f2bf(vq_[i]); *(bf16_t*)(lds + CK_QS + (t + 1) * 272 + c1 * 2) = f2bf(vq_[i + 1]);
                *(bf16_t*)(lds + CK_KS + t * 272 + c1 * 2) = f2bf(k0); *(bf16_t*)(lds + CK_KS + (t + 1) * 272 + c1 * 2) = f2bf(k1);
                kt[i >> 1] = pk2(k0 * cum[128 + t], k1 * cum[128 + t + 1]);
            }
            *(u32x4*)(lds + CK_KT + c1 * 144 + 32 * tq) = (u32x4){kt[0], kt[1], kt[2], kt[3]};
            *(u32x4*)(lds + CK_KT + c1 * 144 + 32 * tq + 16) = (u32x4){kt[4], kt[5], kt[6], kt[7]};
        } else if constexpr (TYPE == 2) {
            unsigned kt[8];
#pragma unroll
            for (int i = 0; i < 16; i += 2) {
                const int t = 16 * tq + i;
                *(bf16_t*)(lds + CK_QS + t * 272 + c1 * 2) = f2bf(vq_[i]); *(bf16_t*)(lds + CK_QS + (t + 1) * 272 + c1 * 2) = f2bf(vq_[i + 1]);
                *(bf16_t*)(lds + CK_KS + t * 272 + c1 * 2) = f2bf(vk_[i]); *(bf16_t*)(lds + CK_KS + (t + 1) * 272 + c1 * 2) = f2bf(vk_[i + 1]);
                kt[i >> 1] = pk2(kt_[i], kt_[i + 1]);
            }
            *(u32x4*)(lds + CK_KT + c1 * 144 + 32 * tq) = (u32x4){kt[0], kt[1], kt[2], kt[3]};
            *(u32x4*)(lds + CK_KT + c1 * 144 + 32 * tq + 16) = (u32x4){kt[4], kt[5], kt[6], kt[7]};
            cum[tq * 128 + c1] = Eval;
        } else {
            const int isk = c1 >> 6, jf = c1 & 63;
            if (isk == 0) {
#pragma unroll
                for (int i = 0; i < 16; ++i) { const int t = 16 * tq + i; *(bf16_t*)(lds + CK_QS + t * 272 + jf * 2) = f2bf(vq_[i]); *(bf16_t*)(lds + CK_QS + t * 272 + (jf + 64) * 2) = f2bf(vk_[i]); }
            } else {
                unsigned kta[8], ktb[8];
#pragma unroll
                for (int i = 0; i < 16; i += 2) {
                    const int t = 16 * tq + i;
                    const float a0 = vq_[i] * 0.08838834764831845f, a1 = vq_[i + 1] * 0.08838834764831845f, b0 = vk_[i] * 0.08838834764831845f, b1 = vk_[i + 1] * 0.08838834764831845f;
                    *(bf16_t*)(lds + CK_KS + t * 272 + jf * 2) = f2bf(a0); *(bf16_t*)(lds + CK_KS + (t + 1) * 272 + jf * 2) = f2bf(a1);
                    *(bf16_t*)(lds + CK_KS + t * 272 + (jf + 64) * 2) = f2bf(b0); *(bf16_t*)(lds + CK_KS + (t + 1) * 272 + (jf + 64) * 2) = f2bf(b1);
                    kta[i >> 1] = pk2(a0 * cum[128 + t], a1 * cum[128 + t + 1]); ktb[i >> 1] = pk2(b0 * cum[128 + t], b1 * cum[128 + t + 1]);
                }
                *(u32x4*)(lds + CK_KT + jf * 144 + 32 * tq) = (u32x4){kta[0], kta[1], kta[2], kta[3]};
                *(u32x4*)(lds + CK_KT + jf * 144 + 32 * tq + 16) = (u32x4){kta[4], kta[5], kta[6], kta[7]};
                *(u32x4*)(lds + CK_KT + (jf + 64) * 144 + 32 * tq) = (u32x4){ktb[0], ktb[1], ktb[2], ktb[3]};
                *(u32x4*)(lds + CK_KT + (jf + 64) * 144 + 32 * tq + 16) = (u32x4){ktb[4], ktb[5], ktb[6], ktb[7]};
            }
        }
        *(u32x4*)(lds + CK_VT + cx * 144 + 16 * tx) = (u32x4){pk2(vx_[0], vx_[1]), pk2(vx_[2], vx_[3]), pk2(vx_[4], vx_[5]), pk2(vx_[6], vx_[7])};
        __syncthreads();
        if (c + 1 < 32) load_raw(c + 1);
        if constexpr (TYPE < 2) {
        bf16x8 aQ[4];
#pragma unroll
        for (int kb = 0; kb < 4; ++kb) aQ[kb] = ck_frag(lds, CK_QS, 272, 16 * I + r, kb, q);
        float cumi[4];
#pragma unroll
        for (int jx = 0; jx < 4; ++jx) cumi[jx] = cum[16 * I + 4 * q + jx];
#pragma unroll
        for (int jj = 0; jj < 2; ++jj) {
            const int J = Vn0 + jj;
            f32x4 acc = (f32x4){0.f, 0.f, 0.f, 0.f};
#pragma unroll
            for (int kb = 0; kb < 4; ++kb) acc = __builtin_amdgcn_mfma_f32_16x16x32_bf16(aQ[kb], ck_frag(lds, CK_KS, 272, 16 * J + r, kb, q), acc, 0, 0, 0);
            const int jcol = 16 * J + r; const float cumj = cum[jcol];
#pragma unroll
            for (int jx = 0; jx < 4; ++jx) {
                const int i = 16 * I + 4 * q + jx;
                const float v = (jcol <= i) ? acc[jx] * __expf(fminf(cumi[jx] - cumj, 0.f)) : 0.f;
                *(bf16_t*)(lds + CK_PS + i * 144 + jcol * 2) = f2bf(v);
            }
        }
        __syncthreads();
#pragma unroll
        for (int vv = 0; vv < 2; ++vv) {
            const int Vn = Vn0 + vv;
            f32x4 aPV = (f32x4){0.f, 0.f, 0.f, 0.f}, aQS = (f32x4){0.f, 0.f, 0.f, 0.f};
#pragma unroll
            for (int jb = 0; jb < 2; ++jb) aPV = __builtin_amdgcn_mfma_f32_16x16x32_bf16(ck_frag(lds, CK_PS, 144, 16 * I + r, jb, q), ck_frag(lds, CK_VT, 144, 16 * Vn + r, jb, q), aPV, 0, 0, 0);
#pragma unroll
            for (int kb = 0; kb < 4; ++kb) aQS = __builtin_amdgcn_mfma_f32_16x16x32_bf16(aQ[kb], ck_frag(lds, CK_ST, 272, 16 * Vn + r, kb, q), aQS, 0, 0, 0);
#pragma unroll
            for (int jx = 0; jx < 4; ++jx) {
                const int i = 16 * I + 4 * q + jx, v = 16 * Vn + r;
                const float o = aPV[jx] + cum[64 + i] * aQS[jx];
                if constexpr (TYPE == 0) {
                    const float xsv = bf2f(*(const bf16_t*)(lds + CK_VT + v * 144 + i * 2));
                    yz[(size_t)(t0 + i) * 4096 + h * 64 + v] = f2bf((o + Dh * xsv) * silu(bf2f(zc[vv * 4 + jx])));
                } else {
                    yz[(size_t)(t0 + i) * 4096 + 2048 + h * 256 + s * 64 + v] = f2bf(o);
                }
            }
        }
        __syncthreads();
        const float elast = cum[256];
#pragma unroll
        for (int Vn = 0; Vn < 4; ++Vn) {
            Sacc[Vn] = Sacc[Vn] * elast;
#pragma unroll
            for (int tb = 0; tb < 2; ++tb) Sacc[Vn] = __builtin_amdgcn_mfma_f32_16x16x32_bf16(ck_frag(lds, CK_KT, 144, 16 * w + r, tb, q), ck_frag(lds, CK_VT, 144, 16 * Vn + r, tb, q), Sacc[Vn], 0, 0, 0);
            *(u32x2*)(lds + CK_ST + (16 * Vn + r) * 272 + (16 * w + 4 * q) * 2) = (u32x2){pk2_sw(Sacc[Vn][0], Sacc[Vn][1]), pk2_sw(Sacc[Vn][2], Sacc[Vn][3])};
        }
            } else {
            const bf16x8 zf = (bf16x8){0, 0, 0, 0, 0, 0, 0, 0};
            if ((w & 1) == 0) {
                f32x4 acc = (f32x4){0.f, 0.f, 0.f, 0.f};
#pragma unroll
                for (int kb = 0; kb < 4; ++kb) acc = __builtin_amdgcn_mfma_f32_16x16x32_bf16(ck_frag(lds, CK_QS, 272, 16 * I + r, kb, q), ck_frag(lds, CK_KS, 272, 16 * I + r, kb, q), acc, 0, 0, 0);
#pragma unroll
                for (int jx = 0; jx < 4; ++jx) {
                    const float v = (r <= 4 * q + jx) ? acc[jx] : 0.f;
                    *(bf16_t*)(lds + CK_PS + (16 * I + 4 * q + jx) * 144 + (16 * I + r) * 2) = f2bf(v);
                }
            }
            __syncthreads();
#pragma unroll 1
            for (int sc = 0; sc < 4; ++sc) {
                if (w < 4) {
                    const int Vn = w;
                    f32x4 aO = (f32x4){0.f, 0.f, 0.f, 0.f};
                    const bf16x8 pa = (q < 2) ? *(const bf16x8*)(lds + CK_PS + (16 * sc + r) * 144 + (16 * sc + 8 * q) * 2) : zf;
                    const bf16x8 vb = (q < 2) ? *(const bf16x8*)(lds + CK_VT + (16 * Vn + r) * 144 + (16 * sc + 8 * q) * 2) : zf;
                    aO = __builtin_amdgcn_mfma_f32_16x16x32_bf16(pa, vb, aO, 0, 0, 0);
#pragma unroll
                    for (int kb = 0; kb < 4; ++kb) aO = __builtin_amdgcn_mfma_f32_16x16x32_bf16(ck_frag(lds, CK_QS, 272, 16 * sc + r, kb, q), ck_frag(lds, CK_ST, 272, 16 * Vn + r, kb, q), aO, 0, 0, 0);
#pragma unroll
                    for (int jx = 0; jx < 4; ++jx) yz[(size_t)(t0 + 16 * sc + 4 * q + jx) * 4096 + h * 128 + s * 64 + 16 * Vn + r] = (bf16_t)(pk2_sw(aO[jx], 0.f) & 0xffffu);
                }
                __syncthreads();
                {
                    const f32x4 e4 = *(const f32x4*)(cum + sc * 128 + 16 * w + 4 * q);
                    const bf16x8 ka = (q < 2) ? *(const bf16x8*)(lds + CK_KT + (16 * w + r) * 144 + (16 * sc + 8 * q) * 2) : zf;
#pragma unroll
                    for (int Vn = 0; Vn < 4; ++Vn) {
                        const bf16x8 vb = (q < 2) ? *(const bf16x8*)(lds + CK_VT + (16 * Vn + r) * 144 + (16 * sc + 8 * q) * 2) : zf;
                        Sacc[Vn] = __builtin_amdgcn_mfma_f32_16x16x32_bf16(ka, vb, Sacc[Vn] * e4, 0, 0, 0);
                        *(u32x2*)(lds + CK_ST + (16 * Vn + r) * 272 + (16 * w + 4 * q) * 2) = (u32x2){pk2_sw(Sacc[Vn][0], Sacc[Vn][1]), pk2_sw(Sacc[Vn][2], Sacc[Vn][3])};
                    }
                }
                __syncthreads();
            }
        }
    }
    const int ldS = TYPE == 0 ? 64 : (TYPE == 1 ? 256 : 128);
    float* Sout = p.out + (TYPE == 0 ? O_SSMP + ((size_t)(b * 32 + h) * 128) * 64 : (TYPE == 1 ? O_RETP + ((size_t)(b * 8 + h) * 128) * 256 + s * 64 : O_HGP + ((size_t)(b * 16 + h) * 128) * 128 + s * 64));
#pragma unroll
    for (int Vn = 0; Vn < 4; ++Vn)
#pragma unroll
        for (int jx = 0; jx < 4; ++jx) Sout[(size_t)(16 * w + 4 * q + jx) * ldS + 16 * Vn + r] = Sacc[Vn][jx];
}

__device__ __forceinline__ void lru_dec_unit(const Params& p, int b) {
    int tid = threadIdx.x; asm volatile("" : "+v"(tid));
    const int c = tid * 4;
    const int row0 = MP + 4 * b;
    const float* LA = (const float*)(p.ws + WS_LA) + (size_t)row0 * 2048 + c;
    const bf16_t* LBv = (const bf16_t*)(p.ws + WS_LBB) + (size_t)row0 * 2048 + c;
    const bf16_t* rg = (const bf16_t*)(p.ws + WS_PROJ) + (size_t)row0 * LD1 + 10240 + c;
    bf16_t* mixa = (bf16_t*)(p.ws + WS_ACT) + (size_t)row0 * 4096 + 2048 + c;
    f32x4 hst = *(const f32x4*)(p.in[6 + p.z] + (size_t)b * 2048 + c);
#pragma unroll
    for (int t = 0; t < 4; ++t) {
        const f32x4 a = *(const f32x4*)(LA + (size_t)t * 2048);
        float bb[4], gg[4]; unpack4(*(const u32x2*)(LBv + (size_t)t * 2048), bb); unpack4(*(const u32x2*)(rg + (size_t)t * LD1), gg);
        float y[4];
#pragma unroll
        for (int j = 0; j < 4; ++j) { hst[j] = a[j] * hst[j] + bb[j]; y[j] = hst[j] * gelu_tanh(gg[j]); }
        u32x2 ov; ov.x = pk2(y[0], y[1]); ov.y = pk2(y[2], y[3]);
        *(u32x2*)(mixa + (size_t)t * 4096) = ov;
    }
    *(f32x4*)(p.out + O_LRUS + (size_t)b * 2048 + c) = hst;
}

__device__ __forceinline__ void lru_scan_item(const Params& p, float* ldsf, int b, int cg) {
    int tid = threadIdx.x; asm volatile("" : "+v"(tid));
    const int w = tid >> 6, lane = tid & 63, c = cg * 64 + lane;
    const size_t row0 = (size_t)2048 * b + 256 * w;
    const float* LA = (const float*)(p.ws + WS_LA) + row0 * 2048 + c;
    const bf16_t* LBv = (const bf16_t*)(p.ws + WS_LBB) + row0 * 2048 + c;
    const bf16_t* rg = (const bf16_t*)(p.ws + WS_PROJ) + row0 * LD1 + 10240 + c;
    bf16_t* mixa = (bf16_t*)(p.ws + WS_ACT) + row0 * 4096 + 2048 + c;
    float hl = 0.f, pr = 1.f;
    for (int tb = 0; tb < 256; tb += 16) {
        float a0[16]; unsigned short b0[16];
#pragma unroll
        for (int t = 0; t < 16; ++t) { a0[t] = LA[(size_t)(tb + t) * 2048]; b0[t] = LBv[(size_t)(tb + t) * 2048]; }
#pragma unroll
        for (int t = 0; t < 16; ++t) { hl = a0[t] * hl + bf2f(b0[t]); pr *= a0[t]; }
    }
    ldsf[w * 128 + lane] = pr; ldsf[w * 128 + 64 + lane] = hl;
    __syncthreads();
    float hst = 0.f;
    for (int ww = 0; ww < w; ++ww) hst = ldsf[ww * 128 + lane] * hst + ldsf[ww * 128 + 64 + lane];
    for (int tb = 0; tb < 256; tb += 16) {
        float a0[16]; unsigned short b0[16], g0[16];
#pragma unroll
        for (int t = 0; t < 16; ++t) { a0[t] = LA[(size_t)(tb + t) * 2048]; b0[t] = LBv[(size_t)(tb + t) * 2048]; g0[t] = rg[(size_t)(tb + t) * LD1]; }
#pragma unroll
        for (int t = 0; t < 16; ++t) {
            hst = a0[t] * hst + bf2f(b0[t]);
            mixa[(size_t)(tb + t) * 4096] = f2bf(hst * gelu_tanh(bf2f(g0[t])));
        }
    }
    if (w == 7) p.out[O_LRUP + (size_t)b * 2048 + c] = hst;
}

__device__ __forceinline__ void phase_rec0(const Params& p, float* ldsf) {
    unsigned* ctr = (unsigned*)(p.ws + WS_CTL);
    const int total = 256 + 512 + 512;
    for (;;) {
        const int it = next_item(ctr, ldsf);
        if (it >= total) break;
        if (it < 128) chunk_item<0>(p, (unsigned char*)ldsf, it >> 5, it & 31, 0);
        else if (it < 256) { const int j = it - 128; chunk_item<1>(p, (unsigned char*)ldsf, j >> 5, (j & 31) >> 2, j & 3); }
        else if (it < 768) { const int j = it - 256; dec_unit<0>(p, ldsf, j >> 2, j & 3); }
        else { const int j = it - 768; dec_unit<1>(p, ldsf, j >> 2, j & 3); }
    }
}
__device__ __forceinline__ void phase_rec1(const Params& p, float* ldsf) {
    unsigned* ctr = (unsigned*)(p.ws + WS_CTL) + 64;
    const int total = 128 + 128 + 512 + 128;
    for (;;) {
        const int it = next_item(ctr, ldsf);
        if (it >= total) break;
        if (it < 128) chunk_item<2>(p, (unsigned char*)ldsf, it >> 5, (it & 31) >> 1, it & 1);
        else if (it < 256) { const int j = it - 128; lru_scan_item(p, ldsf, j >> 5, j & 31); }
        else if (it < 768) { const int j = it - 256; dec_unit<2>(p, ldsf, j >> 2, j & 3); }
        else lru_dec_unit(p, it - 768);
    }
}

__device__ __forceinline__ void seq_of_row(int row, int& sample, int& b, int& t, int& L) {
    if (row < MP) { sample = 0; b = row >> 11; t = row & 2047; L = 2048; } else { sample = 1; b = (row - MP) >> 2; t = (row - MP) & 3; L = 4; }
}

__device__ __forceinline__ void phase_prep0(const Params& p) {
    int tid = threadIdx.x; asm volatile("" : "+v"(tid));
    const int wave = tid >> 6, lane = tid & 63;
    const int gw = blockIdx.x * 8 + wave, NGW = gridDim.x * 8;
    const bf16_t* YZ = (const bf16_t*)(p.ws + WS_YZ); const bf16_t* PR = (const bf16_t*)(p.ws + WS_PROJ);
    bf16_t* MX = (bf16_t*)(p.ws + WS_ACT);
    const float* nw = p.in[18 + p.z];
    for (int row = gw; row < MT; row += NGW) {
        const bf16_t* yz = YZ + (size_t)row * 4096; bf16_t* mx = MX + (size_t)row * 4096;
#pragma unroll 1
        for (int g = 0; g < 4; ++g) {
            const int c = g * 512 + lane * 8;
            float v[8]; unpack8(*(const u32x4*)(yz + c), v);
            float s = 0.f;
#pragma unroll
            for (int j = 0; j < 8; ++j) s += v[j] * v[j];
            s = wave_sum(s);
            const float rs = rsqrtf(s * (1.0f / 512.0f) + EPS);
            const f32x4 n0 = *(const f32x4*)(nw + c), n1 = *(const f32x4*)(nw + c + 4);
            u32x4 o; o.x = pk2(v[0] * rs * n0[0], v[1] * rs * n0[1]); o.y = pk2(v[2] * rs * n0[2], v[3] * rs * n0[3]);
            o.z = pk2(v[4] * rs * n1[0], v[5] * rs * n1[1]); o.w = pk2(v[6] * rs * n1[2], v[7] * rs * n1[3]);
            *(u32x4*)(mx + c) = o;
        }
#pragma unroll 2
        for (int hh = 0; hh < 8; ++hh) {
            const int c = hh * 256 + lane * 4;
            float v[4]; unpack4(*(const u32x2*)(yz + 2048 + c), v);
            float gt[4]; unpack4(*(const u32x2*)(PR + (size_t)row * LD0 + 9248 + c), gt);
            float s = (v[0] * v[0] + v[1] * v[1]) + (v[2] * v[2] + v[3] * v[3]);
            s = wave_sum(s);
            const float rs = rsqrtf(s * (1.0f / 256.0f) + EPS);
            u32x2 o; o.x = pk2(v[0] * rs * silu(gt[0]), v[1] * rs * silu(gt[1])); o.y = pk2(v[2] * rs * silu(gt[2]), v[3] * rs * silu(gt[3]));
            *(u32x2*)(mx + 2048 + c) = o;
        }
        int sample, b, t, L; seq_of_row(row, sample, b, t, L);
        if (t >= L - 3) {
            float* dst = p.out + (sample ? O_SCS : O_SCP) + ((size_t)b * 3 + (t - (L - 3))) * 3072;
            const bf16_t* src = PR + (size_t)row * LD0 + 2048;
#pragma unroll 4
            for (int c = lane; c < 3072; c += 64) dst[c] = bf2f(src[c]);
        }
    }
}

__device__ __forceinline__ void phase_prep1(const Params& p) {
    int tid = threadIdx.x; asm volatile("" : "+v"(tid));
    const int wave = tid >> 6, lane = tid & 63;
    const int gw = blockIdx.x * 8 + wave, NGW = gridDim.x * 8;
    const bf16_t* YZ = (const bf16_t*)(p.ws + WS_YZ); const bf16_t* PR = (const bf16_t*)(p.ws + WS_PROJ);
    bf16_t* MX = (bf16_t*)(p.ws + WS_ACT);
    const float* nw = p.in[22 + p.z];
    for (int row = gw; row < MT; row += NGW) {
#pragma unroll 1
        for (int it = 0; it < 4; ++it) {
            const int c = it * 512 + lane * 8;
            float v[8]; unpack8(*(const u32x4*)(YZ + (size_t)row * 4096 + c), v);
            float gt[8]; unpack8(*(const u32x4*)(PR + (size_t)row * LD1 + 6144 + c), gt);
            float s = 0.f;
#pragma unroll
            for (int j = 0; j < 8; ++j) s += v[j] * v[j];
            s += __shfl_xor(s, 1); s += __shfl_xor(s, 2); s += __shfl_xor(s, 4); s += __shfl_xor(s, 8);
            const float rs = rsqrtf(s * (1.0f / 128.0f) + EPS);
            const f32x4 n0 = *(const f32x4*)(nw + (c & 127)), n1 = *(const f32x4*)(nw + (c & 127) + 4);
            float o[8];
#pragma unroll
            for (int j = 0; j < 8; ++j) o[j] = v[j] * rs * (j < 4 ? n0[j] : n1[j - 4]) * silu(gt[j]);
            u32x4 ov; ov.x = pk2(o[0], o[1]); ov.y = pk2(o[2], o[3]); ov.z = pk2(o[4], o[5]); ov.w = pk2(o[6], o[7]);
            *(u32x4*)(MX + (size_t)row * 4096 + c) = ov;
        }
    }
}

__device__ __forceinline__ void phase_act(const Params& p, int l) {
    const bf16_t* PR = (const bf16_t*)(p.ws + WS_PROJ); bf16_t* ACT = (bf16_t*)(p.ws + WS_ACT);
    const float* cw = p.in[32 + p.z] + (size_t)l * 3 * DFF; const float* cbv = p.in[33 + p.z] + (size_t)l * DFF;
    const float* st = p.in[8 + p.z] + (size_t)l * 128 * 2 * DFF;
    const int total = MT * 704;
    for (int idx = blockIdx.x * 512 + threadIdx.x; idx < total; idx += gridDim.x * 512) {
        const int row = idx / 704, c = (idx - row * 704) * 8;
        int sample, b, t, L; seq_of_row(row, sample, b, t, L);
        float g2[8], g1[8], g0[8], uu[8];
        unpack8(*(const u32x4*)(PR + (size_t)row * LDU + c), g2);
        unpack8(*(const u32x4*)(PR + (size_t)row * LDU + DFF + c), uu);
        if (t >= 1) unpack8(*(const u32x4*)(PR + (size_t)(row - 1) * LDU + c), g1);
        else {
#pragma unroll
            for (int j = 0; j < 8; ++j) g1[j] = sample ? st[((size_t)b * 2 + 1) * DFF + c + j] : 0.f;
        }
        if (t >= 2) unpack8(*(const u32x4*)(PR + (size_t)(row - 2) * LDU + c), g0);
        else {
#pragma unroll
            for (int j = 0; j < 8; ++j) g0[j] = sample ? st[((size_t)b * 2 + t) * DFF + c + j] : 0.f;
        }
        float o[8];
#pragma unroll
        for (int j = 0; j < 8; ++j) {
            const float y = cbv[c + j] + cw[c + j] * g0[j] + cw[DFF + c + j] * g1[j] + cw[2 * DFF + c + j] * g2[j];
            o[j] = silu(y) * uu[j];
        }
        u32x4 ov; ov.x = pk2(o[0], o[1]); ov.y = pk2(o[2], o[3]); ov.z = pk2(o[4], o[5]); ov.w = pk2(o[6], o[7]);
        *(u32x4*)(ACT + (size_t)row * DFF + c) = ov;
        if (t >= L - 2) {
            float* dst = p.out + (sample ? O_FCS + (((size_t)l * 128 + b) * 2 + (t - (L - 2))) * DFF : O_FCP + (((size_t)l * 4 + b) * 2 + (t - (L - 2))) * DFF) + c;
            *(f32x4*)dst = (f32x4){g2[0], g2[1], g2[2], g2[3]}; *(f32x4*)(dst + 4) = (f32x4){g2[4], g2[5], g2[6], g2[7]};
        }
    }
}

__device__ __forceinline__ void phase_lruconv(const Params& p) {
    const bf16_t* PR = (const bf16_t*)(p.ws + WS_PROJ); bf16_t* XR = (bf16_t*)(p.ws + WS_XR);
    const float* cw = p.in[23 + p.z]; const float* cbv = p.in[24 + p.z]; const float* st = p.in[7 + p.z];
    const int total = MT * 256;
    for (int idx = blockIdx.x * 512 + threadIdx.x; idx < total; idx += gridDim.x * 512) {
        const int row = idx >> 8, c = (idx & 255) * 8;
        int sample, b, t, L; seq_of_row(row, sample, b, t, L);
        float x[4][8];
#pragma unroll
        for (int j = 0; j < 4; ++j) {
            const int tt = t + j - 3;
            if (tt >= 0) unpack8(*(const u32x4*)(PR + (size_t)(row + j - 3) * LD1 + 8192 + c), x[j]);
            else {
#pragma unroll
                for (int i = 0; i < 8; ++i) x[j][i] = sample ? st[((size_t)b * 3 + (t + j)) * 2048 + c + i] : 0.f;
            }
        }
        float o[8];
#pragma unroll
        for (int i = 0; i < 8; ++i) o[i] = cbv[c + i] + cw[c + i] * x[0][i] + cw[2048 + c + i] * x[1][i] + cw[4096 + c + i] * x[2][i] + cw[6144 + c + i] * x[3][i];
        u32x4 ov; ov.x = pk2(o[0], o[1]); ov.y = pk2(o[2], o[3]); ov.z = pk2(o[4], o[5]); ov.w = pk2(o[6], o[7]);
        *(u32x4*)(XR + (size_t)row * 2048 + c) = ov;
        if (t >= L - 3) {
            float* dst = p.out + (sample ? O_LCS : O_LCP) + ((size_t)b * 3 + (t - (L - 3))) * 2048 + c;
            *(f32x4*)dst = (f32x4){x[3][0], x[3][1], x[3][2], x[3][3]}; *(f32x4*)(dst + 4) = (f32x4){x[3][4], x[3][5], x[3][6], x[3][7]};
        }
    }
}

__device__ __forceinline__ void finalize_sample_rows(const Params& p, float* ssdst, int nsplit) {
    int tid = threadIdx.x; asm volatile("" : "+v"(tid));
    const int wave = tid >> 6, lane = tid & 63;
    const int gw = blockIdx.x * 8 + wave, NGW = gridDim.x * 8;
    float* X = (float*)(p.ws + WS_X); bf16_t* XB = (bf16_t*)(p.ws + WS_XB); const float* PT = (const float*)(p.ws + WS_PROJ);
    for (int row = MP + gw; row < MT; row += NGW) {
        float s = 0.f;
#pragma unroll 2
        for (int j = 0; j < 8; ++j) {
            const unsigned o = (unsigned)row * 2048u + (unsigned)(lane + 64 * j) * 4u;
            f32x4 v = *(const f32x4*)(X + o);
            for (int ks = 0; ks < nsplit; ++ks) v += *(const f32x4*)(PT + (size_t)ks * (512 * 2048) + (o - (unsigned)MP * 2048u));
            *(f32x4*)(X + o) = v;
            u32x2 w; w.x = pk2(v[0], v[1]); w.y = pk2(v[2], v[3]);
            *(u32x2*)(XB + o) = w;
            s += (v[0] * v[0] + v[1] * v[1]) + (v[2] * v[2] + v[3] * v[3]);
        }
        s = wave_sum(s);
        if (lane == 0) ssdst[row] = s;
    }
}

__device__ __forceinline__ void phase_final(const Params& p) {
    int tid = threadIdx.x; asm volatile("" : "+v"(tid));
    const int wave = tid >> 6, lane = tid & 63;
    const int gw = blockIdx.x * 8 + wave, NGW = gridDim.x * 8;
    const float* X = (const float*)(p.ws + WS_X); const float* nf = p.in[11 + p.z];
    for (int row = gw; row < MT; row += NGW) {
        f32x4 v[8]; float sq = 0.f;
#pragma unroll
        for (int j = 0; j < 8; ++j) { v[j] = *(const f32x4*)(X + (size_t)row * 2048 + (lane + 64 * j) * 4);
            if (row >= MP) { for (int ks = 0; ks < 11; ++ks) v[j] += *(const f32x4*)((const float*)(p.ws + WS_PROJ) + (size_t)ks * (512 * 2048) + (size_t)(row - MP) * 2048 + (lane + 64 * j) * 4); }
            sq += (v[j][0] * v[j][0] + v[j][1] * v[j][1]) + (v[j][2] * v[j][2] + v[j][3] * v[j][3]); }
        sq = wave_sum(sq);
        const float rs = rsqrtf(sq * (1.0f / 2048.0f) + EPS);
        float* dst = p.out + (row < MP ? O_YP + (size_t)row * 2048 : O_YS + (size_t)(row - MP) * 2048);
#pragma unroll
        for (int j = 0; j < 8; ++j) {
            const int c = (lane + 64 * j) * 4;
            *(f32x4*)(dst + c) = v[j] * rs * *(const f32x4*)(nf + c);
        }
    }
}

#define XB_TMO      128
#define XB_XCNT(j)  (256  + 64 * (j))
#define XB_XSUB(j)  (1280 + 64 * (j))
#define XB_XGEN(j)  (2304 + 64 * (j))
#define XB_TOP      3328
#define XB_TOPGEN   3392
#define XCD_BAR_WORDS 3456
#define XB_SPIN_CAP (1u << 22)
__device__ __forceinline__ unsigned xb_ld(unsigned* p)              { return __hip_atomic_load(p, __ATOMIC_RELAXED, __HIP_MEMORY_SCOPE_AGENT); }
__device__ __forceinline__ unsigned xb_add(unsigned* p, unsigned v) { return __hip_atomic_fetch_add(p, v, __ATOMIC_RELAXED, __HIP_MEMORY_SCOPE_AGENT); }
__device__ __forceinline__ unsigned xb_xcc_id() { return (unsigned)__builtin_amdgcn_s_getreg((3 << 11) | 20) & 0xFu; }
#define XB_SPIN(cond, bar) do { unsigned _sp = 0; while (cond) { __builtin_amdgcn_s_sleep(1); \
    if ((++_sp & 255u) == 0u) { if (xb_ld(&(bar)[XB_TMO])) break; if (_sp > XB_SPIN_CAP) { atomicAdd(&(bar)[XB_TMO], 1u); break; } } } } while (0)
struct XcdBarrier { unsigned* bar; unsigned x; volatile LAS unsigned* st; };
__device__ __forceinline__ XcdBarrier xcd_barrier_post(unsigned* bar, volatile LAS unsigned* st) {
    XcdBarrier b; b.bar = bar; b.x = xb_xcc_id(); b.st = st;
    if (threadIdx.x == 0) (void)xb_add(&bar[XB_XCNT(b.x)], 1u);
    return b;
}
__device__ __forceinline__ void xcd_barrier_complete(unsigned* bar, unsigned x, unsigned& nloc, unsigned& nx) {
    const unsigned G = gridDim.x * gridDim.y * gridDim.z;
    unsigned sum, cnt, mine, sp = 0u;
    for (;;) {
        sum = 0u; cnt = 0u; mine = 0u;
#pragma unroll
        for (unsigned j = 0; j < 16; ++j) { const unsigned c = xb_ld(&bar[XB_XCNT(j)]); sum += c; cnt += (c > 0u) ? 1u : 0u; mine = (j == x) ? c : mine; }
        if (sum == G) break;
        __builtin_amdgcn_s_sleep(1);
        if ((++sp & 255u) == 0u) { if (xb_ld(&bar[XB_TMO])) break; if (sp > XB_SPIN_CAP) { atomicAdd(&bar[XB_TMO], 1u); break; } }
    }
    nloc = mine > 0u ? mine : 1u; nx = cnt > 0u ? cnt : 1u;
}
__device__ __forceinline__ void xcd_barrier(const XcdBarrier& b) {
    asm volatile("s_waitcnt vmcnt(0)" ::: "memory");
    __syncthreads();
    if (threadIdx.x == 0) {
        unsigned* bar = b.bar;
        __builtin_amdgcn_s_waitcnt(0);
        unsigned nloc = b.st[0], nx = b.st[1];
        if (nloc == 0u) { xcd_barrier_complete(bar, b.x, nloc, nx); b.st[0] = nloc; b.st[1] = nx; }
        const unsigned old = xb_add(&bar[XB_XSUB(b.x)], 1u);
        const unsigned gen = old / nloc;
        if (old + 1u == (gen + 1u) * nloc) {
            __builtin_amdgcn_fence(__ATOMIC_RELEASE, "agent");
            asm volatile("s_waitcnt vmcnt(0)" ::: "memory");
            const unsigned og = xb_add(&bar[XB_TOP], 1u);
            const unsigned tg = og / nx;
            if (og + 1u == (tg + 1u) * nx) xb_add(&bar[XB_TOPGEN], 1u);
            else XB_SPIN(xb_ld(&bar[XB_TOPGEN]) == tg, bar);
            __builtin_amdgcn_fence(__ATOMIC_ACQUIRE, "agent");
            xb_add(&bar[XB_XGEN(b.x)], 1u);
            asm volatile("s_waitcnt vmcnt(0)" ::: "memory");
        } else {
            XB_SPIN(xb_ld(&bar[XB_XGEN(b.x)]) == gen, bar);
            __builtin_amdgcn_fence(__ATOMIC_ACQUIRE, "agent");
            asm volatile("s_waitcnt vmcnt(0)" ::: "memory");
        }
    }
    __syncthreads();
}

#ifndef PROBE_MASK
#define PROBE_MASK 0u
#endif
#ifndef PHMASK
#define PHMASK 0xFFFFFFFFu
#endif
#define EN(i) (((PHMASK) >> (i)) & 1u)
__global__ void __launch_bounds__(512, 2) fwd_megakernel(Params p) {
    extern __shared__ __attribute__((aligned(16))) unsigned char shm[];
    float* ldsf = (float*)shm;
    LAS unsigned char* ldsg = (LAS unsigned char*)shm;
    unsigned char* ws = p.ws;
    float* ssb = (float*)(ws + WS_SS);
    volatile LAS unsigned* xst = (volatile LAS unsigned*)(ldsg + 133120);
    if (threadIdx.x == 0) { xst[0] = 0u; xst[1] = 0u; }
    __syncthreads();
    (void)xcd_barrier_post((unsigned*)(ws + WS_CTL) + 256, xst);
#define XBAR() do { XcdBarrier _b; _b.bar = (unsigned*)(p.ws + WS_CTL) + 256; _b.x = xb_xcc_id(); _b.st = (volatile LAS unsigned*)((LAS unsigned char*)shm + 133120); xcd_barrier(_b); } while (0)
#if PROBE_MASK
    unsigned long long tph = __builtin_amdgcn_s_memrealtime();
#endif
    for (int ph = p.ph_lo; ph < p.ph_hi; ++ph) {
        if (ph > p.ph_lo) {
            if (ph == 1) cg::this_grid().sync();
            else XBAR();
#if PROBE_MASK
            {
                const unsigned long long t1 = __builtin_amdgcn_s_memrealtime();
                if ((PROBE_MASK >> (ph - 1)) & 1u) { const unsigned long long dt = t1 - tph; while (__builtin_amdgcn_s_memrealtime() - t1 < dt) __builtin_amdgcn_s_sleep(8); }
                tph = __builtin_amdgcn_s_memrealtime();
            }
#endif
        }
        if (EN(0) && ph == 0) phase_prologue(p, ldsf);
        else if (EN(1) && (ph == 1 || ph == 5 || ph == 8 || ph == 14)) {
            pg8::Gemm g; pg8::EpiScaleBf16 E; int N;
            if (ph != 1) { finalize_sample_rows(p, ssb + (ph == 5 ? 1 : (ph == 8 ? 2 : 3)) * MT, ph == 8 ? 11 : 16); XBAR(); }
            g.A = (const char*)(ws + WS_XB); g.lda = 2048; g.ldb = 2048;
            if (ph == 1) { g.Bt = (const char*)(ws + WS_WIN0); N = LD0; E.ss = ssb; }
            else if (ph == 5) { g.Bt = (const char*)(ws + WS_WUP0); N = LDU; E.ss = ssb + MT; }
            else if (ph == 8) { g.Bt = (const char*)(ws + WS_WIN1); N = LD1; E.ss = ssb + 2 * MT; }
            else { g.Bt = (const char*)(ws + WS_WUP1); N = LDU; E.ss = ssb + 3 * MT; }
            E.O = (bf16_t*)(ws + WS_PROJ); E.ldc = N;
            pg8::Order S; S.nMm = 32; S.nN = N / 256; S.n_main = 32 * S.nN; S.n_tail = 2 * S.nN; S.ksplit = 1; S.nt_full = 32; S.G = gridDim.x; S.c = blockIdx.x;
            S.a_t = (size_t)256 * 2048 * 2; S.b_t = (size_t)256 * 2048 * 2; S.acol = 0;
            pg8::gemm_phase<pg8::EpiScaleBf16>(ldsg, g, S, E);
        }
        else if (EN(4) && (ph == 4 || ph == 7 || ph == 13 || ph == 16)) {
            pg8::Gemm g; pg8::EpiResid E;
            g.A = (const char*)(ws + WS_ACT);
            if (ph == 4) { g.Bt = (const char*)(ws + WS_WOUT0); g.lda = 4096; E.ssout = ssb + MT; }
            else if (ph == 7) { g.Bt = (const char*)(ws + WS_WDN0); g.lda = DFF; E.ssout = ssb + 2 * MT; }
            else if (ph == 13) { g.Bt = (const char*)(ws + WS_WOUT1); g.lda = 4096; E.ssout = ssb + 3 * MT; }
            else { g.Bt = (const char*)(ws + WS_WDN1); g.lda = DFF; E.ssout = ssb + 4 * MT; }
            g.ldb = g.lda;
            E.X = (float*)(ws + WS_X); E.XB = (bf16_t*)(ws + WS_XB); E.part = (float*)(ws + WS_PROJ);
            pg8::Order S; S.nMm = 32; S.nN = 8; S.n_main = 256; S.nt_full = g.lda / 64; S.ksplit = (g.lda == 4096) ? 16 : 11; S.n_tail = 16 * S.ksplit; S.G = gridDim.x; S.c = blockIdx.x;
            S.a_t = (size_t)256 * g.lda * 2; S.b_t = (size_t)256 * g.ldb * 2; S.acol = 0;
            pg8::gemm_phase<pg8::EpiResid>(ldsg, g, S, E);
        }
        else if (EN(10) && ph == 10) {
            pg8::Gemm g; pg8::EpiLru E;
            g.A = (const char*)(ws + WS_XR); g.Bt = (const char*)(ws + WS_WLRU); g.lda = 2048; g.ldb = 256;
            E.br = p.in[26 + p.z]; E.bi = p.in[28 + p.z]; E.sp = (const float*)(ws + WS_SP); E.XR = (const bf16_t*)(ws + WS_XR);
            E.LA = (float*)(ws + WS_LA); E.LBv = (bf16_t*)(ws + WS_LBB);
            pg8::Order S; S.nMm = 34; S.nN = 16; S.n_main = 34 * 16; S.n_tail = 0; S.ksplit = 1; S.nt_full = 4 + p.z; S.G = gridDim.x; S.c = blockIdx.x;
            S.a_t = (size_t)256 * 2048 * 2; S.b_t = (size_t)256 * 256 * 2; S.acol = 512;
            pg8::gemm_phase<pg8::EpiLru>(ldsg, g, S, E);
        }
        else if (EN(2) && ph == 2) phase_rec0(p, ldsf);
        else if (EN(3) && ph == 3) phase_prep0(p);
        else if (EN(6) && ph == 6) phase_act(p, 0);
        else if (EN(9) && ph == 9) phase_lruconv(p);
        else if (EN(11) && ph == 11) phase_rec1(p, ldsf);
        else if (EN(12) && ph == 12) phase_prep1(p);
        else if (EN(15) && ph == 15) phase_act(p, 1);
        else if (EN(17) && ph == 17) phase_final(p);
    }
}

#ifndef N_LAUNCH_MODE
#define N_LAUNCH_MODE 0
#endif

extern "C" void kernel_launch(void* const* d_in, const int* in_sizes, int n_in, void* d_out, int out_size, void* d_ws, size_t ws_size, hipStream_t stream) {
    static int grid = 0;
    if (grid == 0) {
        if (n_in != 35 || (size_t)out_size != O_END || ws_size < WS_END) { fprintf(stderr, "kernel_launch: unexpected shapes: n_in %d out %d ws %zu (need %zu)\n", n_in, out_size, ws_size, (size_t)WS_END); grid = -1; return; }
        int dev = 0, cus = 0, per_cu = 0;
        hipGetDevice(&dev);
        hipDeviceGetAttribute(&cus, hipDeviceAttributeMultiprocessorCount, dev);
        if (hipFuncSetAttribute((const void*)fwd_megakernel, hipFuncAttributeMaxDynamicSharedMemorySize, LDS_BYTES) != hipSuccess) { fprintf(stderr, "kernel_launch: hipFuncSetAttribute failed\n"); grid = -1; return; }
        if (hipOccupancyMaxActiveBlocksPerMultiprocessor(&per_cu, (const void*)fwd_megakernel, 512, LDS_BYTES) != hipSuccess || per_cu < 1) { fprintf(stderr, "kernel_launch: occupancy query says %d\n", per_cu); per_cu = 1; }
        (void)hipGetLastError();
        grid = cus;
    }
    if (grid < 0) return;
    (void)hipMemsetAsync((char*)d_ws + WS_CTL, 0, 16384, stream);
    Params p{};
    for (int i = 0; i < 35; ++i) p.in[i] = (const float*)d_in[i];
    p.z = 0; p.pad = 0;
    p.out = (float*)d_out; p.ws = (unsigned char*)d_ws;
#if N_LAUNCH_MODE == 0
    p.ph_lo = 0; p.ph_hi = NPHASE;
    void* args[] = {&p};
    hipError_t e = hipLaunchCooperativeKernel((const void*)fwd_megakernel, dim3(grid), dim3(512), args, LDS_BYTES, stream);
    if (e != hipSuccess) fprintf(stderr, "cooperative launch failed: %s (grid %d)\n", hipGetErrorString(e), grid);
#else
    for (int ph = 0; ph < NPHASE; ++ph) {
        p.ph_lo = ph; p.ph_hi = ph + 1;
        hipLaunchKernelGGL(fwd_megakernel, dim3(grid), dim3(512), LDS_BYTES, stream, p);
    }
#endif
}
```

```cpp
#include <hip/hip_runtime.h>
#include <hip/hip_cooperative_groups.h>
#include <cstdio>
#include <cstdint>
namespace cg = cooperative_groups;

#define LAS __attribute__((address_space(3)))
typedef unsigned short bf16_t;
typedef short bf16x8 __attribute__((ext_vector_type(8)));
typedef float f32x4 __attribute__((ext_vector_type(4)));
typedef float f32x2 __attribute__((ext_vector_type(2)));
typedef unsigned u32x4 __attribute__((ext_vector_type(4)));
typedef unsigned u32x2 __attribute__((ext_vector_type(2)));

constexpr int D = 2048, MP = 8192, MS = 512, MT = 8704;
constexpr int LD0 = 11520, LD1 = 12288, LDU = 11264, DFF = 5632;
constexpr float EPS = 1e-6f;
constexpr size_t O_YP = 0;
constexpr size_t O_YS = O_YP + (size_t)4 * 2048 * 2048;
constexpr size_t O_SSMP = O_YS + (size_t)128 * 4 * 2048;
constexpr size_t O_SSMS = O_SSMP + (size_t)4 * 32 * 128 * 64;
constexpr size_t O_SCP = O_SSMS + (size_t)128 * 32 * 128 * 64;
constexpr size_t O_SCS = O_SCP + (size_t)4 * 3 * 3072;
constexpr size_t O_RETP = O_SCS + (size_t)128 * 3 * 3072;
constexpr size_t O_RETS = O_RETP + (size_t)4 * 8 * 128 * 256;
constexpr size_t O_HGP = O_RETS + (size_t)128 * 8 * 128 * 256;
constexpr size_t O_HGS = O_HGP + (size_t)4 * 16 * 128 * 128;
constexpr size_t O_LRUP = O_HGS + (size_t)128 * 16 * 128 * 128;
constexpr size_t O_LRUS = O_LRUP + (size_t)4 * 2048;
constexpr size_t O_LCP = O_LRUS + (size_t)128 * 2048;
constexpr size_t O_LCS = O_LCP + (size_t)4 * 3 * 2048;
constexpr size_t O_FCP = O_LCS + (size_t)128 * 3 * 2048;
constexpr size_t O_FCS = O_FCP + (size_t)2 * 4 * 2 * 5632;
constexpr size_t O_END = O_FCS + (size_t)2 * 128 * 2 * 5632;
constexpr size_t al256(size_t x) { return (x + 255) & ~(size_t)255; }
constexpr size_t WS_CTL = 0;
constexpr size_t WS_SS = 16384;
constexpr size_t WS_SP = al256(WS_SS + (size_t)5 * MT * 4);
constexpr size_t WS_LB = WS_SP + 8192;
constexpr size_t WS_WIN0 = WS_LB + 8192;
constexpr size_t WS_WOUT0 = WS_WIN0 + (size_t)LD0 * 2048 * 2;
constexpr size_t WS_WUP0 = WS_WOUT0 + (size_t)2048 * 4096 * 2;
constexpr size_t WS_WDN0 = WS_WUP0 + (size_t)LDU * 2048 * 2;
constexpr size_t WS_WIN1 = WS_WDN0 + (size_t)2048 * DFF * 2;
constexpr size_t WS_WOUT1 = WS_WIN1 + (size_t)LD1 * 2048 * 2;
constexpr size_t WS_WUP1 = WS_WOUT1 + (size_t)2048 * 4096 * 2;
constexpr size_t WS_WDN1 = WS_WUP1 + (size_t)LDU * 2048 * 2;
constexpr size_t WS_WLRU = WS_WDN1 + (size_t)2048 * DFF * 2;
constexpr size_t WS_X = WS_WLRU + (size_t)16 * 256 * 256 * 2;
constexpr size_t WS_XB = WS_X + (size_t)MT * 2048 * 4;
constexpr size_t WS_PROJ = WS_XB + (size_t)MT * 2048 * 2;
constexpr size_t WS_ACT = WS_PROJ + (size_t)MT * LD1 * 2;
constexpr size_t WS_YZ = WS_ACT + (size_t)MT * DFF * 2;
constexpr size_t WS_LA = WS_YZ + (size_t)MT * 4096 * 2;
constexpr size_t WS_LBB = WS_LA + (size_t)MT * 2048 * 4;
constexpr size_t WS_XR = WS_LBB + (size_t)MT * 2048 * 2;
constexpr size_t WS_END = WS_XR + (size_t)MT * 2048 * 2;

constexpr int LDS_BYTES = 133120 + 256;
constexpr int NPHASE = 18;

struct Params {
    const float* in[35];
    float* out;
    unsigned char* ws;
    int ph_lo, ph_hi;
    int z, pad;
};

__device__ __forceinline__ float bf2f(unsigned v) { return __uint_as_float(v << 16); }
__device__ __forceinline__ unsigned pk2(float lo, float hi) { unsigned r; asm volatile("v_cvt_pk_bf16_f32 %0, %1, %2" : "=v"(r) : "v"(lo), "v"(hi)); return r; }
__device__ __forceinline__ unsigned pk2_sw(float lo, float hi) {
    unsigned a = __float_as_uint(lo), b = __float_as_uint(hi); a += 0x7fffu + ((a >> 16) & 1u); b += 0x7fffu + ((b >> 16) & 1u); return (a >> 16) | (b & 0xffff0000u); }
__device__ __forceinline__ bf16_t f2bf(float x) { return (bf16_t)(pk2(x, 0.f) & 0xffffu); }
__device__ __forceinline__ float sigm(float x) { return __builtin_amdgcn_rcpf(1.f + __expf(-x)); }
__device__ __forceinline__ float silu(float x) { return x * __builtin_amdgcn_rcpf(1.f + __expf(-x)); }
__device__ __forceinline__ float softplus(float x) { return fmaxf(x, 0.f) + log1pf(__expf(-fabsf(x))); }
__device__ __forceinline__ float gelu_tanh(float x) { const float u = 0.7978845608f * (x + 0.044715f * x * x * x); const float t = 1.f - 2.f * __builtin_amdgcn_rcpf(1.f + __expf(2.f * u)); return 0.5f * x * (1.f + t); }
__device__ __forceinline__ float wave_sum(float v) {
#pragma unroll
    for (int o = 1; o < 64; o <<= 1) v += __shfl_xor(v, o);
    return v;
}
__device__ __forceinline__ void unpack8(u32x4 r, float* f) {
    f[0] = bf2f(r.x & 0xffffu); f[1] = __uint_as_float(r.x & 0xffff0000u); f[2] = bf2f(r.y & 0xffffu); f[3] = __uint_as_float(r.y & 0xffff0000u);
    f[4] = bf2f(r.z & 0xffffu); f[5] = __uint_as_float(r.z & 0xffff0000u); f[6] = bf2f(r.w & 0xffffu); f[7] = __uint_as_float(r.w & 0xffff0000u);
}
__device__ __forceinline__ void unpack4(u32x2 r, float* f) {
    f[0] = bf2f(r.x & 0xffffu); f[1] = __uint_as_float(r.x & 0xffff0000u); f[2] = bf2f(r.y & 0xffffu); f[3] = __uint_as_float(r.y & 0xffff0000u);
}
#define LDS_WAIT() asm volatile("s_waitcnt lgkmcnt(0)" ::: "memory")

namespace pg8 {
constexpr int BM = 256, BK = 64, HALF = 128, HTB = HALF * BK * 2, NXCD = 8, WGM = 8;
__device__ __forceinline__ int lds_byte(int r, int c) { const int st = (r >> 4) * 2 + (c >> 5), rr = r & 15, cc = c & 31, ob = rr * 64 + cc * 2; return st * 1024 + (ob ^ (((ob >> 9) & 1) << 5)); }
__device__ __forceinline__ void stage_rc(int b, int& R, int& C) { const int st = b / 1024, sb = b % 1024, swz = sb ^ (((sb >> 9) & 1) << 5); R = (st >> 1) * 16 + swz / 64; C = (st & 1) * 32 + (swz % 64) / 2; }
__device__ __forceinline__ int perm32(int rho) { const int n = rho >> 4, i = rho & 15; return 8 * (i >> 2) + 4 * n + (i & 3); }

struct Unit { int pm, pn, nt, kind, ks; size_t aoff, boff; };
struct Gemm { const char* A; const char* Bt; int lda, ldb; };
struct Order {
    int nMm, nN, n_main, n_tail, ksplit, nt_full, G, c; size_t a_t, b_t, acol;
    __device__ __forceinline__ bool next(int i, Unit& u) const {
        const long L = (long)i * G + c;
        if (L < n_main) {
            const int nwg = n_main;
            int wgid = (int)L; { const int q = nwg / NXCD, r = nwg % NXCD, xcd = wgid % NXCD, off = wgid / NXCD; wgid = (xcd < r ? xcd * (q + 1) : r * (q + 1) + (xcd - r) * q) + off; }
            const int nig = WGM * nN, gid = wgid / nig, fm = gid * WGM, gsz = (nMm - fm) < WGM ? (nMm - fm) : WGM;
            u.pm = fm + ((wgid % nig) % gsz); u.pn = (wgid % nig) / gsz; u.nt = nt_full; u.kind = 0; u.ks = 0;
            u.aoff = (size_t)u.pm * a_t + (size_t)(u.pn >> 1) * acol; u.boff = (size_t)u.pn * b_t; return true;
        }
        const int Lt = (int)(L - n_main); if (Lt >= n_tail) return false;
        const int ks = Lt % ksplit, r = Lt / ksplit;
        u.pm = nMm + (r & 1); u.pn = r >> 1; u.nt = nt_full / ksplit; u.kind = ksplit > 1 ? 1 : 0; u.ks = ks;
        const size_t kofs = (size_t)ks * u.nt * (BK * 2);
        u.aoff = (size_t)u.pm * a_t + (size_t)(u.pn >> 1) * acol + kofs; u.boff = (size_t)u.pn * b_t + kofs; return true;
    }
};

struct EpiScaleBf16 {
    static constexpr bool PERM = true;
    bf16_t* O; int ldc; const float* ss;
    __device__ __forceinline__ void operator()(const f32x4 (&acc)[2][2][4][2], const Unit& u, int wr, int wc, int fr, int fq) const {
        const int row0 = u.pm * BM + wr * 64 + fr, col0 = u.pn * BM + wc * 32 + 8 * fq;
#pragma unroll
        for (int ai = 0; ai < 2; ++ai)
#pragma unroll
            for (int m = 0; m < 4; ++m) {
                const int row = row0 + ai * HALF + m * 16;
                const float rs = rsqrtf(ss[row] * (1.0f / 2048.0f) + EPS);
                bf16_t* rowp = O + ((unsigned)row * (unsigned)ldc + (unsigned)col0);
#pragma unroll
                for (int bj = 0; bj < 2; ++bj) {
                    const f32x4 v0 = acc[ai][bj][m][0] * rs, v1 = acc[ai][bj][m][1] * rs;
                    u32x4 w; w.x = pk2(v0[0], v0[1]); w.y = pk2(v0[2], v0[3]); w.z = pk2(v1[0], v1[1]); w.w = pk2(v1[2], v1[3]);
                    *(u32x4*)(rowp + bj * HALF) = w;
                }
            }
    }
};
struct EpiResid {
    static constexpr bool PERM = false;
    float* X; bf16_t* XB; float* ssout; float* part;
    __device__ __forceinline__ void operator()(const f32x4 (&acc)[2][2][4][2], const Unit& u, int wr, int wc, int fr, int fq) const {
        const int row0 = u.pm * BM + wr * 64 + fr, col0 = u.pn * BM + wc * 32 + 4 * fq;
        if (u.kind == 1) {
            float* P = part + (size_t)u.ks * (512 * 2048);
#pragma unroll
            for (int ai = 0; ai < 2; ++ai)
#pragma unroll
                for (int m = 0; m < 4; ++m) {
                    const unsigned off = (unsigned)(row0 - MP + ai * HALF + m * 16) * 2048u + (unsigned)col0;
#pragma unroll
                    for (int bj = 0; bj < 2; ++bj)
#pragma unroll
                        for (int n = 0; n < 2; ++n) *(f32x4*)(P + off + bj * HALF + n * 16) = acc[ai][bj][m][n];
                }
            return;
        }
#pragma unroll
        for (int ai = 0; ai < 2; ++ai)
#pragma unroll
            for (int m = 0; m < 4; ++m) {
                const int row = row0 + ai * HALF + m * 16;
                const unsigned off = (unsigned)row * 2048u + (unsigned)col0;
                float sq = 0.f;
#pragma unroll
                for (int bj = 0; bj < 2; ++bj)
#pragma unroll
                    for (int n = 0; n < 2; ++n) {
                        const unsigned o = off + bj * HALF + n * 16;
                        f32x4 x = *(const f32x4*)(X + o) + acc[ai][bj][m][n];
                        *(f32x4*)(X + o) = x;
                        u32x2 w; w.x = pk2(x[0], x[1]); w.y = pk2(x[2], x[3]);
                        *(u32x2*)(XB + o) = w;
                        sq += (x[0] * x[0] + x[1] * x[1]) + (x[2] * x[2] + x[3] * x[3]);
                    }
                sq += __shfl_xor(sq, 16); sq += __shfl_xor(sq, 32);
                if (fq == 0) atomicAdd(ssout + row, sq);
                asm volatile("" ::: "memory");
            }
    }
};
struct EpiLru {
    static constexpr bool PERM = false;
    const float* br; const float* bi; const float* sp; const bf16_t* XR; float* LA; bf16_t* LBv;
    __device__ __forceinline__ void operator()(const f32x4 (&acc)[2][2][4][2], const Unit& u, int wr, int wc, int fr, int fq) const {
        const int row0 = u.pm * BM + wr * 64 + fr;
        const int cbase = (u.pn >> 1) * 256 + (u.pn & 1) * 128 + wc * 32 + 4 * fq;
#pragma unroll
        for (int ai = 0; ai < 2; ++ai)
#pragma unroll
            for (int m = 0; m < 4; ++m) {
                const int row = row0 + ai * HALF + m * 16;
                const bool first = (row < MP) && ((row & 2047) == 0);
#pragma unroll
                for (int n = 0; n < 2; ++n) {
                    const int c = cbase + n * 16;
                    const f32x4 br4 = *(const f32x4*)(br + c), bi4 = *(const f32x4*)(bi + c), sp4 = *(const f32x4*)(sp + c);
                    const unsigned o = (unsigned)row * 2048u + (unsigned)c;
                    float xr[4]; unpack4(*(const u32x2*)(XR + o), xr);
                    f32x4 av; float bb[4];
#pragma unroll
                    for (int j = 0; j < 4; ++j) {
                        const float r = sigm(acc[ai][0][m][n][j] + br4[j]), gi = sigm(acc[ai][1][m][n][j] + bi4[j]);
                        const float la = -8.0f * r * sp4[j];
                        const float a = __expf(la);
                        const float mult = first ? 1.0f : __builtin_amdgcn_sqrtf(fmaxf(1.0f - a * a, 0.f));
                        av[j] = a; bb[j] = mult * gi * xr[j];
                    }
                    *(f32x4*)(LA + o) = av;
                    u32x2 w; w.x = pk2(bb[0], bb[1]); w.y = pk2(bb[2], bb[3]);
                    *(u32x2*)(LBv + o) = w;
                    asm volatile("" ::: "memory");
                }
            }
    }
};

template <class Epi>
__device__ __forceinline__ void gemm_phase(LAS unsigned char* lds, const Gemm g, const Order& S, const Epi& E) {
    int tid = threadIdx.x; asm volatile("" : "+v"(tid));
    const int wid = __builtin_amdgcn_readfirstlane(tid >> 6), lane = tid & 63, wr = wid >> 2, wc = wid & 3, fr = lane & 15, fq = lane >> 4;
    unsigned voffA[2], voffB[2];
#pragma unroll
    for (int i = 0; i < 2; ++i) { int R, C; stage_rc(tid * 16 + i * 8192, R, C); const int Rb = Epi::PERM ? ((R & ~31) + perm32(R & 31)) : R;
        voffA[i] = (unsigned)(R * g.lda + C) * 2u; voffB[i] = (unsigned)(Rb * g.ldb + C) * 2u; }
    const size_t kstep = (size_t)(BK * 2);
    const size_t hstepA = (size_t)HALF * g.lda * 2, hstepB = (size_t)HALF * g.ldb * 2;
    const unsigned ldsw = (unsigned)wid * 1024u;
    const int aoff = lds_byte(wr * 64 + fr, fq * 8), boff = lds_byte(wc * 32 + fr, fq * 8);
#define PG8_SA(b, h) (((b) * 2 + (h)) * HTB)
#define PG8_SB(b, h) ((4 + (b) * 2 + (h)) * HTB)
#define PG8_STAGE(bufoff, gbase, voff) do { _Pragma("unroll") for (int _i = 0; _i < 2; ++_i) \
        __builtin_amdgcn_global_load_lds((const unsigned*)((const char*)(gbase) + (voff)[_i]), (LAS unsigned*)(lds + (bufoff) + ldsw + _i * 8192), 16, 0, 0); } while (0)
#define PG8_LDA(dst, b, h) do { _Pragma("unroll") for (int m = 0; m < 4; ++m) _Pragma("unroll") for (int k = 0; k < 2; ++k) dst[m][k] = *(const LAS bf16x8*)(lds + PG8_SA(b, h) + aoff + m * 2048 + k * 1024); } while (0)
#define PG8_LDB(dst, b, h) do { _Pragma("unroll") for (int n = 0; n < 2; ++n) _Pragma("unroll") for (int k = 0; k < 2; ++k) dst[n][k] = *(const LAS bf16x8*)(lds + PG8_SB(b, h) + boff + n * 2048 + k * 1024); } while (0)
#define PG8_MMA(ai, bj, At, Bt) do { __builtin_amdgcn_s_setprio(1); _Pragma("unroll") for (int m = 0; m < 4; ++m) _Pragma("unroll") for (int n = 0; n < 2; ++n) _Pragma("unroll") for (int k = 0; k < 2; ++k) \
        acc[ai][bj][m][n] = __builtin_amdgcn_mfma_f32_16x16x32_bf16(Bt[n][k], At[m][k], acc[ai][bj][m][n], 0, 0, 0); __builtin_amdgcn_s_setprio(0); } while (0)
#define PG8_WAIT_V(n) asm volatile("s_waitcnt vmcnt(" #n ")" ::: "memory")
#define PG8_WAIT_L(n) asm volatile("s_waitcnt lgkmcnt(" #n ")" ::: "memory")
#define PG8_BAR __builtin_amdgcn_s_barrier()
#define PG8_SCHED __builtin_amdgcn_sched_barrier(0)
    Unit cur, nxt; int ui = 0;
    if (!S.next(0, cur)) return;
    f32x4 acc[2][2][4][2];
#pragma unroll
    for (int a = 0; a < 2; ++a)
#pragma unroll
        for (int b = 0; b < 2; ++b)
#pragma unroll
            for (int m = 0; m < 4; ++m)
#pragma unroll
                for (int n = 0; n < 2; ++n) acc[a][b][m][n] = (f32x4){0.f, 0.f, 0.f, 0.f};
    bf16x8 At[4][2], B0[2][2], B1[2][2];
    const char* cA = g.A + cur.aoff; const char* cB = g.Bt + cur.boff;
    PG8_STAGE(PG8_SB(0, 0), cB, voffB); PG8_STAGE(PG8_SA(0, 0), cA, voffA); PG8_STAGE(PG8_SB(0, 1), cB + hstepB, voffB); PG8_STAGE(PG8_SA(0, 1), cA + hstepA, voffA);
    if (wr == 1) PG8_BAR;
    PG8_WAIT_V(4); PG8_BAR;
    PG8_STAGE(PG8_SB(1, 0), cB + kstep, voffB); PG8_STAGE(PG8_SA(1, 0), cA + kstep, voffA); PG8_STAGE(PG8_SB(1, 1), cB + hstepB + kstep, voffB);
    PG8_WAIT_V(6); PG8_BAR;
    for (;;) {
        const bool has_next = S.next(ui + 1, nxt);
        const char* nA = has_next ? g.A + nxt.aoff : cA; const char* nB = has_next ? g.Bt + nxt.boff : cB;
        const int nt = cur.nt;
        for (int t = 0; t < nt; t += 2) {
            const bool last = (t == nt - 2);
            const char* a1 = cA + (size_t)(t + 1) * kstep;
            const char* a2 = last ? nA : cA + (size_t)(t + 2) * kstep; const char* b2 = last ? nB : cB + (size_t)(t + 2) * kstep;
            const char* a3 = a2 + kstep; const char* b3 = b2 + kstep;
            PG8_LDB(B0, 0, 0); PG8_SCHED; PG8_LDA(At, 0, 0); PG8_STAGE(PG8_SA(1, 1), a1 + hstepA, voffA);
            PG8_WAIT_L(8); PG8_BAR; PG8_WAIT_L(0); PG8_MMA(0, 0, At, B0); PG8_BAR; PG8_SCHED;
            PG8_LDB(B1, 0, 1); PG8_STAGE(PG8_SB(0, 0), b2, voffB);
            PG8_BAR; PG8_WAIT_L(0); PG8_MMA(0, 1, At, B1); PG8_BAR;
            PG8_LDA(At, 0, 1); PG8_STAGE(PG8_SA(0, 0), a2, voffA);
            PG8_BAR; PG8_WAIT_L(0); PG8_MMA(1, 0, At, B0); PG8_BAR; PG8_SCHED;
            PG8_STAGE(PG8_SB(0, 1), b2 + hstepB, voffB);
            PG8_WAIT_V(6); PG8_BAR; PG8_MMA(1, 1, At, B1); PG8_BAR;
            PG8_LDB(B0, 1, 0); PG8_SCHED; PG8_LDA(At, 1, 0); PG8_STAGE(PG8_SA(0, 1), a2 + hstepA, voffA);
            PG8_WAIT_L(8); PG8_BAR; PG8_WAIT_L(0); PG8_MMA(0, 0, At, B0); PG8_BAR; PG8_SCHED;
            PG8_LDB(B1, 1, 1); PG8_STAGE(PG8_SB(1, 0), b3, voffB);
            PG8_BAR; PG8_WAIT_L(0); PG8_MMA(0, 1, At, B1); PG8_BAR;
            PG8_LDA(At, 1, 1); PG8_STAGE(PG8_SA(1, 0), a3, voffA);
            PG8_BAR; PG8_WAIT_L(0); PG8_MMA(1, 0, At, B0); PG8_BAR; PG8_SCHED;
            PG8_STAGE(PG8_SB(1, 1), b3 + hstepB, voffB);
            PG8_WAIT_V(6); PG8_BAR; PG8_MMA(1, 1, At, B1); PG8_BAR;
        }
        E(acc, cur, wr, wc, fr, fq);
        if (!has_next) break;
#pragma unroll
        for (int a = 0; a < 2; ++a)
#pragma unroll
            for (int b = 0; b < 2; ++b)
#pragma unroll
                for (int m = 0; m < 4; ++m)
#pragma unroll
                    for (int n = 0; n < 2; ++n) acc[a][b][m][n] = (f32x4){0.f, 0.f, 0.f, 0.f};
        cur = nxt; cA = nA; cB = nB; ++ui;
    }
    PG8_WAIT_V(0);
    if (wr == 0) PG8_BAR;
    PG8_BAR;
#undef PG8_SA
#undef PG8_SB
#undef PG8_STAGE
#undef PG8_LDA
#undef PG8_LDB
#undef PG8_MMA
#undef PG8_WAIT_V
#undef PG8_WAIT_L
#undef PG8_BAR
#undef PG8_SCHED
}
}

__device__ __forceinline__ void tr_item(const float* __restrict__ W, int ldw, int N, int k0, int n0, const float* __restrict__ scale, bf16_t* __restrict__ dst, int ldd, float* scr, int lane) {
    const int r4 = lane >> 4, c4 = (lane & 15) * 4;
    const bool inb = (n0 + c4) < N;
    f32x4 v[16];
#pragma unroll
    for (int i = 0; i < 16; ++i) v[i] = inb ? *(const f32x4*)(W + (size_t)(k0 + 4 * i + r4) * ldw + n0 + c4) : (f32x4){0.f, 0.f, 0.f, 0.f};
#pragma unroll
    for (int i = 0; i < 16; ++i) { float* d = scr + (4 * i + r4) * 65 + c4; d[0] = v[i][0]; d[1] = v[i][1]; d[2] = v[i][2]; d[3] = v[i][3]; }
    LDS_WAIT();
    const int c = lane & 7;
    f32x4 s0 = (f32x4){1.f, 1.f, 1.f, 1.f}, s1 = s0;
    if (scale) { s0 = *(const f32x4*)(scale + k0 + 8 * c); s1 = *(const f32x4*)(scale + k0 + 8 * c + 4); }
#pragma unroll
    for (int j = 0; j < 8; ++j) { const int n = (lane >> 3) + 8 * j; const float* sp = scr + (8 * c) * 65 + n;
        u32x4 o; o.x = pk2(sp[0 * 65] * s0[0], sp[1 * 65] * s0[1]); o.y = pk2(sp[2 * 65] * s0[2], sp[3 * 65] * s0[3]); o.z = pk2(sp[4 * 65] * s1[0], sp[5 * 65] * s1[1]); o.w = pk2(sp[6 * 65] * s1[2], sp[7 * 65] * s1[3]);
        *(u32x4*)(dst + (size_t)n * ldd + 8 * c) = o; }
    LDS_WAIT();
}

__device__ __forceinline__ void phase_prologue(const Params& p, float* ldsf) {
    int tid = threadIdx.x; asm volatile("" : "+v"(tid));
    const int wave = tid >> 6, lane = tid & 63;
    const int gw = blockIdx.x * 8 + wave, NGW = gridDim.x * 8;
    float* scr = ldsf + wave * 4160;
    unsigned char* ws = p.ws;
    constexpr int I0 = 32 * 177, I1 = 64 * 32, I2 = 32 * 176, I3 = 88 * 32, I4 = 32 * 192, I5 = I1, I6 = I2, I7 = I3, I8 = 128, I9 = 128;
    constexpr int NIT = I0 + I1 + I2 + I3 + I4 + I5 + I6 + I7 + I8 + I9;
    for (int it = gw; it < NIT; it += NGW) {
        int r = it;
        const float* W; int K, N; const float* sc = nullptr; bf16_t* WT;
        if (r < I0) { W = p.in[12 + p.z]; K = 2048; N = 11296; sc = p.in[9 + p.z]; WT = (bf16_t*)(ws + WS_WIN0); }
        else if ((r -= I0) < I1) { W = p.in[19 + p.z]; K = 4096; N = 2048; WT = (bf16_t*)(ws + WS_WOUT0); }
        else if ((r -= I1) < I2) { W = p.in[31 + p.z]; K = 2048; N = 11264; sc = p.in[10 + p.z]; WT = (bf16_t*)(ws + WS_WUP0); }
        else if ((r -= I2) < I3) { W = p.in[34 + p.z]; K = 5632; N = 2048; WT = (bf16_t*)(ws + WS_WDN0); }
        else if ((r -= I3) < I4) { W = p.in[20 + p.z]; K = 2048; N = 12288; sc = p.in[9 + p.z] + 2048; WT = (bf16_t*)(ws + WS_WIN1); }
        else if ((r -= I4) < I5) { W = p.in[30 + p.z]; K = 4096; N = 2048; WT = (bf16_t*)(ws + WS_WOUT1); }
        else if ((r -= I5) < I6) { W = p.in[31 + p.z] + (size_t)2048 * 11264; K = 2048; N = 11264; sc = p.in[10 + p.z] + 2048; WT = (bf16_t*)(ws + WS_WUP1); }
        else if ((r -= I6) < I7) { W = p.in[34 + p.z] + (size_t)5632 * 2048; K = 5632; N = 2048; WT = (bf16_t*)(ws + WS_WDN1); }
        else {
            r -= I7; const int which = r >> 7; r &= 127;
            const int blk = r >> 4, kb = (r >> 2) & 3, nb = r & 3, n0 = 64 * nb, k0 = 64 * kb;
            const float* Wl = (which ? p.in[27 + p.z] : p.in[25 + p.z]) + (size_t)blk * 65536;
            const int drow = (blk * 2 + (n0 >> 7)) * 256 + which * 128 + (n0 & 127);
            tr_item(Wl, 256, 256, k0, n0, nullptr, (bf16_t*)(ws + WS_WLRU) + (size_t)drow * 256 + k0, 256, scr, lane);
            continue;
        }
        const int nblk = (N + 63) / 64, kbl = r & 7, r8 = r >> 3, nb = r8 % nblk, kb = (r8 / nblk) * 8 + kbl, k0 = 64 * kb, n0 = 64 * nb;
        tr_item(W, N, N, k0, n0, sc, WT + (size_t)n0 * K + k0, K, scr, lane);
    }
    {
        u32x4* z = (u32x4*)((bf16_t*)(ws + WS_WIN0) + (size_t)11296 * 2048);
        const int n16 = 224 * 2048 * 2 / 16;
        for (int i = blockIdx.x * 512 + tid; i < n16; i += gridDim.x * 512) z[i] = (u32x4){0u, 0u, 0u, 0u};
    }
    float* X = (float*)(ws + WS_X); bf16_t* XB = (bf16_t*)(ws + WS_XB); float* ss = (float*)(ws + WS_SS);
    for (int row = gw; row < MT; row += NGW) {
        const float* src = row < MP ? p.in[0 + p.z] + (size_t)row * 2048 : p.in[1 + p.z] + (size_t)(row - MP) * 2048;
        float s = 0.f;
#pragma unroll
        for (int j = 0; j < 8; ++j) {
            const f32x4 v = *(const f32x4*)(src + (lane + 64 * j) * 4);
            *(f32x4*)(X + (size_t)row * 2048 + (lane + 64 * j) * 4) = v;
            u32x2 w; w.x = pk2(v[0], v[1]); w.y = pk2(v[2], v[3]);
            *(u32x2*)(XB + (size_t)row * 2048 + (lane + 64 * j) * 4) = w;
            s += (v[0] * v[0] + v[1] * v[1]) + (v[2] * v[2] + v[3] * v[3]);
        }
        s = wave_sum(s);
        if (lane == 0) ss[row] = s;
    }
    for (int i = blockIdx.x * 512 + tid; i < 4 * MT; i += gridDim.x * 512) ss[MT + i] = 0.f;
    for (int i = blockIdx.x * 512 + tid; i < 2048; i += gridDim.x * 512) {
        ((float*)(ws + WS_SP))[i] = softplus(-p.in[29 + p.z][i]);
        ((float*)(ws + WS_LB))[i] = sigm(p.in[21 + p.z][2048 + i] - p.in[21 + p.z][i]);
    }
}

__device__ __forceinline__ int next_item(unsigned* ctr, float* ldsf) {
    __syncthreads();
    if (threadIdx.x == 0) ((volatile unsigned*)ldsf)[24576] = atomicAdd(ctr, 1u);
    __syncthreads();
    return (int)((volatile unsigned*)ldsf)[24576];
}

template <int TYPE, int VW>
__device__ __forceinline__ void rec_item(const Params& p, float* ldsf, int sample, int b, int h, int s) {
    constexpr int NV = VW / 16;
    typedef float VT __attribute__((ext_vector_type(NV)));
    int tid = threadIdx.x; asm volatile("" : "+v"(tid));
    const int w = tid >> 6, lane = tid & 63, kg = lane >> 4, vq = lane & 15, kb = 16 * w + 4 * kg;
    const int L = sample ? 4 : 2048, row0 = sample ? MP + 4 * b : 2048 * b, pos0 = sample ? 16384 : 0;
    constexpr int LDP = TYPE < 2 ? LD0 : LD1;
    const bf16_t* proj = (const bf16_t*)(p.ws + WS_PROJ) + (size_t)row0 * LDP;
    bf16_t* yz = (bf16_t*)(p.ws + WS_YZ) + (size_t)row0 * 4096;
    float* part = ldsf + 8192;
    int colA = -1, colB = -1, role = -1, didx = 0;
    float w0 = 0.f, w1 = 0.f, w2 = 0.f, w3 = 0.f, cbias = 0.f, c0 = 0.f, c1 = 0.f, c2 = 0.f, aux = 0.f, aux2 = 0.f;
    if constexpr (TYPE == 0) {
        if (tid < 320) {
            role = tid < 128 ? 0 : (tid < 256 ? 1 : 2);
            didx = tid < 128 ? tid : (tid < 256 ? tid - 128 : tid - 256);
            const int ch = tid < 128 ? 2560 + (h >> 3) * 128 + tid : (tid < 256 ? 2048 + (h >> 3) * 128 + (tid - 128) : h * 64 + (tid - 256));
            colA = 2048 + ch;
            const float* cw = p.in[13 + p.z];
            w0 = cw[ch]; w1 = cw[3072 + ch]; w2 = cw[2 * 3072 + ch]; w3 = cw[3 * 3072 + ch]; cbias = p.in[14 + p.z][ch];
            if (sample) { const float* st = p.in[3 + p.z] + (size_t)b * 3 * 3072; c0 = st[ch]; c1 = st[3072 + ch]; c2 = st[2 * 3072 + ch]; }
        } else if (tid < 328) { role = 3; didx = tid - 320; colA = 5120 + h; aux = p.in[15 + p.z][h]; aux2 = -__expf(p.in[16 + p.z][h]); }
    } else if constexpr (TYPE == 1) {
        if (tid < 128) { role = tid < 64 ? 0 : 1; didx = tid & 63; colA = (tid < 64 ? 5152 : 6176) + h * 128 + didx; colB = colA + 64;
            aux = exp2f(-(float)didx * 0.20762050593046014f); }
        else if (tid < 128 + VW) { role = 2; didx = tid - 128; colA = 7200 + h * 256 + s * VW + didx; }
    } else {
        if (tid < 128) { role = 0; didx = tid; colA = h * 128 + tid; }
        else if (tid < 256) { role = 1; didx = tid - 128; colA = 2048 + h * 128 + didx; aux = ((const float*)(p.ws + WS_LB))[h * 128 + didx]; }
        else if (tid < 256 + VW) { role = 2; didx = tid - 256; colA = 4096 + h * 128 + s * VW + didx; }
    }
    const float Dh = TYPE == 0 ? p.in[17 + p.z][h] : 0.f;
    const float gamma = TYPE == 1 ? 1.0f - exp2f(-5.0f - (float)h * (4.0f / 7.0f)) : 0.f;
    const int ldS = TYPE == 0 ? 64 : (TYPE == 1 ? 256 : 128);
    size_t soff;
    if constexpr (TYPE == 0) soff = ((size_t)(b * 32 + h) * 128) * 64;
    else if constexpr (TYPE == 1) soff = ((size_t)(b * 8 + h) * 128) * 256 + s * VW;
    else soff = ((size_t)(b * 16 + h) * 128) * 128 + s * VW;
    const float* S0 = TYPE == 0 ? p.in[2 + p.z] : (TYPE == 1 ? p.in[4 + p.z] : p.in[5 + p.z]);
    float* Sout = p.out + (TYPE == 0 ? (sample ? O_SSMS : O_SSMP) : (TYPE == 1 ? (sample ? O_RETS : O_RETP) : (sample ? O_HGS : O_HGP))) + soff;
    VT S[4];
#pragma unroll
    for (int i = 0; i < 4; ++i) { if (sample) S[i] = *(const VT*)(S0 + soff + (size_t)(kb + i) * ldS + NV * vq); else S[i] = (VT)(0.f); }
    unsigned short ra[8], rb[8]; unsigned short zr = 0;
    const int R = (L + 7) >> 3;
    auto load_raw = [&](int r) {
#pragma unroll
        for (int t = 0; t < 8; ++t) {
            const int tt = 8 * r + t;
            ra[t] = 0; rb[t] = 0;
            if (tt < L) {
                if (colA >= 0) ra[t] = proj[(size_t)tt * LDP + colA];
                if (TYPE == 1 && colB >= 0) rb[t] = proj[(size_t)tt * LDP + colB];
            }
        }
        if (TYPE == 0) { const int tt = 8 * r + w; if (tt < L) zr = proj[(size_t)tt * LDP + h * 64 + lane]; }
    };
    load_raw(0);
    for (int r = 0; r < R; ++r) {
        const int nv = (L - 8 * r) < 8 ? (L - 8 * r) : 8;
        float* stg = ldsf + (r & 1) * 4096;
        float* qs = stg; float* ks = stg + 1024; float* as = stg + 2048; float* vs = stg + 3072; float* ad = stg + 3584;
        if constexpr (TYPE == 0) {
            if (role >= 0 && role < 3) {
                float* dst = role == 0 ? qs : (role == 1 ? ks : vs); const int dstr = role == 2 ? 64 : 128;
#pragma unroll
                for (int t = 0; t < 8; ++t) {
                    const float x = bf2f(ra[t]);
                    const float y = cbias + w0 * c0 + w1 * c1 + w2 * c2 + w3 * x;
                    c0 = c1; c1 = c2; c2 = x;
                    dst[t * dstr + didx] = silu(y);
                }
            } else if (role == 3) {
                float xv = 0.f;
#pragma unroll
                for (int t = 0; t < 8; ++t) if (t == didx) xv = bf2f(ra[t]);
                const float dt = softplus(xv + aux);
                ad[2 * didx] = __expf(dt * aux2); ad[2 * didx + 1] = dt;
            }
        } else if constexpr (TYPE == 1) {
            if (role == 0 || role == 1) {
                float* dst = role == 0 ? qs : ks; const float sc = role == 0 ? 1.0f : 0.08838834764831845f;
#pragma unroll
                for (int t = 0; t < 8; ++t) {
                    const int pos = pos0 + 8 * r + t;
                    const double rev = (double)pos * (double)aux * 0.15915494309189535;
                    const float fr = (float)(rev - floor(rev));
                    const float sn = __builtin_amdgcn_sinf(fr), cs = __builtin_amdgcn_cosf(fr);
                    const float x1 = bf2f(ra[t]) * sc, x2 = bf2f(rb[t]) * sc;
                    dst[t * 128 + didx] = x1 * cs - x2 * sn;
                    dst[t * 128 + 64 + didx] = x1 * sn + x2 * cs;
                }
            } else if (role == 2) {
#pragma unroll
                for (int t = 0; t < 8; ++t) vs[t * VW + didx] = bf2f(ra[t]);
            }
        } else {
            if (role == 0) {
#pragma unroll
                for (int t = 0; t < 8; ++t) qs[t * 128 + didx] = silu(bf2f(ra[t]));
            } else if (role == 1) {
#pragma unroll
                for (int t = 0; t < 8; ++t) { const float f = aux + (1.0f - aux) * sigm(bf2f(ra[t])); as[t * 128 + didx] = f; ks[t * 128 + didx] = 1.0f - f; }
            } else if (role == 2) {
#pragma unroll
                for (int t = 0; t < 8; ++t) vs[t * VW + didx] = bf2f(ra[t]);
            }
        }
        const unsigned short zc = zr;
        __syncthreads();
        if (r + 1 < R) load_raw(r + 1);
        for (int t0 = 0; t0 < nv; t0 += 4) {
#pragma unroll
            for (int tt = 0; tt < 4; ++tt) {
                const int t = t0 + tt;
                const f32x4 q4 = *(const f32x4*)(qs + t * 128 + kb);
                f32x4 k4 = *(const f32x4*)(ks + t * 128 + kb);
                const VT v4 = *(const VT*)(vs + t * VW + NV * vq);
                f32x4 a4;
                if constexpr (TYPE == 0) { const f32x2 adv = *(const f32x2*)(ad + 2 * t); a4 = (f32x4){adv.x, adv.x, adv.x, adv.x}; k4 = k4 * adv.y; }
                else if constexpr (TYPE == 1) a4 = (f32x4){gamma, gamma, gamma, gamma};
                else a4 = *(const f32x4*)(as + t * 128 + kb);
                VT o = (VT)(0.f);
#pragma unroll
                for (int i = 0; i < 4; ++i) { S[i] = a4[i] * S[i] + k4[i] * v4; o += q4[i] * S[i]; }
                *(VT*)(part + ((t * 32 + w * 4 + kg) * VW + NV * vq)) = o;
            }
        }
        __syncthreads();
        const int rt = tid / VW, rv = tid % VW;
        if (tid < 8 * VW && rt < nv) {
            float o = 0.f;
#pragma unroll
            for (int pp = 0; pp < 32; ++pp) o += part[(rt * 32 + pp) * VW + rv];
            const size_t trow = (size_t)(8 * r + rt);
            if constexpr (TYPE == 0) {
                const float y = (o + Dh * vs[rt * 64 + rv]) * silu(bf2f(zc));
                yz[trow * 4096 + h * 64 + rv] = f2bf(y);
            } else if constexpr (TYPE == 1) {
                yz[trow * 4096 + 2048 + h * 256 + s * VW + rv] = f2bf(o);
            } else {
                yz[trow * 4096 + h * 128 + s * VW + rv] = f2bf(o);
            }
        }
    }
#pragma unroll
    for (int i = 0; i < 4; ++i) *(VT*)(Sout + (size_t)(kb + i) * ldS + NV * vq) = S[i];
}

template <int TYPE>
__device__ __forceinline__ void dec_unit(const Params& p, float* ldsf, int b, int u) {
    int tid = threadIdx.x; asm volatile("" : "+v"(tid));
    const int w = tid >> 6, lane = tid & 63, kg = lane >> 4, vq = lane & 15;
    const int row0 = MP + 4 * b;
    constexpr int LDP = TYPE < 2 ? LD0 : LD1;
    const bf16_t* proj = (const bf16_t*)(p.ws + WS_PROJ) + (size_t)row0 * LDP;
    bf16_t* yz = (bf16_t*)(p.ws + WS_YZ) + (size_t)row0 * 4096;
    int h, sl; size_t soff; int ldS;
    if constexpr (TYPE == 0) { h = 8 * u + w; sl = 0; ldS = 64; soff = ((size_t)(b * 32 + h) * 128) * 64; }
    else if constexpr (TYPE == 1) { h = 2 * u + (w >> 2); sl = w & 3; ldS = 256; soff = ((size_t)(b * 8 + h) * 128) * 256 + sl * 64; }
    else { h = 4 * u + (w >> 1); sl = w & 1; ldS = 128; soff = ((size_t)(b * 16 + h) * 128) * 128 + sl * 64; }
    const float* S0 = (TYPE == 0 ? p.in[2 + p.z] : (TYPE == 1 ? p.in[4 + p.z] : p.in[5 + p.z])) + soff + (size_t)(32 * kg) * ldS + 4 * vq;
    float* Sout = p.out + (TYPE == 0 ? O_SSMS : (TYPE == 1 ? O_RETS : O_HGS)) + soff + (size_t)(32 * kg) * ldS + 4 * vq;
    if constexpr (TYPE == 0) {
        float* qs = ldsf; float* ks = ldsf + 512; float* xs = ldsf + 1024; float* zs = ldsf + 3072; float* ad = ldsf + 5120;
        unsigned short xr[2][4]; float cw[2][4], cb[2], st[2][3]; unsigned short zr[4]; unsigned short dr = 0;
#pragma unroll
        for (int q = 0; q < 2; ++q) {
            const int idx = tid + 512 * q;
            if (idx < 768) {
                const int ch = idx < 128 ? 2560 + u * 128 + idx : (idx < 256 ? 2048 + u * 128 + (idx - 128) : u * 512 + (idx - 256));
#pragma unroll
                for (int t = 0; t < 4; ++t) xr[q][t] = proj[(size_t)t * LDP + 2048 + ch];
#pragma unroll
                for (int j = 0; j < 4; ++j) cw[q][j] = p.in[13 + p.z][j * 3072 + ch];
                cb[q] = p.in[14 + p.z][ch];
#pragma unroll
                for (int j = 0; j < 3; ++j) st[q][j] = p.in[3 + p.z][((size_t)b * 3 + j) * 3072 + ch];
            }
        }
#pragma unroll
        for (int t = 0; t < 4; ++t) zr[t] = proj[(size_t)t * LDP + u * 512 + tid];
        if (tid < 32) dr = proj[(size_t)(tid >> 3) * LDP + 5120 + 8 * u + (tid & 7)];
        f32x4 S[32];
#pragma unroll
        for (int i = 0; i < 32; ++i) S[i] = *(const f32x4*)(S0 + (size_t)i * ldS);
#pragma unroll
        for (int q = 0; q < 2; ++q) {
            const int idx = tid + 512 * q;
            if (idx < 768) {
                float* dst = idx < 128 ? qs + idx : (idx < 256 ? ks + (idx - 128) : xs + (idx - 256));
                const int dstr = idx < 256 ? 128 : 512;
                float c0 = st[q][0], c1 = st[q][1], c2 = st[q][2];
#pragma unroll
                for (int t = 0; t < 4; ++t) {
                    const float x = bf2f(xr[q][t]);
                    const float y = cb[q] + cw[q][0] * c0 + cw[q][1] * c1 + cw[q][2] * c2 + cw[q][3] * x;
                    c0 = c1; c1 = c2; c2 = x;
                    dst[t * dstr] = silu(y);
                }
            }
        }
#pragma unroll
        for (int t = 0; t < 4; ++t) zs[t * 512 + tid] = silu(bf2f(zr[t]));
        if (tid < 32) {
            const int hh = 8 * u + (tid & 7);
            const float dt = softplus(bf2f(dr) + p.in[15 + p.z][hh]);
            ad[2 * tid] = __expf(-dt * __expf(p.in[16 + p.z][hh])); ad[2 * tid + 1] = dt;
        }
        __syncthreads();
        const float Dh = p.in[17 + p.z][h];
#pragma unroll 1
        for (int t = 0; t < 4; ++t) {
            const f32x2 adv = *(const f32x2*)(ad + 2 * (t * 8 + w));
            const f32x4 v4 = *(const f32x4*)(xs + t * 512 + w * 64 + 4 * vq);
            f32x4 o = (f32x4){0.f, 0.f, 0.f, 0.f};
#pragma unroll
            for (int i4 = 0; i4 < 8; ++i4) {
                const f32x4 q4 = *(const f32x4*)(qs + t * 128 + 32 * kg + 4 * i4);
                const f32x4 k4 = *(const f32x4*)(ks + t * 128 + 32 * kg + 4 * i4) * adv.y;
#pragma unroll
                for (int ii = 0; ii < 4; ++ii) { S[4 * i4 + ii] = adv.x * S[4 * i4 + ii] + k4[ii] * v4; o += q4[ii] * S[4 * i4 + ii]; }
            }
#pragma unroll
            for (int j = 0; j < 4; ++j) { o[j] += __shfl_xor(o[j], 16); o[j] += __shfl_xor(o[j], 32); }
            if (kg == 0) {
                const f32x4 z4 = *(const f32x4*)(zs + t * 512 + w * 64 + 4 * vq);
                const f32x4 y = (o + Dh * v4) * z4;
                u32x2 ov; ov.x = pk2(y[0], y[1]); ov.y = pk2(y[2], y[3]);
                *(u32x2*)(yz + (size_t)t * 4096 + h * 64 + 4 * vq) = ov;
            }
        }
#pragma unroll
        for (int i = 0; i < 32; ++i) *(f32x4*)(Sout + (size_t)i * ldS) = S[i];
    } else if constexpr (TYPE == 1) {
        float* qs = ldsf; float* ks = ldsf + 1024; float* vs = ldsf + 2048;
        unsigned short x1[4], x2[4], vr[4];
        const int hl = tid >> 7, isk = (tid >> 6) & 1, jf = tid & 63;
        if (tid < 256) {
            const int col = (isk ? 6176 : 5152) + (2 * u + hl) * 128 + jf;
#pragma unroll
            for (int t = 0; t < 4; ++t) { x1[t] = proj[(size_t)t * LDP + col]; x2[t] = proj[(size_t)t * LDP + col + 64]; }
        }
#pragma unroll
        for (int t = 0; t < 4; ++t) vr[t] = proj[(size_t)t * LDP + 7200 + (2 * u + (tid >> 8)) * 256 + (tid & 255)];
        f32x4 S[32];
#pragma unroll
        for (int i = 0; i < 32; ++i) S[i] = *(const f32x4*)(S0 + (size_t)i * ldS);
        if (tid < 256) {
            const float inv = exp2f(-(float)jf * 0.20762050593046014f);
            float* dst = isk ? ks : qs; const float sc = isk ? 0.08838834764831845f : 1.0f;
#pragma unroll
            for (int t = 0; t < 4; ++t) {
                const double rev = (double)(16384 + t) * (double)inv * 0.15915494309189535;
                const float fr = (float)(rev - floor(rev));
                const float sn = __builtin_amdgcn_sinf(fr), cs = __builtin_amdgcn_cosf(fr);
                const float a1 = bf2f(x1[t]) * sc, a2 = bf2f(x2[t]) * sc;
                dst[(t * 2 + hl) * 128 + jf] = a1 * cs - a2 * sn;
                dst[(t * 2 + hl) * 128 + 64 + jf] = a1 * sn + a2 * cs;
            }
        }
#pragma unroll
        for (int t = 0; t < 4; ++t) vs[(t * 2 + (tid >> 8)) * 256 + (tid & 255)] = bf2f(vr[t]);
        __syncthreads();
        const float gamma = 1.0f - exp2f(-5.0f - (float)h * (4.0f / 7.0f));
        const int hw = w >> 2;
#pragma unroll 1
        for (int t = 0; t < 4; ++t) {
            const f32x4 v4 = *(const f32x4*)(vs + (t * 2 + hw) * 256 + sl * 64 + 4 * vq);
            f32x4 o = (f32x4){0.f, 0.f, 0.f, 0.f};
#pragma unroll
            for (int i4 = 0; i4 < 8; ++i4) {
                const f32x4 q4 = *(const f32x4*)(qs + (t * 2 + hw) * 128 + 32 * kg + 4 * i4);
                const f32x4 k4 = *(const f32x4*)(ks + (t * 2 + hw) * 128 + 32 * kg + 4 * i4);
#pragma unroll
                for (int ii = 0; ii < 4; ++ii) { S[4 * i4 + ii] = gamma * S[4 * i4 + ii] + k4[ii] * v4; o += q4[ii] * S[4 * i4 + ii]; }
            }
#pragma unroll
            for (int j = 0; j < 4; ++j) { o[j] += __shfl_xor(o[j], 16); o[j] += __shfl_xor(o[j], 32); }
            if (kg == 0) {
                u32x2 ov; ov.x = pk2(o[0], o[1]); ov.y = pk2(o[2], o[3]);
                *(u32x2*)(yz + (size_t)t * 4096 + 2048 + h * 256 + sl * 64 + 4 * vq) = ov;
            }
        }
#pragma unroll
        for (int i = 0; i < 32; ++i) *(f32x4*)(Sout + (size_t)i * ldS) = S[i];
    } else {
        float* qs = ldsf; float* ks = ldsf + 2048; float* as = ldsf + 4096; float* vs = ldsf + 6144;
        unsigned short qr[4], fr_[4], vr[4];
        const int hl = tid >> 7, kk = tid & 127, col = (4 * u + hl) * 128 + kk;
#pragma unroll
        for (int t = 0; t < 4; ++t) { qr[t] = proj[(size_t)t * LDP + col]; fr_[t] = proj[(size_t)t * LDP + 2048 + col]; vr[t] = proj[(size_t)t * LDP + 4096 + col]; }
        const float lb = ((const float*)(p.ws + WS_LB))[col];
        f32x4 S[32];
#pragma unroll
        for (int i = 0; i < 32; ++i) S[i] = *(const f32x4*)(S0 + (size_t)i * ldS);
#pragma unroll
        for (int t = 0; t < 4; ++t) {
            const int o = (t * 4 + hl) * 128 + kk;
            qs[o] = silu(bf2f(qr[t]));
            const float f = lb + (1.0f - lb) * sigm(bf2f(fr_[t]));
            as[o] = f; ks[o] = 1.0f - f; vs[o] = bf2f(vr[t]);
        }
        __syncthreads();
        const int hw = w >> 1;
#pragma unroll 1
        for (int t = 0; t < 4; ++t) {
            const f32x4 v4 = *(const f32x4*)(vs + (t * 4 + hw) * 128 + sl * 64 + 4 * vq);
            f32x4 o = (f32x4){0.f, 0.f, 0.f, 0.f};
#pragma unroll
            for (int i4 = 0; i4 < 8; ++i4) {
                const int off = (t * 4 + hw) * 128 + 32 * kg + 4 * i4;
                const f32x4 q4 = *(const f32x4*)(qs + off), k4 = *(const f32x4*)(ks + off), a4 = *(const f32x4*)(as + off);
#pragma unroll
                for (int ii = 0; ii < 4; ++ii) { S[4 * i4 + ii] = a4[ii] * S[4 * i4 + ii] + k4[ii] * v4; o += q4[ii] * S[4 * i4 + ii]; }
            }
#pragma unroll
            for (int j = 0; j < 4; ++j) { o[j] += __shfl_xor(o[j], 16); o[j] += __shfl_xor(o[j], 32); }
            if (kg == 0) {
                u32x2 ov; ov.x = pk2(o[0], o[1]); ov.y = pk2(o[2], o[3]);
                *(u32x2*)(yz + (size_t)t * 4096 + h * 128 + sl * 64 + 4 * vq) = ov;
            }
        }
#pragma unroll
        for (int i = 0; i < 32; ++i) *(f32x4*)(Sout + (size_t)i * ldS) = S[i];
    }
}

#define CK_QS 0
#define CK_KS 17408
#define CK_KT 34816
#define CK_VT 53248
#define CK_PS 62464
#define CK_ST 71680
#define CK_CUM 89088
__device__ __forceinline__ bf16x8 ck_frag(const unsigned char* lds, int base, int pitch, int row, int kb, int q) {
    return *(const bf16x8*)(lds + base + row * pitch + (32 * kb + 8 * q) * 2);
}
template <int TYPE>
__device__ __forceinline__ void chunk_item(const Params& p, unsigned char* lds, int b, int h, int s) {
    int tid = threadIdx.x; asm volatile("" : "+v"(tid));
    const int w = tid >> 6, lane = tid & 63, r = lane & 15, q = lane >> 4;
    constexpr int LDP = TYPE < 2 ? LD0 : LD1;
    const bf16_t* proj = (const bf16_t*)(p.ws + WS_PROJ) + (size_t)(2048 * b) * LDP;
    bf16_t* yz = (bf16_t*)(p.ws + WS_YZ) + (size_t)(2048 * b) * 4096;
    const int I = w >> 1, Vn0 = 2 * (w & 1);
    const int c1 = tid & 127, tq = tid >> 7;
    const int cx = tid & 63, tx = tid >> 6;
    const int g = h >> 3;
    float cwC[4], cwB[4], cwX[4], cbC = 0.f, cbB = 0.f, cbX = 0.f, inv = 0.f, dtb = 0.f, Aneg = 0.f, Dh = 0.f;
    int colC = 0, colB = 0, colX = 0;
    if constexpr (TYPE == 0) {
        const int chC = 2560 + g * 128 + c1, chB = 2048 + g * 128 + c1, chX = h * 64 + cx;
        colC = 2048 + chC; colB = 2048 + chB; colX = 2048 + chX;
#pragma unroll
        for (int j = 0; j < 4; ++j) { cwC[j] = p.in[13 + p.z][j * 3072 + chC]; cwB[j] = p.in[13 + p.z][j * 3072 + chB]; cwX[j] = p.in[13 + p.z][j * 3072 + chX]; }
        cbC = p.in[14 + p.z][chC]; cbB = p.in[14 + p.z][chB]; cbX = p.in[14 + p.z][chX];
        dtb = p.in[15 + p.z][h]; Aneg = -__expf(p.in[16 + p.z][h]); Dh = p.in[17 + p.z][h];
    } else if constexpr (TYPE == 1) {
        const int isk = c1 >> 6, jf = c1 & 63;
        colC = (isk ? 6176 : 5152) + h * 128 + jf; colB = colC + 64; colX = 7200 + h * 256 + s * 64 + cx;
        inv = exp2f(-(float)jf * 0.20762050593046014f);
    } else {
        colC = h * 128 + c1; colB = 2048 + h * 128 + c1; colX = 4096 + h * 128 + s * 64 + cx;
        inv = ((const float*)(p.ws + WS_LB))[h * 128 + c1];
    }
    float* cumb = (float*)(lds + CK_CUM);
    if constexpr (TYPE == 1) {
        const float lg = __logf(1.0f - exp2f(-5.0f - (float)h * (4.0f / 7.0f)));
        if (tid < 64) {
#pragma unroll
            for (int bfi = 0; bfi < 2; ++bfi) { float* cb = cumb + bfi * 320; cb[tid] = (tid + 1) * lg; cb[64 + tid] = __expf((tid + 1) * lg); cb[128 + tid] = __expf((63 - tid) * lg); cb[192 + tid] = 1.0f; if (tid == 0) cb[256] = __expf(64.0f * lg); }
        }
    }
    for (int i = tid; i < 17408 / 4; i += 512) ((unsigned*)(lds + CK_ST))[i] = 0u;
    f32x4 Sacc[4];
#pragma unroll
    for (int i = 0; i < 4; ++i) Sacc[i] = (f32x4){0.f, 0.f, 0.f, 0.f};
    unsigned short xc[19], xb[19], xx[11], zr[8], dr = 0;
    auto load_raw = [&](int c) {
        const int t0 = 64 * c;
        if constexpr (TYPE == 0) {
#pragma unroll
            for (int i = 0; i < 19; ++i) { const int t = t0 + 16 * tq - 3 + i; xc[i] = 0; xb[i] = 0; if (t >= 0) { xc[i] = proj[(size_t)t * LDP + colC]; xb[i] = proj[(size_t)t * LDP + colB]; } }
#pragma unroll
            for (int i = 0; i < 11; ++i) { const int t = t0 + 8 * tx - 3 + i; xx[i] = 0; if (t >= 0) xx[i] = proj[(size_t)t * LDP + colX]; }
            if (w == 7) dr = proj[(size_t)(t0 + lane) * LDP + 5120 + h];
#pragma unroll
            for (int vv = 0; vv < 2; ++vv)
#pragma unroll
                for (int jx = 0; jx < 4; ++jx) zr[vv * 4 + jx] = proj[(size_t)(t0 + 16 * I + 4 * q + jx) * LDP + h * 64 + 16 * (Vn0 + vv) + r];
        } else {
#pragma unroll
            for (int i = 0; i < 16; ++i) { const int t = t0 + 16 * tq + i; xc[i] = proj[(size_t)t * LDP + colC]; xb[i] = proj[(size_t)t * LDP + colB]; }
#pragma unroll
            for (int i = 0; i < 8; ++i) xx[i] = proj[(size_t)(t0 + 8 * tx + i) * LDP + colX];
        }
    };
    load_raw(0);
    for (int c = 0; c < 32; ++c) {
        const int t0 = 64 * c;
        float* cum = cumb + (TYPE == 0 ? (c & 1) * 320 : 0);
        float vq_[16], vk_[16], vx_[8], kt_[16], Eval = 0.f;
        (void)kt_; (void)Eval;
        if constexpr (TYPE == 0) {
#pragma unroll
            for (int i = 0; i < 16; ++i) {
                vq_[i] = silu(cbC + cwC[0] * bf2f(xc[i]) + cwC[1] * bf2f(xc[i + 1]) + cwC[2] * bf2f(xc[i + 2]) + cwC[3] * bf2f(xc[i + 3]));
                vk_[i] = silu(cbB + cwB[0] * bf2f(xb[i]) + cwB[1] * bf2f(xb[i + 1]) + cwB[2] * bf2f(xb[i + 2]) + cwB[3] * bf2f(xb[i + 3]));
            }
#pragma unroll
            for (int i = 0; i < 8; ++i) vx_[i] = silu(cbX + cwX[0] * bf2f(xx[i]) + cwX[1] * bf2f(xx[i + 1]) + cwX[2] * bf2f(xx[i + 2]) + cwX[3] * bf2f(xx[i + 3]));
            if (w == 7) {
                const float dt = softplus(bf2f(dr) + dtb);
                float cs = dt * Aneg;
#pragma unroll
                for (int o = 1; o < 64; o <<= 1) { const float t = __shfl_up(cs, o); if (lane >= o) cs += t; }
                const float last = __shfl(cs, 63);
                cum[lane] = cs; cum[64 + lane] = __expf(cs); cum[128 + lane] = __expf(last - cs); cum[192 + lane] = dt;
                if (lane == 0) cum[256] = __expf(last);
            }
        } else if constexpr (TYPE == 2) {
            float lc[16], om[16];
            float run = 0.f;
#pragma unroll
            for (int i = 0; i < 16; ++i) { const float f = inv + (1.0f - inv) * sigm(bf2f(xb[i])); run += __logf(f); lc[i] = run; om[i] = 1.0f - f; }
#pragma unroll
            for (int i = 0; i < 16; ++i) { vq_[i] = silu(bf2f(xc[i])) * __expf(lc[i]); vk_[i] = om[i] * __expf(-lc[i]); kt_[i] = om[i] * __expf(run - lc[i]); }
            Eval = __expf(run);
#pragma unroll
            for (int i = 0; i < 8; ++i) vx_[i] = bf2f(xx[i]);
        } else {
#pragma unroll
            for (int i = 0; i < 16; ++i) {
                const double rev = (double)(t0 + 16 * tq + i) * (double)inv * 0.15915494309189535;
                const float fr = (float)(rev - floor(rev));
                const float sn = __builtin_amdgcn_sinf(fr), cs = __builtin_amdgcn_cosf(fr);
                const float a1 = bf2f(xc[i]), a2 = bf2f(xb[i]);
                vq_[i] = a1 * cs - a2 * sn; vk_[i] = a1 * sn + a2 * cs;
            }
#pragma unroll
            for (int i = 0; i < 8; ++i) vx_[i] = bf2f(xx[i]);
        }
        unsigned short zc[8];
#pragma unroll
        for (int i = 0; i < 8; ++i) zc[i] = zr[i];
        __syncthreads();
        if constexpr (TYPE == 0) {
            unsigned kt[8];
#pragma unroll
            for (int i = 0; i < 16; i += 2) {
                const int t = 16 * tq + i;
                const float k0 = vk_[i] * cum[192 + t], k1 = vk_[i + 1] * cum[192 + t + 1];
                *(bf16_t*)(lds + CK_QS + t * 272 + c1 * 2) = f2bf(vq_[i]); *(bf16_t*)(lds + CK_QS + (t + 1) * 272 + c1 * 2) = f2bf(vq_[i + 1]);
                *(bf16_t*)(lds + CK_KS + t * 272 + c1 * 2) = f2bf(k0); *(bf16_t*)(lds + CK_KS + (t + 1) * 272 + c1 * 2) = f2bf(k1);
                kt[i >> 1] = pk2(k0 * cum[128 + t], k1 * cum[128 + t + 1]);
            }
            *(u32x4*)(lds + CK_KT + c1 * 144 + 32 * tq) = (u32x4){kt[0], kt[1], kt[2], kt[3]};
            *(u32x4*)(lds + CK_KT + c1 * 144 + 32 * tq + 16) = (u32x4){kt[4], kt[5], kt[6], kt[7]};
        } else if constexpr (TYPE == 2) {
            unsigned kt[8];
#pragma unroll
            for (int i = 0; i < 16; i += 2) {
                const int t = 16 * tq + i;
                *(bf16_t*)(lds + CK_QS + t * 272 + c1 * 2) = f2bf(vq_[i]); *(bf16_t*)(lds + CK_QS + (t + 1) * 272 + c1 * 2) = f2bf(vq_[i + 1]);
                *(bf16_t*)(lds + CK_KS + t * 272 + c1 * 2) = f2bf(vk_[i]); *(bf16_t*)(lds + CK_KS + (t + 1) * 272 + c1 * 2) = f2bf(vk_[i + 1]);
                kt[i >> 1] = pk2(kt_[i], kt_[i + 1]);
            }
            *(u32x4*)(lds + CK_KT + c1 * 144 + 32 * tq) = (u32x4){kt[0], kt[1], kt[2], kt[3]};
            *(u32x4*)(lds + CK_KT + c1 * 144 + 32 * tq + 16) = (u32x4){kt[4], kt[5], kt[6], kt[7]};
            cum[tq * 128 + c1] = Eval;
        } else {
            const int isk = c1 >> 6, jf = c1 & 63;
            if (isk == 0) {
#pragma unroll
                for (int i = 0; i < 16; ++i) { const int t = 16 * tq + i; *(bf16_t*)(lds + CK_QS + t * 272 + jf * 2) = f2bf(vq_[i]); *(bf16_t*)(lds + CK_QS + t * 272 + (jf + 64) * 2) = f2bf(vk_[i]); }
            } else {
                unsigned kta[8], ktb[8];
#pragma unroll
                for (int i = 0; i < 16; i += 2) {
                    const int t = 16 * tq + i;
                    const float a0 = vq_[i] * 0.08838834764831845f, a1 = vq_[i + 1] * 0.08838834764831845f, b0 = vk_[i] * 0.08838834764831845f, b1 = vk_[i + 1] * 0.08838834764831845f;
                    *(bf16_t*)(lds + CK_KS + t * 272 + jf * 2) = f2bf(a0); *(bf16_t*)(lds + CK_KS + (t + 1) * 272 + jf * 2) = f2bf(a1);
                    *(bf16_t*)(lds + CK_KS + t * 272 + (jf + 64) * 2) = f2bf(b0); *(bf16_t*)(lds + CK_KS + (t + 1) * 272 + (jf + 64) * 2) = f2bf(b1);
                    kta[i >> 1] = pk2(a0 * cum[128 + t], a1 * cum[128 + t + 1]); ktb[i >> 1] = pk2(b0 * cum[128 + t], b1 * cum[128 + t + 1]);
                }
                *(u32x4*)(lds + CK_KT + jf * 144 + 32 * tq) = (u32x4){kta[0], kta[1], kta[2], kta[3]};
                *(u32x4*)(lds + CK_KT + jf * 144 + 32 * tq + 16) = (u32x4){kta[4], kta[5], kta[6], kta[7]};
                *(u32x4*)(lds + CK_KT + (jf + 64) * 144 + 32 * tq) = (u32x4){ktb[0], ktb[1], ktb[2], ktb[3]};
                *(u32x4*)(lds + CK_KT + (jf + 64) * 144 + 32 * tq + 16) = (u32x4){ktb[4], ktb[5], ktb[6], ktb[7]};
            }
        }
        *(u32x4*)(lds + CK_VT + cx * 144 + 16 * tx) = (u32x4){pk2(vx_[0], vx_[1]), pk2(vx_[2], vx_[3]), pk2(vx_[4], vx_[5]), pk2(vx_[6], vx_[7])};
        __syncthreads();
        if (c + 1 < 32) load_raw(c + 1);
        if constexpr (TYPE < 2) {
        bf16x8 aQ[4];
#pragma unroll
        for (int kb = 0; kb < 4; ++kb) aQ[kb] = ck_frag(lds, CK_QS, 272, 16 * I + r, kb, q);
        float cumi[4];
#pragma unroll
        for (int jx = 0; jx < 4; ++jx) cumi[jx] = cum[16 * I + 4 * q + jx];
#pragma unroll
        for (int jj = 0; jj < 2; ++jj) {
            const int J = Vn0 + jj;
            f32x4 acc = (f32x4){0.f, 0.f, 0.f, 0.f};
#pragma unroll
            for (int kb = 0; kb < 4; ++kb) acc = __builtin_amdgcn_mfma_f32_16x16x32_bf16(aQ[kb], ck_frag(lds, CK_KS, 272, 16 * J + r, kb, q), acc, 0, 0, 0);
            const int jcol = 16 * J + r; const float cumj = cum[jcol];
#pragma unroll
            for (int jx = 0; jx < 4; ++jx) {
                const int i = 16 * I + 4 * q + jx;
                const float v = (jcol <= i) ? acc[jx] * __expf(fminf(cumi[jx] - cumj, 0.f)) : 0.f;
                *(bf16_t*)(lds + CK_PS + i * 144 + jcol * 2) = f2bf(v);
            }
        }
        __syncthreads();
#pragma unroll
        for (int vv = 0; vv < 2; ++vv) {
            const int Vn = Vn0 + vv;
            f32x4 aPV = (f32x4){0.f, 0.f, 0.f, 0.f}, aQS = (f32x4){0.f, 0.f, 0.f, 0.f};
#pragma unroll
            for (int jb = 0; jb < 2; ++jb) aPV = __builtin_amdgcn_mfma_f32_16x16x32_bf16(ck_frag(lds, CK_PS, 144, 16 * I + r, jb, q), ck_frag(lds, CK_VT, 144, 16 * Vn + r, jb, q), aPV, 0, 0, 0);
#pragma unroll
            for (int kb = 0; kb < 4; ++kb) aQS = __builtin_amdgcn_mfma_f32_16x16x32_bf16(aQ[kb], ck_frag(lds, CK_ST, 272, 16 * Vn + r, kb, q), aQS, 0, 0, 0);
#pragma unroll
            for (int jx = 0; jx < 4; ++jx) {
                const int i = 16 * I + 4 * q + jx, v = 16 * Vn + r;
                const float o = aPV[jx] + cum[64 + i] * aQS[jx];
                if constexpr (TYPE == 0) {
                    const float xsv = bf2f(*(const bf16_t*)(lds + CK_VT + v * 144 + i * 2));
                    yz[(size_t)(t0 + i) * 4096 + h * 64 + v] = f2bf((o + Dh * xsv) * silu(bf2f(zc[vv * 4 + jx])));
                } else {
                    yz[(size_t)(t0 + i) * 4096 + 2048 + h * 256 + s * 64 + v] = f2bf(o);
                }
            }
        }
        __syncthreads();
        const float elast = cum[256];
#pragma unroll
        for (int Vn = 0; Vn < 4; ++Vn) {
            Sacc[Vn] = Sacc[Vn] * elast;
#pragma unroll
            for (int tb = 0; tb < 2; ++tb) Sacc[Vn] = __builtin_amdgcn_mfma_f32_16x16x32_bf16(ck_frag(lds, CK_KT, 144, 16 * w + r, tb, q), ck_frag(lds, CK_VT, 144, 16 * Vn + r, tb, q), Sacc[Vn], 0, 0, 0);
            *(u32x2*)(lds + CK_ST + (16 * Vn + r) * 272 + (16 * w + 4 * q) * 2) = (u32x2){pk2_sw(Sacc[Vn][0], Sacc[Vn][1]), pk2_sw(Sacc[Vn][2], Sacc[Vn][3])};
        }
            } else {
            const bf16x8 zf = (bf16x8){0, 0, 0, 0, 0, 0, 0, 0};
            if ((w & 1) == 0) {
                f32x4 acc = (f32x4){0.f, 0.f, 0.f, 0.f};
#pragma unroll
                for (int kb = 0; kb < 4; ++kb) acc = __builtin_amdgcn_mfma_f32_16x16x32_bf16(ck_frag(lds, CK_QS, 272, 16 * I + r, kb, q), ck_frag(lds, CK_KS, 272, 16 * I + r, kb, q), acc, 0, 0, 0);
#pragma unroll
                for (int jx = 0; jx < 4; ++jx) {
                    const float v = (r <= 4 * q + jx) ? acc[jx] : 0.f;
                    *(bf16_t*)(lds + CK_PS + (16 * I + 4 * q + jx) * 144 + (16 * I + r) * 2) = f2bf(v);
                }
            }
            __syncthreads();
#pragma unroll 1
            for (int sc = 0; sc < 4; ++sc) {
                if (w < 4) {
                    const int Vn = w;
                    f32x4 aO = (f32x4){0.f, 0.f, 0.f, 0.f};
                    const bf16x8 pa = (q < 2) ? *(const bf16x8*)(lds + CK_PS + (16 * sc + r) * 144 + (16 * sc + 8 * q) * 2) : zf;
                    const bf16x8 vb = (q < 2) ? *(const bf16x8*)(lds + CK_VT + (16 * Vn + r) * 144 + (16 * sc + 8 * q) * 2) : zf;
                    aO = __builtin_amdgcn_mfma_f32_16x16x32_bf16(pa, vb, aO, 0, 0, 0);
#pragma unroll
                    for (int kb = 0; kb < 4; ++kb) aO = __builtin_amdgcn_mfma_f32_16x16x32_bf16(ck_frag(lds, CK_QS, 272, 16 * sc + r, kb, q), ck_frag(lds, CK_ST, 272, 16 * Vn + r, kb, q), aO, 0, 0, 0);
#pragma unroll
                    for (int jx = 0; jx < 4; ++jx) yz[(size_t)(t0 + 16 * sc + 4 * q + jx) * 4096 + h * 128 + s * 64 + 16 * Vn + r] = (bf16_t)(pk2_sw(aO[jx], 0.f) & 0xffffu);
                }
                __syncthreads();
                {
                    const f32x4 e4 = *(const f32x4*)(cum + sc * 128 + 16 * w + 4 * q);
                    const bf16x8 ka = (q < 2) ? *(const bf16x8*)(lds + CK_KT + (16 * w + r) * 144 + (16 * sc + 8 * q) * 2) : zf;
#pragma unroll
                    for (int Vn = 0; Vn < 4; ++Vn) {
                        const bf16x8 vb = (q < 2) ? *(const bf16x8*)(lds + CK_VT + (16 * Vn + r) * 144 + (16 * sc + 8 * q) * 2) : zf;
                        Sacc[Vn] = __builtin_amdgcn_mfma_f32_16x16x32_bf16(ka, vb, Sacc[Vn] * e4, 0, 0, 0);
                        *(u32x2*)(lds + CK_ST + (16 * Vn + r) * 272 + (16 * w + 4 * q) * 2) = (u32x2){pk2_sw(Sacc[Vn][0], Sacc[Vn][1]), pk2_sw(Sacc[Vn][2], Sacc[Vn][3])};
                    }
                }
                __syncthreads();
            }
        }
    }
    const int ldS = TYPE == 0 ? 64 : (TYPE == 1 ? 256 : 128);
    float* Sout = p.out + (TYPE == 0 ? O_SSMP + ((size_t)(b * 32 + h) * 128) * 64 : (TYPE == 1 ? O_RETP + ((size_t)(b * 8 + h) * 128) * 256 + s * 64 : O_HGP + ((size_t)(b * 16 + h) * 128) * 128 + s * 64));
#pragma unroll
    for (int Vn = 0; Vn < 4; ++Vn)
#pragma unroll
        for (int jx = 0; jx < 4; ++jx) Sout[(size_t)(16 * w + 4 * q + jx) * ldS + 16 * Vn + r] = Sacc[Vn][jx];
}

__device__ __forceinline__ void lru_dec_unit(const Params& p, int b) {
    int tid = threadIdx.x; asm volatile("" : "+v"(tid));
    const int c = tid * 4;
    const int row0 = MP + 4 * b;
    const float* LA = (const float*)(p.ws + WS_LA) + (size_t)row0 * 2048 + c;
    const bf16_t* LBv = (const bf16_t*)(p.ws + WS_LBB) + (size_t)row0 * 2048 + c;
    const bf16_t* rg = (const bf16_t*)(p.ws + WS_PROJ) + (size_t)row0 * LD1 + 10240 + c;
    bf16_t* mixa = (bf16_t*)(p.ws + WS_ACT) + (size_t)row0 * 4096 + 2048 + c;
    f32x4 hst = *(const f32x4*)(p.in[6 + p.z] + (size_t)b * 2048 + c);
#pragma unroll
    for (int t = 0; t < 4; ++t) {
        const f32x4 a = *(const f32x4*)(LA + (size_t)t * 2048);
        float bb[4], gg[4]; unpack4(*(const u32x2*)(LBv + (size_t)t * 2048), bb); unpack4(*(const u32x2*)(rg + (size_t)t * LD1), gg);
        float y[4];
#pragma unroll
        for (int j = 0; j < 4; ++j) { hst[j] = a[j] * hst[j] + bb[j]; y[j] = hst[j] * gelu_tanh(gg[j]); }
        u32x2 ov; ov.x = pk2(y[0], y[1]); ov.y = pk2(y[2], y[3]);
        *(u32x2*)(mixa + (size_t)t * 4096) = ov;
    }
    *(f32x4*)(p.out + O_LRUS + (size_t)b * 2048 + c) = hst;
}

__device__ __forceinline__ void lru_scan_item(const Params& p, float* ldsf, int b, int cg) {
    int tid = threadIdx.x; asm volatile("" : "+v"(tid));
    const int w = tid >> 6, lane = tid & 63, c = cg * 64 + lane;
    const size_t row0 = (size_t)2048 * b + 256 * w;
    const float* LA = (const float*)(p.ws + WS_LA) + row0 * 2048 + c;
    const bf16_t* LBv = (const bf16_t*)(p.ws + WS_LBB) + row0 * 2048 + c;
    const bf16_t* rg = (const bf16_t*)(p.ws + WS_PROJ) + row0 * LD1 + 10240 + c;
    bf16_t* mixa = (bf16_t*)(p.ws + WS_ACT) + row0 * 4096 + 2048 + c;
    float hl = 0.f, pr = 1.f;
    for (int tb = 0; tb < 256; tb += 16) {
        float a0[16]; unsigned short b0[16];
#pragma unroll
        for (int t = 0; t < 16; ++t) { a0[t] = LA[(size_t)(tb + t) * 2048]; b0[t] = LBv[(size_t)(tb + t) * 2048]; }
#pragma unroll
        for (int t = 0; t < 16; ++t) { hl = a0[t] * hl + bf2f(b0[t]); pr *= a0[t]; }
    }
    ldsf[w * 128 + lane] = pr; ldsf[w * 128 + 64 + lane] = hl;
    __syncthreads();
    float hst = 0.f;
    for (int ww = 0; ww < w; ++ww) hst = ldsf[ww * 128 + lane] * hst + ldsf[ww * 128 + 64 + lane];
    for (int tb = 0; tb < 256; tb += 16) {
        float a0[16]; unsigned short b0[16], g0[16];
#pragma unroll
        for (int t = 0; t < 16; ++t) { a0[t] = LA[(size_t)(tb + t) * 2048]; b0[t] = LBv[(size_t)(tb + t) * 2048]; g0[t] = rg[(size_t)(tb + t) * LD1]; }
#pragma unroll
        for (int t = 0; t < 16; ++t) {
            hst = a0[t] * hst + bf2f(b0[t]);
            mixa[(size_t)(tb + t) * 4096] = f2bf(hst * gelu_tanh(bf2f(g0[t])));
        }
    }
    if (w == 7) p.out[O_LRUP + (size_t)b * 2048 + c] = hst;
}

__device__ __forceinline__ void phase_rec0(const Params& p, float* ldsf) {
    unsigned* ctr = (unsigned*)(p.ws + WS_CTL);
    const int total = 256 + 512 + 512;
    for (;;) {
        const int it = next_item(ctr, ldsf);
        if (it >= total) break;
        if (it < 128) chunk_item<0>(p, (unsigned char*)ldsf, it >> 5, it & 31, 0);
        else if (it < 256) { const int j = it - 128; chunk_item<1>(p, (unsigned char*)ldsf, j >> 5, (j & 31) >> 2, j & 3); }
        else if (it < 768) { const int j = it - 256; dec_unit<0>(p, ldsf, j >> 2, j & 3); }
        else { const int j = it - 768; dec_unit<1>(p, ldsf, j >> 2, j & 3); }
    }
}
__device__ __forceinline__ void phase_rec1(const Params& p, float* ldsf) {
    unsigned* ctr = (unsigned*)(p.ws + WS_CTL) + 64;
    const int total = 128 + 128 + 512 + 128;
    for (;;) {
        const int it = next_item(ctr, ldsf);
        if (it >= total) break;
        if (it < 128) chunk_item<2>(p, (unsigned char*)ldsf, it >> 5, (it & 31) >> 1, it & 1);
        else if (it < 256) { const int j = it - 128; lru_scan_item(p, ldsf, j >> 5, j & 31); }
        else if (it < 768) { const int j = it - 256; dec_unit<2>(p, ldsf, j >> 2, j & 3); }
        else lru_dec_unit(p, it - 768);
    }
}

__device__ __forceinline__ void seq_of_row(int row, int& sample, int& b, int& t, int& L) {
    if (row < MP) { sample = 0; b = row >> 11; t = row & 2047; L = 2048; } else { sample = 1; b = (row - MP) >> 2; t = (row - MP) & 3; L = 4; }
}

__device__ __forceinline__ void phase_prep0(const Params& p) {
    int tid = threadIdx.x; asm volatile("" : "+v"(tid));
    const int wave = tid >> 6, lane = tid & 63;
    const int gw = blockIdx.x * 8 + wave, NGW = gridDim.x * 8;
    const bf16_t* YZ = (const bf16_t*)(p.ws + WS_YZ); const bf16_t* PR = (const bf16_t*)(p.ws + WS_PROJ);
    bf16_t* MX = (bf16_t*)(p.ws + WS_ACT);
    const float* nw = p.in[18 + p.z];
    for (int row = gw; row < MT; row += NGW) {
        const bf16_t* yz = YZ + (size_t)row * 4096; bf16_t* mx = MX + (size_t)row * 4096;
        u32x4 ya[4]; u32x2 yb[8], gb[8];
#pragma unroll
        for (int g = 0; g < 4; ++g) ya[g] = *(const u32x4*)(yz + g * 512 + lane * 8);
#pragma unroll
        for (int hh = 0; hh < 8; ++hh) { yb[hh] = *(const u32x2*)(yz + 2048 + hh * 256 + lane * 4); gb[hh] = *(const u32x2*)(PR + (size_t)row * LD0 + 9248 + hh * 256 + lane * 4); }
#pragma unroll
        for (int g = 0; g < 4; ++g) {
            const int c = g * 512 + lane * 8;
            float v[8]; unpack8(ya[g], v);
            float s = 0.f;
#pragma unroll
            for (int j = 0; j < 8; ++j) s += v[j] * v[j];
            s = wave_sum(s);
            const float rs = rsqrtf(s * (1.0f / 512.0f) + EPS);
            const f32x4 n0 = *(const f32x4*)(nw + c), n1 = *(const f32x4*)(nw + c + 4);
            u32x4 o; o.x = pk2(v[0] * rs * n0[0], v[1] * rs * n0[1]); o.y = pk2(v[2] * rs * n0[2], v[3] * rs * n0[3]);
            o.z = pk2(v[4] * rs * n1[0], v[5] * rs * n1[1]); o.w = pk2(v[6] * rs * n1[2], v[7] * rs * n1[3]);
            *(u32x4*)(mx + c) = o;
        }
#pragma unroll
        for (int hh = 0; hh < 8; ++hh) {
            const int c = hh * 256 + lane * 4;
            float v[4]; unpack4(yb[hh], v);
            float gt[4]; unpack4(gb[hh], gt);
            float s = (v[0] * v[0] + v[1] * v[1]) + (v[2] * v[2] + v[3] * v[3]);
            s = wave_sum(s);
            const float rs = rsqrtf(s * (1.0f / 256.0f) + EPS);
            u32x2 o; o.x = pk2(v[0] * rs * silu(gt[0]), v[1] * rs * silu(gt[1])); o.y = pk2(v[2] * rs * silu(gt[2]), v[3] * rs * silu(gt[3]));
            *(u32x2*)(mx + 2048 + c) = o;
        }
        int sample, b, t, L; seq_of_row(row, sample, b, t, L);
        if (t >= L - 3) {
            float* dst = p.out + (sample ? O_SCS : O_SCP) + ((size_t)b * 3 + (t - (L - 3))) * 3072;
            const bf16_t* src = PR + (size_t)row * LD0 + 2048;
#pragma unroll 4
            for (int c = lane; c < 3072; c += 64) dst[c] = bf2f(src[c]);
        }
    }
}

__device__ __forceinline__ void phase_prep1(const Params& p) {
    int tid = threadIdx.x; asm volatile("" : "+v"(tid));
    const int wave = tid >> 6, lane = tid & 63;
    const int gw = blockIdx.x * 8 + wave, NGW = gridDim.x * 8;
    const bf16_t* YZ = (const bf16_t*)(p.ws + WS_YZ); const bf16_t* PR = (const bf16_t*)(p.ws + WS_PROJ);
    bf16_t* MX = (bf16_t*)(p.ws + WS_ACT);
    const float* nw = p.in[22 + p.z];
    for (int row = gw; row < MT; row += NGW) {
        u32x4 ya[4], ga[4];
#pragma unroll
        for (int it = 0; it < 4; ++it) { ya[it] = *(const u32x4*)(YZ + (size_t)row * 4096 + it * 512 + lane * 8); ga[it] = *(const u32x4*)(PR + (size_t)row * LD1 + 6144 + it * 512 + lane * 8); }
#pragma unroll
        for (int it = 0; it < 4; ++it) {
            const int c = it * 512 + lane * 8;
            float v[8]; unpack8(ya[it], v);
            float gt[8]; unpack8(ga[it], gt);
            float s = 0.f;
#pragma unroll
            for (int j = 0; j < 8; ++j) s += v[j] * v[j];
            s += __shfl_xor(s, 1); s += __shfl_xor(s, 2); s += __shfl_xor(s, 4); s += __shfl_xor(s, 8);
            const float rs = rsqrtf(s * (1.0f / 128.0f) + EPS);
            const f32x4 n0 = *(const f32x4*)(nw + (c & 127)), n1 = *(const f32x4*)(nw + (c & 127) + 4);
            float o[8];
#pragma unroll
            for (int j = 0; j < 8; ++j) o[j] = v[j] * rs * (j < 4 ? n0[j] : n1[j - 4]) * silu(gt[j]);
            u32x4 ov; ov.x = pk2(o[0], o[1]); ov.y = pk2(o[2], o[3]); ov.z = pk2(o[4], o[5]); ov.w = pk2(o[6], o[7]);
            *(u32x4*)(MX + (size_t)row * 4096 + c) = ov;
        }
    }
}

__device__ __forceinline__ void phase_act(const Params& p, int l) {
    int tid = threadIdx.x; asm volatile("" : "+v"(tid));
    const bf16_t* PR = (const bf16_t*)(p.ws + WS_PROJ); bf16_t* ACT = (bf16_t*)(p.ws + WS_ACT);
    const float* cw = p.in[32 + p.z] + (size_t)l * 3 * DFF; const float* cbv = p.in[33 + p.z] + (size_t)l * DFF;
    const float* st = p.in[8 + p.z] + (size_t)l * 128 * 2 * DFF;
    const int total = (MT / 4) * 704;
    for (int idx = blockIdx.x * 512 + tid; idx < total; idx += gridDim.x * 512) {
        const int rb = idx / 704, c = (idx - rb * 704) * 8, r0 = rb * 4;
        int sample, b, t0, L; seq_of_row(r0, sample, b, t0, L);
        u32x4 gr[6], ur[4];
#pragma unroll
        for (int i = 0; i < 4; ++i) { gr[i + 2] = *(const u32x4*)(PR + (size_t)(r0 + i) * LDU + c); ur[i] = *(const u32x4*)(PR + (size_t)(r0 + i) * LDU + DFF + c); }
        float g[6][8];
        if (t0 >= 2) { gr[0] = *(const u32x4*)(PR + (size_t)(r0 - 2) * LDU + c); gr[1] = *(const u32x4*)(PR + (size_t)(r0 - 1) * LDU + c); unpack8(gr[0], g[0]); unpack8(gr[1], g[1]); }
        else {
#pragma unroll
            for (int j = 0; j < 8; ++j) { g[0][j] = sample ? st[((size_t)b * 2 + 0) * DFF + c + j] : 0.f; g[1][j] = sample ? st[((size_t)b * 2 + 1) * DFF + c + j] : 0.f; }
        }
#pragma unroll
        for (int i = 0; i < 4; ++i) unpack8(gr[i + 2], g[i + 2]);
        float w0[8], w1[8], w2[8], bb[8];
#pragma unroll
        for (int j = 0; j < 8; ++j) { w0[j] = cw[c + j]; w1[j] = cw[DFF + c + j]; w2[j] = cw[2 * DFF + c + j]; bb[j] = cbv[c + j]; }
#pragma unroll
        for (int i = 0; i < 4; ++i) {
            float uu[8], o[8]; unpack8(ur[i], uu);
#pragma unroll
            for (int j = 0; j < 8; ++j) o[j] = silu(bb[j] + w0[j] * g[i][j] + w1[j] * g[i + 1][j] + w2[j] * g[i + 2][j]) * uu[j];
            u32x4 ov; ov.x = pk2(o[0], o[1]); ov.y = pk2(o[2], o[3]); ov.z = pk2(o[4], o[5]); ov.w = pk2(o[6], o[7]);
            *(u32x4*)(ACT + (size_t)(r0 + i) * DFF + c) = ov;
        }
        if (t0 + 4 == L) {
#pragma unroll
            for (int i = 0; i < 2; ++i) {
                float* dst = p.out + (sample ? O_FCS + (((size_t)l * 128 + b) * 2 + i) * DFF : O_FCP + (((size_t)l * 4 + b) * 2 + i) * DFF) + c;
                *(f32x4*)dst = (f32x4){g[4 + i][0], g[4 + i][1], g[4 + i][2], g[4 + i][3]}; *(f32x4*)(dst + 4) = (f32x4){g[4 + i][4], g[4 + i][5], g[4 + i][6], g[4 + i][7]};
            }
        }
    }
}

__device__ __forceinline__ void phase_lruconv(const Params& p) {
    int tid = threadIdx.x; asm volatile("" : "+v"(tid));
    const bf16_t* PR = (const bf16_t*)(p.ws + WS_PROJ); bf16_t* XR = (bf16_t*)(p.ws + WS_XR);
    const float* cw = p.in[23 + p.z]; const float* cbv = p.in[24 + p.z]; const float* st = p.in[7 + p.z];
    const int total = (MT / 4) * 256;
    for (int idx = blockIdx.x * 512 + tid; idx < total; idx += gridDim.x * 512) {
        const int rb = idx >> 8, c = (idx & 255) * 8, r0 = rb * 4;
        int sample, b, t0, L; seq_of_row(r0, sample, b, t0, L);
        float x[7][8];
#pragma unroll
        for (int j = 3; j < 7; ++j) unpack8(*(const u32x4*)(PR + (size_t)(r0 - 3 + j) * LD1 + 8192 + c), x[j]);
        if (t0 >= 3) {
#pragma unroll
            for (int j = 0; j < 3; ++j) unpack8(*(const u32x4*)(PR + (size_t)(r0 - 3 + j) * LD1 + 8192 + c), x[j]);
        } else {
#pragma unroll
            for (int j = 0; j < 3; ++j)
#pragma unroll
                for (int i = 0; i < 8; ++i) x[j][i] = sample ? st[((size_t)b * 3 + j) * 2048 + c + i] : 0.f;
        }
        float w0[8], w1[8], w2[8], w3[8], bb[8];
#pragma unroll
        for (int i = 0; i < 8; ++i) { w0[i] = cw[c + i]; w1[i] = cw[2048 + c + i]; w2[i] = cw[4096 + c + i]; w3[i] = cw[6144 + c + i]; bb[i] = cbv[c + i]; }
#pragma unroll
        for (int rr = 0; rr < 4; ++rr) {
            float o[8];
#pragma unroll
            for (int i = 0; i < 8; ++i) o[i] = bb[i] + w0[i] * x[rr][i] + w1[i] * x[rr + 1][i] + w2[i] * x[rr + 2][i] + w3[i] * x[rr + 3][i];
            u32x4 ov; ov.x = pk2(o[0], o[1]); ov.y = pk2(o[2], o[3]); ov.z = pk2(o[4], o[5]); ov.w = pk2(o[6], o[7]);
            *(u32x4*)(XR + (size_t)(r0 + rr) * 2048 + c) = ov;
        }
        if (t0 + 4 == L) {
#pragma unroll
            for (int j = 0; j < 3; ++j) {
                float* dst = p.out + (sample ? O_LCS : O_LCP) + ((size_t)b * 3 + j) * 2048 + c;
                *(f32x4*)dst = (f32x4){x[4 + j][0], x[4 + j][1], x[4 + j][2], x[4 + j][3]}; *(f32x4*)(dst + 4) = (f32x4){x[4 + j][4], x[4 + j][5], x[4 + j][6], x[4 + j][7]};
            }
        }
    }
}

__device__ __forceinline__ void finalize_sample_rows(const Params& p, float* ssdst, int nsplit) {
    int tid = threadIdx.x; asm volatile("" : "+v"(tid));
    const int wave = tid >> 6, lane = tid & 63;
    const int gw = blockIdx.x * 8 + wave, NGW = gridDim.x * 8;
    float* X = (float*)(p.ws + WS_X); bf16_t* XB = (bf16_t*)(p.ws + WS_XB); const float* PT = (const float*)(p.ws + WS_PROJ);
    for (int row = MP + gw; row < MT; row += NGW) {
        float s = 0.f;
#pragma unroll 2
        for (int j = 0; j < 8; ++j) {
            const unsigned o = (unsigned)row * 2048u + (unsigned)(lane + 64 * j) * 4u;
            f32x4 v = *(const f32x4*)(X + o);
            for (int ks = 0; ks < nsplit; ++ks) v += *(const f32x4*)(PT + (size_t)ks * (512 * 2048) + (o - (unsigned)MP * 2048u));
            *(f32x4*)(X + o) = v;
            u32x2 w; w.x = pk2(v[0], v[1]); w.y = pk2(v[2], v[3]);
            *(u32x2*)(XB + o) = w;
            s += (v[0] * v[0] + v[1] * v[1]) + (v[2] * v[2] + v[3] * v[3]);
        }
        s = wave_sum(s);
        if (lane == 0) ssdst[row] = s;
    }
}

__device__ __forceinline__ void phase_final(const Params& p) {
    int tid = threadIdx.x; asm volatile("" : "+v"(tid));
    const int wave = tid >> 6, lane = tid & 63;
    const int gw = blockIdx.x * 8 + wave, NGW = gridDim.x * 8;
    const float* X = (const float*)(p.ws + WS_X); const float* nf = p.in[11 + p.z];
    for (int row = gw; row < MT; row += NGW) {
        f32x4 v[8]; float sq = 0.f;
#pragma unroll
        for (int j = 0; j < 8; ++j) { v[j] = *(const f32x4*)(X + (size_t)row * 2048 + (lane + 64 * j) * 4);
            if (row >= MP) { for (int ks = 0; ks < 11; ++ks) v[j] += *(const f32x4*)((const float*)(p.ws + WS_PROJ) + (size_t)ks * (512 * 2048) + (size_t)(row - MP) * 2048 + (lane + 64 * j) * 4); }
            sq += (v[j][0] * v[j][0] + v[j][1] * v[j][1]) + (v[j][2] * v[j][2] + v[j][3] * v[j][3]); }
        sq = wave_sum(sq);
        const float rs = rsqrtf(sq * (1.0f / 2048.0f) + EPS);
        float* dst = p.out + (row < MP ? O_YP + (size_t)row * 2048 : O_YS + (size_t)(row - MP) * 2048);
#pragma unroll
        for (int j = 0; j < 8; ++j) {
            const int c = (lane + 64 * j) * 4;
            *(f32x4*)(dst + c) = v[j] * rs * *(const f32x4*)(nf + c);
        }
    }
}

#define XB_TMO      128
#define XB_XCNT(j)  (256  + 64 * (j))
#define XB_XSUB(j)  (1280 + 64 * (j))
#define XB_XGEN(j)  (2304 + 64 * (j))
#define XB_TOP      3328
#define XB_TOPGEN   3392
#define XCD_BAR_WORDS 3456
#define XB_SPIN_CAP (1u << 22)
__device__ __forceinline__ unsigned xb_ld(unsigned* p)              { return __hip_atomic_load(p, __ATOMIC_RELAXED, __HIP_MEMORY_SCOPE_AGENT); }
__device__ __forceinline__ unsigned xb_add(unsigned* p, unsigned v) { return __hip_atomic_fetch_add(p, v, __ATOMIC_RELAXED, __HIP_MEMORY_SCOPE_AGENT); }
__device__ __forceinline__ unsigned xb_xcc_id() { return (unsigned)__builtin_amdgcn_s_getreg((3 << 11) | 20) & 0xFu; }
#define XB_SPIN(cond, bar) do { unsigned _sp = 0; while (cond) { __builtin_amdgcn_s_sleep(1); \
    if ((++_sp & 255u) == 0u) { if (xb_ld(&(bar)[XB_TMO])) break; if (_sp > XB_SPIN_CAP) { atomicAdd(&(bar)[XB_TMO], 1u); break; } } } } while (0)
struct XcdBarrier { unsigned* bar; unsigned x; volatile LAS unsigned* st; };
__device__ __forceinline__ XcdBarrier xcd_barrier_post(unsigned* bar, volatile LAS unsigned* st) {
    XcdBarrier b; b.bar = bar; b.x = xb_xcc_id(); b.st = st;
    if (threadIdx.x == 0) (void)xb_add(&bar[XB_XCNT(b.x)], 1u);
    return b;
}
__device__ __forceinline__ void xcd_barrier_complete(unsigned* bar, unsigned x, unsigned& nloc, unsigned& nx) {
    const unsigned G = gridDim.x * gridDim.y * gridDim.z;
    unsigned sum, cnt, mine, sp = 0u;
    for (;;) {
        sum = 0u; cnt = 0u; mine = 0u;
#pragma unroll
        for (unsigned j = 0; j < 16; ++j) { const unsigned c = xb_ld(&bar[XB_XCNT(j)]); sum += c; cnt += (c > 0u) ? 1u : 0u; mine = (j == x) ? c : mine; }
        if (sum == G) break;
        __builtin_amdgcn_s_sleep(1);
        if ((++sp & 255u) == 0u) { if (xb_ld(&bar[XB_TMO])) break; if (sp > XB_SPIN_CAP) { atomicAdd(&bar[XB_TMO], 1u); break; } }
    }
    nloc = mine > 0u ? mine : 1u; nx = cnt > 0u ? cnt : 1u;
}
__device__ __forceinline__ void xcd_barrier(const XcdBarrier& b) {
    asm volatile("s_waitcnt vmcnt(0)" ::: "memory");
    __syncthreads();
    if (threadIdx.x == 0) {
        unsigned* bar = b.bar;
        __builtin_amdgcn_s_waitcnt(0);
        unsigned nloc = b.st[0], nx = b.st[1];
        if (nloc == 0u) { xcd_barrier_complete(bar, b.x, nloc, nx); b.st[0] = nloc; b.st[1] = nx; }
        const unsigned old = xb_add(&bar[XB_XSUB(b.x)], 1u);
        const unsigned gen = old / nloc;
        if (old + 1u == (gen + 1u) * nloc) {
            __builtin_amdgcn_fence(__ATOMIC_RELEASE, "agent");
            asm volatile("s_waitcnt vmcnt(0)" ::: "memory");
            const unsigned og = xb_add(&bar[XB_TOP], 1u);
            const unsigned tg = og / nx;
            if (og + 1u == (tg + 1u) * nx) xb_add(&bar[XB_TOPGEN], 1u);
            else XB_SPIN(xb_ld(&bar[XB_TOPGEN]) == tg, bar);
            __builtin_amdgcn_fence(__ATOMIC_ACQUIRE, "agent");
            xb_add(&bar[XB_XGEN(b.x)], 1u);
            asm volatile("s_waitcnt vmcnt(0)" ::: "memory");
        } else {
            XB_SPIN(xb_ld(&bar[XB_XGEN(b.x)]) == gen, bar);
            __builtin_amdgcn_fence(__ATOMIC_ACQUIRE, "agent");
            asm volatile("s_waitcnt vmcnt(0)" ::: "memory");
        }
    }
    __syncthreads();
}

#ifndef PROBE_MASK
#define PROBE_MASK 0u
#endif
#ifndef PHMASK
#define PHMASK 0xFFFFFFFFu
#endif
#define EN(i) (((PHMASK) >> (i)) & 1u)
__global__ void __launch_bounds__(512, 2) fwd_megakernel(Params p) {
    extern __shared__ __attribute__((aligned(16))) unsigned char shm[];
    float* ldsf = (float*)shm;
    LAS unsigned char* ldsg = (LAS unsigned char*)shm;
    unsigned char* ws = p.ws;
    float* ssb = (float*)(ws + WS_SS);
    volatile LAS unsigned* xst = (volatile LAS unsigned*)(ldsg + 133120);
    if (threadIdx.x == 0) { xst[0] = 0u; xst[1] = 0u; }
    __syncthreads();
    (void)xcd_barrier_post((unsigned*)(ws + WS_CTL) + 256, xst);
#define XBAR() do { XcdBarrier _b; _b.bar = (unsigned*)(p.ws + WS_CTL) + 256; _b.x = xb_xcc_id(); _b.st = (volatile LAS unsigned*)((LAS unsigned char*)shm + 133120); xcd_barrier(_b); } while (0)
#if PROBE_MASK
    unsigned long long tph = __builtin_amdgcn_s_memrealtime();
#endif
    for (int ph = p.ph_lo; ph < p.ph_hi; ++ph) {
        if (ph > p.ph_lo) {
            if (ph == 1) cg::this_grid().sync();
            else XBAR();
#if PROBE_MASK
            {
                const unsigned long long t1 = __builtin_amdgcn_s_memrealtime();
                if ((PROBE_MASK >> (ph - 1)) & 1u) { const unsigned long long dt = t1 - tph; while (__builtin_amdgcn_s_memrealtime() - t1 < dt) __builtin_amdgcn_s_sleep(8); }
                tph = __builtin_amdgcn_s_memrealtime();
            }
#endif
        }
        if (EN(0) && ph == 0) phase_prologue(p, ldsf);
        else if (EN(1) && (ph == 1 || ph == 5 || ph == 8 || ph == 14)) {
            pg8::Gemm g; pg8::EpiScaleBf16 E; int N;
            if (ph != 1) { finalize_sample_rows(p, ssb + (ph == 5 ? 1 : (ph == 8 ? 2 : 3)) * MT, ph == 8 ? 11 : 16); XBAR(); }
            g.A = (const char*)(ws + WS_XB); g.lda = 2048; g.ldb = 2048;
            if (ph == 1) { g.Bt = (const char*)(ws + WS_WIN0); N = LD0; E.ss = ssb; }
            else if (ph == 5) { g.Bt = (const char*)(ws + WS_WUP0); N = LDU; E.ss = ssb + MT; }
            else if (ph == 8) { g.Bt = (const char*)(ws + WS_WIN1); N = LD1; E.ss = ssb + 2 * MT; }
            else { g.Bt = (const char*)(ws + WS_WUP1); N = LDU; E.ss = ssb + 3 * MT; }
            E.O = (bf16_t*)(ws + WS_PROJ); E.ldc = N;
            pg8::Order S; S.nMm = 32; S.nN = N / 256; S.n_main = 32 * S.nN; S.n_tail = 2 * S.nN; S.ksplit = 1; S.nt_full = 32; S.G = gridDim.x; S.c = blockIdx.x;
            S.a_t = (size_t)256 * 2048 * 2; S.b_t = (size_t)256 * 2048 * 2; S.acol = 0;
            pg8::gemm_phase<pg8::EpiScaleBf16>(ldsg, g, S, E);
        }
        else if (EN(4) && (ph == 4 || ph == 7 || ph == 13 || ph == 16)) {
            pg8::Gemm g; pg8::EpiResid E;
            g.A = (const char*)(ws + WS_ACT);
            if (ph == 4) { g.Bt = (const char*)(ws + WS_WOUT0); g.lda = 4096; E.ssout = ssb + MT; }
            else if (ph == 7) { g.Bt = (const char*)(ws + WS_WDN0); g.lda = DFF; E.ssout = ssb + 2 * MT; }
            else if (ph == 13) { g.Bt = (const char*)(ws + WS_WOUT1); g.lda = 4096; E.ssout = ssb + 3 * MT; }
            else { g.Bt = (const char*)(ws + WS_WDN1); g.lda = DFF; E.ssout = ssb + 4 * MT; }
            g.ldb = g.lda;
            E.X = (float*)(ws + WS_X); E.XB = (bf16_t*)(ws + WS_XB); E.part = (float*)(ws + WS_PROJ);
            pg8::Order S; S.nMm = 32; S.nN = 8; S.n_main = 256; S.nt_full = g.lda / 64; S.ksplit = (g.lda == 4096) ? 16 : 11; S.n_tail = 16 * S.ksplit; S.G = gridDim.x; S.c = blockIdx.x;
            S.a_t = (size_t)256 * g.lda * 2; S.b_t = (size_t)256 * g.ldb * 2; S.acol = 0;
            pg8::gemm_phase<pg8::EpiResid>(ldsg, g, S, E);
        }
        else if (EN(10) && ph == 10) {
            pg8::Gemm g; pg8::EpiLru E;
            g.A = (const char*)(ws + WS_XR); g.Bt = (const char*)(ws + WS_WLRU); g.lda = 2048; g.ldb = 256;
            E.br = p.in[26 + p.z]; E.bi = p.in[28 + p.z]; E.sp = (const float*)(ws + WS_SP); E.XR = (const bf16_t*)(ws + WS_XR);
            E.LA = (float*)(ws + WS_LA); E.LBv = (bf16_t*)(ws + WS_LBB);
            pg8::Order S; S.nMm = 34; S.nN = 16; S.n_main = 34 * 16; S.n_tail = 0; S.ksplit = 1; S.nt_full = 4 + p.z; S.G = gridDim.x; S.c = blockIdx.x;
            S.a_t = (size_t)256 * 2048 * 2; S.b_t = (size_t)256 * 256 * 2; S.acol = 512;
            pg8::gemm_phase<pg8::EpiLru>(ldsg, g, S, E);
        }
        else if (EN(2) && ph == 2) phase_rec0(p, ldsf);
        else if (EN(3) && ph == 3) phase_prep0(p);
        else if (EN(6) && ph == 6) phase_act(p, 0);
        else if (EN(9) && ph == 9) phase_lruconv(p);
        else if (EN(11) && ph == 11) phase_rec1(p, ldsf);
        else if (EN(12) && ph == 12) phase_prep1(p);
        else if (EN(15) && ph == 15) phase_act(p, 1);
        else if (EN(17) && ph == 17) phase_final(p);
    }
}

#ifndef N_LAUNCH_MODE
#define N_LAUNCH_MODE 0
#endif

extern "C" void kernel_launch(void* const* d_in, const int* in_sizes, int n_in, void* d_out, int out_size, void* d_ws, size_t ws_size, hipStream_t stream) {
    static int grid = 0;
    if (grid == 0) {
        if (n_in != 35 || (size_t)out_size != O_END || ws_size < WS_END) { fprintf(stderr, "kernel_launch: unexpected shapes: n_in %d out %d ws %zu (need %zu)\n", n_in, out_size, ws_size, (size_t)WS_END); grid = -1; return; }
        int dev = 0, cus = 0, per_cu = 0;
        hipGetDevice(&dev);
        hipDeviceGetAttribute(&cus, hipDeviceAttributeMultiprocessorCount, dev);
        if (hipFuncSetAttribute((const void*)fwd_megakernel, hipFuncAttributeMaxDynamicSharedMemorySize, LDS_BYTES) != hipSuccess) { fprintf(stderr, "kernel_launch: hipFuncSetAttribute failed\n"); grid = -1; return; }
        if (hipOccupancyMaxActiveBlocksPerMultiprocessor(&per_cu, (const void*)fwd_megakernel, 512, LDS_BYTES) != hipSuccess || per_cu < 1) { fprintf(stderr, "kernel_launch: occupancy query says %d\n", per_cu); per_cu = 1; }
        (void)hipGetLastError();
        grid = cus;
    }
    if (grid < 0) return;
    (void)hipMemsetAsync((char*)d_ws + WS_CTL, 0, 16384, stream);
    Params p{};
    for (int i = 0; i < 35; ++i) p.in[i] = (const float*)d_in[i];
    p.z = 0; p.pad = 0;
    p.out = (float*)d_out; p.ws = (unsigned char*)d_ws;
#if N_LAUNCH_MODE == 0
    p.ph_lo = 0; p.ph_hi = NPHASE;
    void* args[] = {&p};
    hipError_t e = hipLaunchCooperativeKernel((const void*)fwd_megakernel, dim3(grid), dim3(512), args, LDS_BYTES, stream);
    if (e != hipSuccess) fprintf(stderr, "cooperative launch failed: %s (grid %d)\n", hipGetErrorString(e), grid);
#else
    for (int ph = 0; ph < NPHASE; ++ph) {
        p.ph_lo = ph; p.ph_hi = ph + 1;
        hipLaunchKernelGGL(fwd_megakernel, dim3(grid), dim3(512), LDS_BYTES, stream, p);
    }
#endif
}
```

```cpp
#include <hip/hip_runtime.h>
#include <hip/hip_cooperative_groups.h>
#include <cstdio>
#include <cstdint>
namespace cg = cooperative_groups;

#define LAS __attribute__((address_space(3)))
typedef unsigned short bf16_t;
typedef short bf16x8 __attribute__((ext_vector_type(8)));
typedef float f32x4 __attribute__((ext_vector_type(4)));
typedef float f32x2 __attribute__((ext_vector_type(2)));
typedef unsigned u32x4 __attribute__((ext_vector_type(4)));
typedef unsigned u32x2 __attribute__((ext_vector_type(2)));

constexpr int D = 2048, MP = 8192, MS = 512, MT = 8704;
constexpr int LD0 = 11520, LD1 = 12288, LDU = 11264, DFF = 5632;
constexpr float EPS = 1e-6f;
constexpr size_t O_YP = 0;
constexpr size_t O_YS = O_YP + (size_t)4 * 2048 * 2048;
constexpr size_t O_SSMP = O_YS + (size_t)128 * 4 * 2048;
constexpr size_t O_SSMS = O_SSMP + (size_t)4 * 32 * 128 * 64;
constexpr size_t O_SCP = O_SSMS + (size_t)128 * 32 * 128 * 64;
constexpr size_t O_SCS = O_SCP + (size_t)4 * 3 * 3072;
constexpr size_t O_RETP = O_SCS + (size_t)128 * 3 * 3072;
constexpr size_t O_RETS = O_RETP + (size_t)4 * 8 * 128 * 256;
constexpr size_t O_HGP = O_RETS + (size_t)128 * 8 * 128 * 256;
constexpr size_t O_HGS = O_HGP + (size_t)4 * 16 * 128 * 128;
constexpr size_t O_LRUP = O_HGS + (size_t)128 * 16 * 128 * 128;
constexpr size_t O_LRUS = O_LRUP + (size_t)4 * 2048;
constexpr size_t O_LCP = O_LRUS + (size_t)128 * 2048;
constexpr size_t O_LCS = O_LCP + (size_t)4 * 3 * 2048;
constexpr size_t O_FCP = O_LCS + (size_t)128 * 3 * 2048;
constexpr size_t O_FCS = O_FCP + (size_t)2 * 4 * 2 * 5632;
constexpr size_t O_END = O_FCS + (size_t)2 * 128 * 2 * 5632;
constexpr size_t al256(size_t x) { return (x + 255) & ~(size_t)255; }
constexpr size_t WS_CTL = 0;
constexpr size_t WS_SS = 16384;
constexpr size_t WS_SP = al256(WS_SS + (size_t)5 * MT * 4);
constexpr size_t WS_LB = WS_SP + 8192;
constexpr size_t WS_WIN0 = WS_LB + 8192;
constexpr size_t WS_WOUT0 = WS_WIN0 + (size_t)LD0 * 2048 * 2;
constexpr size_t WS_WUP0 = WS_WOUT0 + (size_t)2048 * 4096 * 2;
constexpr size_t WS_WDN0 = WS_WUP0 + (size_t)LDU * 2048 * 2;
constexpr size_t WS_WIN1 = WS_WDN0 + (size_t)2048 * DFF * 2;
constexpr size_t WS_WOUT1 = WS_WIN1 + (size_t)LD1 * 2048 * 2;
constexpr size_t WS_WUP1 = WS_WOUT1 + (size_t)2048 * 4096 * 2;
constexpr size_t WS_WDN1 = WS_WUP1 + (size_t)LDU * 2048 * 2;
constexpr size_t WS_WLRU = WS_WDN1 + (size_t)2048 * DFF * 2;
constexpr size_t WS_X = WS_WLRU + (size_t)16 * 256 * 256 * 2;
constexpr size_t WS_XB = WS_X + (size_t)MT * 2048 * 4;
constexpr size_t WS_PROJ = WS_XB + (size_t)MT * 2048 * 2;
constexpr size_t WS_ACT = WS_PROJ + (size_t)MT * LD1 * 2;
constexpr size_t WS_YZ = WS_ACT + (size_t)MT * DFF * 2;
constexpr size_t WS_LA = WS_YZ + (size_t)MT * 4096 * 2;
constexpr size_t WS_LBB = WS_LA + (size_t)MT * 2048 * 4;
constexpr size_t WS_XR = WS_LBB + (size_t)MT * 2048 * 2;
constexpr size_t WS_END = WS_XR + (size_t)MT * 2048 * 2;

constexpr int LDS_BYTES = 133120 + 256;
constexpr int NPHASE = 18;

struct Params {
    const float* in[35];
    float* out;
    unsigned char* ws;
    int ph_lo, ph_hi;
    int z, pad;
};

__device__ __forceinline__ float bf2f(unsigned v) { return __uint_as_float(v << 16); }
__device__ __forceinline__ unsigned pk2(float lo, float hi) { unsigned r; asm volatile("v_cvt_pk_bf16_f32 %0, %1, %2" : "=v"(r) : "v"(lo), "v"(hi)); return r; }
__device__ __forceinline__ unsigned pk2_sw(float lo, float hi) {
    unsigned a = __float_as_uint(lo), b = __float_as_uint(hi); a += 0x7fffu + ((a >> 16) & 1u); b += 0x7fffu + ((b >> 16) & 1u); return (a >> 16) | (b & 0xffff0000u); }
__device__ __forceinline__ bf16_t f2bf(float x) { return (bf16_t)(pk2(x, 0.f) & 0xffffu); }
__device__ __forceinline__ float sigm(float x) { return __builtin_amdgcn_rcpf(1.f + __expf(-x)); }
__device__ __forceinline__ float silu(float x) { return x * __builtin_amdgcn_rcpf(1.f + __expf(-x)); }
__device__ __forceinline__ float softplus(float x) { return fmaxf(x, 0.f) + log1pf(__expf(-fabsf(x))); }
__device__ __forceinline__ float gelu_tanh(float x) { const float u = 0.7978845608f * (x + 0.044715f * x * x * x); const float t = 1.f - 2.f * __builtin_amdgcn_rcpf(1.f + __expf(2.f * u)); return 0.5f * x * (1.f + t); }
__device__ __forceinline__ float wave_sum(float v) {
#pragma unroll
    for (int o = 1; o < 64; o <<= 1) v += __shfl_xor(v, o);
    return v;
}
__device__ __forceinline__ void unpack8(u32x4 r, float* f) {
    f[0] = bf2f(r.x & 0xffffu); f[1] = __uint_as_float(r.x & 0xffff0000u); f[2] = bf2f(r.y & 0xffffu); f[3] = __uint_as_float(r.y & 0xffff0000u);
    f[4] = bf2f(r.z & 0xffffu); f[5] = __uint_as_float(r.z & 0xffff0000u); f[6] = bf2f(r.w & 0xffffu); f[7] = __uint_as_float(r.w & 0xffff0000u);
}
__device__ __forceinline__ void unpack4(u32x2 r, float* f) {
    f[0] = bf2f(r.x & 0xffffu); f[1] = __uint_as_float(r.x & 0xffff0000u); f[2] = bf2f(r.y & 0xffffu); f[3] = __uint_as_float(r.y & 0xffff0000u);
}
#define LDS_WAIT() asm volatile("s_waitcnt lgkmcnt(0)" ::: "memory")

namespace pg8 {
constexpr int BM = 256, BK = 64, HALF = 128, HTB = HALF * BK * 2, NXCD = 8, WGM = 8;
__device__ __forceinline__ int lds_byte(int r, int c) { const int st = (r >> 4) * 2 + (c >> 5), rr = r & 15, cc = c & 31, ob = rr * 64 + cc * 2; return st * 1024 + (ob ^ (((ob >> 9) & 1) << 5)); }
__device__ __forceinline__ void stage_rc(int b, int& R, int& C) { const int st = b / 1024, sb = b % 1024, swz = sb ^ (((sb >> 9) & 1) << 5); R = (st >> 1) * 16 + swz / 64; C = (st & 1) * 32 + (swz % 64) / 2; }
__device__ __forceinline__ int perm32(int rho) { const int n = rho >> 4, i = rho & 15; return 8 * (i >> 2) + 4 * n + (i & 3); }

struct Unit { int pm, pn, nt, kind, ks; size_t aoff, boff; };
struct Gemm { const char* A; const char* Bt; int lda, ldb; };
struct Order {
    int nMm, nN, n_main, n_tail, ksplit, nt_full, G, c; size_t a_t, b_t, acol;
    __device__ __forceinline__ bool next(int i, Unit& u) const {
        const long L = (long)i * G + c;
        if (L < n_main) {
            const int nwg = n_main;
            int wgid = (int)L; { const int q = nwg / NXCD, r = nwg % NXCD, xcd = wgid % NXCD, off = wgid / NXCD; wgid = (xcd < r ? xcd * (q + 1) : r * (q + 1) + (xcd - r) * q) + off; }
            const int nig = WGM * nN, gid = wgid / nig, fm = gid * WGM, gsz = (nMm - fm) < WGM ? (nMm - fm) : WGM;
            u.pm = fm + ((wgid % nig) % gsz); u.pn = (wgid % nig) / gsz; u.nt = nt_full; u.kind = 0; u.ks = 0;
            u.aoff = (size_t)u.pm * a_t + (size_t)(u.pn >> 1) * acol; u.boff = (size_t)u.pn * b_t; return true;
        }
        const int Lt = (int)(L - n_main); if (Lt >= n_tail) return false;
        const int ks = Lt % ksplit, r = Lt / ksplit;
        u.pm = nMm + (r & 1); u.pn = r >> 1; u.nt = nt_full / ksplit; u.kind = ksplit > 1 ? 1 : 0; u.ks = ks;
        const size_t kofs = (size_t)ks * u.nt * (BK * 2);
        u.aoff = (size_t)u.pm * a_t + (size_t)(u.pn >> 1) * acol + kofs; u.boff = (size_t)u.pn * b_t + kofs; return true;
    }
};

struct EpiScaleBf16 {
    static constexpr bool PERM = true;
    bf16_t* O; int ldc; const float* ss;
    __device__ __forceinline__ void operator()(const f32x4 (&acc)[2][2][4][2], const Unit& u, int wr, int wc, int fr, int fq) const {
        const int row0 = u.pm * BM + wr * 64 + fr, col0 = u.pn * BM + wc * 32 + 8 * fq;
        float ssv[8];
#pragma unroll
        for (int ai = 0; ai < 2; ++ai)
#pragma unroll
            for (int m = 0; m < 4; ++m) ssv[ai * 4 + m] = ss[row0 + ai * HALF + m * 16];
#pragma unroll
        for (int ai = 0; ai < 2; ++ai)
#pragma unroll
            for (int m = 0; m < 4; ++m) {
                const int row = row0 + ai * HALF + m * 16;
                const float rs = rsqrtf(ssv[ai * 4 + m] * (1.0f / 2048.0f) + EPS);
                bf16_t* rowp = O + ((unsigned)row * (unsigned)ldc + (unsigned)col0);
#pragma unroll
                for (int bj = 0; bj < 2; ++bj) {
                    const f32x4 v0 = acc[ai][bj][m][0] * rs, v1 = acc[ai][bj][m][1] * rs;
                    u32x4 w; w.x = pk2(v0[0], v0[1]); w.y = pk2(v0[2], v0[3]); w.z = pk2(v1[0], v1[1]); w.w = pk2(v1[2], v1[3]);
                    *(u32x4*)(rowp + bj * HALF) = w;
                }
            }
    }
};
struct EpiResid {
    static constexpr bool PERM = false;
    float* X; bf16_t* XB; float* ssout; float* part;
    __device__ __forceinline__ void operator()(const f32x4 (&acc)[2][2][4][2], const Unit& u, int wr, int wc, int fr, int fq) const {
        const int row0 = u.pm * BM + wr * 64 + fr, col0 = u.pn * BM + wc * 32 + 4 * fq;
        if (u.kind == 1) {
            float* P = part + (size_t)u.ks * (512 * 2048);
#pragma unroll
            for (int ai = 0; ai < 2; ++ai)
#pragma unroll
                for (int m = 0; m < 4; ++m) {
                    const unsigned off = (unsigned)(row0 - MP + ai * HALF + m * 16) * 2048u + (unsigned)col0;
#pragma unroll
                    for (int bj = 0; bj < 2; ++bj)
#pragma unroll
                        for (int n = 0; n < 2; ++n) *(f32x4*)(P + off + bj * HALF + n * 16) = acc[ai][bj][m][n];
                }
            return;
        }
#pragma unroll
        for (int ai = 0; ai < 2; ++ai)
#pragma unroll
            for (int mp = 0; mp < 4; mp += 2) {
                f32x4 xin[2][2][2];
#pragma unroll
                for (int mm = 0; mm < 2; ++mm)
#pragma unroll
                    for (int bj = 0; bj < 2; ++bj)
#pragma unroll
                        for (int n = 0; n < 2; ++n) xin[mm][bj][n] = *(const f32x4*)(X + ((unsigned)(row0 + ai * HALF + (mp + mm) * 16) * 2048u + (unsigned)col0 + bj * HALF + n * 16));
#pragma unroll
                for (int mm = 0; mm < 2; ++mm) {
                    const int row = row0 + ai * HALF + (mp + mm) * 16;
                    const unsigned off = (unsigned)row * 2048u + (unsigned)col0;
                    float sq = 0.f;
#pragma unroll
                    for (int bj = 0; bj < 2; ++bj)
#pragma unroll
                        for (int n = 0; n < 2; ++n) {
                            const unsigned o = off + bj * HALF + n * 16;
                            const f32x4 x = xin[mm][bj][n] + acc[ai][bj][mp + mm][n];
                            *(f32x4*)(X + o) = x;
                            u32x2 w; w.x = pk2(x[0], x[1]); w.y = pk2(x[2], x[3]);
                            *(u32x2*)(XB + o) = w;
                            sq += (x[0] * x[0] + x[1] * x[1]) + (x[2] * x[2] + x[3] * x[3]);
                        }
                    sq += __shfl_xor(sq, 16); sq += __shfl_xor(sq, 32);
                    if (fq == 0) atomicAdd(ssout + row, sq);
                }
                asm volatile("" ::: "memory");
            }
    }
};
struct EpiLru {
    static constexpr bool PERM = false;
    const float* br; const float* bi; const float* sp; const bf16_t* XR; float* LA; bf16_t* LBv;
    __device__ __forceinline__ void operator()(const f32x4 (&acc)[2][2][4][2], const Unit& u, int wr, int wc, int fr, int fq) const {
        const int row0 = u.pm * BM + wr * 64 + fr;
        const int cbase = (u.pn >> 1) * 256 + (u.pn & 1) * 128 + wc * 32 + 4 * fq;
        f32x4 br4[2], bi4[2], sp4[2];
#pragma unroll
        for (int n = 0; n < 2; ++n) { br4[n] = *(const f32x4*)(br + cbase + n * 16); bi4[n] = *(const f32x4*)(bi + cbase + n * 16); sp4[n] = *(const f32x4*)(sp + cbase + n * 16); }
#pragma unroll
        for (int ai = 0; ai < 2; ++ai)
#pragma unroll
            for (int mp = 0; mp < 4; mp += 2) {
                u32x2 xrr[2][2];
#pragma unroll
                for (int mm = 0; mm < 2; ++mm)
#pragma unroll
                    for (int n = 0; n < 2; ++n) xrr[mm][n] = *(const u32x2*)(XR + ((unsigned)(row0 + ai * HALF + (mp + mm) * 16) * 2048u + (unsigned)(cbase + n * 16)));
#pragma unroll
                for (int mm = 0; mm < 2; ++mm) {
                    const int row = row0 + ai * HALF + (mp + mm) * 16;
                    const bool first = (row < MP) && ((row & 2047) == 0);
#pragma unroll
                    for (int n = 0; n < 2; ++n) {
                        const unsigned o = (unsigned)row * 2048u + (unsigned)(cbase + n * 16);
                        float xr[4]; unpack4(xrr[mm][n], xr);
                        f32x4 av; float bb[4];
#pragma unroll
                        for (int j = 0; j < 4; ++j) {
                            const float r = sigm(acc[ai][0][mp + mm][n][j] + br4[n][j]), gi = sigm(acc[ai][1][mp + mm][n][j] + bi4[n][j]);
                            const float la = -8.0f * r * sp4[n][j];
                            const float a = __expf(la);
                            const float mult = first ? 1.0f : __builtin_amdgcn_sqrtf(fmaxf(1.0f - a * a, 0.f));
                            av[j] = a; bb[j] = mult * gi * xr[j];
                        }
                        *(f32x4*)(LA + o) = av;
                        u32x2 w; w.x = pk2(bb[0], bb[1]); w.y = pk2(bb[2], bb[3]);
                        *(u32x2*)(LBv + o) = w;
                    }
                }
                asm volatile("" ::: "memory");
            }
    }
};

template <class Epi>
__device__ __forceinline__ void gemm_phase(LAS unsigned char* lds, const Gemm g, const Order& S, const Epi& E) {
    int tid = threadIdx.x; asm volatile("" : "+v"(tid));
    const int wid = __builtin_amdgcn_readfirstlane(tid >> 6), lane = tid & 63, wr = wid >> 2, wc = wid & 3, fr = lane & 15, fq = lane >> 4;
    unsigned voffA[2], voffB[2];
#pragma unroll
    for (int i = 0; i < 2; ++i) { int R, C; stage_rc(tid * 16 + i * 8192, R, C); const int Rb = Epi::PERM ? ((R & ~31) + perm32(R & 31)) : R;
        voffA[i] = (unsigned)(R * g.lda + C) * 2u; voffB[i] = (unsigned)(Rb * g.ldb + C) * 2u; }
    const size_t kstep = (size_t)(BK * 2);
    const size_t hstepA = (size_t)HALF * g.lda * 2, hstepB = (size_t)HALF * g.ldb * 2;
    const unsigned ldsw = (unsigned)wid * 1024u;
    const int aoff = lds_byte(wr * 64 + fr, fq * 8), boff = lds_byte(wc * 32 + fr, fq * 8);
#define PG8_SA(b, h) (((b) * 2 + (h)) * HTB)
#define PG8_SB(b, h) ((4 + (b) * 2 + (h)) * HTB)
#define PG8_STAGE(bufoff, gbase, voff) do { _Pragma("unroll") for (int _i = 0; _i < 2; ++_i) \
        __builtin_amdgcn_global_load_lds((const unsigned*)((const char*)(gbase) + (voff)[_i]), (LAS unsigned*)(lds + (bufoff) + ldsw + _i * 8192), 16, 0, 0); } while (0)
#define PG8_LDA(dst, b, h) do { _Pragma("unroll") for (int m = 0; m < 4; ++m) _Pragma("unroll") for (int k = 0; k < 2; ++k) dst[m][k] = *(const LAS bf16x8*)(lds + PG8_SA(b, h) + aoff + m * 2048 + k * 1024); } while (0)
#define PG8_LDB(dst, b, h) do { _Pragma("unroll") for (int n = 0; n < 2; ++n) _Pragma("unroll") for (int k = 0; k < 2; ++k) dst[n][k] = *(const LAS bf16x8*)(lds + PG8_SB(b, h) + boff + n * 2048 + k * 1024); } while (0)
#define PG8_MMA(ai, bj, At, Bt) do { __builtin_amdgcn_s_setprio(1); _Pragma("unroll") for (int m = 0; m < 4; ++m) _Pragma("unroll") for (int n = 0; n < 2; ++n) _Pragma("unroll") for (int k = 0; k < 2; ++k) \
        acc[ai][bj][m][n] = __builtin_amdgcn_mfma_f32_16x16x32_bf16(Bt[n][k], At[m][k], acc[ai][bj][m][n], 0, 0, 0); __builtin_amdgcn_s_setprio(0); } while (0)
#define PG8_WAIT_V(n) asm volatile("s_waitcnt vmcnt(" #n ")" ::: "memory")
#define PG8_WAIT_L(n) asm volatile("s_waitcnt lgkmcnt(" #n ")" ::: "memory")
#define PG8_BAR __builtin_amdgcn_s_barrier()
#define PG8_SCHED __builtin_amdgcn_sched_barrier(0)
    Unit cur, nxt; int ui = 0;
    if (!S.next(0, cur)) return;
    f32x4 acc[2][2][4][2];
#pragma unroll
    for (int a = 0; a < 2; ++a)
#pragma unroll
        for (int b = 0; b < 2; ++b)
#pragma unroll
            for (int m = 0; m < 4; ++m)
#pragma unroll
                for (int n = 0; n < 2; ++n) acc[a][b][m][n] = (f32x4){0.f, 0.f, 0.f, 0.f};
    bf16x8 At[4][2], B0[2][2], B1[2][2];
    const char* cA = g.A + cur.aoff; const char* cB = g.Bt + cur.boff;
    PG8_STAGE(PG8_SB(0, 0), cB, voffB); PG8_STAGE(PG8_SA(0, 0), cA, voffA); PG8_STAGE(PG8_SB(0, 1), cB + hstepB, voffB); PG8_STAGE(PG8_SA(0, 1), cA + hstepA, voffA);
    if (wr == 1) PG8_BAR;
    PG8_WAIT_V(4); PG8_BAR;
    PG8_STAGE(PG8_SB(1, 0), cB + kstep, voffB); PG8_STAGE(PG8_SA(1, 0), cA + kstep, voffA); PG8_STAGE(PG8_SB(1, 1), cB + hstepB + kstep, voffB);
    PG8_WAIT_V(6); PG8_BAR;
    for (;;) {
        const bool has_next = S.next(ui + 1, nxt);
        const char* nA = has_next ? g.A + nxt.aoff : cA; const char* nB = has_next ? g.Bt + nxt.boff : cB;
        const int nt = cur.nt;
        for (int t = 0; t < nt; t += 2) {
            const bool last = (t == nt - 2);
            const char* a1 = cA + (size_t)(t + 1) * kstep;
            const char* a2 = last ? nA : cA + (size_t)(t + 2) * kstep; const char* b2 = last ? nB : cB + (size_t)(t + 2) * kstep;
            const char* a3 = a2 + kstep; const char* b3 = b2 + kstep;
            PG8_LDB(B0, 0, 0); PG8_SCHED; PG8_LDA(At, 0, 0); PG8_STAGE(PG8_SA(1, 1), a1 + hstepA, voffA);
            PG8_WAIT_L(8); PG8_BAR; PG8_WAIT_L(0); PG8_MMA(0, 0, At, B0); PG8_BAR; PG8_SCHED;
            PG8_LDB(B1, 0, 1); PG8_STAGE(PG8_SB(0, 0), b2, voffB);
            PG8_BAR; PG8_WAIT_L(0); PG8_MMA(0, 1, At, B1); PG8_BAR;
            PG8_LDA(At, 0, 1); PG8_STAGE(PG8_SA(0, 0), a2, voffA);
            PG8_BAR; PG8_WAIT_L(0); PG8_MMA(1, 0, At, B0); PG8_BAR; PG8_SCHED;
            PG8_STAGE(PG8_SB(0, 1), b2 + hstepB, voffB);
            PG8_WAIT_V(6); PG8_BAR; PG8_MMA(1, 1, At, B1); PG8_BAR;
            PG8_LDB(B0, 1, 0); PG8_SCHED; PG8_LDA(At, 1, 0); PG8_STAGE(PG8_SA(0, 1), a2 + hstepA, voffA);
            PG8_WAIT_L(8); PG8_BAR; PG8_WAIT_L(0); PG8_MMA(0, 0, At, B0); PG8_BAR; PG8_SCHED;
            PG8_LDB(B1, 1, 1); PG8_STAGE(PG8_SB(1, 0), b3, voffB);
            PG8_BAR; PG8_WAIT_L(0); PG8_MMA(0, 1, At, B1); PG8_BAR;
            PG8_LDA(At, 1, 1); PG8_STAGE(PG8_SA(1, 0), a3, voffA);
            PG8_BAR; PG8_WAIT_L(0); PG8_MMA(1, 0, At, B0); PG8_BAR; PG8_SCHED;
            PG8_STAGE(PG8_SB(1, 1), b3 + hstepB, voffB);
            PG8_WAIT_V(6); PG8_BAR; PG8_MMA(1, 1, At, B1); PG8_BAR;
        }
        E(acc, cur, wr, wc, fr, fq);
        if (!has_next) break;
#pragma unroll
        for (int a = 0; a < 2; ++a)
#pragma unroll
            for (int b = 0; b < 2; ++b)
#pragma unroll
                for (int m = 0; m < 4; ++m)
#pragma unroll
                    for (int n = 0; n < 2; ++n) acc[a][b][m][n] = (f32x4){0.f, 0.f, 0.f, 0.f};
        cur = nxt; cA = nA; cB = nB; ++ui;
    }
    PG8_WAIT_V(0);
    if (wr == 0) PG8_BAR;
    PG8_BAR;
#undef PG8_SA
#undef PG8_SB
#undef PG8_STAGE
#undef PG8_LDA
#undef PG8_LDB
#undef PG8_MMA
#undef PG8_WAIT_V
#undef PG8_WAIT_L
#undef PG8_BAR
#undef PG8_SCHED
}
}

__device__ __forceinline__ void tr_item(const float* __restrict__ W, int ldw, int N, int k0, int n0, const float* __restrict__ scale, bf16_t* __restrict__ dst, int ldd, float* scr, int lane) {
    const int r4 = lane >> 4, c4 = (lane & 15) * 4;
    const bool inb = (n0 + c4) < N;
    f32x4 v[16];
#pragma unroll
    for (int i = 0; i < 16; ++i) v[i] = inb ? *(const f32x4*)(W + (size_t)(k0 + 4 * i + r4) * ldw + n0 + c4) : (f32x4){0.f, 0.f, 0.f, 0.f};
#pragma unroll
    for (int i = 0; i < 16; ++i) { float* d = scr + (4 * i + r4) * 65 + c4; d[0] = v[i][0]; d[1] = v[i][1]; d[2] = v[i][2]; d[3] = v[i][3]; }
    LDS_WAIT();
    const int c = lane & 7;
    f32x4 s0 = (f32x4){1.f, 1.f, 1.f, 1.f}, s1 = s0;
    if (scale) { s0 = *(const f32x4*)(scale + k0 + 8 * c); s1 = *(const f32x4*)(scale + k0 + 8 * c + 4); }
#pragma unroll
    for (int j = 0; j < 8; ++j) { const int n = (lane >> 3) + 8 * j; const float* sp = scr + (8 * c) * 65 + n;
        u32x4 o; o.x = pk2(sp[0 * 65] * s0[0], sp[1 * 65] * s0[1]); o.y = pk2(sp[2 * 65] * s0[2], sp[3 * 65] * s0[3]); o.z = pk2(sp[4 * 65] * s1[0], sp[5 * 65] * s1[1]); o.w = pk2(sp[6 * 65] * s1[2], sp[7 * 65] * s1[3]);
        *(u32x4*)(dst + (size_t)n * ldd + 8 * c) = o; }
    LDS_WAIT();
}

__device__ __forceinline__ void phase_prologue(const Params& p, float* ldsf) {
    int tid = threadIdx.x; asm volatile("" : "+v"(tid));
    const int wave = tid >> 6, lane = tid & 63;
    const int gw = blockIdx.x * 8 + wave, NGW = gridDim.x * 8;
    float* scr = ldsf + wave * 4160;
    unsigned char* ws = p.ws;
    constexpr int I0 = 32 * 177, I1 = 64 * 32, I2 = 32 * 176, I3 = 88 * 32, I4 = 32 * 192, I5 = I1, I6 = I2, I7 = I3, I8 = 128, I9 = 128;
    constexpr int NIT = I0 + I1 + I2 + I3 + I4 + I5 + I6 + I7 + I8 + I9;
    for (int it = gw; it < NIT; it += NGW) {
        int r = it;
        const float* W; int K, N; const float* sc = nullptr; bf16_t* WT;
        if (r < I0) { W = p.in[12 + p.z]; K = 2048; N = 11296; sc = p.in[9 + p.z]; WT = (bf16_t*)(ws + WS_WIN0); }
        else if ((r -= I0) < I1) { W = p.in[19 + p.z]; K = 4096; N = 2048; WT = (bf16_t*)(ws + WS_WOUT0); }
        else if ((r -= I1) < I2) { W = p.in[31 + p.z]; K = 2048; N = 11264; sc = p.in[10 + p.z]; WT = (bf16_t*)(ws + WS_WUP0); }
        else if ((r -= I2) < I3) { W = p.in[34 + p.z]; K = 5632; N = 2048; WT = (bf16_t*)(ws + WS_WDN0); }
        else if ((r -= I3) < I4) { W = p.in[20 + p.z]; K = 2048; N = 12288; sc = p.in[9 + p.z] + 2048; WT = (bf16_t*)(ws + WS_WIN1); }
        else if ((r -= I4) < I5) { W = p.in[30 + p.z]; K = 4096; N = 2048; WT = (bf16_t*)(ws + WS_WOUT1); }
        else if ((r -= I5) < I6) { W = p.in[31 + p.z] + (size_t)2048 * 11264; K = 2048; N = 11264; sc = p.in[10 + p.z] + 2048; WT = (bf16_t*)(ws + WS_WUP1); }
        else if ((r -= I6) < I7) { W = p.in[34 + p.z] + (size_t)5632 * 2048; K = 5632; N = 2048; WT = (bf16_t*)(ws + WS_WDN1); }
        else {
            r -= I7; const int which = r >> 7; r &= 127;
            const int blk = r >> 4, kb = (r >> 2) & 3, nb = r & 3, n0 = 64 * nb, k0 = 64 * kb;
            const float* Wl = (which ? p.in[27 + p.z] : p.in[25 + p.z]) + (size_t)blk * 65536;
            const int drow = (blk * 2 + (n0 >> 7)) * 256 + which * 128 + (n0 & 127);
            tr_item(Wl, 256, 256, k0, n0, nullptr, (bf16_t*)(ws + WS_WLRU) + (size_t)drow * 256 + k0, 256, scr, lane);
            continue;
        }
        const int nblk = (N + 63) / 64, kbl = r & 7, r8 = r >> 3, nb = r8 % nblk, kb = (r8 / nblk) * 8 + kbl, k0 = 64 * kb, n0 = 64 * nb;
        tr_item(W, N, N, k0, n0, sc, WT + (size_t)n0 * K + k0, K, scr, lane);
    }
    {
        u32x4* z = (u32x4*)((bf16_t*)(ws + WS_WIN0) + (size_t)11296 * 2048);
        const int n16 = 224 * 2048 * 2 / 16;
        for (int i = blockIdx.x * 512 + tid; i < n16; i += gridDim.x * 512) z[i] = (u32x4){0u, 0u, 0u, 0u};
    }
    float* X = (float*)(ws + WS_X); bf16_t* XB = (bf16_t*)(ws + WS_XB); float* ss = (float*)(ws + WS_SS);
    for (int row = gw; row < MT; row += NGW) {
        const float* src = row < MP ? p.in[0 + p.z] + (size_t)row * 2048 : p.in[1 + p.z] + (size_t)(row - MP) * 2048;
        float s = 0.f;
#pragma unroll
        for (int j = 0; j < 8; ++j) {
            const f32x4 v = *(const f32x4*)(src + (lane + 64 * j) * 4);
            *(f32x4*)(X + (size_t)row * 2048 + (lane + 64 * j) * 4) = v;
            u32x2 w; w.x = pk2(v[0], v[1]); w.y = pk2(v[2], v[3]);
            *(u32x2*)(XB + (size_t)row * 2048 + (lane + 64 * j) * 4) = w;
            s += (v[0] * v[0] + v[1] * v[1]) + (v[2] * v[2] + v[3] * v[3]);
        }
        s = wave_sum(s);
        if (lane == 0) ss[row] = s;
    }
    for (int i = blockIdx.x * 512 + tid; i < 4 * MT; i += gridDim.x * 512) ss[MT + i] = 0.f;
    for (int i = blockIdx.x * 512 + tid; i < 2048; i += gridDim.x * 512) {
        ((float*)(ws + WS_SP))[i] = softplus(-p.in[29 + p.z][i]);
        ((float*)(ws + WS_LB))[i] = sigm(p.in[21 + p.z][2048 + i] - p.in[21 + p.z][i]);
    }
}

__device__ __forceinline__ int next_item(unsigned* ctr, float* ldsf) {
    __syncthreads();
    if (threadIdx.x == 0) ((volatile unsigned*)ldsf)[24576] = atomicAdd(ctr, 1u);
    __syncthreads();
    return (int)((volatile unsigned*)ldsf)[24576];
}

template <int TYPE, int VW>
__device__ __forceinline__ void rec_item(const Params& p, float* ldsf, int sample, int b, int h, int s) {
    constexpr int NV = VW / 16;
    typedef float VT __attribute__((ext_vector_type(NV)));
    int tid = threadIdx.x; asm volatile("" : "+v"(tid));
    const int w = tid >> 6, lane = tid & 63, kg = lane >> 4, vq = lane & 15, kb = 16 * w + 4 * kg;
    const int L = sample ? 4 : 2048, row0 = sample ? MP + 4 * b : 2048 * b, pos0 = sample ? 16384 : 0;
    constexpr int LDP = TYPE < 2 ? LD0 : LD1;
    const bf16_t* proj = (const bf16_t*)(p.ws + WS_PROJ) + (size_t)row0 * LDP;
    bf16_t* yz = (bf16_t*)(p.ws + WS_YZ) + (size_t)row0 * 4096;
    float* part = ldsf + 8192;
    int colA = -1, colB = -1, role = -1, didx = 0;
    float w0 = 0.f, w1 = 0.f, w2 = 0.f, w3 = 0.f, cbias = 0.f, c0 = 0.f, c1 = 0.f, c2 = 0.f, aux = 0.f, aux2 = 0.f;
    if constexpr (TYPE == 0) {
        if (tid < 320) {
            role = tid < 128 ? 0 : (tid < 256 ? 1 : 2);
            didx = tid < 128 ? tid : (tid < 256 ? tid - 128 : tid - 256);
            const int ch = tid < 128 ? 2560 + (h >> 3) * 128 + tid : (tid < 256 ? 2048 + (h >> 3) * 128 + (tid - 128) : h * 64 + (tid - 256));
            colA = 2048 + ch;
            const float* cw = p.in[13 + p.z];
            w0 = cw[ch]; w1 = cw[3072 + ch]; w2 = cw[2 * 3072 + ch]; w3 = cw[3 * 3072 + ch]; cbias = p.in[14 + p.z][ch];
            if (sample) { const float* st = p.in[3 + p.z] + (size_t)b * 3 * 3072; c0 = st[ch]; c1 = st[3072 + ch]; c2 = st[2 * 3072 + ch]; }
        } else if (tid < 328) { role = 3; didx = tid - 320; colA = 5120 + h; aux = p.in[15 + p.z][h]; aux2 = -__expf(p.in[16 + p.z][h]); }
    } else if constexpr (TYPE == 1) {
        if (tid < 128) { role = tid < 64 ? 0 : 1; didx = tid & 63; colA = (tid < 64 ? 5152 : 6176) + h * 128 + didx; colB = colA + 64;
            aux = exp2f(-(float)didx * 0.20762050593046014f); }
        else if (tid < 128 + VW) { role = 2; didx = tid - 128; colA = 7200 + h * 256 + s * VW + didx; }
    } else {
        if (tid < 128) { role = 0; didx = tid; colA = h * 128 + tid; }
        else if (tid < 256) { role = 1; didx = tid - 128; colA = 2048 + h * 128 + didx; aux = ((const float*)(p.ws + WS_LB))[h * 128 + didx]; }
        else if (tid < 256 + VW) { role = 2; didx = tid - 256; colA = 4096 + h * 128 + s * VW + didx; }
    }
    const float Dh = TYPE == 0 ? p.in[17 + p.z][h] : 0.f;
    const float gamma = TYPE == 1 ? 1.0f - exp2f(-5.0f - (float)h * (4.0f / 7.0f)) : 0.f;
    const int ldS = TYPE == 0 ? 64 : (TYPE == 1 ? 256 : 128);
    size_t soff;
    if constexpr (TYPE == 0) soff = ((size_t)(b * 32 + h) * 128) * 64;
    else if constexpr (TYPE == 1) soff = ((size_t)(b * 8 + h) * 128) * 256 + s * VW;
    else soff = ((size_t)(b * 16 + h) * 128) * 128 + s * VW;
    const float* S0 = TYPE == 0 ? p.in[2 + p.z] : (TYPE == 1 ? p.in[4 + p.z] : p.in[5 + p.z]);
    float* Sout = p.out + (TYPE == 0 ? (sample ? O_SSMS : O_SSMP) : (TYPE == 1 ? (sample ? O_RETS : O_RETP) : (sample ? O_HGS : O_HGP))) + soff;
    VT S[4];
#pragma unroll
    for (int i = 0; i < 4; ++i) { if (sample) S[i] = *(const VT*)(S0 + soff + (size_t)(kb + i) * ldS + NV * vq); else S[i] = (VT)(0.f); }
    unsigned short ra[8], rb[8]; unsigned short zr = 0;
    const int R = (L + 7) >> 3;
    auto load_raw = [&](int r) {
#pragma unroll
        for (int t = 0; t < 8; ++t) {
            const int tt = 8 * r + t;
            ra[t] = 0; rb[t] = 0;
            if (tt < L) {
                if (colA >= 0) ra[t] = proj[(size_t)tt * LDP + colA];
                if (TYPE == 1 && colB >= 0) rb[t] = proj[(size_t)tt * LDP + colB];
            }
        }
        if (TYPE == 0) { const int tt = 8 * r + w; if (tt < L) zr = proj[(size_t)tt * LDP + h * 64 + lane]; }
    };
    load_raw(0);
    for (int r = 0; r < R; ++r) {
        const int nv = (L - 8 * r) < 8 ? (L - 8 * r) : 8;
        float* stg = ldsf + (r & 1) * 4096;
        float* qs = stg; float* ks = stg + 1024; float* as = stg + 2048; float* vs = stg + 3072; float* ad = stg + 3584;
        if constexpr (TYPE == 0) {
            if (role >= 0 && role < 3) {
                float* dst = role == 0 ? qs : (role == 1 ? ks : vs); const int dstr = role == 2 ? 64 : 128;
#pragma unroll
                for (int t = 0; t < 8; ++t) {
                    const float x = bf2f(ra[t]);
                    const float y = cbias + w0 * c0 + w1 * c1 + w2 * c2 + w3 * x;
                    c0 = c1; c1 = c2; c2 = x;
                    dst[t * dstr + didx] = silu(y);
                }
            } else if (role == 3) {
                float xv = 0.f;
#pragma unroll
                for (int t = 0; t < 8; ++t) if (t == didx) xv = bf2f(ra[t]);
                const float dt = softplus(xv + aux);
                ad[2 * didx] = __expf(dt * aux2); ad[2 * didx + 1] = dt;
            }
        } else if constexpr (TYPE == 1) {
            if (role == 0 || role == 1) {
                float* dst = role == 0 ? qs : ks; const float sc = role == 0 ? 1.0f : 0.08838834764831845f;
#pragma unroll
                for (int t = 0; t < 8; ++t) {
                    const int pos = pos0 + 8 * r + t;
                    const double rev = (double)pos * (double)aux * 0.15915494309189535;
                    const float fr = (float)(rev - floor(rev));
                    const float sn = __builtin_amdgcn_sinf(fr), cs = __builtin_amdgcn_cosf(fr);
                    const float x1 = bf2f(ra[t]) * sc, x2 = bf2f(rb[t]) * sc;
                    dst[t * 128 + didx] = x1 * cs - x2 * sn;
                    dst[t * 128 + 64 + didx] = x1 * sn + x2 * cs;
                }
            } else if (role == 2) {
#pragma unroll
                for (int t = 0; t < 8; ++t) vs[t * VW + didx] = bf2f(ra[t]);
            }
        } else {
            if (role == 0) {
#pragma unroll
                for (int t = 0; t < 8; ++t) qs[t * 128 + didx] = silu(bf2f(ra[t]));
            } else if (role == 1) {
#pragma unroll
                for (int t = 0; t < 8; ++t) { const float f = aux + (1.0f - aux) * sigm(bf2f(ra[t])); as[t * 128 + didx] = f; ks[t * 128 + didx] = 1.0f - f; }
            } else if (role == 2) {
#pragma unroll
                for (int t = 0; t < 8; ++t) vs[t * VW + didx] = bf2f(ra[t]);
            }
        }
        const unsigned short zc = zr;
        __syncthreads();
        if (r + 1 < R) load_raw(r + 1);
        for (int t0 = 0; t0 < nv; t0 += 4) {
#pragma unroll
            for (int tt = 0; tt < 4; ++tt) {
                const int t = t0 + tt;
                const f32x4 q4 = *(const f32x4*)(qs + t * 128 + kb);
                f32x4 k4 = *(const f32x4*)(ks + t * 128 + kb);
                const VT v4 = *(const VT*)(vs + t * VW + NV * vq);
                f32x4 a4;
                if constexpr (TYPE == 0) { const f32x2 adv = *(const f32x2*)(ad + 2 * t); a4 = (f32x4){adv.x, adv.x, adv.x, adv.x}; k4 = k4 * adv.y; }
                else if constexpr (TYPE == 1) a4 = (f32x4){gamma, gamma, gamma, gamma};
                else a4 = *(const f32x4*)(as + t * 128 + kb);
                VT o = (VT)(0.f);
#pragma unroll
                for (int i = 0; i < 4; ++i) { S[i] = a4[i] * S[i] + k4[i] * v4; o += q4[i] * S[i]; }
                *(VT*)(part + ((t * 32 + w * 4 + kg) * VW + NV * vq)) = o;
            }
        }
        __syncthreads();
        const int rt = tid / VW, rv = tid % VW;
        if (tid < 8 * VW && rt < nv) {
            float o = 0.f;
#pragma unroll
            for (int pp = 0; pp < 32; ++pp) o += part[(rt * 32 + pp) * VW + rv];
            const size_t trow = (size_t)(8 * r + rt);
            if constexpr (TYPE == 0) {
                const float y = (o + Dh * vs[rt * 64 + rv]) * silu(bf2f(zc));
                yz[trow * 4096 + h * 64 + rv] = f2bf(y);
            } else if constexpr (TYPE == 1) {
                yz[trow * 4096 + 2048 + h * 256 + s * VW + rv] = f2bf(o);
            } else {
                yz[trow * 4096 + h * 128 + s * VW + rv] = f2bf(o);
            }
        }
    }
#pragma unroll
    for (int i = 0; i < 4; ++i) *(VT*)(Sout + (size_t)(kb + i) * ldS + NV * vq) = S[i];
}

template <int TYPE>
__device__ __forceinline__ void dec_unit(const Params& p, float* ldsf, int b, int u) {
    int tid = threadIdx.x; asm volatile("" : "+v"(tid));
    const int w = tid >> 6, lane = tid & 63, kg = lane >> 4, vq = lane & 15;
    const int row0 = MP + 4 * b;
    constexpr int LDP = TYPE < 2 ? LD0 : LD1;
    const bf16_t* proj = (const bf16_t*)(p.ws + WS_PROJ) + (size_t)row0 * LDP;
    bf16_t* yz = (bf16_t*)(p.ws + WS_YZ) + (size_t)row0 * 4096;
    int h, sl; size_t soff; int ldS;
    if constexpr (TYPE == 0) { h = 8 * u + w; sl = 0; ldS = 64; soff = ((size_t)(b * 32 + h) * 128) * 64; }
    else if constexpr (TYPE == 1) { h = 2 * u + (w >> 2); sl = w & 3; ldS = 256; soff = ((size_t)(b * 8 + h) * 128) * 256 + sl * 64; }
    else { h = 4 * u + (w >> 1); sl = w & 1; ldS = 128; soff = ((size_t)(b * 16 + h) * 128) * 128 + sl * 64; }
    const float* S0 = (TYPE == 0 ? p.in[2 + p.z] : (TYPE == 1 ? p.in[4 + p.z] : p.in[5 + p.z])) + soff + (size_t)(32 * kg) * ldS + 4 * vq;
    float* Sout = p.out + (TYPE == 0 ? O_SSMS : (TYPE == 1 ? O_RETS : O_HGS)) + soff + (size_t)(32 * kg) * ldS + 4 * vq;
    if constexpr (TYPE == 0) {
        float* qs = ldsf; float* ks = ldsf + 512; float* xs = ldsf + 1024; float* zs = ldsf + 3072; float* ad = ldsf + 5120;
        unsigned short xr[2][4]; float cw[2][4], cb[2], st[2][3]; unsigned short zr[4]; unsigned short dr = 0;
#pragma unroll
        for (int q = 0; q < 2; ++q) {
            const int idx = tid + 512 * q;
            if (idx < 768) {
                const int ch = idx < 128 ? 2560 + u * 128 + idx : (idx < 256 ? 2048 + u * 128 + (idx - 128) : u * 512 + (idx - 256));
#pragma unroll
                for (int t = 0; t < 4; ++t) xr[q][t] = proj[(size_t)t * LDP + 2048 + ch];
#pragma unroll
                for (int j = 0; j < 4; ++j) cw[q][j] = p.in[13 + p.z][j * 3072 + ch];
                cb[q] = p.in[14 + p.z][ch];
#pragma unroll
                for (int j = 0; j < 3; ++j) st[q][j] = p.in[3 + p.z][((size_t)b * 3 + j) * 3072 + ch];
            }
        }
#pragma unroll
        for (int t = 0; t < 4; ++t) zr[t] = proj[(size_t)t * LDP + u * 512 + tid];
        if (tid < 32) dr = proj[(size_t)(tid >> 3) * LDP + 5120 + 8 * u + (tid & 7)];
        f32x4 S[32];
#pragma unroll
        for (int i = 0; i < 32; ++i) S[i] = *(const f32x4*)(S0 + (size_t)i * ldS);
#pragma unroll
        for (int q = 0; q < 2; ++q) {
            const int idx = tid + 512 * q;
            if (idx < 768) {
                float* dst = idx < 128 ? qs + idx : (idx < 256 ? ks + (idx - 128) : xs + (idx - 256));
                const int dstr = idx < 256 ? 128 : 512;
                float c0 = st[q][0], c1 = st[q][1], c2 = st[q][2];
#pragma unroll
                for (int t = 0; t < 4; ++t) {
                    const float x = bf2f(xr[q][t]);
                    const float y = cb[q] + cw[q][0] * c0 + cw[q][1] * c1 + cw[q][2] * c2 + cw[q][3] * x;
                    c0 = c1; c1 = c2; c2 = x;
                    dst[t * dstr] = silu(y);
                }
            }
        }
#pragma unroll
        for (int t = 0; t < 4; ++t) zs[t * 512 + tid] = silu(bf2f(zr[t]));
        if (tid < 32) {
            const int hh = 8 * u + (tid & 7);
            const float dt = softplus(bf2f(dr) + p.in[15 + p.z][hh]);
            ad[2 * tid] = __expf(-dt * __expf(p.in[16 + p.z][hh])); ad[2 * tid + 1] = dt;
        }
        __syncthreads();
        const float Dh = p.in[17 + p.z][h];
#pragma unroll 1
        for (int t = 0; t < 4; ++t) {
            const f32x2 adv = *(const f32x2*)(ad + 2 * (t * 8 + w));
            const f32x4 v4 = *(const f32x4*)(xs + t * 512 + w * 64 + 4 * vq);
            f32x4 o = (f32x4){0.f, 0.f, 0.f, 0.f};
#pragma unroll
            for (int i4 = 0; i4 < 8; ++i4) {
                const f32x4 q4 = *(const f32x4*)(qs + t * 128 + 32 * kg + 4 * i4);
                const f32x4 k4 = *(const f32x4*)(ks + t * 128 + 32 * kg + 4 * i4) * adv.y;
#pragma unroll
                for (int ii = 0; ii < 4; ++ii) { S[4 * i4 + ii] = adv.x * S[4 * i4 + ii] + k4[ii] * v4; o += q4[ii] * S[4 * i4 + ii]; }
            }
#pragma unroll
            for (int j = 0; j < 4; ++j) { o[j] += __shfl_xor(o[j], 16); o[j] += __shfl_xor(o[j], 32); }
            if (kg == 0) {
                const f32x4 z4 = *(const f32x4*)(zs + t * 512 + w * 64 + 4 * vq);
                const f32x4 y = (o + Dh * v4) * z4;
                u32x2 ov; ov.x = pk2(y[0], y[1]); ov.y = pk2(y[2], y[3]);
                *(u32x2*)(yz + (size_t)t * 4096 + h * 64 + 4 * vq) = ov;
            }
        }
#pragma unroll
        for (int i = 0; i < 32; ++i) *(f32x4*)(Sout + (size_t)i * ldS) = S[i];
    } else if constexpr (TYPE == 1) {
        float* qs = ldsf; float* ks = ldsf + 1024; float* vs = ldsf + 2048;
        unsigned short x1[4], x2[4], vr[4];
        const int hl = tid >> 7, isk = (tid >> 6) & 1, jf = tid & 63;
        if (tid < 256) {
            const int col = (isk ? 6176 : 5152) + (2 * u + hl) * 128 + jf;
#pragma unroll
            for (int t = 0; t < 4; ++t) { x1[t] = proj[(size_t)t * LDP + col]; x2[t] = proj[(size_t)t * LDP + col + 64]; }
        }
#pragma unroll
        for (int t = 0; t < 4; ++t) vr[t] = proj[(size_t)t * LDP + 7200 + (2 * u + (tid >> 8)) * 256 + (tid & 255)];
        f32x4 S[32];
#pragma unroll
        for (int i = 0; i < 32; ++i) S[i] = *(const f32x4*)(S0 + (size_t)i * ldS);
        if (tid < 256) {
            const float inv = exp2f(-(float)jf * 0.20762050593046014f);
            float* dst = isk ? ks : qs; const float sc = isk ? 0.08838834764831845f : 1.0f;
#pragma unroll
            for (int t = 0; t < 4; ++t) {
                const double rev = (double)(16384 + t) * (double)inv * 0.15915494309189535;
                const float fr = (float)(rev - floor(rev));
                const float sn = __builtin_amdgcn_sinf(fr), cs = __builtin_amdgcn_cosf(fr);
                const float a1 = bf2f(x1[t]) * sc, a2 = bf2f(x2[t]) * sc;
                dst[(t * 2 + hl) * 128 + jf] = a1 * cs - a2 * sn;
                dst[(t * 2 + hl) * 128 + 64 + jf] = a1 * sn + a2 * cs;
            }
        }
#pragma unroll
        for (int t = 0; t < 4; ++t) vs[(t * 2 + (tid >> 8)) * 256 + (tid & 255)] = bf2f(vr[t]);
        __syncthreads();
        const float gamma = 1.0f - exp2f(-5.0f - (float)h * (4.0f / 7.0f));
        const int hw = w >> 2;
#pragma unroll 1
        for (int t = 0; t < 4; ++t) {
            const f32x4 v4 = *(const f32x4*)(vs + (t * 2 + hw) * 256 + sl * 64 + 4 * vq);
            f32x4 o = (f32x4){0.f, 0.f, 0.f, 0.f};
#pragma unroll
            for (int i4 = 0; i4 < 8; ++i4) {
                const f32x4 q4 = *(const f32x4*)(qs + (t * 2 + hw) * 128 + 32 * kg + 4 * i4);
                const f32x4 k4 = *(const f32x4*)(ks + (t * 2 + hw) * 128 + 32 * kg + 4 * i4);
#pragma unroll
                for (int ii = 0; ii < 4; ++ii) { S[4 * i4 + ii] = gamma * S[4 * i4 + ii] + k4[ii] * v4; o += q4[ii] * S[4 * i4 + ii]; }
            }
#pragma unroll
            for (int j = 0; j < 4; ++j) { o[j] += __shfl_xor(o[j], 16); o[j] += __shfl_xor(o[j], 32); }
            if (kg == 0) {
                u32x2 ov; ov.x = pk2(o[0], o[1]); ov.y = pk2(o[2], o[3]);
                *(u32x2*)(yz + (size_t)t * 4096 + 2048 + h * 256 + sl * 64 + 4 * vq) = ov;
            }
        }
#pragma unroll
        for (int i = 0; i < 32; ++i) *(f32x4*)(Sout + (size_t)i * ldS) = S[i];
    } else {
        float* qs = ldsf; float* ks = ldsf + 2048; float* as = ldsf + 4096; float* vs = ldsf + 6144;
        unsigned short qr[4], fr_[4], vr[4];
        const int hl = tid >> 7, kk = tid & 127, col = (4 * u + hl) * 128 + kk;
#pragma unroll
        for (int t = 0; t < 4; ++t) { qr[t] = proj[(size_t)t * LDP + col]; fr_[t] = proj[(size_t)t * LDP + 2048 + col]; vr[t] = proj[(size_t)t * LDP + 4096 + col]; }
        const float lb = ((const float*)(p.ws + WS_LB))[col];
        f32x4 S[32];
#pragma unroll
        for (int i = 0; i < 32; ++i) S[i] = *(const f32x4*)(S0 + (size_t)i * ldS);
#pragma unroll
        for (int t = 0; t < 4; ++t) {
            const int o = (t * 4 + hl) * 128 + kk;
            qs[o] = silu(bf2f(qr[t]));
            const float f = lb + (1.0f - lb) * sigm(bf2f(fr_[t]));
            as[o] = f; ks[o] = 1.0f - f; vs[o] = bf2f(vr[t]);
        }
        __syncthreads();
        const int hw = w >> 1;
#pragma unroll 1
        for (int t = 0; t < 4; ++t) {
            const f32x4 v4 = *(const f32x4*)(vs + (t * 4 + hw) * 128 + sl * 64 + 4 * vq);
            f32x4 o = (f32x4){0.f, 0.f, 0.f, 0.f};
#pragma unroll
            for (int i4 = 0; i4 < 8; ++i4) {
                const int off = (t * 4 + hw) * 128 + 32 * kg + 4 * i4;
                const f32x4 q4 = *(const f32x4*)(qs + off), k4 = *(const f32x4*)(ks + off), a4 = *(const f32x4*)(as + off);
#pragma unroll
                for (int ii = 0; ii < 4; ++ii) { S[4 * i4 + ii] = a4[ii] * S[4 * i4 + ii] + k4[ii] * v4; o += q4[ii] * S[4 * i4 + ii]; }
            }
#pragma unroll
            for (int j = 0; j < 4; ++j) { o[j] += __shfl_xor(o[j], 16); o[j] += __shfl_xor(o[j], 32); }
            if (kg == 0) {
                u32x2 ov; ov.x = pk2(o[0], o[1]); ov.y = pk2(o[2], o[3]);
                *(u32x2*)(yz + (size_t)t * 4096 + h * 128 + sl * 64 + 4 * vq) = ov;
            }
        }
#pragma unroll
        for (int i = 0; i < 32; ++i) *(f32x4*)(Sout + (size_t)i * ldS) = S[i];
    }
}

#define CK_QS 0
#define CK_KS 17408
#define CK_KT 34816
#define CK_VT 53248
#define CK_PS 62464
#define CK_ST 71680
#define CK_CUM 89088
__device__ __forceinline__ bf16x8 ck_frag(const unsigned char* lds, int base, int pitch, int row, int kb, int q) {
    return *(const bf16x8*)(lds + base + row * pitch + (32 * kb + 8 * q) * 2);
}
template <int TYPE>
__device__ __forceinline__ void chunk_item(const Params& p, unsigned char* lds, int b, int h, int s) {
    int tid = threadIdx.x; asm volatile("" : "+v"(tid));
    const int w = tid >> 6, lane = tid & 63, r = lane & 15, q = lane >> 4;
    constexpr int LDP = TYPE < 2 ? LD0 : LD1;
    const bf16_t* proj = (const bf16_t*)(p.ws + WS_PROJ) + (size_t)(2048 * b) * LDP;
    bf16_t* yz = (bf16_t*)(p.ws + WS_YZ) + (size_t)(2048 * b) * 4096;
    const int I = w >> 1, Vn0 = 2 * (w & 1);
    const int c1 = tid & 127, tq = tid >> 7;
    const int cx = tid & 63, tx = tid >> 6;
    const int g = h >> 3;
    float cwC[4], cwB[4], cwX[4], cbC = 0.f, cbB = 0.f, cbX = 0.f, inv = 0.f, dtb = 0.f, Aneg = 0.f, Dh = 0.f;
    int colC = 0, colB = 0, colX = 0;
    if constexpr (TYPE == 0) {
        const int chC = 2560 + g * 128 + c1, chB = 2048 + g * 128 + c1, chX = h * 64 + cx;
        colC = 2048 + chC; colB = 2048 + chB; colX = 2048 + chX;
#pragma unroll
        for (int j = 0; j < 4; ++j) { cwC[j] = p.in[13 + p.z][j * 3072 + chC]; cwB[j] = p.in[13 + p.z][j * 3072 + chB]; cwX[j] = p.in[13 + p.z][j * 3072 + chX]; }
        cbC = p.in[14 + p.z][chC]; cbB = p.in[14 + p.z][chB]; cbX = p.in[14 + p.z][chX];
        dtb = p.in[15 + p.z][h]; Aneg = -__expf(p.in[16 + p.z][h]); Dh = p.in[17 + p.z][h];
    } else if constexpr (TYPE == 1) {
        const int isk = c1 >> 6, jf = c1 & 63;
        colC = (isk ? 6176 : 5152) + h * 128 + jf; colB = colC + 64; colX = 7200 + h * 256 + s * 64 + cx;
        inv = exp2f(-(float)jf * 0.20762050593046014f);
    } else {
        colC = h * 128 + c1; colB = 2048 + h * 128 + c1; colX = 4096 + h * 128 + s * 64 + cx;
        inv = ((const float*)(p.ws + WS_LB))[h * 128 + c1];
    }
    float* cumb = (float*)(lds + CK_CUM);
    if constexpr (TYPE == 1) {
        const float lg = __logf(1.0f - exp2f(-5.0f - (float)h * (4.0f / 7.0f)));
        if (tid < 64) {
#pragma unroll
            for (int bfi = 0; bfi < 2; ++bfi) { float* cb = cumb + bfi * 320; cb[tid] = (tid + 1) * lg; cb[64 + tid] = __expf((tid + 1) * lg); cb[128 + tid] = __expf((63 - tid) * lg); cb[192 + tid] = 1.0f; if (tid == 0) cb[256] = __expf(64.0f * lg); }
        }
    }
    for (int i = tid; i < 17408 / 4; i += 512) ((unsigned*)(lds + CK_ST))[i] = 0u;
    f32x4 Sacc[4];
#pragma unroll
    for (int i = 0; i < 4; ++i) Sacc[i] = (f32x4){0.f, 0.f, 0.f, 0.f};
    unsigned short xc[19], xb[19], xx[11], zr[8], dr = 0;
    auto load_raw = [&](int c) {
        const int t0 = 64 * c;
        if constexpr (TYPE == 0) {
#pragma unroll
            for (int i = 0; i < 19; ++i) { const int t = t0 + 16 * tq - 3 + i; xc[i] = 0; xb[i] = 0; if (t >= 0) { xc[i] = proj[(size_t)t * LDP + colC]; xb[i] = proj[(size_t)t * LDP + colB]; } }
#pragma unroll
            for (int i = 0; i < 11; ++i) { const int t = t0 + 8 * tx - 3 + i; xx[i] = 0; if (t >= 0) xx[i] = proj[(size_t)t * LDP + colX]; }
            if (w == 7) dr = proj[(size_t)(t0 + lane) * LDP + 5120 + h];
#pragma unroll
            for (int vv = 0; vv < 2; ++vv)
#pragma unroll
                for (int jx = 0; jx < 4; ++jx) zr[vv * 4 + jx] = proj[(size_t)(t0 + 16 * I + 4 * q + jx) * LDP + h * 64 + 16 * (Vn0 + vv) + r];
        } else {
#pragma unroll
            for (int i = 0; i < 16; ++i) { const int t = t0 + 16 * tq + i; xc[i] = proj[(size_t)t * LDP + colC]; xb[i] = proj[(size_t)t * LDP + colB]; }
#pragma unroll
            for (int i = 0; i < 8; ++i) xx[i] = proj[(size_t)(t0 + 8 * tx + i) * LDP + colX];
        }
    };
    load_raw(0);
    for (int c = 0; c < 32; ++c) {
        const int t0 = 64 * c;
        float* cum = cumb + (TYPE == 0 ? (c & 1) * 320 : 0);
        float vq_[16], vk_[16], vx_[8], kt_[16], Eval = 0.f;
        (void)kt_; (void)Eval;
        if constexpr (TYPE == 0) {
#pragma unroll
            for (int i = 0; i < 16; ++i) {
                vq_[i] = silu(cbC + cwC[0] * bf2f(xc[i]) + cwC[1] * bf2f(xc[i + 1]) + cwC[2] * bf2f(xc[i + 2]) + cwC[3] * bf2f(xc[i + 3]));
                vk_[i] = silu(cbB + cwB[0] * bf2f(xb[i]) + cwB[1] * bf2f(xb[i + 1]) + cwB[2] * bf2f(xb[i + 2]) + cwB[3] * bf2f(xb[i + 3]));
            }
#pragma unroll
            for (int i = 0; i < 8; ++i) vx_[i] = silu(cbX + cwX[0] * bf2f(xx[i]) + cwX[1] * bf2f(xx[i + 1]) + cwX[2] * bf2f(xx[i + 2]) + cwX[3] * bf2f(xx[i + 3]));
            if (w == 7) {
                const float dt = softplus(bf2f(dr) + dtb);
                float cs = dt * Aneg;
#pragma unroll
                for (int o = 1; o < 64; o <<= 1) { const float t = __shfl_up(cs, o); if (lane >= o) cs += t; }
                const float last = __shfl(cs, 63);
                cum[lane] = cs; cum[64 + lane] = __expf(cs); cum[128 + lane] = __expf(last - cs); cum[192 + lane] = dt;
                if (lane == 0) cum[256] = __expf(last);
            }
        } else if constexpr (TYPE == 2) {
            float lc[16], om[16];
            float run = 0.f;
#pragma unroll
            for (int i = 0; i < 16; ++i) { const float f = inv + (1.0f - inv) * sigm(bf2f(xb[i])); run += __logf(f); lc[i] = run; om[i] = 1.0f - f; }
#pragma unroll
            for (int i = 0; i < 16; ++i) { vq_[i] = silu(bf2f(xc[i])) * __expf(lc[i]); vk_[i] = om[i] * __expf(-lc[i]); kt_[i] = om[i] * __expf(run - lc[i]); }
            Eval = __expf(run);
#pragma unroll
            for (int i = 0; i < 8; ++i) vx_[i] = bf2f(xx[i]);
        } else {
#pragma unroll
            for (int i = 0; i < 16; ++i) {
                const double rev = (double)(t0 + 16 * tq + i) * (double)inv * 0.15915494309189535;
                const float fr = (float)(rev - floor(rev));
                const float sn = __builtin_amdgcn_sinf(fr), cs = __builtin_amdgcn_cosf(fr);
                const float a1 = bf2f(xc[i]), a2 = bf2f(xb[i]);
                vq_[i] = a1 * cs - a2 * sn; vk_[i] = a1 * sn + a2 * cs;
            }
#pragma unroll
            for (int i = 0; i < 8; ++i) vx_[i] = bf2f(xx[i]);
        }
        unsigned short zc[8];
#pragma unroll
        for (int i = 0; i < 8; ++i) zc[i] = zr[i];
        __syncthreads();
        if constexpr (TYPE == 0) {
            unsigned kt[8];
#pragma unroll
            for (int i = 0; i < 16; i += 2) {
                const int t = 16 * tq + i;
                const float k0 = vk_[i] * cum[192 + t], k1 = vk_[i + 1] * cum[192 + t + 1];
                *(bf16_t*)(lds + CK_QS + t * 272 + c1 * 2) = f2bf(vq_[i]); *(bf16_t*)(lds + CK_QS + (t + 1) * 272 + c1 * 2) = f2bf(vq_[i + 1]);
                *(bf16_t*)(lds + CK_KS + t * 272 + c1 * 2) = f2bf(k0); *(bf16_t*)(lds + CK_KS + (t + 1) * 272 + c1 * 2) = f2bf(k1);
                kt[i >> 1] = pk2(k0 * cum[128 + t], k1 * cum[128 + t + 1]);
            }
            *(u32x4*)(lds + CK_KT + c1 * 144 + 32 * tq) = (u32x4){kt[0], kt[1], kt[2], kt[3]};
            *(u32x4*)(lds + CK_KT + c1 * 144 + 32 * tq + 16) = (u32x4){kt[4], kt[5], kt[6], kt[7]};
        } else if constexpr (TYPE == 2) {
            unsigned kt[8];
#pragma unroll
            for (int i = 0; i < 16; i += 2) {
                const int t = 16 * tq + i;
                *(bf16_t*)(lds + CK_QS + t * 272 + c1 * 2) = f2bf(vq_[i]); *(bf16_t*)(lds + CK_QS + (t + 1) * 272 + c1 * 2) = f2bf(vq_[i + 1]);
                *(bf16_t*)(lds + CK_KS + t * 272 + c1 * 2) = f2bf(vk_[i]); *(bf16_t*)(lds + CK_KS + (t + 1) * 272 + c1 * 2) = f2bf(vk_[i + 1]);
                kt[i >> 1] = pk2(kt_[i], kt_[i + 1]);
            }
            *(u32x4*)(lds + CK_KT + c1 * 144 + 32 * tq) = (u32x4){kt[0], kt[1], kt[2], kt[3]};
            *(u32x4*)(lds + CK_KT + c1 * 144 + 32 * tq + 16) = (u32x4){kt[4], kt[5], kt[6], kt[7]};
            cum[tq * 128 + c1] = Eval;
        } else {
            const int isk = c1 >> 6, jf = c1 & 63;
            if (isk == 0) {
#pragma unroll
                for (int i = 0; i < 16; ++i) { const int t = 16 * tq + i; *(bf16_t*)(lds + CK_QS + t * 272 + jf * 2) = f2bf(vq_[i]); *(bf16_t*)(lds + CK_QS + t * 272 + (jf + 64) * 2) = f2bf(vk_[i]); }
            } else {
                unsigned kta[8], ktb[8];
#pragma unroll
                for (int i = 0; i < 16; i += 2) {
                    const int t = 16 * tq + i;
                    const float a0 = vq_[i] * 0.08838834764831845f, a1 = vq_[i + 1] * 0.08838834764831845f, b0 = vk_[i] * 0.08838834764831845f, b1 = vk_[i + 1] * 0.08838834764831845f;
                    *(bf16_t*)(lds + CK_KS + t * 272 + jf * 2) = f2bf(a0); *(bf16_t*)(lds + CK_KS + (t + 1) * 272 + jf * 2) = f2bf(a1);
                    *(bf16_t*)(lds + CK_KS + t * 272 + (jf + 64) * 2) = f2bf(b0); *(bf16_t*)(lds + CK_KS + (t + 1) * 272 + (jf + 64) * 2) = f2bf(b1);
                    kta[i >> 1] = pk2(a0 * cum[128 + t], a1 * cum[128 + t + 1]); ktb[i >> 1] = pk2(b0 * cum[128 + t], b1 * cum[128 + t + 1]);
                }
                *(u32x4*)(lds + CK_KT + jf * 144 + 32 * tq) = (u32x4){kta[0], kta[1], kta[2], kta[3]};
                *(u32x4*)(lds + CK_KT + jf * 144 + 32 * tq + 16) = (u32x4){kta[4], kta[5], kta[6], kta[7]};
                *(u32x4*)(lds + CK_KT + (jf + 64) * 144 + 32 * tq) = (u32x4){ktb[0], ktb[1], ktb[2], ktb[3]};
                *(u32x4*)(lds + CK_KT + (jf + 64) * 144 + 32 * tq + 16) = (u32x4){ktb[4], ktb[5], ktb[6], ktb[7]};
            }
        }
        *(u32x4*)(lds + CK_VT + cx * 144 + 16 * tx) = (u32x4){pk2(vx_[0], vx_[1]), pk2(vx_[2], vx_[3]), pk2(vx_[4], vx_[5]), pk2(vx_[6], vx_[7])};
        __syncthreads();
        if (c + 1 < 32) load_raw(c + 1);
        if constexpr (TYPE < 2) {
        bf16x8 aQ[4];
#pragma unroll
        for (int kb = 0; kb < 4; ++kb) aQ[kb] = ck_frag(lds, CK_QS, 272, 16 * I + r, kb, q);
        float cumi[4];
#pragma unroll
        for (int jx = 0; jx < 4; ++jx) cumi[jx] = cum[16 * I + 4 * q + jx];
#pragma unroll
        for (int jj = 0; jj < 2; ++jj) {
            const int J = Vn0 + jj;
            f32x4 acc = (f32x4){0.f, 0.f, 0.f, 0.f};
#pragma unroll
            for (int kb = 0; kb < 4; ++kb) acc = __builtin_amdgcn_mfma_f32_16x16x32_bf16(aQ[kb], ck_frag(lds, CK_KS, 272, 16 * J + r, kb, q), acc, 0, 0, 0);
            const int jcol = 16 * J + r; const float cumj = cum[jcol];
#pragma unroll
            for (int jx = 0; jx < 4; ++jx) {
                const int i = 16 * I + 4 * q + jx;
                const float v = (jcol <= i) ? acc[jx] * __expf(fminf(cumi[jx] - cumj, 0.f)) : 0.f;
                *(bf16_t*)(lds + CK_PS + i * 144 + jcol * 2) = f2bf(v);
            }
        }
        __syncthreads();
#pragma unroll
        for (int vv = 0; vv < 2; ++vv) {
            const int Vn = Vn0 + vv;
            f32x4 aPV = (f32x4){0.f, 0.f, 0.f, 0.f}, aQS = (f32x4){0.f, 0.f, 0.f, 0.f};
#pragma unroll
            for (int jb = 0; jb < 2; ++jb) aPV = __builtin_amdgcn_mfma_f32_16x16x32_bf16(ck_frag(lds, CK_PS, 144, 16 * I + r, jb, q), ck_frag(lds, CK_VT, 144, 16 * Vn + r, jb, q), aPV, 0, 0, 0);
#pragma unroll
            for (int kb = 0; kb < 4; ++kb) aQS = __builtin_amdgcn_mfma_f32_16x16x32_bf16(aQ[kb], ck_frag(lds, CK_ST, 272, 16 * Vn + r, kb, q), aQS, 0, 0, 0);
#pragma unroll
            for (int jx = 0; jx < 4; ++jx) {
                const int i = 16 * I + 4 * q + jx, v = 16 * Vn + r;
                const float o = aPV[jx] + cum[64 + i] * aQS[jx];
                if constexpr (TYPE == 0) {
                    const float xsv = bf2f(*(const bf16_t*)(lds + CK_VT + v * 144 + i * 2));
                    yz[(size_t)(t0 + i) * 4096 + h * 64 + v] = f2bf((o + Dh * xsv) * silu(bf2f(zc[vv * 4 + jx])));
                } else {
                    yz[(size_t)(t0 + i) * 4096 + 2048 + h * 256 + s * 64 + v] = f2bf(o);
                }
            }
        }
        __syncthreads();
        const float elast = cum[256];
#pragma unroll
        for (int Vn = 0; Vn < 4; ++Vn) {
            Sacc[Vn] = Sacc[Vn] * elast;
#pragma unroll
            for (int tb = 0; tb < 2; ++tb) Sacc[Vn] = __builtin_amdgcn_mfma_f32_16x16x32_bf16(ck_frag(lds, CK_KT, 144, 16 * w + r, tb, q), ck_frag(lds, CK_VT, 144, 16 * Vn + r, tb, q), Sacc[Vn], 0, 0, 0);
            *(u32x2*)(lds + CK_ST + (16 * Vn + r) * 272 + (16 * w + 4 * q) * 2) = (u32x2){pk2_sw(Sacc[Vn][0], Sacc[Vn][1]), pk2_sw(Sacc[Vn][2], Sacc[Vn][3])};
        }
            } else {
            const bf16x8 zf = (bf16x8){0, 0, 0, 0, 0, 0, 0, 0};
            if ((w & 1) == 0) {
                f32x4 acc = (f32x4){0.f, 0.f, 0.f, 0.f};
#pragma unroll
                for (int kb = 0; kb < 4; ++kb) acc = __builtin_amdgcn_mfma_f32_16x16x32_bf16(ck_frag(lds, CK_QS, 272, 16 * I + r, kb, q), ck_frag(lds, CK_KS, 272, 16 * I + r, kb, q), acc, 0, 0, 0);
#pragma unroll
                for (int jx = 0; jx < 4; ++jx) {
                    const float v = (r <= 4 * q + jx) ? acc[jx] : 0.f;
                    *(bf16_t*)(lds + CK_PS + (16 * I + 4 * q + jx) * 144 + (16 * I + r) * 2) = f2bf(v);
                }
            }
            __syncthreads();
#pragma unroll 1
            for (int sc = 0; sc < 4; ++sc) {
                if (w < 4) {
                    const int Vn = w;
                    f32x4 aO = (f32x4){0.f, 0.f, 0.f, 0.f};
                    const bf16x8 pa = (q < 2) ? *(const bf16x8*)(lds + CK_PS + (16 * sc + r) * 144 + (16 * sc + 8 * q) * 2) : zf;
                    const bf16x8 vb = (q < 2) ? *(const bf16x8*)(lds + CK_VT + (16 * Vn + r) * 144 + (16 * sc + 8 * q) * 2) : zf;
                    aO = __builtin_amdgcn_mfma_f32_16x16x32_bf16(pa, vb, aO, 0, 0, 0);
#pragma unroll
                    for (int kb = 0; kb < 4; ++kb) aO = __builtin_amdgcn_mfma_f32_16x16x32_bf16(ck_frag(lds, CK_QS, 272, 16 * sc + r, kb, q), ck_frag(lds, CK_ST, 272, 16 * Vn + r, kb, q), aO, 0, 0, 0);
#pragma unroll
                    for (int jx = 0; jx < 4; ++jx) yz[(size_t)(t0 + 16 * sc + 4 * q + jx) * 4096 + h * 128 + s * 64 + 16 * Vn + r] = (bf16_t)(pk2_sw(aO[jx], 0.f) & 0xffffu);
                }
                __syncthreads();
                {
                    const f32x4 e4 = *(const f32x4*)(cum + sc * 128 + 16 * w + 4 * q);
                    const bf16x8 ka = (q < 2) ? *(const bf16x8*)(lds + CK_KT + (16 * w + r) * 144 + (16 * sc + 8 * q) * 2) : zf;
#pragma unroll
                    for (int Vn = 0; Vn < 4; ++Vn) {
                        const bf16x8 vb = (q < 2) ? *(const bf16x8*)(lds + CK_VT + (16 * Vn + r) * 144 + (16 * sc + 8 * q) * 2) : zf;
                        Sacc[Vn] = __builtin_amdgcn_mfma_f32_16x16x32_bf16(ka, vb, Sacc[Vn] * e4, 0, 0, 0);
                        *(u32x2*)(lds + CK_ST + (16 * Vn + r) * 272 + (16 * w + 4 * q) * 2) = (u32x2){pk2_sw(Sacc[Vn][0], Sacc[Vn][1]), pk2_sw(Sacc[Vn][2], Sacc[Vn][3])};
                    }
                }
                __syncthreads();
            }
        }
    }
    const int ldS = TYPE == 0 ? 64 : (TYPE == 1 ? 256 : 128);
    float* Sout = p.out + (TYPE == 0 ? O_SSMP + ((size_t)(b * 32 + h) * 128) * 64 : (TYPE == 1 ? O_RETP + ((size_t)(b * 8 + h) * 128) * 256 + s * 64 : O_HGP + ((size_t)(b * 16 + h) * 128) * 128 + s * 64));
#pragma unroll
    for (int Vn = 0; Vn < 4; ++Vn)
#pragma unroll
        for (int jx = 0; jx < 4; ++jx) Sout[(size_t)(16 * w + 4 * q + jx) * ldS + 16 * Vn + r] = Sacc[Vn][jx];
}

__device__ __forceinline__ void lru_dec_unit(const Params& p, int b) {
    int tid = threadIdx.x; asm volatile("" : "+v"(tid));
    const int c = tid * 4;
    const int row0 = MP + 4 * b;
    const float* LA = (const float*)(p.ws + WS_LA) + (size_t)row0 * 2048 + c;
    const bf16_t* LBv = (const bf16_t*)(p.ws + WS_LBB) + (size_t)row0 * 2048 + c;
    const bf16_t* rg = (const bf16_t*)(p.ws + WS_PROJ) + (size_t)row0 * LD1 + 10240 + c;
    bf16_t* mixa = (bf16_t*)(p.ws + WS_ACT) + (size_t)row0 * 4096 + 2048 + c;
    f32x4 hst = *(const f32x4*)(p.in[6 + p.z] + (size_t)b * 2048 + c);
#pragma unroll
    for (int t = 0; t < 4; ++t) {
        const f32x4 a = *(const f32x4*)(LA + (size_t)t * 2048);
        float bb[4], gg[4]; unpack4(*(const u32x2*)(LBv + (size_t)t * 2048), bb); unpack4(*(const u32x2*)(rg + (size_t)t * LD1), gg);
        float y[4];
#pragma unroll
        for (int j = 0; j < 4; ++j) { hst[j] = a[j] * hst[j] + bb[j]; y[j] = hst[j] * gelu_tanh(gg[j]); }
        u32x2 ov; ov.x = pk2(y[0], y[1]); ov.y = pk2(y[2], y[3]);
        *(u32x2*)(mixa + (size_t)t * 4096) = ov;
    }
    *(f32x4*)(p.out + O_LRUS + (size_t)b * 2048 + c) = hst;
}

__device__ __forceinline__ void lru_scan_item(const Params& p, float* ldsf, int b, int cg) {
    int tid = threadIdx.x; asm volatile("" : "+v"(tid));
    const int w = tid >> 6, lane = tid & 63, c = cg * 64 + lane;
    const size_t row0 = (size_t)2048 * b + 256 * w;
    const float* LA = (const float*)(p.ws + WS_LA) + row0 * 2048 + c;
    const bf16_t* LBv = (const bf16_t*)(p.ws + WS_LBB) + row0 * 2048 + c;
    const bf16_t* rg = (const bf16_t*)(p.ws + WS_PROJ) + row0 * LD1 + 10240 + c;
    bf16_t* mixa = (bf16_t*)(p.ws + WS_ACT) + row0 * 4096 + 2048 + c;
    float hl = 0.f, pr = 1.f;
    for (int tb = 0; tb < 256; tb += 16) {
        float a0[16]; unsigned short b0[16];
#pragma unroll
        for (int t = 0; t < 16; ++t) { a0[t] = LA[(size_t)(tb + t) * 2048]; b0[t] = LBv[(size_t)(tb + t) * 2048]; }
#pragma unroll
        for (int t = 0; t < 16; ++t) { hl = a0[t] * hl + bf2f(b0[t]); pr *= a0[t]; }
    }
    ldsf[w * 128 + lane] = pr; ldsf[w * 128 + 64 + lane] = hl;
    __syncthreads();
    float hst = 0.f;
    for (int ww = 0; ww < w; ++ww) hst = ldsf[ww * 128 + lane] * hst + ldsf[ww * 128 + 64 + lane];
    for (int tb = 0; tb < 256; tb += 16) {
        float a0[16]; unsigned short b0[16], g0[16];
#pragma unroll
        for (int t = 0; t < 16; ++t) { a0[t] = LA[(size_t)(tb + t) * 2048]; b0[t] = LBv[(size_t)(tb + t) * 2048]; g0[t] = rg[(size_t)(tb + t) * LD1]; }
#pragma unroll
        for (int t = 0; t < 16; ++t) {
            hst = a0[t] * hst + bf2f(b0[t]);
            mixa[(size_t)(tb + t) * 4096] = f2bf(hst * gelu_tanh(bf2f(g0[t])));
        }
    }
    if (w == 7) p.out[O_LRUP + (size_t)b * 2048 + c] = hst;
}

__device__ __forceinline__ void phase_rec0(const Params& p, float* ldsf) {
    unsigned* ctr = (unsigned*)(p.ws + WS_CTL);
    const int total = 256 + 512 + 512;
    for (;;) {
        const int it = next_item(ctr, ldsf);
        if (it >= total) break;
        if (it < 128) chunk_item<0>(p, (unsigned char*)ldsf, it >> 5, it & 31, 0);
        else if (it < 256) { const int j = it - 128; chunk_item<1>(p, (unsigned char*)ldsf, j >> 5, (j & 31) >> 2, j & 3); }
        else if (it < 768) { const int j = it - 256; dec_unit<0>(p, ldsf, j >> 2, j & 3); }
        else { const int j = it - 768; dec_unit<1>(p, ldsf, j >> 2, j & 3); }
    }
}
__device__ __forceinline__ void phase_rec1(const Params& p, float* ldsf) {
    unsigned* ctr = (unsigned*)(p.ws + WS_CTL) + 64;
    const int total = 128 + 128 + 512 + 128;
    for (;;) {
        const int it = next_item(ctr, ldsf);
        if (it >= total) break;
        if (it < 128) chunk_item<2>(p, (unsigned char*)ldsf, it >> 5, (it & 31) >> 1, it & 1);
        else if (it < 256) { const int j = it - 128; lru_scan_item(p, ldsf, j >> 5, j & 31); }
        else if (it < 768) { const int j = it - 256; dec_unit<2>(p, ldsf, j >> 2, j & 3); }
        else lru_dec_unit(p, it - 768);
    }
}

__device__ __forceinline__ void seq_of_row(int row, int& sample, int& b, int& t, int& L) {
    if (row < MP) { sample = 0; b = row >> 11; t = row & 2047; L = 2048; } else { sample = 1; b = (row - MP) >> 2; t = (row - MP) & 3; L = 4; }
}

__device__ __forceinline__ void phase_prep0(const Params& p) {
    int tid = threadIdx.x; asm volatile("" : "+v"(tid));
    const int wave = tid >> 6, lane = tid & 63;
    const int gw = blockIdx.x * 8 + wave, NGW = gridDim.x * 8;
    const bf16_t* YZ = (const bf16_t*)(p.ws + WS_YZ); const bf16_t* PR = (const bf16_t*)(p.ws + WS_PROJ);
    bf16_t* MX = (bf16_t*)(p.ws + WS_ACT);
    const float* nw = p.in[18 + p.z];
    for (int row = gw; row < MT; row += NGW) {
        const bf16_t* yz = YZ + (size_t)row * 4096; bf16_t* mx = MX + (size_t)row * 4096;
        u32x4 ya[4]; u32x2 yb[8], gb[8];
#pragma unroll
        for (int g = 0; g < 4; ++g) ya[g] = *(const u32x4*)(yz + g * 512 + lane * 8);
#pragma unroll
        for (int hh = 0; hh < 8; ++hh) { yb[hh] = *(const u32x2*)(yz + 2048 + hh * 256 + lane * 4); gb[hh] = *(const u32x2*)(PR + (size_t)row * LD0 + 9248 + hh * 256 + lane * 4); }
#pragma unroll
        for (int g = 0; g < 4; ++g) {
            const int c = g * 512 + lane * 8;
            float v[8]; unpack8(ya[g], v);
            float s = 0.f;
#pragma unroll
            for (int j = 0; j < 8; ++j) s += v[j] * v[j];
            s = wave_sum(s);
            const float rs = rsqrtf(s * (1.0f / 512.0f) + EPS);
            const f32x4 n0 = *(const f32x4*)(nw + c), n1 = *(const f32x4*)(nw + c + 4);
            u32x4 o; o.x = pk2(v[0] * rs * n0[0], v[1] * rs * n0[1]); o.y = pk2(v[2] * rs * n0[2], v[3] * rs * n0[3]);
            o.z = pk2(v[4] * rs * n1[0], v[5] * rs * n1[1]); o.w = pk2(v[6] * rs * n1[2], v[7] * rs * n1[3]);
            *(u32x4*)(mx + c) = o;
        }
#pragma unroll
        for (int hh = 0; hh < 8; ++hh) {
            const int c = hh * 256 + lane * 4;
            float v[4]; unpack4(yb[hh], v);
            float gt[4]; unpack4(gb[hh], gt);
            float s = (v[0] * v[0] + v[1] * v[1]) + (v[2] * v[2] + v[3] * v[3]);
            s = wave_sum(s);
            const float rs = rsqrtf(s * (1.0f / 256.0f) + EPS);
            u32x2 o; o.x = pk2(v[0] * rs * silu(gt[0]), v[1] * rs * silu(gt[1])); o.y = pk2(v[2] * rs * silu(gt[2]), v[3] * rs * silu(gt[3]));
            *(u32x2*)(mx + 2048 + c) = o;
        }
        int sample, b, t, L; seq_of_row(row, sample, b, t, L);
        if (t >= L - 3) {
            float* dst = p.out + (sample ? O_SCS : O_SCP) + ((size_t)b * 3 + (t - (L - 3))) * 3072;
            const bf16_t* src = PR + (size_t)row * LD0 + 2048;
#pragma unroll 4
            for (int c = lane; c < 3072; c += 64) dst[c] = bf2f(src[c]);
        }
    }
}

__device__ __forceinline__ void phase_prep1(const Params& p) {
    int tid = threadIdx.x; asm volatile("" : "+v"(tid));
    const int wave = tid >> 6, lane = tid & 63;
    const int gw = blockIdx.x * 8 + wave, NGW = gridDim.x * 8;
    const bf16_t* YZ = (const bf16_t*)(p.ws + WS_YZ); const bf16_t* PR = (const bf16_t*)(p.ws + WS_PROJ);
    bf16_t* MX = (bf16_t*)(p.ws + WS_ACT);
    const float* nw = p.in[22 + p.z];
    for (int row = gw; row < MT; row += NGW) {
        u32x4 ya[4], ga[4];
#pragma unroll
        for (int it = 0; it < 4; ++it) { ya[it] = *(const u32x4*)(YZ + (size_t)row * 4096 + it * 512 + lane * 8); ga[it] = *(const u32x4*)(PR + (size_t)row * LD1 + 6144 + it * 512 + lane * 8); }
#pragma unroll
        for (int it = 0; it < 4; ++it) {
            const int c = it * 512 + lane * 8;
            float v[8]; unpack8(ya[it], v);
            float gt[8]; unpack8(ga[it], gt);
            float s = 0.f;
#pragma unroll
            for (int j = 0; j < 8; ++j) s += v[j] * v[j];
            s += __shfl_xor(s, 1); s += __shfl_xor(s, 2); s += __shfl_xor(s, 4); s += __shfl_xor(s, 8);
            const float rs = rsqrtf(s * (1.0f / 128.0f) + EPS);
            const f32x4 n0 = *(const f32x4*)(nw + (c & 127)), n1 = *(const f32x4*)(nw + (c & 127) + 4);
            float o[8];
#pragma unroll
            for (int j = 0; j < 8; ++j) o[j] = v[j] * rs * (j < 4 ? n0[j] : n1[j - 4]) * silu(gt[j]);
            u32x4 ov; ov.x = pk2(o[0], o[1]); ov.y = pk2(o[2], o[3]); ov.z = pk2(o[4], o[5]); ov.w = pk2(o[6], o[7]);
            *(u32x4*)(MX + (size_t)row * 4096 + c) = ov;
        }
    }
}

__device__ __forceinline__ void phase_act(const Params& p, int l) {
    int tid = threadIdx.x; asm volatile("" : "+v"(tid));
    const bf16_t* PR = (const bf16_t*)(p.ws + WS_PROJ); bf16_t* ACT = (bf16_t*)(p.ws + WS_ACT);
    const float* cw = p.in[32 + p.z] + (size_t)l * 3 * DFF; const float* cbv = p.in[33 + p.z] + (size_t)l * DFF;
    const float* st = p.in[8 + p.z] + (size_t)l * 128 * 2 * DFF;
    const int total = (MT / 4) * 704;
    for (int idx = blockIdx.x * 512 + tid; idx < total; idx += gridDim.x * 512) {
        const int rb = idx / 704, c = (idx - rb * 704) * 8, r0 = rb * 4;
        int sample, b, t0, L; seq_of_row(r0, sample, b, t0, L);
        u32x4 gr[6], ur[4];
#pragma unroll
        for (int i = 0; i < 4; ++i) { gr[i + 2] = *(const u32x4*)(PR + (size_t)(r0 + i) * LDU + c); ur[i] = *(const u32x4*)(PR + (size_t)(r0 + i) * LDU + DFF + c); }
        float g[6][8];
        if (t0 >= 2) { gr[0] = *(const u32x4*)(PR + (size_t)(r0 - 2) * LDU + c); gr[1] = *(const u32x4*)(PR + (size_t)(r0 - 1) * LDU + c); unpack8(gr[0], g[0]); unpack8(gr[1], g[1]); }
        else {
#pragma unroll
            for (int j = 0; j < 8; ++j) { g[0][j] = sample ? st[((size_t)b * 2 + 0) * DFF + c + j] : 0.f; g[1][j] = sample ? st[((size_t)b * 2 + 1) * DFF + c + j] : 0.f; }
        }
#pragma unroll
        for (int i = 0; i < 4; ++i) unpack8(gr[i + 2], g[i + 2]);
        float w0[8], w1[8], w2[8], bb[8];
#pragma unroll
        for (int j = 0; j < 8; ++j) { w0[j] = cw[c + j]; w1[j] = cw[DFF + c + j]; w2[j] = cw[2 * DFF + c + j]; bb[j] = cbv[c + j]; }
#pragma unroll
        for (int i = 0; i < 4; ++i) {
            float uu[8], o[8]; unpack8(ur[i], uu);
#pragma unroll
            for (int j = 0; j < 8; ++j) o[j] = silu(bb[j] + w0[j] * g[i][j] + w1[j] * g[i + 1][j] + w2[j] * g[i + 2][j]) * uu[j];
            u32x4 ov; ov.x = pk2(o[0], o[1]); ov.y = pk2(o[2], o[3]); ov.z = pk2(o[4], o[5]); ov.w = pk2(o[6], o[7]);
            *(u32x4*)(ACT + (size_t)(r0 + i) * DFF + c) = ov;
        }
        if (t0 + 4 == L) {
#pragma unroll
            for (int i = 0; i < 2; ++i) {
                float* dst = p.out + (sample ? O_FCS + (((size_t)l * 128 + b) * 2 + i) * DFF : O_FCP + (((size_t)l * 4 + b) * 2 + i) * DFF) + c;
                *(f32x4*)dst = (f32x4){g[4 + i][0], g[4 + i][1], g[4 + i][2], g[4 + i][3]}; *(f32x4*)(dst + 4) = (f32x4){g[4 + i][4], g[4 + i][5], g[4 + i][6], g[4 + i][7]};
            }
        }
    }
}

__device__ __forceinline__ void phase_lruconv(const Params& p) {
    int tid = threadIdx.x; asm volatile("" : "+v"(tid));
    const bf16_t* PR = (const bf16_t*)(p.ws + WS_PROJ); bf16_t* XR = (bf16_t*)(p.ws + WS_XR);
    const float* cw = p.in[23 + p.z]; const float* cbv = p.in[24 + p.z]; const float* st = p.in[7 + p.z];
    const int total = (MT / 4) * 256;
    for (int idx = blockIdx.x * 512 + tid; idx < total; idx += gridDim.x * 512) {
        const int rb = idx >> 8, c = (idx & 255) * 8, r0 = rb * 4;
        int sample, b, t0, L; seq_of_row(r0, sample, b, t0, L);
        float x[7][8];
#pragma unroll
        for (int j = 3; j < 7; ++j) unpack8(*(const u32x4*)(PR + (size_t)(r0 - 3 + j) * LD1 + 8192 + c), x[j]);
        if (t0 >= 3) {
#pragma unroll
            for (int j = 0; j < 3; ++j) unpack8(*(const u32x4*)(PR + (size_t)(r0 - 3 + j) * LD1 + 8192 + c), x[j]);
        } else {
#pragma unroll
            for (int j = 0; j < 3; ++j)
#pragma unroll
                for (int i = 0; i < 8; ++i) x[j][i] = sample ? st[((size_t)b * 3 + j) * 2048 + c + i] : 0.f;
        }
        float w0[8], w1[8], w2[8], w3[8], bb[8];
#pragma unroll
        for (int i = 0; i < 8; ++i) { w0[i] = cw[c + i]; w1[i] = cw[2048 + c + i]; w2[i] = cw[4096 + c + i]; w3[i] = cw[6144 + c + i]; bb[i] = cbv[c + i]; }
#pragma unroll
        for (int rr = 0; rr < 4; ++rr) {
            float o[8];
#pragma unroll
            for (int i = 0; i < 8; ++i) o[i] = bb[i] + w0[i] * x[rr][i] + w1[i] * x[rr + 1][i] + w2[i] * x[rr + 2][i] + w3[i] * x[rr + 3][i];
            u32x4 ov; ov.x = pk2(o[0], o[1]); ov.y = pk2(o[2], o[3]); ov.z = pk2(o[4], o[5]); ov.w = pk2(o[6], o[7]);
            *(u32x4*)(XR + (size_t)(r0 + rr) * 2048 + c) = ov;
        }
        if (t0 + 4 == L) {
#pragma unroll
            for (int j = 0; j < 3; ++j) {
                float* dst = p.out + (sample ? O_LCS : O_LCP) + ((size_t)b * 3 + j) * 2048 + c;
                *(f32x4*)dst = (f32x4){x[4 + j][0], x[4 + j][1], x[4 + j][2], x[4 + j][3]}; *(f32x4*)(dst + 4) = (f32x4){x[4 + j][4], x[4 + j][5], x[4 + j][6], x[4 + j][7]};
            }
        }
    }
}

__device__ __forceinline__ void finalize_sample_rows(const Params& p, float* ssdst, int nsplit) {
    int tid = threadIdx.x; asm volatile("" : "+v"(tid));
    const int wave = tid >> 6, lane = tid & 63;
    const int gw = blockIdx.x * 8 + wave, NGW = gridDim.x * 8;
    float* X = (float*)(p.ws + WS_X); bf16_t* XB = (bf16_t*)(p.ws + WS_XB); const float* PT = (const float*)(p.ws + WS_PROJ);
    for (int row = MP + gw; row < MT; row += NGW) {
        float s = 0.f;
#pragma unroll 2
        for (int j = 0; j < 8; ++j) {
            const unsigned o = (unsigned)row * 2048u + (unsigned)(lane + 64 * j) * 4u;
            f32x4 v = *(const f32x4*)(X + o);
            for (int ks = 0; ks < nsplit; ++ks) v += *(const f32x4*)(PT + (size_t)ks * (512 * 2048) + (o - (unsigned)MP * 2048u));
            *(f32x4*)(X + o) = v;
            u32x2 w; w.x = pk2(v[0], v[1]); w.y = pk2(v[2], v[3]);
            *(u32x2*)(XB + o) = w;
            s += (v[0] * v[0] + v[1] * v[1]) + (v[2] * v[2] + v[3] * v[3]);
        }
        s = wave_sum(s);
        if (lane == 0) ssdst[row] = s;
    }
}

__device__ __forceinline__ void phase_final(const Params& p) {
    int tid = threadIdx.x; asm volatile("" : "+v"(tid));
    const int wave = tid >> 6, lane = tid & 63;
    const int gw = blockIdx.x * 8 + wave, NGW = gridDim.x * 8;
    const float* X = (const float*)(p.ws + WS_X); const float* nf = p.in[11 + p.z];
    for (int row = gw; row < MT; row += NGW) {
        f32x4 v[8]; float sq = 0.f;
#pragma unroll
        for (int j = 0; j < 8; ++j) { v[j] = *(const f32x4*)(X + (size_t)row * 2048 + (lane + 64 * j) * 4);
            if (row >= MP) { for (int ks = 0; ks < 11; ++ks) v[j] += *(const f32x4*)((const float*)(p.ws + WS_PROJ) + (size_t)ks * (512 * 2048) + (size_t)(row - MP) * 2048 + (lane + 64 * j) * 4); }
            sq += (v[j][0] * v[j][0] + v[j][1] * v[j][1]) + (v[j][2] * v[j][2] + v[j][3] * v[j][3]); }
        sq = wave_sum(sq);
        const float rs = rsqrtf(sq * (1.0f / 2048.0f) + EPS);
        float* dst = p.out + (row < MP ? O_YP + (size_t)row * 2048 : O_YS + (size_t)(row - MP) * 2048);
#pragma unroll
        for (int j = 0; j < 8; ++j) {
            const int c = (lane + 64 * j) * 4;
            *(f32x4*)(dst + c) = v[j] * rs * *(const f32x4*)(nf + c);
        }
    }
}

#define XB_TMO      128
#define XB_XCNT(j)  (256  + 64 * (j))
#define XB_XSUB(j)  (1280 + 64 * (j))
#define XB_XGEN(j)  (2304 + 64 * (j))
#define XB_TOP      3328
#define XB_TOPGEN   3392
#define XCD_BAR_WORDS 3456
#define XB_SPIN_CAP (1u << 22)
__device__ __forceinline__ unsigned xb_ld(unsigned* p)              { return __hip_atomic_load(p, __ATOMIC_RELAXED, __HIP_MEMORY_SCOPE_AGENT); }
__device__ __forceinline__ unsigned xb_add(unsigned* p, unsigned v) { return __hip_atomic_fetch_add(p, v, __ATOMIC_RELAXED, __HIP_MEMORY_SCOPE_AGENT); }
__device__ __forceinline__ unsigned xb_xcc_id() { return (unsigned)__builtin_amdgcn_s_getreg((3 << 11) | 20) & 0xFu; }
#define XB_SPIN(cond, bar) do { unsigned _sp = 0; while (cond) { __builtin_amdgcn_s_sleep(1); \
    if ((++_sp & 255u) == 0u) { if (xb_ld(&(bar)[XB_TMO])) break; if (_sp > XB_SPIN_CAP) { atomicAdd(&(bar)[XB_TMO], 1u); break; } } } } while (0)
struct XcdBarrier { unsigned* bar; unsigned x; volatile LAS unsigned* st; };
__device__ __forceinline__ XcdBarrier xcd_barrier_post(unsigned* bar, volatile LAS unsigned* st) {
    XcdBarrier b; b.bar = bar; b.x = xb_xcc_id(); b.st = st;
    if (threadIdx.x == 0) (void)xb_add(&bar[XB_XCNT(b.x)], 1u);
    return b;
}
__device__ __forceinline__ void xcd_barrier_complete(unsigned* bar, unsigned x, unsigned& nloc, unsigned& nx) {
    const unsigned G = gridDim.x * gridDim.y * gridDim.z;
    unsigned sum, cnt, mine, sp = 0u;
    for (;;) {
        sum = 0u; cnt = 0u; mine = 0u;
#pragma unroll
        for (unsigned j = 0; j < 16; ++j) { const unsigned c = xb_ld(&bar[XB_XCNT(j)]); sum += c; cnt += (c > 0u) ? 1u : 0u; mine = (j == x) ? c : mine; }
        if (sum == G) break;
        __builtin_amdgcn_s_sleep(1);
        if ((++sp & 255u) == 0u) { if (xb_ld(&bar[XB_TMO])) break; if (sp > XB_SPIN_CAP) { atomicAdd(&bar[XB_TMO], 1u); break; } }
    }
    nloc = mine > 0u ? mine : 1u; nx = cnt > 0u ? cnt : 1u;
}
__device__ __forceinline__ void xcd_barrier(const XcdBarrier& b) {
    asm volatile("s_waitcnt vmcnt(0)" ::: "memory");
    __syncthreads();
    if (threadIdx.x == 0) {
        unsigned* bar = b.bar;
        __builtin_amdgcn_s_waitcnt(0);
        unsigned nloc = b.st[0], nx = b.st[1];
        if (nloc == 0u) { xcd_barrier_complete(bar, b.x, nloc, nx); b.st[0] = nloc; b.st[1] = nx; }
        const unsigned old = xb_add(&bar[XB_XSUB(b.x)], 1u);
        const unsigned gen = old / nloc;
        if (old + 1u == (gen + 1u) * nloc) {
            __builtin_amdgcn_fence(__ATOMIC_RELEASE, "agent");
            asm volatile("s_waitcnt vmcnt(0)" ::: "memory");
            const unsigned og = xb_add(&bar[XB_TOP], 1u);
            const unsigned tg = og / nx;
            if (og + 1u == (tg + 1u) * nx) xb_add(&bar[XB_TOPGEN], 1u);
            else XB_SPIN(xb_ld(&bar[XB_TOPGEN]) == tg, bar);
            __builtin_amdgcn_fence(__ATOMIC_ACQUIRE, "agent");
            xb_add(&bar[XB_XGEN(b.x)], 1u);
            asm volatile("s_waitcnt vmcnt(0)" ::: "memory");
        } else {
            XB_SPIN(xb_ld(&bar[XB_XGEN(b.x)]) == gen, bar);
            __builtin_amdgcn_fence(__ATOMIC_ACQUIRE, "agent");
            asm volatile("s_waitcnt vmcnt(0)" ::: "memory");
        }
    }
    __syncthreads();
}

#ifndef PROBE_MASK
#define PROBE_MASK 0u
#endif
#ifndef PHMASK
#define PHMASK 0xFFFFFFFFu
#endif
#define EN(i) (((PHMASK) >> (i)) & 1u)
__global__ void __launch_bounds__(512, 2) fwd_megakernel(Params p) {
    extern __shared__ __attribute__((aligned(16))) unsigned char shm[];
    float* ldsf = (float*)shm;
    LAS unsigned char* ldsg = (LAS unsigned char*)shm;
    unsigned char* ws = p.ws;
    float* ssb = (float*)(ws + WS_SS);
    volatile LAS unsigned* xst = (volatile LAS unsigned*)(ldsg + 133120);
    if (threadIdx.x == 0) { xst[0] = 0u; xst[1] = 0u; }
    __syncthreads();
    (void)xcd_barrier_post((unsigned*)(ws + WS_CTL) + 256, xst);
#define XBAR() do { XcdBarrier _b; _b.bar = (unsigned*)(p.ws + WS_CTL) + 256; _b.x = xb_xcc_id(); _b.st = (volatile LAS unsigned*)((LAS unsigned char*)shm + 133120); xcd_barrier(_b); } while (0)
#if PROBE_MASK
    unsigned long long tph = __builtin_amdgcn_s_memrealtime();
#endif
    for (int ph = p.ph_lo; ph < p.ph_hi; ++ph) {
        if (ph > p.ph_lo) {
            if (ph == 1) cg::this_grid().sync();
            else XBAR();
#if PROBE_MASK
            {
                const unsigned long long t1 = __builtin_amdgcn_s_memrealtime();
                if ((PROBE_MASK >> (ph - 1)) & 1u) { const unsigned long long dt = t1 - tph; while (__builtin_amdgcn_s_memrealtime() - t1 < dt) __builtin_amdgcn_s_sleep(8); }
                tph = __builtin_amdgcn_s_memrealtime();
            }
#endif
        }
        if (EN(0) && ph == 0) phase_prologue(p, ldsf);
        else if (EN(1) && (ph == 1 || ph == 5 || ph == 8 || ph == 14)) {
            pg8::Gemm g; pg8::EpiScaleBf16 E; int N;
            if (ph != 1) { finalize_sample_rows(p, ssb + (ph == 5 ? 1 : (ph == 8 ? 2 : 3)) * MT, ph == 8 ? 11 : 16); XBAR(); }
            g.A = (const char*)(ws + WS_XB); g.lda = 2048; g.ldb = 2048;
            if (ph == 1) { g.Bt = (const char*)(ws + WS_WIN0); N = LD0; E.ss = ssb; }
            else if (ph == 5) { g.Bt = (const char*)(ws + WS_WUP0); N = LDU; E.ss = ssb + MT; }
            else if (ph == 8) { g.Bt = (const char*)(ws + WS_WIN1); N = LD1; E.ss = ssb + 2 * MT; }
            else { g.Bt = (const char*)(ws + WS_WUP1); N = LDU; E.ss = ssb + 3 * MT; }
            E.O = (bf16_t*)(ws + WS_PROJ); E.ldc = N;
            pg8::Order S; S.nMm = 32; S.nN = N / 256; S.n_main = 32 * S.nN; S.n_tail = 2 * S.nN; S.ksplit = 1; S.nt_full = 32; S.G = gridDim.x; S.c = blockIdx.x;
            S.a_t = (size_t)256 * 2048 * 2; S.b_t = (size_t)256 * 2048 * 2; S.acol = 0;
            pg8::gemm_phase<pg8::EpiScaleBf16>(ldsg, g, S, E);
        }
        else if (EN(4) && (ph == 4 || ph == 7 || ph == 13 || ph == 16)) {
            pg8::Gemm g; pg8::EpiResid E;
            g.A = (const char*)(ws + WS_ACT);
            if (ph == 4) { g.Bt = (const char*)(ws + WS_WOUT0); g.lda = 4096; E.ssout = ssb + MT; }
            else if (ph == 7) { g.Bt = (const char*)(ws + WS_WDN0); g.lda = DFF; E.ssout = ssb + 2 * MT; }
            else if (ph == 13) { g.Bt = (const char*)(ws + WS_WOUT1); g.lda = 4096; E.ssout = ssb + 3 * MT; }
            else { g.Bt = (const char*)(ws + WS_WDN1); g.lda = DFF; E.ssout = ssb + 4 * MT; }
            g.ldb = g.lda;
            E.X = (float*)(ws + WS_X); E.XB = (bf16_t*)(ws + WS_XB); E.part = (float*)(ws + WS_PROJ);
            pg8::Order S; S.nMm = 32; S.nN = 8; S.n_main = 256; S.nt_full = g.lda / 64; S.ksplit = (g.lda == 4096) ? 16 : 11; S.n_tail = 16 * S.ksplit; S.G = gridDim.x; S.c = blockIdx.x;
            S.a_t = (size_t)256 * g.lda * 2; S.b_t = (size_t)256 * g.ldb * 2; S.acol = 0;
            pg8::gemm_phase<pg8::EpiResid>(ldsg, g, S, E);
        }
        else if (EN(10) && ph == 10) {
            pg8::Gemm g; pg8::EpiLru E;
            g.A = (const char*)(ws + WS_XR); g.Bt = (const char*)(ws + WS_WLRU); g.lda = 2048; g.ldb = 256;
            E.br = p.in[26 + p.z]; E.bi = p.in[28 + p.z]; E.sp = (const float*)(ws + WS_SP); E.XR = (const bf16_t*)(ws + WS_XR);
            E.LA = (float*)(ws + WS_LA); E.LBv = (bf16_t*)(ws + WS_LBB);
            pg8::Order S; S.nMm = 34; S.nN = 16; S.n_main = 34 * 16; S.n_tail = 0; S.ksplit = 1; S.nt_full = 4 + p.z; S.G = gridDim.x; S.c = blockIdx.x;
            S.a_t = (size_t)256 * 2048 * 2; S.b_t = (size_t)256 * 256 * 2; S.acol = 512;
            pg8::gemm_phase<pg8::EpiLru>(ldsg, g, S, E);
        }
        else if (EN(2) && ph == 2) phase_rec0(p, ldsf);
        else if (EN(3) && ph == 3) phase_prep0(p);
        else if (EN(6) && ph == 6) phase_act(p, 0);
        else if (EN(9) && ph == 9) phase_lruconv(p);
        else if (EN(11) && ph == 11) phase_rec1(p, ldsf);
        else if (EN(12) && ph == 12) phase_prep1(p);
        else if (EN(15) && ph == 15) phase_act(p, 1);
        else if (EN(17) && ph == 17) phase_final(p);
    }
}

#ifndef N_LAUNCH_MODE
#define N_LAUNCH_MODE 0
#endif

extern "C" void kernel_launch(void* const* d_in, const int* in_sizes, int n_in, void* d_out, int out_size, void* d_ws, size_t ws_size, hipStream_t stream) {
    static int grid = 0;
    if (grid == 0) {
        if (n_in != 35 || (size_t)out_size != O_END || ws_size < WS_END) { fprintf(stderr, "kernel_launch: unexpected shapes: n_in %d out %d ws %zu (need %zu)\n", n_in, out_size, ws_size, (size_t)WS_END); grid = -1; return; }
        int dev = 0, cus = 0, per_cu = 0;
        hipGetDevice(&dev);
        hipDeviceGetAttribute(&cus, hipDeviceAttributeMultiprocessorCount, dev);
        if (hipFuncSetAttribute((const void*)fwd_megakernel, hipFuncAttributeMaxDynamicSharedMemorySize, LDS_BYTES) != hipSuccess) { fprintf(stderr, "kernel_launch: hipFuncSetAttribute failed\n"); grid = -1; return; }
        if (hipOccupancyMaxActiveBlocksPerMultiprocessor(&per_cu, (const void*)fwd_megakernel, 512, LDS_BYTES) != hipSuccess || per_cu < 1) { fprintf(stderr, "kernel_launch: occupancy query says %d\n", per_cu); per_cu = 1; }
        (void)hipGetLastError();
        grid = cus;
    }
    if (grid < 0) return;
    (void)hipMemsetAsync((char*)d_ws + WS_CTL, 0, 16384, stream);
    Params p{};
    for (int i = 0; i < 35; ++i) p.in[i] = (const float*)d_in[i];
    p.z = 0; p.pad = 0;
    p.out = (float*)d_out; p.ws = (unsigned char*)d_ws;
#if N_LAUNCH_MODE == 0
    p.ph_lo = 0; p.ph_hi = NPHASE;
    void* args[] = {&p};
    hipError_t e = hipLaunchCooperativeKernel((const void*)fwd_megakernel, dim3(grid), dim3(512), args, LDS_BYTES, stream);
    if (e != hipSuccess) fprintf(stderr, "cooperative launch failed: %s (grid %d)\n", hipGetErrorString(e), grid);
#else
    for (int ph = 0; ph < NPHASE; ++ph) {
        p.ph_lo = ph; p.ph_hi = ph + 1;
        hipLaunchKernelGGL(fwd_megakernel, dim3(grid), dim3(512), LDS_BYTES, stream, p);
    }
#endif
}
```

```cpp
#include <hip/hip_runtime.h>
#include <hip/hip_cooperative_groups.h>
#include <cstdio>
#include <cstdint>
namespace cg = cooperative_groups;

#define LAS __attribute__((address_space(3)))
typedef unsigned short bf16_t;
typedef short bf16x8 __attribute__((ext_vector_type(8)));
typedef float f32x4 __attribute__((ext_vector_type(4)));
typedef float f32x2 __attribute__((ext_vector_type(2)));
typedef unsigned u32x4 __attribute__((ext_vector_type(4)));
typedef unsigned u32x2 __attribute__((ext_vector_type(2)));

constexpr int D = 2048, MP = 8192, MS = 512, MT = 8704;
constexpr int LD0 = 11520, LD1 = 12288, LDU = 11264, DFF = 5632;
constexpr float EPS = 1e-6f;
constexpr size_t O_YP = 0;
constexpr size_t O_YS = O_YP + (size_t)4 * 2048 * 2048;
constexpr size_t O_SSMP = O_YS + (size_t)128 * 4 * 2048;
constexpr size_t O_SSMS = O_SSMP + (size_t)4 * 32 * 128 * 64;
constexpr size_t O_SCP = O_SSMS + (size_t)128 * 32 * 128 * 64;
constexpr size_t O_SCS = O_SCP + (size_t)4 * 3 * 3072;
constexpr size_t O_RETP = O_SCS + (size_t)128 * 3 * 3072;
constexpr size_t O_RETS = O_RETP + (size_t)4 * 8 * 128 * 256;
constexpr size_t O_HGP = O_RETS + (size_t)128 * 8 * 128 * 256;
constexpr size_t O_HGS = O_HGP + (size_t)4 * 16 * 128 * 128;
constexpr size_t O_LRUP = O_HGS + (size_t)128 * 16 * 128 * 128;
constexpr size_t O_LRUS = O_LRUP + (size_t)4 * 2048;
constexpr size_t O_LCP = O_LRUS + (size_t)128 * 2048;
constexpr size_t O_LCS = O_LCP + (size_t)4 * 3 * 2048;
constexpr size_t O_FCP = O_LCS + (size_t)128 * 3 * 2048;
constexpr size_t O_FCS = O_FCP + (size_t)2 * 4 * 2 * 5632;
constexpr size_t O_END = O_FCS + (size_t)2 * 128 * 2 * 5632;
constexpr size_t al256(size_t x) { return (x + 255) & ~(size_t)255; }
constexpr size_t WS_CTL = 0;
constexpr size_t WS_SS = 16384;
constexpr size_t WS_SP = al256(WS_SS + (size_t)5 * MT * 4);
constexpr size_t WS_LB = WS_SP + 8192;
constexpr size_t WS_WIN0 = WS_LB + 8192;
constexpr size_t WS_WOUT0 = WS_WIN0 + (size_t)LD0 * 2048 * 2;
constexpr size_t WS_WUP0 = WS_WOUT0 + (size_t)2048 * 4096 * 2;
constexpr size_t WS_WDN0 = WS_WUP0 + (size_t)LDU * 2048 * 2;
constexpr size_t WS_WIN1 = WS_WDN0 + (size_t)2048 * DFF * 2;
constexpr size_t WS_WOUT1 = WS_WIN1 + (size_t)LD1 * 2048 * 2;
constexpr size_t WS_WUP1 = WS_WOUT1 + (size_t)2048 * 4096 * 2;
constexpr size_t WS_WDN1 = WS_WUP1 + (size_t)LDU * 2048 * 2;
constexpr size_t WS_WLRU = WS_WDN1 + (size_t)2048 * DFF * 2;
constexpr size_t WS_X = WS_WLRU + (size_t)16 * 256 * 256 * 2;
constexpr size_t WS_XB = WS_X + (size_t)MT * 2048 * 4;
constexpr size_t WS_PROJ = WS_XB + (size_t)MT * 2048 * 2;
constexpr size_t WS_ACT = WS_PROJ + (size_t)MT * LD1 * 2;
constexpr size_t WS_YZ = WS_ACT + (size_t)MT * DFF * 2;
constexpr size_t WS_LA = WS_YZ + (size_t)MT * 4096 * 2;
constexpr size_t WS_LBB = WS_LA + (size_t)MT * 2048 * 4;
constexpr size_t WS_XR = WS_LBB + (size_t)MT * 2048 * 2;
constexpr size_t WS_END = WS_XR + (size_t)MT * 2048 * 2;

constexpr int LDS_BYTES = 133120 + 256;
constexpr int NPHASE = 18;

struct Params {
    const float* in[35];
    float* out;
    unsigned char* ws;
    int ph_lo, ph_hi;
    int z, pad;
};

__device__ __forceinline__ float bf2f(unsigned v) { return __uint_as_float(v << 16); }
__device__ __forceinline__ unsigned pk2(float lo, float hi) { unsigned r; asm volatile("v_cvt_pk_bf16_f32 %0, %1, %2" : "=v"(r) : "v"(lo), "v"(hi)); return r; }
__device__ __forceinline__ unsigned pk2_sw(float lo, float hi) {
    unsigned a = __float_as_uint(lo), b = __float_as_uint(hi); a += 0x7fffu + ((a >> 16) & 1u); b += 0x7fffu + ((b >> 16) & 1u); return (a >> 16) | (b & 0xffff0000u); }
__device__ __forceinline__ bf16_t f2bf(float x) { return (bf16_t)(pk2(x, 0.f) & 0xffffu); }
__device__ __forceinline__ float sigm(float x) { return __builtin_amdgcn_rcpf(1.f + __expf(-x)); }
__device__ __forceinline__ float silu(float x) { return x * __builtin_amdgcn_rcpf(1.f + __expf(-x)); }
__device__ __forceinline__ float softplus(float x) { return fmaxf(x, 0.f) + log1pf(__expf(-fabsf(x))); }
__device__ __forceinline__ float gelu_tanh(float x) { const float u = 0.7978845608f * (x + 0.044715f * x * x * x); const float t = 1.f - 2.f * __builtin_amdgcn_rcpf(1.f + __expf(2.f * u)); return 0.5f * x * (1.f + t); }
__device__ __forceinline__ float wave_sum(float v) {
#pragma unroll
    for (int o = 1; o < 64; o <<= 1) v += __shfl_xor(v, o);
    return v;
}
__device__ __forceinline__ void unpack8(u32x4 r, float* f) {
    f[0] = bf2f(r.x & 0xffffu); f[1] = __uint_as_float(r.x & 0xffff0000u); f[2] = bf2f(r.y & 0xffffu); f[3] = __uint_as_float(r.y & 0xffff0000u);
    f[4] = bf2f(r.z & 0xffffu); f[5] = __uint_as_float(r.z & 0xffff0000u); f[6] = bf2f(r.w & 0xffffu); f[7] = __uint_as_float(r.w & 0xffff0000u);
}
__device__ __forceinline__ void unpack4(u32x2 r, float* f) {
    f[0] = bf2f(r.x & 0xffffu); f[1] = __uint_as_float(r.x & 0xffff0000u); f[2] = bf2f(r.y & 0xffffu); f[3] = __uint_as_float(r.y & 0xffff0000u);
}
#define LDS_WAIT() asm volatile("s_waitcnt lgkmcnt(0)" ::: "memory")

namespace pg8 {
constexpr int BM = 256, BK = 64, HALF = 128, HTB = HALF * BK * 2, NXCD = 8, WGM = 8;
__device__ __forceinline__ int lds_byte(int r, int c) { const int st = (r >> 4) * 2 + (c >> 5), rr = r & 15, cc = c & 31, ob = rr * 64 + cc * 2; return st * 1024 + (ob ^ (((ob >> 9) & 1) << 5)); }
__device__ __forceinline__ void stage_rc(int b, int& R, int& C) { const int st = b / 1024, sb = b % 1024, swz = sb ^ (((sb >> 9) & 1) << 5); R = (st >> 1) * 16 + swz / 64; C = (st & 1) * 32 + (swz % 64) / 2; }
__device__ __forceinline__ int perm32(int rho) { const int n = rho >> 4, i = rho & 15; return 8 * (i >> 2) + 4 * n + (i & 3); }

struct Unit { int pm, pn, nt, kind, ks; size_t aoff, boff; };
struct Gemm { const char* A; const char* Bt; int lda, ldb; };
struct Order {
    int nMm, nN, n_main, n_tail, ksplit, nt_full, G, c; size_t a_t, b_t, acol;
    __device__ __forceinline__ bool next(int i, Unit& u) const {
        const long L = (long)i * G + c;
        if (L < n_main) {
            const int nwg = n_main;
            int wgid = (int)L; { const int q = nwg / NXCD, r = nwg % NXCD, xcd = wgid % NXCD, off = wgid / NXCD; wgid = (xcd < r ? xcd * (q + 1) : r * (q + 1) + (xcd - r) * q) + off; }
            const int nig = WGM * nN, gid = wgid / nig, fm = gid * WGM, gsz = (nMm - fm) < WGM ? (nMm - fm) : WGM;
            u.pm = fm + ((wgid % nig) % gsz); u.pn = (wgid % nig) / gsz; u.nt = nt_full; u.kind = 0; u.ks = 0;
            u.aoff = (size_t)u.pm * a_t + (size_t)(u.pn >> 1) * acol; u.boff = (size_t)u.pn * b_t; return true;
        }
        const int Lt = (int)(L - n_main); if (Lt >= n_tail) return false;
        const int ks = Lt % ksplit, r = Lt / ksplit;
        u.pm = nMm + (r & 1); u.pn = r >> 1; u.nt = nt_full / ksplit; u.kind = ksplit > 1 ? 1 : 0; u.ks = ks;
        const size_t kofs = (size_t)ks * u.nt * (BK * 2);
        u.aoff = (size_t)u.pm * a_t + (size_t)(u.pn >> 1) * acol + kofs; u.boff = (size_t)u.pn * b_t + kofs; return true;
    }
};

struct EpiScaleBf16 {
    static constexpr bool PERM = true;
    bf16_t* O; int ldc; const float* ss;
    __device__ __forceinline__ void operator()(const f32x4 (&acc)[2][2][4][2], const Unit& u, int wr, int wc, int fr, int fq) const {
        const int row0 = u.pm * BM + wr * 64 + fr, col0 = u.pn * BM + wc * 32 + 8 * fq;
        float ssv[8];
#pragma unroll
        for (int ai = 0; ai < 2; ++ai)
#pragma unroll
            for (int m = 0; m < 4; ++m) ssv[ai * 4 + m] = ss[row0 + ai * HALF + m * 16];
#pragma unroll
        for (int ai = 0; ai < 2; ++ai)
#pragma unroll
            for (int m = 0; m < 4; ++m) {
                const int row = row0 + ai * HALF + m * 16;
                const float rs = rsqrtf(ssv[ai * 4 + m] * (1.0f / 2048.0f) + EPS);
                bf16_t* rowp = O + ((unsigned)row * (unsigned)ldc + (unsigned)col0);
#pragma unroll
                for (int bj = 0; bj < 2; ++bj) {
                    const f32x4 v0 = acc[ai][bj][m][0] * rs, v1 = acc[ai][bj][m][1] * rs;
                    u32x4 w; w.x = pk2(v0[0], v0[1]); w.y = pk2(v0[2], v0[3]); w.z = pk2(v1[0], v1[1]); w.w = pk2(v1[2], v1[3]);
                    *(u32x4*)(rowp + bj * HALF) = w;
                }
            }
    }
};
struct EpiResid {
    static constexpr bool PERM = false;
    float* X; bf16_t* XB; float* ssout; float* part;
    __device__ __forceinline__ void operator()(const f32x4 (&acc)[2][2][4][2], const Unit& u, int wr, int wc, int fr, int fq) const {
        const int row0 = u.pm * BM + wr * 64 + fr, col0 = u.pn * BM + wc * 32 + 4 * fq;
        if (u.kind == 1) {
            float* P = part + (size_t)u.ks * (512 * 2048);
#pragma unroll
            for (int ai = 0; ai < 2; ++ai)
#pragma unroll
                for (int m = 0; m < 4; ++m) {
                    const unsigned off = (unsigned)(row0 - MP + ai * HALF + m * 16) * 2048u + (unsigned)col0;
#pragma unroll
                    for (int bj = 0; bj < 2; ++bj)
#pragma unroll
                        for (int n = 0; n < 2; ++n) *(f32x4*)(P + off + bj * HALF + n * 16) = acc[ai][bj][m][n];
                }
            return;
        }
#pragma unroll
        for (int ai = 0; ai < 2; ++ai)
#pragma unroll
            for (int mp = 0; mp < 4; mp += 2) {
                f32x4 xin[2][2][2];
#pragma unroll
                for (int mm = 0; mm < 2; ++mm)
#pragma unroll
                    for (int bj = 0; bj < 2; ++bj)
#pragma unroll
                        for (int n = 0; n < 2; ++n) xin[mm][bj][n] = *(const f32x4*)(X + ((unsigned)(row0 + ai * HALF + (mp + mm) * 16) * 2048u + (unsigned)col0 + bj * HALF + n * 16));
#pragma unroll
                for (int mm = 0; mm < 2; ++mm) {
                    const int row = row0 + ai * HALF + (mp + mm) * 16;
                    const unsigned off = (unsigned)row * 2048u + (unsigned)col0;
                    float sq = 0.f;
#pragma unroll
                    for (int bj = 0; bj < 2; ++bj)
#pragma unroll
                        for (int n = 0; n < 2; ++n) {
                            const unsigned o = off + bj * HALF + n * 16;
                            const f32x4 x = xin[mm][bj][n] + acc[ai][bj][mp + mm][n];
                            *(f32x4*)(X + o) = x;
                            u32x2 w; w.x = pk2(x[0], x[1]); w.y = pk2(x[2], x[3]);
                            *(u32x2*)(XB + o) = w;
                            sq += (x[0] * x[0] + x[1] * x[1]) + (x[2] * x[2] + x[3] * x[3]);
                        }
                    sq += __shfl_xor(sq, 16); sq += __shfl_xor(sq, 32);
                    if (fq == 0) atomicAdd(ssout + row, sq);
                }
                asm volatile("" ::: "memory");
            }
    }
};
struct EpiLru {
    static constexpr bool PERM = false;
    const float* br; const float* bi; const float* sp; const bf16_t* XR; float* LA; bf16_t* LBv;
    __device__ __forceinline__ void operator()(const f32x4 (&acc)[2][2][4][2], const Unit& u, int wr, int wc, int fr, int fq) const {
        const int row0 = u.pm * BM + wr * 64 + fr;
        const int cbase = (u.pn >> 1) * 256 + (u.pn & 1) * 128 + wc * 32 + 4 * fq;
        f32x4 br4[2], bi4[2], sp4[2];
#pragma unroll
        for (int n = 0; n < 2; ++n) { br4[n] = *(const f32x4*)(br + cbase + n * 16); bi4[n] = *(const f32x4*)(bi + cbase + n * 16); sp4[n] = *(const f32x4*)(sp + cbase + n * 16); }
#pragma unroll
        for (int ai = 0; ai < 2; ++ai)
#pragma unroll
            for (int mp = 0; mp < 4; mp += 2) {
                u32x2 xrr[2][2];
#pragma unroll
                for (int mm = 0; mm < 2; ++mm)
#pragma unroll
                    for (int n = 0; n < 2; ++n) xrr[mm][n] = *(const u32x2*)(XR + ((unsigned)(row0 + ai * HALF + (mp + mm) * 16) * 2048u + (unsigned)(cbase + n * 16)));
#pragma unroll
                for (int mm = 0; mm < 2; ++mm) {
                    const int row = row0 + ai * HALF + (mp + mm) * 16;
                    const bool first = (row < MP) && ((row & 2047) == 0);
#pragma unroll
                    for (int n = 0; n < 2; ++n) {
                        const unsigned o = (unsigned)row * 2048u + (unsigned)(cbase + n * 16);
                        float xr[4]; unpack4(xrr[mm][n], xr);
                        f32x4 av; float bb[4];
#pragma unroll
                        for (int j = 0; j < 4; ++j) {
                            const float r = sigm(acc[ai][0][mp + mm][n][j] + br4[n][j]), gi = sigm(acc[ai][1][mp + mm][n][j] + bi4[n][j]);
                            const float la = -8.0f * r * sp4[n][j];
                            const float a = __expf(la);
                            const float mult = first ? 1.0f : __builtin_amdgcn_sqrtf(fmaxf(1.0f - a * a, 0.f));
                            av[j] = a; bb[j] = mult * gi * xr[j];
                        }
                        *(f32x4*)(LA + o) = av;
                        u32x2 w; w.x = pk2(bb[0], bb[1]); w.y = pk2(bb[2], bb[3]);
                        *(u32x2*)(LBv + o) = w;
                    }
                }
                asm volatile("" ::: "memory");
            }
    }
};

template <class Epi>
__device__ __forceinline__ void gemm_phase(LAS unsigned char* lds, const Gemm g, const Order& S, const Epi& E) {
    int tid = threadIdx.x; asm volatile("" : "+v"(tid));
    const int wid = __builtin_amdgcn_readfirstlane(tid >> 6), lane = tid & 63, wr = wid >> 2, wc = wid & 3, fr = lane & 15, fq = lane >> 4;
    unsigned voffA[2], voffB[2];
#pragma unroll
    for (int i = 0; i < 2; ++i) { int R, C; stage_rc(tid * 16 + i * 8192, R, C); const int Rb = Epi::PERM ? ((R & ~31) + perm32(R & 31)) : R;
        voffA[i] = (unsigned)(R * g.lda + C) * 2u; voffB[i] = (unsigned)(Rb * g.ldb + C) * 2u; }
    const size_t kstep = (size_t)(BK * 2);
    const size_t hstepA = (size_t)HALF * g.lda * 2, hstepB = (size_t)HALF * g.ldb * 2;
    const unsigned ldsw = (unsigned)wid * 1024u;
    const int aoff = lds_byte(wr * 64 + fr, fq * 8), boff = lds_byte(wc * 32 + fr, fq * 8);
#define PG8_SA(b, h) (((b) * 2 + (h)) * HTB)
#define PG8_SB(b, h) ((4 + (b) * 2 + (h)) * HTB)
#define PG8_STAGE(bufoff, gbase, voff) do { _Pragma("unroll") for (int _i = 0; _i < 2; ++_i) \
        __builtin_amdgcn_global_load_lds((const unsigned*)((const char*)(gbase) + (voff)[_i]), (LAS unsigned*)(lds + (bufoff) + ldsw + _i * 8192), 16, 0, 0); } while (0)
#define PG8_LDA(dst, b, h) do { _Pragma("unroll") for (int m = 0; m < 4; ++m) _Pragma("unroll") for (int k = 0; k < 2; ++k) dst[m][k] = *(const LAS bf16x8*)(lds + PG8_SA(b, h) + aoff + m * 2048 + k * 1024); } while (0)
#define PG8_LDB(dst, b, h) do { _Pragma("unroll") for (int n = 0; n < 2; ++n) _Pragma("unroll") for (int k = 0; k < 2; ++k) dst[n][k] = *(const LAS bf16x8*)(lds + PG8_SB(b, h) + boff + n * 2048 + k * 1024); } while (0)
#define PG8_MMA(ai, bj, At, Bt) do { __builtin_amdgcn_s_setprio(1); _Pragma("unroll") for (int m = 0; m < 4; ++m) _Pragma("unroll") for (int n = 0; n < 2; ++n) _Pragma("unroll") for (int k = 0; k < 2; ++k) \
        acc[ai][bj][m][n] = __builtin_amdgcn_mfma_f32_16x16x32_bf16(Bt[n][k], At[m][k], acc[ai][bj][m][n], 0, 0, 0); __builtin_amdgcn_s_setprio(0); } while (0)
#define PG8_WAIT_V(n) asm volatile("s_waitcnt vmcnt(" #n ")" ::: "memory")
#define PG8_WAIT_L(n) asm volatile("s_waitcnt lgkmcnt(" #n ")" ::: "memory")
#define PG8_BAR __builtin_amdgcn_s_barrier()
#define PG8_SCHED __builtin_amdgcn_sched_barrier(0)
    Unit cur, nxt; int ui = 0;
    if (!S.next(0, cur)) return;
    f32x4 acc[2][2][4][2];
#pragma unroll
    for (int a = 0; a < 2; ++a)
#pragma unroll
        for (int b = 0; b < 2; ++b)
#pragma unroll
            for (int m = 0; m < 4; ++m)
#pragma unroll
                for (int n = 0; n < 2; ++n) acc[a][b][m][n] = (f32x4){0.f, 0.f, 0.f, 0.f};
    bf16x8 At[4][2], B0[2][2], B1[2][2];
    const char* cA = g.A + cur.aoff; const char* cB = g.Bt + cur.boff;
    PG8_STAGE(PG8_SB(0, 0), cB, voffB); PG8_STAGE(PG8_SA(0, 0), cA, voffA); PG8_STAGE(PG8_SB(0, 1), cB + hstepB, voffB); PG8_STAGE(PG8_SA(0, 1), cA + hstepA, voffA);
    if (wr == 1) PG8_BAR;
    PG8_WAIT_V(4); PG8_BAR;
    PG8_STAGE(PG8_SB(1, 0), cB + kstep, voffB); PG8_STAGE(PG8_SA(1, 0), cA + kstep, voffA); PG8_STAGE(PG8_SB(1, 1), cB + hstepB + kstep, voffB);
    PG8_WAIT_V(6); PG8_BAR;
    for (;;) {
        const bool has_next = S.next(ui + 1, nxt);
        const char* nA = has_next ? g.A + nxt.aoff : cA; const char* nB = has_next ? g.Bt + nxt.boff : cB;
        const int nt = cur.nt;
        for (int t = 0; t < nt; t += 2) {
            const bool last = (t == nt - 2);
            const char* a1 = cA + (size_t)(t + 1) * kstep;
            const char* a2 = last ? nA : cA + (size_t)(t + 2) * kstep; const char* b2 = last ? nB : cB + (size_t)(t + 2) * kstep;
            const char* a3 = a2 + kstep; const char* b3 = b2 + kstep;
            PG8_LDB(B0, 0, 0); PG8_SCHED; PG8_LDA(At, 0, 0); PG8_STAGE(PG8_SA(1, 1), a1 + hstepA, voffA);
            PG8_WAIT_L(8); PG8_BAR; PG8_WAIT_L(0); PG8_MMA(0, 0, At, B0); PG8_BAR; PG8_SCHED;
            PG8_LDB(B1, 0, 1); PG8_STAGE(PG8_SB(0, 0), b2, voffB);
            PG8_BAR; PG8_WAIT_L(0); PG8_MMA(0, 1, At, B1); PG8_BAR;
            PG8_LDA(At, 0, 1); PG8_STAGE(PG8_SA(0, 0), a2, voffA);
            PG8_BAR; PG8_WAIT_L(0); PG8_MMA(1, 0, At, B0); PG8_BAR; PG8_SCHED;
            PG8_STAGE(PG8_SB(0, 1), b2 + hstepB, voffB);
            PG8_WAIT_V(6); PG8_BAR; PG8_MMA(1, 1, At, B1); PG8_BAR;
            PG8_LDB(B0, 1, 0); PG8_SCHED; PG8_LDA(At, 1, 0); PG8_STAGE(PG8_SA(0, 1), a2 + hstepA, voffA);
            PG8_WAIT_L(8); PG8_BAR; PG8_WAIT_L(0); PG8_MMA(0, 0, At, B0); PG8_BAR; PG8_SCHED;
            PG8_LDB(B1, 1, 1); PG8_STAGE(PG8_SB(1, 0), b3, voffB);
            PG8_BAR; PG8_WAIT_L(0); PG8_MMA(0, 1, At, B1); PG8_BAR;
            PG8_LDA(At, 1, 1); PG8_STAGE(PG8_SA(1, 0), a3, voffA);
            PG8_BAR; PG8_WAIT_L(0); PG8_MMA(1, 0, At, B0); PG8_BAR; PG8_SCHED;
            PG8_STAGE(PG8_SB(1, 1), b3 + hstepB, voffB);
            PG8_WAIT_V(6); PG8_BAR; PG8_MMA(1, 1, At, B1); PG8_BAR;
        }
        if (wr == 0) PG8_BAR;
        E(acc, cur, wr, wc, fr, fq);
        if (!has_next) break;
#pragma unroll
        for (int a = 0; a < 2; ++a)
#pragma unroll
            for (int b = 0; b < 2; ++b)
#pragma unroll
                for (int m = 0; m < 4; ++m)
#pragma unroll
                    for (int n = 0; n < 2; ++n) acc[a][b][m][n] = (f32x4){0.f, 0.f, 0.f, 0.f};
        cur = nxt; cA = nA; cB = nB; ++ui;
        if (wr == 1) PG8_BAR;
    }
    PG8_WAIT_V(0);
    PG8_BAR;
#undef PG8_SA
#undef PG8_SB
#undef PG8_STAGE
#undef PG8_LDA
#undef PG8_LDB
#undef PG8_MMA
#undef PG8_WAIT_V
#undef PG8_WAIT_L
#undef PG8_BAR
#undef PG8_SCHED
}
}

__device__ __forceinline__ void tr_item(const float* __restrict__ W, int ldw, int N, int k0, int n0, const float* __restrict__ scale, bf16_t* __restrict__ dst, int ldd, float* scr, int lane) {
    const int r4 = lane >> 4, c4 = (lane & 15) * 4;
    const bool inb = (n0 + c4) < N;
    f32x4 v[16];
#pragma unroll
    for (int i = 0; i < 16; ++i) v[i] = inb ? *(const f32x4*)(W + (size_t)(k0 + 4 * i + r4) * ldw + n0 + c4) : (f32x4){0.f, 0.f, 0.f, 0.f};
#pragma unroll
    for (int i = 0; i < 16; ++i) { float* d = scr + (4 * i + r4) * 65 + c4; d[0] = v[i][0]; d[1] = v[i][1]; d[2] = v[i][2]; d[3] = v[i][3]; }
    LDS_WAIT();
    const int c = lane & 7;
    f32x4 s0 = (f32x4){1.f, 1.f, 1.f, 1.f}, s1 = s0;
    if (scale) { s0 = *(const f32x4*)(scale + k0 + 8 * c); s1 = *(const f32x4*)(scale + k0 + 8 * c + 4); }
#pragma unroll
    for (int j = 0; j < 8; ++j) { const int n = (lane >> 3) + 8 * j; const float* sp = scr + (8 * c) * 65 + n;
        u32x4 o; o.x = pk2(sp[0 * 65] * s0[0], sp[1 * 65] * s0[1]); o.y = pk2(sp[2 * 65] * s0[2], sp[3 * 65] * s0[3]); o.z = pk2(sp[4 * 65] * s1[0], sp[5 * 65] * s1[1]); o.w = pk2(sp[6 * 65] * s1[2], sp[7 * 65] * s1[3]);
        *(u32x4*)(dst + (size_t)n * ldd + 8 * c) = o; }
    LDS_WAIT();
}

__device__ __forceinline__ void phase_prologue(const Params& p, float* ldsf) {
    int tid = threadIdx.x; asm volatile("" : "+v"(tid));
    const int wave = tid >> 6, lane = tid & 63;
    const int gw = blockIdx.x * 8 + wave, NGW = gridDim.x * 8;
    float* scr = ldsf + wave * 4160;
    unsigned char* ws = p.ws;
    constexpr int I0 = 32 * 177, I1 = 64 * 32, I2 = 32 * 176, I3 = 88 * 32, I4 = 32 * 192, I5 = I1, I6 = I2, I7 = I3, I8 = 128, I9 = 128;
    constexpr int NIT = I0 + I1 + I2 + I3 + I4 + I5 + I6 + I7 + I8 + I9;
    for (int it = gw; it < NIT; it += NGW) {
        int r = it;
        const float* W; int K, N; const float* sc = nullptr; bf16_t* WT;
        if (r < I0) { W = p.in[12 + p.z]; K = 2048; N = 11296; sc = p.in[9 + p.z]; WT = (bf16_t*)(ws + WS_WIN0); }
        else if ((r -= I0) < I1) { W = p.in[19 + p.z]; K = 4096; N = 2048; WT = (bf16_t*)(ws + WS_WOUT0); }
        else if ((r -= I1) < I2) { W = p.in[31 + p.z]; K = 2048; N = 11264; sc = p.in[10 + p.z]; WT = (bf16_t*)(ws + WS_WUP0); }
        else if ((r -= I2) < I3) { W = p.in[34 + p.z]; K = 5632; N = 2048; WT = (bf16_t*)(ws + WS_WDN0); }
        else if ((r -= I3) < I4) { W = p.in[20 + p.z]; K = 2048; N = 12288; sc = p.in[9 + p.z] + 2048; WT = (bf16_t*)(ws + WS_WIN1); }
        else if ((r -= I4) < I5) { W = p.in[30 + p.z]; K = 4096; N = 2048; WT = (bf16_t*)(ws + WS_WOUT1); }
        else if ((r -= I5) < I6) { W = p.in[31 + p.z] + (size_t)2048 * 11264; K = 2048; N = 11264; sc = p.in[10 + p.z] + 2048; WT = (bf16_t*)(ws + WS_WUP1); }
        else if ((r -= I6) < I7) { W = p.in[34 + p.z] + (size_t)5632 * 2048; K = 5632; N = 2048; WT = (bf16_t*)(ws + WS_WDN1); }
        else {
            r -= I7; const int which = r >> 7; r &= 127;
            const int blk = r >> 4, kb = (r >> 2) & 3, nb = r & 3, n0 = 64 * nb, k0 = 64 * kb;
            const float* Wl = (which ? p.in[27 + p.z] : p.in[25 + p.z]) + (size_t)blk * 65536;
            const int drow = (blk * 2 + (n0 >> 7)) * 256 + which * 128 + (n0 & 127);
            tr_item(Wl, 256, 256, k0, n0, nullptr, (bf16_t*)(ws + WS_WLRU) + (size_t)drow * 256 + k0, 256, scr, lane);
            continue;
        }
        const int nblk = (N + 63) / 64, kbl = r & 7, r8 = r >> 3, nb = r8 % nblk, kb = (r8 / nblk) * 8 + kbl, k0 = 64 * kb, n0 = 64 * nb;
        tr_item(W, N, N, k0, n0, sc, WT + (size_t)n0 * K + k0, K, scr, lane);
    }
    {
        u32x4* z = (u32x4*)((bf16_t*)(ws + WS_WIN0) + (size_t)11296 * 2048);
        const int n16 = 224 * 2048 * 2 / 16;
        for (int i = blockIdx.x * 512 + tid; i < n16; i += gridDim.x * 512) z[i] = (u32x4){0u, 0u, 0u, 0u};
    }
    float* X = (float*)(ws + WS_X); bf16_t* XB = (bf16_t*)(ws + WS_XB); float* ss = (float*)(ws + WS_SS);
    for (int row = gw; row < MT; row += NGW) {
        const float* src = row < MP ? p.in[0 + p.z] + (size_t)row * 2048 : p.in[1 + p.z] + (size_t)(row - MP) * 2048;
        float s = 0.f;
#pragma unroll
        for (int j = 0; j < 8; ++j) {
            const f32x4 v = *(const f32x4*)(src + (lane + 64 * j) * 4);
            *(f32x4*)(X + (size_t)row * 2048 + (lane + 64 * j) * 4) = v;
            u32x2 w; w.x = pk2(v[0], v[1]); w.y = pk2(v[2], v[3]);
            *(u32x2*)(XB + (size_t)row * 2048 + (lane + 64 * j) * 4) = w;
            s += (v[0] * v[0] + v[1] * v[1]) + (v[2] * v[2] + v[3] * v[3]);
        }
        s = wave_sum(s);
        if (lane == 0) ss[row] = s;
    }
    for (int i = blockIdx.x * 512 + tid; i < 4 * MT; i += gridDim.x * 512) ss[MT + i] = 0.f;
    for (int i = blockIdx.x * 512 + tid; i < 2048; i += gridDim.x * 512) {
        ((float*)(ws + WS_SP))[i] = softplus(-p.in[29 + p.z][i]);
        ((float*)(ws + WS_LB))[i] = sigm(p.in[21 + p.z][2048 + i] - p.in[21 + p.z][i]);
    }
}

__device__ __forceinline__ int next_item(unsigned* ctr, float* ldsf) {
    __syncthreads();
    if (threadIdx.x == 0) ((volatile unsigned*)ldsf)[24576] = atomicAdd(ctr, 1u);
    __syncthreads();
    return (int)((volatile unsigned*)ldsf)[24576];
}

template <int TYPE, int VW>
__device__ __forceinline__ void rec_item(const Params& p, float* ldsf, int sample, int b, int h, int s) {
    constexpr int NV = VW / 16;
    typedef float VT __attribute__((ext_vector_type(NV)));
    int tid = threadIdx.x; asm volatile("" : "+v"(tid));
    const int w = tid >> 6, lane = tid & 63, kg = lane >> 4, vq = lane & 15, kb = 16 * w + 4 * kg;
    const int L = sample ? 4 : 2048, row0 = sample ? MP + 4 * b : 2048 * b, pos0 = sample ? 16384 : 0;
    constexpr int LDP = TYPE < 2 ? LD0 : LD1;
    const bf16_t* proj = (const bf16_t*)(p.ws + WS_PROJ) + (size_t)row0 * LDP;
    bf16_t* yz = (bf16_t*)(p.ws + WS_YZ) + (size_t)row0 * 4096;
    float* part = ldsf + 8192;
    int colA = -1, colB = -1, role = -1, didx = 0;
    float w0 = 0.f, w1 = 0.f, w2 = 0.f, w3 = 0.f, cbias = 0.f, c0 = 0.f, c1 = 0.f, c2 = 0.f, aux = 0.f, aux2 = 0.f;
    if constexpr (TYPE == 0) {
        if (tid < 320) {
            role = tid < 128 ? 0 : (tid < 256 ? 1 : 2);
            didx = tid < 128 ? tid : (tid < 256 ? tid - 128 : tid - 256);
            const int ch = tid < 128 ? 2560 + (h >> 3) * 128 + tid : (tid < 256 ? 2048 + (h >> 3) * 128 + (tid - 128) : h * 64 + (tid - 256));
            colA = 2048 + ch;
            const float* cw = p.in[13 + p.z];
            w0 = cw[ch]; w1 = cw[3072 + ch]; w2 = cw[2 * 3072 + ch]; w3 = cw[3 * 3072 + ch]; cbias = p.in[14 + p.z][ch];
            if (sample) { const float* st = p.in[3 + p.z] + (size_t)b * 3 * 3072; c0 = st[ch]; c1 = st[3072 + ch]; c2 = st[2 * 3072 + ch]; }
        } else if (tid < 328) { role = 3; didx = tid - 320; colA = 5120 + h; aux = p.in[15 + p.z][h]; aux2 = -__expf(p.in[16 + p.z][h]); }
    } else if constexpr (TYPE == 1) {
        if (tid < 128) { role = tid < 64 ? 0 : 1; didx = tid & 63; colA = (tid < 64 ? 5152 : 6176) + h * 128 + didx; colB = colA + 64;
            aux = exp2f(-(float)didx * 0.20762050593046014f); }
        else if (tid < 128 + VW) { role = 2; didx = tid - 128; colA = 7200 + h * 256 + s * VW + didx; }
    } else {
        if (tid < 128) { role = 0; didx = tid; colA = h * 128 + tid; }
        else if (tid < 256) { role = 1; didx = tid - 128; colA = 2048 + h * 128 + didx; aux = ((const float*)(p.ws + WS_LB))[h * 128 + didx]; }
        else if (tid < 256 + VW) { role = 2; didx = tid - 256; colA = 4096 + h * 128 + s * VW + didx; }
    }
    const float Dh = TYPE == 0 ? p.in[17 + p.z][h] : 0.f;
    const float gamma = TYPE == 1 ? 1.0f - exp2f(-5.0f - (float)h * (4.0f / 7.0f)) : 0.f;
    const int ldS = TYPE == 0 ? 64 : (TYPE == 1 ? 256 : 128);
    size_t soff;
    if constexpr (TYPE == 0) soff = ((size_t)(b * 32 + h) * 128) * 64;
    else if constexpr (TYPE == 1) soff = ((size_t)(b * 8 + h) * 128) * 256 + s * VW;
    else soff = ((size_t)(b * 16 + h) * 128) * 128 + s * VW;
    const float* S0 = TYPE == 0 ? p.in[2 + p.z] : (TYPE == 1 ? p.in[4 + p.z] : p.in[5 + p.z]);
    float* Sout = p.out + (TYPE == 0 ? (sample ? O_SSMS : O_SSMP) : (TYPE == 1 ? (sample ? O_RETS : O_RETP) : (sample ? O_HGS : O_HGP))) + soff;
    VT S[4];
#pragma unroll
    for (int i = 0; i < 4; ++i) { if (sample) S[i] = *(const VT*)(S0 + soff + (size_t)(kb + i) * ldS + NV * vq); else S[i] = (VT)(0.f); }
    unsigned short ra[8], rb[8]; unsigned short zr = 0;
    const int R = (L + 7) >> 3;
    auto load_raw = [&](int r) {
#pragma unroll
        for (int t = 0; t < 8; ++t) {
            const int tt = 8 * r + t;
            ra[t] = 0; rb[t] = 0;
            if (tt < L) {
                if (colA >= 0) ra[t] = proj[(size_t)tt * LDP + colA];
                if (TYPE == 1 && colB >= 0) rb[t] = proj[(size_t)tt * LDP + colB];
            }
        }
        if (TYPE == 0) { const int tt = 8 * r + w; if (tt < L) zr = proj[(size_t)tt * LDP + h * 64 + lane]; }
    };
    load_raw(0);
    for (int r = 0; r < R; ++r) {
        const int nv = (L - 8 * r) < 8 ? (L - 8 * r) : 8;
        float* stg = ldsf + (r & 1) * 4096;
        float* qs = stg; float* ks = stg + 1024; float* as = stg + 2048; float* vs = stg + 3072; float* ad = stg + 3584;
        if constexpr (TYPE == 0) {
            if (role >= 0 && role < 3) {
                float* dst = role == 0 ? qs : (role == 1 ? ks : vs); const int dstr = role == 2 ? 64 : 128;
#pragma unroll
                for (int t = 0; t < 8; ++t) {
                    const float x = bf2f(ra[t]);
                    const float y = cbias + w0 * c0 + w1 * c1 + w2 * c2 + w3 * x;
                    c0 = c1; c1 = c2; c2 = x;
                    dst[t * dstr + didx] = silu(y);
                }
            } else if (role == 3) {
                float xv = 0.f;
#pragma unroll
                for (int t = 0; t < 8; ++t) if (t == didx) xv = bf2f(ra[t]);
                const float dt = softplus(xv + aux);
                ad[2 * didx] = __expf(dt * aux2); ad[2 * didx + 1] = dt;
            }
        } else if constexpr (TYPE == 1) {
            if (role == 0 || role == 1) {
                float* dst = role == 0 ? qs : ks; const float sc = role == 0 ? 1.0f : 0.08838834764831845f;
#pragma unroll
                for (int t = 0; t < 8; ++t) {
                    const int pos = pos0 + 8 * r + t;
                    const double rev = (double)pos * (double)aux * 0.15915494309189535;
                    const float fr = (float)(rev - floor(rev));
                    const float sn = __builtin_amdgcn_sinf(fr), cs = __builtin_amdgcn_cosf(fr);
                    const float x1 = bf2f(ra[t]) * sc, x2 = bf2f(rb[t]) * sc;
                    dst[t * 128 + didx] = x1 * cs - x2 * sn;
                    dst[t * 128 + 64 + didx] = x1 * sn + x2 * cs;
                }
            } else if (role == 2) {
#pragma unroll
                for (int t = 0; t < 8; ++t) vs[t * VW + didx] = bf2f(ra[t]);
            }
        } else {
            if (role == 0) {
#pragma unroll
                for (int t = 0; t < 8; ++t) qs[t * 128 + didx] = silu(bf2f(ra[t]));
            } else if (role == 1) {
#pragma unroll
                for (int t = 0; t < 8; ++t) { const float f = aux + (1.0f - aux) * sigm(bf2f(ra[t])); as[t * 128 + didx] = f; ks[t * 128 + didx] = 1.0f - f; }
            } else if (role == 2) {
#pragma unroll
                for (int t = 0; t < 8; ++t) vs[t * VW + didx] = bf2f(ra[t]);
            }
        }
        const unsigned short zc = zr;
        __syncthreads();
        if (r + 1 < R) load_raw(r + 1);
        for (int t0 = 0; t0 < nv; t0 += 4) {
#pragma unroll
            for (int tt = 0; tt < 4; ++tt) {
                const int t = t0 + tt;
                const f32x4 q4 = *(const f32x4*)(qs + t * 128 + kb);
                f32x4 k4 = *(const f32x4*)(ks + t * 128 + kb);
                const VT v4 = *(const VT*)(vs + t * VW + NV * vq);
                f32x4 a4;
                if constexpr (TYPE == 0) { const f32x2 adv = *(const f32x2*)(ad + 2 * t); a4 = (f32x4){adv.x, adv.x, adv.x, adv.x}; k4 = k4 * adv.y; }
                else if constexpr (TYPE == 1) a4 = (f32x4){gamma, gamma, gamma, gamma};
                else a4 = *(const f32x4*)(as + t * 128 + kb);
                VT o = (VT)(0.f);
#pragma unroll
                for (int i = 0; i < 4; ++i) { S[i] = a4[i] * S[i] + k4[i] * v4; o += q4[i] * S[i]; }
                *(VT*)(part + ((t * 32 + w * 4 + kg) * VW + NV * vq)) = o;
            }
        }
        __syncthreads();
        const int rt = tid / VW, rv = tid % VW;
        if (tid < 8 * VW && rt < nv) {
            float o = 0.f;
#pragma unroll
            for (int pp = 0; pp < 32; ++pp) o += part[(rt * 32 + pp) * VW + rv];
            const size_t trow = (size_t)(8 * r + rt);
            if constexpr (TYPE == 0) {
                const float y = (o + Dh * vs[rt * 64 + rv]) * silu(bf2f(zc));
                yz[trow * 4096 + h * 64 + rv] = f2bf(y);
            } else if constexpr (TYPE == 1) {
                yz[trow * 4096 + 2048 + h * 256 + s * VW + rv] = f2bf(o);
            } else {
                yz[trow * 4096 + h * 128 + s * VW + rv] = f2bf(o);
            }
        }
    }
#pragma unroll
    for (int i = 0; i < 4; ++i) *(VT*)(Sout + (size_t)(kb + i) * ldS + NV * vq) = S[i];
}

template <int TYPE>
__device__ __forceinline__ void dec_unit(const Params& p, float* ldsf, int b, int u) {
    int tid = threadIdx.x; asm volatile("" : "+v"(tid));
    const int w = tid >> 6, lane = tid & 63, kg = lane >> 4, vq = lane & 15;
    const int row0 = MP + 4 * b;
    constexpr int LDP = TYPE < 2 ? LD0 : LD1;
    const bf16_t* proj = (const bf16_t*)(p.ws + WS_PROJ) + (size_t)row0 * LDP;
    bf16_t* yz = (bf16_t*)(p.ws + WS_YZ) + (size_t)row0 * 4096;
    int h, sl; size_t soff; int ldS;
    if constexpr (TYPE == 0) { h = 8 * u + w; sl = 0; ldS = 64; soff = ((size_t)(b * 32 + h) * 128) * 64; }
    else if constexpr (TYPE == 1) { h = 2 * u + (w >> 2); sl = w & 3; ldS = 256; soff = ((size_t)(b * 8 + h) * 128) * 256 + sl * 64; }
    else { h = 4 * u + (w >> 1); sl = w & 1; ldS = 128; soff = ((size_t)(b * 16 + h) * 128) * 128 + sl * 64; }
    const float* S0 = (TYPE == 0 ? p.in[2 + p.z] : (TYPE == 1 ? p.in[4 + p.z] : p.in[5 + p.z])) + soff + (size_t)(32 * kg) * ldS + 4 * vq;
    float* Sout = p.out + (TYPE == 0 ? O_SSMS : (TYPE == 1 ? O_RETS : O_HGS)) + soff + (size_t)(32 * kg) * ldS + 4 * vq;
    if constexpr (TYPE == 0) {
        float* qs = ldsf; float* ks = ldsf + 512; float* xs = ldsf + 1024; float* zs = ldsf + 3072; float* ad = ldsf + 5120;
        unsigned short xr[2][4]; float cw[2][4], cb[2], st[2][3]; unsigned short zr[4]; unsigned short dr = 0;
#pragma unroll
        for (int q = 0; q < 2; ++q) {
            const int idx = tid + 512 * q;
            if (idx < 768) {
                const int ch = idx < 128 ? 2560 + u * 128 + idx : (idx < 256 ? 2048 + u * 128 + (idx - 128) : u * 512 + (idx - 256));
#pragma unroll
                for (int t = 0; t < 4; ++t) xr[q][t] = proj[(size_t)t * LDP + 2048 + ch];
#pragma unroll
                for (int j = 0; j < 4; ++j) cw[q][j] = p.in[13 + p.z][j * 3072 + ch];
                cb[q] = p.in[14 + p.z][ch];
#pragma unroll
                for (int j = 0; j < 3; ++j) st[q][j] = p.in[3 + p.z][((size_t)b * 3 + j) * 3072 + ch];
            }
        }
#pragma unroll
        for (int t = 0; t < 4; ++t) zr[t] = proj[(size_t)t * LDP + u * 512 + tid];
        if (tid < 32) dr = proj[(size_t)(tid >> 3) * LDP + 5120 + 8 * u + (tid & 7)];
        f32x4 S[32];
#pragma unroll
        for (int i = 0; i < 32; ++i) S[i] = *(const f32x4*)(S0 + (size_t)i * ldS);
#pragma unroll
        for (int q = 0; q < 2; ++q) {
            const int idx = tid + 512 * q;
            if (idx < 768) {
                float* dst = idx < 128 ? qs + idx : (idx < 256 ? ks + (idx - 128) : xs + (idx - 256));
                const int dstr = idx < 256 ? 128 : 512;
                float c0 = st[q][0], c1 = st[q][1], c2 = st[q][2];
#pragma unroll
                for (int t = 0; t < 4; ++t) {
                    const float x = bf2f(xr[q][t]);
                    const float y = cb[q] + cw[q][0] * c0 + cw[q][1] * c1 + cw[q][2] * c2 + cw[q][3] * x;
                    c0 = c1; c1 = c2; c2 = x;
                    dst[t * dstr] = silu(y);
                }
            }
        }
#pragma unroll
        for (int t = 0; t < 4; ++t) zs[t * 512 + tid] = silu(bf2f(zr[t]));
        if (tid < 32) {
            const int hh = 8 * u + (tid & 7);
            const float dt = softplus(bf2f(dr) + p.in[15 + p.z][hh]);
            ad[2 * tid] = __expf(-dt * __expf(p.in[16 + p.z][hh])); ad[2 * tid + 1] = dt;
        }
        __syncthreads();
        const float Dh = p.in[17 + p.z][h];
#pragma unroll 1
        for (int t = 0; t < 4; ++t) {
            const f32x2 adv = *(const f32x2*)(ad + 2 * (t * 8 + w));
            const f32x4 v4 = *(const f32x4*)(xs + t * 512 + w * 64 + 4 * vq);
            f32x4 o = (f32x4){0.f, 0.f, 0.f, 0.f};
#pragma unroll
            for (int i4 = 0; i4 < 8; ++i4) {
                const f32x4 q4 = *(const f32x4*)(qs + t * 128 + 32 * kg + 4 * i4);
                const f32x4 k4 = *(const f32x4*)(ks + t * 128 + 32 * kg + 4 * i4) * adv.y;
#pragma unroll
                for (int ii = 0; ii < 4; ++ii) { S[4 * i4 + ii] = adv.x * S[4 * i4 + ii] + k4[ii] * v4; o += q4[ii] * S[4 * i4 + ii]; }
            }
#pragma unroll
            for (int j = 0; j < 4; ++j) { o[j] += __shfl_xor(o[j], 16); o[j] += __shfl_xor(o[j], 32); }
            if (kg == 0) {
                const f32x4 z4 = *(const f32x4*)(zs + t * 512 + w * 64 + 4 * vq);
                const f32x4 y = (o + Dh * v4) * z4;
                u32x2 ov; ov.x = pk2(y[0], y[1]); ov.y = pk2(y[2], y[3]);
                *(u32x2*)(yz + (size_t)t * 4096 + h * 64 + 4 * vq) = ov;
            }
        }
#pragma unroll
        for (int i = 0; i < 32; ++i) *(f32x4*)(Sout + (size_t)i * ldS) = S[i];
    } else if constexpr (TYPE == 1) {
        float* qs = ldsf; float* ks = ldsf + 1024; float* vs = ldsf + 2048;
        unsigned short x1[4], x2[4], vr[4];
        const int hl = tid >> 7, isk = (tid >> 6) & 1, jf = tid & 63;
        if (tid < 256) {
            const int col = (isk ? 6176 : 5152) + (2 * u + hl) * 128 + jf;
#pragma unroll
            for (int t = 0; t < 4; ++t) { x1[t] = proj[(size_t)t * LDP + col]; x2[t] = proj[(size_t)t * LDP + col + 64]; }
        }
#pragma unroll
        for (int t = 0; t < 4; ++t) vr[t] = proj[(size_t)t * LDP + 7200 + (2 * u + (tid >> 8)) * 256 + (tid & 255)];
        f32x4 S[32];
#pragma unroll
        for (int i = 0; i < 32; ++i) S[i] = *(const f32x4*)(S0 + (size_t)i * ldS);
        if (tid < 256) {
            const float inv = exp2f(-(float)jf * 0.20762050593046014f);
            float* dst = isk ? ks : qs; const float sc = isk ? 0.08838834764831845f : 1.0f;
#pragma unroll
            for (int t = 0; t < 4; ++t) {
                const double rev = (double)(16384 + t) * (double)inv * 0.15915494309189535;
                const float fr = (float)(rev - floor(rev));
                const float sn = __builtin_amdgcn_sinf(fr), cs = __builtin_amdgcn_cosf(fr);
                const float a1 = bf2f(x1[t]) * sc, a2 = bf2f(x2[t]) * sc;
                dst[(t * 2 + hl) * 128 + jf] = a1 * cs - a2 * sn;
                dst[(t * 2 + hl) * 128 + 64 + jf] = a1 * sn + a2 * cs;
            }
        }
#pragma unroll
        for (int t = 0; t < 4; ++t) vs[(t * 2 + (tid >> 8)) * 256 + (tid & 255)] = bf2f(vr[t]);
        __syncthreads();
        const float gamma = 1.0f - exp2f(-5.0f - (float)h * (4.0f / 7.0f));
        const int hw = w >> 2;
#pragma unroll 1
        for (int t = 0; t < 4; ++t) {
            const f32x4 v4 = *(const f32x4*)(vs + (t * 2 + hw) * 256 + sl * 64 + 4 * vq);
            f32x4 o = (f32x4){0.f, 0.f, 0.f, 0.f};
#pragma unroll
            for (int i4 = 0; i4 < 8; ++i4) {
                const f32x4 q4 = *(const f32x4*)(qs + (t * 2 + hw) * 128 + 32 * kg + 4 * i4);
                const f32x4 k4 = *(const f32x4*)(ks + (t * 2 + hw) * 128 + 32 * kg + 4 * i4);
#pragma unroll
                for (int ii = 0; ii < 4; ++ii) { S[4 * i4 + ii] = gamma * S[4 * i4 + ii] + k4[ii] * v4; o += q4[ii] * S[4 * i4 + ii]; }
            }
#pragma unroll
            for (int j = 0; j < 4; ++j) { o[j] += __shfl_xor(o[j], 16); o[j] += __shfl_xor(o[j], 32); }
            if (kg == 0) {
                u32x2 ov; ov.x = pk2(o[0], o[1]); ov.y = pk2(o[2], o[3]);
                *(u32x2*)(yz + (size_t)t * 4096 + 2048 + h * 256 + sl * 64 + 4 * vq) = ov;
            }
        }
#pragma unroll
        for (int i = 0; i < 32; ++i) *(f32x4*)(Sout + (size_t)i * ldS) = S[i];
    } else {
        float* qs = ldsf; float* ks = ldsf + 2048; float* as = ldsf + 4096; float* vs = ldsf + 6144;
        unsigned short qr[4], fr_[4], vr[4];
        const int hl = tid >> 7, kk = tid & 127, col = (4 * u + hl) * 128 + kk;
#pragma unroll
        for (int t = 0; t < 4; ++t) { qr[t] = proj[(size_t)t * LDP + col]; fr_[t] = proj[(size_t)t * LDP + 2048 + col]; vr[t] = proj[(size_t)t * LDP + 4096 + col]; }
        const float lb = ((const float*)(p.ws + WS_LB))[col];
        f32x4 S[32];
#pragma unroll
        for (int i = 0; i < 32; ++i) S[i] = *(const f32x4*)(S0 + (size_t)i * ldS);
#pragma unroll
        for (int t = 0; t < 4; ++t) {
            const int o = (t * 4 + hl) * 128 + kk;
            qs[o] = silu(bf2f(qr[t]));
            const float f = lb + (1.0f - lb) * sigm(bf2f(fr_[t]));
            as[o] = f; ks[o] = 1.0f - f; vs[o] = bf2f(vr[t]);
        }
        __syncthreads();
        const int hw = w >> 1;
#pragma unroll 1
        for (int t = 0; t < 4; ++t) {
            const f32x4 v4 = *(const f32x4*)(vs + (t * 4 + hw) * 128 + sl * 64 + 4 * vq);
            f32x4 o = (f32x4){0.f, 0.f, 0.f, 0.f};
#pragma unroll
            for (int i4 = 0; i4 < 8; ++i4) {
                const int off = (t * 4 + hw) * 128 + 32 * kg + 4 * i4;
                const f32x4 q4 = *(const f32x4*)(qs + off), k4 = *(const f32x4*)(ks + off), a4 = *(const f32x4*)(as + off);
#pragma unroll
                for (int ii = 0; ii < 4; ++ii) { S[4 * i4 + ii] = a4[ii] * S[4 * i4 + ii] + k4[ii] * v4; o += q4[ii] * S[4 * i4 + ii]; }
            }
#pragma unroll
            for (int j = 0; j < 4; ++j) { o[j] += __shfl_xor(o[j], 16); o[j] += __shfl_xor(o[j], 32); }
            if (kg == 0) {
                u32x2 ov; ov.x = pk2(o[0], o[1]); ov.y = pk2(o[2], o[3]);
                *(u32x2*)(yz + (size_t)t * 4096 + h * 128 + sl * 64 + 4 * vq) = ov;
            }
        }
#pragma unroll
        for (int i = 0; i < 32; ++i) *(f32x4*)(Sout + (size_t)i * ldS) = S[i];
    }
}

#define CK_QS 0
#define CK_KS 17408
#define CK_KT 34816
#define CK_VT 53248
#define CK_PS 62464
#define CK_ST 71680
#define CK_CUM 89088
__device__ __forceinline__ bf16x8 ck_frag(const unsigned char* lds, int base, int pitch, int row, int kb, int q) {
    return *(const bf16x8*)(lds + base + row * pitch + (32 * kb + 8 * q) * 2);
}
template <int TYPE>
__device__ __forceinline__ void chunk_item(const Params& p, unsigned char* lds, int b, int h, int s) {
    int tid = threadIdx.x; asm volatile("" : "+v"(tid));
    const int w = tid >> 6, lane = tid & 63, r = lane & 15, q = lane >> 4;
    constexpr int LDP = TYPE < 2 ? LD0 : LD1;
    const bf16_t* proj = (const bf16_t*)(p.ws + WS_PROJ) + (size_t)(2048 * b) * LDP;
    bf16_t* yz = (bf16_t*)(p.ws + WS_YZ) + (size_t)(2048 * b) * 4096;
    const int I = w >> 1, Vn0 = 2 * (w & 1);
    const int c1 = tid & 127, tq = tid >> 7;
    const int cx = tid & 63, tx = tid >> 6;
    const int g = h >> 3;
    float cwC[4], cwB[4], cwX[4], cbC = 0.f, cbB = 0.f, cbX = 0.f, inv = 0.f, dtb = 0.f, Aneg = 0.f, Dh = 0.f;
    int colC = 0, colB = 0, colX = 0;
    if constexpr (TYPE == 0) {
        const int chC = 2560 + g * 128 + c1, chB = 2048 + g * 128 + c1, chX = h * 64 + cx;
        colC = 2048 + chC; colB = 2048 + chB; colX = 2048 + chX;
#pragma unroll
        for (int j = 0; j < 4; ++j) { cwC[j] = p.in[13 + p.z][j * 3072 + chC]; cwB[j] = p.in[13 + p.z][j * 3072 + chB]; cwX[j] = p.in[13 + p.z][j * 3072 + chX]; }
        cbC = p.in[14 + p.z][chC]; cbB = p.in[14 + p.z][chB]; cbX = p.in[14 + p.z][chX];
        dtb = p.in[15 + p.z][h]; Aneg = -__expf(p.in[16 + p.z][h]); Dh = p.in[17 + p.z][h];
    } else if constexpr (TYPE == 1) {
        const int isk = c1 >> 6, jf = c1 & 63;
        colC = (isk ? 6176 : 5152) + h * 128 + jf; colB = colC + 64; colX = 7200 + h * 256 + s * 64 + cx;
        inv = exp2f(-(float)jf * 0.20762050593046014f);
    } else {
        colC = h * 128 + c1; colB = 2048 + h * 128 + c1; colX = 4096 + h * 128 + s * 64 + cx;
        inv = ((const float*)(p.ws + WS_LB))[h * 128 + c1];
    }
    float* cumb = (float*)(lds + CK_CUM);
    if constexpr (TYPE == 1) {
        const float lg = __logf(1.0f - exp2f(-5.0f - (float)h * (4.0f / 7.0f)));
        if (tid < 64) {
#pragma unroll
            for (int bfi = 0; bfi < 2; ++bfi) { float* cb = cumb + bfi * 320; cb[tid] = (tid + 1) * lg; cb[64 + tid] = __expf((tid + 1) * lg); cb[128 + tid] = __expf((63 - tid) * lg); cb[192 + tid] = 1.0f; if (tid == 0) cb[256] = __expf(64.0f * lg); }
        }
    }
    for (int i = tid; i < 17408 / 4; i += 512) ((unsigned*)(lds + CK_ST))[i] = 0u;
    f32x4 Sacc[4];
#pragma unroll
    for (int i = 0; i < 4; ++i) Sacc[i] = (f32x4){0.f, 0.f, 0.f, 0.f};
    unsigned short xc[19], xb[19], xx[11], zr[8], dr = 0;
    auto load_raw = [&](int c) {
        const int t0 = 64 * c;
        if constexpr (TYPE == 0) {
#pragma unroll
            for (int i = 0; i < 19; ++i) { const int t = t0 + 16 * tq - 3 + i; xc[i] = 0; xb[i] = 0; if (t >= 0) { xc[i] = proj[(size_t)t * LDP + colC]; xb[i] = proj[(size_t)t * LDP + colB]; } }
#pragma unroll
            for (int i = 0; i < 11; ++i) { const int t = t0 + 8 * tx - 3 + i; xx[i] = 0; if (t >= 0) xx[i] = proj[(size_t)t * LDP + colX]; }
            if (w == 7) dr = proj[(size_t)(t0 + lane) * LDP + 5120 + h];
#pragma unroll
            for (int vv = 0; vv < 2; ++vv)
#pragma unroll
                for (int jx = 0; jx < 4; ++jx) zr[vv * 4 + jx] = proj[(size_t)(t0 + 16 * I + 4 * q + jx) * LDP + h * 64 + 16 * (Vn0 + vv) + r];
        } else {
#pragma unroll
            for (int i = 0; i < 16; ++i) { const int t = t0 + 16 * tq + i; xc[i] = proj[(size_t)t * LDP + colC]; xb[i] = proj[(size_t)t * LDP + colB]; }
#pragma unroll
            for (int i = 0; i < 8; ++i) xx[i] = proj[(size_t)(t0 + 8 * tx + i) * LDP + colX];
        }
    };
    load_raw(0);
    for (int c = 0; c < 32; ++c) {
        const int t0 = 64 * c;
        float* cum = cumb + (TYPE == 0 ? (c & 1) * 320 : 0);
        float vq_[16], vk_[16], vx_[8], kt_[16], Eval = 0.f;
        (void)kt_; (void)Eval;
        if constexpr (TYPE == 0) {
#pragma unroll
            for (int i = 0; i < 16; ++i) {
                vq_[i] = silu(cbC + cwC[0] * bf2f(xc[i]) + cwC[1] * bf2f(xc[i + 1]) + cwC[2] * bf2f(xc[i + 2]) + cwC[3] * bf2f(xc[i + 3]));
                vk_[i] = silu(cbB + cwB[0] * bf2f(xb[i]) + cwB[1] * bf2f(xb[i + 1]) + cwB[2] * bf2f(xb[i + 2]) + cwB[3] * bf2f(xb[i + 3]));
            }
#pragma unroll
            for (int i = 0; i < 8; ++i) vx_[i] = silu(cbX + cwX[0] * bf2f(xx[i]) + cwX[1] * bf2f(xx[i + 1]) + cwX[2] * bf2f(xx[i + 2]) + cwX[3] * bf2f(xx[i + 3]));
            if (w == 7) {
                const float dt = softplus(bf2f(dr) + dtb);
                float cs = dt * Aneg;
#pragma unroll
                for (int o = 1; o < 64; o <<= 1) { const float t = __shfl_up(cs, o); if (lane >= o) cs += t; }
                const float last = __shfl(cs, 63);
                cum[lane] = cs; cum[64 + lane] = __expf(cs); cum[128 + lane] = __expf(last - cs); cum[192 + lane] = dt;
                if (lane == 0) cum[256] = __expf(last);
            }
        } else if constexpr (TYPE == 2) {
            float lc[16], om[16];
            float run = 0.f;
#pragma unroll
            for (int i = 0; i < 16; ++i) { const float f = inv + (1.0f - inv) * sigm(bf2f(xb[i])); run += __logf(f); lc[i] = run; om[i] = 1.0f - f; }
#pragma unroll
            for (int i = 0; i < 16; ++i) { vq_[i] = silu(bf2f(xc[i])) * __expf(lc[i]); vk_[i] = om[i] * __expf(-lc[i]); kt_[i] = om[i] * __expf(run - lc[i]); }
            Eval = __expf(run);
#pragma unroll
            for (int i = 0; i < 8; ++i) vx_[i] = bf2f(xx[i]);
        } else {
#pragma unroll
            for (int i = 0; i < 16; ++i) {
                const double rev = (double)(t0 + 16 * tq + i) * (double)inv * 0.15915494309189535;
                const float fr = (float)(rev - floor(rev));
                const float sn = __builtin_amdgcn_sinf(fr), cs = __builtin_amdgcn_cosf(fr);
                const float a1 = bf2f(xc[i]), a2 = bf2f(xb[i]);
                vq_[i] = a1 * cs - a2 * sn; vk_[i] = a1 * sn + a2 * cs;
            }
#pragma unroll
            for (int i = 0; i < 8; ++i) vx_[i] = bf2f(xx[i]);
        }
        unsigned short zc[8];
#pragma unroll
        for (int i = 0; i < 8; ++i) zc[i] = zr[i];
        __syncthreads();
        if constexpr (TYPE == 0) {
            unsigned kt[8];
#pragma unroll
            for (int i = 0; i < 16; i += 2) {
                const int t = 16 * tq + i;
                const float k0 = vk_[i] * cum[192 + t], k1 = vk_[i + 1] * cum[192 + t + 1];
                *(bf16_t*)(lds + CK_QS + t * 272 + c1 * 2) = f2bf(vq_[i]); *(bf16_t*)(lds + CK_QS + (t + 1) * 272 + c1 * 2) = f2bf(vq_[i + 1]);
                *(bf16_t*)(lds + CK_KS + t * 272 + c1 * 2) = f2bf(k0); *(bf16_t*)(lds + CK_KS + (t + 1) * 272 + c1 * 2) = f2bf(k1);
                kt[i >> 1] = pk2(k0 * cum[128 + t], k1 * cum[128 + t + 1]);
            }
            *(u32x4*)(lds + CK_KT + c1 * 144 + 32 * tq) = (u32x4){kt[0], kt[1], kt[2], kt[3]};
            *(u32x4*)(lds + CK_KT + c1 * 144 + 32 * tq + 16) = (u32x4){kt[4], kt[5], kt[6], kt[7]};
        } else if constexpr (TYPE == 2) {
            unsigned kt[8];
#pragma unroll
            for (int i = 0; i < 16; i += 2) {
                const int t = 16 * tq + i;
                *(bf16_t*)(lds + CK_QS + t * 272 + c1 * 2) = f2bf(vq_[i]); *(bf16_t*)(lds + CK_QS + (t + 1) * 272 + c1 * 2) = f2bf(vq_[i + 1]);
                *(bf16_t*)(lds + CK_KS + t * 272 + c1 * 2) = f2bf(vk_[i]); *(bf16_t*)(lds + CK_KS + (t + 1) * 272 + c1 * 2) = f2bf(vk_[i + 1]);
                kt[i >> 1] = pk2(kt_[i], kt_[i + 1]);
            }
            *(u32x4*)(lds + CK_KT + c1 * 144 + 32 * tq) = (u32x4){kt[0], kt[1], kt[2], kt[3]};
            *(u32x4*)(lds + CK_KT + c1 * 144 + 32 * tq + 16) = (u32x4){kt[4], kt[5], kt[6], kt[7]};
            cum[tq * 128 + c1] = Eval;
        } else {
            const int isk = c1 >> 6, jf = c1 & 63;
            if (isk == 0) {
#pragma unroll
                for (int i = 0; i < 16; ++i) { const int t = 16 * tq + i; *(bf16_t*)(lds + CK_QS + t * 272 + jf * 2) = f2bf(vq_[i]); *(bf16_t*)(lds + CK_QS + t * 272 + (jf + 64) * 2) = f2bf(vk_[i]); }
            } else {
                unsigned kta[8], ktb[8];
#pragma unroll
                for (int i = 0; i < 16; i += 2) {
                    const int t = 16 * tq + i;
                    const float a0 = vq_[i] * 0.08838834764831845f, a1 = vq_[i + 1] * 0.08838834764831845f, b0 = vk_[i] * 0.08838834764831845f, b1 = vk_[i + 1] * 0.08838834764831845f;
                    *(bf16_t*)(lds + CK_KS + t * 272 + jf * 2) = f2bf(a0); *(bf16_t*)(lds + CK_KS + (t + 1) * 272 + jf * 2) = f2bf(a1);
                    *(bf16_t*)(lds + CK_KS + t * 272 + (jf + 64) * 2) = f2bf(b0); *(bf16_t*)(lds + CK_KS + (t + 1) * 272 + (jf + 64) * 2) = f2bf(b1);
                    kta[i >> 1] = pk2(a0 * cum[128 + t], a1 * cum[128 + t + 1]); ktb[i >> 1] = pk2(b0 * cum[128 + t], b1 * cum[128 + t + 1]);
                }
                *(u32x4*)(lds + CK_KT + jf * 144 + 32 * tq) = (u32x4){kta[0], kta[1], kta[2], kta[3]};
                *(u32x4*)(lds + CK_KT + jf * 144 + 32 * tq + 16) = (u32x4){kta[4], kta[5], kta[6], kta[7]};
                *(u32x4*)(lds + CK_KT + (jf + 64) * 144 + 32 * tq) = (u32x4){ktb[0], ktb[1], ktb[2], ktb[3]};
                *(u32x4*)(lds + CK_KT + (jf + 64) * 144 + 32 * tq + 16) = (u32x4){ktb[4], ktb[5], ktb[6], ktb[7]};
            }
        }
        *(u32x4*)(lds + CK_VT + cx * 144 + 16 * tx) = (u32x4){pk2(vx_[0], vx_[1]), pk2(vx_[2], vx_[3]), pk2(vx_[4], vx_[5]), pk2(vx_[6], vx_[7])};
        __syncthreads();
        if (c + 1 < 32) load_raw(c + 1);
        if constexpr (TYPE < 2) {
        bf16x8 aQ[4];
#pragma unroll
        for (int kb = 0; kb < 4; ++kb) aQ[kb] = ck_frag(lds, CK_QS, 272, 16 * I + r, kb, q);
        float cumi[4];
#pragma unroll
        for (int jx = 0; jx < 4; ++jx) cumi[jx] = cum[16 * I + 4 * q + jx];
#pragma unroll
        for (int jj = 0; jj < 2; ++jj) {
            const int J = Vn0 + jj;
            f32x4 acc = (f32x4){0.f, 0.f, 0.f, 0.f};
#pragma unroll
            for (int kb = 0; kb < 4; ++kb) acc = __builtin_amdgcn_mfma_f32_16x16x32_bf16(aQ[kb], ck_frag(lds, CK_KS, 272, 16 * J + r, kb, q), acc, 0, 0, 0);
            const int jcol = 16 * J + r; const float cumj = cum[jcol];
#pragma unroll
            for (int jx = 0; jx < 4; ++jx) {
                const int i = 16 * I + 4 * q + jx;
                const float v = (jcol <= i) ? acc[jx] * __expf(fminf(cumi[jx] - cumj, 0.f)) : 0.f;
                *(bf16_t*)(lds + CK_PS + i * 144 + jcol * 2) = f2bf(v);
            }
        }
        __syncthreads();
#pragma unroll
        for (int vv = 0; vv < 2; ++vv) {
            const int Vn = Vn0 + vv;
            f32x4 aPV = (f32x4){0.f, 0.f, 0.f, 0.f}, aQS = (f32x4){0.f, 0.f, 0.f, 0.f};
#pragma unroll
            for (int jb = 0; jb < 2; ++jb) aPV = __builtin_amdgcn_mfma_f32_16x16x32_bf16(ck_frag(lds, CK_PS, 144, 16 * I + r, jb, q), ck_frag(lds, CK_VT, 144, 16 * Vn + r, jb, q), aPV, 0, 0, 0);
#pragma unroll
            for (int kb = 0; kb < 4; ++kb) aQS = __builtin_amdgcn_mfma_f32_16x16x32_bf16(aQ[kb], ck_frag(lds, CK_ST, 272, 16 * Vn + r, kb, q), aQS, 0, 0, 0);
#pragma unroll
            for (int jx = 0; jx < 4; ++jx) {
                const int i = 16 * I + 4 * q + jx, v = 16 * Vn + r;
                const float o = aPV[jx] + cum[64 + i] * aQS[jx];
                if constexpr (TYPE == 0) {
                    const float xsv = bf2f(*(const bf16_t*)(lds + CK_VT + v * 144 + i * 2));
                    yz[(size_t)(t0 + i) * 4096 + h * 64 + v] = f2bf((o + Dh * xsv) * silu(bf2f(zc[vv * 4 + jx])));
                } else {
                    yz[(size_t)(t0 + i) * 4096 + 2048 + h * 256 + s * 64 + v] = f2bf(o);
                }
            }
        }
        __syncthreads();
        const float elast = cum[256];
#pragma unroll
        for (int Vn = 0; Vn < 4; ++Vn) {
            Sacc[Vn] = Sacc[Vn] * elast;
#pragma unroll
            for (int tb = 0; tb < 2; ++tb) Sacc[Vn] = __builtin_amdgcn_mfma_f32_16x16x32_bf16(ck_frag(lds, CK_KT, 144, 16 * w + r, tb, q), ck_frag(lds, CK_VT, 144, 16 * Vn + r, tb, q), Sacc[Vn], 0, 0, 0);
            *(u32x2*)(lds + CK_ST + (16 * Vn + r) * 272 + (16 * w + 4 * q) * 2) = (u32x2){pk2_sw(Sacc[Vn][0], Sacc[Vn][1]), pk2_sw(Sacc[Vn][2], Sacc[Vn][3])};
        }
            } else {
            const bf16x8 zf = (bf16x8){0, 0, 0, 0, 0, 0, 0, 0};
            if ((w & 1) == 0) {
                f32x4 acc = (f32x4){0.f, 0.f, 0.f, 0.f};
#pragma unroll
                for (int kb = 0; kb < 4; ++kb) acc = __builtin_amdgcn_mfma_f32_16x16x32_bf16(ck_frag(lds, CK_QS, 272, 16 * I + r, kb, q), ck_frag(lds, CK_KS, 272, 16 * I + r, kb, q), acc, 0, 0, 0);
#pragma unroll
                for (int jx = 0; jx < 4; ++jx) {
                    const float v = (r <= 4 * q + jx) ? acc[jx] : 0.f;
                    *(bf16_t*)(lds + CK_PS + (16 * I + 4 * q + jx) * 144 + (16 * I + r) * 2) = f2bf(v);
                }
            }
            __syncthreads();
#pragma unroll 1
            for (int sc = 0; sc < 4; ++sc) {
                if (w < 4) {
                    const int Vn = w;
                    f32x4 aO = (f32x4){0.f, 0.f, 0.f, 0.f};
                    const bf16x8 pa = (q < 2) ? *(const bf16x8*)(lds + CK_PS + (16 * sc + r) * 144 + (16 * sc + 8 * q) * 2) : zf;
                    const bf16x8 vb = (q < 2) ? *(const bf16x8*)(lds + CK_VT + (16 * Vn + r) * 144 + (16 * sc + 8 * q) * 2) : zf;
                    aO = __builtin_amdgcn_mfma_f32_16x16x32_bf16(pa, vb, aO, 0, 0, 0);
#pragma unroll
                    for (int kb = 0; kb < 4; ++kb) aO = __builtin_amdgcn_mfma_f32_16x16x32_bf16(ck_frag(lds, CK_QS, 272, 16 * sc + r, kb, q), ck_frag(lds, CK_ST, 272, 16 * Vn + r, kb, q), aO, 0, 0, 0);
#pragma unroll
                    for (int jx = 0; jx < 4; ++jx) yz[(size_t)(t0 + 16 * sc + 4 * q + jx) * 4096 + h * 128 + s * 64 + 16 * Vn + r] = (bf16_t)(pk2_sw(aO[jx], 0.f) & 0xffffu);
                }
                __syncthreads();
                {
                    const f32x4 e4 = *(const f32x4*)(cum + sc * 128 + 16 * w + 4 * q);
                    const bf16x8 ka = (q < 2) ? *(const bf16x8*)(lds + CK_KT + (16 * w + r) * 144 + (16 * sc + 8 * q) * 2) : zf;
#pragma unroll
                    for (int Vn = 0; Vn < 4; ++Vn) {
                        const bf16x8 vb = (q < 2) ? *(const bf16x8*)(lds + CK_VT + (16 * Vn + r) * 144 + (16 * sc + 8 * q) * 2) : zf;
                        Sacc[Vn] = __builtin_amdgcn_mfma_f32_16x16x32_bf16(ka, vb, Sacc[Vn] * e4, 0, 0, 0);
                        *(u32x2*)(lds + CK_ST + (16 * Vn + r) * 272 + (16 * w + 4 * q) * 2) = (u32x2){pk2_sw(Sacc[Vn][0], Sacc[Vn][1]), pk2_sw(Sacc[Vn][2], Sacc[Vn][3])};
                    }
                }
                __syncthreads();
            }
        }
    }
    const int ldS = TYPE == 0 ? 64 : (TYPE == 1 ? 256 : 128);
    float* Sout = p.out + (TYPE == 0 ? O_SSMP + ((size_t)(b * 32 + h) * 128) * 64 : (TYPE == 1 ? O_RETP + ((size_t)(b * 8 + h) * 128) * 256 + s * 64 : O_HGP + ((size_t)(b * 16 + h) * 128) * 128 + s * 64));
#pragma unroll
    for (int Vn = 0; Vn < 4; ++Vn)
#pragma unroll
        for (int jx = 0; jx < 4; ++jx) Sout[(size_t)(16 * w + 4 * q + jx) * ldS + 16 * Vn + r] = Sacc[Vn][jx];
}

__device__ __forceinline__ void lru_dec_unit(const Params& p, int b) {
    int tid = threadIdx.x; asm volatile("" : "+v"(tid));
    const int c = tid * 4;
    const int row0 = MP + 4 * b;
    const float* LA = (const float*)(p.ws + WS_LA) + (size_t)row0 * 2048 + c;
    const bf16_t* LBv = (const bf16_t*)(p.ws + WS_LBB) + (size_t)row0 * 2048 + c;
    const bf16_t* rg = (const bf16_t*)(p.ws + WS_PROJ) + (size_t)row0 * LD1 + 10240 + c;
    bf16_t* mixa = (bf16_t*)(p.ws + WS_ACT) + (size_t)row0 * 4096 + 2048 + c;
    f32x4 hst = *(const f32x4*)(p.in[6 + p.z] + (size_t)b * 2048 + c);
#pragma unroll
    for (int t = 0; t < 4; ++t) {
        const f32x4 a = *(const f32x4*)(LA + (size_t)t * 2048);
        float bb[4], gg[4]; unpack4(*(const u32x2*)(LBv + (size_t)t * 2048), bb); unpack4(*(const u32x2*)(rg + (size_t)t * LD1), gg);
        float y[4];
#pragma unroll
        for (int j = 0; j < 4; ++j) { hst[j] = a[j] * hst[j] + bb[j]; y[j] = hst[j] * gelu_tanh(gg[j]); }
        u32x2 ov; ov.x = pk2(y[0], y[1]); ov.y = pk2(y[2], y[3]);
        *(u32x2*)(mixa + (size_t)t * 4096) = ov;
    }
    *(f32x4*)(p.out + O_LRUS + (size_t)b * 2048 + c) = hst;
}

__device__ __forceinline__ void lru_scan_item(const Params& p, float* ldsf, int b, int cg) {
    int tid = threadIdx.x; asm volatile("" : "+v"(tid));
    const int w = tid >> 6, lane = tid & 63, c = cg * 64 + lane;
    const size_t row0 = (size_t)2048 * b + 256 * w;
    const float* LA = (const float*)(p.ws + WS_LA) + row0 * 2048 + c;
    const bf16_t* LBv = (const bf16_t*)(p.ws + WS_LBB) + row0 * 2048 + c;
    const bf16_t* rg = (const bf16_t*)(p.ws + WS_PROJ) + row0 * LD1 + 10240 + c;
    bf16_t* mixa = (bf16_t*)(p.ws + WS_ACT) + row0 * 4096 + 2048 + c;
    float hl = 0.f, pr = 1.f;
    for (int tb = 0; tb < 256; tb += 16) {
        float a0[16]; unsigned short b0[16];
#pragma unroll
        for (int t = 0; t < 16; ++t) { a0[t] = LA[(size_t)(tb + t) * 2048]; b0[t] = LBv[(size_t)(tb + t) * 2048]; }
#pragma unroll
        for (int t = 0; t < 16; ++t) { hl = a0[t] * hl + bf2f(b0[t]); pr *= a0[t]; }
    }
    ldsf[w * 128 + lane] = pr; ldsf[w * 128 + 64 + lane] = hl;
    __syncthreads();
    float hst = 0.f;
    for (int ww = 0; ww < w; ++ww) hst = ldsf[ww * 128 + lane] * hst + ldsf[ww * 128 + 64 + lane];
    for (int tb = 0; tb < 256; tb += 16) {
        float a0[16]; unsigned short b0[16], g0[16];
#pragma unroll
        for (int t = 0; t < 16; ++t) { a0[t] = LA[(size_t)(tb + t) * 2048]; b0[t] = LBv[(size_t)(tb + t) * 2048]; g0[t] = rg[(size_t)(tb + t) * LD1]; }
#pragma unroll
        for (int t = 0; t < 16; ++t) {
            hst = a0[t] * hst + bf2f(b0[t]);
            mixa[(size_t)(tb + t) * 4096] = f2bf(hst * gelu_tanh(bf2f(g0[t])));
        }
    }
    if (w == 7) p.out[O_LRUP + (size_t)b * 2048 + c] = hst;
}

__device__ __forceinline__ void phase_rec0(const Params& p, float* ldsf) {
    unsigned* ctr = (unsigned*)(p.ws + WS_CTL);
    const int total = 256 + 512 + 512;
    for (;;) {
        const int it = next_item(ctr, ldsf);
        if (it >= total) break;
        if (it < 128) chunk_item<0>(p, (unsigned char*)ldsf, it >> 5, it & 31, 0);
        else if (it < 256) { const int j = it - 128; chunk_item<1>(p, (unsigned char*)ldsf, j >> 5, (j & 31) >> 2, j & 3); }
        else if (it < 768) { const int j = it - 256; dec_unit<0>(p, ldsf, j >> 2, j & 3); }
        else { const int j = it - 768; dec_unit<1>(p, ldsf, j >> 2, j & 3); }
    }
}
__device__ __forceinline__ void phase_rec1(const Params& p, float* ldsf) {
    unsigned* ctr = (unsigned*)(p.ws + WS_CTL) + 64;
    const int total = 128 + 128 + 512 + 128;
    for (;;) {
        const int it = next_item(ctr, ldsf);
        if (it >= total) break;
        if (it < 128) chunk_item<2>(p, (unsigned char*)ldsf, it >> 5, (it & 31) >> 1, it & 1);
        else if (it < 256) { const int j = it - 128; lru_scan_item(p, ldsf, j >> 5, j & 31); }
        else if (it < 768) { const int j = it - 256; dec_unit<2>(p, ldsf, j >> 2, j & 3); }
        else lru_dec_unit(p, it - 768);
    }
}

__device__ __forceinline__ void seq_of_row(int row, int& sample, int& b, int& t, int& L) {
    if (row < MP) { sample = 0; b = row >> 11; t = row & 2047; L = 2048; } else { sample = 1; b = (row - MP) >> 2; t = (row - MP) & 3; L = 4; }
}

__device__ __forceinline__ void phase_prep0(const Params& p) {
    int tid = threadIdx.x; asm volatile("" : "+v"(tid));
    const int wave = tid >> 6, lane = tid & 63;
    const int gw = blockIdx.x * 8 + wave, NGW = gridDim.x * 8;
    const bf16_t* YZ = (const bf16_t*)(p.ws + WS_YZ); const bf16_t* PR = (const bf16_t*)(p.ws + WS_PROJ);
    bf16_t* MX = (bf16_t*)(p.ws + WS_ACT);
    const float* nw = p.in[18 + p.z];
    for (int row = gw; row < MT; row += NGW) {
        const bf16_t* yz = YZ + (size_t)row * 4096; bf16_t* mx = MX + (size_t)row * 4096;
        u32x4 ya[4]; u32x2 yb[8], gb[8];
#pragma unroll
        for (int g = 0; g < 4; ++g) ya[g] = *(const u32x4*)(yz + g * 512 + lane * 8);
#pragma unroll
        for (int hh = 0; hh < 8; ++hh) { yb[hh] = *(const u32x2*)(yz + 2048 + hh * 256 + lane * 4); gb[hh] = *(const u32x2*)(PR + (size_t)row * LD0 + 9248 + hh * 256 + lane * 4); }
#pragma unroll
        for (int g = 0; g < 4; ++g) {
            const int c = g * 512 + lane * 8;
            float v[8]; unpack8(ya[g], v);
            float s = 0.f;
#pragma unroll
            for (int j = 0; j < 8; ++j) s += v[j] * v[j];
            s = wave_sum(s);
            const float rs = rsqrtf(s * (1.0f / 512.0f) + EPS);
            const f32x4 n0 = *(const f32x4*)(nw + c), n1 = *(const f32x4*)(nw + c + 4);
            u32x4 o; o.x = pk2(v[0] * rs * n0[0], v[1] * rs * n0[1]); o.y = pk2(v[2] * rs * n0[2], v[3] * rs * n0[3]);
            o.z = pk2(v[4] * rs * n1[0], v[5] * rs * n1[1]); o.w = pk2(v[6] * rs * n1[2], v[7] * rs * n1[3]);
            *(u32x4*)(mx + c) = o;
        }
#pragma unroll
        for (int hh = 0; hh < 8; ++hh) {
            const int c = hh * 256 + lane * 4;
            float v[4]; unpack4(yb[hh], v);
            float gt[4]; unpack4(gb[hh], gt);
            float s = (v[0] * v[0] + v[1] * v[1]) + (v[2] * v[2] + v[3] * v[3]);
            s = wave_sum(s);
            const float rs = rsqrtf(s * (1.0f / 256.0f) + EPS);
            u32x2 o; o.x = pk2(v[0] * rs * silu(gt[0]), v[1] * rs * silu(gt[1])); o.y = pk2(v[2] * rs * silu(gt[2]), v[3] * rs * silu(gt[3]));
            *(u32x2*)(mx + 2048 + c) = o;
        }
        int sample, b, t, L; seq_of_row(row, sample, b, t, L);
        if (t >= L - 3) {
            float* dst = p.out + (sample ? O_SCS : O_SCP) + ((size_t)b * 3 + (t - (L - 3))) * 3072;
            const bf16_t* src = PR + (size_t)row * LD0 + 2048;
#pragma unroll 4
            for (int c = lane; c < 3072; c += 64) dst[c] = bf2f(src[c]);
        }
    }
}

__device__ __forceinline__ void phase_prep1(const Params& p) {
    int tid = threadIdx.x; asm volatile("" : "+v"(tid));
    const int wave = tid >> 6, lane = tid & 63;
    const int gw = blockIdx.x * 8 + wave, NGW = gridDim.x * 8;
    const bf16_t* YZ = (const bf16_t*)(p.ws + WS_YZ); const bf16_t* PR = (const bf16_t*)(p.ws + WS_PROJ);
    bf16_t* MX = (bf16_t*)(p.ws + WS_ACT);
    const float* nw = p.in[22 + p.z];
    for (int row = gw; row < MT; row += NGW) {
        u32x4 ya[4], ga[4];
#pragma unroll
        for (int it = 0; it < 4; ++it) { ya[it] = *(const u32x4*)(YZ + (size_t)row * 4096 + it * 512 + lane * 8); ga[it] = *(const u32x4*)(PR + (size_t)row * LD1 + 6144 + it * 512 + lane * 8); }
#pragma unroll
        for (int it = 0; it < 4; ++it) {
            const int c = it * 512 + lane * 8;
            float v[8]; unpack8(ya[it], v);
            float gt[8]; unpack8(ga[it], gt);
            float s = 0.f;
#pragma unroll
            for (int j = 0; j < 8; ++j) s += v[j] * v[j];
            s += __shfl_xor(s, 1); s += __shfl_xor(s, 2); s += __shfl_xor(s, 4); s += __shfl_xor(s, 8);
            const float rs = rsqrtf(s * (1.0f / 128.0f) + EPS);
            const f32x4 n0 = *(const f32x4*)(nw + (c & 127)), n1 = *(const f32x4*)(nw + (c & 127) + 4);
            float o[8];
#pragma unroll
            for (int j = 0; j < 8; ++j) o[j] = v[j] * rs * (j < 4 ? n0[j] : n1[j - 4]) * silu(gt[j]);
            u32x4 ov; ov.x = pk2(o[0], o[1]); ov.y = pk2(o[2], o[3]); ov.z = pk2(o[4], o[5]); ov.w = pk2(o[6], o[7]);
            *(u32x4*)(MX + (size_t)row * 4096 + c) = ov;
        }
    }
}

__device__ __forceinline__ void phase_act(const Params& p, int l) {
    int tid = threadIdx.x; asm volatile("" : "+v"(tid));
    const bf16_t* PR = (const bf16_t*)(p.ws + WS_PROJ); bf16_t* ACT = (bf16_t*)(p.ws + WS_ACT);
    const float* cw = p.in[32 + p.z] + (size_t)l * 3 * DFF; const float* cbv = p.in[33 + p.z] + (size_t)l * DFF;
    const float* st = p.in[8 + p.z] + (size_t)l * 128 * 2 * DFF;
    const int total = (MT / 4) * 704;
    for (int idx = blockIdx.x * 512 + tid; idx < total; idx += gridDim.x * 512) {
        const int rb = idx / 704, c = (idx - rb * 704) * 8, r0 = rb * 4;
        int sample, b, t0, L; seq_of_row(r0, sample, b, t0, L);
        u32x4 gr[6], ur[4];
#pragma unroll
        for (int i = 0; i < 4; ++i) { gr[i + 2] = *(const u32x4*)(PR + (size_t)(r0 + i) * LDU + c); ur[i] = *(const u32x4*)(PR + (size_t)(r0 + i) * LDU + DFF + c); }
        float g[6][8];
        if (t0 >= 2) { gr[0] = *(const u32x4*)(PR + (size_t)(r0 - 2) * LDU + c); gr[1] = *(const u32x4*)(PR + (size_t)(r0 - 1) * LDU + c); unpack8(gr[0], g[0]); unpack8(gr[1], g[1]); }
        else {
#pragma unroll
            for (int j = 0; j < 8; ++j) { g[0][j] = sample ? st[((size_t)b * 2 + 0) * DFF + c + j] : 0.f; g[1][j] = sample ? st[((size_t)b * 2 + 1) * DFF + c + j] : 0.f; }
        }
#pragma unroll
        for (int i = 0; i < 4; ++i) unpack8(gr[i + 2], g[i + 2]);
        float w0[8], w1[8], w2[8], bb[8];
#pragma unroll
        for (int j = 0; j < 8; ++j) { w0[j] = cw[c + j]; w1[j] = cw[DFF + c + j]; w2[j] = cw[2 * DFF + c + j]; bb[j] = cbv[c + j]; }
#pragma unroll
        for (int i = 0; i < 4; ++i) {
            float uu[8], o[8]; unpack8(ur[i], uu);
#pragma unroll
            for (int j = 0; j < 8; ++j) o[j] = silu(bb[j] + w0[j] * g[i][j] + w1[j] * g[i + 1][j] + w2[j] * g[i + 2][j]) * uu[j];
            u32x4 ov; ov.x = pk2(o[0], o[1]); ov.y = pk2(o[2], o[3]); ov.z = pk2(o[4], o[5]); ov.w = pk2(o[6], o[7]);
            *(u32x4*)(ACT + (size_t)(r0 + i) * DFF + c) = ov;
        }
        if (t0 + 4 == L) {
#pragma unroll
            for (int i = 0; i < 2; ++i) {
                float* dst = p.out + (sample ? O_FCS + (((size_t)l * 128 + b) * 2 + i) * DFF : O_FCP + (((size_t)l * 4 + b) * 2 + i) * DFF) + c;
                *(f32x4*)dst = (f32x4){g[4 + i][0], g[4 + i][1], g[4 + i][2], g[4 + i][3]}; *(f32x4*)(dst + 4) = (f32x4){g[4 + i][4], g[4 + i][5], g[4 + i][6], g[4 + i][7]};
            }
        }
    }
}

__device__ __forceinline__ void phase_lruconv(const Params& p) {
    int tid = threadIdx.x; asm volatile("" : "+v"(tid));
    const bf16_t* PR = (const bf16_t*)(p.ws + WS_PROJ); bf16_t* XR = (bf16_t*)(p.ws + WS_XR);
    const float* cw = p.in[23 + p.z]; const float* cbv = p.in[24 + p.z]; const float* st = p.in[7 + p.z];
    const int total = (MT / 4) * 256;
    for (int idx = blockIdx.x * 512 + tid; idx < total; idx += gridDim.x * 512) {
        const int rb = idx >> 8, c = (idx & 255) * 8, r0 = rb * 4;
        int sample, b, t0, L; seq_of_row(r0, sample, b, t0, L);
        float x[7][8];
#pragma unroll
        for (int j = 3; j < 7; ++j) unpack8(*(const u32x4*)(PR + (size_t)(r0 - 3 + j) * LD1 + 8192 + c), x[j]);
        if (t0 >= 3) {
#pragma unroll
            for (int j = 0; j < 3; ++j) unpack8(*(const u32x4*)(PR + (size_t)(r0 - 3 + j) * LD1 + 8192 + c), x[j]);
        } else {
#pragma unroll
            for (int j = 0; j < 3; ++j)
#pragma unroll
                for (int i = 0; i < 8; ++i) x[j][i] = sample ? st[((size_t)b * 3 + j) * 2048 + c + i] : 0.f;
        }
        float w0[8], w1[8], w2[8], w3[8], bb[8];
#pragma unroll
        for (int i = 0; i < 8; ++i) { w0[i] = cw[c + i]; w1[i] = cw[2048 + c + i]; w2[i] = cw[4096 + c + i]; w3[i] = cw[6144 + c + i]; bb[i] = cbv[c + i]; }
#pragma unroll
        for (int rr = 0; rr < 4; ++rr) {
            float o[8];
#pragma unroll
            for (int i = 0; i < 8; ++i) o[i] = bb[i] + w0[i] * x[rr][i] + w1[i] * x[rr + 1][i] + w2[i] * x[rr + 2][i] + w3[i] * x[rr + 3][i];
            u32x4 ov; ov.x = pk2(o[0], o[1]); ov.y = pk2(o[2], o[3]); ov.z = pk2(o[4], o[5]); ov.w = pk2(o[6], o[7]);
            *(u32x4*)(XR + (size_t)(r0 + rr) * 2048 + c) = ov;
        }
        if (t0 + 4 == L) {
#pragma unroll
            for (int j = 0; j < 3; ++j) {
                float* dst = p.out + (sample ? O_LCS : O_LCP) + ((size_t)b * 3 + j) * 2048 + c;
                *(f32x4*)dst = (f32x4){x[4 + j][0], x[4 + j][1], x[4 + j][2], x[4 + j][3]}; *(f32x4*)(dst + 4) = (f32x4){x[4 + j][4], x[4 + j][5], x[4 + j][6], x[4 + j][7]};
            }
        }
    }
}

template <int NS>
__device__ __forceinline__ void finalize_sample_rows(const Params& p, float* ssdst) {
    int tid = threadIdx.x; asm volatile("" : "+v"(tid));
    float* X = (float*)(p.ws + WS_X); bf16_t* XB = (bf16_t*)(p.ws + WS_XB); const float* PT = (const float*)(p.ws + WS_PROJ);
    for (int item = blockIdx.x * 512 + tid; item < 512 * 512; item += gridDim.x * 512) {
        const int row = item >> 9, c4 = item & 511;
        const unsigned o = (unsigned)(MP + row) * 2048u + (unsigned)c4 * 4u, po = (unsigned)row * 2048u + (unsigned)c4 * 4u;
        f32x4 v = *(const f32x4*)(X + o);
        f32x4 pv[NS];
#pragma unroll
        for (int ks = 0; ks < NS; ++ks) pv[ks] = *(const f32x4*)(PT + (size_t)ks * (512 * 2048) + po);
#pragma unroll
        for (int ks = 0; ks < NS; ++ks) v += pv[ks];
        *(f32x4*)(X + o) = v;
        u32x2 w; w.x = pk2(v[0], v[1]); w.y = pk2(v[2], v[3]);
        *(u32x2*)(XB + o) = w;
        float s2 = (v[0] * v[0] + v[1] * v[1]) + (v[2] * v[2] + v[3] * v[3]);
        s2 = wave_sum(s2);
        if ((tid & 63) == 0) atomicAdd(ssdst + MP + row, s2);
    }
}

__device__ __forceinline__ void phase_final(const Params& p) {
    int tid = threadIdx.x; asm volatile("" : "+v"(tid));
    const int wave = tid >> 6, lane = tid & 63;
    const int gw = blockIdx.x * 8 + wave, NGW = gridDim.x * 8;
    const float* X = (const float*)(p.ws + WS_X); const float* nf = p.in[11 + p.z];
    for (int row = gw; row < MT; row += NGW) {
        f32x4 v[8]; float sq = 0.f;
#pragma unroll
        for (int j = 0; j < 8; ++j) { v[j] = *(const f32x4*)(X + (size_t)row * 2048 + (lane + 64 * j) * 4);
            if (row >= MP) {
#pragma unroll
                for (int ks = 0; ks < 11; ++ks) v[j] += *(const f32x4*)((const float*)(p.ws + WS_PROJ) + (size_t)ks * (512 * 2048) + (size_t)(row - MP) * 2048 + (lane + 64 * j) * 4); }
            sq += (v[j][0] * v[j][0] + v[j][1] * v[j][1]) + (v[j][2] * v[j][2] + v[j][3] * v[j][3]); }
        sq = wave_sum(sq);
        const float rs = rsqrtf(sq * (1.0f / 2048.0f) + EPS);
        float* dst = p.out + (row < MP ? O_YP + (size_t)row * 2048 : O_YS + (size_t)(row - MP) * 2048);
#pragma unroll
        for (int j = 0; j < 8; ++j) {
            const int c = (lane + 64 * j) * 4;
            *(f32x4*)(dst + c) = v[j] * rs * *(const f32x4*)(nf + c);
        }
    }
}

#define XB_TMO      128
#define XB_XCNT(j)  (256  + 64 * (j))
#define XB_XSUB(j)  (1280 + 64 * (j))
#define XB_XGEN(j)  (2304 + 64 * (j))
#define XB_TOP      3328
#define XB_TOPGEN   3392
#define XCD_BAR_WORDS 3456
#define XB_SPIN_CAP (1u << 22)
__device__ __forceinline__ unsigned xb_ld(unsigned* p)              { return __hip_atomic_load(p, __ATOMIC_RELAXED, __HIP_MEMORY_SCOPE_AGENT); }
__device__ __forceinline__ unsigned xb_add(unsigned* p, unsigned v) { return __hip_atomic_fetch_add(p, v, __ATOMIC_RELAXED, __HIP_MEMORY_SCOPE_AGENT); }
__device__ __forceinline__ unsigned xb_xcc_id() { return (unsigned)__builtin_amdgcn_s_getreg((3 << 11) | 20) & 0xFu; }
#define XB_SPIN(cond, bar) do { unsigned _sp = 0; while (cond) { __builtin_amdgcn_s_sleep(1); \
    if ((++_sp & 255u) == 0u) { if (xb_ld(&(bar)[XB_TMO])) break; if (_sp > XB_SPIN_CAP) { atomicAdd(&(bar)[XB_TMO], 1u); break; } } } } while (0)
struct XcdBarrier { unsigned* bar; unsigned x; volatile LAS unsigned* st; };
__device__ __forceinline__ XcdBarrier xcd_barrier_post(unsigned* bar, volatile LAS unsigned* st) {
    XcdBarrier b; b.bar = bar; b.x = xb_xcc_id(); b.st = st;
    if (threadIdx.x == 0) (void)xb_add(&bar[XB_XCNT(b.x)], 1u);
    return b;
}
__device__ __forceinline__ void xcd_barrier_complete(unsigned* bar, unsigned x, unsigned& nloc, unsigned& nx) {
    const unsigned G = gridDim.x * gridDim.y * gridDim.z;
    unsigned sum, cnt, mine, sp = 0u;
    for (;;) {
        sum = 0u; cnt = 0u; mine = 0u;
#pragma unroll
        for (unsigned j = 0; j < 16; ++j) { const unsigned c = xb_ld(&bar[XB_XCNT(j)]); sum += c; cnt += (c > 0u) ? 1u : 0u; mine = (j == x) ? c : mine; }
        if (sum == G) break;
        __builtin_amdgcn_s_sleep(1);
        if ((++sp & 255u) == 0u) { if (xb_ld(&bar[XB_TMO])) break; if (sp > XB_SPIN_CAP) { atomicAdd(&bar[XB_TMO], 1u); break; } }
    }
    nloc = mine > 0u ? mine : 1u; nx = cnt > 0u ? cnt : 1u;
}
__device__ __forceinline__ void xcd_barrier(const XcdBarrier& b) {
    asm volatile("s_waitcnt vmcnt(0)" ::: "memory");
    __syncthreads();
    if (threadIdx.x == 0) {
        unsigned* bar = b.bar;
        __builtin_amdgcn_s_waitcnt(0);
        unsigned nloc = b.st[0], nx = b.st[1];
        if (nloc == 0u) { xcd_barrier_complete(bar, b.x, nloc, nx); b.st[0] = nloc; b.st[1] = nx; }
        const unsigned old = xb_add(&bar[XB_XSUB(b.x)], 1u);
        const unsigned gen = old / nloc;
        if (old + 1u == (gen + 1u) * nloc) {
            __builtin_amdgcn_fence(__ATOMIC_RELEASE, "agent");
            asm volatile("s_waitcnt vmcnt(0)" ::: "memory");
            const unsigned og = xb_add(&bar[XB_TOP], 1u);
            const unsigned tg = og / nx;
            if (og + 1u == (tg + 1u) * nx) xb_add(&bar[XB_TOPGEN], 1u);
            else XB_SPIN(xb_ld(&bar[XB_TOPGEN]) == tg, bar);
            __builtin_amdgcn_fence(__ATOMIC_ACQUIRE, "agent");
            xb_add(&bar[XB_XGEN(b.x)], 1u);
            asm volatile("s_waitcnt vmcnt(0)" ::: "memory");
        } else {
            XB_SPIN(xb_ld(&bar[XB_XGEN(b.x)]) == gen, bar);
            __builtin_amdgcn_fence(__ATOMIC_ACQUIRE, "agent");
            asm volatile("s_waitcnt vmcnt(0)" ::: "memory");
        }
    }
    __syncthreads();
}

#ifndef PROBE_MASK
#define PROBE_MASK 0u
#endif
#ifndef PHMASK
#define PHMASK 0xFFFFFFFFu
#endif
#define EN(i) (((PHMASK) >> (i)) & 1u)
__global__ void __launch_bounds__(512, 2) fwd_megakernel(Params p) {
    extern __shared__ __attribute__((aligned(16))) unsigned char shm[];
    float* ldsf = (float*)shm;
    LAS unsigned char* ldsg = (LAS unsigned char*)shm;
    unsigned char* ws = p.ws;
    float* ssb = (float*)(ws + WS_SS);
    volatile LAS unsigned* xst = (volatile LAS unsigned*)(ldsg + 133120);
    if (threadIdx.x == 0) { xst[0] = 0u; xst[1] = 0u; }
    __syncthreads();
    (void)xcd_barrier_post((unsigned*)(ws + WS_CTL) + 256, xst);
#define XBAR() do { XcdBarrier _b; _b.bar = (unsigned*)(p.ws + WS_CTL) + 256; _b.x = xb_xcc_id(); _b.st = (volatile LAS unsigned*)((LAS unsigned char*)shm + 133120); xcd_barrier(_b); } while (0)
#if PROBE_MASK
    unsigned long long tph = __builtin_amdgcn_s_memrealtime();
#endif
    for (int ph = p.ph_lo; ph < p.ph_hi; ++ph) {
        if (ph > p.ph_lo) {
            if (ph == 1) cg::this_grid().sync();
            else XBAR();
#if PROBE_MASK
            {
                const unsigned long long t1 = __builtin_amdgcn_s_memrealtime();
                if ((PROBE_MASK >> (ph - 1)) & 1u) { const unsigned long long dt = t1 - tph; while (__builtin_amdgcn_s_memrealtime() - t1 < dt) __builtin_amdgcn_s_sleep(8); }
                tph = __builtin_amdgcn_s_memrealtime();
            }
#endif
        }
        if (EN(0) && ph == 0) phase_prologue(p, ldsf);
        else if (EN(1) && (ph == 1 || ph == 5 || ph == 8 || ph == 14)) {
            pg8::Gemm g; pg8::EpiScaleBf16 E; int N;
            if (ph != 1) { float* sd = ssb + (ph == 5 ? 1 : (ph == 8 ? 2 : 3)) * MT; if (ph == 8) finalize_sample_rows<11>(p, sd); else finalize_sample_rows<16>(p, sd); XBAR(); }
            g.A = (const char*)(ws + WS_XB); g.lda = 2048; g.ldb = 2048;
            if (ph == 1) { g.Bt = (const char*)(ws + WS_WIN0); N = LD0; E.ss = ssb; }
            else if (ph == 5) { g.Bt = (const char*)(ws + WS_WUP0); N = LDU; E.ss = ssb + MT; }
            else if (ph == 8) { g.Bt = (const char*)(ws + WS_WIN1); N = LD1; E.ss = ssb + 2 * MT; }
            else { g.Bt = (const char*)(ws + WS_WUP1); N = LDU; E.ss = ssb + 3 * MT; }
            E.O = (bf16_t*)(ws + WS_PROJ); E.ldc = N;
            pg8::Order S; S.nMm = 32; S.nN = N / 256; S.n_main = 32 * S.nN; S.n_tail = 2 * S.nN; S.ksplit = 1; S.nt_full = 32; S.G = gridDim.x; S.c = blockIdx.x;
            S.a_t = (size_t)256 * 2048 * 2; S.b_t = (size_t)256 * 2048 * 2; S.acol = 0;
            pg8::gemm_phase<pg8::EpiScaleBf16>(ldsg, g, S, E);
        }
        else if (EN(4) && (ph == 4 || ph == 7 || ph == 13 || ph == 16)) {
            pg8::Gemm g; pg8::EpiResid E;
            g.A = (const char*)(ws + WS_ACT);
            if (ph == 4) { g.Bt = (const char*)(ws + WS_WOUT0); g.lda = 4096; E.ssout = ssb + MT; }
            else if (ph == 7) { g.Bt = (const char*)(ws + WS_WDN0); g.lda = DFF; E.ssout = ssb + 2 * MT; }
            else if (ph == 13) { g.Bt = (const char*)(ws + WS_WOUT1); g.lda = 4096; E.ssout = ssb + 3 * MT; }
            else { g.Bt = (const char*)(ws + WS_WDN1); g.lda = DFF; E.ssout = ssb + 4 * MT; }
            g.ldb = g.lda;
            E.X = (float*)(ws + WS_X); E.XB = (bf16_t*)(ws + WS_XB); E.part = (float*)(ws + WS_PROJ);
            pg8::Order S; S.nMm = 32; S.nN = 8; S.n_main = 256; S.nt_full = g.lda / 64; S.ksplit = (g.lda == 4096) ? 16 : 11; S.n_tail = 16 * S.ksplit; S.G = gridDim.x; S.c = blockIdx.x;
            S.a_t = (size_t)256 * g.lda * 2; S.b_t = (size_t)256 * g.ldb * 2; S.acol = 0;
            pg8::gemm_phase<pg8::EpiResid>(ldsg, g, S, E);
        }
        else if (EN(10) && ph == 10) {
            pg8::Gemm g; pg8::EpiLru E;
            g.A = (const char*)(ws + WS_XR); g.Bt = (const char*)(ws + WS_WLRU); g.lda = 2048; g.ldb = 256;
            E.br = p.in[26 + p.z]; E.bi = p.in[28 + p.z]; E.sp = (const float*)(ws + WS_SP); E.XR = (const bf16_t*)(ws + WS_XR);
            E.LA = (float*)(ws + WS_LA); E.LBv = (bf16_t*)(ws + WS_LBB);
            pg8::Order S; S.nMm = 34; S.nN = 16; S.n_main = 34 * 16; S.n_tail = 0; S.ksplit = 1; S.nt_full = 4 + p.z; S.G = gridDim.x; S.c = blockIdx.x;
            S.a_t = (size_t)256 * 2048 * 2; S.b_t = (size_t)256 * 256 * 2; S.acol = 512;
            pg8::gemm_phase<pg8::EpiLru>(ldsg, g, S, E);
        }
        else if (EN(2) && ph == 2) phase_rec0(p, ldsf);
        else if (EN(3) && ph == 3) phase_prep0(p);
        else if (EN(6) && ph == 6) phase_act(p, 0);
        else if (EN(9) && ph == 9) phase_lruconv(p);
        else if (EN(11) && ph == 11) phase_rec1(p, ldsf);
        else if (EN(12) && ph == 12) phase_prep1(p);
        else if (EN(15) && ph == 15) phase_act(p, 1);
        else if (EN(17) && ph == 17) phase_final(p);
    }
}

#ifndef N_LAUNCH_MODE
#define N_LAUNCH_MODE 0
#endif

extern "C" void kernel_launch(void* const* d_in, const int* in_sizes, int n_in, void* d_out, int out_size, void* d_ws, size_t ws_size, hipStream_t stream) {
    static int grid = 0;
    if (grid == 0) {
        if (n_in != 35 || (size_t)out_size != O_END || ws_size < WS_END) { fprintf(stderr, "kernel_launch: unexpected shapes: n_in %d out %d ws %zu (need %zu)\n", n_in, out_size, ws_size, (size_t)WS_END); grid = -1; return; }
        int dev = 0, cus = 0, per_cu = 0;
        hipGetDevice(&dev);
        hipDeviceGetAttribute(&cus, hipDeviceAttributeMultiprocessorCount, dev);
        if (hipFuncSetAttribute((const void*)fwd_megakernel, hipFuncAttributeMaxDynamicSharedMemorySize, LDS_BYTES) != hipSuccess) { fprintf(stderr, "kernel_launch: hipFuncSetAttribute failed\n"); grid = -1; return; }
        if (hipOccupancyMaxActiveBlocksPerMultiprocessor(&per_cu, (const void*)fwd_megakernel, 512, LDS_BYTES) != hipSuccess || per_cu < 1) { fprintf(stderr, "kernel_launch: occupancy query says %d\n", per_cu); per_cu = 1; }
        (void)hipGetLastError();
        grid = cus;
    }
    if (grid < 0) return;
    (void)hipMemsetAsync((char*)d_ws + WS_CTL, 0, 16384, stream);
    Params p{};
    for (int i = 0; i < 35; ++i) p.in[i] = (const float*)d_in[i];
    p.z = 0; p.pad = 0;
    p.out = (float*)d_out; p.ws = (unsigned char*)d_ws;
#if N_LAUNCH_MODE == 0
    p.ph_lo = 0; p.ph_hi = NPHASE;
    void* args[] = {&p};
    hipError_t e = hipLaunchCooperativeKernel((const void*)fwd_megakernel, dim3(grid), dim3(512), args, LDS_BYTES, stream);
    if (e != hipSuccess) fprintf(stderr, "cooperative launch failed: %s (grid %d)\n", hipGetErrorString(e), grid);
#else
    for (int ph = 0; ph < NPHASE; ++ph) {
        p.ph_lo = ph; p.ph_hi = ph + 1;
        hipLaunchKernelGGL(fwd_megakernel, dim3(grid), dim3(512), LDS_BYTES, stream, p);
    }
#endif
}
```

```cpp
#include <hip/hip_runtime.h>
#include <hip/hip_cooperative_groups.h>
#include <cstdio>
#include <cstdint>
namespace cg = cooperative_groups;

#define LAS __attribute__((address_space(3)))
typedef unsigned short bf16_t;
typedef short bf16x8 __attribute__((ext_vector_type(8)));
typedef float f32x4 __attribute__((ext_vector_type(4)));
typedef float f32x2 __attribute__((ext_vector_type(2)));
typedef unsigned u32x4 __attribute__((ext_vector_type(4)));
typedef unsigned u32x2 __attribute__((ext_vector_type(2)));

constexpr int D = 2048, MP = 8192, MS = 512, MT = 8704;
constexpr int LD0 = 11520, LD1 = 12288, LDU = 11264, DFF = 5632;
constexpr float EPS = 1e-6f;
constexpr size_t O_YP = 0;
constexpr size_t O_YS = O_YP + (size_t)4 * 2048 * 2048;
constexpr size_t O_SSMP = O_YS + (size_t)128 * 4 * 2048;
constexpr size_t O_SSMS = O_SSMP + (size_t)4 * 32 * 128 * 64;
constexpr size_t O_SCP = O_SSMS + (size_t)128 * 32 * 128 * 64;
constexpr size_t O_SCS = O_SCP + (size_t)4 * 3 * 3072;
constexpr size_t O_RETP = O_SCS + (size_t)128 * 3 * 3072;
constexpr size_t O_RETS = O_RETP + (size_t)4 * 8 * 128 * 256;
constexpr size_t O_HGP = O_RETS + (size_t)128 * 8 * 128 * 256;
constexpr size_t O_HGS = O_HGP + (size_t)4 * 16 * 128 * 128;
constexpr size_t O_LRUP = O_HGS + (size_t)128 * 16 * 128 * 128;
constexpr size_t O_LRUS = O_LRUP + (size_t)4 * 2048;
constexpr size_t O_LCP = O_LRUS + (size_t)128 * 2048;
constexpr size_t O_LCS = O_LCP + (size_t)4 * 3 * 2048;
constexpr size_t O_FCP = O_LCS + (size_t)128 * 3 * 2048;
constexpr size_t O_FCS = O_FCP + (size_t)2 * 4 * 2 * 5632;
constexpr size_t O_END = O_FCS + (size_t)2 * 128 * 2 * 5632;
constexpr size_t al256(size_t x) { return (x + 255) & ~(size_t)255; }
constexpr size_t WS_CTL = 0;
constexpr size_t WS_SS = 16384;
constexpr size_t WS_SP = al256(WS_SS + (size_t)5 * MT * 4);
constexpr size_t WS_LB = WS_SP + 8192;
constexpr size_t WS_WIN0 = WS_LB + 8192;
constexpr size_t WS_WOUT0 = WS_WIN0 + (size_t)LD0 * 2048 * 2;
constexpr size_t WS_WUP0 = WS_WOUT0 + (size_t)2048 * 4096 * 2;
constexpr size_t WS_WDN0 = WS_WUP0 + (size_t)LDU * 2048 * 2;
constexpr size_t WS_WIN1 = WS_WDN0 + (size_t)2048 * DFF * 2;
constexpr size_t WS_WOUT1 = WS_WIN1 + (size_t)LD1 * 2048 * 2;
constexpr size_t WS_WUP1 = WS_WOUT1 + (size_t)2048 * 4096 * 2;
constexpr size_t WS_WDN1 = WS_WUP1 + (size_t)LDU * 2048 * 2;
constexpr size_t WS_WLRU = WS_WDN1 + (size_t)2048 * DFF * 2;
constexpr size_t WS_X = WS_WLRU + (size_t)16 * 256 * 256 * 2;
constexpr size_t WS_XB = WS_X + (size_t)MT * 2048 * 4;
constexpr size_t WS_PROJ = WS_XB + (size_t)MT * 2048 * 2;
constexpr size_t WS_ACT = WS_PROJ + (size_t)MT * LD1 * 2;
constexpr size_t WS_YZ = WS_ACT + (size_t)MT * DFF * 2;
constexpr size_t WS_LA = WS_YZ + (size_t)MT * 4096 * 2;
constexpr size_t WS_LBB = WS_LA + (size_t)MT * 2048 * 4;
constexpr size_t WS_XR = WS_LBB + (size_t)MT * 2048 * 2;
constexpr size_t WS_END = WS_XR + (size_t)MT * 2048 * 2;

constexpr int LDS_BYTES = 133120 + 256;
constexpr int NPHASE = 18;

struct Params {
    const float* in[35];
    float* out;
    unsigned char* ws;
    int ph_lo, ph_hi;
    int z, pad;
};

__device__ __forceinline__ float bf2f(unsigned v) { return __uint_as_float(v << 16); }
__device__ __forceinline__ unsigned pk2(float lo, float hi) { unsigned r; asm volatile("v_cvt_pk_bf16_f32 %0, %1, %2" : "=v"(r) : "v"(lo), "v"(hi)); return r; }
__device__ __forceinline__ unsigned pk2_sw(float lo, float hi) {
    unsigned a = __float_as_uint(lo), b = __float_as_uint(hi); a += 0x7fffu + ((a >> 16) & 1u); b += 0x7fffu + ((b >> 16) & 1u); return (a >> 16) | (b & 0xffff0000u); }
__device__ __forceinline__ bf16_t f2bf(float x) { return (bf16_t)(pk2(x, 0.f) & 0xffffu); }
__device__ __forceinline__ float sigm(float x) { return __builtin_amdgcn_rcpf(1.f + __expf(-x)); }
__device__ __forceinline__ float silu(float x) { return x * __builtin_amdgcn_rcpf(1.f + __expf(-x)); }
__device__ __forceinline__ float softplus(float x) { return fmaxf(x, 0.f) + log1pf(__expf(-fabsf(x))); }
__device__ __forceinline__ float gelu_tanh(float x) { const float u = 0.7978845608f * (x + 0.044715f * x * x * x); const float t = 1.f - 2.f * __builtin_amdgcn_rcpf(1.f + __expf(2.f * u)); return 0.5f * x * (1.f + t); }
__device__ __forceinline__ float wave_sum(float v) {
#pragma unroll
    for (int o = 1; o < 64; o <<= 1) v += __shfl_xor(v, o);
    return v;
}
__device__ __forceinline__ void unpack8(u32x4 r, float* f) {
    f[0] = bf2f(r.x & 0xffffu); f[1] = __uint_as_float(r.x & 0xffff0000u); f[2] = bf2f(r.y & 0xffffu); f[3] = __uint_as_float(r.y & 0xffff0000u);
    f[4] = bf2f(r.z & 0xffffu); f[5] = __uint_as_float(r.z & 0xffff0000u); f[6] = bf2f(r.w & 0xffffu); f[7] = __uint_as_float(r.w & 0xffff0000u);
}
__device__ __forceinline__ void unpack4(u32x2 r, float* f) {
    f[0] = bf2f(r.x & 0xffffu); f[1] = __uint_as_float(r.x & 0xffff0000u); f[2] = bf2f(r.y & 0xffffu); f[3] = __uint_as_float(r.y & 0xffff0000u);
}
#define LDS_WAIT() asm volatile("s_waitcnt lgkmcnt(0)" ::: "memory")

namespace pg8 {
constexpr int BM = 256, BK = 64, HALF = 128, HTB = HALF * BK * 2, NXCD = 8, WGM = 8;
__device__ __forceinline__ int lds_byte(int r, int c) { const int st = (r >> 4) * 2 + (c >> 5), rr = r & 15, cc = c & 31, ob = rr * 64 + cc * 2; return st * 1024 + (ob ^ (((ob >> 9) & 1) << 5)); }
__device__ __forceinline__ void stage_rc(int b, int& R, int& C) { const int st = b / 1024, sb = b % 1024, swz = sb ^ (((sb >> 9) & 1) << 5); R = (st >> 1) * 16 + swz / 64; C = (st & 1) * 32 + (swz % 64) / 2; }
__device__ __forceinline__ int perm32(int rho) { const int n = rho >> 4, i = rho & 15; return 8 * (i >> 2) + 4 * n + (i & 3); }

struct Unit { int pm, pn, nt, kind, ks; size_t aoff, boff; };
struct Gemm { const char* A; const char* Bt; int lda, ldb; };
struct Order {
    int nMm, nN, n_main, n_tail, ksplit, nt_full, G, c; size_t a_t, b_t, acol;
    __device__ __forceinline__ bool next(int i, Unit& u) const {
        const long L = (long)i * G + c;
        if (L < n_main) {
            const int nwg = n_main;
            int wgid = (int)L; { const int q = nwg / NXCD, r = nwg % NXCD, xcd = wgid % NXCD, off = wgid / NXCD; wgid = (xcd < r ? xcd * (q + 1) : r * (q + 1) + (xcd - r) * q) + off; }
            const int nig = WGM * nN, gid = wgid / nig, fm = gid * WGM, gsz = (nMm - fm) < WGM ? (nMm - fm) : WGM;
            u.pm = fm + ((wgid % nig) % gsz); u.pn = (wgid % nig) / gsz; u.nt = nt_full; u.kind = 0; u.ks = 0;
            u.aoff = (size_t)u.pm * a_t + (size_t)(u.pn >> 1) * acol; u.boff = (size_t)u.pn * b_t; return true;
        }
        const int Lt = (int)(L - n_main); if (Lt >= n_tail) return false;
        const int ks = Lt % ksplit, r = Lt / ksplit;
        u.pm = nMm + (r & 1); u.pn = r >> 1; u.nt = nt_full / ksplit; u.kind = ksplit > 1 ? 1 : 0; u.ks = ks;
        const size_t kofs = (size_t)ks * u.nt * (BK * 2);
        u.aoff = (size_t)u.pm * a_t + (size_t)(u.pn >> 1) * acol + kofs; u.boff = (size_t)u.pn * b_t + kofs; return true;
    }
};

struct EpiScaleBf16 {
    static constexpr bool PERM = true;
    bf16_t* O; int ldc; const float* ss;
    __device__ __forceinline__ void operator()(const f32x4 (&acc)[2][2][4][2], const Unit& u, int wr, int wc, int fr, int fq) const {
        const int row0 = u.pm * BM + wr * 64 + fr, col0 = u.pn * BM + wc * 32 + 8 * fq;
        float ssv[8];
#pragma unroll
        for (int ai = 0; ai < 2; ++ai)
#pragma unroll
            for (int m = 0; m < 4; ++m) ssv[ai * 4 + m] = ss[row0 + ai * HALF + m * 16];
#pragma unroll
        for (int ai = 0; ai < 2; ++ai)
#pragma unroll
            for (int m = 0; m < 4; ++m) {
                const int row = row0 + ai * HALF + m * 16;
                const float rs = rsqrtf(ssv[ai * 4 + m] * (1.0f / 2048.0f) + EPS);
                bf16_t* rowp = O + ((unsigned)row * (unsigned)ldc + (unsigned)col0);
#pragma unroll
                for (int bj = 0; bj < 2; ++bj) {
                    const f32x4 v0 = acc[ai][bj][m][0] * rs, v1 = acc[ai][bj][m][1] * rs;
                    u32x4 w; w.x = pk2(v0[0], v0[1]); w.y = pk2(v0[2], v0[3]); w.z = pk2(v1[0], v1[1]); w.w = pk2(v1[2], v1[3]);
                    *(u32x4*)(rowp + bj * HALF) = w;
                }
            }
    }
};
struct EpiResid {
    static constexpr bool PERM = false;
    float* X; bf16_t* XB; float* ssout; float* part;
    __device__ __forceinline__ void operator()(const f32x4 (&acc)[2][2][4][2], const Unit& u, int wr, int wc, int fr, int fq) const {
        const int row0 = u.pm * BM + wr * 64 + fr, col0 = u.pn * BM + wc * 32 + 4 * fq;
        if (u.kind == 1) {
            float* P = part + (size_t)u.ks * (512 * 2048);
#pragma unroll
            for (int ai = 0; ai < 2; ++ai)
#pragma unroll
                for (int m = 0; m < 4; ++m) {
                    const unsigned off = (unsigned)(row0 - MP + ai * HALF + m * 16) * 2048u + (unsigned)col0;
#pragma unroll
                    for (int bj = 0; bj < 2; ++bj)
#pragma unroll
                        for (int n = 0; n < 2; ++n) *(f32x4*)(P + off + bj * HALF + n * 16) = acc[ai][bj][m][n];
                }
            return;
        }
#pragma unroll
        for (int ai = 0; ai < 2; ++ai)
#pragma unroll
            for (int mp = 0; mp < 4; mp += 2) {
                f32x4 xin[2][2][2];
#pragma unroll
                for (int mm = 0; mm < 2; ++mm)
#pragma unroll
                    for (int bj = 0; bj < 2; ++bj)
#pragma unroll
                        for (int n = 0; n < 2; ++n) xin[mm][bj][n] = *(const f32x4*)(X + ((unsigned)(row0 + ai * HALF + (mp + mm) * 16) * 2048u + (unsigned)col0 + bj * HALF + n * 16));
#pragma unroll
                for (int mm = 0; mm < 2; ++mm) {
                    const int row = row0 + ai * HALF + (mp + mm) * 16;
                    const unsigned off = (unsigned)row * 2048u + (unsigned)col0;
                    float sq = 0.f;
#pragma unroll
                    for (int bj = 0; bj < 2; ++bj)
#pragma unroll
                        for (int n = 0; n < 2; ++n) {
                            const unsigned o = off + bj * HALF + n * 16;
                            const f32x4 x = xin[mm][bj][n] + acc[ai][bj][mp + mm][n];
                            *(f32x4*)(X + o) = x;
                            u32x2 w; w.x = pk2(x[0], x[1]); w.y = pk2(x[2], x[3]);
                            *(u32x2*)(XB + o) = w;
                            sq += (x[0] * x[0] + x[1] * x[1]) + (x[2] * x[2] + x[3] * x[3]);
                        }
                    sq += __shfl_xor(sq, 16); sq += __shfl_xor(sq, 32);
                    if (fq == 0) atomicAdd(ssout + row, sq);
                }
                asm volatile("" ::: "memory");
            }
    }
};
struct EpiLru {
    static constexpr bool PERM = false;
    const float* br; const float* bi; const float* sp; const bf16_t* XR; float* LA; bf16_t* LBv;
    __device__ __forceinline__ void operator()(const f32x4 (&acc)[2][2][4][2], const Unit& u, int wr, int wc, int fr, int fq) const {
        const int row0 = u.pm * BM + wr * 64 + fr;
        const int cbase = (u.pn >> 1) * 256 + (u.pn & 1) * 128 + wc * 32 + 4 * fq;
        f32x4 br4[2], bi4[2], sp4[2];
#pragma unroll
        for (int n = 0; n < 2; ++n) { br4[n] = *(const f32x4*)(br + cbase + n * 16); bi4[n] = *(const f32x4*)(bi + cbase + n * 16); sp4[n] = *(const f32x4*)(sp + cbase + n * 16); }
#pragma unroll
        for (int ai = 0; ai < 2; ++ai)
#pragma unroll
            for (int mp = 0; mp < 4; mp += 2) {
                u32x2 xrr[2][2];
#pragma unroll
                for (int mm = 0; mm < 2; ++mm)
#pragma unroll
                    for (int n = 0; n < 2; ++n) xrr[mm][n] = *(const u32x2*)(XR + ((unsigned)(row0 + ai * HALF + (mp + mm) * 16) * 2048u + (unsigned)(cbase + n * 16)));
#pragma unroll
                for (int mm = 0; mm < 2; ++mm) {
                    const int row = row0 + ai * HALF + (mp + mm) * 16;
                    const bool first = (row < MP) && ((row & 2047) == 0);
#pragma unroll
                    for (int n = 0; n < 2; ++n) {
                        const unsigned o = (unsigned)row * 2048u + (unsigned)(cbase + n * 16);
                        float xr[4]; unpack4(xrr[mm][n], xr);
                        f32x4 av; float bb[4];
#pragma unroll
                        for (int j = 0; j < 4; ++j) {
                            const float r = sigm(acc[ai][0][mp + mm][n][j] + br4[n][j]), gi = sigm(acc[ai][1][mp + mm][n][j] + bi4[n][j]);
                            const float la = -8.0f * r * sp4[n][j];
                            const float a = __expf(la);
                            const float mult = first ? 1.0f : __builtin_amdgcn_sqrtf(fmaxf(1.0f - a * a, 0.f));
                            av[j] = a; bb[j] = mult * gi * xr[j];
                        }
                        *(f32x4*)(LA + o) = av;
                        u32x2 w; w.x = pk2(bb[0], bb[1]); w.y = pk2(bb[2], bb[3]);
                        *(u32x2*)(LBv + o) = w;
                    }
                }
                asm volatile("" ::: "memory");
            }
    }
};

template <class Epi>
__device__ __forceinline__ void gemm_phase(LAS unsigned char* lds, const Gemm g, const Order& S, const Epi& E) {
    int tid = threadIdx.x; asm volatile("" : "+v"(tid));
    const int wid = __builtin_amdgcn_readfirstlane(tid >> 6), lane = tid & 63, wr = wid >> 2, wc = wid & 3, fr = lane & 15, fq = lane >> 4;
    unsigned voffA[2], voffB[2];
#pragma unroll
    for (int i = 0; i < 2; ++i) { int R, C; stage_rc(tid * 16 + i * 8192, R, C); const int Rb = Epi::PERM ? ((R & ~31) + perm32(R & 31)) : R;
        voffA[i] = (unsigned)(R * g.lda + C) * 2u; voffB[i] = (unsigned)(Rb * g.ldb + C) * 2u; }
    const size_t kstep = (size_t)(BK * 2);
    const size_t hstepA = (size_t)HALF * g.lda * 2, hstepB = (size_t)HALF * g.ldb * 2;
    const unsigned ldsw = (unsigned)wid * 1024u;
    const int aoff = lds_byte(wr * 64 + fr, fq * 8), boff = lds_byte(wc * 32 + fr, fq * 8);
#define PG8_SA(b, h) (((b) * 2 + (h)) * HTB)
#define PG8_SB(b, h) ((4 + (b) * 2 + (h)) * HTB)
#define PG8_STAGE(bufoff, gbase, voff) do { _Pragma("unroll") for (int _i = 0; _i < 2; ++_i) \
        __builtin_amdgcn_global_load_lds((const unsigned*)((const char*)(gbase) + (voff)[_i]), (LAS unsigned*)(lds + (bufoff) + ldsw + _i * 8192), 16, 0, 0); } while (0)
#define PG8_LDA(dst, b, h) do { _Pragma("unroll") for (int m = 0; m < 4; ++m) _Pragma("unroll") for (int k = 0; k < 2; ++k) dst[m][k] = *(const LAS bf16x8*)(lds + PG8_SA(b, h) + aoff + m * 2048 + k * 1024); } while (0)
#define PG8_LDB(dst, b, h) do { _Pragma("unroll") for (int n = 0; n < 2; ++n) _Pragma("unroll") for (int k = 0; k < 2; ++k) dst[n][k] = *(const LAS bf16x8*)(lds + PG8_SB(b, h) + boff + n * 2048 + k * 1024); } while (0)
#define PG8_MMA(ai, bj, At, Bt) do { __builtin_amdgcn_s_setprio(1); _Pragma("unroll") for (int m = 0; m < 4; ++m) _Pragma("unroll") for (int n = 0; n < 2; ++n) _Pragma("unroll") for (int k = 0; k < 2; ++k) \
        acc[ai][bj][m][n] = __builtin_amdgcn_mfma_f32_16x16x32_bf16(Bt[n][k], At[m][k], acc[ai][bj][m][n], 0, 0, 0); __builtin_amdgcn_s_setprio(0); } while (0)
#define PG8_WAIT_V(n) asm volatile("s_waitcnt vmcnt(" #n ")" ::: "memory")
#define PG8_WAIT_L(n) asm volatile("s_waitcnt lgkmcnt(" #n ")" ::: "memory")
#define PG8_BAR __builtin_amdgcn_s_barrier()
#define PG8_SCHED __builtin_amdgcn_sched_barrier(0)
    Unit cur, nxt; int ui = 0;
    if (!S.next(0, cur)) return;
    f32x4 acc[2][2][4][2];
#pragma unroll
    for (int a = 0; a < 2; ++a)
#pragma unroll
        for (int b = 0; b < 2; ++b)
#pragma unroll
            for (int m = 0; m < 4; ++m)
#pragma unroll
                for (int n = 0; n < 2; ++n) acc[a][b][m][n] = (f32x4){0.f, 0.f, 0.f, 0.f};
    bf16x8 At[4][2], B0[2][2], B1[2][2];
    const char* cA = g.A + cur.aoff; const char* cB = g.Bt + cur.boff;
    PG8_STAGE(PG8_SB(0, 0), cB, voffB); PG8_STAGE(PG8_SA(0, 0), cA, voffA); PG8_STAGE(PG8_SB(0, 1), cB + hstepB, voffB); PG8_STAGE(PG8_SA(0, 1), cA + hstepA, voffA);
    if (wr == 1) PG8_BAR;
    PG8_WAIT_V(4); PG8_BAR;
    PG8_STAGE(PG8_SB(1, 0), cB + kstep, voffB); PG8_STAGE(PG8_SA(1, 0), cA + kstep, voffA); PG8_STAGE(PG8_SB(1, 1), cB + hstepB + kstep, voffB);
    PG8_WAIT_V(6); PG8_BAR;
    for (;;) {
        const bool has_next = S.next(ui + 1, nxt);
        const char* nA = has_next ? g.A + nxt.aoff : cA; const char* nB = has_next ? g.Bt + nxt.boff : cB;
        const int nt = cur.nt;
        for (int t = 0; t < nt; t += 2) {
            const bool last = (t == nt - 2);
            const char* a1 = cA + (size_t)(t + 1) * kstep;
            const char* a2 = last ? nA : cA + (size_t)(t + 2) * kstep; const char* b2 = last ? nB : cB + (size_t)(t + 2) * kstep;
            const char* a3 = a2 + kstep; const char* b3 = b2 + kstep;
            PG8_LDB(B0, 0, 0); PG8_SCHED; PG8_LDA(At, 0, 0); PG8_STAGE(PG8_SA(1, 1), a1 + hstepA, voffA);
            PG8_WAIT_L(8); PG8_BAR; PG8_WAIT_L(0); PG8_MMA(0, 0, At, B0); PG8_BAR; PG8_SCHED;
            PG8_LDB(B1, 0, 1); PG8_STAGE(PG8_SB(0, 0), b2, voffB);
            PG8_BAR; PG8_WAIT_L(0); PG8_MMA(0, 1, At, B1); PG8_BAR;
            PG8_LDA(At, 0, 1); PG8_STAGE(PG8_SA(0, 0), a2, voffA);
            PG8_BAR; PG8_WAIT_L(0); PG8_MMA(1, 0, At, B0); PG8_BAR; PG8_SCHED;
            PG8_STAGE(PG8_SB(0, 1), b2 + hstepB, voffB);
            PG8_WAIT_V(6); PG8_BAR; PG8_MMA(1, 1, At, B1); PG8_BAR;
            PG8_LDB(B0, 1, 0); PG8_SCHED; PG8_LDA(At, 1, 0); PG8_STAGE(PG8_SA(0, 1), a2 + hstepA, voffA);
            PG8_WAIT_L(8); PG8_BAR; PG8_WAIT_L(0); PG8_MMA(0, 0, At, B0); PG8_BAR; PG8_SCHED;
            PG8_LDB(B1, 1, 1); PG8_STAGE(PG8_SB(1, 0), b3, voffB);
            PG8_BAR; PG8_WAIT_L(0); PG8_MMA(0, 1, At, B1); PG8_BAR;
            PG8_LDA(At, 1, 1); PG8_STAGE(PG8_SA(1, 0), a3, voffA);
            PG8_BAR; PG8_WAIT_L(0); PG8_MMA(1, 0, At, B0); PG8_BAR; PG8_SCHED;
            PG8_STAGE(PG8_SB(1, 1), b3 + hstepB, voffB);
            PG8_WAIT_V(6); PG8_BAR; PG8_MMA(1, 1, At, B1); PG8_BAR;
        }
        if (wr == 0) PG8_BAR;
        E(acc, cur, wr, wc, fr, fq);
        if (!has_next) break;
#pragma unroll
        for (int a = 0; a < 2; ++a)
#pragma unroll
            for (int b = 0; b < 2; ++b)
#pragma unroll
                for (int m = 0; m < 4; ++m)
#pragma unroll
                    for (int n = 0; n < 2; ++n) acc[a][b][m][n] = (f32x4){0.f, 0.f, 0.f, 0.f};
        cur = nxt; cA = nA; cB = nB; ++ui;
        if (wr == 1) PG8_BAR;
    }
    PG8_WAIT_V(0);
    PG8_BAR;
#undef PG8_SA
#undef PG8_SB
#undef PG8_STAGE
#undef PG8_LDA
#undef PG8_LDB
#undef PG8_MMA
#undef PG8_WAIT_V
#undef PG8_WAIT_L
#undef PG8_BAR
#undef PG8_SCHED
}
}

__device__ __forceinline__ void tr_item(const float* __restrict__ W, int ldw, int N, int k0, int n0, const float* __restrict__ scale, bf16_t* __restrict__ dst, int ldd, float* scr, int lane) {
    const int r4 = lane >> 4, c4 = (lane & 15) * 4;
    const bool inb = (n0 + c4) < N;
    f32x4 v[16];
#pragma unroll
    for (int i = 0; i < 16; ++i) v[i] = inb ? *(const f32x4*)(W + (size_t)(k0 + 4 * i + r4) * ldw + n0 + c4) : (f32x4){0.f, 0.f, 0.f, 0.f};
#pragma unroll
    for (int i = 0; i < 16; ++i) { float* d = scr + (4 * i + r4) * 65 + c4; d[0] = v[i][0]; d[1] = v[i][1]; d[2] = v[i][2]; d[3] = v[i][3]; }
    LDS_WAIT();
    const int c = lane & 7;
    f32x4 s0 = (f32x4){1.f, 1.f, 1.f, 1.f}, s1 = s0;
    if (scale) { s0 = *(const f32x4*)(scale + k0 + 8 * c); s1 = *(const f32x4*)(scale + k0 + 8 * c + 4); }
#pragma unroll
    for (int j = 0; j < 8; ++j) { const int n = (lane >> 3) + 8 * j; const float* sp = scr + (8 * c) * 65 + n;
        u32x4 o; o.x = pk2(sp[0 * 65] * s0[0], sp[1 * 65] * s0[1]); o.y = pk2(sp[2 * 65] * s0[2], sp[3 * 65] * s0[3]); o.z = pk2(sp[4 * 65] * s1[0], sp[5 * 65] * s1[1]); o.w = pk2(sp[6 * 65] * s1[2], sp[7 * 65] * s1[3]);
        *(u32x4*)(dst + (size_t)n * ldd + 8 * c) = o; }
    LDS_WAIT();
}

__device__ __forceinline__ void phase_prologue(const Params& p, float* ldsf) {
    int tid = threadIdx.x; asm volatile("" : "+v"(tid));
    const int wave = tid >> 6, lane = tid & 63;
    const int gw = blockIdx.x * 8 + wave, NGW = gridDim.x * 8;
    float* scr = ldsf + wave * 4160;
    unsigned char* ws = p.ws;
    constexpr int I0 = 32 * 177, I1 = 64 * 32, I2 = 32 * 176, I3 = 88 * 32, I4 = 32 * 192, I5 = I1, I6 = I2, I7 = I3, I8 = 128, I9 = 128;
    constexpr int NIT = I0 + I1 + I2 + I3 + I4 + I5 + I6 + I7 + I8 + I9;
    for (int it = gw; it < NIT; it += NGW) {
        int r = it;
        const float* W; int K, N; const float* sc = nullptr; bf16_t* WT;
        if (r < I0) { W = p.in[12 + p.z]; K = 2048; N = 11296; sc = p.in[9 + p.z]; WT = (bf16_t*)(ws + WS_WIN0); }
        else if ((r -= I0) < I1) { W = p.in[19 + p.z]; K = 4096; N = 2048; WT = (bf16_t*)(ws + WS_WOUT0); }
        else if ((r -= I1) < I2) { W = p.in[31 + p.z]; K = 2048; N = 11264; sc = p.in[10 + p.z]; WT = (bf16_t*)(ws + WS_WUP0); }
        else if ((r -= I2) < I3) { W = p.in[34 + p.z]; K = 5632; N = 2048; WT = (bf16_t*)(ws + WS_WDN0); }
        else if ((r -= I3) < I4) { W = p.in[20 + p.z]; K = 2048; N = 12288; sc = p.in[9 + p.z] + 2048; WT = (bf16_t*)(ws + WS_WIN1); }
        else if ((r -= I4) < I5) { W = p.in[30 + p.z]; K = 4096; N = 2048; WT = (bf16_t*)(ws + WS_WOUT1); }
        else if ((r -= I5) < I6) { W = p.in[31 + p.z] + (size_t)2048 * 11264; K = 2048; N = 11264; sc = p.in[10 + p.z] + 2048; WT = (bf16_t*)(ws + WS_WUP1); }
        else if ((r -= I6) < I7) { W = p.in[34 + p.z] + (size_t)5632 * 2048; K = 5632; N = 2048; WT = (bf16_t*)(ws + WS_WDN1); }
        else {
            r -= I7; const int which = r >> 7; r &= 127;
            const int blk = r >> 4, kb = (r >> 2) & 3, nb = r & 3, n0 = 64 * nb, k0 = 64 * kb;
            const float* Wl = (which ? p.in[27 + p.z] : p.in[25 + p.z]) + (size_t)blk * 65536;
            const int drow = (blk * 2 + (n0 >> 7)) * 256 + which * 128 + (n0 & 127);
            tr_item(Wl, 256, 256, k0, n0, nullptr, (bf16_t*)(ws + WS_WLRU) + (size_t)drow * 256 + k0, 256, scr, lane);
            continue;
        }
        const int nblk = (N + 63) / 64, kbl = r & 7, r8 = r >> 3, nb = r8 % nblk, kb = (r8 / nblk) * 8 + kbl, k0 = 64 * kb, n0 = 64 * nb;
        tr_item(W, N, N, k0, n0, sc, WT + (size_t)n0 * K + k0, K, scr, lane);
    }
    {
        u32x4* z = (u32x4*)((bf16_t*)(ws + WS_WIN0) + (size_t)11296 * 2048);
        const int n16 = 224 * 2048 * 2 / 16;
        for (int i = blockIdx.x * 512 + tid; i < n16; i += gridDim.x * 512) z[i] = (u32x4){0u, 0u, 0u, 0u};
    }
    float* X = (float*)(ws + WS_X); bf16_t* XB = (bf16_t*)(ws + WS_XB); float* ss = (float*)(ws + WS_SS);
    for (int row = gw; row < MT; row += NGW) {
        const float* src = row < MP ? p.in[0 + p.z] + (size_t)row * 2048 : p.in[1 + p.z] + (size_t)(row - MP) * 2048;
        float s = 0.f;
#pragma unroll
        for (int j = 0; j < 8; ++j) {
            const f32x4 v = *(const f32x4*)(src + (lane + 64 * j) * 4);
            *(f32x4*)(X + (size_t)row * 2048 + (lane + 64 * j) * 4) = v;
            u32x2 w; w.x = pk2(v[0], v[1]); w.y = pk2(v[2], v[3]);
            *(u32x2*)(XB + (size_t)row * 2048 + (lane + 64 * j) * 4) = w;
            s += (v[0] * v[0] + v[1] * v[1]) + (v[2] * v[2] + v[3] * v[3]);
        }
        s = wave_sum(s);
        if (lane == 0) ss[row] = s;
    }
    for (int i = blockIdx.x * 512 + tid; i < 4 * MT; i += gridDim.x * 512) ss[MT + i] = 0.f;
    for (int i = blockIdx.x * 512 + tid; i < 2048; i += gridDim.x * 512) {
        ((float*)(ws + WS_SP))[i] = softplus(-p.in[29 + p.z][i]);
        ((float*)(ws + WS_LB))[i] = sigm(p.in[21 + p.z][2048 + i] - p.in[21 + p.z][i]);
    }
}

__device__ __forceinline__ int next_item(unsigned* ctr, float* ldsf) {
    __syncthreads();
    if (threadIdx.x == 0) ((volatile unsigned*)ldsf)[24576] = atomicAdd(ctr, 1u);
    __syncthreads();
    return (int)((volatile unsigned*)ldsf)[24576];
}

template <int TYPE, int VW>
__device__ __forceinline__ void rec_item(const Params& p, float* ldsf, int sample, int b, int h, int s) {
    constexpr int NV = VW / 16;
    typedef float VT __attribute__((ext_vector_type(NV)));
    int tid = threadIdx.x; asm volatile("" : "+v"(tid));
    const int w = tid >> 6, lane = tid & 63, kg = lane >> 4, vq = lane & 15, kb = 16 * w + 4 * kg;
    const int L = sample ? 4 : 2048, row0 = sample ? MP + 4 * b : 2048 * b, pos0 = sample ? 16384 : 0;
    constexpr int LDP = TYPE < 2 ? LD0 : LD1;
    const bf16_t* proj = (const bf16_t*)(p.ws + WS_PROJ) + (size_t)row0 * LDP;
    bf16_t* yz = (bf16_t*)(p.ws + WS_YZ) + (size_t)row0 * 4096;
    float* part = ldsf + 8192;
    int colA = -1, colB = -1, role = -1, didx = 0;
    float w0 = 0.f, w1 = 0.f, w2 = 0.f, w3 = 0.f, cbias = 0.f, c0 = 0.f, c1 = 0.f, c2 = 0.f, aux = 0.f, aux2 = 0.f;
    if constexpr (TYPE == 0) {
        if (tid < 320) {
            role = tid < 128 ? 0 : (tid < 256 ? 1 : 2);
            didx = tid < 128 ? tid : (tid < 256 ? tid - 128 : tid - 256);
            const int ch = tid < 128 ? 2560 + (h >> 3) * 128 + tid : (tid < 256 ? 2048 + (h >> 3) * 128 + (tid - 128) : h * 64 + (tid - 256));
            colA = 2048 + ch;
            const float* cw = p.in[13 + p.z];
            w0 = cw[ch]; w1 = cw[3072 + ch]; w2 = cw[2 * 3072 + ch]; w3 = cw[3 * 3072 + ch]; cbias = p.in[14 + p.z][ch];
            if (sample) { const float* st = p.in[3 + p.z] + (size_t)b * 3 * 3072; c0 = st[ch]; c1 = st[3072 + ch]; c2 = st[2 * 3072 + ch]; }
        } else if (tid < 328) { role = 3; didx = tid - 320; colA = 5120 + h; aux = p.in[15 + p.z][h]; aux2 = -__expf(p.in[16 + p.z][h]); }
    } else if constexpr (TYPE == 1) {
        if (tid < 128) { role = tid < 64 ? 0 : 1; didx = tid & 63; colA = (tid < 64 ? 5152 : 6176) + h * 128 + didx; colB = colA + 64;
            aux = exp2f(-(float)didx * 0.20762050593046014f); }
        else if (tid < 128 + VW) { role = 2; didx = tid - 128; colA = 7200 + h * 256 + s * VW + didx; }
    } else {
        if (tid < 128) { role = 0; didx = tid; colA = h * 128 + tid; }
        else if (tid < 256) { role = 1; didx = tid - 128; colA = 2048 + h * 128 + didx; aux = ((const float*)(p.ws + WS_LB))[h * 128 + didx]; }
        else if (tid < 256 + VW) { role = 2; didx = tid - 256; colA = 4096 + h * 128 + s * VW + didx; }
    }
    const float Dh = TYPE == 0 ? p.in[17 + p.z][h] : 0.f;
    const float gamma = TYPE == 1 ? 1.0f - exp2f(-5.0f - (float)h * (4.0f / 7.0f)) : 0.f;
    const int ldS = TYPE == 0 ? 64 : (TYPE == 1 ? 256 : 128);
    size_t soff;
    if constexpr (TYPE == 0) soff = ((size_t)(b * 32 + h) * 128) * 64;
    else if constexpr (TYPE == 1) soff = ((size_t)(b * 8 + h) * 128) * 256 + s * VW;
    else soff = ((size_t)(b * 16 + h) * 128) * 128 + s * VW;
    const float* S0 = TYPE == 0 ? p.in[2 + p.z] : (TYPE == 1 ? p.in[4 + p.z] : p.in[5 + p.z]);
    float* Sout = p.out + (TYPE == 0 ? (sample ? O_SSMS : O_SSMP) : (TYPE == 1 ? (sample ? O_RETS : O_RETP) : (sample ? O_HGS : O_HGP))) + soff;
    VT S[4];
#pragma unroll
    for (int i = 0; i < 4; ++i) { if (sample) S[i] = *(const VT*)(S0 + soff + (size_t)(kb + i) * ldS + NV * vq); else S[i] = (VT)(0.f); }
    unsigned short ra[8], rb[8]; unsigned short zr = 0;
    const int R = (L + 7) >> 3;
    auto load_raw = [&](int r) {
#pragma unroll
        for (int t = 0; t < 8; ++t) {
            const int tt = 8 * r + t;
            ra[t] = 0; rb[t] = 0;
            if (tt < L) {
                if (colA >= 0) ra[t] = proj[(size_t)tt * LDP + colA];
                if (TYPE == 1 && colB >= 0) rb[t] = proj[(size_t)tt * LDP + colB];
            }
        }
        if (TYPE == 0) { const int tt = 8 * r + w; if (tt < L) zr = proj[(size_t)tt * LDP + h * 64 + lane]; }
    };
    load_raw(0);
    for (int r = 0; r < R; ++r) {
        const int nv = (L - 8 * r) < 8 ? (L - 8 * r) : 8;
        float* stg = ldsf + (r & 1) * 4096;
        float* qs = stg; float* ks = stg + 1024; float* as = stg + 2048; float* vs = stg + 3072; float* ad = stg + 3584;
        if constexpr (TYPE == 0) {
            if (role >= 0 && role < 3) {
                float* dst = role == 0 ? qs : (role == 1 ? ks : vs); const int dstr = role == 2 ? 64 : 128;
#pragma unroll
                for (int t = 0; t < 8; ++t) {
                    const float x = bf2f(ra[t]);
                    const float y = cbias + w0 * c0 + w1 * c1 + w2 * c2 + w3 * x;
                    c0 = c1; c1 = c2; c2 = x;
                    dst[t * dstr + didx] = silu(y);
                }
            } else if (role == 3) {
                float xv = 0.f;
#pragma unroll
                for (int t = 0; t < 8; ++t) if (t == didx) xv = bf2f(ra[t]);
                const float dt = softplus(xv + aux);
                ad[2 * didx] = __expf(dt * aux2); ad[2 * didx + 1] = dt;
            }
        } else if constexpr (TYPE == 1) {
            if (role == 0 || role == 1) {
                float* dst = role == 0 ? qs : ks; const float sc = role == 0 ? 1.0f : 0.08838834764831845f;
#pragma unroll
                for (int t = 0; t < 8; ++t) {
                    const int pos = pos0 + 8 * r + t;
                    const double rev = (double)pos * (double)aux * 0.15915494309189535;
                    const float fr = (float)(rev - floor(rev));
                    const float sn = __builtin_amdgcn_sinf(fr), cs = __builtin_amdgcn_cosf(fr);
                    const float x1 = bf2f(ra[t]) * sc, x2 = bf2f(rb[t]) * sc;
                    dst[t * 128 + didx] = x1 * cs - x2 * sn;
                    dst[t * 128 + 64 + didx] = x1 * sn + x2 * cs;
                }
            } else if (role == 2) {
#pragma unroll
                for (int t = 0; t < 8; ++t) vs[t * VW + didx] = bf2f(ra[t]);
            }
        } else {
            if (role == 0) {
#pragma unroll
                for (int t = 0; t < 8; ++t) qs[t * 128 + didx] = silu(bf2f(ra[t]));
            } else if (role == 1) {
#pragma unroll
                for (int t = 0; t < 8; ++t) { const float f = aux + (1.0f - aux) * sigm(bf2f(ra[t])); as[t * 128 + didx] = f; ks[t * 128 + didx] = 1.0f - f; }
            } else if (role == 2) {
#pragma unroll
                for (int t = 0; t < 8; ++t) vs[t * VW + didx] = bf2f(ra[t]);
            }
        }
        const unsigned short zc = zr;
        __syncthreads();
        if (r + 1 < R) load_raw(r + 1);
        for (int t0 = 0; t0 < nv; t0 += 4) {
#pragma unroll
            for (int tt = 0; tt < 4; ++tt) {
                const int t = t0 + tt;
                const f32x4 q4 = *(const f32x4*)(qs + t * 128 + kb);
                f32x4 k4 = *(const f32x4*)(ks + t * 128 + kb);
                const VT v4 = *(const VT*)(vs + t * VW + NV * vq);
                f32x4 a4;
                if constexpr (TYPE == 0) { const f32x2 adv = *(const f32x2*)(ad + 2 * t); a4 = (f32x4){adv.x, adv.x, adv.x, adv.x}; k4 = k4 * adv.y; }
                else if constexpr (TYPE == 1) a4 = (f32x4){gamma, gamma, gamma, gamma};
                else a4 = *(const f32x4*)(as + t * 128 + kb);
                VT o = (VT)(0.f);
#pragma unroll
                for (int i = 0; i < 4; ++i) { S[i] = a4[i] * S[i] + k4[i] * v4; o += q4[i] * S[i]; }
                *(VT*)(part + ((t * 32 + w * 4 + kg) * VW + NV * vq)) = o;
            }
        }
        __syncthreads();
        const int rt = tid / VW, rv = tid % VW;
        if (tid < 8 * VW && rt < nv) {
            float o = 0.f;
#pragma unroll
            for (int pp = 0; pp < 32; ++pp) o += part[(rt * 32 + pp) * VW + rv];
            const size_t trow = (size_t)(8 * r + rt);
            if constexpr (TYPE == 0) {
                const float y = (o + Dh * vs[rt * 64 + rv]) * silu(bf2f(zc));
                yz[trow * 4096 + h * 64 + rv] = f2bf(y);
            } else if constexpr (TYPE == 1) {
                yz[trow * 4096 + 2048 + h * 256 + s * VW + rv] = f2bf(o);
            } else {
                yz[trow * 4096 + h * 128 + s * VW + rv] = f2bf(o);
            }
        }
    }
#pragma unroll
    for (int i = 0; i < 4; ++i) *(VT*)(Sout + (size_t)(kb + i) * ldS + NV * vq) = S[i];
}

template <int TYPE>
__device__ __forceinline__ void dec_unit(const Params& p, float* ldsf, int b, int u) {
    int tid = threadIdx.x; asm volatile("" : "+v"(tid));
    const int w = tid >> 6, lane = tid & 63, kg = lane >> 4, vq = lane & 15;
    const int row0 = MP + 4 * b;
    constexpr int LDP = TYPE < 2 ? LD0 : LD1;
    const bf16_t* proj = (const bf16_t*)(p.ws + WS_PROJ) + (size_t)row0 * LDP;
    bf16_t* yz = (bf16_t*)(p.ws + WS_YZ) + (size_t)row0 * 4096;
    int h, sl; size_t soff; int ldS;
    if constexpr (TYPE == 0) { h = 8 * u + w; sl = 0; ldS = 64; soff = ((size_t)(b * 32 + h) * 128) * 64; }
    else if constexpr (TYPE == 1) { h = 2 * u + (w >> 2); sl = w & 3; ldS = 256; soff = ((size_t)(b * 8 + h) * 128) * 256 + sl * 64; }
    else { h = 4 * u + (w >> 1); sl = w & 1; ldS = 128; soff = ((size_t)(b * 16 + h) * 128) * 128 + sl * 64; }
    const float* S0 = (TYPE == 0 ? p.in[2 + p.z] : (TYPE == 1 ? p.in[4 + p.z] : p.in[5 + p.z])) + soff + (size_t)(32 * kg) * ldS + 4 * vq;
    float* Sout = p.out + (TYPE == 0 ? O_SSMS : (TYPE == 1 ? O_RETS : O_HGS)) + soff + (size_t)(32 * kg) * ldS + 4 * vq;
    if constexpr (TYPE == 0) {
        float* qs = ldsf; float* ks = ldsf + 512; float* xs = ldsf + 1024; float* zs = ldsf + 3072; float* ad = ldsf + 5120;
        unsigned short xr[2][4]; float cw[2][4], cb[2], st[2][3]; unsigned short zr[4]; unsigned short dr = 0;
#pragma unroll
        for (int q = 0; q < 2; ++q) {
            const int idx = tid + 512 * q;
            if (idx < 768) {
                const int ch = idx < 128 ? 2560 + u * 128 + idx : (idx < 256 ? 2048 + u * 128 + (idx - 128) : u * 512 + (idx - 256));
#pragma unroll
                for (int t = 0; t < 4; ++t) xr[q][t] = proj[(size_t)t * LDP + 2048 + ch];
#pragma unroll
                for (int j = 0; j < 4; ++j) cw[q][j] = p.in[13 + p.z][j * 3072 + ch];
                cb[q] = p.in[14 + p.z][ch];
#pragma unroll
                for (int j = 0; j < 3; ++j) st[q][j] = p.in[3 + p.z][((size_t)b * 3 + j) * 3072 + ch];
            }
        }
#pragma unroll
        for (int t = 0; t < 4; ++t) zr[t] = proj[(size_t)t * LDP + u * 512 + tid];
        if (tid < 32) dr = proj[(size_t)(tid >> 3) * LDP + 5120 + 8 * u + (tid & 7)];
        f32x4 S[32];
#pragma unroll
        for (int i = 0; i < 32; ++i) S[i] = *(const f32x4*)(S0 + (size_t)i * ldS);
#pragma unroll
        for (int q = 0; q < 2; ++q) {
            const int idx = tid + 512 * q;
            if (idx < 768) {
                float* dst = idx < 128 ? qs + idx : (idx < 256 ? ks + (idx - 128) : xs + (idx - 256));
                const int dstr = idx < 256 ? 128 : 512;
                float c0 = st[q][0], c1 = st[q][1], c2 = st[q][2];
#pragma unroll
                for (int t = 0; t < 4; ++t) {
                    const float x = bf2f(xr[q][t]);
                    const float y = cb[q] + cw[q][0] * c0 + cw[q][1] * c1 + cw[q][2] * c2 + cw[q][3] * x;
                    c0 = c1; c1 = c2; c2 = x;
                    dst[t * dstr] = silu(y);
                }
            }
        }
#pragma unroll
        for (int t = 0; t < 4; ++t) zs[t * 512 + tid] = silu(bf2f(zr[t]));
        if (tid < 32) {
            const int hh = 8 * u + (tid & 7);
            const float dt = softplus(bf2f(dr) + p.in[15 + p.z][hh]);
            ad[2 * tid] = __expf(-dt * __expf(p.in[16 + p.z][hh])); ad[2 * tid + 1] = dt;
        }
        __syncthreads();
        const float Dh = p.in[17 + p.z][h];
#pragma unroll 1
        for (int t = 0; t < 4; ++t) {
            const f32x2 adv = *(const f32x2*)(ad + 2 * (t * 8 + w));
            const f32x4 v4 = *(const f32x4*)(xs + t * 512 + w * 64 + 4 * vq);
            f32x4 o = (f32x4){0.f, 0.f, 0.f, 0.f};
#pragma unroll
            for (int i4 = 0; i4 < 8; ++i4) {
                const f32x4 q4 = *(const f32x4*)(qs + t * 128 + 32 * kg + 4 * i4);
                const f32x4 k4 = *(const f32x4*)(ks + t * 128 + 32 * kg + 4 * i4) * adv.y;
#pragma unroll
                for (int ii = 0; ii < 4; ++ii) { S[4 * i4 + ii] = adv.x * S[4 * i4 + ii] + k4[ii] * v4; o += q4[ii] * S[4 * i4 + ii]; }
            }
#pragma unroll
            for (int j = 0; j < 4; ++j) { o[j] += __shfl_xor(o[j], 16); o[j] += __shfl_xor(o[j], 32); }
            if (kg == 0) {
                const f32x4 z4 = *(const f32x4*)(zs + t * 512 + w * 64 + 4 * vq);
                const f32x4 y = (o + Dh * v4) * z4;
                u32x2 ov; ov.x = pk2(y[0], y[1]); ov.y = pk2(y[2], y[3]);
                *(u32x2*)(yz + (size_t)t * 4096 + h * 64 + 4 * vq) = ov;
            }
        }
#pragma unroll
        for (int i = 0; i < 32; ++i) *(f32x4*)(Sout + (size_t)i * ldS) = S[i];
    } else if constexpr (TYPE == 1) {
        float* qs = ldsf; float* ks = ldsf + 1024; float* vs = ldsf + 2048;
        unsigned short x1[4], x2[4], vr[4];
        const int hl = tid >> 7, isk = (tid >> 6) & 1, jf = tid & 63;
        if (tid < 256) {
            const int col = (isk ? 6176 : 5152) + (2 * u + hl) * 128 + jf;
#pragma unroll
            for (int t = 0; t < 4; ++t) { x1[t] = proj[(size_t)t * LDP + col]; x2[t] = proj[(size_t)t * LDP + col + 64]; }
        }
#pragma unroll
        for (int t = 0; t < 4; ++t) vr[t] = proj[(size_t)t * LDP + 7200 + (2 * u + (tid >> 8)) * 256 + (tid & 255)];
        f32x4 S[32];
#pragma unroll
        for (int i = 0; i < 32; ++i) S[i] = *(const f32x4*)(S0 + (size_t)i * ldS);
        if (tid < 256) {
            const float inv = exp2f(-(float)jf * 0.20762050593046014f);
            float* dst = isk ? ks : qs; const float sc = isk ? 0.08838834764831845f : 1.0f;
#pragma unroll
            for (int t = 0; t < 4; ++t) {
                const double rev = (double)(16384 + t) * (double)inv * 0.15915494309189535;
                const float fr = (float)(rev - floor(rev));
                const float sn = __builtin_amdgcn_sinf(fr), cs = __builtin_amdgcn_cosf(fr);
                const float a1 = bf2f(x1[t]) * sc, a2 = bf2f(x2[t]) * sc;
                dst[(t * 2 + hl) * 128 + jf] = a1 * cs - a2 * sn;
                dst[(t * 2 + hl) * 128 + 64 + jf] = a1 * sn + a2 * cs;
            }
        }
#pragma unroll
        for (int t = 0; t < 4; ++t) vs[(t * 2 + (tid >> 8)) * 256 + (tid & 255)] = bf2f(vr[t]);
        __syncthreads();
        const float gamma = 1.0f - exp2f(-5.0f - (float)h * (4.0f / 7.0f));
        const int hw = w >> 2;
#pragma unroll 1
        for (int t = 0; t < 4; ++t) {
            const f32x4 v4 = *(const f32x4*)(vs + (t * 2 + hw) * 256 + sl * 64 + 4 * vq);
            f32x4 o = (f32x4){0.f, 0.f, 0.f, 0.f};
#pragma unroll
            for (int i4 = 0; i4 < 8; ++i4) {
                const f32x4 q4 = *(const f32x4*)(qs + (t * 2 + hw) * 128 + 32 * kg + 4 * i4);
                const f32x4 k4 = *(const f32x4*)(ks + (t * 2 + hw) * 128 + 32 * kg + 4 * i4);
#pragma unroll
                for (int ii = 0; ii < 4; ++ii) { S[4 * i4 + ii] = gamma * S[4 * i4 + ii] + k4[ii] * v4; o += q4[ii] * S[4 * i4 + ii]; }
            }
#pragma unroll
            for (int j = 0; j < 4; ++j) { o[j] += __shfl_xor(o[j], 16); o[j] += __shfl_xor(o[j], 32); }
            if (kg == 0) {
                u32x2 ov; ov.x = pk2(o[0], o[1]); ov.y = pk2(o[2], o[3]);
                *(u32x2*)(yz + (size_t)t * 4096 + 2048 + h * 256 + sl * 64 + 4 * vq) = ov;
            }
        }
#pragma unroll
        for (int i = 0; i < 32; ++i) *(f32x4*)(Sout + (size_t)i * ldS) = S[i];
    } else {
        float* qs = ldsf; float* ks = ldsf + 2048; float* as = ldsf + 4096; float* vs = ldsf + 6144;
        unsigned short qr[4], fr_[4], vr[4];
        const int hl = tid >> 7, kk = tid & 127, col = (4 * u + hl) * 128 + kk;
#pragma unroll
        for (int t = 0; t < 4; ++t) { qr[t] = proj[(size_t)t * LDP + col]; fr_[t] = proj[(size_t)t * LDP + 2048 + col]; vr[t] = proj[(size_t)t * LDP + 4096 + col]; }
        const float lb = ((const float*)(p.ws + WS_LB))[col];
        f32x4 S[32];
#pragma unroll
        for (int i = 0; i < 32; ++i) S[i] = *(const f32x4*)(S0 + (size_t)i * ldS);
#pragma unroll
        for (int t = 0; t < 4; ++t) {
            const int o = (t * 4 + hl) * 128 + kk;
            qs[o] = silu(bf2f(qr[t]));
            const float f = lb + (1.0f - lb) * sigm(bf2f(fr_[t]));
            as[o] = f; ks[o] = 1.0f - f; vs[o] = bf2f(vr[t]);
        }
        __syncthreads();
        const int hw = w >> 1;
#pragma unroll 1
        for (int t = 0; t < 4; ++t) {
            const f32x4 v4 = *(const f32x4*)(vs + (t * 4 + hw) * 128 + sl * 64 + 4 * vq);
            f32x4 o = (f32x4){0.f, 0.f, 0.f, 0.f};
#pragma unroll
            for (int i4 = 0; i4 < 8; ++i4) {
                const int off = (t * 4 + hw) * 128 + 32 * kg + 4 * i4;
                const f32x4 q4 = *(const f32x4*)(qs + off), k4 = *(const f32x4*)(ks + off), a4 = *(const f32x4*)(as + off);
#pragma unroll
                for (int ii = 0; ii < 4; ++ii) { S[4 * i4 + ii] = a4[ii] * S[4 * i4 + ii] + k4[ii] * v4; o += q4[ii] * S[4 * i4 + ii]; }
            }
#pragma unroll
            for (int j = 0; j < 4; ++j) { o[j] += __shfl_xor(o[j], 16); o[j] += __shfl_xor(o[j], 32); }
            if (kg == 0) {
                u32x2 ov; ov.x = pk2(o[0], o[1]); ov.y = pk2(o[2], o[3]);
                *(u32x2*)(yz + (size_t)t * 4096 + h * 128 + sl * 64 + 4 * vq) = ov;
            }
        }
#pragma unroll
        for (int i = 0; i < 32; ++i) *(f32x4*)(Sout + (size_t)i * ldS) = S[i];
    }
}

#define CK_QS 0
#define CK_KS 17408
#define CK_KT 34816
#define CK_VT 53248
#define CK_PS 62464
#define CK_ST 71680
#define CK_CUM 89088
__device__ __forceinline__ bf16x8 ck_frag(const unsigned char* lds, int base, int pitch, int row, int kb, int q) {
    return *(const bf16x8*)(lds + base + row * pitch + (32 * kb + 8 * q) * 2);
}
template <int TYPE>
__device__ __forceinline__ void chunk_item(const Params& p, unsigned char* lds, int b, int h, int s) {
    int tid = threadIdx.x; asm volatile("" : "+v"(tid));
    const int w = tid >> 6, lane = tid & 63, r = lane & 15, q = lane >> 4;
    constexpr int LDP = TYPE < 2 ? LD0 : LD1;
    const bf16_t* proj = (const bf16_t*)(p.ws + WS_PROJ) + (size_t)(2048 * b) * LDP;
    bf16_t* yz = (bf16_t*)(p.ws + WS_YZ) + (size_t)(2048 * b) * 4096;
    const int I = w >> 1, Vn0 = 2 * (w & 1);
    const int c1 = tid & 127, tq = tid >> 7;
    const int cx = tid & 63, tx = tid >> 6;
    const int g = h >> 3;
    float cwC[4], cwB[4], cwX[4], cbC = 0.f, cbB = 0.f, cbX = 0.f, inv = 0.f, dtb = 0.f, Aneg = 0.f, Dh = 0.f, sstep = 0.f, cstep = 1.f;
    (void)sstep; (void)cstep;
    int colC = 0, colB = 0, colX = 0;
    if constexpr (TYPE == 0) {
        const int chC = 2560 + g * 128 + c1, chB = 2048 + g * 128 + c1, chX = h * 64 + cx;
        colC = 2048 + chC; colB = 2048 + chB; colX = 2048 + chX;
#pragma unroll
        for (int j = 0; j < 4; ++j) { cwC[j] = p.in[13 + p.z][j * 3072 + chC]; cwB[j] = p.in[13 + p.z][j * 3072 + chB]; cwX[j] = p.in[13 + p.z][j * 3072 + chX]; }
        cbC = p.in[14 + p.z][chC]; cbB = p.in[14 + p.z][chB]; cbX = p.in[14 + p.z][chX];
        dtb = p.in[15 + p.z][h]; Aneg = -__expf(p.in[16 + p.z][h]); Dh = p.in[17 + p.z][h];
    } else if constexpr (TYPE == 1) {
        const int isk = c1 >> 6, jf = c1 & 63;
        colC = (isk ? 6176 : 5152) + h * 128 + jf; colB = colC + 64; colX = 7200 + h * 256 + s * 64 + cx;
        inv = exp2f(-(float)jf * 0.20762050593046014f);
        { const float frs = inv * 0.15915494309189535f; sstep = __builtin_amdgcn_sinf(frs); cstep = __builtin_amdgcn_cosf(frs); }
    } else {
        colC = h * 128 + c1; colB = 2048 + h * 128 + c1; colX = 4096 + h * 128 + s * 64 + cx;
        inv = ((const float*)(p.ws + WS_LB))[h * 128 + c1];
    }
    float* cumb = (float*)(lds + CK_CUM);
    if constexpr (TYPE == 1) {
        const float lg = __logf(1.0f - exp2f(-5.0f - (float)h * (4.0f / 7.0f)));
        if (tid < 64) {
#pragma unroll
            for (int bfi = 0; bfi < 2; ++bfi) { float* cb = cumb + bfi * 320; cb[tid] = (tid + 1) * lg; cb[64 + tid] = __expf((tid + 1) * lg); cb[128 + tid] = __expf((63 - tid) * lg); cb[192 + tid] = 1.0f; if (tid == 0) cb[256] = __expf(64.0f * lg); }
        }
    }
    for (int i = tid; i < 17408 / 4; i += 512) ((unsigned*)(lds + CK_ST))[i] = 0u;
    f32x4 Sacc[4];
#pragma unroll
    for (int i = 0; i < 4; ++i) Sacc[i] = (f32x4){0.f, 0.f, 0.f, 0.f};
    unsigned short xc[19], xb[19], xx[11], zr[8], dr = 0;
    auto load_raw = [&](int c) {
        const int t0 = 64 * c;
        if constexpr (TYPE == 0) {
#pragma unroll
            for (int i = 0; i < 19; ++i) { const int t = t0 + 16 * tq - 3 + i; xc[i] = 0; xb[i] = 0; if (t >= 0) { xc[i] = proj[(size_t)t * LDP + colC]; xb[i] = proj[(size_t)t * LDP + colB]; } }
#pragma unroll
            for (int i = 0; i < 11; ++i) { const int t = t0 + 8 * tx - 3 + i; xx[i] = 0; if (t >= 0) xx[i] = proj[(size_t)t * LDP + colX]; }
            if (w == 7) dr = proj[(size_t)(t0 + lane) * LDP + 5120 + h];
#pragma unroll
            for (int vv = 0; vv < 2; ++vv)
#pragma unroll
                for (int jx = 0; jx < 4; ++jx) zr[vv * 4 + jx] = proj[(size_t)(t0 + 16 * I + 4 * q + jx) * LDP + h * 64 + 16 * (Vn0 + vv) + r];
        } else {
#pragma unroll
            for (int i = 0; i < 16; ++i) { const int t = t0 + 16 * tq + i; xc[i] = proj[(size_t)t * LDP + colC]; xb[i] = proj[(size_t)t * LDP + colB]; }
#pragma unroll
            for (int i = 0; i < 8; ++i) xx[i] = proj[(size_t)(t0 + 8 * tx + i) * LDP + colX];
        }
    };
    load_raw(0);
    for (int c = 0; c < 32; ++c) {
        const int t0 = 64 * c;
        float* cum = cumb + (TYPE == 0 ? (c & 1) * 320 : 0);
        float vq_[16], vk_[16], vx_[8], kt_[16], Eval = 0.f;
        (void)kt_; (void)Eval;
        if constexpr (TYPE == 0) {
#pragma unroll
            for (int i = 0; i < 16; ++i) {
                vq_[i] = silu(cbC + cwC[0] * bf2f(xc[i]) + cwC[1] * bf2f(xc[i + 1]) + cwC[2] * bf2f(xc[i + 2]) + cwC[3] * bf2f(xc[i + 3]));
                vk_[i] = silu(cbB + cwB[0] * bf2f(xb[i]) + cwB[1] * bf2f(xb[i + 1]) + cwB[2] * bf2f(xb[i + 2]) + cwB[3] * bf2f(xb[i + 3]));
            }
#pragma unroll
            for (int i = 0; i < 8; ++i) vx_[i] = silu(cbX + cwX[0] * bf2f(xx[i]) + cwX[1] * bf2f(xx[i + 1]) + cwX[2] * bf2f(xx[i + 2]) + cwX[3] * bf2f(xx[i + 3]));
            if (w == 7) {
                const float dt = softplus(bf2f(dr) + dtb);
                float cs = dt * Aneg;
#pragma unroll
                for (int o = 1; o < 64; o <<= 1) { const float t = __shfl_up(cs, o); if (lane >= o) cs += t; }
                const float last = __shfl(cs, 63);
                cum[lane] = cs; cum[64 + lane] = __expf(cs); cum[128 + lane] = __expf(last - cs); cum[192 + lane] = dt;
                if (lane == 0) cum[256] = __expf(last);
            }
        } else if constexpr (TYPE == 2) {
            float pr[16], om[16];
            float run = 1.f;
#pragma unroll
            for (int i = 0; i < 16; ++i) { const float f = inv + (1.0f - inv) * sigm(bf2f(xb[i])); run *= f; pr[i] = run; om[i] = 1.0f - f; }
#pragma unroll
            for (int i = 0; i < 16; ++i) { const float ip = __builtin_amdgcn_rcpf(pr[i]); vq_[i] = silu(bf2f(xc[i])) * pr[i]; vk_[i] = om[i] * ip; kt_[i] = om[i] * ip * run; }
            Eval = run;
#pragma unroll
            for (int i = 0; i < 8; ++i) vx_[i] = bf2f(xx[i]);
        } else {
            {
                const double rev = (double)(t0 + 16 * tq) * (double)inv * 0.15915494309189535;
                const float fr = (float)(rev - floor(rev));
                float sn = __builtin_amdgcn_sinf(fr), cs = __builtin_amdgcn_cosf(fr);
#pragma unroll
                for (int i = 0; i < 16; ++i) {
                    const float a1 = bf2f(xc[i]), a2 = bf2f(xb[i]);
                    vq_[i] = a1 * cs - a2 * sn; vk_[i] = a1 * sn + a2 * cs;
                    const float c2 = cs * cstep - sn * sstep, s2 = sn * cstep + cs * sstep;
                    cs = c2; sn = s2;
                }
            }
#pragma unroll
            for (int i = 0; i < 8; ++i) vx_[i] = bf2f(xx[i]);
        }
        unsigned short zc[8];
#pragma unroll
        for (int i = 0; i < 8; ++i) zc[i] = zr[i];
        __syncthreads();
        if constexpr (TYPE == 0) {
            unsigned kt[8];
#pragma unroll
            for (int i = 0; i < 16; i += 2) {
                const int t = 16 * tq + i;
                const float k0 = vk_[i] * cum[192 + t], k1 = vk_[i + 1] * cum[192 + t + 1];
                *(bf16_t*)(lds + CK_QS + t * 272 + c1 * 2) = f2bf(vq_[i]); *(bf16_t*)(lds + CK_QS + (t + 1) * 272 + c1 * 2) = f2bf(vq_[i + 1]);
                *(bf16_t*)(lds + CK_KS + t * 272 + c1 * 2) = f2bf(k0); *(bf16_t*)(lds + CK_KS + (t + 1) * 272 + c1 * 2) = f2bf(k1);
                kt[i >> 1] = pk2(k0 * cum[128 + t], k1 * cum[128 + t + 1]);
            }
            *(u32x4*)(lds + CK_KT + c1 * 144 + 32 * tq) = (u32x4){kt[0], kt[1], kt[2], kt[3]};
            *(u32x4*)(lds + CK_KT + c1 * 144 + 32 * tq + 16) = (u32x4){kt[4], kt[5], kt[6], kt[7]};
        } else if constexpr (TYPE == 2) {
            unsigned kt[8];
#pragma unroll
            for (int i = 0; i < 16; i += 2) {
                const int t = 16 * tq + i;
                *(bf16_t*)(lds + CK_QS + t * 272 + c1 * 2) = f2bf(vq_[i]); *(bf16_t*)(lds + CK_QS + (t + 1) * 272 + c1 * 2) = f2bf(vq_[i + 1]);
                *(bf16_t*)(lds + CK_KS + t * 272 + c1 * 2) = f2bf(vk_[i]); *(bf16_t*)(lds + CK_KS + (t + 1) * 272 + c1 * 2) = f2bf(vk_[i + 1]);
                kt[i >> 1] = pk2(kt_[i], kt_[i + 1]);
            }
            *(u32x4*)(lds + CK_KT + c1 * 144 + 32 * tq) = (u32x4){kt[0], kt[1], kt[2], kt[3]};
            *(u32x4*)(lds + CK_KT + c1 * 144 + 32 * tq + 16) = (u32x4){kt[4], kt[5], kt[6], kt[7]};
            cum[tq * 128 + c1] = Eval;
        } else {
            const int isk = c1 >> 6, jf = c1 & 63;
            if (isk == 0) {
#pragma unroll
                for (int i = 0; i < 16; ++i) { const int t = 16 * tq + i; *(bf16_t*)(lds + CK_QS + t * 272 + jf * 2) = f2bf(vq_[i]); *(bf16_t*)(lds + CK_QS + t * 272 + (jf + 64) * 2) = f2bf(vk_[i]); }
            } else {
                unsigned kta[8], ktb[8];
#pragma unroll
                for (int i = 0; i < 16; i += 2) {
                    const int t = 16 * tq + i;
                    const float a0 = vq_[i] * 0.08838834764831845f, a1 = vq_[i + 1] * 0.08838834764831845f, b0 = vk_[i] * 0.08838834764831845f, b1 = vk_[i + 1] * 0.08838834764831845f;
                    *(bf16_t*)(lds + CK_KS + t * 272 + jf * 2) = f2bf(a0); *(bf16_t*)(lds + CK_KS + (t + 1) * 272 + jf * 2) = f2bf(a1);
                    *(bf16_t*)(lds + CK_KS + t * 272 + (jf + 64) * 2) = f2bf(b0); *(bf16_t*)(lds + CK_KS + (t + 1) * 272 + (jf + 64) * 2) = f2bf(b1);
                    kta[i >> 1] = pk2(a0 * cum[128 + t], a1 * cum[128 + t + 1]); ktb[i >> 1] = pk2(b0 * cum[128 + t], b1 * cum[128 + t + 1]);
                }
                *(u32x4*)(lds + CK_KT + jf * 144 + 32 * tq) = (u32x4){kta[0], kta[1], kta[2], kta[3]};
                *(u32x4*)(lds + CK_KT + jf * 144 + 32 * tq + 16) = (u32x4){kta[4], kta[5], kta[6], kta[7]};
                *(u32x4*)(lds + CK_KT + (jf + 64) * 144 + 32 * tq) = (u32x4){ktb[0], ktb[1], ktb[2], ktb[3]};
                *(u32x4*)(lds + CK_KT + (jf + 64) * 144 + 32 * tq + 16) = (u32x4){ktb[4], ktb[5], ktb[6], ktb[7]};
            }
        }
        *(u32x4*)(lds + CK_VT + cx * 144 + 16 * tx) = (u32x4){pk2(vx_[0], vx_[1]), pk2(vx_[2], vx_[3]), pk2(vx_[4], vx_[5]), pk2(vx_[6], vx_[7])};
        __syncthreads();
        if (c + 1 < 32) load_raw(c + 1);
        if constexpr (TYPE < 2) {
        bf16x8 aQ[4];
#pragma unroll
        for (int kb = 0; kb < 4; ++kb) aQ[kb] = ck_frag(lds, CK_QS, 272, 16 * I + r, kb, q);
        float cumi[4];
#pragma unroll
        for (int jx = 0; jx < 4; ++jx) cumi[jx] = cum[16 * I + 4 * q + jx];
#pragma unroll
        for (int jj = 0; jj < 2; ++jj) {
            const int J = Vn0 + jj;
            f32x4 acc = (f32x4){0.f, 0.f, 0.f, 0.f};
#pragma unroll
            for (int kb = 0; kb < 4; ++kb) acc = __builtin_amdgcn_mfma_f32_16x16x32_bf16(aQ[kb], ck_frag(lds, CK_KS, 272, 16 * J + r, kb, q), acc, 0, 0, 0);
            const int jcol = 16 * J + r; const float cumj = cum[jcol];
#pragma unroll
            for (int jx = 0; jx < 4; ++jx) {
                const int i = 16 * I + 4 * q + jx;
                const float v = (jcol <= i) ? acc[jx] * __expf(fminf(cumi[jx] - cumj, 0.f)) : 0.f;
                *(bf16_t*)(lds + CK_PS + i * 144 + jcol * 2) = f2bf(v);
            }
        }
        __syncthreads();
#pragma unroll
        for (int vv = 0; vv < 2; ++vv) {
            const int Vn = Vn0 + vv;
            f32x4 aPV = (f32x4){0.f, 0.f, 0.f, 0.f}, aQS = (f32x4){0.f, 0.f, 0.f, 0.f};
#pragma unroll
            for (int jb = 0; jb < 2; ++jb) aPV = __builtin_amdgcn_mfma_f32_16x16x32_bf16(ck_frag(lds, CK_PS, 144, 16 * I + r, jb, q), ck_frag(lds, CK_VT, 144, 16 * Vn + r, jb, q), aPV, 0, 0, 0);
#pragma unroll
            for (int kb = 0; kb < 4; ++kb) aQS = __builtin_amdgcn_mfma_f32_16x16x32_bf16(aQ[kb], ck_frag(lds, CK_ST, 272, 16 * Vn + r, kb, q), aQS, 0, 0, 0);
#pragma unroll
            for (int jx = 0; jx < 4; ++jx) {
                const int i = 16 * I + 4 * q + jx, v = 16 * Vn + r;
                const float o = aPV[jx] + cum[64 + i] * aQS[jx];
                if constexpr (TYPE == 0) {
                    const float xsv = bf2f(*(const bf16_t*)(lds + CK_VT + v * 144 + i * 2));
                    yz[(size_t)(t0 + i) * 4096 + h * 64 + v] = f2bf((o + Dh * xsv) * silu(bf2f(zc[vv * 4 + jx])));
                } else {
                    yz[(size_t)(t0 + i) * 4096 + 2048 + h * 256 + s * 64 + v] = f2bf(o);
                }
            }
        }
        __syncthreads();
        const float elast = cum[256];
#pragma unroll
        for (int Vn = 0; Vn < 4; ++Vn) {
            Sacc[Vn] = Sacc[Vn] * elast;
#pragma unroll
            for (int tb = 0; tb < 2; ++tb) Sacc[Vn] = __builtin_amdgcn_mfma_f32_16x16x32_bf16(ck_frag(lds, CK_KT, 144, 16 * w + r, tb, q), ck_frag(lds, CK_VT, 144, 16 * Vn + r, tb, q), Sacc[Vn], 0, 0, 0);
            *(u32x2*)(lds + CK_ST + (16 * Vn + r) * 272 + (16 * w + 4 * q) * 2) = (u32x2){pk2_sw(Sacc[Vn][0], Sacc[Vn][1]), pk2_sw(Sacc[Vn][2], Sacc[Vn][3])};
        }
            } else {
            const bf16x8 zf = (bf16x8){0, 0, 0, 0, 0, 0, 0, 0};
            if ((w & 1) == 0) {
                f32x4 acc = (f32x4){0.f, 0.f, 0.f, 0.f};
#pragma unroll
                for (int kb = 0; kb < 4; ++kb) acc = __builtin_amdgcn_mfma_f32_16x16x32_bf16(ck_frag(lds, CK_QS, 272, 16 * I + r, kb, q), ck_frag(lds, CK_KS, 272, 16 * I + r, kb, q), acc, 0, 0, 0);
#pragma unroll
                for (int jx = 0; jx < 4; ++jx) {
                    const float v = (r <= 4 * q + jx) ? acc[jx] : 0.f;
                    *(bf16_t*)(lds + CK_PS + (16 * I + 4 * q + jx) * 144 + (16 * I + r) * 2) = f2bf(v);
                }
            }
            __syncthreads();
#pragma unroll 1
            for (int sc = 0; sc < 4; ++sc) {
                if (w < 4) {
                    const int Vn = w;
                    f32x4 aO = (f32x4){0.f, 0.f, 0.f, 0.f};
                    const bf16x8 pa = (q < 2) ? *(const bf16x8*)(lds + CK_PS + (16 * sc + r) * 144 + (16 * sc + 8 * q) * 2) : zf;
                    const bf16x8 vb = (q < 2) ? *(const bf16x8*)(lds + CK_VT + (16 * Vn + r) * 144 + (16 * sc + 8 * q) * 2) : zf;
                    aO = __builtin_amdgcn_mfma_f32_16x16x32_bf16(pa, vb, aO, 0, 0, 0);
#pragma unroll
                    for (int kb = 0; kb < 4; ++kb) aO = __builtin_amdgcn_mfma_f32_16x16x32_bf16(ck_frag(lds, CK_QS, 272, 16 * sc + r, kb, q), ck_frag(lds, CK_ST, 272, 16 * Vn + r, kb, q), aO, 0, 0, 0);
#pragma unroll
                    for (int jx = 0; jx < 4; ++jx) yz[(size_t)(t0 + 16 * sc + 4 * q + jx) * 4096 + h * 128 + s * 64 + 16 * Vn + r] = (bf16_t)(pk2_sw(aO[jx], 0.f) & 0xffffu);
                }
                __syncthreads();
                {
                    const f32x4 e4 = *(const f32x4*)(cum + sc * 128 + 16 * w + 4 * q);
                    const bf16x8 ka = (q < 2) ? *(const bf16x8*)(lds + CK_KT + (16 * w + r) * 144 + (16 * sc + 8 * q) * 2) : zf;
#pragma unroll
                    for (int Vn = 0; Vn < 4; ++Vn) {
                        const bf16x8 vb = (q < 2) ? *(const bf16x8*)(lds + CK_VT + (16 * Vn + r) * 144 + (16 * sc + 8 * q) * 2) : zf;
                        Sacc[Vn] = __builtin_amdgcn_mfma_f32_16x16x32_bf16(ka, vb, Sacc[Vn] * e4, 0, 0, 0);
                        *(u32x2*)(lds + CK_ST + (16 * Vn + r) * 272 + (16 * w + 4 * q) * 2) = (u32x2){pk2_sw(Sacc[Vn][0], Sacc[Vn][1]), pk2_sw(Sacc[Vn][2], Sacc[Vn][3])};
                    }
                }
                __syncthreads();
            }
        }
    }
    const int ldS = TYPE == 0 ? 64 : (TYPE == 1 ? 256 : 128);
    float* Sout = p.out + (TYPE == 0 ? O_SSMP + ((size_t)(b * 32 + h) * 128) * 64 : (TYPE == 1 ? O_RETP + ((size_t)(b * 8 + h) * 128) * 256 + s * 64 : O_HGP + ((size_t)(b * 16 + h) * 128) * 128 + s * 64));
#pragma unroll
    for (int Vn = 0; Vn < 4; ++Vn)
#pragma unroll
        for (int jx = 0; jx < 4; ++jx) Sout[(size_t)(16 * w + 4 * q + jx) * ldS + 16 * Vn + r] = Sacc[Vn][jx];
}

__device__ __forceinline__ void lru_dec_unit(const Params& p, int b) {
    int tid = threadIdx.x; asm volatile("" : "+v"(tid));
    const int c = tid * 4;
    const int row0 = MP + 4 * b;
    const float* LA = (const float*)(p.ws + WS_LA) + (size_t)row0 * 2048 + c;
    const bf16_t* LBv = (const bf16_t*)(p.ws + WS_LBB) + (size_t)row0 * 2048 + c;
    const bf16_t* rg = (const bf16_t*)(p.ws + WS_PROJ) + (size_t)row0 * LD1 + 10240 + c;
    bf16_t* mixa = (bf16_t*)(p.ws + WS_ACT) + (size_t)row0 * 4096 + 2048 + c;
    f32x4 hst = *(const f32x4*)(p.in[6 + p.z] + (size_t)b * 2048 + c);
#pragma unroll
    for (int t = 0; t < 4; ++t) {
        const f32x4 a = *(const f32x4*)(LA + (size_t)t * 2048);
        float bb[4], gg[4]; unpack4(*(const u32x2*)(LBv + (size_t)t * 2048), bb); unpack4(*(const u32x2*)(rg + (size_t)t * LD1), gg);
        float y[4];
#pragma unroll
        for (int j = 0; j < 4; ++j) { hst[j] = a[j] * hst[j] + bb[j]; y[j] = hst[j] * gelu_tanh(gg[j]); }
        u32x2 ov; ov.x = pk2(y[0], y[1]); ov.y = pk2(y[2], y[3]);
        *(u32x2*)(mixa + (size_t)t * 4096) = ov;
    }
    *(f32x4*)(p.out + O_LRUS + (size_t)b * 2048 + c) = hst;
}

__device__ __forceinline__ void lru_scan_item(const Params& p, float* ldsf, int b, int cg) {
    int tid = threadIdx.x; asm volatile("" : "+v"(tid));
    const int w = tid >> 6, lane = tid & 63, c = cg * 64 + lane;
    const size_t row0 = (size_t)2048 * b + 256 * w;
    const float* LA = (const float*)(p.ws + WS_LA) + row0 * 2048 + c;
    const bf16_t* LBv = (const bf16_t*)(p.ws + WS_LBB) + row0 * 2048 + c;
    const bf16_t* rg = (const bf16_t*)(p.ws + WS_PROJ) + row0 * LD1 + 10240 + c;
    bf16_t* mixa = (bf16_t*)(p.ws + WS_ACT) + row0 * 4096 + 2048 + c;
    float hl = 0.f, pr = 1.f;
    for (int tb = 0; tb < 256; tb += 16) {
        float a0[16]; unsigned short b0[16];
#pragma unroll
        for (int t = 0; t < 16; ++t) { a0[t] = LA[(size_t)(tb + t) * 2048]; b0[t] = LBv[(size_t)(tb + t) * 2048]; }
#pragma unroll
        for (int t = 0; t < 16; ++t) { hl = a0[t] * hl + bf2f(b0[t]); pr *= a0[t]; }
    }
    ldsf[w * 128 + lane] = pr; ldsf[w * 128 + 64 + lane] = hl;
    __syncthreads();
    float hst = 0.f;
    for (int ww = 0; ww < w; ++ww) hst = ldsf[ww * 128 + lane] * hst + ldsf[ww * 128 + 64 + lane];
    for (int tb = 0; tb < 256; tb += 16) {
        float a0[16]; unsigned short b0[16], g0[16];
#pragma unroll
        for (int t = 0; t < 16; ++t) { a0[t] = LA[(size_t)(tb + t) * 2048]; b0[t] = LBv[(size_t)(tb + t) * 2048]; g0[t] = rg[(size_t)(tb + t) * LD1]; }
#pragma unroll
        for (int t = 0; t < 16; ++t) {
            hst = a0[t] * hst + bf2f(b0[t]);
            mixa[(size_t)(tb + t) * 4096] = f2bf(hst * gelu_tanh(bf2f(g0[t])));
        }
    }
    if (w == 7) p.out[O_LRUP + (size_t)b * 2048 + c] = hst;
}

__device__ __forceinline__ void phase_rec0(const Params& p, float* ldsf) {
    unsigned* ctr = (unsigned*)(p.ws + WS_CTL);
    const int total = 256 + 512 + 512;
    for (;;) {
        const int it = next_item(ctr, ldsf);
        if (it >= total) break;
        if (it < 128) chunk_item<0>(p, (unsigned char*)ldsf, it >> 5, it & 31, 0);
        else if (it < 256) { const int j = it - 128; chunk_item<1>(p, (unsigned char*)ldsf, j >> 5, (j & 31) >> 2, j & 3); }
        else if (it < 768) { const int j = it - 256; dec_unit<0>(p, ldsf, j >> 2, j & 3); }
        else { const int j = it - 768; dec_unit<1>(p, ldsf, j >> 2, j & 3); }
    }
}
__device__ __forceinline__ void phase_rec1(const Params& p, float* ldsf) {
    unsigned* ctr = (unsigned*)(p.ws + WS_CTL) + 64;
    const int total = 128 + 128 + 512 + 128;
    for (;;) {
        const int it = next_item(ctr, ldsf);
        if (it >= total) break;
        if (it < 128) chunk_item<2>(p, (unsigned char*)ldsf, it >> 5, (it & 31) >> 1, it & 1);
        else if (it < 256) { const int j = it - 128; lru_scan_item(p, ldsf, j >> 5, j & 31); }
        else if (it < 768) { const int j = it - 256; dec_unit<2>(p, ldsf, j >> 2, j & 3); }
        else lru_dec_unit(p, it - 768);
    }
}

__device__ __forceinline__ void seq_of_row(int row, int& sample, int& b, int& t, int& L) {
    if (row < MP) { sample = 0; b = row >> 11; t = row & 2047; L = 2048; } else { sample = 1; b = (row - MP) >> 2; t = (row - MP) & 3; L = 4; }
}

__device__ __forceinline__ void phase_prep0(const Params& p) {
    int tid = threadIdx.x; asm volatile("" : "+v"(tid));
    const int wave = tid >> 6, lane = tid & 63;
    const int gw = blockIdx.x * 8 + wave, NGW = gridDim.x * 8;
    const bf16_t* YZ = (const bf16_t*)(p.ws + WS_YZ); const bf16_t* PR = (const bf16_t*)(p.ws + WS_PROJ);
    bf16_t* MX = (bf16_t*)(p.ws + WS_ACT);
    const float* nw = p.in[18 + p.z];
    u32x4 nya[4]; u32x2 nyb[8], ngb[8];
    auto ldrow = [&](int row) {
#pragma unroll
        for (int g = 0; g < 4; ++g) nya[g] = *(const u32x4*)(YZ + (size_t)row * 4096 + g * 512 + lane * 8);
#pragma unroll
        for (int hh = 0; hh < 8; ++hh) { nyb[hh] = *(const u32x2*)(YZ + (size_t)row * 4096 + 2048 + hh * 256 + lane * 4); ngb[hh] = *(const u32x2*)(PR + (size_t)row * LD0 + 9248 + hh * 256 + lane * 4); }
    };
    if (gw < MT) ldrow(gw);
    for (int row = gw; row < MT; row += NGW) {
        bf16_t* mx = MX + (size_t)row * 4096;
        u32x4 ya[4]; u32x2 yb[8], gb[8];
#pragma unroll
        for (int g = 0; g < 4; ++g) ya[g] = nya[g];
#pragma unroll
        for (int hh = 0; hh < 8; ++hh) { yb[hh] = nyb[hh]; gb[hh] = ngb[hh]; }
        if (row + NGW < MT) ldrow(row + NGW);
#pragma unroll
        for (int g = 0; g < 4; ++g) {
            const int c = g * 512 + lane * 8;
            float v[8]; unpack8(ya[g], v);
            float s = 0.f;
#pragma unroll
            for (int j = 0; j < 8; ++j) s += v[j] * v[j];
            s = wave_sum(s);
            const float rs = rsqrtf(s * (1.0f / 512.0f) + EPS);
            const f32x4 n0 = *(const f32x4*)(nw + c), n1 = *(const f32x4*)(nw + c + 4);
            u32x4 o; o.x = pk2(v[0] * rs * n0[0], v[1] * rs * n0[1]); o.y = pk2(v[2] * rs * n0[2], v[3] * rs * n0[3]);
            o.z = pk2(v[4] * rs * n1[0], v[5] * rs * n1[1]); o.w = pk2(v[6] * rs * n1[2], v[7] * rs * n1[3]);
            *(u32x4*)(mx + c) = o;
        }
#pragma unroll
        for (int hh = 0; hh < 8; ++hh) {
            const int c = hh * 256 + lane * 4;
            float v[4]; unpack4(yb[hh], v);
            float gt[4]; unpack4(gb[hh], gt);
            float s = (v[0] * v[0] + v[1] * v[1]) + (v[2] * v[2] + v[3] * v[3]);
            s = wave_sum(s);
            const float rs = rsqrtf(s * (1.0f / 256.0f) + EPS);
            u32x2 o; o.x = pk2(v[0] * rs * silu(gt[0]), v[1] * rs * silu(gt[1])); o.y = pk2(v[2] * rs * silu(gt[2]), v[3] * rs * silu(gt[3]));
            *(u32x2*)(mx + 2048 + c) = o;
        }
        int sample, b, t, L; seq_of_row(row, sample, b, t, L);
        if (t >= L - 3) {
            float* dst = p.out + (sample ? O_SCS : O_SCP) + ((size_t)b * 3 + (t - (L - 3))) * 3072;
            const bf16_t* src = PR + (size_t)row * LD0 + 2048;
#pragma unroll 4
            for (int c = lane; c < 3072; c += 64) dst[c] = bf2f(src[c]);
        }
    }
}

__device__ __forceinline__ void phase_prep1(const Params& p) {
    int tid = threadIdx.x; asm volatile("" : "+v"(tid));
    const int wave = tid >> 6, lane = tid & 63;
    const int gw = blockIdx.x * 8 + wave, NGW = gridDim.x * 8;
    const bf16_t* YZ = (const bf16_t*)(p.ws + WS_YZ); const bf16_t* PR = (const bf16_t*)(p.ws + WS_PROJ);
    bf16_t* MX = (bf16_t*)(p.ws + WS_ACT);
    const float* nw = p.in[22 + p.z];
    u32x4 nya[4], nga[4];
    auto ldrow = [&](int row) {
#pragma unroll
        for (int it = 0; it < 4; ++it) { nya[it] = *(const u32x4*)(YZ + (size_t)row * 4096 + it * 512 + lane * 8); nga[it] = *(const u32x4*)(PR + (size_t)row * LD1 + 6144 + it * 512 + lane * 8); }
    };
    if (gw < MT) ldrow(gw);
    for (int row = gw; row < MT; row += NGW) {
        u32x4 ya[4], ga[4];
#pragma unroll
        for (int it = 0; it < 4; ++it) { ya[it] = nya[it]; ga[it] = nga[it]; }
        if (row + NGW < MT) ldrow(row + NGW);
#pragma unroll
        for (int it = 0; it < 4; ++it) {
            const int c = it * 512 + lane * 8;
            float v[8]; unpack8(ya[it], v);
            float gt[8]; unpack8(ga[it], gt);
            float s = 0.f;
#pragma unroll
            for (int j = 0; j < 8; ++j) s += v[j] * v[j];
            s += __shfl_xor(s, 1); s += __shfl_xor(s, 2); s += __shfl_xor(s, 4); s += __shfl_xor(s, 8);
            const float rs = rsqrtf(s * (1.0f / 128.0f) + EPS);
            const f32x4 n0 = *(const f32x4*)(nw + (c & 127)), n1 = *(const f32x4*)(nw + (c & 127) + 4);
            float o[8];
#pragma unroll
            for (int j = 0; j < 8; ++j) o[j] = v[j] * rs * (j < 4 ? n0[j] : n1[j - 4]) * silu(gt[j]);
            u32x4 ov; ov.x = pk2(o[0], o[1]); ov.y = pk2(o[2], o[3]); ov.z = pk2(o[4], o[5]); ov.w = pk2(o[6], o[7]);
            *(u32x4*)(MX + (size_t)row * 4096 + c) = ov;
        }
    }
}

__device__ __forceinline__ void phase_act(const Params& p, int l) {
    int tid = threadIdx.x; asm volatile("" : "+v"(tid));
    const bf16_t* PR = (const bf16_t*)(p.ws + WS_PROJ); bf16_t* ACT = (bf16_t*)(p.ws + WS_ACT);
    const float* cw = p.in[32 + p.z] + (size_t)l * 3 * DFF; const float* cbv = p.in[33 + p.z] + (size_t)l * DFF;
    const float* st = p.in[8 + p.z] + (size_t)l * 128 * 2 * DFF;
    const int total = (MT / 4) * 704;
    for (int idx = blockIdx.x * 512 + tid; idx < total; idx += gridDim.x * 512) {
        const int rb = idx / 704, c = (idx - rb * 704) * 8, r0 = rb * 4;
        int sample, b, t0, L; seq_of_row(r0, sample, b, t0, L);
        u32x4 gr[6], ur[4];
#pragma unroll
        for (int i = 0; i < 4; ++i) { gr[i + 2] = *(const u32x4*)(PR + (size_t)(r0 + i) * LDU + c); ur[i] = *(const u32x4*)(PR + (size_t)(r0 + i) * LDU + DFF + c); }
        float g[6][8];
        if (t0 >= 2) { gr[0] = *(const u32x4*)(PR + (size_t)(r0 - 2) * LDU + c); gr[1] = *(const u32x4*)(PR + (size_t)(r0 - 1) * LDU + c); unpack8(gr[0], g[0]); unpack8(gr[1], g[1]); }
        else {
#pragma unroll
            for (int j = 0; j < 8; ++j) { g[0][j] = sample ? st[((size_t)b * 2 + 0) * DFF + c + j] : 0.f; g[1][j] = sample ? st[((size_t)b * 2 + 1) * DFF + c + j] : 0.f; }
        }
#pragma unroll
        for (int i = 0; i < 4; ++i) unpack8(gr[i + 2], g[i + 2]);
        float w0[8], w1[8], w2[8], bb[8];
#pragma unroll
        for (int j = 0; j < 8; ++j) { w0[j] = cw[c + j]; w1[j] = cw[DFF + c + j]; w2[j] = cw[2 * DFF + c + j]; bb[j] = cbv[c + j]; }
#pragma unroll
        for (int i = 0; i < 4; ++i) {
            float uu[8], o[8]; unpack8(ur[i], uu);
#pragma unroll
            for (int j = 0; j < 8; ++j) o[j] = silu(bb[j] + w0[j] * g[i][j] + w1[j] * g[i + 1][j] + w2[j] * g[i + 2][j]) * uu[j];
            u32x4 ov; ov.x = pk2(o[0], o[1]); ov.y = pk2(o[2], o[3]); ov.z = pk2(o[4], o[5]); ov.w = pk2(o[6], o[7]);
            *(u32x4*)(ACT + (size_t)(r0 + i) * DFF + c) = ov;
        }
        if (t0 + 4 == L) {
#pragma unroll
            for (int i = 0; i < 2; ++i) {
                float* dst = p.out + (sample ? O_FCS + (((size_t)l * 128 + b) * 2 + i) * DFF : O_FCP + (((size_t)l * 4 + b) * 2 + i) * DFF) + c;
                *(f32x4*)dst = (f32x4){g[4 + i][0], g[4 + i][1], g[4 + i][2], g[4 + i][3]}; *(f32x4*)(dst + 4) = (f32x4){g[4 + i][4], g[4 + i][5], g[4 + i][6], g[4 + i][7]};
            }
        }
    }
}

__device__ __forceinline__ void phase_lruconv(const Params& p) {
    int tid = threadIdx.x; asm volatile("" : "+v"(tid));
    const bf16_t* PR = (const bf16_t*)(p.ws + WS_PROJ); bf16_t* XR = (bf16_t*)(p.ws + WS_XR);
    const float* cw = p.in[23 + p.z]; const float* cbv = p.in[24 + p.z]; const float* st = p.in[7 + p.z];
    const int total = (MT / 4) * 256;
    for (int idx = blockIdx.x * 512 + tid; idx < total; idx += gridDim.x * 512) {
        const int rb = idx >> 8, c = (idx & 255) * 8, r0 = rb * 4;
        int sample, b, t0, L; seq_of_row(r0, sample, b, t0, L);
        float x[7][8];
#pragma unroll
        for (int j = 3; j < 7; ++j) unpack8(*(const u32x4*)(PR + (size_t)(r0 - 3 + j) * LD1 + 8192 + c), x[j]);
        if (t0 >= 3) {
#pragma unroll
            for (int j = 0; j < 3; ++j) unpack8(*(const u32x4*)(PR + (size_t)(r0 - 3 + j) * LD1 + 8192 + c), x[j]);
        } else {
#pragma unroll
            for (int j = 0; j < 3; ++j)
#pragma unroll
                for (int i = 0; i < 8; ++i) x[j][i] = sample ? st[((size_t)b * 3 + j) * 2048 + c + i] : 0.f;
        }
        float w0[8], w1[8], w2[8], w3[8], bb[8];
#pragma unroll
        for (int i = 0; i < 8; ++i) { w0[i] = cw[c + i]; w1[i] = cw[2048 + c + i]; w2[i] = cw[4096 + c + i]; w3[i] = cw[6144 + c + i]; bb[i] = cbv[c + i]; }
#pragma unroll
        for (int rr = 0; rr < 4; ++rr) {
            float o[8];
#pragma unroll
            for (int i = 0; i < 8; ++i) o[i] = bb[i] + w0[i] * x[rr][i] + w1[i] * x[rr + 1][i] + w2[i] * x[rr + 2][i] + w3[i] * x[rr + 3][i];
            u32x4 ov; ov.x = pk2(o[0], o[1]); ov.y = pk2(o[2], o[3]); ov.z = pk2(o[4], o[5]); ov.w = pk2(o[6], o[7]);
            *(u32x4*)(XR + (size_t)(r0 + rr) * 2048 + c) = ov;
        }
        if (t0 + 4 == L) {
#pragma unroll
            for (int j = 0; j < 3; ++j) {
                float* dst = p.out + (sample ? O_LCS : O_LCP) + ((size_t)b * 3 + j) * 2048 + c;
                *(f32x4*)dst = (f32x4){x[4 + j][0], x[4 + j][1], x[4 + j][2], x[4 + j][3]}; *(f32x4*)(dst + 4) = (f32x4){x[4 + j][4], x[4 + j][5], x[4 + j][6], x[4 + j][7]};
            }
        }
    }
}

template <int NS>
__device__ __forceinline__ void finalize_sample_rows(const Params& p, float* ssdst) {
    int tid = threadIdx.x; asm volatile("" : "+v"(tid));
    float* X = (float*)(p.ws + WS_X); bf16_t* XB = (bf16_t*)(p.ws + WS_XB); const float* PT = (const float*)(p.ws + WS_PROJ);
    for (int item = blockIdx.x * 512 + tid; item < 512 * 512; item += gridDim.x * 512) {
        const int row = item >> 9, c4 = item & 511;
        const unsigned o = (unsigned)(MP + row) * 2048u + (unsigned)c4 * 4u, po = (unsigned)row * 2048u + (unsigned)c4 * 4u;
        f32x4 v = *(const f32x4*)(X + o);
        f32x4 pv[NS];
#pragma unroll
        for (int ks = 0; ks < NS; ++ks) pv[ks] = *(const f32x4*)(PT + (size_t)ks * (512 * 2048) + po);
#pragma unroll
        for (int ks = 0; ks < NS; ++ks) v += pv[ks];
        *(f32x4*)(X + o) = v;
        u32x2 w; w.x = pk2(v[0], v[1]); w.y = pk2(v[2], v[3]);
        *(u32x2*)(XB + o) = w;
        float s2 = (v[0] * v[0] + v[1] * v[1]) + (v[2] * v[2] + v[3] * v[3]);
        s2 = wave_sum(s2);
        if ((tid & 63) == 0) atomicAdd(ssdst + MP + row, s2);
    }
}

__device__ __forceinline__ void phase_final(const Params& p) {
    int tid = threadIdx.x; asm volatile("" : "+v"(tid));
    const int wave = tid >> 6, lane = tid & 63;
    const int gw = blockIdx.x * 8 + wave, NGW = gridDim.x * 8;
    const float* X = (const float*)(p.ws + WS_X); const float* nf = p.in[11 + p.z];
    f32x4 nv[8];
    auto ldrow = [&](int row) {
#pragma unroll
        for (int j = 0; j < 8; ++j) nv[j] = *(const f32x4*)(X + (size_t)row * 2048 + (lane + 64 * j) * 4);
    };
    if (gw < MT) ldrow(gw);
    for (int row = gw; row < MT; row += NGW) {
        f32x4 v[8]; float sq = 0.f;
#pragma unroll
        for (int j = 0; j < 8; ++j) v[j] = nv[j];
        if (row + NGW < MT) ldrow(row + NGW);
        if (row >= MP) {
#pragma unroll
            for (int j = 0; j < 8; ++j) {
                f32x4 pv[11];
#pragma unroll
                for (int ks = 0; ks < 11; ++ks) pv[ks] = *(const f32x4*)((const float*)(p.ws + WS_PROJ) + (size_t)ks * (512 * 2048) + (size_t)(row - MP) * 2048 + (lane + 64 * j) * 4);
#pragma unroll
                for (int ks = 0; ks < 11; ++ks) v[j] += pv[ks];
            }
        }
#pragma unroll
        for (int j = 0; j < 8; ++j) sq += (v[j][0] * v[j][0] + v[j][1] * v[j][1]) + (v[j][2] * v[j][2] + v[j][3] * v[j][3]);
        sq = wave_sum(sq);
        const float rs = rsqrtf(sq * (1.0f / 2048.0f) + EPS);
        float* dst = p.out + (row < MP ? O_YP + (size_t)row * 2048 : O_YS + (size_t)(row - MP) * 2048);
#pragma unroll
        for (int j = 0; j < 8; ++j) {
            const int c = (lane + 64 * j) * 4;
            *(f32x4*)(dst + c) = v[j] * rs * *(const f32x4*)(nf + c);
        }
    }
}

#define XB_TMO      128
#define XB_XCNT(j)  (256  + 64 * (j))
#define XB_XSUB(j)  (1280 + 64 * (j))
#define XB_XGEN(j)  (2304 + 64 * (j))
#define XB_TOP      3328
#define XB_TOPGEN   3392
#define XCD_BAR_WORDS 3456
#define XB_SPIN_CAP (1u << 22)
__device__ __forceinline__ unsigned xb_ld(unsigned* p)              { return __hip_atomic_load(p, __ATOMIC_RELAXED, __HIP_MEMORY_SCOPE_AGENT); }
__device__ __forceinline__ unsigned xb_add(unsigned* p, unsigned v) { return __hip_atomic_fetch_add(p, v, __ATOMIC_RELAXED, __HIP_MEMORY_SCOPE_AGENT); }
__device__ __forceinline__ unsigned xb_xcc_id() { return (unsigned)__builtin_amdgcn_s_getreg((3 << 11) | 20) & 0xFu; }
#define XB_SPIN(cond, bar) do { unsigned _sp = 0; while (cond) { __builtin_amdgcn_s_sleep(1); \
    if ((++_sp & 255u) == 0u) { if (xb_ld(&(bar)[XB_TMO])) break; if (_sp > XB_SPIN_CAP) { atomicAdd(&(bar)[XB_TMO], 1u); break; } } } } while (0)
struct XcdBarrier { unsigned* bar; unsigned x; volatile LAS unsigned* st; };
__device__ __forceinline__ XcdBarrier xcd_barrier_post(unsigned* bar, volatile LAS unsigned* st) {
    XcdBarrier b; b.bar = bar; b.x = xb_xcc_id(); b.st = st;
    if (threadIdx.x == 0) (void)xb_add(&bar[XB_XCNT(b.x)], 1u);
    return b;
}
__device__ __forceinline__ void xcd_barrier_complete(unsigned* bar, unsigned x, unsigned& nloc, unsigned& nx) {
    const unsigned G = gridDim.x * gridDim.y * gridDim.z;
    unsigned sum, cnt, mine, sp = 0u;
    for (;;) {
        sum = 0u; cnt = 0u; mine = 0u;
#pragma unroll
        for (unsigned j = 0; j < 16; ++j) { const unsigned c = xb_ld(&bar[XB_XCNT(j)]); sum += c; cnt += (c > 0u) ? 1u : 0u; mine = (j == x) ? c : mine; }
        if (sum == G) break;
        __builtin_amdgcn_s_sleep(1);
        if ((++sp & 255u) == 0u) { if (xb_ld(&bar[XB_TMO])) break; if (sp > XB_SPIN_CAP) { atomicAdd(&bar[XB_TMO], 1u); break; } }
    }
    nloc = mine > 0u ? mine : 1u; nx = cnt > 0u ? cnt : 1u;
}
__device__ __forceinline__ void xcd_barrier(const XcdBarrier& b) {
    asm volatile("s_waitcnt vmcnt(0)" ::: "memory");
    __syncthreads();
    if (threadIdx.x == 0) {
        unsigned* bar = b.bar;
        __builtin_amdgcn_s_waitcnt(0);
        unsigned nloc = b.st[0], nx = b.st[1];
        if (nloc == 0u) { xcd_barrier_complete(bar, b.x, nloc, nx); b.st[0] = nloc; b.st[1] = nx; }
        const unsigned old = xb_add(&bar[XB_XSUB(b.x)], 1u);
        const unsigned gen = old / nloc;
        if (old + 1u == (gen + 1u) * nloc) {
            __builtin_amdgcn_fence(__ATOMIC_RELEASE, "agent");
            asm volatile("s_waitcnt vmcnt(0)" ::: "memory");
            const unsigned og = xb_add(&bar[XB_TOP], 1u);
            const unsigned tg = og / nx;
            if (og + 1u == (tg + 1u) * nx) xb_add(&bar[XB_TOPGEN], 1u);
            else XB_SPIN(xb_ld(&bar[XB_TOPGEN]) == tg, bar);
            __builtin_amdgcn_fence(__ATOMIC_ACQUIRE, "agent");
            xb_add(&bar[XB_XGEN(b.x)], 1u);
            asm volatile("s_waitcnt vmcnt(0)" ::: "memory");
        } else {
            XB_SPIN(xb_ld(&bar[XB_XGEN(b.x)]) == gen, bar);
            __builtin_amdgcn_fence(__ATOMIC_ACQUIRE, "agent");
            asm volatile("s_waitcnt vmcnt(0)" ::: "memory");
        }
    }
    __syncthreads();
}

#ifndef PROBE_MASK
#define PROBE_MASK 0u
#endif
#ifndef PHMASK
#define PHMASK 0xFFFFFFFFu
#endif
#define EN(i) (((PHMASK) >> (i)) & 1u)
__global__ void __launch_bounds__(512, 2) fwd_megakernel(Params p) {
    extern __shared__ __attribute__((aligned(16))) unsigned char shm[];
    float* ldsf = (float*)shm;
    LAS unsigned char* ldsg = (LAS unsigned char*)shm;
    unsigned char* ws = p.ws;
    float* ssb = (float*)(ws + WS_SS);
    volatile LAS unsigned* xst = (volatile LAS unsigned*)(ldsg + 133120);
    if (threadIdx.x == 0) { xst[0] = 0u; xst[1] = 0u; }
    __syncthreads();
    (void)xcd_barrier_post((unsigned*)(ws + WS_CTL) + 256, xst);
#define XBAR() do { XcdBarrier _b; _b.bar = (unsigned*)(p.ws + WS_CTL) + 256; _b.x = xb_xcc_id(); _b.st = (volatile LAS unsigned*)((LAS unsigned char*)shm + 133120); xcd_barrier(_b); } while (0)
#if PROBE_MASK
    unsigned long long tph = __builtin_amdgcn_s_memrealtime();
#endif
    for (int ph = p.ph_lo; ph < p.ph_hi; ++ph) {
        if (ph > p.ph_lo) {
            if (ph == 1) cg::this_grid().sync();
            else XBAR();
#if PROBE_MASK
            {
                const unsigned long long t1 = __builtin_amdgcn_s_memrealtime();
                if ((PROBE_MASK >> (ph - 1)) & 1u) { const unsigned long long dt = t1 - tph; while (__builtin_amdgcn_s_memrealtime() - t1 < dt) __builtin_amdgcn_s_sleep(8); }
                tph = __builtin_amdgcn_s_memrealtime();
            }
#endif
        }
        if (EN(0) && ph == 0) phase_prologue(p, ldsf);
        else if (EN(1) && (ph == 1 || ph == 5 || ph == 8 || ph == 14)) {
            pg8::Gemm g; pg8::EpiScaleBf16 E; int N;
            if (ph != 1) { float* sd = ssb + (ph == 5 ? 1 : (ph == 8 ? 2 : 3)) * MT; if (ph == 8) finalize_sample_rows<11>(p, sd); else finalize_sample_rows<16>(p, sd); XBAR(); }
            g.A = (const char*)(ws + WS_XB); g.lda = 2048; g.ldb = 2048;
            if (ph == 1) { g.Bt = (const char*)(ws + WS_WIN0); N = LD0; E.ss = ssb; }
            else if (ph == 5) { g.Bt = (const char*)(ws + WS_WUP0); N = LDU; E.ss = ssb + MT; }
            else if (ph == 8) { g.Bt = (const char*)(ws + WS_WIN1); N = LD1; E.ss = ssb + 2 * MT; }
            else { g.Bt = (const char*)(ws + WS_WUP1); N = LDU; E.ss = ssb + 3 * MT; }
            E.O = (bf16_t*)(ws + WS_PROJ); E.ldc = N;
            pg8::Order S; S.nMm = 32; S.nN = N / 256; S.n_main = 32 * S.nN; S.n_tail = 2 * S.nN; S.ksplit = 1; S.nt_full = 32; S.G = gridDim.x; S.c = blockIdx.x;
            S.a_t = (size_t)256 * 2048 * 2; S.b_t = (size_t)256 * 2048 * 2; S.acol = 0;
            pg8::gemm_phase<pg8::EpiScaleBf16>(ldsg, g, S, E);
        }
        else if (EN(4) && (ph == 4 || ph == 7 || ph == 13 || ph == 16)) {
            pg8::Gemm g; pg8::EpiResid E;
            g.A = (const char*)(ws + WS_ACT);
            if (ph == 4) { g.Bt = (const char*)(ws + WS_WOUT0); g.lda = 4096; E.ssout = ssb + MT; }
            else if (ph == 7) { g.Bt = (const char*)(ws + WS_WDN0); g.lda = DFF; E.ssout = ssb + 2 * MT; }
            else if (ph == 13) { g.Bt = (const char*)(ws + WS_WOUT1); g.lda = 4096; E.ssout = ssb + 3 * MT; }
            else { g.Bt = (const char*)(ws + WS_WDN1); g.lda = DFF; E.ssout = ssb + 4 * MT; }
            g.ldb = g.lda;
            E.X = (float*)(ws + WS_X); E.XB = (bf16_t*)(ws + WS_XB); E.part = (float*)(ws + WS_PROJ);
            pg8::Order S; S.nMm = 32; S.nN = 8; S.n_main = 256; S.nt_full = g.lda / 64; S.ksplit = (g.lda == 4096) ? 16 : 11; S.n_tail = 16 * S.ksplit; S.G = gridDim.x; S.c = blockIdx.x;
            S.a_t = (size_t)256 * g.lda * 2; S.b_t = (size_t)256 * g.ldb * 2; S.acol = 0;
            pg8::gemm_phase<pg8::EpiResid>(ldsg, g, S, E);
        }
        else if (EN(10) && ph == 10) {
            pg8::Gemm g; pg8::EpiLru E;
            g.A = (const char*)(ws + WS_XR); g.Bt = (const char*)(ws + WS_WLRU); g.lda = 2048; g.ldb = 256;
            E.br = p.in[26 + p.z]; E.bi = p.in[28 + p.z]; E.sp = (const float*)(ws + WS_SP); E.XR = (const bf16_t*)(ws + WS_XR);
            E.LA = (float*)(ws + WS_LA); E.LBv = (bf16_t*)(ws + WS_LBB);
            pg8::Order S; S.nMm = 34; S.nN = 16; S.n_main = 34 * 16; S.n_tail = 0; S.ksplit = 1; S.nt_full = 4 + p.z; S.G = gridDim.x; S.c = blockIdx.x;
            S.a_t = (size_t)256 * 2048 * 2; S.b_t = (size_t)256 * 256 * 2; S.acol = 512;
            pg8::gemm_phase<pg8::EpiLru>(ldsg, g, S, E);
        }
        else if (EN(2) && ph == 2) phase_rec0(p, ldsf);
        else if (EN(3) && ph == 3) phase_prep0(p);
        else if (EN(6) && ph == 6) phase_act(p, 0);
        else if (EN(9) && ph == 9) phase_lruconv(p);
        else if (EN(11) && ph == 11) phase_rec1(p, ldsf);
        else if (EN(12) && ph == 12) phase_prep1(p);
        else if (EN(15) && ph == 15) phase_act(p, 1);
        else if (EN(17) && ph == 17) phase_final(p);
    }
}

#ifndef N_LAUNCH_MODE
#define N_LAUNCH_MODE 0
#endif

extern "C" void kernel_launch(void* const* d_in, const int* in_sizes, int n_in, void* d_out, int out_size, void* d_ws, size_t ws_size, hipStream_t stream) {
    static int grid = 0;
    if (grid == 0) {
        if (n_in != 35 || (size_t)out_size != O_END || ws_size < WS_END) { fprintf(stderr, "kernel_launch: unexpected shapes: n_in %d out %d ws %zu (need %zu)\n", n_in, out_size, ws_size, (size_t)WS_END); grid = -1; return; }
        int dev = 0, cus = 0, per_cu = 0;
        hipGetDevice(&dev);
        hipDeviceGetAttribute(&cus, hipDeviceAttributeMultiprocessorCount, dev);
        if (hipFuncSetAttribute((const void*)fwd_megakernel, hipFuncAttributeMaxDynamicSharedMemorySize, LDS_BYTES) != hipSuccess) { fprintf(stderr, "kernel_launch: hipFuncSetAttribute failed\n"); grid = -1; return; }
        if (hipOccupancyMaxActiveBlocksPerMultiprocessor(&per_cu, (const void*)fwd_megakernel, 512, LDS_BYTES) != hipSuccess || per_cu < 1) { fprintf(stderr, "kernel_launch: occupancy query says %d\n", per_cu); per_cu = 1; }
        (void)hipGetLastError();
        grid = cus;
    }
    if (grid < 0) return;
    (void)hipMemsetAsync((char*)d_ws + WS_CTL, 0, 16384, stream);
    Params p{};
    for (int i = 0; i < 35; ++i) p.in[i] = (const float*)d_in[i];
    p.z = 0; p.pad = 0;
    p.out = (float*)d_out; p.ws = (unsigned char*)d_ws;
#if N_LAUNCH_MODE == 0
    p.ph_lo = 0; p.ph_hi = NPHASE;
    void* args[] = {&p};
    hipError_t e = hipLaunchCooperativeKernel((const void*)fwd_megakernel, dim3(grid), dim3(512), args, LDS_BYTES, stream);
    if (e != hipSuccess) fprintf(stderr, "cooperative launch failed: %s (grid %d)\n", hipGetErrorString(e), grid);
#else
    for (int ph = 0; ph < NPHASE; ++ph) {
        p.ph_lo = ph; p.ph_hi = ph + 1;
        hipLaunchKernelGGL(fwd_megakernel, dim3(grid), dim3(512), LDS_BYTES, stream, p);
    }
#endif
}
```

```cpp
#include <hip/hip_runtime.h>
#include <hip/hip_cooperative_groups.h>
#include <cstdio>
#include <cstdint>
namespace cg = cooperative_groups;

#define LAS __attribute__((address_space(3)))
typedef unsigned short bf16_t;
typedef short bf16x8 __attribute__((ext_vector_type(8)));
typedef float f32x4 __attribute__((ext_vector_type(4)));
typedef float f32x2 __attribute__((ext_vector_type(2)));
typedef unsigned u32x4 __attribute__((ext_vector_type(4)));
typedef unsigned u32x2 __attribute__((ext_vector_type(2)));

constexpr int D = 2048, MP = 8192, MS = 512, MT = 8704;
constexpr int LD0 = 11520, LD1 = 12288, LDU = 11264, DFF = 5632;
constexpr float EPS = 1e-6f;
constexpr size_t O_YP = 0;
constexpr size_t O_YS = O_YP + (size_t)4 * 2048 * 2048;
constexpr size_t O_SSMP = O_YS + (size_t)128 * 4 * 2048;
constexpr size_t O_SSMS = O_SSMP + (size_t)4 * 32 * 128 * 64;
constexpr size_t O_SCP = O_SSMS + (size_t)128 * 32 * 128 * 64;
constexpr size_t O_SCS = O_SCP + (size_t)4 * 3 * 3072;
constexpr size_t O_RETP = O_SCS + (size_t)128 * 3 * 3072;
constexpr size_t O_RETS = O_RETP + (size_t)4 * 8 * 128 * 256;
constexpr size_t O_HGP = O_RETS + (size_t)128 * 8 * 128 * 256;
constexpr size_t O_HGS = O_HGP + (size_t)4 * 16 * 128 * 128;
constexpr size_t O_LRUP = O_HGS + (size_t)128 * 16 * 128 * 128;
constexpr size_t O_LRUS = O_LRUP + (size_t)4 * 2048;
constexpr size_t O_LCP = O_LRUS + (size_t)128 * 2048;
constexpr size_t O_LCS = O_LCP + (size_t)4 * 3 * 2048;
constexpr size_t O_FCP = O_LCS + (size_t)128 * 3 * 2048;
constexpr size_t O_FCS = O_FCP + (size_t)2 * 4 * 2 * 5632;
constexpr size_t O_END = O_FCS + (size_t)2 * 128 * 2 * 5632;
constexpr size_t al256(size_t x) { return (x + 255) & ~(size_t)255; }
constexpr size_t WS_CTL = 0;
constexpr size_t WS_SS = 16384;
constexpr size_t WS_SP = al256(WS_SS + (size_t)5 * MT * 4);
constexpr size_t WS_LB = WS_SP + 8192;
constexpr size_t WS_WIN0 = WS_LB + 8192;
constexpr size_t WS_WOUT0 = WS_WIN0 + (size_t)LD0 * 2048 * 2;
constexpr size_t WS_WUP0 = WS_WOUT0 + (size_t)2048 * 4096 * 2;
constexpr size_t WS_WDN0 = WS_WUP0 + (size_t)LDU * 2048 * 2;
constexpr size_t WS_WIN1 = WS_WDN0 + (size_t)2048 * DFF * 2;
constexpr size_t WS_WOUT1 = WS_WIN1 + (size_t)LD1 * 2048 * 2;
constexpr size_t WS_WUP1 = WS_WOUT1 + (size_t)2048 * 4096 * 2;
constexpr size_t WS_WDN1 = WS_WUP1 + (size_t)LDU * 2048 * 2;
constexpr size_t WS_WLRU = WS_WDN1 + (size_t)2048 * DFF * 2;
constexpr size_t WS_X = WS_WLRU + (size_t)16 * 256 * 256 * 2;
constexpr size_t WS_XB = WS_X + (size_t)MT * 2048 * 4;
constexpr size_t WS_PROJ = WS_XB + (size_t)MT * 2048 * 2;
constexpr size_t WS_ACT = WS_PROJ + (size_t)MT * LD1 * 2;
constexpr size_t WS_YZ = WS_ACT + (size_t)MT * DFF * 2;
constexpr size_t WS_LA = WS_YZ + (size_t)MT * 4096 * 2;
constexpr size_t WS_LBB = WS_LA + (size_t)MT * 2048 * 4;
constexpr size_t WS_XR = WS_LBB + (size_t)MT * 2048 * 2;
constexpr size_t WS_END = WS_XR + (size_t)MT * 2048 * 2;

constexpr int LDS_BYTES = 133120 + 256;
constexpr int NPHASE = 18;

struct Params {
    const float* in[35];
    float* out;
    unsigned char* ws;
    int ph_lo, ph_hi;
    int z, pad;
};

__device__ __forceinline__ float bf2f(unsigned v) { return __uint_as_float(v << 16); }
__device__ __forceinline__ unsigned pk2(float lo, float hi) { unsigned r; asm volatile("v_cvt_pk_bf16_f32 %0, %1, %2" : "=v"(r) : "v"(lo), "v"(hi)); return r; }
__device__ __forceinline__ unsigned pk2_sw(float lo, float hi) {
    unsigned a = __float_as_uint(lo), b = __float_as_uint(hi); a += 0x7fffu + ((a >> 16) & 1u); b += 0x7fffu + ((b >> 16) & 1u); return (a >> 16) | (b & 0xffff0000u); }
__device__ __forceinline__ bf16_t f2bf(float x) { return (bf16_t)(pk2(x, 0.f) & 0xffffu); }
__device__ __forceinline__ float sigm(float x) { return __builtin_amdgcn_rcpf(1.f + __expf(-x)); }
__device__ __forceinline__ float silu(float x) { return x * __builtin_amdgcn_rcpf(1.f + __expf(-x)); }
__device__ __forceinline__ float softplus(float x) { return fmaxf(x, 0.f) + log1pf(__expf(-fabsf(x))); }
__device__ __forceinline__ float gelu_tanh(float x) { const float u = 0.7978845608f * (x + 0.044715f * x * x * x); const float t = 1.f - 2.f * __builtin_amdgcn_rcpf(1.f + __expf(2.f * u)); return 0.5f * x * (1.f + t); }
__device__ __forceinline__ float wave_sum(float v) {
#pragma unroll
    for (int o = 1; o < 64; o <<= 1) v += __shfl_xor(v, o);
    return v;
}
__device__ __forceinline__ void unpack8(u32x4 r, float* f) {
    f[0] = bf2f(r.x & 0xffffu); f[1] = __uint_as_float(r.x & 0xffff0000u); f[2] = bf2f(r.y & 0xffffu); f[3] = __uint_as_float(r.y & 0xffff0000u);
    f[4] = bf2f(r.z & 0xffffu); f[5] = __uint_as_float(r.z & 0xffff0000u); f[6] = bf2f(r.w & 0xffffu); f[7] = __uint_as_float(r.w & 0xffff0000u);
}
__device__ __forceinline__ void unpack4(u32x2 r, float* f) {
    f[0] = bf2f(r.x & 0xffffu); f[1] = __uint_as_float(r.x & 0xffff0000u); f[2] = bf2f(r.y & 0xffffu); f[3] = __uint_as_float(r.y & 0xffff0000u);
}
#define LDS_WAIT() asm volatile("s_waitcnt lgkmcnt(0)" ::: "memory")

namespace pg8 {
constexpr int BM = 256, BK = 64, HALF = 128, HTB = HALF * BK * 2, NXCD = 8, WGM = 8;
__device__ __forceinline__ int lds_byte(int r, int c) { const int st = (r >> 4) * 2 + (c >> 5), rr = r & 15, cc = c & 31, ob = rr * 64 + cc * 2; return st * 1024 + (ob ^ (((ob >> 9) & 1) << 5)); }
__device__ __forceinline__ void stage_rc(int b, int& R, int& C) { const int st = b / 1024, sb = b % 1024, swz = sb ^ (((sb >> 9) & 1) << 5); R = (st >> 1) * 16 + swz / 64; C = (st & 1) * 32 + (swz % 64) / 2; }
__device__ __forceinline__ int perm32(int rho) { const int n = rho >> 4, i = rho & 15; return 8 * (i >> 2) + 4 * n + (i & 3); }

struct Unit { int pm, pn, nt, kind, ks; size_t aoff, boff; };
struct Gemm { const char* A; const char* Bt; int lda, ldb; };
struct Order {
    int nMm, nN, n_main, n_tail, ksplit, nt_full, G, c; size_t a_t, b_t, acol;
    __device__ __forceinline__ bool next(int i, Unit& u) const {
        const long L = (long)i * G + c;
        if (L < n_main) {
            const int nwg = n_main;
            int wgid = (int)L; { const int q = nwg / NXCD, r = nwg % NXCD, xcd = wgid % NXCD, off = wgid / NXCD; wgid = (xcd < r ? xcd * (q + 1) : r * (q + 1) + (xcd - r) * q) + off; }
            const int nig = WGM * nN, gid = wgid / nig, fm = gid * WGM, gsz = (nMm - fm) < WGM ? (nMm - fm) : WGM;
            u.pm = fm + ((wgid % nig) % gsz); u.pn = (wgid % nig) / gsz; u.nt = nt_full; u.kind = 0; u.ks = 0;
            u.aoff = (size_t)u.pm * a_t + (size_t)(u.pn >> 1) * acol; u.boff = (size_t)u.pn * b_t; return true;
        }
        const int Lt = (int)(L - n_main); if (Lt >= n_tail) return false;
        const int ks = Lt % ksplit, r = Lt / ksplit;
        u.pm = nMm + (r & 1); u.pn = r >> 1; u.nt = nt_full / ksplit; u.kind = ksplit > 1 ? 1 : 0; u.ks = ks;
        const size_t kofs = (size_t)ks * u.nt * (BK * 2);
        u.aoff = (size_t)u.pm * a_t + (size_t)(u.pn >> 1) * acol + kofs; u.boff = (size_t)u.pn * b_t + kofs; return true;
    }
};

struct EpiScaleBf16 {
    static constexpr bool PERM = true;
    bf16_t* O; int ldc; const float* ss;
    __device__ __forceinline__ void operator()(const f32x4 (&acc)[2][2][4][2], const Unit& u, int wr, int wc, int fr, int fq) const {
        const int row0 = u.pm * BM + wr * 64 + fr, col0 = u.pn * BM + wc * 32 + 8 * fq;
        float ssv[8];
#pragma unroll
        for (int ai = 0; ai < 2; ++ai)
#pragma unroll
            for (int m = 0; m < 4; ++m) ssv[ai * 4 + m] = ss[row0 + ai * HALF + m * 16];
#pragma unroll
        for (int ai = 0; ai < 2; ++ai)
#pragma unroll
            for (int m = 0; m < 4; ++m) {
                const int row = row0 + ai * HALF + m * 16;
                const float rs = rsqrtf(ssv[ai * 4 + m] * (1.0f / 2048.0f) + EPS);
                bf16_t* rowp = O + ((unsigned)row * (unsigned)ldc + (unsigned)col0);
#pragma unroll
                for (int bj = 0; bj < 2; ++bj) {
                    const f32x4 v0 = acc[ai][bj][m][0] * rs, v1 = acc[ai][bj][m][1] * rs;
                    u32x4 w; w.x = pk2(v0[0], v0[1]); w.y = pk2(v0[2], v0[3]); w.z = pk2(v1[0], v1[1]); w.w = pk2(v1[2], v1[3]);
                    *(u32x4*)(rowp + bj * HALF) = w;
                }
            }
    }
};
struct EpiResid {
    static constexpr bool PERM = false;
    float* X; bf16_t* XB; float* ssout; float* part;
    __device__ __forceinline__ void operator()(const f32x4 (&acc)[2][2][4][2], const Unit& u, int wr, int wc, int fr, int fq) const {
        const int row0 = u.pm * BM + wr * 64 + fr, col0 = u.pn * BM + wc * 32 + 4 * fq;
        if (u.kind == 1) {
            float* P = part + (size_t)u.ks * (512 * 2048);
#pragma unroll
            for (int ai = 0; ai < 2; ++ai)
#pragma unroll
                for (int m = 0; m < 4; ++m) {
                    const unsigned off = (unsigned)(row0 - MP + ai * HALF + m * 16) * 2048u + (unsigned)col0;
#pragma unroll
                    for (int bj = 0; bj < 2; ++bj)
#pragma unroll
                        for (int n = 0; n < 2; ++n) *(f32x4*)(P + off + bj * HALF + n * 16) = acc[ai][bj][m][n];
                }
            return;
        }
#pragma unroll
        for (int ai = 0; ai < 2; ++ai)
#pragma unroll
            for (int mp = 0; mp < 4; mp += 2) {
                f32x4 xin[2][2][2];
#pragma unroll
                for (int mm = 0; mm < 2; ++mm)
#pragma unroll
                    for (int bj = 0; bj < 2; ++bj)
#pragma unroll
                        for (int n = 0; n < 2; ++n) xin[mm][bj][n] = *(const f32x4*)(X + ((unsigned)(row0 + ai * HALF + (mp + mm) * 16) * 2048u + (unsigned)col0 + bj * HALF + n * 16));
#pragma unroll
                for (int mm = 0; mm < 2; ++mm) {
                    const int row = row0 + ai * HALF + (mp + mm) * 16;
                    const unsigned off = (unsigned)row * 2048u + (unsigned)col0;
                    float sq = 0.f;
#pragma unroll
                    for (int bj = 0; bj < 2; ++bj)
#pragma unroll
                        for (int n = 0; n < 2; ++n) {
                            const unsigned o = off + bj * HALF + n * 16;
                            const f32x4 x = xin[mm][bj][n] + acc[ai][bj][mp + mm][n];
                            *(f32x4*)(X + o) = x;
                            u32x2 w; w.x = pk2(x[0], x[1]); w.y = pk2(x[2], x[3]);
                            *(u32x2*)(XB + o) = w;
                            sq += (x[0] * x[0] + x[1] * x[1]) + (x[2] * x[2] + x[3] * x[3]);
                        }
                    sq += __shfl_xor(sq, 16); sq += __shfl_xor(sq, 32);
                    if (fq == 0) atomicAdd(ssout + row, sq);
                }
                asm volatile("" ::: "memory");
            }
    }
};
struct EpiLru {
    static constexpr bool PERM = false;
    const float* br; const float* bi; const float* sp; const bf16_t* XR; float* LA; bf16_t* LBv;
    __device__ __forceinline__ void operator()(const f32x4 (&acc)[2][2][4][2], const Unit& u, int wr, int wc, int fr, int fq) const {
        const int row0 = u.pm * BM + wr * 64 + fr;
        const int cbase = (u.pn >> 1) * 256 + (u.pn & 1) * 128 + wc * 32 + 4 * fq;
        f32x4 br4[2], bi4[2], sp4[2];
#pragma unroll
        for (int n = 0; n < 2; ++n) { br4[n] = *(const f32x4*)(br + cbase + n * 16); bi4[n] = *(const f32x4*)(bi + cbase + n * 16); sp4[n] = *(const f32x4*)(sp + cbase + n * 16); }
#pragma unroll
        for (int ai = 0; ai < 2; ++ai)
#pragma unroll
            for (int mp = 0; mp < 4; mp += 2) {
                u32x2 xrr[2][2];
#pragma unroll
                for (int mm = 0; mm < 2; ++mm)
#pragma unroll
                    for (int n = 0; n < 2; ++n) xrr[mm][n] = *(const u32x2*)(XR + ((unsigned)(row0 + ai * HALF + (mp + mm) * 16) * 2048u + (unsigned)(cbase + n * 16)));
#pragma unroll
                for (int mm = 0; mm < 2; ++mm) {
                    const int row = row0 + ai * HALF + (mp + mm) * 16;
                    const bool first = (row < MP) && ((row & 2047) == 0);
#pragma unroll
                    for (int n = 0; n < 2; ++n) {
                        const unsigned o = (unsigned)row * 2048u + (unsigned)(cbase + n * 16);
                        float xr[4]; unpack4(xrr[mm][n], xr);
                        f32x4 av; float bb[4];
#pragma unroll
                        for (int j = 0; j < 4; ++j) {
                            const float r = sigm(acc[ai][0][mp + mm][n][j] + br4[n][j]), gi = sigm(acc[ai][1][mp + mm][n][j] + bi4[n][j]);
                            const float la = -8.0f * r * sp4[n][j];
                            const float a = __expf(la);
                            const float mult = first ? 1.0f : __builtin_amdgcn_sqrtf(fmaxf(1.0f - a * a, 0.f));
                            av[j] = a; bb[j] = mult * gi * xr[j];
                        }
                        *(f32x4*)(LA + o) = av;
                        u32x2 w; w.x = pk2(bb[0], bb[1]); w.y = pk2(bb[2], bb[3]);
                        *(u32x2*)(LBv + o) = w;
                    }
                }
                asm volatile("" ::: "memory");
            }
    }
};

template <class Epi>
__device__ __forceinline__ void gemm_phase(LAS unsigned char* lds, const Gemm g, const Order& S, const Epi& E) {
    int tid = threadIdx.x; asm volatile("" : "+v"(tid));
    const int wid = __builtin_amdgcn_readfirstlane(tid >> 6), lane = tid & 63, wr = wid >> 2, wc = wid & 3, fr = lane & 15, fq = lane >> 4;
    unsigned voffA[2], voffB[2];
#pragma unroll
    for (int i = 0; i < 2; ++i) { int R, C; stage_rc(tid * 16 + i * 8192, R, C); const int Rb = Epi::PERM ? ((R & ~31) + perm32(R & 31)) : R;
        voffA[i] = (unsigned)(R * g.lda + C) * 2u; voffB[i] = (unsigned)(Rb * g.ldb + C) * 2u; }
    const size_t kstep = (size_t)(BK * 2);
    const size_t hstepA = (size_t)HALF * g.lda * 2, hstepB = (size_t)HALF * g.ldb * 2;
    const unsigned ldsw = (unsigned)wid * 1024u;
    const int aoff = lds_byte(wr * 64 + fr, fq * 8), boff = lds_byte(wc * 32 + fr, fq * 8);
#define PG8_SA(b, h) (((b) * 2 + (h)) * HTB)
#define PG8_SB(b, h) ((4 + (b) * 2 + (h)) * HTB)
#define PG8_STAGE(bufoff, gbase, voff) do { _Pragma("unroll") for (int _i = 0; _i < 2; ++_i) \
        __builtin_amdgcn_global_load_lds((const unsigned*)((const char*)(gbase) + (voff)[_i]), (LAS unsigned*)(lds + (bufoff) + ldsw + _i * 8192), 16, 0, 0); } while (0)
#define PG8_LDA(dst, b, h) do { _Pragma("unroll") for (int m = 0; m < 4; ++m) _Pragma("unroll") for (int k = 0; k < 2; ++k) dst[m][k] = *(const LAS bf16x8*)(lds + PG8_SA(b, h) + aoff + m * 2048 + k * 1024); } while (0)
#define PG8_LDB(dst, b, h) do { _Pragma("unroll") for (int n = 0; n < 2; ++n) _Pragma("unroll") for (int k = 0; k < 2; ++k) dst[n][k] = *(const LAS bf16x8*)(lds + PG8_SB(b, h) + boff + n * 2048 + k * 1024); } while (0)
#define PG8_MMA(ai, bj, At, Bt) do { __builtin_amdgcn_s_setprio(1); _Pragma("unroll") for (int m = 0; m < 4; ++m) _Pragma("unroll") for (int n = 0; n < 2; ++n) _Pragma("unroll") for (int k = 0; k < 2; ++k) \
        acc[ai][bj][m][n] = __builtin_amdgcn_mfma_f32_16x16x32_bf16(Bt[n][k], At[m][k], acc[ai][bj][m][n], 0, 0, 0); __builtin_amdgcn_s_setprio(0); } while (0)
#define PG8_WAIT_V(n) asm volatile("s_waitcnt vmcnt(" #n ")" ::: "memory")
#define PG8_WAIT_L(n) asm volatile("s_waitcnt lgkmcnt(" #n ")" ::: "memory")
#define PG8_BAR __builtin_amdgcn_s_barrier()
#define PG8_SCHED __builtin_amdgcn_sched_barrier(0)
    Unit cur, nxt; int ui = 0;
    if (!S.next(0, cur)) return;
    f32x4 acc[2][2][4][2];
#pragma unroll
    for (int a = 0; a < 2; ++a)
#pragma unroll
        for (int b = 0; b < 2; ++b)
#pragma unroll
            for (int m = 0; m < 4; ++m)
#pragma unroll
                for (int n = 0; n < 2; ++n) acc[a][b][m][n] = (f32x4){0.f, 0.f, 0.f, 0.f};
    bf16x8 At[4][2], B0[2][2], B1[2][2];
    const char* cA = g.A + cur.aoff; const char* cB = g.Bt + cur.boff;
    PG8_STAGE(PG8_SB(0, 0), cB, voffB); PG8_STAGE(PG8_SA(0, 0), cA, voffA); PG8_STAGE(PG8_SB(0, 1), cB + hstepB, voffB); PG8_STAGE(PG8_SA(0, 1), cA + hstepA, voffA);
    if (wr == 1) PG8_BAR;
    PG8_WAIT_V(4); PG8_BAR;
    PG8_STAGE(PG8_SB(1, 0), cB + kstep, voffB); PG8_STAGE(PG8_SA(1, 0), cA + kstep, voffA); PG8_STAGE(PG8_SB(1, 1), cB + hstepB + kstep, voffB);
    PG8_WAIT_V(6); PG8_BAR;
    for (;;) {
        const bool has_next = S.next(ui + 1, nxt);
        const char* nA = has_next ? g.A + nxt.aoff : cA; const char* nB = has_next ? g.Bt + nxt.boff : cB;
        const int nt = cur.nt;
        for (int t = 0; t < nt; t += 2) {
            const bool last = (t == nt - 2);
            const char* a1 = cA + (size_t)(t + 1) * kstep;
            const char* a2 = last ? nA : cA + (size_t)(t + 2) * kstep; const char* b2 = last ? nB : cB + (size_t)(t + 2) * kstep;
            const char* a3 = a2 + kstep; const char* b3 = b2 + kstep;
            PG8_LDB(B0, 0, 0); PG8_SCHED; PG8_LDA(At, 0, 0); PG8_STAGE(PG8_SA(1, 1), a1 + hstepA, voffA);
            PG8_WAIT_L(8); PG8_BAR; PG8_WAIT_L(0); PG8_MMA(0, 0, At, B0); PG8_BAR; PG8_SCHED;
            PG8_LDB(B1, 0, 1); PG8_STAGE(PG8_SB(0, 0), b2, voffB);
            PG8_BAR; PG8_WAIT_L(0); PG8_MMA(0, 1, At, B1); PG8_BAR;
            PG8_LDA(At, 0, 1); PG8_STAGE(PG8_SA(0, 0), a2, voffA);
            PG8_BAR; PG8_WAIT_L(0); PG8_MMA(1, 0, At, B0); PG8_BAR; PG8_SCHED;
            PG8_STAGE(PG8_SB(0, 1), b2 + hstepB, voffB);
            PG8_WAIT_V(6); PG8_BAR; PG8_MMA(1, 1, At, B1); PG8_BAR;
            PG8_LDB(B0, 1, 0); PG8_SCHED; PG8_LDA(At, 1, 0); PG8_STAGE(PG8_SA(0, 1), a2 + hstepA, voffA);
            PG8_WAIT_L(8); PG8_BAR; PG8_WAIT_L(0); PG8_MMA(0, 0, At, B0); PG8_BAR; PG8_SCHED;
            PG8_LDB(B1, 1, 1); PG8_STAGE(PG8_SB(1, 0), b3, voffB);
            PG8_BAR; PG8_WAIT_L(0); PG8_MMA(0, 1, At, B1); PG8_BAR;
            PG8_LDA(At, 1, 1); PG8_STAGE(PG8_SA(1, 0), a3, voffA);
            PG8_BAR; PG8_WAIT_L(0); PG8_MMA(1, 0, At, B0); PG8_BAR; PG8_SCHED;
            PG8_STAGE(PG8_SB(1, 1), b3 + hstepB, voffB);
            PG8_WAIT_V(6); PG8_BAR; PG8_MMA(1, 1, At, B1); PG8_BAR;
        }
        if (wr == 0) PG8_BAR;
        E(acc, cur, wr, wc, fr, fq);
        if (!has_next) break;
#pragma unroll
        for (int a = 0; a < 2; ++a)
#pragma unroll
            for (int b = 0; b < 2; ++b)
#pragma unroll
                for (int m = 0; m < 4; ++m)
#pragma unroll
                    for (int n = 0; n < 2; ++n) acc[a][b][m][n] = (f32x4){0.f, 0.f, 0.f, 0.f};
        cur = nxt; cA = nA; cB = nB; ++ui;
        if (wr == 1) PG8_BAR;
    }
    PG8_WAIT_V(0);
    PG8_BAR;
#undef PG8_SA
#undef PG8_SB
#undef PG8_STAGE
#undef PG8_LDA
#undef PG8_LDB
#undef PG8_MMA
#undef PG8_WAIT_V
#undef PG8_WAIT_L
#undef PG8_BAR
#undef PG8_SCHED
}
}

__device__ __forceinline__ void tr_item(const float* __restrict__ W, int ldw, int N, int k0, int n0, const float* __restrict__ scale, bf16_t* __restrict__ dst, int ldd, float* scr, int lane) {
    const int r4 = lane >> 4, c4 = (lane & 15) * 4;
    const bool inb = (n0 + c4) < N;
    f32x4 v[16];
#pragma unroll
    for (int i = 0; i < 16; ++i) v[i] = inb ? *(const f32x4*)(W + (size_t)(k0 + 4 * i + r4) * ldw + n0 + c4) : (f32x4){0.f, 0.f, 0.f, 0.f};
#pragma unroll
    for (int i = 0; i < 16; ++i) { float* d = scr + (4 * i + r4) * 65 + c4; d[0] = v[i][0]; d[1] = v[i][1]; d[2] = v[i][2]; d[3] = v[i][3]; }
    LDS_WAIT();
    const int c = lane & 7;
    f32x4 s0 = (f32x4){1.f, 1.f, 1.f, 1.f}, s1 = s0;
    if (scale) { s0 = *(const f32x4*)(scale + k0 + 8 * c); s1 = *(const f32x4*)(scale + k0 + 8 * c + 4); }
#pragma unroll
    for (int j = 0; j < 8; ++j) { const int n = (lane >> 3) + 8 * j; const float* sp = scr + (8 * c) * 65 + n;
        u32x4 o; o.x = pk2(sp[0 * 65] * s0[0], sp[1 * 65] * s0[1]); o.y = pk2(sp[2 * 65] * s0[2], sp[3 * 65] * s0[3]); o.z = pk2(sp[4 * 65] * s1[0], sp[5 * 65] * s1[1]); o.w = pk2(sp[6 * 65] * s1[2], sp[7 * 65] * s1[3]);
        *(u32x4*)(dst + (size_t)n * ldd + 8 * c) = o; }
    LDS_WAIT();
}

__device__ __forceinline__ void phase_prologue(const Params& p, float* ldsf) {
    int tid = threadIdx.x; asm volatile("" : "+v"(tid));
    const int wave = tid >> 6, lane = tid & 63;
    const int gw = blockIdx.x * 8 + wave, NGW = gridDim.x * 8;
    float* scr = ldsf + wave * 4160;
    unsigned char* ws = p.ws;
    constexpr int I0 = 32 * 177, I1 = 64 * 32, I2 = 32 * 176, I3 = 88 * 32, I4 = 32 * 192, I5 = I1, I6 = I2, I7 = I3, I8 = 128, I9 = 128;
    constexpr int NIT = I0 + I1 + I2 + I3 + I4 + I5 + I6 + I7 + I8 + I9;
    for (int it = gw; it < NIT; it += NGW) {
        int r = it;
        const float* W; int K, N; const float* sc = nullptr; bf16_t* WT;
        if (r < I0) { W = p.in[12 + p.z]; K = 2048; N = 11296; sc = p.in[9 + p.z]; WT = (bf16_t*)(ws + WS_WIN0); }
        else if ((r -= I0) < I1) { W = p.in[19 + p.z]; K = 4096; N = 2048; WT = (bf16_t*)(ws + WS_WOUT0); }
        else if ((r -= I1) < I2) { W = p.in[31 + p.z]; K = 2048; N = 11264; sc = p.in[10 + p.z]; WT = (bf16_t*)(ws + WS_WUP0); }
        else if ((r -= I2) < I3) { W = p.in[34 + p.z]; K = 5632; N = 2048; WT = (bf16_t*)(ws + WS_WDN0); }
        else if ((r -= I3) < I4) { W = p.in[20 + p.z]; K = 2048; N = 12288; sc = p.in[9 + p.z] + 2048; WT = (bf16_t*)(ws + WS_WIN1); }
        else if ((r -= I4) < I5) { W = p.in[30 + p.z]; K = 4096; N = 2048; WT = (bf16_t*)(ws + WS_WOUT1); }
        else if ((r -= I5) < I6) { W = p.in[31 + p.z] + (size_t)2048 * 11264; K = 2048; N = 11264; sc = p.in[10 + p.z] + 2048; WT = (bf16_t*)(ws + WS_WUP1); }
        else if ((r -= I6) < I7) { W = p.in[34 + p.z] + (size_t)5632 * 2048; K = 5632; N = 2048; WT = (bf16_t*)(ws + WS_WDN1); }
        else {
            r -= I7; const int which = r >> 7; r &= 127;
            const int blk = r >> 4, kb = (r >> 2) & 3, nb = r & 3, n0 = 64 * nb, k0 = 64 * kb;
            const float* Wl = (which ? p.in[27 + p.z] : p.in[25 + p.z]) + (size_t)blk * 65536;
            const int drow = (blk * 2 + (n0 >> 7)) * 256 + which * 128 + (n0 & 127);
            tr_item(Wl, 256, 256, k0, n0, nullptr, (bf16_t*)(ws + WS_WLRU) + (size_t)drow * 256 + k0, 256, scr, lane);
            continue;
        }
        const int nblk = (N + 63) / 64, kbl = r & 7, r8 = r >> 3, nb = r8 % nblk, kb = (r8 / nblk) * 8 + kbl, k0 = 64 * kb, n0 = 64 * nb;
        tr_item(W, N, N, k0, n0, sc, WT + (size_t)n0 * K + k0, K, scr, lane);
    }
    {
        u32x4* z = (u32x4*)((bf16_t*)(ws + WS_WIN0) + (size_t)11296 * 2048);
        const int n16 = 224 * 2048 * 2 / 16;
        for (int i = blockIdx.x * 512 + tid; i < n16; i += gridDim.x * 512) z[i] = (u32x4){0u, 0u, 0u, 0u};
    }
    float* X = (float*)(ws + WS_X); bf16_t* XB = (bf16_t*)(ws + WS_XB); float* ss = (float*)(ws + WS_SS);
    for (int row = gw; row < MT; row += NGW) {
        const float* src = row < MP ? p.in[0 + p.z] + (size_t)row * 2048 : p.in[1 + p.z] + (size_t)(row - MP) * 2048;
        float s = 0.f;
#pragma unroll
        for (int j = 0; j < 8; ++j) {
            const f32x4 v = *(const f32x4*)(src + (lane + 64 * j) * 4);
            *(f32x4*)(X + (size_t)row * 2048 + (lane + 64 * j) * 4) = v;
            u32x2 w; w.x = pk2(v[0], v[1]); w.y = pk2(v[2], v[3]);
            *(u32x2*)(XB + (size_t)row * 2048 + (lane + 64 * j) * 4) = w;
            s += (v[0] * v[0] + v[1] * v[1]) + (v[2] * v[2] + v[3] * v[3]);
        }
        s = wave_sum(s);
        if (lane == 0) ss[row] = s;
    }
    for (int i = blockIdx.x * 512 + tid; i < 4 * MT; i += gridDim.x * 512) ss[MT + i] = 0.f;
    for (int i = blockIdx.x * 512 + tid; i < 2048; i += gridDim.x * 512) {
        ((float*)(ws + WS_SP))[i] = softplus(-p.in[29 + p.z][i]);
        ((float*)(ws + WS_LB))[i] = sigm(p.in[21 + p.z][2048 + i] - p.in[21 + p.z][i]);
    }
}

__device__ __forceinline__ int next_item(unsigned* ctr, float* ldsf) {
    __syncthreads();
    if (threadIdx.x == 0) ((volatile unsigned*)ldsf)[33284] = atomicAdd(ctr, 1u);
    __syncthreads();
    return (int)((volatile unsigned*)ldsf)[33284];
}

template <int TYPE, int VW>
__device__ __forceinline__ void rec_item(const Params& p, float* ldsf, int sample, int b, int h, int s) {
    constexpr int NV = VW / 16;
    typedef float VT __attribute__((ext_vector_type(NV)));
    int tid = threadIdx.x; asm volatile("" : "+v"(tid));
    const int w = tid >> 6, lane = tid & 63, kg = lane >> 4, vq = lane & 15, kb = 16 * w + 4 * kg;
    const int L = sample ? 4 : 2048, row0 = sample ? MP + 4 * b : 2048 * b, pos0 = sample ? 16384 : 0;
    constexpr int LDP = TYPE < 2 ? LD0 : LD1;
    const bf16_t* proj = (const bf16_t*)(p.ws + WS_PROJ) + (size_t)row0 * LDP;
    bf16_t* yz = (bf16_t*)(p.ws + WS_YZ) + (size_t)row0 * 4096;
    float* part = ldsf + 8192;
    int colA = -1, colB = -1, role = -1, didx = 0;
    float w0 = 0.f, w1 = 0.f, w2 = 0.f, w3 = 0.f, cbias = 0.f, c0 = 0.f, c1 = 0.f, c2 = 0.f, aux = 0.f, aux2 = 0.f;
    if constexpr (TYPE == 0) {
        if (tid < 320) {
            role = tid < 128 ? 0 : (tid < 256 ? 1 : 2);
            didx = tid < 128 ? tid : (tid < 256 ? tid - 128 : tid - 256);
            const int ch = tid < 128 ? 2560 + (h >> 3) * 128 + tid : (tid < 256 ? 2048 + (h >> 3) * 128 + (tid - 128) : h * 64 + (tid - 256));
            colA = 2048 + ch;
            const float* cw = p.in[13 + p.z];
            w0 = cw[ch]; w1 = cw[3072 + ch]; w2 = cw[2 * 3072 + ch]; w3 = cw[3 * 3072 + ch]; cbias = p.in[14 + p.z][ch];
            if (sample) { const float* st = p.in[3 + p.z] + (size_t)b * 3 * 3072; c0 = st[ch]; c1 = st[3072 + ch]; c2 = st[2 * 3072 + ch]; }
        } else if (tid < 328) { role = 3; didx = tid - 320; colA = 5120 + h; aux = p.in[15 + p.z][h]; aux2 = -__expf(p.in[16 + p.z][h]); }
    } else if constexpr (TYPE == 1) {
        if (tid < 128) { role = tid < 64 ? 0 : 1; didx = tid & 63; colA = (tid < 64 ? 5152 : 6176) + h * 128 + didx; colB = colA + 64;
            aux = exp2f(-(float)didx * 0.20762050593046014f); }
        else if (tid < 128 + VW) { role = 2; didx = tid - 128; colA = 7200 + h * 256 + s * VW + didx; }
    } else {
        if (tid < 128) { role = 0; didx = tid; colA = h * 128 + tid; }
        else if (tid < 256) { role = 1; didx = tid - 128; colA = 2048 + h * 128 + didx; aux = ((const float*)(p.ws + WS_LB))[h * 128 + didx]; }
        else if (tid < 256 + VW) { role = 2; didx = tid - 256; colA = 4096 + h * 128 + s * VW + didx; }
    }
    const float Dh = TYPE == 0 ? p.in[17 + p.z][h] : 0.f;
    const float gamma = TYPE == 1 ? 1.0f - exp2f(-5.0f - (float)h * (4.0f / 7.0f)) : 0.f;
    const int ldS = TYPE == 0 ? 64 : (TYPE == 1 ? 256 : 128);
    size_t soff;
    if constexpr (TYPE == 0) soff = ((size_t)(b * 32 + h) * 128) * 64;
    else if constexpr (TYPE == 1) soff = ((size_t)(b * 8 + h) * 128) * 256 + s * VW;
    else soff = ((size_t)(b * 16 + h) * 128) * 128 + s * VW;
    const float* S0 = TYPE == 0 ? p.in[2 + p.z] : (TYPE == 1 ? p.in[4 + p.z] : p.in[5 + p.z]);
    float* Sout = p.out + (TYPE == 0 ? (sample ? O_SSMS : O_SSMP) : (TYPE == 1 ? (sample ? O_RETS : O_RETP) : (sample ? O_HGS : O_HGP))) + soff;
    VT S[4];
#pragma unroll
    for (int i = 0; i < 4; ++i) { if (sample) S[i] = *(const VT*)(S0 + soff + (size_t)(kb + i) * ldS + NV * vq); else S[i] = (VT)(0.f); }
    unsigned short ra[8], rb[8]; unsigned short zr = 0;
    const int R = (L + 7) >> 3;
    auto load_raw = [&](int r) {
#pragma unroll
        for (int t = 0; t < 8; ++t) {
            const int tt = 8 * r + t;
            ra[t] = 0; rb[t] = 0;
            if (tt < L) {
                if (colA >= 0) ra[t] = proj[(size_t)tt * LDP + colA];
                if (TYPE == 1 && colB >= 0) rb[t] = proj[(size_t)tt * LDP + colB];
            }
        }
        if (TYPE == 0) { const int tt = 8 * r + w; if (tt < L) zr = proj[(size_t)tt * LDP + h * 64 + lane]; }
    };
    load_raw(0);
    for (int r = 0; r < R; ++r) {
        const int nv = (L - 8 * r) < 8 ? (L - 8 * r) : 8;
        float* stg = ldsf + (r & 1) * 4096;
        float* qs = stg; float* ks = stg + 1024; float* as = stg + 2048; float* vs = stg + 3072; float* ad = stg + 3584;
        if constexpr (TYPE == 0) {
            if (role >= 0 && role < 3) {
                float* dst = role == 0 ? qs : (role == 1 ? ks : vs); const int dstr = role == 2 ? 64 : 128;
#pragma unroll
                for (int t = 0; t < 8; ++t) {
                    const float x = bf2f(ra[t]);
                    const float y = cbias + w0 * c0 + w1 * c1 + w2 * c2 + w3 * x;
                    c0 = c1; c1 = c2; c2 = x;
                    dst[t * dstr + didx] = silu(y);
                }
            } else if (role == 3) {
                float xv = 0.f;
#pragma unroll
                for (int t = 0; t < 8; ++t) if (t == didx) xv = bf2f(ra[t]);
                const float dt = softplus(xv + aux);
                ad[2 * didx] = __expf(dt * aux2); ad[2 * didx + 1] = dt;
            }
        } else if constexpr (TYPE == 1) {
            if (role == 0 || role == 1) {
                float* dst = role == 0 ? qs : ks; const float sc = role == 0 ? 1.0f : 0.08838834764831845f;
#pragma unroll
                for (int t = 0; t < 8; ++t) {
                    const int pos = pos0 + 8 * r + t;
                    const double rev = (double)pos * (double)aux * 0.15915494309189535;
                    const float fr = (float)(rev - floor(rev));
                    const float sn = __builtin_amdgcn_sinf(fr), cs = __builtin_amdgcn_cosf(fr);
                    const float x1 = bf2f(ra[t]) * sc, x2 = bf2f(rb[t]) * sc;
                    dst[t * 128 + didx] = x1 * cs - x2 * sn;
                    dst[t * 128 + 64 + didx] = x1 * sn + x2 * cs;
                }
            } else if (role == 2) {
#pragma unroll
                for (int t = 0; t < 8; ++t) vs[t * VW + didx] = bf2f(ra[t]);
            }
        } else {
            if (role == 0) {
#pragma unroll
                for (int t = 0; t < 8; ++t) qs[t * 128 + didx] = silu(bf2f(ra[t]));
            } else if (role == 1) {
#pragma unroll
                for (int t = 0; t < 8; ++t) { const float f = aux + (1.0f - aux) * sigm(bf2f(ra[t])); as[t * 128 + didx] = f; ks[t * 128 + didx] = 1.0f - f; }
            } else if (role == 2) {
#pragma unroll
                for (int t = 0; t < 8; ++t) vs[t * VW + didx] = bf2f(ra[t]);
            }
        }
        const unsigned short zc = zr;
        __syncthreads();
        if (r + 1 < R) load_raw(r + 1);
        for (int t0 = 0; t0 < nv; t0 += 4) {
#pragma unroll
            for (int tt = 0; tt < 4; ++tt) {
                const int t = t0 + tt;
                const f32x4 q4 = *(const f32x4*)(qs + t * 128 + kb);
                f32x4 k4 = *(const f32x4*)(ks + t * 128 + kb);
                const VT v4 = *(const VT*)(vs + t * VW + NV * vq);
                f32x4 a4;
                if constexpr (TYPE == 0) { const f32x2 adv = *(const f32x2*)(ad + 2 * t); a4 = (f32x4){adv.x, adv.x, adv.x, adv.x}; k4 = k4 * adv.y; }
                else if constexpr (TYPE == 1) a4 = (f32x4){gamma, gamma, gamma, gamma};
                else a4 = *(const f32x4*)(as + t * 128 + kb);
                VT o = (VT)(0.f);
#pragma unroll
                for (int i = 0; i < 4; ++i) { S[i] = a4[i] * S[i] + k4[i] * v4; o += q4[i] * S[i]; }
                *(VT*)(part + ((t * 32 + w * 4 + kg) * VW + NV * vq)) = o;
            }
        }
        __syncthreads();
        const int rt = tid / VW, rv = tid % VW;
        if (tid < 8 * VW && rt < nv) {
            float o = 0.f;
#pragma unroll
            for (int pp = 0; pp < 32; ++pp) o += part[(rt * 32 + pp) * VW + rv];
            const size_t trow = (size_t)(8 * r + rt);
            if constexpr (TYPE == 0) {
                const float y = (o + Dh * vs[rt * 64 + rv]) * silu(bf2f(zc));
                yz[trow * 4096 + h * 64 + rv] = f2bf(y);
            } else if constexpr (TYPE == 1) {
                yz[trow * 4096 + 2048 + h * 256 + s * VW + rv] = f2bf(o);
            } else {
                yz[trow * 4096 + h * 128 + s * VW + rv] = f2bf(o);
            }
        }
    }
#pragma unroll
    for (int i = 0; i < 4; ++i) *(VT*)(Sout + (size_t)(kb + i) * ldS + NV * vq) = S[i];
}

template <int TYPE>
__device__ __forceinline__ void dec_unit(const Params& p, float* ldsf, int b, int u) {
    int tid = threadIdx.x; asm volatile("" : "+v"(tid));
    const int w = tid >> 6, lane = tid & 63, kg = lane >> 4, vq = lane & 15;
    const int row0 = MP + 4 * b;
    constexpr int LDP = TYPE < 2 ? LD0 : LD1;
    const bf16_t* proj = (const bf16_t*)(p.ws + WS_PROJ) + (size_t)row0 * LDP;
    bf16_t* yz = (bf16_t*)(p.ws + WS_YZ) + (size_t)row0 * 4096;
    int h, sl; size_t soff; int ldS;
    if constexpr (TYPE == 0) { h = 8 * u + w; sl = 0; ldS = 64; soff = ((size_t)(b * 32 + h) * 128) * 64; }
    else if constexpr (TYPE == 1) { h = 2 * u + (w >> 2); sl = w & 3; ldS = 256; soff = ((size_t)(b * 8 + h) * 128) * 256 + sl * 64; }
    else { h = 4 * u + (w >> 1); sl = w & 1; ldS = 128; soff = ((size_t)(b * 16 + h) * 128) * 128 + sl * 64; }
    const float* S0 = (TYPE == 0 ? p.in[2 + p.z] : (TYPE == 1 ? p.in[4 + p.z] : p.in[5 + p.z])) + soff + (size_t)(32 * kg) * ldS + 4 * vq;
    float* Sout = p.out + (TYPE == 0 ? O_SSMS : (TYPE == 1 ? O_RETS : O_HGS)) + soff + (size_t)(32 * kg) * ldS + 4 * vq;
    if constexpr (TYPE == 0) {
        float* qs = ldsf; float* ks = ldsf + 512; float* xs = ldsf + 1024; float* zs = ldsf + 3072; float* ad = ldsf + 5120;
        unsigned short xr[2][4]; float cw[2][4], cb[2], st[2][3]; unsigned short zr[4]; unsigned short dr = 0;
#pragma unroll
        for (int q = 0; q < 2; ++q) {
            const int idx = tid + 512 * q;
            if (idx < 768) {
                const int ch = idx < 128 ? 2560 + u * 128 + idx : (idx < 256 ? 2048 + u * 128 + (idx - 128) : u * 512 + (idx - 256));
#pragma unroll
                for (int t = 0; t < 4; ++t) xr[q][t] = proj[(size_t)t * LDP + 2048 + ch];
#pragma unroll
                for (int j = 0; j < 4; ++j) cw[q][j] = p.in[13 + p.z][j * 3072 + ch];
                cb[q] = p.in[14 + p.z][ch];
#pragma unroll
                for (int j = 0; j < 3; ++j) st[q][j] = p.in[3 + p.z][((size_t)b * 3 + j) * 3072 + ch];
            }
        }
#pragma unroll
        for (int t = 0; t < 4; ++t) zr[t] = proj[(size_t)t * LDP + u * 512 + tid];
        if (tid < 32) dr = proj[(size_t)(tid >> 3) * LDP + 5120 + 8 * u + (tid & 7)];
        f32x4 S[32];
#pragma unroll
        for (int i = 0; i < 32; ++i) S[i] = *(const f32x4*)(S0 + (size_t)i * ldS);
#pragma unroll
        for (int q = 0; q < 2; ++q) {
            const int idx = tid + 512 * q;
            if (idx < 768) {
                float* dst = idx < 128 ? qs + idx : (idx < 256 ? ks + (idx - 128) : xs + (idx - 256));
                const int dstr = idx < 256 ? 128 : 512;
                float c0 = st[q][0], c1 = st[q][1], c2 = st[q][2];
#pragma unroll
                for (int t = 0; t < 4; ++t) {
                    const float x = bf2f(xr[q][t]);
                    const float y = cb[q] + cw[q][0] * c0 + cw[q][1] * c1 + cw[q][2] * c2 + cw[q][3] * x;
                    c0 = c1; c1 = c2; c2 = x;
                    dst[t * dstr] = silu(y);
                }
            }
        }
#pragma unroll
        for (int t = 0; t < 4; ++t) zs[t * 512 + tid] = silu(bf2f(zr[t]));
        if (tid < 32) {
            const int hh = 8 * u + (tid & 7);
            const float dt = softplus(bf2f(dr) + p.in[15 + p.z][hh]);
            ad[2 * tid] = __expf(-dt * __expf(p.in[16 + p.z][hh])); ad[2 * tid + 1] = dt;
        }
        __syncthreads();
        const float Dh = p.in[17 + p.z][h];
#pragma unroll 1
        for (int t = 0; t < 4; ++t) {
            const f32x2 adv = *(const f32x2*)(ad + 2 * (t * 8 + w));
            const f32x4 v4 = *(const f32x4*)(xs + t * 512 + w * 64 + 4 * vq);
            f32x4 o = (f32x4){0.f, 0.f, 0.f, 0.f};
#pragma unroll
            for (int i4 = 0; i4 < 8; ++i4) {
                const f32x4 q4 = *(const f32x4*)(qs + t * 128 + 32 * kg + 4 * i4);
                const f32x4 k4 = *(const f32x4*)(ks + t * 128 + 32 * kg + 4 * i4) * adv.y;
#pragma unroll
                for (int ii = 0; ii < 4; ++ii) { S[4 * i4 + ii] = adv.x * S[4 * i4 + ii] + k4[ii] * v4; o += q4[ii] * S[4 * i4 + ii]; }
            }
#pragma unroll
            for (int j = 0; j < 4; ++j) { o[j] += __shfl_xor(o[j], 16); o[j] += __shfl_xor(o[j], 32); }
            if (kg == 0) {
                const f32x4 z4 = *(const f32x4*)(zs + t * 512 + w * 64 + 4 * vq);
                const f32x4 y = (o + Dh * v4) * z4;
                u32x2 ov; ov.x = pk2(y[0], y[1]); ov.y = pk2(y[2], y[3]);
                *(u32x2*)(yz + (size_t)t * 4096 + h * 64 + 4 * vq) = ov;
            }
        }
#pragma unroll
        for (int i = 0; i < 32; ++i) *(f32x4*)(Sout + (size_t)i * ldS) = S[i];
    } else if constexpr (TYPE == 1) {
        float* qs = ldsf; float* ks = ldsf + 1024; float* vs = ldsf + 2048;
        unsigned short x1[4], x2[4], vr[4];
        const int hl = tid >> 7, isk = (tid >> 6) & 1, jf = tid & 63;
        if (tid < 256) {
            const int col = (isk ? 6176 : 5152) + (2 * u + hl) * 128 + jf;
#pragma unroll
            for (int t = 0; t < 4; ++t) { x1[t] = proj[(size_t)t * LDP + col]; x2[t] = proj[(size_t)t * LDP + col + 64]; }
        }
#pragma unroll
        for (int t = 0; t < 4; ++t) vr[t] = proj[(size_t)t * LDP + 7200 + (2 * u + (tid >> 8)) * 256 + (tid & 255)];
        f32x4 S[32];
#pragma unroll
        for (int i = 0; i < 32; ++i) S[i] = *(const f32x4*)(S0 + (size_t)i * ldS);
        if (tid < 256) {
            const float inv = exp2f(-(float)jf * 0.20762050593046014f);
            float* dst = isk ? ks : qs; const float sc = isk ? 0.08838834764831845f : 1.0f;
#pragma unroll
            for (int t = 0; t < 4; ++t) {
                const double rev = (double)(16384 + t) * (double)inv * 0.15915494309189535;
                const float fr = (float)(rev - floor(rev));
                const float sn = __builtin_amdgcn_sinf(fr), cs = __builtin_amdgcn_cosf(fr);
                const float a1 = bf2f(x1[t]) * sc, a2 = bf2f(x2[t]) * sc;
                dst[(t * 2 + hl) * 128 + jf] = a1 * cs - a2 * sn;
                dst[(t * 2 + hl) * 128 + 64 + jf] = a1 * sn + a2 * cs;
            }
        }
#pragma unroll
        for (int t = 0; t < 4; ++t) vs[(t * 2 + (tid >> 8)) * 256 + (tid & 255)] = bf2f(vr[t]);
        __syncthreads();
        const float gamma = 1.0f - exp2f(-5.0f - (float)h * (4.0f / 7.0f));
        const int hw = w >> 2;
#pragma unroll 1
        for (int t = 0; t < 4; ++t) {
            const f32x4 v4 = *(const f32x4*)(vs + (t * 2 + hw) * 256 + sl * 64 + 4 * vq);
            f32x4 o = (f32x4){0.f, 0.f, 0.f, 0.f};
#pragma unroll
            for (int i4 = 0; i4 < 8; ++i4) {
                const f32x4 q4 = *(const f32x4*)(qs + (t * 2 + hw) * 128 + 32 * kg + 4 * i4);
                const f32x4 k4 = *(const f32x4*)(ks + (t * 2 + hw) * 128 + 32 * kg + 4 * i4);
#pragma unroll
                for (int ii = 0; ii < 4; ++ii) { S[4 * i4 + ii] = gamma * S[4 * i4 + ii] + k4[ii] * v4; o += q4[ii] * S[4 * i4 + ii]; }
            }
#pragma unroll
            for (int j = 0; j < 4; ++j) { o[j] += __shfl_xor(o[j], 16); o[j] += __shfl_xor(o[j], 32); }
            if (kg == 0) {
                u32x2 ov; ov.x = pk2(o[0], o[1]); ov.y = pk2(o[2], o[3]);
                *(u32x2*)(yz + (size_t)t * 4096 + 2048 + h * 256 + sl * 64 + 4 * vq) = ov;
            }
        }
#pragma unroll
        for (int i = 0; i < 32; ++i) *(f32x4*)(Sout + (size_t)i * ldS) = S[i];
    } else {
        float* qs = ldsf; float* ks = ldsf + 2048; float* as = ldsf + 4096; float* vs = ldsf + 6144;
        unsigned short qr[4], fr_[4], vr[4];
        const int hl = tid >> 7, kk = tid & 127, col = (4 * u + hl) * 128 + kk;
#pragma unroll
        for (int t = 0; t < 4; ++t) { qr[t] = proj[(size_t)t * LDP + col]; fr_[t] = proj[(size_t)t * LDP + 2048 + col]; vr[t] = proj[(size_t)t * LDP + 4096 + col]; }
        const float lb = ((const float*)(p.ws + WS_LB))[col];
        f32x4 S[32];
#pragma unroll
        for (int i = 0; i < 32; ++i) S[i] = *(const f32x4*)(S0 + (size_t)i * ldS);
#pragma unroll
        for (int t = 0; t < 4; ++t) {
            const int o = (t * 4 + hl) * 128 + kk;
            qs[o] = silu(bf2f(qr[t]));
            const float f = lb + (1.0f - lb) * sigm(bf2f(fr_[t]));
            as[o] = f; ks[o] = 1.0f - f; vs[o] = bf2f(vr[t]);
        }
        __syncthreads();
        const int hw = w >> 1;
#pragma unroll 1
        for (int t = 0; t < 4; ++t) {
            const f32x4 v4 = *(const f32x4*)(vs + (t * 4 + hw) * 128 + sl * 64 + 4 * vq);
            f32x4 o = (f32x4){0.f, 0.f, 0.f, 0.f};
#pragma unroll
            for (int i4 = 0; i4 < 8; ++i4) {
                const int off = (t * 4 + hw) * 128 + 32 * kg + 4 * i4;
                const f32x4 q4 = *(const f32x4*)(qs + off), k4 = *(const f32x4*)(ks + off), a4 = *(const f32x4*)(as + off);
#pragma unroll
                for (int ii = 0; ii < 4; ++ii) { S[4 * i4 + ii] = a4[ii] * S[4 * i4 + ii] + k4[ii] * v4; o += q4[ii] * S[4 * i4 + ii]; }
            }
#pragma unroll
            for (int j = 0; j < 4; ++j) { o[j] += __shfl_xor(o[j], 16); o[j] += __shfl_xor(o[j], 32); }
            if (kg == 0) {
                u32x2 ov; ov.x = pk2(o[0], o[1]); ov.y = pk2(o[2], o[3]);
                *(u32x2*)(yz + (size_t)t * 4096 + h * 128 + sl * 64 + 4 * vq) = ov;
            }
        }
#pragma unroll
        for (int i = 0; i < 32; ++i) *(f32x4*)(Sout + (size_t)i * ldS) = S[i];
    }
}

#define CK_QS 0
#define CK_KS 17408
#define CK_KT 34816
#define CK_VT 53248
#define CK_PS 62464
#define CK_ST 71680
#define CK_CUM 89088
__device__ __forceinline__ bf16x8 ck_frag(const unsigned char* lds, int base, int pitch, int row, int kb, int q) {
    return *(const bf16x8*)(lds + base + row * pitch + (32 * kb + 8 * q) * 2);
}
template <int TYPE>
__device__ __forceinline__ void chunk_item(const Params& p, unsigned char* lds, int b, int h, int s) {
    int tid = threadIdx.x; asm volatile("" : "+v"(tid));
    const int w = tid >> 6, lane = tid & 63, r = lane & 15, q = lane >> 4;
    constexpr int LDP = TYPE < 2 ? LD0 : LD1;
    const bf16_t* proj = (const bf16_t*)(p.ws + WS_PROJ) + (size_t)(2048 * b) * LDP;
    bf16_t* yz = (bf16_t*)(p.ws + WS_YZ) + (size_t)(2048 * b) * 4096;
    const int I = w >> 1, Vn0 = 2 * (w & 1);
    const int c1 = tid & 127, tq = tid >> 7;
    const int cx = tid & 63, tx = tid >> 6;
    const int g = h >> 3;
    float cwC[4], cwB[4], cwX[4], cbC = 0.f, cbB = 0.f, cbX = 0.f, inv = 0.f, dtb = 0.f, Aneg = 0.f, Dh = 0.f, sstep = 0.f, cstep = 1.f;
    (void)sstep; (void)cstep;
    int colC = 0, colB = 0, colX = 0;
    if constexpr (TYPE == 0) {
        const int chC = 2560 + g * 128 + c1, chB = 2048 + g * 128 + c1, chX = h * 64 + cx;
        colC = 2048 + chC; colB = 2048 + chB; colX = 2048 + chX;
#pragma unroll
        for (int j = 0; j < 4; ++j) { cwC[j] = p.in[13 + p.z][j * 3072 + chC]; cwB[j] = p.in[13 + p.z][j * 3072 + chB]; cwX[j] = p.in[13 + p.z][j * 3072 + chX]; }
        cbC = p.in[14 + p.z][chC]; cbB = p.in[14 + p.z][chB]; cbX = p.in[14 + p.z][chX];
        dtb = p.in[15 + p.z][h]; Aneg = -__expf(p.in[16 + p.z][h]); Dh = p.in[17 + p.z][h];
    } else if constexpr (TYPE == 1) {
        const int isk = c1 >> 6, jf = c1 & 63;
        colC = (isk ? 6176 : 5152) + h * 128 + jf; colB = colC + 64; colX = 7200 + h * 256 + s * 64 + cx;
        inv = exp2f(-(float)jf * 0.20762050593046014f);
        { const float frs = inv * 0.15915494309189535f; sstep = __builtin_amdgcn_sinf(frs); cstep = __builtin_amdgcn_cosf(frs); }
    } else {
        colC = h * 128 + c1; colB = 2048 + h * 128 + c1; colX = 4096 + h * 128 + s * 64 + cx;
        inv = ((const float*)(p.ws + WS_LB))[h * 128 + c1];
    }
    float* cumb = (float*)(lds + CK_CUM);
    if constexpr (TYPE == 1) {
        const float lg = __logf(1.0f - exp2f(-5.0f - (float)h * (4.0f / 7.0f)));
        if (tid < 64) {
#pragma unroll
            for (int bfi = 0; bfi < 2; ++bfi) { float* cb = cumb + bfi * 320; cb[tid] = (tid + 1) * lg; cb[64 + tid] = __expf((tid + 1) * lg); cb[128 + tid] = __expf((63 - tid) * lg); cb[192 + tid] = 1.0f; if (tid == 0) cb[256] = __expf(64.0f * lg); }
        }
    }
    for (int i = tid; i < 17408 / 4; i += 512) ((unsigned*)(lds + CK_ST))[i] = 0u;
    f32x4 Sacc[4];
#pragma unroll
    for (int i = 0; i < 4; ++i) Sacc[i] = (f32x4){0.f, 0.f, 0.f, 0.f};
    unsigned short xc[19], xb[19], xx[11], zr[8], dr = 0;
    auto load_raw = [&](int c) {
        const int t0 = 64 * c;
        if constexpr (TYPE == 0) {
#pragma unroll
            for (int i = 0; i < 19; ++i) { const int t = t0 + 16 * tq - 3 + i; xc[i] = 0; xb[i] = 0; if (t >= 0) { xc[i] = proj[(size_t)t * LDP + colC]; xb[i] = proj[(size_t)t * LDP + colB]; } }
#pragma unroll
            for (int i = 0; i < 11; ++i) { const int t = t0 + 8 * tx - 3 + i; xx[i] = 0; if (t >= 0) xx[i] = proj[(size_t)t * LDP + colX]; }
            if (w == 7) dr = proj[(size_t)(t0 + lane) * LDP + 5120 + h];
#pragma unroll
            for (int vv = 0; vv < 2; ++vv)
#pragma unroll
                for (int jx = 0; jx < 4; ++jx) zr[vv * 4 + jx] = proj[(size_t)(t0 + 16 * I + 4 * q + jx) * LDP + h * 64 + 16 * (Vn0 + vv) + r];
        } else {
#pragma unroll
            for (int i = 0; i < 16; ++i) { const int t = t0 + 16 * tq + i; xc[i] = proj[(size_t)t * LDP + colC]; xb[i] = proj[(size_t)t * LDP + colB]; }
#pragma unroll
            for (int i = 0; i < 8; ++i) xx[i] = proj[(size_t)(t0 + 8 * tx + i) * LDP + colX];
        }
    };
    load_raw(0);
    for (int c = 0; c < 32; ++c) {
        const int t0 = 64 * c;
        float* cum = cumb + (TYPE == 0 ? (c & 1) * 320 : 0);
        float vq_[16], vk_[16], vx_[8], kt_[16], Eval = 0.f;
        (void)kt_; (void)Eval;
        if constexpr (TYPE == 0) {
#pragma unroll
            for (int i = 0; i < 16; ++i) {
                vq_[i] = silu(cbC + cwC[0] * bf2f(xc[i]) + cwC[1] * bf2f(xc[i + 1]) + cwC[2] * bf2f(xc[i + 2]) + cwC[3] * bf2f(xc[i + 3]));
                vk_[i] = silu(cbB + cwB[0] * bf2f(xb[i]) + cwB[1] * bf2f(xb[i + 1]) + cwB[2] * bf2f(xb[i + 2]) + cwB[3] * bf2f(xb[i + 3]));
            }
#pragma unroll
            for (int i = 0; i < 8; ++i) vx_[i] = silu(cbX + cwX[0] * bf2f(xx[i]) + cwX[1] * bf2f(xx[i + 1]) + cwX[2] * bf2f(xx[i + 2]) + cwX[3] * bf2f(xx[i + 3]));
            if (w == 7) {
                const float dt = softplus(bf2f(dr) + dtb);
                float cs = dt * Aneg;
#pragma unroll
                for (int o = 1; o < 64; o <<= 1) { const float t = __shfl_up(cs, o); if (lane >= o) cs += t; }
                const float last = __shfl(cs, 63);
                cum[lane] = cs; cum[64 + lane] = __expf(cs); cum[128 + lane] = __expf(last - cs); cum[192 + lane] = dt;
                if (lane == 0) cum[256] = __expf(last);
            }
        } else if constexpr (TYPE == 2) {
            float pr[16], om[16];
            float run = 1.f;
#pragma unroll
            for (int i = 0; i < 16; ++i) { const float f = inv + (1.0f - inv) * sigm(bf2f(xb[i])); run *= f; pr[i] = run; om[i] = 1.0f - f; }
#pragma unroll
            for (int i = 0; i < 16; ++i) { const float ip = __builtin_amdgcn_rcpf(pr[i]); vq_[i] = silu(bf2f(xc[i])) * pr[i]; vk_[i] = om[i] * ip; kt_[i] = om[i] * ip * run; }
            Eval = run;
#pragma unroll
            for (int i = 0; i < 8; ++i) vx_[i] = bf2f(xx[i]);
        } else {
            {
                const double rev = (double)(t0 + 16 * tq) * (double)inv * 0.15915494309189535;
                const float fr = (float)(rev - floor(rev));
                float sn = __builtin_amdgcn_sinf(fr), cs = __builtin_amdgcn_cosf(fr);
#pragma unroll
                for (int i = 0; i < 16; ++i) {
                    const float a1 = bf2f(xc[i]), a2 = bf2f(xb[i]);
                    vq_[i] = a1 * cs - a2 * sn; vk_[i] = a1 * sn + a2 * cs;
                    const float c2 = cs * cstep - sn * sstep, s2 = sn * cstep + cs * sstep;
                    cs = c2; sn = s2;
                }
            }
#pragma unroll
            for (int i = 0; i < 8; ++i) vx_[i] = bf2f(xx[i]);
        }
        unsigned short zc[8];
#pragma unroll
        for (int i = 0; i < 8; ++i) zc[i] = zr[i];
        __syncthreads();
        if constexpr (TYPE == 0) {
            unsigned kt[8];
#pragma unroll
            for (int i = 0; i < 16; i += 2) {
                const int t = 16 * tq + i;
                const float k0 = vk_[i] * cum[192 + t], k1 = vk_[i + 1] * cum[192 + t + 1];
                *(bf16_t*)(lds + CK_QS + t * 272 + c1 * 2) = f2bf(vq_[i]); *(bf16_t*)(lds + CK_QS + (t + 1) * 272 + c1 * 2) = f2bf(vq_[i + 1]);
                *(bf16_t*)(lds + CK_KS + t * 272 + c1 * 2) = f2bf(k0); *(bf16_t*)(lds + CK_KS + (t + 1) * 272 + c1 * 2) = f2bf(k1);
                kt[i >> 1] = pk2(k0 * cum[128 + t], k1 * cum[128 + t + 1]);
            }
            *(u32x4*)(lds + CK_KT + c1 * 144 + 32 * tq) = (u32x4){kt[0], kt[1], kt[2], kt[3]};
            *(u32x4*)(lds + CK_KT + c1 * 144 + 32 * tq + 16) = (u32x4){kt[4], kt[5], kt[6], kt[7]};
        } else if constexpr (TYPE == 2) {
            unsigned kt[8];
#pragma unroll
            for (int i = 0; i < 16; i += 2) {
                const int t = 16 * tq + i;
                *(bf16_t*)(lds + CK_QS + t * 272 + c1 * 2) = f2bf(vq_[i]); *(bf16_t*)(lds + CK_QS + (t + 1) * 272 + c1 * 2) = f2bf(vq_[i + 1]);
                *(bf16_t*)(lds + CK_KS + t * 272 + c1 * 2) = f2bf(vk_[i]); *(bf16_t*)(lds + CK_KS + (t + 1) * 272 + c1 * 2) = f2bf(vk_[i + 1]);
                kt[i >> 1] = pk2(kt_[i], kt_[i + 1]);
            }
            *(u32x4*)(lds + CK_KT + c1 * 144 + 32 * tq) = (u32x4){kt[0], kt[1], kt[2], kt[3]};
            *(u32x4*)(lds + CK_KT + c1 * 144 + 32 * tq + 16) = (u32x4){kt[4], kt[5], kt[6], kt[7]};
            cum[tq * 128 + c1] = Eval;
        } else {
            const int isk = c1 >> 6, jf = c1 & 63;
            if (isk == 0) {
#pragma unroll
                for (int i = 0; i < 16; ++i) { const int t = 16 * tq + i; *(bf16_t*)(lds + CK_QS + t * 272 + jf * 2) = f2bf(vq_[i]); *(bf16_t*)(lds + CK_QS + t * 272 + (jf + 64) * 2) = f2bf(vk_[i]); }
            } else {
                unsigned kta[8], ktb[8];
#pragma unroll
                for (int i = 0; i < 16; i += 2) {
                    const int t = 16 * tq + i;
                    const float a0 = vq_[i] * 0.08838834764831845f, a1 = vq_[i + 1] * 0.08838834764831845f, b0 = vk_[i] * 0.08838834764831845f, b1 = vk_[i + 1] * 0.08838834764831845f;
                    *(bf16_t*)(lds + CK_KS + t * 272 + jf * 2) = f2bf(a0); *(bf16_t*)(lds + CK_KS + (t + 1) * 272 + jf * 2) = f2bf(a1);
                    *(bf16_t*)(lds + CK_KS + t * 272 + (jf + 64) * 2) = f2bf(b0); *(bf16_t*)(lds + CK_KS + (t + 1) * 272 + (jf + 64) * 2) = f2bf(b1);
                    kta[i >> 1] = pk2(a0 * cum[128 + t], a1 * cum[128 + t + 1]); ktb[i >> 1] = pk2(b0 * cum[128 + t], b1 * cum[128 + t + 1]);
                }
                *(u32x4*)(lds + CK_KT + jf * 144 + 32 * tq) = (u32x4){kta[0], kta[1], kta[2], kta[3]};
                *(u32x4*)(lds + CK_KT + jf * 144 + 32 * tq + 16) = (u32x4){kta[4], kta[5], kta[6], kta[7]};
                *(u32x4*)(lds + CK_KT + (jf + 64) * 144 + 32 * tq) = (u32x4){ktb[0], ktb[1], ktb[2], ktb[3]};
                *(u32x4*)(lds + CK_KT + (jf + 64) * 144 + 32 * tq + 16) = (u32x4){ktb[4], ktb[5], ktb[6], ktb[7]};
            }
        }
        *(u32x4*)(lds + CK_VT + cx * 144 + 16 * tx) = (u32x4){pk2(vx_[0], vx_[1]), pk2(vx_[2], vx_[3]), pk2(vx_[4], vx_[5]), pk2(vx_[6], vx_[7])};
        __syncthreads();
        if (c + 1 < 32) load_raw(c + 1);
        if constexpr (TYPE < 2) {
        bf16x8 aQ[4];
#pragma unroll
        for (int kb = 0; kb < 4; ++kb) aQ[kb] = ck_frag(lds, CK_QS, 272, 16 * I + r, kb, q);
        float cumi[4];
#pragma unroll
        for (int jx = 0; jx < 4; ++jx) cumi[jx] = cum[16 * I + 4 * q + jx];
#pragma unroll
        for (int jj = 0; jj < 2; ++jj) {
            const int J = Vn0 + jj;
            f32x4 acc = (f32x4){0.f, 0.f, 0.f, 0.f};
#pragma unroll
            for (int kb = 0; kb < 4; ++kb) acc = __builtin_amdgcn_mfma_f32_16x16x32_bf16(aQ[kb], ck_frag(lds, CK_KS, 272, 16 * J + r, kb, q), acc, 0, 0, 0);
            const int jcol = 16 * J + r; const float cumj = cum[jcol];
#pragma unroll
            for (int jx = 0; jx < 4; ++jx) {
                const int i = 16 * I + 4 * q + jx;
                const float v = (jcol <= i) ? acc[jx] * __expf(fminf(cumi[jx] - cumj, 0.f)) : 0.f;
                *(bf16_t*)(lds + CK_PS + i * 144 + jcol * 2) = f2bf(v);
            }
        }
        __syncthreads();
#pragma unroll
        for (int vv = 0; vv < 2; ++vv) {
            const int Vn = Vn0 + vv;
            f32x4 aPV = (f32x4){0.f, 0.f, 0.f, 0.f}, aQS = (f32x4){0.f, 0.f, 0.f, 0.f};
#pragma unroll
            for (int jb = 0; jb < 2; ++jb) aPV = __builtin_amdgcn_mfma_f32_16x16x32_bf16(ck_frag(lds, CK_PS, 144, 16 * I + r, jb, q), ck_frag(lds, CK_VT, 144, 16 * Vn + r, jb, q), aPV, 0, 0, 0);
#pragma unroll
            for (int kb = 0; kb < 4; ++kb) aQS = __builtin_amdgcn_mfma_f32_16x16x32_bf16(aQ[kb], ck_frag(lds, CK_ST, 272, 16 * Vn + r, kb, q), aQS, 0, 0, 0);
#pragma unroll
            for (int jx = 0; jx < 4; ++jx) {
                const int i = 16 * I + 4 * q + jx, v = 16 * Vn + r;
                const float o = aPV[jx] + cum[64 + i] * aQS[jx];
                if constexpr (TYPE == 0) {
                    const float xsv = bf2f(*(const bf16_t*)(lds + CK_VT + v * 144 + i * 2));
                    yz[(size_t)(t0 + i) * 4096 + h * 64 + v] = f2bf((o + Dh * xsv) * silu(bf2f(zc[vv * 4 + jx])));
                } else {
                    yz[(size_t)(t0 + i) * 4096 + 2048 + h * 256 + s * 64 + v] = f2bf(o);
                }
            }
        }
        __syncthreads();
        const float elast = cum[256];
#pragma unroll
        for (int Vn = 0; Vn < 4; ++Vn) {
            Sacc[Vn] = Sacc[Vn] * elast;
#pragma unroll
            for (int tb = 0; tb < 2; ++tb) Sacc[Vn] = __builtin_amdgcn_mfma_f32_16x16x32_bf16(ck_frag(lds, CK_KT, 144, 16 * w + r, tb, q), ck_frag(lds, CK_VT, 144, 16 * Vn + r, tb, q), Sacc[Vn], 0, 0, 0);
            *(u32x2*)(lds + CK_ST + (16 * Vn + r) * 272 + (16 * w + 4 * q) * 2) = (u32x2){pk2_sw(Sacc[Vn][0], Sacc[Vn][1]), pk2_sw(Sacc[Vn][2], Sacc[Vn][3])};
        }
            } else {
            const bf16x8 zf = (bf16x8){0, 0, 0, 0, 0, 0, 0, 0};
            if ((w & 1) == 0) {
                f32x4 acc = (f32x4){0.f, 0.f, 0.f, 0.f};
#pragma unroll
                for (int kb = 0; kb < 4; ++kb) acc = __builtin_amdgcn_mfma_f32_16x16x32_bf16(ck_frag(lds, CK_QS, 272, 16 * I + r, kb, q), ck_frag(lds, CK_KS, 272, 16 * I + r, kb, q), acc, 0, 0, 0);
#pragma unroll
                for (int jx = 0; jx < 4; ++jx) {
                    const float v = (r <= 4 * q + jx) ? acc[jx] : 0.f;
                    *(bf16_t*)(lds + CK_PS + (16 * I + 4 * q + jx) * 144 + (16 * I + r) * 2) = f2bf(v);
                }
            }
            __syncthreads();
#pragma unroll
            for (int sc = 0; sc < 4; ++sc) {
                const int stb = sc == 0 ? CK_ST : (sc == 1 ? CK_KS : (sc == 2 ? 91648 : 109056));
                const f32x4 e4 = *(const f32x4*)(cum + sc * 128 + 16 * w + 4 * q);
                const bf16x8 ka = (q < 2) ? *(const bf16x8*)(lds + CK_KT + (16 * w + r) * 144 + (16 * sc + 8 * q) * 2) : zf;
#pragma unroll
                for (int Vn = 0; Vn < 4; ++Vn) {
                    *(u32x2*)(lds + stb + (16 * Vn + r) * 272 + (16 * w + 4 * q) * 2) = (u32x2){pk2_sw(Sacc[Vn][0], Sacc[Vn][1]), pk2_sw(Sacc[Vn][2], Sacc[Vn][3])};
                    const bf16x8 vb = (q < 2) ? *(const bf16x8*)(lds + CK_VT + (16 * Vn + r) * 144 + (16 * sc + 8 * q) * 2) : zf;
                    Sacc[Vn] = __builtin_amdgcn_mfma_f32_16x16x32_bf16(ka, vb, Sacc[Vn] * e4, 0, 0, 0);
                }
            }
            __syncthreads();
            {
                const int sc = I;
                const int stb = sc == 0 ? CK_ST : (sc == 1 ? CK_KS : (sc == 2 ? 91648 : 109056));
                const bf16x8 pa = (q < 2) ? *(const bf16x8*)(lds + CK_PS + (16 * sc + r) * 144 + (16 * sc + 8 * q) * 2) : zf;
                bf16x8 qa[4];
#pragma unroll
                for (int kb = 0; kb < 4; ++kb) qa[kb] = ck_frag(lds, CK_QS, 272, 16 * sc + r, kb, q);
#pragma unroll
                for (int vv = 0; vv < 2; ++vv) {
                    const int Vn = Vn0 + vv;
                    const bf16x8 vb = (q < 2) ? *(const bf16x8*)(lds + CK_VT + (16 * Vn + r) * 144 + (16 * sc + 8 * q) * 2) : zf;
                    f32x4 aO = __builtin_amdgcn_mfma_f32_16x16x32_bf16(pa, vb, (f32x4){0.f, 0.f, 0.f, 0.f}, 0, 0, 0);
#pragma unroll
                    for (int kb = 0; kb < 4; ++kb) aO = __builtin_amdgcn_mfma_f32_16x16x32_bf16(qa[kb], ck_frag(lds, stb, 272, 16 * Vn + r, kb, q), aO, 0, 0, 0);
#pragma unroll
                    for (int jx = 0; jx < 4; ++jx) yz[(size_t)(t0 + 16 * sc + 4 * q + jx) * 4096 + h * 128 + s * 64 + 16 * Vn + r] = (bf16_t)(pk2_sw(aO[jx], 0.f) & 0xffffu);
                }
            }
        }
    }
    const int ldS = TYPE == 0 ? 64 : (TYPE == 1 ? 256 : 128);
    float* Sout = p.out + (TYPE == 0 ? O_SSMP + ((size_t)(b * 32 + h) * 128) * 64 : (TYPE == 1 ? O_RETP + ((size_t)(b * 8 + h) * 128) * 256 + s * 64 : O_HGP + ((size_t)(b * 16 + h) * 128) * 128 + s * 64));
#pragma unroll
    for (int Vn = 0; Vn < 4; ++Vn)
#pragma unroll
        for (int jx = 0; jx < 4; ++jx) Sout[(size_t)(16 * w + 4 * q + jx) * ldS + 16 * Vn + r] = Sacc[Vn][jx];
}

__device__ __forceinline__ void lru_dec_unit(const Params& p, int b) {
    int tid = threadIdx.x; asm volatile("" : "+v"(tid));
    const int c = tid * 4;
    const int row0 = MP + 4 * b;
    const float* LA = (const float*)(p.ws + WS_LA) + (size_t)row0 * 2048 + c;
    const bf16_t* LBv = (const bf16_t*)(p.ws + WS_LBB) + (size_t)row0 * 2048 + c;
    const bf16_t* rg = (const bf16_t*)(p.ws + WS_PROJ) + (size_t)row0 * LD1 + 10240 + c;
    bf16_t* mixa = (bf16_t*)(p.ws + WS_ACT) + (size_t)row0 * 4096 + 2048 + c;
    f32x4 hst = *(const f32x4*)(p.in[6 + p.z] + (size_t)b * 2048 + c);
#pragma unroll
    for (int t = 0; t < 4; ++t) {
        const f32x4 a = *(const f32x4*)(LA + (size_t)t * 2048);
        float bb[4], gg[4]; unpack4(*(const u32x2*)(LBv + (size_t)t * 2048), bb); unpack4(*(const u32x2*)(rg + (size_t)t * LD1), gg);
        float y[4];
#pragma unroll
        for (int j = 0; j < 4; ++j) { hst[j] = a[j] * hst[j] + bb[j]; y[j] = hst[j] * gelu_tanh(gg[j]); }
        u32x2 ov; ov.x = pk2(y[0], y[1]); ov.y = pk2(y[2], y[3]);
        *(u32x2*)(mixa + (size_t)t * 4096) = ov;
    }
    *(f32x4*)(p.out + O_LRUS + (size_t)b * 2048 + c) = hst;
}

__device__ __forceinline__ void lru_scan_item(const Params& p, float* ldsf, int b, int cg) {
    int tid = threadIdx.x; asm volatile("" : "+v"(tid));
    const int w = tid >> 6, lane = tid & 63, c = cg * 64 + lane;
    const size_t row0 = (size_t)2048 * b + 256 * w;
    const float* LA = (const float*)(p.ws + WS_LA) + row0 * 2048 + c;
    const bf16_t* LBv = (const bf16_t*)(p.ws + WS_LBB) + row0 * 2048 + c;
    const bf16_t* rg = (const bf16_t*)(p.ws + WS_PROJ) + row0 * LD1 + 10240 + c;
    bf16_t* mixa = (bf16_t*)(p.ws + WS_ACT) + row0 * 4096 + 2048 + c;
    float hl = 0.f, pr = 1.f;
    for (int tb = 0; tb < 256; tb += 16) {
        float a0[16]; unsigned short b0[16];
#pragma unroll
        for (int t = 0; t < 16; ++t) { a0[t] = LA[(size_t)(tb + t) * 2048]; b0[t] = LBv[(size_t)(tb + t) * 2048]; }
#pragma unroll
        for (int t = 0; t < 16; ++t) { hl = a0[t] * hl + bf2f(b0[t]); pr *= a0[t]; }
    }
    ldsf[w * 128 + lane] = pr; ldsf[w * 128 + 64 + lane] = hl;
    __syncthreads();
    float hst = 0.f;
    for (int ww = 0; ww < w; ++ww) hst = ldsf[ww * 128 + lane] * hst + ldsf[ww * 128 + 64 + lane];
    for (int tb = 0; tb < 256; tb += 16) {
        float a0[16]; unsigned short b0[16], g0[16];
#pragma unroll
        for (int t = 0; t < 16; ++t) { a0[t] = LA[(size_t)(tb + t) * 2048]; b0[t] = LBv[(size_t)(tb + t) * 2048]; g0[t] = rg[(size_t)(tb + t) * LD1]; }
#pragma unroll
        for (int t = 0; t < 16; ++t) {
            hst = a0[t] * hst + bf2f(b0[t]);
            mixa[(size_t)(tb + t) * 4096] = f2bf(hst * gelu_tanh(bf2f(g0[t])));
        }
    }
    if (w == 7) p.out[O_LRUP + (size_t)b * 2048 + c] = hst;
}

__device__ __forceinline__ void phase_rec0(const Params& p, float* ldsf) {
    unsigned* ctr = (unsigned*)(p.ws + WS_CTL);
    const int total = 256 + 512 + 512;
    for (;;) {
        const int it = next_item(ctr, ldsf);
        if (it >= total) break;
        if (it < 128) chunk_item<0>(p, (unsigned char*)ldsf, it >> 5, it & 31, 0);
        else if (it < 256) { const int j = it - 128; chunk_item<1>(p, (unsigned char*)ldsf, j >> 5, (j & 31) >> 2, j & 3); }
        else if (it < 768) { const int j = it - 256; dec_unit<0>(p, ldsf, j >> 2, j & 3); }
        else { const int j = it - 768; dec_unit<1>(p, ldsf, j >> 2, j & 3); }
    }
}
__device__ __forceinline__ void phase_rec1(const Params& p, float* ldsf) {
    unsigned* ctr = (unsigned*)(p.ws + WS_CTL) + 64;
    const int total = 128 + 128 + 512 + 128;
    for (;;) {
        const int it = next_item(ctr, ldsf);
        if (it >= total) break;
        if (it < 128) chunk_item<2>(p, (unsigned char*)ldsf, it >> 5, (it & 31) >> 1, it & 1);
        else if (it < 256) { const int j = it - 128; lru_scan_item(p, ldsf, j >> 5, j & 31); }
        else if (it < 768) { const int j = it - 256; dec_unit<2>(p, ldsf, j >> 2, j & 3); }
        else lru_dec_unit(p, it - 768);
    }
}

__device__ __forceinline__ void seq_of_row(int row, int& sample, int& b, int& t, int& L) {
    if (row < MP) { sample = 0; b = row >> 11; t = row & 2047; L = 2048; } else { sample = 1; b = (row - MP) >> 2; t = (row - MP) & 3; L = 4; }
}

__device__ __forceinline__ void phase_prep0(const Params& p) {
    int tid = threadIdx.x; asm volatile("" : "+v"(tid));
    const int wave = tid >> 6, lane = tid & 63;
    const int gw = blockIdx.x * 8 + wave, NGW = gridDim.x * 8;
    const bf16_t* YZ = (const bf16_t*)(p.ws + WS_YZ); const bf16_t* PR = (const bf16_t*)(p.ws + WS_PROJ);
    bf16_t* MX = (bf16_t*)(p.ws + WS_ACT);
    const float* nw = p.in[18 + p.z];
    u32x4 nya[4]; u32x2 nyb[8], ngb[8];
    auto ldrow = [&](int row) {
#pragma unroll
        for (int g = 0; g < 4; ++g) nya[g] = *(const u32x4*)(YZ + (size_t)row * 4096 + g * 512 + lane * 8);
#pragma unroll
        for (int hh = 0; hh < 8; ++hh) { nyb[hh] = *(const u32x2*)(YZ + (size_t)row * 4096 + 2048 + hh * 256 + lane * 4); ngb[hh] = *(const u32x2*)(PR + (size_t)row * LD0 + 9248 + hh * 256 + lane * 4); }
    };
    if (gw < MT) ldrow(gw);
    for (int row = gw; row < MT; row += NGW) {
        bf16_t* mx = MX + (size_t)row * 4096;
        u32x4 ya[4]; u32x2 yb[8], gb[8];
#pragma unroll
        for (int g = 0; g < 4; ++g) ya[g] = nya[g];
#pragma unroll
        for (int hh = 0; hh < 8; ++hh) { yb[hh] = nyb[hh]; gb[hh] = ngb[hh]; }
        if (row + NGW < MT) ldrow(row + NGW);
#pragma unroll
        for (int g = 0; g < 4; ++g) {
            const int c = g * 512 + lane * 8;
            float v[8]; unpack8(ya[g], v);
            float s = 0.f;
#pragma unroll
            for (int j = 0; j < 8; ++j) s += v[j] * v[j];
            s = wave_sum(s);
            const float rs = rsqrtf(s * (1.0f / 512.0f) + EPS);
            const f32x4 n0 = *(const f32x4*)(nw + c), n1 = *(const f32x4*)(nw + c + 4);
            u32x4 o; o.x = pk2(v[0] * rs * n0[0], v[1] * rs * n0[1]); o.y = pk2(v[2] * rs * n0[2], v[3] * rs * n0[3]);
            o.z = pk2(v[4] * rs * n1[0], v[5] * rs * n1[1]); o.w = pk2(v[6] * rs * n1[2], v[7] * rs * n1[3]);
            *(u32x4*)(mx + c) = o;
        }
#pragma unroll
        for (int hh = 0; hh < 8; ++hh) {
            const int c = hh * 256 + lane * 4;
            float v[4]; unpack4(yb[hh], v);
            float gt[4]; unpack4(gb[hh], gt);
            float s = (v[0] * v[0] + v[1] * v[1]) + (v[2] * v[2] + v[3] * v[3]);
            s = wave_sum(s);
            const float rs = rsqrtf(s * (1.0f / 256.0f) + EPS);
            u32x2 o; o.x = pk2(v[0] * rs * silu(gt[0]), v[1] * rs * silu(gt[1])); o.y = pk2(v[2] * rs * silu(gt[2]), v[3] * rs * silu(gt[3]));
            *(u32x2*)(mx + 2048 + c) = o;
        }
        int sample, b, t, L; seq_of_row(row, sample, b, t, L);
        if (t >= L - 3) {
            float* dst = p.out + (sample ? O_SCS : O_SCP) + ((size_t)b * 3 + (t - (L - 3))) * 3072;
            const bf16_t* src = PR + (size_t)row * LD0 + 2048;
#pragma unroll 4
            for (int c = lane; c < 3072; c += 64) dst[c] = bf2f(src[c]);
        }
    }
}

__device__ __forceinline__ void phase_prep1(const Params& p) {
    int tid = threadIdx.x; asm volatile("" : "+v"(tid));
    const int wave = tid >> 6, lane = tid & 63;
    const int gw = blockIdx.x * 8 + wave, NGW = gridDim.x * 8;
    const bf16_t* YZ = (const bf16_t*)(p.ws + WS_YZ); const bf16_t* PR = (const bf16_t*)(p.ws + WS_PROJ);
    bf16_t* MX = (bf16_t*)(p.ws + WS_ACT);
    const float* nw = p.in[22 + p.z];
    u32x4 nya[4], nga[4];
    auto ldrow = [&](int row) {
#pragma unroll
        for (int it = 0; it < 4; ++it) { nya[it] = *(const u32x4*)(YZ + (size_t)row * 4096 + it * 512 + lane * 8); nga[it] = *(const u32x4*)(PR + (size_t)row * LD1 + 6144 + it * 512 + lane * 8); }
    };
    if (gw < MT) ldrow(gw);
    for (int row = gw; row < MT; row += NGW) {
        u32x4 ya[4], ga[4];
#pragma unroll
        for (int it = 0; it < 4; ++it) { ya[it] = nya[it]; ga[it] = nga[it]; }
        if (row + NGW < MT) ldrow(row + NGW);
#pragma unroll
        for (int it = 0; it < 4; ++it) {
            const int c = it * 512 + lane * 8;
            float v[8]; unpack8(ya[it], v);
            float gt[8]; unpack8(ga[it], gt);
            float s = 0.f;
#pragma unroll
            for (int j = 0; j < 8; ++j) s += v[j] * v[j];
            s += __shfl_xor(s, 1); s += __shfl_xor(s, 2); s += __shfl_xor(s, 4); s += __shfl_xor(s, 8);
            const float rs = rsqrtf(s * (1.0f / 128.0f) + EPS);
            const f32x4 n0 = *(const f32x4*)(nw + (c & 127)), n1 = *(const f32x4*)(nw + (c & 127) + 4);
            float o[8];
#pragma unroll
            for (int j = 0; j < 8; ++j) o[j] = v[j] * rs * (j < 4 ? n0[j] : n1[j - 4]) * silu(gt[j]);
            u32x4 ov; ov.x = pk2(o[0], o[1]); ov.y = pk2(o[2], o[3]); ov.z = pk2(o[4], o[5]); ov.w = pk2(o[6], o[7]);
            *(u32x4*)(MX + (size_t)row * 4096 + c) = ov;
        }
    }
}

__device__ __forceinline__ void phase_act(const Params& p, int l) {
    int tid = threadIdx.x; asm volatile("" : "+v"(tid));
    const bf16_t* PR = (const bf16_t*)(p.ws + WS_PROJ); bf16_t* ACT = (bf16_t*)(p.ws + WS_ACT);
    const float* cw = p.in[32 + p.z] + (size_t)l * 3 * DFF; const float* cbv = p.in[33 + p.z] + (size_t)l * DFF;
    const float* st = p.in[8 + p.z] + (size_t)l * 128 * 2 * DFF;
    const int total = (MT / 4) * 704;
    for (int idx = blockIdx.x * 512 + tid; idx < total; idx += gridDim.x * 512) {
        const int rb = idx / 704, c = (idx - rb * 704) * 8, r0 = rb * 4;
        int sample, b, t0, L; seq_of_row(r0, sample, b, t0, L);
        u32x4 gr[6], ur[4];
#pragma unroll
        for (int i = 0; i < 4; ++i) { gr[i + 2] = *(const u32x4*)(PR + (size_t)(r0 + i) * LDU + c); ur[i] = *(const u32x4*)(PR + (size_t)(r0 + i) * LDU + DFF + c); }
        float g[6][8];
        if (t0 >= 2) { gr[0] = *(const u32x4*)(PR + (size_t)(r0 - 2) * LDU + c); gr[1] = *(const u32x4*)(PR + (size_t)(r0 - 1) * LDU + c); unpack8(gr[0], g[0]); unpack8(gr[1], g[1]); }
        else {
#pragma unroll
            for (int j = 0; j < 8; ++j) { g[0][j] = sample ? st[((size_t)b * 2 + 0) * DFF + c + j] : 0.f; g[1][j] = sample ? st[((size_t)b * 2 + 1) * DFF + c + j] : 0.f; }
        }
#pragma unroll
        for (int i = 0; i < 4; ++i) unpack8(gr[i + 2], g[i + 2]);
        float w0[8], w1[8], w2[8], bb[8];
#pragma unroll
        for (int j = 0; j < 8; ++j) { w0[j] = cw[c + j]; w1[j] = cw[DFF + c + j]; w2[j] = cw[2 * DFF + c + j]; bb[j] = cbv[c + j]; }
#pragma unroll
        for (int i = 0; i < 4; ++i) {
            float uu[8], o[8]; unpack8(ur[i], uu);
#pragma unroll
            for (int j = 0; j < 8; ++j) o[j] = silu(bb[j] + w0[j] * g[i][j] + w1[j] * g[i + 1][j] + w2[j] * g[i + 2][j]) * uu[j];
            u32x4 ov; ov.x = pk2(o[0], o[1]); ov.y = pk2(o[2], o[3]); ov.z = pk2(o[4], o[5]); ov.w = pk2(o[6], o[7]);
            *(u32x4*)(ACT + (size_t)(r0 + i) * DFF + c) = ov;
        }
        if (t0 + 4 == L) {
#pragma unroll
            for (int i = 0; i < 2; ++i) {
                float* dst = p.out + (sample ? O_FCS + (((size_t)l * 128 + b) * 2 + i) * DFF : O_FCP + (((size_t)l * 4 + b) * 2 + i) * DFF) + c;
                *(f32x4*)dst = (f32x4){g[4 + i][0], g[4 + i][1], g[4 + i][2], g[4 + i][3]}; *(f32x4*)(dst + 4) = (f32x4){g[4 + i][4], g[4 + i][5], g[4 + i][6], g[4 + i][7]};
            }
        }
    }
}

__device__ __forceinline__ void phase_lruconv(const Params& p) {
    int tid = threadIdx.x; asm volatile("" : "+v"(tid));
    const bf16_t* PR = (const bf16_t*)(p.ws + WS_PROJ); bf16_t* XR = (bf16_t*)(p.ws + WS_XR);
    const float* cw = p.in[23 + p.z]; const float* cbv = p.in[24 + p.z]; const float* st = p.in[7 + p.z];
    const int total = (MT / 4) * 256;
    for (int idx = blockIdx.x * 512 + tid; idx < total; idx += gridDim.x * 512) {
        const int rb = idx >> 8, c = (idx & 255) * 8, r0 = rb * 4;
        int sample, b, t0, L; seq_of_row(r0, sample, b, t0, L);
        float x[7][8];
#pragma unroll
        for (int j = 3; j < 7; ++j) unpack8(*(const u32x4*)(PR + (size_t)(r0 - 3 + j) * LD1 + 8192 + c), x[j]);
        if (t0 >= 3) {
#pragma unroll
            for (int j = 0; j < 3; ++j) unpack8(*(const u32x4*)(PR + (size_t)(r0 - 3 + j) * LD1 + 8192 + c), x[j]);
        } else {
#pragma unroll
            for (int j = 0; j < 3; ++j)
#pragma unroll
                for (int i = 0; i < 8; ++i) x[j][i] = sample ? st[((size_t)b * 3 + j) * 2048 + c + i] : 0.f;
        }
        float w0[8], w1[8], w2[8], w3[8], bb[8];
#pragma unroll
        for (int i = 0; i < 8; ++i) { w0[i] = cw[c + i]; w1[i] = cw[2048 + c + i]; w2[i] = cw[4096 + c + i]; w3[i] = cw[6144 + c + i]; bb[i] = cbv[c + i]; }
#pragma unroll
        for (int rr = 0; rr < 4; ++rr) {
            float o[8];
#pragma unroll
            for (int i = 0; i < 8; ++i) o[i] = bb[i] + w0[i] * x[rr][i] + w1[i] * x[rr + 1][i] + w2[i] * x[rr + 2][i] + w3[i] * x[rr + 3][i];
            u32x4 ov; ov.x = pk2(o[0], o[1]); ov.y = pk2(o[2], o[3]); ov.z = pk2(o[4], o[5]); ov.w = pk2(o[6], o[7]);
            *(u32x4*)(XR + (size_t)(r0 + rr) * 2048 + c) = ov;
        }
        if (t0 + 4 == L) {
#pragma unroll
            for (int j = 0; j < 3; ++j) {
                float* dst = p.out + (sample ? O_LCS : O_LCP) + ((size_t)b * 3 + j) * 2048 + c;
                *(f32x4*)dst = (f32x4){x[4 + j][0], x[4 + j][1], x[4 + j][2], x[4 + j][3]}; *(f32x4*)(dst + 4) = (f32x4){x[4 + j][4], x[4 + j][5], x[4 + j][6], x[4 + j][7]};
            }
        }
    }
}

template <int NS>
__device__ __forceinline__ void finalize_sample_rows(const Params& p, float* ssdst) {
    int tid = threadIdx.x; asm volatile("" : "+v"(tid));
    float* X = (float*)(p.ws + WS_X); bf16_t* XB = (bf16_t*)(p.ws + WS_XB); const float* PT = (const float*)(p.ws + WS_PROJ);
    for (int item = blockIdx.x * 512 + tid; item < 512 * 512; item += gridDim.x * 512) {
        const int row = item >> 9, c4 = item & 511;
        const unsigned o = (unsigned)(MP + row) * 2048u + (unsigned)c4 * 4u, po = (unsigned)row * 2048u + (unsigned)c4 * 4u;
        f32x4 v = *(const f32x4*)(X + o);
        f32x4 pv[NS];
#pragma unroll
        for (int ks = 0; ks < NS; ++ks) pv[ks] = *(const f32x4*)(PT + (size_t)ks * (512 * 2048) + po);
#pragma unroll
        for (int ks = 0; ks < NS; ++ks) v += pv[ks];
        *(f32x4*)(X + o) = v;
        u32x2 w; w.x = pk2(v[0], v[1]); w.y = pk2(v[2], v[3]);
        *(u32x2*)(XB + o) = w;
        float s2 = (v[0] * v[0] + v[1] * v[1]) + (v[2] * v[2] + v[3] * v[3]);
        s2 = wave_sum(s2);
        if ((tid & 63) == 0) atomicAdd(ssdst + MP + row, s2);
    }
}

__device__ __forceinline__ void phase_final(const Params& p) {
    int tid = threadIdx.x; asm volatile("" : "+v"(tid));
    const int wave = tid >> 6, lane = tid & 63;
    const int gw = blockIdx.x * 8 + wave, NGW = gridDim.x * 8;
    const float* X = (const float*)(p.ws + WS_X); const float* nf = p.in[11 + p.z];
    f32x4 nv[8];
    auto ldrow = [&](int row) {
#pragma unroll
        for (int j = 0; j < 8; ++j) nv[j] = *(const f32x4*)(X + (size_t)row * 2048 + (lane + 64 * j) * 4);
    };
    if (gw < MT) ldrow(gw);
    for (int row = gw; row < MT; row += NGW) {
        f32x4 v[8]; float sq = 0.f;
#pragma unroll
        for (int j = 0; j < 8; ++j) v[j] = nv[j];
        if (row + NGW < MT) ldrow(row + NGW);
        if (row >= MP) {
#pragma unroll
            for (int j = 0; j < 8; ++j) {
                f32x4 pv[11];
#pragma unroll
                for (int ks = 0; ks < 11; ++ks) pv[ks] = *(const f32x4*)((const float*)(p.ws + WS_PROJ) + (size_t)ks * (512 * 2048) + (size_t)(row - MP) * 2048 + (lane + 64 * j) * 4);
#pragma unroll
                for (int ks = 0; ks < 11; ++ks) v[j] += pv[ks];
            }
        }
#pragma unroll
        for (int j = 0; j < 8; ++j) sq += (v[j][0] * v[j][0] + v[j][1] * v[j][1]) + (v[j][2] * v[j][2] + v[j][3] * v[j][3]);
        sq = wave_sum(sq);
        const float rs = rsqrtf(sq * (1.0f / 2048.0f) + EPS);
        float* dst = p.out + (row < MP ? O_YP + (size_t)row * 2048 : O_YS + (size_t)(row - MP) * 2048);
#pragma unroll
        for (int j = 0; j < 8; ++j) {
            const int c = (lane + 64 * j) * 4;
            *(f32x4*)(dst + c) = v[j] * rs * *(const f32x4*)(nf + c);
        }
    }
}

#define XB_TMO      128
#define XB_XCNT(j)  (256  + 64 * (j))
#define XB_XSUB(j)  (1280 + 64 * (j))
#define XB_XGEN(j)  (2304 + 64 * (j))
#define XB_TOP      3328
#define XB_TOPGEN   3392
#define XCD_BAR_WORDS 3456
#define XB_SPIN_CAP (1u << 22)
__device__ __forceinline__ unsigned xb_ld(unsigned* p)              { return __hip_atomic_load(p, __ATOMIC_RELAXED, __HIP_MEMORY_SCOPE_AGENT); }
__device__ __forceinline__ unsigned xb_add(unsigned* p, unsigned v) { return __hip_atomic_fetch_add(p, v, __ATOMIC_RELAXED, __HIP_MEMORY_SCOPE_AGENT); }
__device__ __forceinline__ unsigned xb_xcc_id() { return (unsigned)__builtin_amdgcn_s_getreg((3 << 11) | 20) & 0xFu; }
#define XB_SPIN(cond, bar) do { unsigned _sp = 0; while (cond) { __builtin_amdgcn_s_sleep(1); \
    if ((++_sp & 255u) == 0u) { if (xb_ld(&(bar)[XB_TMO])) break; if (_sp > XB_SPIN_CAP) { atomicAdd(&(bar)[XB_TMO], 1u); break; } } } } while (0)
struct XcdBarrier { unsigned* bar; unsigned x; volatile LAS unsigned* st; };
__device__ __forceinline__ XcdBarrier xcd_barrier_post(unsigned* bar, volatile LAS unsigned* st) {
    XcdBarrier b; b.bar = bar; b.x = xb_xcc_id(); b.st = st;
    if (threadIdx.x == 0) (void)xb_add(&bar[XB_XCNT(b.x)], 1u);
    return b;
}
__device__ __forceinline__ void xcd_barrier_complete(unsigned* bar, unsigned x, unsigned& nloc, unsigned& nx) {
    const unsigned G = gridDim.x * gridDim.y * gridDim.z;
    unsigned sum, cnt, mine, sp = 0u;
    for (;;) {
        sum = 0u; cnt = 0u; mine = 0u;
#pragma unroll
        for (unsigned j = 0; j < 16; ++j) { const unsigned c = xb_ld(&bar[XB_XCNT(j)]); sum += c; cnt += (c > 0u) ? 1u : 0u; mine = (j == x) ? c : mine; }
        if (sum == G) break;
        __builtin_amdgcn_s_sleep(1);
        if ((++sp & 255u) == 0u) { if (xb_ld(&bar[XB_TMO])) break; if (sp > XB_SPIN_CAP) { atomicAdd(&bar[XB_TMO], 1u); break; } }
    }
    nloc = mine > 0u ? mine : 1u; nx = cnt > 0u ? cnt : 1u;
}
__device__ __forceinline__ void xcd_barrier(const XcdBarrier& b) {
    asm volatile("s_waitcnt vmcnt(0)" ::: "memory");
    __syncthreads();
    if (threadIdx.x == 0) {
        unsigned* bar = b.bar;
        __builtin_amdgcn_s_waitcnt(0);
        unsigned nloc = b.st[0], nx = b.st[1];
        if (nloc == 0u) { xcd_barrier_complete(bar, b.x, nloc, nx); b.st[0] = nloc; b.st[1] = nx; }
        const unsigned old = xb_add(&bar[XB_XSUB(b.x)], 1u);
        const unsigned gen = old / nloc;
        if (old + 1u == (gen + 1u) * nloc) {
            __builtin_amdgcn_fence(__ATOMIC_RELEASE, "agent");
            asm volatile("s_waitcnt vmcnt(0)" ::: "memory");
            const unsigned og = xb_add(&bar[XB_TOP], 1u);
            const unsigned tg = og / nx;
            if (og + 1u == (tg + 1u) * nx) xb_add(&bar[XB_TOPGEN], 1u);
            else XB_SPIN(xb_ld(&bar[XB_TOPGEN]) == tg, bar);
            __builtin_amdgcn_fence(__ATOMIC_ACQUIRE, "agent");
            xb_add(&bar[XB_XGEN(b.x)], 1u);
            asm volatile("s_waitcnt vmcnt(0)" ::: "memory");
        } else {
            XB_SPIN(xb_ld(&bar[XB_XGEN(b.x)]) == gen, bar);
            __builtin_amdgcn_fence(__ATOMIC_ACQUIRE, "agent");
            asm volatile("s_waitcnt vmcnt(0)" ::: "memory");
        }
    }
    __syncthreads();
}

#ifndef PROBE_MASK
#define PROBE_MASK 0u
#endif
#ifndef PHMASK
#define PHMASK 0xFFFFFFFFu
#endif
#define EN(i) (((PHMASK) >> (i)) & 1u)
__global__ void __launch_bounds__(512, 2) fwd_megakernel(Params p) {
    extern __shared__ __attribute__((aligned(16))) unsigned char shm[];
    float* ldsf = (float*)shm;
    LAS unsigned char* ldsg = (LAS unsigned char*)shm;
    unsigned char* ws = p.ws;
    float* ssb = (float*)(ws + WS_SS);
    volatile LAS unsigned* xst = (volatile LAS unsigned*)(ldsg + 133120);
    if (threadIdx.x == 0) { xst[0] = 0u; xst[1] = 0u; }
    __syncthreads();
    (void)xcd_barrier_post((unsigned*)(ws + WS_CTL) + 256, xst);
#define XBAR() do { XcdBarrier _b; _b.bar = (unsigned*)(p.ws + WS_CTL) + 256; _b.x = xb_xcc_id(); _b.st = (volatile LAS unsigned*)((LAS unsigned char*)shm + 133120); xcd_barrier(_b); } while (0)
#if PROBE_MASK
    unsigned long long tph = __builtin_amdgcn_s_memrealtime();
#endif
    for (int ph = p.ph_lo; ph < p.ph_hi; ++ph) {
        if (ph > p.ph_lo) {
            if (ph == 1) cg::this_grid().sync();
            else XBAR();
#if PROBE_MASK
            {
                const unsigned long long t1 = __builtin_amdgcn_s_memrealtime();
                if ((PROBE_MASK >> (ph - 1)) & 1u) { const unsigned long long dt = t1 - tph; while (__builtin_amdgcn_s_memrealtime() - t1 < dt) __builtin_amdgcn_s_sleep(8); }
                tph = __builtin_amdgcn_s_memrealtime();
            }
#endif
        }
        if (EN(0) && ph == 0) phase_prologue(p, ldsf);
        else if (EN(1) && (ph == 1 || ph == 5 || ph == 8 || ph == 14)) {
            pg8::Gemm g; pg8::EpiScaleBf16 E; int N;
            if (ph != 1) { float* sd = ssb + (ph == 5 ? 1 : (ph == 8 ? 2 : 3)) * MT; if (ph == 8) finalize_sample_rows<11>(p, sd); else finalize_sample_rows<16>(p, sd); XBAR(); }
            g.A = (const char*)(ws + WS_XB); g.lda = 2048; g.ldb = 2048;
            if (ph == 1) { g.Bt = (const char*)(ws + WS_WIN0); N = LD0; E.ss = ssb; }
            else if (ph == 5) { g.Bt = (const char*)(ws + WS_WUP0); N = LDU; E.ss = ssb + MT; }
            else if (ph == 8) { g.Bt = (const char*)(ws + WS_WIN1); N = LD1; E.ss = ssb + 2 * MT; }
            else { g.Bt = (const char*)(ws + WS_WUP1); N = LDU; E.ss = ssb + 3 * MT; }
            E.O = (bf16_t*)(ws + WS_PROJ); E.ldc = N;
            pg8::Order S; S.nMm = 32; S.nN = N / 256; S.n_main = 32 * S.nN; S.n_tail = 2 * S.nN; S.ksplit = 1; S.nt_full = 32; S.G = gridDim.x; S.c = blockIdx.x;
            S.a_t = (size_t)256 * 2048 * 2; S.b_t = (size_t)256 * 2048 * 2; S.acol = 0;
            pg8::gemm_phase<pg8::EpiScaleBf16>(ldsg, g, S, E);
        }
        else if (EN(4) && (ph == 4 || ph == 7 || ph == 13 || ph == 16)) {
            pg8::Gemm g; pg8::EpiResid E;
            g.A = (const char*)(ws + WS_ACT);
            if (ph == 4) { g.Bt = (const char*)(ws + WS_WOUT0); g.lda = 4096; E.ssout = ssb + MT; }
            else if (ph == 7) { g.Bt = (const char*)(ws + WS_WDN0); g.lda = DFF; E.ssout = ssb + 2 * MT; }
            else if (ph == 13) { g.Bt = (const char*)(ws + WS_WOUT1); g.lda = 4096; E.ssout = ssb + 3 * MT; }
            else { g.Bt = (const char*)(ws + WS_WDN1); g.lda = DFF; E.ssout = ssb + 4 * MT; }
            g.ldb = g.lda;
            E.X = (float*)(ws + WS_X); E.XB = (bf16_t*)(ws + WS_XB); E.part = (float*)(ws + WS_PROJ);
            pg8::Order S; S.nMm = 32; S.nN = 8; S.n_main = 256; S.nt_full = g.lda / 64; S.ksplit = (g.lda == 4096) ? 16 : 11; S.n_tail = 16 * S.ksplit; S.G = gridDim.x; S.c = blockIdx.x;
            S.a_t = (size_t)256 * g.lda * 2; S.b_t = (size_t)256 * g.ldb * 2; S.acol = 0;
            pg8::gemm_phase<pg8::EpiResid>(ldsg, g, S, E);
        }
        else if (EN(10) && ph == 10) {
            pg8::Gemm g; pg8::EpiLru E;
            g.A = (const char*)(ws + WS_XR); g.Bt = (const char*)(ws + WS_WLRU); g.lda = 2048; g.ldb = 256;
            E.br = p.in[26 + p.z]; E.bi = p.in[28 + p.z]; E.sp = (const float*)(ws + WS_SP); E.XR = (const bf16_t*)(ws + WS_XR);
            E.LA = (float*)(ws + WS_LA); E.LBv = (bf16_t*)(ws + WS_LBB);
            pg8::Order S; S.nMm = 34; S.nN = 16; S.n_main = 34 * 16; S.n_tail = 0; S.ksplit = 1; S.nt_full = 4 + p.z; S.G = gridDim.x; S.c = blockIdx.x;
            S.a_t = (size_t)256 * 2048 * 2; S.b_t = (size_t)256 * 256 * 2; S.acol = 512;
            pg8::gemm_phase<pg8::EpiLru>(ldsg, g, S, E);
        }
        else if (EN(2) && ph == 2) phase_rec0(p, ldsf);
        else if (EN(3) && ph == 3) phase_prep0(p);
        else if (EN(6) && ph == 6) phase_act(p, 0);
        else if (EN(9) && ph == 9) phase_lruconv(p);
        else if (EN(11) && ph == 11) phase_rec1(p, ldsf);
        else if (EN(12) && ph == 12) phase_prep1(p);
        else if (EN(15) && ph == 15) phase_act(p, 1);
        else if (EN(17) && ph == 17) phase_final(p);
    }
}

#ifndef N_LAUNCH_MODE
#define N_LAUNCH_MODE 0
#endif

extern "C" void kernel_launch(void* const* d_in, const int* in_sizes, int n_in, void* d_out, int out_size, void* d_ws, size_t ws_size, hipStream_t stream) {
    static int grid = 0;
    if (grid == 0) {
        if (n_in != 35 || (size_t)out_size != O_END || ws_size < WS_END) { fprintf(stderr, "kernel_launch: unexpected shapes: n_in %d out %d ws %zu (need %zu)\n", n_in, out_size, ws_size, (size_t)WS_END); grid = -1; return; }
        int dev = 0, cus = 0, per_cu = 0;
        hipGetDevice(&dev);
        hipDeviceGetAttribute(&cus, hipDeviceAttributeMultiprocessorCount, dev);
        if (hipFuncSetAttribute((const void*)fwd_megakernel, hipFuncAttributeMaxDynamicSharedMemorySize, LDS_BYTES) != hipSuccess) { fprintf(stderr, "kernel_launch: hipFuncSetAttribute failed\n"); grid = -1; return; }
        if (hipOccupancyMaxActiveBlocksPerMultiprocessor(&per_cu, (const void*)fwd_megakernel, 512, LDS_BYTES) != hipSuccess || per_cu < 1) { fprintf(stderr, "kernel_launch: occupancy query says %d\n", per_cu); per_cu = 1; }
        (void)hipGetLastError();
        grid = cus;
    }
    if (grid < 0) return;
    (void)hipMemsetAsync((char*)d_ws + WS_CTL, 0, 16384, stream);
    Params p{};
    for (int i = 0; i < 35; ++i) p.in[i] = (const float*)d_in[i];
    p.z = 0; p.pad = 0;
    p.out = (float*)d_out; p.ws = (unsigned char*)d_ws;
#if N_LAUNCH_MODE == 0
    p.ph_lo = 0; p.ph_hi = NPHASE;
    void* args[] = {&p};
    hipError_t e = hipLaunchCooperativeKernel((const void*)fwd_megakernel, dim3(grid), dim3(512), args, LDS_BYTES, stream);
    if (e != hipSuccess) fprintf(stderr, "cooperative launch failed: %s (grid %d)\n", hipGetErrorString(e), grid);
#else
    for (int ph = 0; ph < NPHASE; ++ph) {
        p.ph_lo = ph; p.ph_hi = ph + 1;
        hipLaunchKernelGGL(fwd_megakernel, dim3(grid), dim3(512), LDS_BYTES, stream, p);
    }
#endif
}
```

```cpp
#include <hip/hip_runtime.h>
#include <hip/hip_cooperative_groups.h>
#include <cstdio>
#include <cstdint>
namespace cg = cooperative_groups;

#define LAS __attribute__((address_space(3)))
typedef unsigned short bf16_t;
typedef short bf16x8 __attribute__((ext_vector_type(8)));
typedef float f32x4 __attribute__((ext_vector_type(4)));
typedef float f32x2 __attribute__((ext_vector_type(2)));
typedef unsigned u32x4 __attribute__((ext_vector_type(4)));
typedef unsigned u32x2 __attribute__((ext_vector_type(2)));

constexpr int D = 2048, MP = 8192, MS = 512, MT = 8704;
constexpr int LD0 = 11520, LD1 = 12288, LDU = 11264, DFF = 5632;
constexpr float EPS = 1e-6f;
constexpr size_t O_YP = 0;
constexpr size_t O_YS = O_YP + (size_t)4 * 2048 * 2048;
constexpr size_t O_SSMP = O_YS + (size_t)128 * 4 * 2048;
constexpr size_t O_SSMS = O_SSMP + (size_t)4 * 32 * 128 * 64;
constexpr size_t O_SCP = O_SSMS + (size_t)128 * 32 * 128 * 64;
constexpr size_t O_SCS = O_SCP + (size_t)4 * 3 * 3072;
constexpr size_t O_RETP = O_SCS + (size_t)128 * 3 * 3072;
constexpr size_t O_RETS = O_RETP + (size_t)4 * 8 * 128 * 256;
constexpr size_t O_HGP = O_RETS + (size_t)128 * 8 * 128 * 256;
constexpr size_t O_HGS = O_HGP + (size_t)4 * 16 * 128 * 128;
constexpr size_t O_LRUP = O_HGS + (size_t)128 * 16 * 128 * 128;
constexpr size_t O_LRUS = O_LRUP + (size_t)4 * 2048;
constexpr size_t O_LCP = O_LRUS + (size_t)128 * 2048;
constexpr size_t O_LCS = O_LCP + (size_t)4 * 3 * 2048;
constexpr size_t O_FCP = O_LCS + (size_t)128 * 3 * 2048;
constexpr size_t O_FCS = O_FCP + (size_t)2 * 4 * 2 * 5632;
constexpr size_t O_END = O_FCS + (size_t)2 * 128 * 2 * 5632;
constexpr size_t al256(size_t x) { return (x + 255) & ~(size_t)255; }
constexpr size_t WS_CTL = 0;
constexpr size_t WS_SS = 16384;
constexpr size_t WS_SP = al256(WS_SS + (size_t)5 * MT * 4);
constexpr size_t WS_LB = WS_SP + 8192;
constexpr size_t WS_WIN0 = WS_LB + 8192;
constexpr size_t WS_WOUT0 = WS_WIN0 + (size_t)LD0 * 2048 * 2;
constexpr size_t WS_WUP0 = WS_WOUT0 + (size_t)2048 * 4096 * 2;
constexpr size_t WS_WDN0 = WS_WUP0 + (size_t)LDU * 2048 * 2;
constexpr size_t WS_WIN1 = WS_WDN0 + (size_t)2048 * DFF * 2;
constexpr size_t WS_WOUT1 = WS_WIN1 + (size_t)LD1 * 2048 * 2;
constexpr size_t WS_WUP1 = WS_WOUT1 + (size_t)2048 * 4096 * 2;
constexpr size_t WS_WDN1 = WS_WUP1 + (size_t)LDU * 2048 * 2;
constexpr size_t WS_WLRU = WS_WDN1 + (size_t)2048 * DFF * 2;
constexpr size_t WS_X = WS_WLRU + (size_t)16 * 256 * 256 * 2;
constexpr size_t WS_XB = WS_X + (size_t)MT * 2048 * 4;
constexpr size_t WS_PROJ = WS_XB + (size_t)MT * 2048 * 2;
constexpr size_t WS_ACT = WS_PROJ + (size_t)MT * LD1 * 2;
constexpr size_t WS_YZ = WS_ACT + (size_t)MT * DFF * 2;
constexpr size_t WS_LA = WS_YZ + (size_t)MT * 4096 * 2;
constexpr size_t WS_LBB = WS_LA + (size_t)MT * 2048 * 4;
constexpr size_t WS_XR = WS_LBB + (size_t)MT * 2048 * 2;
constexpr size_t WS_END = WS_XR + (size_t)MT * 2048 * 2;

constexpr int LDS_BYTES = 133120 + 256;
constexpr int NPHASE = 18;

struct Params {
    const float* in[35];
    float* out;
    unsigned char* ws;
    int ph_lo, ph_hi;
    int z, pad;
};

__device__ __forceinline__ float bf2f(unsigned v) { return __uint_as_float(v << 16); }
__device__ __forceinline__ unsigned pk2(float lo, float hi) { unsigned r; asm volatile("v_cvt_pk_bf16_f32 %0, %1, %2" : "=v"(r) : "v"(lo), "v"(hi)); return r; }
__device__ __forceinline__ unsigned pk2_sw(float lo, float hi) {
    unsigned a = __float_as_uint(lo), b = __float_as_uint(hi); a += 0x7fffu + ((a >> 16) & 1u); b += 0x7fffu + ((b >> 16) & 1u); return (a >> 16) | (b & 0xffff0000u); }
__device__ __forceinline__ bf16_t f2bf(float x) { return (bf16_t)(pk2(x, 0.f) & 0xffffu); }
__device__ __forceinline__ float sigm(float x) { return __builtin_amdgcn_rcpf(1.f + __expf(-x)); }
__device__ __forceinline__ float silu(float x) { return x * __builtin_amdgcn_rcpf(1.f + __expf(-x)); }
__device__ __forceinline__ float softplus(float x) { return fmaxf(x, 0.f) + log1pf(__expf(-fabsf(x))); }
__device__ __forceinline__ float gelu_tanh(float x) { const float u = 0.7978845608f * (x + 0.044715f * x * x * x); const float t = 1.f - 2.f * __builtin_amdgcn_rcpf(1.f + __expf(2.f * u)); return 0.5f * x * (1.f + t); }
__device__ __forceinline__ float wave_sum(float v) {
#pragma unroll
    for (int o = 1; o < 64; o <<= 1) v += __shfl_xor(v, o);
    return v;
}
__device__ __forceinline__ void unpack8(u32x4 r, float* f) {
    f[0] = bf2f(r.x & 0xffffu); f[1] = __uint_as_float(r.x & 0xffff0000u); f[2] = bf2f(r.y & 0xffffu); f[3] = __uint_as_float(r.y & 0xffff0000u);
    f[4] = bf2f(r.z & 0xffffu); f[5] = __uint_as_float(r.z & 0xffff0000u); f[6] = bf2f(r.w & 0xffffu); f[7] = __uint_as_float(r.w & 0xffff0000u);
}
__device__ __forceinline__ void unpack4(u32x2 r, float* f) {
    f[0] = bf2f(r.x & 0xffffu); f[1] = __uint_as_float(r.x & 0xffff0000u); f[2] = bf2f(r.y & 0xffffu); f[3] = __uint_as_float(r.y & 0xffff0000u);
}
#define LDS_WAIT() asm volatile("s_waitcnt lgkmcnt(0)" ::: "memory")

namespace pg8 {
constexpr int BM = 256, BK = 64, HALF = 128, HTB = HALF * BK * 2, NXCD = 8, WGM = 8;
__device__ __forceinline__ int lds_byte(int r, int c) { const int st = (r >> 4) * 2 + (c >> 5), rr = r & 15, cc = c & 31, ob = rr * 64 + cc * 2; return st * 1024 + (ob ^ (((ob >> 9) & 1) << 5)); }
__device__ __forceinline__ void stage_rc(int b, int& R, int& C) { const int st = b / 1024, sb = b % 1024, swz = sb ^ (((sb >> 9) & 1) << 5); R = (st >> 1) * 16 + swz / 64; C = (st & 1) * 32 + (swz % 64) / 2; }
__device__ __forceinline__ int perm32(int rho) { const int n = rho >> 4, i = rho & 15; return 8 * (i >> 2) + 4 * n + (i & 3); }

struct Unit { int pm, pn, nt, kind, ks; size_t aoff, boff; };
struct Gemm { const char* A; const char* Bt; int lda, ldb; };
struct Order {
    int nMm, nN, n_main, n_tail, ksplit, nt_full, G, c; size_t a_t, b_t, acol;
    __device__ __forceinline__ bool next(int i, Unit& u) const {
        const long L = (long)i * G + c;
        if (L < n_main) {
            const int nwg = n_main;
            int wgid = (int)L; { const int q = nwg / NXCD, r = nwg % NXCD, xcd = wgid % NXCD, off = wgid / NXCD; wgid = (xcd < r ? xcd * (q + 1) : r * (q + 1) + (xcd - r) * q) + off; }
            const int nig = WGM * nN, gid = wgid / nig, fm = gid * WGM, gsz = (nMm - fm) < WGM ? (nMm - fm) : WGM;
            u.pm = fm + ((wgid % nig) % gsz); u.pn = (wgid % nig) / gsz; u.nt = nt_full; u.kind = 0; u.ks = 0;
            u.aoff = (size_t)u.pm * a_t + (size_t)(u.pn >> 1) * acol; u.boff = (size_t)u.pn * b_t; return true;
        }
        const int Lt = (int)(L - n_main); if (Lt >= n_tail) return false;
        const int ks = Lt % ksplit, r = Lt / ksplit;
        u.pm = nMm + (r & 1); u.pn = r >> 1; u.nt = nt_full / ksplit; u.kind = ksplit > 1 ? 1 : 0; u.ks = ks;
        const size_t kofs = (size_t)ks * u.nt * (BK * 2);
        u.aoff = (size_t)u.pm * a_t + (size_t)(u.pn >> 1) * acol + kofs; u.boff = (size_t)u.pn * b_t + kofs; return true;
    }
};

struct EpiScaleBf16 {
    static constexpr bool PERM = true;
    bf16_t* O; int ldc; const float* ss;
    __device__ __forceinline__ void operator()(const f32x4 (&acc)[2][2][4][2], const Unit& u, int wr, int wc, int fr, int fq) const {
        const int row0 = u.pm * BM + wr * 64 + fr, col0 = u.pn * BM + wc * 32 + 8 * fq;
        float ssv[8];
#pragma unroll
        for (int ai = 0; ai < 2; ++ai)
#pragma unroll
            for (int m = 0; m < 4; ++m) ssv[ai * 4 + m] = ss[row0 + ai * HALF + m * 16];
#pragma unroll
        for (int ai = 0; ai < 2; ++ai)
#pragma unroll
            for (int m = 0; m < 4; ++m) {
                const int row = row0 + ai * HALF + m * 16;
                const float rs = rsqrtf(ssv[ai * 4 + m] * (1.0f / 2048.0f) + EPS);
                bf16_t* rowp = O + ((unsigned)row * (unsigned)ldc + (unsigned)col0);
#pragma unroll
                for (int bj = 0; bj < 2; ++bj) {
                    const f32x4 v0 = acc[ai][bj][m][0] * rs, v1 = acc[ai][bj][m][1] * rs;
                    u32x4 w; w.x = pk2(v0[0], v0[1]); w.y = pk2(v0[2], v0[3]); w.z = pk2(v1[0], v1[1]); w.w = pk2(v1[2], v1[3]);
                    *(u32x4*)(rowp + bj * HALF) = w;
                }
            }
    }
};
struct EpiResid {
    static constexpr bool PERM = false;
    float* X; bf16_t* XB; float* ssout; float* part;
    __device__ __forceinline__ void operator()(const f32x4 (&acc)[2][2][4][2], const Unit& u, int wr, int wc, int fr, int fq) const {
        const int row0 = u.pm * BM + wr * 64 + fr, col0 = u.pn * BM + wc * 32 + 4 * fq;
        if (u.kind == 1) {
            float* P = part + (size_t)u.ks * (512 * 2048);
#pragma unroll
            for (int ai = 0; ai < 2; ++ai)
#pragma unroll
                for (int m = 0; m < 4; ++m) {
                    const unsigned off = (unsigned)(row0 - MP + ai * HALF + m * 16) * 2048u + (unsigned)col0;
#pragma unroll
                    for (int bj = 0; bj < 2; ++bj)
#pragma unroll
                        for (int n = 0; n < 2; ++n) *(f32x4*)(P + off + bj * HALF + n * 16) = acc[ai][bj][m][n];
                }
            return;
        }
#pragma unroll
        for (int ai = 0; ai < 2; ++ai)
#pragma unroll
            for (int mp = 0; mp < 4; mp += 2) {
                f32x4 xin[2][2][2];
#pragma unroll
                for (int mm = 0; mm < 2; ++mm)
#pragma unroll
                    for (int bj = 0; bj < 2; ++bj)
#pragma unroll
                        for (int n = 0; n < 2; ++n) xin[mm][bj][n] = *(const f32x4*)(X + ((unsigned)(row0 + ai * HALF + (mp + mm) * 16) * 2048u + (unsigned)col0 + bj * HALF + n * 16));
#pragma unroll
                for (int mm = 0; mm < 2; ++mm) {
                    const int row = row0 + ai * HALF + (mp + mm) * 16;
                    const unsigned off = (unsigned)row * 2048u + (unsigned)col0;
                    float sq = 0.f;
#pragma unroll
                    for (int bj = 0; bj < 2; ++bj)
#pragma unroll
                        for (int n = 0; n < 2; ++n) {
                            const unsigned o = off + bj * HALF + n * 16;
                            const f32x4 x = xin[mm][bj][n] + acc[ai][bj][mp + mm][n];
                            *(f32x4*)(X + o) = x;
                            u32x2 w; w.x = pk2(x[0], x[1]); w.y = pk2(x[2], x[3]);
                            *(u32x2*)(XB + o) = w;
                            sq += (x[0] * x[0] + x[1] * x[1]) + (x[2] * x[2] + x[3] * x[3]);
                        }
                    sq += __shfl_xor(sq, 16); sq += __shfl_xor(sq, 32);
                    if (fq == 0) atomicAdd(ssout + row, sq);
                }
                asm volatile("" ::: "memory");
            }
    }
};
struct EpiLru {
    static constexpr bool PERM = false;
    const float* br; const float* bi; const float* sp; const bf16_t* XR; float* LA; bf16_t* LBv;
    __device__ __forceinline__ void operator()(const f32x4 (&acc)[2][2][4][2], const Unit& u, int wr, int wc, int fr, int fq) const {
        const int row0 = u.pm * BM + wr * 64 + fr;
        const int cbase = (u.pn >> 1) * 256 + (u.pn & 1) * 128 + wc * 32 + 4 * fq;
        f32x4 br4[2], bi4[2], sp4[2];
#pragma unroll
        for (int n = 0; n < 2; ++n) { br4[n] = *(const f32x4*)(br + cbase + n * 16); bi4[n] = *(const f32x4*)(bi + cbase + n * 16); sp4[n] = *(const f32x4*)(sp + cbase + n * 16); }
#pragma unroll
        for (int ai = 0; ai < 2; ++ai)
#pragma unroll
            for (int mp = 0; mp < 4; mp += 2) {
                u32x2 xrr[2][2];
#pragma unroll
                for (int mm = 0; mm < 2; ++mm)
#pragma unroll
                    for (int n = 0; n < 2; ++n) xrr[mm][n] = *(const u32x2*)(XR + ((unsigned)(row0 + ai * HALF + (mp + mm) * 16) * 2048u + (unsigned)(cbase + n * 16)));
#pragma unroll
                for (int mm = 0; mm < 2; ++mm) {
                    const int row = row0 + ai * HALF + (mp + mm) * 16;
                    const bool first = (row < MP) && ((row & 2047) == 0);
#pragma unroll
                    for (int n = 0; n < 2; ++n) {
                        const unsigned o = (unsigned)row * 2048u + (unsigned)(cbase + n * 16);
                        float xr[4]; unpack4(xrr[mm][n], xr);
                        f32x4 av; float bb[4];
#pragma unroll
                        for (int j = 0; j < 4; ++j) {
                            const float r = sigm(acc[ai][0][mp + mm][n][j] + br4[n][j]), gi = sigm(acc[ai][1][mp + mm][n][j] + bi4[n][j]);
                            const float la = -8.0f * r * sp4[n][j];
                            const float a = __expf(la);
                            const float mult = first ? 1.0f : __builtin_amdgcn_sqrtf(fmaxf(1.0f - a * a, 0.f));
                            av[j] = a; bb[j] = mult * gi * xr[j];
                        }
                        *(f32x4*)(LA + o) = av;
                        u32x2 w; w.x = pk2(bb[0], bb[1]); w.y = pk2(bb[2], bb[3]);
                        *(u32x2*)(LBv + o) = w;
                    }
                }
                asm volatile("" ::: "memory");
            }
    }
};

template <class Epi>
__device__ __forceinline__ void gemm_phase(LAS unsigned char* lds, const Gemm g, const Order& S, const Epi& E) {
    int tid = threadIdx.x; asm volatile("" : "+v"(tid));
    const int wid = __builtin_amdgcn_readfirstlane(tid >> 6), lane = tid & 63, wr = wid >> 2, wc = wid & 3, fr = lane & 15, fq = lane >> 4;
    unsigned voffA[2], voffB[2];
#pragma unroll
    for (int i = 0; i < 2; ++i) { int R, C; stage_rc(tid * 16 + i * 8192, R, C); const int Rb = Epi::PERM ? ((R & ~31) + perm32(R & 31)) : R;
        voffA[i] = (unsigned)(R * g.lda + C) * 2u; voffB[i] = (unsigned)(Rb * g.ldb + C) * 2u; }
    const size_t kstep = (size_t)(BK * 2);
    const size_t hstepA = (size_t)HALF * g.lda * 2, hstepB = (size_t)HALF * g.ldb * 2;
    const unsigned ldsw = (unsigned)wid * 1024u;
    const int aoff = lds_byte(wr * 64 + fr, fq * 8), boff = lds_byte(wc * 32 + fr, fq * 8);
#define PG8_SA(b, h) (((b) * 2 + (h)) * HTB)
#define PG8_SB(b, h) ((4 + (b) * 2 + (h)) * HTB)
#define PG8_STAGE(bufoff, gbase, voff) do { _Pragma("unroll") for (int _i = 0; _i < 2; ++_i) \
        __builtin_amdgcn_global_load_lds((const unsigned*)((const char*)(gbase) + (voff)[_i]), (LAS unsigned*)(lds + (bufoff) + ldsw + _i * 8192), 16, 0, 0); } while (0)
#define PG8_LDA(dst, b, h) do { _Pragma("unroll") for (int m = 0; m < 4; ++m) _Pragma("unroll") for (int k = 0; k < 2; ++k) dst[m][k] = *(const LAS bf16x8*)(lds + PG8_SA(b, h) + aoff + m * 2048 + k * 1024); } while (0)
#define PG8_LDB(dst, b, h) do { _Pragma("unroll") for (int n = 0; n < 2; ++n) _Pragma("unroll") for (int k = 0; k < 2; ++k) dst[n][k] = *(const LAS bf16x8*)(lds + PG8_SB(b, h) + boff + n * 2048 + k * 1024); } while (0)
#define PG8_MMA(ai, bj, At, Bt) do { __builtin_amdgcn_s_setprio(1); _Pragma("unroll") for (int m = 0; m < 4; ++m) _Pragma("unroll") for (int n = 0; n < 2; ++n) _Pragma("unroll") for (int k = 0; k < 2; ++k) \
        acc[ai][bj][m][n] = __builtin_amdgcn_mfma_f32_16x16x32_bf16(Bt[n][k], At[m][k], acc[ai][bj][m][n], 0, 0, 0); __builtin_amdgcn_s_setprio(0); } while (0)
#define PG8_WAIT_V(n) asm volatile("s_waitcnt vmcnt(" #n ")" ::: "memory")
#define PG8_WAIT_L(n) asm volatile("s_waitcnt lgkmcnt(" #n ")" ::: "memory")
#define PG8_BAR __builtin_amdgcn_s_barrier()
#define PG8_SCHED __builtin_amdgcn_sched_barrier(0)
    Unit cur, nxt; int ui = 0;
    if (!S.next(0, cur)) return;
    f32x4 acc[2][2][4][2];
#pragma unroll
    for (int a = 0; a < 2; ++a)
#pragma unroll
        for (int b = 0; b < 2; ++b)
#pragma unroll
            for (int m = 0; m < 4; ++m)
#pragma unroll
                for (int n = 0; n < 2; ++n) acc[a][b][m][n] = (f32x4){0.f, 0.f, 0.f, 0.f};
    bf16x8 At[4][2], B0[2][2], B1[2][2];
    const char* cA = g.A + cur.aoff; const char* cB = g.Bt + cur.boff;
    PG8_STAGE(PG8_SB(0, 0), cB, voffB); PG8_STAGE(PG8_SA(0, 0), cA, voffA); PG8_STAGE(PG8_SB(0, 1), cB + hstepB, voffB); PG8_STAGE(PG8_SA(0, 1), cA + hstepA, voffA);
    if (wr == 1) PG8_BAR;
    PG8_WAIT_V(4); PG8_BAR;
    PG8_STAGE(PG8_SB(1, 0), cB + kstep, voffB); PG8_STAGE(PG8_SA(1, 0), cA + kstep, voffA); PG8_STAGE(PG8_SB(1, 1), cB + hstepB + kstep, voffB);
    PG8_WAIT_V(6); PG8_BAR;
    for (;;) {
        const bool has_next = S.next(ui + 1, nxt);
        const char* nA = has_next ? g.A + nxt.aoff : cA; const char* nB = has_next ? g.Bt + nxt.boff : cB;
        const int nt = cur.nt;
        for (int t = 0; t < nt; t += 2) {
            const bool last = (t == nt - 2);
            const char* a1 = cA + (size_t)(t + 1) * kstep;
            const char* a2 = last ? nA : cA + (size_t)(t + 2) * kstep; const char* b2 = last ? nB : cB + (size_t)(t + 2) * kstep;
            const char* a3 = a2 + kstep; const char* b3 = b2 + kstep;
            PG8_LDB(B0, 0, 0); PG8_SCHED; PG8_LDA(At, 0, 0); PG8_STAGE(PG8_SA(1, 1), a1 + hstepA, voffA);
            PG8_WAIT_L(8); PG8_BAR; PG8_WAIT_L(0); PG8_MMA(0, 0, At, B0); PG8_BAR; PG8_SCHED;
            PG8_LDB(B1, 0, 1); PG8_STAGE(PG8_SB(0, 0), b2, voffB);
            PG8_BAR; PG8_WAIT_L(0); PG8_MMA(0, 1, At, B1); PG8_BAR;
            PG8_LDA(At, 0, 1); PG8_STAGE(PG8_SA(0, 0), a2, voffA);
            PG8_BAR; PG8_WAIT_L(0); PG8_MMA(1, 0, At, B0); PG8_BAR; PG8_SCHED;
            PG8_STAGE(PG8_SB(0, 1), b2 + hstepB, voffB);
            PG8_WAIT_V(6); PG8_BAR; PG8_MMA(1, 1, At, B1); PG8_BAR;
            PG8_LDB(B0, 1, 0); PG8_SCHED; PG8_LDA(At, 1, 0); PG8_STAGE(PG8_SA(0, 1), a2 + hstepA, voffA);
            PG8_WAIT_L(8); PG8_BAR; PG8_WAIT_L(0); PG8_MMA(0, 0, At, B0); PG8_BAR; PG8_SCHED;
            PG8_LDB(B1, 1, 1); PG8_STAGE(PG8_SB(1, 0), b3, voffB);
            PG8_BAR; PG8_WAIT_L(0); PG8_MMA(0, 1, At, B1); PG8_BAR;
            PG8_LDA(At, 1, 1); PG8_STAGE(PG8_SA(1, 0), a3, voffA);
            PG8_BAR; PG8_WAIT_L(0); PG8_MMA(1, 0, At, B0); PG8_BAR; PG8_SCHED;
            PG8_STAGE(PG8_SB(1, 1), b3 + hstepB, voffB);
            PG8_WAIT_V(6); PG8_BAR; PG8_MMA(1, 1, At, B1); PG8_BAR;
        }
        if (wr == 0) PG8_BAR;
        E(acc, cur, wr, wc, fr, fq);
        if (!has_next) break;
#pragma unroll
        for (int a = 0; a < 2; ++a)
#pragma unroll
            for (int b = 0; b < 2; ++b)
#pragma unroll
                for (int m = 0; m < 4; ++m)
#pragma unroll
                    for (int n = 0; n < 2; ++n) acc[a][b][m][n] = (f32x4){0.f, 0.f, 0.f, 0.f};
        cur = nxt; cA = nA; cB = nB; ++ui;
        if (wr == 1) PG8_BAR;
    }
    PG8_WAIT_V(0);
    PG8_BAR;
#undef PG8_SA
#undef PG8_SB
#undef PG8_STAGE
#undef PG8_LDA
#undef PG8_LDB
#undef PG8_MMA
#undef PG8_WAIT_V
#undef PG8_WAIT_L
#undef PG8_BAR
#undef PG8_SCHED
}
}

__device__ __forceinline__ void tr_item(const float* __restrict__ W, int ldw, int N, int k0, int n0, const float* __restrict__ scale, bf16_t* __restrict__ dst, int ldd, float* scr, int lane) {
    const int r4 = lane >> 4, c4 = (lane & 15) * 4;
    const bool inb = (n0 + c4) < N;
    f32x4 v[16];
#pragma unroll
    for (int i = 0; i < 16; ++i) v[i] = inb ? __builtin_nontemporal_load((const f32x4*)(W + (size_t)(k0 + 4 * i + r4) * ldw + n0 + c4)) : (f32x4){0.f, 0.f, 0.f, 0.f};
#pragma unroll
    for (int i = 0; i < 16; ++i) { float* d = scr + (4 * i + r4) * 65 + c4; d[0] = v[i][0]; d[1] = v[i][1]; d[2] = v[i][2]; d[3] = v[i][3]; }
    LDS_WAIT();
    const int c = lane & 7;
    f32x4 s0 = (f32x4){1.f, 1.f, 1.f, 1.f}, s1 = s0;
    if (scale) { s0 = *(const f32x4*)(scale + k0 + 8 * c); s1 = *(const f32x4*)(scale + k0 + 8 * c + 4); }
#pragma unroll
    for (int j = 0; j < 8; ++j) { const int n = (lane >> 3) + 8 * j; const float* sp = scr + (8 * c) * 65 + n;
        u32x4 o; o.x = pk2(sp[0 * 65] * s0[0], sp[1 * 65] * s0[1]); o.y = pk2(sp[2 * 65] * s0[2], sp[3 * 65] * s0[3]); o.z = pk2(sp[4 * 65] * s1[0], sp[5 * 65] * s1[1]); o.w = pk2(sp[6 * 65] * s1[2], sp[7 * 65] * s1[3]);
        *(u32x4*)(dst + (size_t)n * ldd + 8 * c) = o; }
    LDS_WAIT();
}

__device__ __forceinline__ void phase_prologue(const Params& p, float* ldsf) {
    int tid = threadIdx.x; asm volatile("" : "+v"(tid));
    const int wave = tid >> 6, lane = tid & 63;
    const int gw = blockIdx.x * 8 + wave, NGW = gridDim.x * 8;
    float* scr = ldsf + wave * 4160;
    unsigned char* ws = p.ws;
    constexpr int I0 = 32 * 177, I1 = 64 * 32, I2 = 32 * 176, I3 = 88 * 32, I4 = 32 * 192, I5 = I1, I6 = I2, I7 = I3, I8 = 128, I9 = 128;
    constexpr int NIT = I0 + I1 + I2 + I3 + I4 + I5 + I6 + I7 + I8 + I9;
    for (int it = gw; it < NIT; it += NGW) {
        int r = it;
        const float* W; int K, N; const float* sc = nullptr; bf16_t* WT;
        if (r < I0) { W = p.in[12 + p.z]; K = 2048; N = 11296; sc = p.in[9 + p.z]; WT = (bf16_t*)(ws + WS_WIN0); }
        else if ((r -= I0) < I1) { W = p.in[19 + p.z]; K = 4096; N = 2048; WT = (bf16_t*)(ws + WS_WOUT0); }
        else if ((r -= I1) < I2) { W = p.in[31 + p.z]; K = 2048; N = 11264; sc = p.in[10 + p.z]; WT = (bf16_t*)(ws + WS_WUP0); }
        else if ((r -= I2) < I3) { W = p.in[34 + p.z]; K = 5632; N = 2048; WT = (bf16_t*)(ws + WS_WDN0); }
        else if ((r -= I3) < I4) { W = p.in[20 + p.z]; K = 2048; N = 12288; sc = p.in[9 + p.z] + 2048; WT = (bf16_t*)(ws + WS_WIN1); }
        else if ((r -= I4) < I5) { W = p.in[30 + p.z]; K = 4096; N = 2048; WT = (bf16_t*)(ws + WS_WOUT1); }
        else if ((r -= I5) < I6) { W = p.in[31 + p.z] + (size_t)2048 * 11264; K = 2048; N = 11264; sc = p.in[10 + p.z] + 2048; WT = (bf16_t*)(ws + WS_WUP1); }
        else if ((r -= I6) < I7) { W = p.in[34 + p.z] + (size_t)5632 * 2048; K = 5632; N = 2048; WT = (bf16_t*)(ws + WS_WDN1); }
        else {
            r -= I7; const int which = r >> 7; r &= 127;
            const int blk = r >> 4, kb = (r >> 2) & 3, nb = r & 3, n0 = 64 * nb, k0 = 64 * kb;
            const float* Wl = (which ? p.in[27 + p.z] : p.in[25 + p.z]) + (size_t)blk * 65536;
            const int drow = (blk * 2 + (n0 >> 7)) * 256 + which * 128 + (n0 & 127);
            tr_item(Wl, 256, 256, k0, n0, nullptr, (bf16_t*)(ws + WS_WLRU) + (size_t)drow * 256 + k0, 256, scr, lane);
            continue;
        }
        const int nblk = (N + 63) / 64, kbl = r & 7, r8 = r >> 3, nb = r8 % nblk, kb = (r8 / nblk) * 8 + kbl, k0 = 64 * kb, n0 = 64 * nb;
        tr_item(W, N, N, k0, n0, sc, WT + (size_t)n0 * K + k0, K, scr, lane);
    }
    {
        u32x4* z = (u32x4*)((bf16_t*)(ws + WS_WIN0) + (size_t)11296 * 2048);
        const int n16 = 224 * 2048 * 2 / 16;
        for (int i = blockIdx.x * 512 + tid; i < n16; i += gridDim.x * 512) z[i] = (u32x4){0u, 0u, 0u, 0u};
    }
    float* X = (float*)(ws + WS_X); bf16_t* XB = (bf16_t*)(ws + WS_XB); float* ss = (float*)(ws + WS_SS);
    for (int row = gw; row < MT; row += NGW) {
        const float* src = row < MP ? p.in[0 + p.z] + (size_t)row * 2048 : p.in[1 + p.z] + (size_t)(row - MP) * 2048;
        float s = 0.f;
#pragma unroll
        for (int j = 0; j < 8; ++j) {
            const f32x4 v = __builtin_nontemporal_load((const f32x4*)(src + (lane + 64 * j) * 4));
            *(f32x4*)(X + (size_t)row * 2048 + (lane + 64 * j) * 4) = v;
            u32x2 w; w.x = pk2(v[0], v[1]); w.y = pk2(v[2], v[3]);
            *(u32x2*)(XB + (size_t)row * 2048 + (lane + 64 * j) * 4) = w;
            s += (v[0] * v[0] + v[1] * v[1]) + (v[2] * v[2] + v[3] * v[3]);
        }
        s = wave_sum(s);
        if (lane == 0) ss[row] = s;
    }
    for (int i = blockIdx.x * 512 + tid; i < 4 * MT; i += gridDim.x * 512) ss[MT + i] = 0.f;
    for (int i = blockIdx.x * 512 + tid; i < 2048; i += gridDim.x * 512) {
        ((float*)(ws + WS_SP))[i] = softplus(-p.in[29 + p.z][i]);
        ((float*)(ws + WS_LB))[i] = sigm(p.in[21 + p.z][2048 + i] - p.in[21 + p.z][i]);
    }
}

__device__ __forceinline__ int next_item(unsigned* ctr, float* ldsf) {
    __syncthreads();
    if (threadIdx.x == 0) ((volatile unsigned*)ldsf)[33284] = atomicAdd(ctr, 1u);
    __syncthreads();
    return (int)((volatile unsigned*)ldsf)[33284];
}

template <int TYPE, int VW>
__device__ __forceinline__ void rec_item(const Params& p, float* ldsf, int sample, int b, int h, int s) {
    constexpr int NV = VW / 16;
    typedef float VT __attribute__((ext_vector_type(NV)));
    int tid = threadIdx.x; asm volatile("" : "+v"(tid));
    const int w = tid >> 6, lane = tid & 63, kg = lane >> 4, vq = lane & 15, kb = 16 * w + 4 * kg;
    const int L = sample ? 4 : 2048, row0 = sample ? MP + 4 * b : 2048 * b, pos0 = sample ? 16384 : 0;
    constexpr int LDP = TYPE < 2 ? LD0 : LD1;
    const bf16_t* proj = (const bf16_t*)(p.ws + WS_PROJ) + (size_t)row0 * LDP;
    bf16_t* yz = (bf16_t*)(p.ws + WS_YZ) + (size_t)row0 * 4096;
    float* part = ldsf + 8192;
    int colA = -1, colB = -1, role = -1, didx = 0;
    float w0 = 0.f, w1 = 0.f, w2 = 0.f, w3 = 0.f, cbias = 0.f, c0 = 0.f, c1 = 0.f, c2 = 0.f, aux = 0.f, aux2 = 0.f;
    if constexpr (TYPE == 0) {
        if (tid < 320) {
            role = tid < 128 ? 0 : (tid < 256 ? 1 : 2);
            didx = tid < 128 ? tid : (tid < 256 ? tid - 128 : tid - 256);
            const int ch = tid < 128 ? 2560 + (h >> 3) * 128 + tid : (tid < 256 ? 2048 + (h >> 3) * 128 + (tid - 128) : h * 64 + (tid - 256));
            colA = 2048 + ch;
            const float* cw = p.in[13 + p.z];
            w0 = cw[ch]; w1 = cw[3072 + ch]; w2 = cw[2 * 3072 + ch]; w3 = cw[3 * 3072 + ch]; cbias = p.in[14 + p.z][ch];
            if (sample) { const float* st = p.in[3 + p.z] + (size_t)b * 3 * 3072; c0 = st[ch]; c1 = st[3072 + ch]; c2 = st[2 * 3072 + ch]; }
        } else if (tid < 328) { role = 3; didx = tid - 320; colA = 5120 + h; aux = p.in[15 + p.z][h]; aux2 = -__expf(p.in[16 + p.z][h]); }
    } else if constexpr (TYPE == 1) {
        if (tid < 128) { role = tid < 64 ? 0 : 1; didx = tid & 63; colA = (tid < 64 ? 5152 : 6176) + h * 128 + didx; colB = colA + 64;
            aux = exp2f(-(float)didx * 0.20762050593046014f); }
        else if (tid < 128 + VW) { role = 2; didx = tid - 128; colA = 7200 + h * 256 + s * VW + didx; }
    } else {
        if (tid < 128) { role = 0; didx = tid; colA = h * 128 + tid; }
        else if (tid < 256) { role = 1; didx = tid - 128; colA = 2048 + h * 128 + didx; aux = ((const float*)(p.ws + WS_LB))[h * 128 + didx]; }
        else if (tid < 256 + VW) { role = 2; didx = tid - 256; colA = 4096 + h * 128 + s * VW + didx; }
    }
    const float Dh = TYPE == 0 ? p.in[17 + p.z][h] : 0.f;
    const float gamma = TYPE == 1 ? 1.0f - exp2f(-5.0f - (float)h * (4.0f / 7.0f)) : 0.f;
    const int ldS = TYPE == 0 ? 64 : (TYPE == 1 ? 256 : 128);
    size_t soff;
    if constexpr (TYPE == 0) soff = ((size_t)(b * 32 + h) * 128) * 64;
    else if constexpr (TYPE == 1) soff = ((size_t)(b * 8 + h) * 128) * 256 + s * VW;
    else soff = ((size_t)(b * 16 + h) * 128) * 128 + s * VW;
    const float* S0 = TYPE == 0 ? p.in[2 + p.z] : (TYPE == 1 ? p.in[4 + p.z] : p.in[5 + p.z]);
    float* Sout = p.out + (TYPE == 0 ? (sample ? O_SSMS : O_SSMP) : (TYPE == 1 ? (sample ? O_RETS : O_RETP) : (sample ? O_HGS : O_HGP))) + soff;
    VT S[4];
#pragma unroll
    for (int i = 0; i < 4; ++i) { if (sample) S[i] = *(const VT*)(S0 + soff + (size_t)(kb + i) * ldS + NV * vq); else S[i] = (VT)(0.f); }
    unsigned short ra[8], rb[8]; unsigned short zr = 0;
    const int R = (L + 7) >> 3;
    auto load_raw = [&](int r) {
#pragma unroll
        for (int t = 0; t < 8; ++t) {
            const int tt = 8 * r + t;
            ra[t] = 0; rb[t] = 0;
            if (tt < L) {
                if (colA >= 0) ra[t] = proj[(size_t)tt * LDP + colA];
                if (TYPE == 1 && colB >= 0) rb[t] = proj[(size_t)tt * LDP + colB];
            }
        }
        if (TYPE == 0) { const int tt = 8 * r + w; if (tt < L) zr = proj[(size_t)tt * LDP + h * 64 + lane]; }
    };
    load_raw(0);
    for (int r = 0; r < R; ++r) {
        const int nv = (L - 8 * r) < 8 ? (L - 8 * r) : 8;
        float* stg = ldsf + (r & 1) * 4096;
        float* qs = stg; float* ks = stg + 1024; float* as = stg + 2048; float* vs = stg + 3072; float* ad = stg + 3584;
        if constexpr (TYPE == 0) {
            if (role >= 0 && role < 3) {
                float* dst = role == 0 ? qs : (role == 1 ? ks : vs); const int dstr = role == 2 ? 64 : 128;
#pragma unroll
                for (int t = 0; t < 8; ++t) {
                    const float x = bf2f(ra[t]);
                    const float y = cbias + w0 * c0 + w1 * c1 + w2 * c2 + w3 * x;
                    c0 = c1; c1 = c2; c2 = x;
                    dst[t * dstr + didx] = silu(y);
                }
            } else if (role == 3) {
                float xv = 0.f;
#pragma unroll
                for (int t = 0; t < 8; ++t) if (t == didx) xv = bf2f(ra[t]);
                const float dt = softplus(xv + aux);
                ad[2 * didx] = __expf(dt * aux2); ad[2 * didx + 1] = dt;
            }
        } else if constexpr (TYPE == 1) {
            if (role == 0 || role == 1) {
                float* dst = role == 0 ? qs : ks; const float sc = role == 0 ? 1.0f : 0.08838834764831845f;
#pragma unroll
                for (int t = 0; t < 8; ++t) {
                    const int pos = pos0 + 8 * r + t;
                    const double rev = (double)pos * (double)aux * 0.15915494309189535;
                    const float fr = (float)(rev - floor(rev));
                    const float sn = __builtin_amdgcn_sinf(fr), cs = __builtin_amdgcn_cosf(fr);
                    const float x1 = bf2f(ra[t]) * sc, x2 = bf2f(rb[t]) * sc;
                    dst[t * 128 + didx] = x1 * cs - x2 * sn;
                    dst[t * 128 + 64 + didx] = x1 * sn + x2 * cs;
                }
            } else if (role == 2) {
#pragma unroll
                for (int t = 0; t < 8; ++t) vs[t * VW + didx] = bf2f(ra[t]);
            }
        } else {
            if (role == 0) {
#pragma unroll
                for (int t = 0; t < 8; ++t) qs[t * 128 + didx] = silu(bf2f(ra[t]));
            } else if (role == 1) {
#pragma unroll
                for (int t = 0; t < 8; ++t) { const float f = aux + (1.0f - aux) * sigm(bf2f(ra[t])); as[t * 128 + didx] = f; ks[t * 128 + didx] = 1.0f - f; }
            } else if (role == 2) {
#pragma unroll
                for (int t = 0; t < 8; ++t) vs[t * VW + didx] = bf2f(ra[t]);
            }
        }
        const unsigned short zc = zr;
        __syncthreads();
        if (r + 1 < R) load_raw(r + 1);
        for (int t0 = 0; t0 < nv; t0 += 4) {
#pragma unroll
            for (int tt = 0; tt < 4; ++tt) {
                const int t = t0 + tt;
                const f32x4 q4 = *(const f32x4*)(qs + t * 128 + kb);
                f32x4 k4 = *(const f32x4*)(ks + t * 128 + kb);
                const VT v4 = *(const VT*)(vs + t * VW + NV * vq);
                f32x4 a4;
                if constexpr (TYPE == 0) { const f32x2 adv = *(const f32x2*)(ad + 2 * t); a4 = (f32x4){adv.x, adv.x, adv.x, adv.x}; k4 = k4 * adv.y; }
                else if constexpr (TYPE == 1) a4 = (f32x4){gamma, gamma, gamma, gamma};
                else a4 = *(const f32x4*)(as + t * 128 + kb);
                VT o = (VT)(0.f);
#pragma unroll
                for (int i = 0; i < 4; ++i) { S[i] = a4[i] * S[i] + k4[i] * v4; o += q4[i] * S[i]; }
                *(VT*)(part + ((t * 32 + w * 4 + kg) * VW + NV * vq)) = o;
            }
        }
        __syncthreads();
        const int rt = tid / VW, rv = tid % VW;
        if (tid < 8 * VW && rt < nv) {
            float o = 0.f;
#pragma unroll
            for (int pp = 0; pp < 32; ++pp) o += part[(rt * 32 + pp) * VW + rv];
            const size_t trow = (size_t)(8 * r + rt);
            if constexpr (TYPE == 0) {
                const float y = (o + Dh * vs[rt * 64 + rv]) * silu(bf2f(zc));
                yz[trow * 4096 + h * 64 + rv] = f2bf(y);
            } else if constexpr (TYPE == 1) {
                yz[trow * 4096 + 2048 + h * 256 + s * VW + rv] = f2bf(o);
            } else {
                yz[trow * 4096 + h * 128 + s * VW + rv] = f2bf(o);
            }
        }
    }
#pragma unroll
    for (int i = 0; i < 4; ++i) *(VT*)(Sout + (size_t)(kb + i) * ldS + NV * vq) = S[i];
}

template <int TYPE>
__device__ __forceinline__ void dec_unit(const Params& p, float* ldsf, int b, int u) {
    int tid = threadIdx.x; asm volatile("" : "+v"(tid));
    const int w = tid >> 6, lane = tid & 63, kg = lane >> 4, vq = lane & 15;
    const int row0 = MP + 4 * b;
    constexpr int LDP = TYPE < 2 ? LD0 : LD1;
    const bf16_t* proj = (const bf16_t*)(p.ws + WS_PROJ) + (size_t)row0 * LDP;
    bf16_t* yz = (bf16_t*)(p.ws + WS_YZ) + (size_t)row0 * 4096;
    int h, sl; size_t soff; int ldS;
    if constexpr (TYPE == 0) { h = 8 * u + w; sl = 0; ldS = 64; soff = ((size_t)(b * 32 + h) * 128) * 64; }
    else if constexpr (TYPE == 1) { h = 2 * u + (w >> 2); sl = w & 3; ldS = 256; soff = ((size_t)(b * 8 + h) * 128) * 256 + sl * 64; }
    else { h = 4 * u + (w >> 1); sl = w & 1; ldS = 128; soff = ((size_t)(b * 16 + h) * 128) * 128 + sl * 64; }
    const float* S0 = (TYPE == 0 ? p.in[2 + p.z] : (TYPE == 1 ? p.in[4 + p.z] : p.in[5 + p.z])) + soff + (size_t)(32 * kg) * ldS + 4 * vq;
    float* Sout = p.out + (TYPE == 0 ? O_SSMS : (TYPE == 1 ? O_RETS : O_HGS)) + soff + (size_t)(32 * kg) * ldS + 4 * vq;
    if constexpr (TYPE == 0) {
        float* qs = ldsf; float* ks = ldsf + 512; float* xs = ldsf + 1024; float* zs = ldsf + 3072; float* ad = ldsf + 5120;
        unsigned short xr[2][4]; float cw[2][4], cb[2], st[2][3]; unsigned short zr[4]; unsigned short dr = 0;
#pragma unroll
        for (int q = 0; q < 2; ++q) {
            const int idx = tid + 512 * q;
            if (idx < 768) {
                const int ch = idx < 128 ? 2560 + u * 128 + idx : (idx < 256 ? 2048 + u * 128 + (idx - 128) : u * 512 + (idx - 256));
#pragma unroll
                for (int t = 0; t < 4; ++t) xr[q][t] = proj[(size_t)t * LDP + 2048 + ch];
#pragma unroll
                for (int j = 0; j < 4; ++j) cw[q][j] = p.in[13 + p.z][j * 3072 + ch];
                cb[q] = p.in[14 + p.z][ch];
#pragma unroll
                for (int j = 0; j < 3; ++j) st[q][j] = p.in[3 + p.z][((size_t)b * 3 + j) * 3072 + ch];
            }
        }
#pragma unroll
        for (int t = 0; t < 4; ++t) zr[t] = proj[(size_t)t * LDP + u * 512 + tid];
        if (tid < 32) dr = proj[(size_t)(tid >> 3) * LDP + 5120 + 8 * u + (tid & 7)];
        f32x4 S[32];
#pragma unroll
        for (int i = 0; i < 32; ++i) S[i] = __builtin_nontemporal_load((const f32x4*)(S0 + (size_t)i * ldS));
#pragma unroll
        for (int q = 0; q < 2; ++q) {
            const int idx = tid + 512 * q;
            if (idx < 768) {
                float* dst = idx < 128 ? qs + idx : (idx < 256 ? ks + (idx - 128) : xs + (idx - 256));
                const int dstr = idx < 256 ? 128 : 512;
                float c0 = st[q][0], c1 = st[q][1], c2 = st[q][2];
#pragma unroll
                for (int t = 0; t < 4; ++t) {
                    const float x = bf2f(xr[q][t]);
                    const float y = cb[q] + cw[q][0] * c0 + cw[q][1] * c1 + cw[q][2] * c2 + cw[q][3] * x;
                    c0 = c1; c1 = c2; c2 = x;
                    dst[t * dstr] = silu(y);
                }
            }
        }
#pragma unroll
        for (int t = 0; t < 4; ++t) zs[t * 512 + tid] = silu(bf2f(zr[t]));
        if (tid < 32) {
            const int hh = 8 * u + (tid & 7);
            const float dt = softplus(bf2f(dr) + p.in[15 + p.z][hh]);
            ad[2 * tid] = __expf(-dt * __expf(p.in[16 + p.z][hh])); ad[2 * tid + 1] = dt;
        }
        __syncthreads();
        const float Dh = p.in[17 + p.z][h];
#pragma unroll 1
        for (int t = 0; t < 4; ++t) {
            const f32x2 adv = *(const f32x2*)(ad + 2 * (t * 8 + w));
            const f32x4 v4 = *(const f32x4*)(xs + t * 512 + w * 64 + 4 * vq);
            f32x4 o = (f32x4){0.f, 0.f, 0.f, 0.f};
#pragma unroll
            for (int i4 = 0; i4 < 8; ++i4) {
                const f32x4 q4 = *(const f32x4*)(qs + t * 128 + 32 * kg + 4 * i4);
                const f32x4 k4 = *(const f32x4*)(ks + t * 128 + 32 * kg + 4 * i4) * adv.y;
#pragma unroll
                for (int ii = 0; ii < 4; ++ii) { S[4 * i4 + ii] = adv.x * S[4 * i4 + ii] + k4[ii] * v4; o += q4[ii] * S[4 * i4 + ii]; }
            }
#pragma unroll
            for (int j = 0; j < 4; ++j) { o[j] += __shfl_xor(o[j], 16); o[j] += __shfl_xor(o[j], 32); }
            if (kg == 0) {
                const f32x4 z4 = *(const f32x4*)(zs + t * 512 + w * 64 + 4 * vq);
                const f32x4 y = (o + Dh * v4) * z4;
                u32x2 ov; ov.x = pk2(y[0], y[1]); ov.y = pk2(y[2], y[3]);
                *(u32x2*)(yz + (size_t)t * 4096 + h * 64 + 4 * vq) = ov;
            }
        }
#pragma unroll
        for (int i = 0; i < 32; ++i) __builtin_nontemporal_store(S[i], (f32x4*)(Sout + (size_t)i * ldS));
    } else if constexpr (TYPE == 1) {
        float* qs = ldsf; float* ks = ldsf + 1024; float* vs = ldsf + 2048;
        unsigned short x1[4], x2[4], vr[4];
        const int hl = tid >> 7, isk = (tid >> 6) & 1, jf = tid & 63;
        if (tid < 256) {
            const int col = (isk ? 6176 : 5152) + (2 * u + hl) * 128 + jf;
#pragma unroll
            for (int t = 0; t < 4; ++t) { x1[t] = proj[(size_t)t * LDP + col]; x2[t] = proj[(size_t)t * LDP + col + 64]; }
        }
#pragma unroll
        for (int t = 0; t < 4; ++t) vr[t] = proj[(size_t)t * LDP + 7200 + (2 * u + (tid >> 8)) * 256 + (tid & 255)];
        f32x4 S[32];
#pragma unroll
        for (int i = 0; i < 32; ++i) S[i] = __builtin_nontemporal_load((const f32x4*)(S0 + (size_t)i * ldS));
        if (tid < 256) {
            const float inv = exp2f(-(float)jf * 0.20762050593046014f);
            float* dst = isk ? ks : qs; const float sc = isk ? 0.08838834764831845f : 1.0f;
#pragma unroll
            for (int t = 0; t < 4; ++t) {
                const double rev = (double)(16384 + t) * (double)inv * 0.15915494309189535;
                const float fr = (float)(rev - floor(rev));
                const float sn = __builtin_amdgcn_sinf(fr), cs = __builtin_amdgcn_cosf(fr);
                const float a1 = bf2f(x1[t]) * sc, a2 = bf2f(x2[t]) * sc;
                dst[(t * 2 + hl) * 128 + jf] = a1 * cs - a2 * sn;
                dst[(t * 2 + hl) * 128 + 64 + jf] = a1 * sn + a2 * cs;
            }
        }
#pragma unroll
        for (int t = 0; t < 4; ++t) vs[(t * 2 + (tid >> 8)) * 256 + (tid & 255)] = bf2f(vr[t]);
        __syncthreads();
        const float gamma = 1.0f - exp2f(-5.0f - (float)h * (4.0f / 7.0f));
        const int hw = w >> 2;
#pragma unroll 1
        for (int t = 0; t < 4; ++t) {
            const f32x4 v4 = *(const f32x4*)(vs + (t * 2 + hw) * 256 + sl * 64 + 4 * vq);
            f32x4 o = (f32x4){0.f, 0.f, 0.f, 0.f};
#pragma unroll
            for (int i4 = 0; i4 < 8; ++i4) {
                const f32x4 q4 = *(const f32x4*)(qs + (t * 2 + hw) * 128 + 32 * kg + 4 * i4);
                const f32x4 k4 = *(const f32x4*)(ks + (t * 2 + hw) * 128 + 32 * kg + 4 * i4);
#pragma unroll
                for (int ii = 0; ii < 4; ++ii) { S[4 * i4 + ii] = gamma * S[4 * i4 + ii] + k4[ii] * v4; o += q4[ii] * S[4 * i4 + ii]; }
            }
#pragma unroll
            for (int j = 0; j < 4; ++j) { o[j] += __shfl_xor(o[j], 16); o[j] += __shfl_xor(o[j], 32); }
            if (kg == 0) {
                u32x2 ov; ov.x = pk2(o[0], o[1]); ov.y = pk2(o[2], o[3]);
                *(u32x2*)(yz + (size_t)t * 4096 + 2048 + h * 256 + sl * 64 + 4 * vq) = ov;
            }
        }
#pragma unroll
        for (int i = 0; i < 32; ++i) __builtin_nontemporal_store(S[i], (f32x4*)(Sout + (size_t)i * ldS));
    } else {
        float* qs = ldsf; float* ks = ldsf + 2048; float* as = ldsf + 4096; float* vs = ldsf + 6144;
        unsigned short qr[4], fr_[4], vr[4];
        const int hl = tid >> 7, kk = tid & 127, col = (4 * u + hl) * 128 + kk;
#pragma unroll
        for (int t = 0; t < 4; ++t) { qr[t] = proj[(size_t)t * LDP + col]; fr_[t] = proj[(size_t)t * LDP + 2048 + col]; vr[t] = proj[(size_t)t * LDP + 4096 + col]; }
        const float lb = ((const float*)(p.ws + WS_LB))[col];
        f32x4 S[32];
#pragma unroll
        for (int i = 0; i < 32; ++i) S[i] = __builtin_nontemporal_load((const f32x4*)(S0 + (size_t)i * ldS));
#pragma unroll
        for (int t = 0; t < 4; ++t) {
            const int o = (t * 4 + hl) * 128 + kk;
            qs[o] = silu(bf2f(qr[t]));
            const float f = lb + (1.0f - lb) * sigm(bf2f(fr_[t]));
            as[o] = f; ks[o] = 1.0f - f; vs[o] = bf2f(vr[t]);
        }
        __syncthreads();
        const int hw = w >> 1;
#pragma unroll 1
        for (int t = 0; t < 4; ++t) {
            const f32x4 v4 = *(const f32x4*)(vs + (t * 4 + hw) * 128 + sl * 64 + 4 * vq);
            f32x4 o = (f32x4){0.f, 0.f, 0.f, 0.f};
#pragma unroll
            for (int i4 = 0; i4 < 8; ++i4) {
                const int off = (t * 4 + hw) * 128 + 32 * kg + 4 * i4;
                const f32x4 q4 = *(const f32x4*)(qs + off), k4 = *(const f32x4*)(ks + off), a4 = *(const f32x4*)(as + off);
#pragma unroll
                for (int ii = 0; ii < 4; ++ii) { S[4 * i4 + ii] = a4[ii] * S[4 * i4 + ii] + k4[ii] * v4; o += q4[ii] * S[4 * i4 + ii]; }
            }
#pragma unroll
            for (int j = 0; j < 4; ++j) { o[j] += __shfl_xor(o[j], 16); o[j] += __shfl_xor(o[j], 32); }
            if (kg == 0) {
                u32x2 ov; ov.x = pk2(o[0], o[1]); ov.y = pk2(o[2], o[3]);
                *(u32x2*)(yz + (size_t)t * 4096 + h * 128 + sl * 64 + 4 * vq) = ov;
            }
        }
#pragma unroll
        for (int i = 0; i < 32; ++i) __builtin_nontemporal_store(S[i], (f32x4*)(Sout + (size_t)i * ldS));
    }
}

#define CK_QS 0
#define CK_KS 17408
#define CK_KT 34816
#define CK_VT 53248
#define CK_PS 62464
#define CK_ST 71680
#define CK_CUM 89088
__device__ __forceinline__ bf16x8 ck_frag(const unsigned char* lds, int base, int pitch, int row, int kb, int q) {
    return *(const bf16x8*)(lds + base + row * pitch + (32 * kb + 8 * q) * 2);
}
template <int TYPE>
__device__ __forceinline__ void chunk_item(const Params& p, unsigned char* lds, int b, int h, int s) {
    int tid = threadIdx.x; asm volatile("" : "+v"(tid));
    const int w = tid >> 6, lane = tid & 63, r = lane & 15, q = lane >> 4;
    constexpr int LDP = TYPE < 2 ? LD0 : LD1;
    const bf16_t* proj = (const bf16_t*)(p.ws + WS_PROJ) + (size_t)(2048 * b) * LDP;
    bf16_t* yz = (bf16_t*)(p.ws + WS_YZ) + (size_t)(2048 * b) * 4096;
    const int I = w >> 1, Vn0 = 2 * (w & 1);
    const int c1 = tid & 127, tq = tid >> 7;
    const int cx = tid & 63, tx = tid >> 6;
    const int g = h >> 3;
    float cwC[4], cwB[4], cwX[4], cbC = 0.f, cbB = 0.f, cbX = 0.f, inv = 0.f, dtb = 0.f, Aneg = 0.f, Dh = 0.f, sstep = 0.f, cstep = 1.f;
    (void)sstep; (void)cstep;
    int colC = 0, colB = 0, colX = 0;
    if constexpr (TYPE == 0) {
        const int chC = 2560 + g * 128 + c1, chB = 2048 + g * 128 + c1, chX = h * 64 + cx;
        colC = 2048 + chC; colB = 2048 + chB; colX = 2048 + chX;
#pragma unroll
        for (int j = 0; j < 4; ++j) { cwC[j] = p.in[13 + p.z][j * 3072 + chC]; cwB[j] = p.in[13 + p.z][j * 3072 + chB]; cwX[j] = p.in[13 + p.z][j * 3072 + chX]; }
        cbC = p.in[14 + p.z][chC]; cbB = p.in[14 + p.z][chB]; cbX = p.in[14 + p.z][chX];
        dtb = p.in[15 + p.z][h]; Aneg = -__expf(p.in[16 + p.z][h]); Dh = p.in[17 + p.z][h];
    } else if constexpr (TYPE == 1) {
        const int isk = c1 >> 6, jf = c1 & 63;
        colC = (isk ? 6176 : 5152) + h * 128 + jf; colB = colC + 64; colX = 7200 + h * 256 + s * 64 + cx;
        inv = exp2f(-(float)jf * 0.20762050593046014f);
        { const float frs = inv * 0.15915494309189535f; sstep = __builtin_amdgcn_sinf(frs); cstep = __builtin_amdgcn_cosf(frs); }
    } else {
        colC = h * 128 + c1; colB = 2048 + h * 128 + c1; colX = 4096 + h * 128 + s * 64 + cx;
        inv = ((const float*)(p.ws + WS_LB))[h * 128 + c1];
    }
    float* cumb = (float*)(lds + CK_CUM);
    if constexpr (TYPE == 1) {
        const float lg = __logf(1.0f - exp2f(-5.0f - (float)h * (4.0f / 7.0f)));
        if (tid < 64) {
#pragma unroll
            for (int bfi = 0; bfi < 2; ++bfi) { float* cb = cumb + bfi * 320; cb[tid] = (tid + 1) * lg; cb[64 + tid] = __expf((tid + 1) * lg); cb[128 + tid] = __expf((63 - tid) * lg); cb[192 + tid] = 1.0f; if (tid == 0) cb[256] = __expf(64.0f * lg); }
        }
    }
    for (int i = tid; i < 17408 / 4; i += 512) ((unsigned*)(lds + CK_ST))[i] = 0u;
    f32x4 Sacc[4];
#pragma unroll
    for (int i = 0; i < 4; ++i) Sacc[i] = (f32x4){0.f, 0.f, 0.f, 0.f};
    unsigned short xc[19], xb[19], xx[11], zr[8], dr = 0;
    auto load_raw = [&](int c) {
        const int t0 = 64 * c;
        if constexpr (TYPE == 0) {
#pragma unroll
            for (int i = 0; i < 19; ++i) { const int t = t0 + 16 * tq - 3 + i; xc[i] = 0; xb[i] = 0; if (t >= 0) { xc[i] = proj[(size_t)t * LDP + colC]; xb[i] = proj[(size_t)t * LDP + colB]; } }
#pragma unroll
            for (int i = 0; i < 11; ++i) { const int t = t0 + 8 * tx - 3 + i; xx[i] = 0; if (t >= 0) xx[i] = proj[(size_t)t * LDP + colX]; }
            if (w == 7) dr = proj[(size_t)(t0 + lane) * LDP + 5120 + h];
#pragma unroll
            for (int vv = 0; vv < 2; ++vv)
#pragma unroll
                for (int jx = 0; jx < 4; ++jx) zr[vv * 4 + jx] = proj[(size_t)(t0 + 16 * I + 4 * q + jx) * LDP + h * 64 + 16 * (Vn0 + vv) + r];
        } else {
#pragma unroll
            for (int i = 0; i < 16; ++i) { const int t = t0 + 16 * tq + i; xc[i] = proj[(size_t)t * LDP + colC]; xb[i] = proj[(size_t)t * LDP + colB]; }
#pragma unroll
            for (int i = 0; i < 8; ++i) xx[i] = proj[(size_t)(t0 + 8 * tx + i) * LDP + colX];
        }
    };
    load_raw(0);
    for (int c = 0; c < 32; ++c) {
        const int t0 = 64 * c;
        float* cum = cumb + (TYPE == 0 ? (c & 1) * 320 : 0);
        float vq_[16], vk_[16], vx_[8], kt_[16], Eval = 0.f;
        (void)kt_; (void)Eval;
        if constexpr (TYPE == 0) {
#pragma unroll
            for (int i = 0; i < 16; ++i) {
                vq_[i] = silu(cbC + cwC[0] * bf2f(xc[i]) + cwC[1] * bf2f(xc[i + 1]) + cwC[2] * bf2f(xc[i + 2]) + cwC[3] * bf2f(xc[i + 3]));
                vk_[i] = silu(cbB + cwB[0] * bf2f(xb[i]) + cwB[1] * bf2f(xb[i + 1]) + cwB[2] * bf2f(xb[i + 2]) + cwB[3] * bf2f(xb[i + 3]));
            }
#pragma unroll
            for (int i = 0; i < 8; ++i) vx_[i] = silu(cbX + cwX[0] * bf2f(xx[i]) + cwX[1] * bf2f(xx[i + 1]) + cwX[2] * bf2f(xx[i + 2]) + cwX[3] * bf2f(xx[i + 3]));
            if (w == 7) {
                const float dt = softplus(bf2f(dr) + dtb);
                float cs = dt * Aneg;
#pragma unroll
                for (int o = 1; o < 64; o <<= 1) { const float t = __shfl_up(cs, o); if (lane >= o) cs += t; }
                const float last = __shfl(cs, 63);
                cum[lane] = cs; cum[64 + lane] = __expf(cs); cum[128 + lane] = __expf(last - cs); cum[192 + lane] = dt;
                if (lane == 0) cum[256] = __expf(last);
            }
        } else if constexpr (TYPE == 2) {
            float pr[16], om[16];
            float run = 1.f;
#pragma unroll
            for (int i = 0; i < 16; ++i) { const float f = inv + (1.0f - inv) * sigm(bf2f(xb[i])); run *= f; pr[i] = run; om[i] = 1.0f - f; }
#pragma unroll
            for (int i = 0; i < 16; ++i) { const float ip = __builtin_amdgcn_rcpf(pr[i]); vq_[i] = silu(bf2f(xc[i])) * pr[i]; vk_[i] = om[i] * ip; kt_[i] = om[i] * ip * run; }
            Eval = run;
#pragma unroll
            for (int i = 0; i < 8; ++i) vx_[i] = bf2f(xx[i]);
        } else {
            {
                const double rev = (double)(t0 + 16 * tq) * (double)inv * 0.15915494309189535;
                const float fr = (float)(rev - floor(rev));
                float sn = __builtin_amdgcn_sinf(fr), cs = __builtin_amdgcn_cosf(fr);
#pragma unroll
                for (int i = 0; i < 16; ++i) {
                    const float a1 = bf2f(xc[i]), a2 = bf2f(xb[i]);
                    vq_[i] = a1 * cs - a2 * sn; vk_[i] = a1 * sn + a2 * cs;
                    const float c2 = cs * cstep - sn * sstep, s2 = sn * cstep + cs * sstep;
                    cs = c2; sn = s2;
                }
            }
#pragma unroll
            for (int i = 0; i < 8; ++i) vx_[i] = bf2f(xx[i]);
        }
        unsigned short zc[8];
#pragma unroll
        for (int i = 0; i < 8; ++i) zc[i] = zr[i];
        __syncthreads();
        if constexpr (TYPE == 0) {
            unsigned kt[8];
#pragma unroll
            for (int i = 0; i < 16; i += 2) {
                const int t = 16 * tq + i;
                const float k0 = vk_[i] * cum[192 + t], k1 = vk_[i + 1] * cum[192 + t + 1];
                *(bf16_t*)(lds + CK_QS + t * 272 + c1 * 2) = f2bf(vq_[i]); *(bf16_t*)(lds + CK_QS + (t + 1) * 272 + c1 * 2) = f2bf(vq_[i + 1]);
                *(bf16_t*)(lds + CK_KS + t * 272 + c1 * 2) = f2bf(k0); *(bf16_t*)(lds + CK_KS + (t + 1) * 272 + c1 * 2) = f2bf(k1);
                kt[i >> 1] = pk2(k0 * cum[128 + t], k1 * cum[128 + t + 1]);
            }
            *(u32x4*)(lds + CK_KT + c1 * 144 + 32 * tq) = (u32x4){kt[0], kt[1], kt[2], kt[3]};
            *(u32x4*)(lds + CK_KT + c1 * 144 + 32 * tq + 16) = (u32x4){kt[4], kt[5], kt[6], kt[7]};
        } else if constexpr (TYPE == 2) {
            unsigned kt[8];
#pragma unroll
            for (int i = 0; i < 16; i += 2) {
                const int t = 16 * tq + i;
                *(bf16_t*)(lds + CK_QS + t * 272 + c1 * 2) = f2bf(vq_[i]); *(bf16_t*)(lds + CK_QS + (t + 1) * 272 + c1 * 2) = f2bf(vq_[i + 1]);
                *(bf16_t*)(lds + CK_KS + t * 272 + c1 * 2) = f2bf(vk_[i]); *(bf16_t*)(lds + CK_KS + (t + 1) * 272 + c1 * 2) = f2bf(vk_[i + 1]);
                kt[i >> 1] = pk2(kt_[i], kt_[i + 1]);
            }
            *(u32x4*)(lds + CK_KT + c1 * 144 + 32 * tq) = (u32x4){kt[0], kt[1], kt[2], kt[3]};
            *(u32x4*)(lds + CK_KT + c1 * 144 + 32 * tq + 16) = (u32x4){kt[4], kt[5], kt[6], kt[7]};
            cum[tq * 128 + c1] = Eval;
        } else {
            const int isk = c1 >> 6, jf = c1 & 63;
            if (isk == 0) {
#pragma unroll
                for (int i = 0; i < 16; ++i) { const int t = 16 * tq + i; *(bf16_t*)(lds + CK_QS + t * 272 + jf * 2) = f2bf(vq_[i]); *(bf16_t*)(lds + CK_QS + t * 272 + (jf + 64) * 2) = f2bf(vk_[i]); }
            } else {
                unsigned kta[8], ktb[8];
#pragma unroll
                for (int i = 0; i < 16; i += 2) {
                    const int t = 16 * tq + i;
                    const float a0 = vq_[i] * 0.08838834764831845f, a1 = vq_[i + 1] * 0.08838834764831845f, b0 = vk_[i] * 0.08838834764831845f, b1 = vk_[i + 1] * 0.08838834764831845f;
                    *(bf16_t*)(lds + CK_KS + t * 272 + jf * 2) = f2bf(a0); *(bf16_t*)(lds + CK_KS + (t + 1) * 272 + jf * 2) = f2bf(a1);
                    *(bf16_t*)(lds + CK_KS + t * 272 + (jf + 64) * 2) = f2bf(b0); *(bf16_t*)(lds + CK_KS + (t + 1) * 272 + (jf + 64) * 2) = f2bf(b1);
                    kta[i >> 1] = pk2(a0 * cum[128 + t], a1 * cum[128 + t + 1]); ktb[i >> 1] = pk2(b0 * cum[128 + t], b1 * cum[128 + t + 1]);
                }
                *(u32x4*)(lds + CK_KT + jf * 144 + 32 * tq) = (u32x4){kta[0], kta[1], kta[2], kta[3]};
                *(u32x4*)(lds + CK_KT + jf * 144 + 32 * tq + 16) = (u32x4){kta[4], kta[5], kta[6], kta[7]};
                *(u32x4*)(lds + CK_KT + (jf + 64) * 144 + 32 * tq) = (u32x4){ktb[0], ktb[1], ktb[2], ktb[3]};
                *(u32x4*)(lds + CK_KT + (jf + 64) * 144 + 32 * tq + 16) = (u32x4){ktb[4], ktb[5], ktb[6], ktb[7]};
            }
        }
        *(u32x4*)(lds + CK_VT + cx * 144 + 16 * tx) = (u32x4){pk2(vx_[0], vx_[1]), pk2(vx_[2], vx_[3]), pk2(vx_[4], vx_[5]), pk2(vx_[6], vx_[7])};
        __syncthreads();
        if (c + 1 < 32) load_raw(c + 1);
        if constexpr (TYPE < 2) {
        bf16x8 aQ[4];
#pragma unroll
        for (int kb = 0; kb < 4; ++kb) aQ[kb] = ck_frag(lds, CK_QS, 272, 16 * I + r, kb, q);
        float cumi[4];
#pragma unroll
        for (int jx = 0; jx < 4; ++jx) cumi[jx] = cum[16 * I + 4 * q + jx];
#pragma unroll
        for (int jj = 0; jj < 2; ++jj) {
            const int J = Vn0 + jj;
            f32x4 acc = (f32x4){0.f, 0.f, 0.f, 0.f};
#pragma unroll
            for (int kb = 0; kb < 4; ++kb) acc = __builtin_amdgcn_mfma_f32_16x16x32_bf16(aQ[kb], ck_frag(lds, CK_KS, 272, 16 * J + r, kb, q), acc, 0, 0, 0);
            const int jcol = 16 * J + r; const float cumj = cum[jcol];
#pragma unroll
            for (int jx = 0; jx < 4; ++jx) {
                const int i = 16 * I + 4 * q + jx;
                const float v = (jcol <= i) ? acc[jx] * __expf(fminf(cumi[jx] - cumj, 0.f)) : 0.f;
                *(bf16_t*)(lds + CK_PS + i * 144 + jcol * 2) = f2bf(v);
            }
        }
        __syncthreads();
#pragma unroll
        for (int vv = 0; vv < 2; ++vv) {
            const int Vn = Vn0 + vv;
            f32x4 aPV = (f32x4){0.f, 0.f, 0.f, 0.f}, aQS = (f32x4){0.f, 0.f, 0.f, 0.f};
#pragma unroll
            for (int jb = 0; jb < 2; ++jb) aPV = __builtin_amdgcn_mfma_f32_16x16x32_bf16(ck_frag(lds, CK_PS, 144, 16 * I + r, jb, q), ck_frag(lds, CK_VT, 144, 16 * Vn + r, jb, q), aPV, 0, 0, 0);
#pragma unroll
            for (int kb = 0; kb < 4; ++kb) aQS = __builtin_amdgcn_mfma_f32_16x16x32_bf16(aQ[kb], ck_frag(lds, CK_ST, 272, 16 * Vn + r, kb, q), aQS, 0, 0, 0);
#pragma unroll
            for (int jx = 0; jx < 4; ++jx) {
                const int i = 16 * I + 4 * q + jx, v = 16 * Vn + r;
                const float o = aPV[jx] + cum[64 + i] * aQS[jx];
                if constexpr (TYPE == 0) {
                    const float xsv = bf2f(*(const bf16_t*)(lds + CK_VT + v * 144 + i * 2));
                    yz[(size_t)(t0 + i) * 4096 + h * 64 + v] = f2bf((o + Dh * xsv) * silu(bf2f(zc[vv * 4 + jx])));
                } else {
                    yz[(size_t)(t0 + i) * 4096 + 2048 + h * 256 + s * 64 + v] = f2bf(o);
                }
            }
        }
        __syncthreads();
        const float elast = cum[256];
#pragma unroll
        for (int Vn = 0; Vn < 4; ++Vn) {
            Sacc[Vn] = Sacc[Vn] * elast;
#pragma unroll
            for (int tb = 0; tb < 2; ++tb) Sacc[Vn] = __builtin_amdgcn_mfma_f32_16x16x32_bf16(ck_frag(lds, CK_KT, 144, 16 * w + r, tb, q), ck_frag(lds, CK_VT, 144, 16 * Vn + r, tb, q), Sacc[Vn], 0, 0, 0);
            *(u32x2*)(lds + CK_ST + (16 * Vn + r) * 272 + (16 * w + 4 * q) * 2) = (u32x2){pk2_sw(Sacc[Vn][0], Sacc[Vn][1]), pk2_sw(Sacc[Vn][2], Sacc[Vn][3])};
        }
            } else {
            const bf16x8 zf = (bf16x8){0, 0, 0, 0, 0, 0, 0, 0};
            if ((w & 1) == 0) {
                f32x4 acc = (f32x4){0.f, 0.f, 0.f, 0.f};
#pragma unroll
                for (int kb = 0; kb < 4; ++kb) acc = __builtin_amdgcn_mfma_f32_16x16x32_bf16(ck_frag(lds, CK_QS, 272, 16 * I + r, kb, q), ck_frag(lds, CK_KS, 272, 16 * I + r, kb, q), acc, 0, 0, 0);
#pragma unroll
                for (int jx = 0; jx < 4; ++jx) {
                    const float v = (r <= 4 * q + jx) ? acc[jx] : 0.f;
                    *(bf16_t*)(lds + CK_PS + (16 * I + 4 * q + jx) * 144 + (16 * I + r) * 2) = f2bf(v);
                }
            }
            __syncthreads();
#pragma unroll
            for (int sc = 0; sc < 4; ++sc) {
                const int stb = sc == 0 ? CK_ST : (sc == 1 ? CK_KS : (sc == 2 ? 91648 : 109056));
                const f32x4 e4 = *(const f32x4*)(cum + sc * 128 + 16 * w + 4 * q);
                const bf16x8 ka = (q < 2) ? *(const bf16x8*)(lds + CK_KT + (16 * w + r) * 144 + (16 * sc + 8 * q) * 2) : zf;
#pragma unroll
                for (int Vn = 0; Vn < 4; ++Vn) {
                    *(u32x2*)(lds + stb + (16 * Vn + r) * 272 + (16 * w + 4 * q) * 2) = (u32x2){pk2_sw(Sacc[Vn][0], Sacc[Vn][1]), pk2_sw(Sacc[Vn][2], Sacc[Vn][3])};
                    const bf16x8 vb = (q < 2) ? *(const bf16x8*)(lds + CK_VT + (16 * Vn + r) * 144 + (16 * sc + 8 * q) * 2) : zf;
                    Sacc[Vn] = __builtin_amdgcn_mfma_f32_16x16x32_bf16(ka, vb, Sacc[Vn] * e4, 0, 0, 0);
                }
            }
            __syncthreads();
            {
                const int sc = I;
                const int stb = sc == 0 ? CK_ST : (sc == 1 ? CK_KS : (sc == 2 ? 91648 : 109056));
                const bf16x8 pa = (q < 2) ? *(const bf16x8*)(lds + CK_PS + (16 * sc + r) * 144 + (16 * sc + 8 * q) * 2) : zf;
                bf16x8 qa[4];
#pragma unroll
                for (int kb = 0; kb < 4; ++kb) qa[kb] = ck_frag(lds, CK_QS, 272, 16 * sc + r, kb, q);
#pragma unroll
                for (int vv = 0; vv < 2; ++vv) {
                    const int Vn = Vn0 + vv;
                    const bf16x8 vb = (q < 2) ? *(const bf16x8*)(lds + CK_VT + (16 * Vn + r) * 144 + (16 * sc + 8 * q) * 2) : zf;
                    f32x4 aO = __builtin_amdgcn_mfma_f32_16x16x32_bf16(pa, vb, (f32x4){0.f, 0.f, 0.f, 0.f}, 0, 0, 0);
#pragma unroll
                    for (int kb = 0; kb < 4; ++kb) aO = __builtin_amdgcn_mfma_f32_16x16x32_bf16(qa[kb], ck_frag(lds, stb, 272, 16 * Vn + r, kb, q), aO, 0, 0, 0);
#pragma unroll
                    for (int jx = 0; jx < 4; ++jx) yz[(size_t)(t0 + 16 * sc + 4 * q + jx) * 4096 + h * 128 + s * 64 + 16 * Vn + r] = (bf16_t)(pk2_sw(aO[jx], 0.f) & 0xffffu);
                }
            }
        }
    }
    const int ldS = TYPE == 0 ? 64 : (TYPE == 1 ? 256 : 128);
    float* Sout = p.out + (TYPE == 0 ? O_SSMP + ((size_t)(b * 32 + h) * 128) * 64 : (TYPE == 1 ? O_RETP + ((size_t)(b * 8 + h) * 128) * 256 + s * 64 : O_HGP + ((size_t)(b * 16 + h) * 128) * 128 + s * 64));
#pragma unroll
    for (int Vn = 0; Vn < 4; ++Vn)
#pragma unroll
        for (int jx = 0; jx < 4; ++jx) Sout[(size_t)(16 * w + 4 * q + jx) * ldS + 16 * Vn + r] = Sacc[Vn][jx];
}

__device__ __forceinline__ void lru_dec_unit(const Params& p, int b) {
    int tid = threadIdx.x; asm volatile("" : "+v"(tid));
    const int c = tid * 4;
    const int row0 = MP + 4 * b;
    const float* LA = (const float*)(p.ws + WS_LA) + (size_t)row0 * 2048 + c;
    const bf16_t* LBv = (const bf16_t*)(p.ws + WS_LBB) + (size_t)row0 * 2048 + c;
    const bf16_t* rg = (const bf16_t*)(p.ws + WS_PROJ) + (size_t)row0 * LD1 + 10240 + c;
    bf16_t* mixa = (bf16_t*)(p.ws + WS_ACT) + (size_t)row0 * 4096 + 2048 + c;
    f32x4 hst = *(const f32x4*)(p.in[6 + p.z] + (size_t)b * 2048 + c);
#pragma unroll
    for (int t = 0; t < 4; ++t) {
        const f32x4 a = *(const f32x4*)(LA + (size_t)t * 2048);
        float bb[4], gg[4]; unpack4(*(const u32x2*)(LBv + (size_t)t * 2048), bb); unpack4(*(const u32x2*)(rg + (size_t)t * LD1), gg);
        float y[4];
#pragma unroll
        for (int j = 0; j < 4; ++j) { hst[j] = a[j] * hst[j] + bb[j]; y[j] = hst[j] * gelu_tanh(gg[j]); }
        u32x2 ov; ov.x = pk2(y[0], y[1]); ov.y = pk2(y[2], y[3]);
        *(u32x2*)(mixa + (size_t)t * 4096) = ov;
    }
    *(f32x4*)(p.out + O_LRUS + (size_t)b * 2048 + c) = hst;
}

__device__ __forceinline__ void lru_scan_item(const Params& p, float* ldsf, int b, int cg) {
    int tid = threadIdx.x; asm volatile("" : "+v"(tid));
    const int w = tid >> 6, lane = tid & 63, c = cg * 64 + lane;
    const size_t row0 = (size_t)2048 * b + 256 * w;
    const float* LA = (const float*)(p.ws + WS_LA) + row0 * 2048 + c;
    const bf16_t* LBv = (const bf16_t*)(p.ws + WS_LBB) + row0 * 2048 + c;
    const bf16_t* rg = (const bf16_t*)(p.ws + WS_PROJ) + row0 * LD1 + 10240 + c;
    bf16_t* mixa = (bf16_t*)(p.ws + WS_ACT) + row0 * 4096 + 2048 + c;
    float hl = 0.f, pr = 1.f;
    for (int tb = 0; tb < 256; tb += 16) {
        float a0[16]; unsigned short b0[16];
#pragma unroll
        for (int t = 0; t < 16; ++t) { a0[t] = LA[(size_t)(tb + t) * 2048]; b0[t] = LBv[(size_t)(tb + t) * 2048]; }
#pragma unroll
        for (int t = 0; t < 16; ++t) { hl = a0[t] * hl + bf2f(b0[t]); pr *= a0[t]; }
    }
    ldsf[w * 128 + lane] = pr; ldsf[w * 128 + 64 + lane] = hl;
    __syncthreads();
    float hst = 0.f;
    for (int ww = 0; ww < w; ++ww) hst = ldsf[ww * 128 + lane] * hst + ldsf[ww * 128 + 64 + lane];
    for (int tb = 0; tb < 256; tb += 16) {
        float a0[16]; unsigned short b0[16], g0[16];
#pragma unroll
        for (int t = 0; t < 16; ++t) { a0[t] = LA[(size_t)(tb + t) * 2048]; b0[t] = LBv[(size_t)(tb + t) * 2048]; g0[t] = rg[(size_t)(tb + t) * LD1]; }
#pragma unroll
        for (int t = 0; t < 16; ++t) {
            hst = a0[t] * hst + bf2f(b0[t]);
            mixa[(size_t)(tb + t) * 4096] = f2bf(hst * gelu_tanh(bf2f(g0[t])));
        }
    }
    if (w == 7) p.out[O_LRUP + (size_t)b * 2048 + c] = hst;
}

__device__ __forceinline__ void phase_rec0(const Params& p, float* ldsf) {
    unsigned* ctr = (unsigned*)(p.ws + WS_CTL);
    const int total = 256 + 512 + 512;
    for (;;) {
        const int it = next_item(ctr, ldsf);
        if (it >= total) break;
        if (it < 128) chunk_item<0>(p, (unsigned char*)ldsf, it >> 5, it & 31, 0);
        else if (it < 256) { const int j = it - 128; chunk_item<1>(p, (unsigned char*)ldsf, j >> 5, (j & 31) >> 2, j & 3); }
        else if (it < 768) { const int j = it - 256; dec_unit<0>(p, ldsf, j >> 2, j & 3); }
        else { const int j = it - 768; dec_unit<1>(p, ldsf, j >> 2, j & 3); }
    }
}
__device__ __forceinline__ void phase_rec1(const Params& p, float* ldsf) {
    unsigned* ctr = (unsigned*)(p.ws + WS_CTL) + 64;
    const int total = 128 + 128 + 512 + 128;
    for (;;) {
        const int it = next_item(ctr, ldsf);
        if (it >= total) break;
        if (it < 128) chunk_item<2>(p, (unsigned char*)ldsf, it >> 5, (it & 31) >> 1, it & 1);
        else if (it < 256) { const int j = it - 128; lru_scan_item(p, ldsf, j >> 5, j & 31); }
        else if (it < 768) { const int j = it - 256; dec_unit<2>(p, ldsf, j >> 2, j & 3); }
        else lru_dec_unit(p, it - 768);
    }
}

__device__ __forceinline__ void seq_of_row(int row, int& sample, int& b, int& t, int& L) {
    if (row < MP) { sample = 0; b = row >> 11; t = row & 2047; L = 2048; } else { sample = 1; b = (row - MP) >> 2; t = (row - MP) & 3; L = 4; }
}

__device__ __forceinline__ void phase_prep0(const Params& p) {
    int tid = threadIdx.x; asm volatile("" : "+v"(tid));
    const int wave = tid >> 6, lane = tid & 63;
    const int gw = blockIdx.x * 8 + wave, NGW = gridDim.x * 8;
    const bf16_t* YZ = (const bf16_t*)(p.ws + WS_YZ); const bf16_t* PR = (const bf16_t*)(p.ws + WS_PROJ);
    bf16_t* MX = (bf16_t*)(p.ws + WS_ACT);
    const float* nw = p.in[18 + p.z];
    u32x4 nya[4]; u32x2 nyb[8], ngb[8];
    auto ldrow = [&](int row) {
#pragma unroll
        for (int g = 0; g < 4; ++g) nya[g] = __builtin_nontemporal_load((const u32x4*)(YZ + (size_t)row * 4096 + g * 512 + lane * 8));
#pragma unroll
        for (int hh = 0; hh < 8; ++hh) { nyb[hh] = __builtin_nontemporal_load((const u32x2*)(YZ + (size_t)row * 4096 + 2048 + hh * 256 + lane * 4)); ngb[hh] = __builtin_nontemporal_load((const u32x2*)(PR + (size_t)row * LD0 + 9248 + hh * 256 + lane * 4)); }
    };
    if (gw < MT) ldrow(gw);
    for (int row = gw; row < MT; row += NGW) {
        bf16_t* mx = MX + (size_t)row * 4096;
        u32x4 ya[4]; u32x2 yb[8], gb[8];
#pragma unroll
        for (int g = 0; g < 4; ++g) ya[g] = nya[g];
#pragma unroll
        for (int hh = 0; hh < 8; ++hh) { yb[hh] = nyb[hh]; gb[hh] = ngb[hh]; }
        if (row + NGW < MT) ldrow(row + NGW);
#pragma unroll
        for (int g = 0; g < 4; ++g) {
            const int c = g * 512 + lane * 8;
            float v[8]; unpack8(ya[g], v);
            float s = 0.f;
#pragma unroll
            for (int j = 0; j < 8; ++j) s += v[j] * v[j];
            s = wave_sum(s);
            const float rs = rsqrtf(s * (1.0f / 512.0f) + EPS);
            const f32x4 n0 = *(const f32x4*)(nw + c), n1 = *(const f32x4*)(nw + c + 4);
            u32x4 o; o.x = pk2(v[0] * rs * n0[0], v[1] * rs * n0[1]); o.y = pk2(v[2] * rs * n0[2], v[3] * rs * n0[3]);
            o.z = pk2(v[4] * rs * n1[0], v[5] * rs * n1[1]); o.w = pk2(v[6] * rs * n1[2], v[7] * rs * n1[3]);
            *(u32x4*)(mx + c) = o;
        }
#pragma unroll
        for (int hh = 0; hh < 8; ++hh) {
            const int c = hh * 256 + lane * 4;
            float v[4]; unpack4(yb[hh], v);
            float gt[4]; unpack4(gb[hh], gt);
            float s = (v[0] * v[0] + v[1] * v[1]) + (v[2] * v[2] + v[3] * v[3]);
            s = wave_sum(s);
            const float rs = rsqrtf(s * (1.0f / 256.0f) + EPS);
            u32x2 o; o.x = pk2(v[0] * rs * silu(gt[0]), v[1] * rs * silu(gt[1])); o.y = pk2(v[2] * rs * silu(gt[2]), v[3] * rs * silu(gt[3]));
            *(u32x2*)(mx + 2048 + c) = o;
        }
        int sample, b, t, L; seq_of_row(row, sample, b, t, L);
        if (t >= L - 3) {
            float* dst = p.out + (sample ? O_SCS : O_SCP) + ((size_t)b * 3 + (t - (L - 3))) * 3072;
            const bf16_t* src = PR + (size_t)row * LD0 + 2048;
#pragma unroll 4
            for (int c = lane; c < 3072; c += 64) dst[c] = bf2f(src[c]);
        }
    }
}

__device__ __forceinline__ void phase_prep1(const Params& p) {
    int tid = threadIdx.x; asm volatile("" : "+v"(tid));
    const int wave = tid >> 6, lane = tid & 63;
    const int gw = blockIdx.x * 8 + wave, NGW = gridDim.x * 8;
    const bf16_t* YZ = (const bf16_t*)(p.ws + WS_YZ); const bf16_t* PR = (const bf16_t*)(p.ws + WS_PROJ);
    bf16_t* MX = (bf16_t*)(p.ws + WS_ACT);
    const float* nw = p.in[22 + p.z];
    u32x4 nya[4], nga[4];
    auto ldrow = [&](int row) {
#pragma unroll
        for (int it = 0; it < 4; ++it) { nya[it] = __builtin_nontemporal_load((const u32x4*)(YZ + (size_t)row * 4096 + it * 512 + lane * 8)); nga[it] = __builtin_nontemporal_load((const u32x4*)(PR + (size_t)row * LD1 + 6144 + it * 512 + lane * 8)); }
    };
    if (gw < MT) ldrow(gw);
    for (int row = gw; row < MT; row += NGW) {
        u32x4 ya[4], ga[4];
#pragma unroll
        for (int it = 0; it < 4; ++it) { ya[it] = nya[it]; ga[it] = nga[it]; }
        if (row + NGW < MT) ldrow(row + NGW);
#pragma unroll
        for (int it = 0; it < 4; ++it) {
            const int c = it * 512 + lane * 8;
            float v[8]; unpack8(ya[it], v);
            float gt[8]; unpack8(ga[it], gt);
            float s = 0.f;
#pragma unroll
            for (int j = 0; j < 8; ++j) s += v[j] * v[j];
            s += __shfl_xor(s, 1); s += __shfl_xor(s, 2); s += __shfl_xor(s, 4); s += __shfl_xor(s, 8);
            const float rs = rsqrtf(s * (1.0f / 128.0f) + EPS);
            const f32x4 n0 = *(const f32x4*)(nw + (c & 127)), n1 = *(const f32x4*)(nw + (c & 127) + 4);
            float o[8];
#pragma unroll
            for (int j = 0; j < 8; ++j) o[j] = v[j] * rs * (j < 4 ? n0[j] : n1[j - 4]) * silu(gt[j]);
            u32x4 ov; ov.x = pk2(o[0], o[1]); ov.y = pk2(o[2], o[3]); ov.z = pk2(o[4], o[5]); ov.w = pk2(o[6], o[7]);
            *(u32x4*)(MX + (size_t)row * 4096 + c) = ov;
        }
    }
}

__device__ __forceinline__ void phase_act(const Params& p, int l) {
    int tid = threadIdx.x; asm volatile("" : "+v"(tid));
    const bf16_t* PR = (const bf16_t*)(p.ws + WS_PROJ); bf16_t* ACT = (bf16_t*)(p.ws + WS_ACT);
    const float* cw = p.in[32 + p.z] + (size_t)l * 3 * DFF; const float* cbv = p.in[33 + p.z] + (size_t)l * DFF;
    const float* st = p.in[8 + p.z] + (size_t)l * 128 * 2 * DFF;
    const int total = (MT / 4) * 704;
    for (int idx = blockIdx.x * 512 + tid; idx < total; idx += gridDim.x * 512) {
        const int rb = idx / 704, c = (idx - rb * 704) * 8, r0 = rb * 4;
        int sample, b, t0, L; seq_of_row(r0, sample, b, t0, L);
        u32x4 gr[6], ur[4];
#pragma unroll
        for (int i = 0; i < 4; ++i) { gr[i + 2] = *(const u32x4*)(PR + (size_t)(r0 + i) * LDU + c); ur[i] = __builtin_nontemporal_load((const u32x4*)(PR + (size_t)(r0 + i) * LDU + DFF + c)); }
        float g[6][8];
        if (t0 >= 2) { gr[0] = *(const u32x4*)(PR + (size_t)(r0 - 2) * LDU + c); gr[1] = *(const u32x4*)(PR + (size_t)(r0 - 1) * LDU + c); unpack8(gr[0], g[0]); unpack8(gr[1], g[1]); }
        else {
#pragma unroll
            for (int j = 0; j < 8; ++j) { g[0][j] = sample ? st[((size_t)b * 2 + 0) * DFF + c + j] : 0.f; g[1][j] = sample ? st[((size_t)b * 2 + 1) * DFF + c + j] : 0.f; }
        }
#pragma unroll
        for (int i = 0; i < 4; ++i) unpack8(gr[i + 2], g[i + 2]);
        float w0[8], w1[8], w2[8], bb[8];
#pragma unroll
        for (int j = 0; j < 8; ++j) { w0[j] = cw[c + j]; w1[j] = cw[DFF + c + j]; w2[j] = cw[2 * DFF + c + j]; bb[j] = cbv[c + j]; }
#pragma unroll
        for (int i = 0; i < 4; ++i) {
            float uu[8], o[8]; unpack8(ur[i], uu);
#pragma unroll
            for (int j = 0; j < 8; ++j) o[j] = silu(bb[j] + w0[j] * g[i][j] + w1[j] * g[i + 1][j] + w2[j] * g[i + 2][j]) * uu[j];
            u32x4 ov; ov.x = pk2(o[0], o[1]); ov.y = pk2(o[2], o[3]); ov.z = pk2(o[4], o[5]); ov.w = pk2(o[6], o[7]);
            *(u32x4*)(ACT + (size_t)(r0 + i) * DFF + c) = ov;
        }
        if (t0 + 4 == L) {
#pragma unroll
            for (int i = 0; i < 2; ++i) {
                float* dst = p.out + (sample ? O_FCS + (((size_t)l * 128 + b) * 2 + i) * DFF : O_FCP + (((size_t)l * 4 + b) * 2 + i) * DFF) + c;
                *(f32x4*)dst = (f32x4){g[4 + i][0], g[4 + i][1], g[4 + i][2], g[4 + i][3]}; *(f32x4*)(dst + 4) = (f32x4){g[4 + i][4], g[4 + i][5], g[4 + i][6], g[4 + i][7]};
            }
        }
    }
}

__device__ __forceinline__ void phase_lruconv(const Params& p) {
    int tid = threadIdx.x; asm volatile("" : "+v"(tid));
    const bf16_t* PR = (const bf16_t*)(p.ws + WS_PROJ); bf16_t* XR = (bf16_t*)(p.ws + WS_XR);
    const float* cw = p.in[23 + p.z]; const float* cbv = p.in[24 + p.z]; const float* st = p.in[7 + p.z];
    const int total = (MT / 4) * 256;
    for (int idx = blockIdx.x * 512 + tid; idx < total; idx += gridDim.x * 512) {
        const int rb = idx >> 8, c = (idx & 255) * 8, r0 = rb * 4;
        int sample, b, t0, L; seq_of_row(r0, sample, b, t0, L);
        float x[7][8];
#pragma unroll
        for (int j = 3; j < 7; ++j) unpack8(*(const u32x4*)(PR + (size_t)(r0 - 3 + j) * LD1 + 8192 + c), x[j]);
        if (t0 >= 3) {
#pragma unroll
            for (int j = 0; j < 3; ++j) unpack8(*(const u32x4*)(PR + (size_t)(r0 - 3 + j) * LD1 + 8192 + c), x[j]);
        } else {
#pragma unroll
            for (int j = 0; j < 3; ++j)
#pragma unroll
                for (int i = 0; i < 8; ++i) x[j][i] = sample ? st[((size_t)b * 3 + j) * 2048 + c + i] : 0.f;
        }
        float w0[8], w1[8], w2[8], w3[8], bb[8];
#pragma unroll
        for (int i = 0; i < 8; ++i) { w0[i] = cw[c + i]; w1[i] = cw[2048 + c + i]; w2[i] = cw[4096 + c + i]; w3[i] = cw[6144 + c + i]; bb[i] = cbv[c + i]; }
#pragma unroll
        for (int rr = 0; rr < 4; ++rr) {
            float o[8];
#pragma unroll
            for (int i = 0; i < 8; ++i) o[i] = bb[i] + w0[i] * x[rr][i] + w1[i] * x[rr + 1][i] + w2[i] * x[rr + 2][i] + w3[i] * x[rr + 3][i];
            u32x4 ov; ov.x = pk2(o[0], o[1]); ov.y = pk2(o[2], o[3]); ov.z = pk2(o[4], o[5]); ov.w = pk2(o[6], o[7]);
            *(u32x4*)(XR + (size_t)(r0 + rr) * 2048 + c) = ov;
        }
        if (t0 + 4 == L) {
#pragma unroll
            for (int j = 0; j < 3; ++j) {
                float* dst = p.out + (sample ? O_LCS : O_LCP) + ((size_t)b * 3 + j) * 2048 + c;
                *(f32x4*)dst = (f32x4){x[4 + j][0], x[4 + j][1], x[4 + j][2], x[4 + j][3]}; *(f32x4*)(dst + 4) = (f32x4){x[4 + j][4], x[4 + j][5], x[4 + j][6], x[4 + j][7]};
            }
        }
    }
}

template <int NS>
__device__ __forceinline__ void finalize_sample_rows(const Params& p, float* ssdst) {
    int tid = threadIdx.x; asm volatile("" : "+v"(tid));
    float* X = (float*)(p.ws + WS_X); bf16_t* XB = (bf16_t*)(p.ws + WS_XB); const float* PT = (const float*)(p.ws + WS_PROJ);
    for (int item = blockIdx.x * 512 + tid; item < 512 * 512; item += gridDim.x * 512) {
        const int row = item >> 9, c4 = item & 511;
        const unsigned o = (unsigned)(MP + row) * 2048u + (unsigned)c4 * 4u, po = (unsigned)row * 2048u + (unsigned)c4 * 4u;
        f32x4 v = *(const f32x4*)(X + o);
        f32x4 pv[NS];
#pragma unroll
        for (int ks = 0; ks < NS; ++ks) pv[ks] = __builtin_nontemporal_load((const f32x4*)(PT + (size_t)ks * (512 * 2048) + po));
#pragma unroll
        for (int ks = 0; ks < NS; ++ks) v += pv[ks];
        *(f32x4*)(X + o) = v;
        u32x2 w; w.x = pk2(v[0], v[1]); w.y = pk2(v[2], v[3]);
        *(u32x2*)(XB + o) = w;
        float s2 = (v[0] * v[0] + v[1] * v[1]) + (v[2] * v[2] + v[3] * v[3]);
        s2 = wave_sum(s2);
        if ((tid & 63) == 0) atomicAdd(ssdst + MP + row, s2);
    }
}

__device__ __forceinline__ void phase_final(const Params& p) {
    int tid = threadIdx.x; asm volatile("" : "+v"(tid));
    const int wave = tid >> 6, lane = tid & 63;
    const int gw = blockIdx.x * 8 + wave, NGW = gridDim.x * 8;
    const float* X = (const float*)(p.ws + WS_X); const float* nf = p.in[11 + p.z];
    f32x4 nv[8];
    auto ldrow = [&](int row) {
#pragma unroll
        for (int j = 0; j < 8; ++j) nv[j] = __builtin_nontemporal_load((const f32x4*)(X + (size_t)row * 2048 + (lane + 64 * j) * 4));
    };
    if (gw < MT) ldrow(gw);
    for (int row = gw; row < MT; row += NGW) {
        f32x4 v[8]; float sq = 0.f;
#pragma unroll
        for (int j = 0; j < 8; ++j) v[j] = nv[j];
        if (row + NGW < MT) ldrow(row + NGW);
        if (row >= MP) {
#pragma unroll
            for (int j = 0; j < 8; ++j) {
                f32x4 pv[11];
#pragma unroll
                for (int ks = 0; ks < 11; ++ks) pv[ks] = *(const f32x4*)((const float*)(p.ws + WS_PROJ) + (size_t)ks * (512 * 2048) + (size_t)(row - MP) * 2048 + (lane + 64 * j) * 4);
#pragma unroll
                for (int ks = 0; ks < 11; ++ks) v[j] += pv[ks];
            }
        }
#pragma unroll
        for (int j = 0; j < 8; ++j) sq += (v[j][0] * v[j][0] + v[j][1] * v[j][1]) + (v[j][2] * v[j][2] + v[j][3] * v[j][3]);
        sq = wave_sum(sq);
        const float rs = rsqrtf(sq * (1.0f / 2048.0f) + EPS);
        float* dst = p.out + (row < MP ? O_YP + (size_t)row * 2048 : O_YS + (size_t)(row - MP) * 2048);
#pragma unroll
        for (int j = 0; j < 8; ++j) {
            const int c = (lane + 64 * j) * 4;
            __builtin_nontemporal_store(v[j] * rs * *(const f32x4*)(nf + c), (f32x4*)(dst + c));
        }
    }
}

#define XB_TMO      128
#define XB_XCNT(j)  (256  + 64 * (j))
#define XB_XSUB(j)  (1280 + 64 * (j))
#define XB_XGEN(j)  (2304 + 64 * (j))
#define XB_TOP      3328
#define XB_TOPGEN   3392
#define XCD_BAR_WORDS 3456
#define XB_SPIN_CAP (1u << 22)
__device__ __forceinline__ unsigned xb_ld(unsigned* p)              { return __hip_atomic_load(p, __ATOMIC_RELAXED, __HIP_MEMORY_SCOPE_AGENT); }
__device__ __forceinline__ unsigned xb_add(unsigned* p, unsigned v) { return __hip_atomic_fetch_add(p, v, __ATOMIC_RELAXED, __HIP_MEMORY_SCOPE_AGENT); }
__device__ __forceinline__ unsigned xb_xcc_id() { return (unsigned)__builtin_amdgcn_s_getreg((3 << 11) | 20) & 0xFu; }
#define XB_SPIN(cond, bar) do { unsigned _sp = 0; while (cond) { __builtin_amdgcn_s_sleep(1); \
    if ((++_sp & 255u) == 0u) { if (xb_ld(&(bar)[XB_TMO])) break; if (_sp > XB_SPIN_CAP) { atomicAdd(&(bar)[XB_TMO], 1u); break; } } } } while (0)
struct XcdBarrier { unsigned* bar; unsigned x; volatile LAS unsigned* st; };
__device__ __forceinline__ XcdBarrier xcd_barrier_post(unsigned* bar, volatile LAS unsigned* st) {
    XcdBarrier b; b.bar = bar; b.x = xb_xcc_id(); b.st = st;
    if (threadIdx.x == 0) (void)xb_add(&bar[XB_XCNT(b.x)], 1u);
    return b;
}
__device__ __forceinline__ void xcd_barrier_complete(unsigned* bar, unsigned x, unsigned& nloc, unsigned& nx) {
    const unsigned G = gridDim.x * gridDim.y * gridDim.z;
    unsigned sum, cnt, mine, sp = 0u;
    for (;;) {
        sum = 0u; cnt = 0u; mine = 0u;
#pragma unroll
        for (unsigned j = 0; j < 16; ++j) { const unsigned c = xb_ld(&bar[XB_XCNT(j)]); sum += c; cnt += (c > 0u) ? 1u : 0u; mine = (j == x) ? c : mine; }
        if (sum == G) break;
        __builtin_amdgcn_s_sleep(1);
        if ((++sp & 255u) == 0u) { if (xb_ld(&bar[XB_TMO])) break; if (sp > XB_SPIN_CAP) { atomicAdd(&bar[XB_TMO], 1u); break; } }
    }
    nloc = mine > 0u ? mine : 1u; nx = cnt > 0u ? cnt : 1u;
}
__device__ __forceinline__ void xcd_barrier(const XcdBarrier& b) {
    asm volatile("s_waitcnt vmcnt(0)" ::: "memory");
    __syncthreads();
    if (threadIdx.x == 0) {
        unsigned* bar = b.bar;
        __builtin_amdgcn_s_waitcnt(0);
        unsigned nloc = b.st[0], nx = b.st[1];
        if (nloc == 0u) { xcd_barrier_complete(bar, b.x, nloc, nx); b.st[0] = nloc; b.st[1] = nx; }
        const unsigned old = xb_add(&bar[XB_XSUB(b.x)], 1u);
        const unsigned gen = old / nloc;
        if (old + 1u == (gen + 1u) * nloc) {
            __builtin_amdgcn_fence(__ATOMIC_RELEASE, "agent");
            asm volatile("s_waitcnt vmcnt(0)" ::: "memory");
            const unsigned og = xb_add(&bar[XB_TOP], 1u);
            const unsigned tg = og / nx;
            if (og + 1u == (tg + 1u) * nx) xb_add(&bar[XB_TOPGEN], 1u);
            else XB_SPIN(xb_ld(&bar[XB_TOPGEN]) == tg, bar);
            __builtin_amdgcn_fence(__ATOMIC_ACQUIRE, "agent");
            xb_add(&bar[XB_XGEN(b.x)], 1u);
            asm volatile("s_waitcnt vmcnt(0)" ::: "memory");
        } else {
            XB_SPIN(xb_ld(&bar[XB_XGEN(b.x)]) == gen, bar);
            __builtin_amdgcn_fence(__ATOMIC_ACQUIRE, "agent");
            asm volatile("s_waitcnt vmcnt(0)" ::: "memory");
        }
    }
    __syncthreads();
}

#ifndef PROBE_MASK
#define PROBE_MASK 0u
#endif
#ifndef PHMASK
#define PHMASK 0xFFFFFFFFu
#endif
#define EN(i) (((PHMASK) >> (i)) & 1u)
__global__ void __launch_bounds__(512, 2) fwd_megakernel(Params p) {
    extern __shared__ __attribute__((aligned(16))) unsigned char shm[];
    float* ldsf = (float*)shm;
    LAS unsigned char* ldsg = (LAS unsigned char*)shm;
    unsigned char* ws = p.ws;
    float* ssb = (float*)(ws + WS_SS);
    volatile LAS unsigned* xst = (volatile LAS unsigned*)(ldsg + 133120);
    if (threadIdx.x == 0) { xst[0] = 0u; xst[1] = 0u; }
    __syncthreads();
    (void)xcd_barrier_post((unsigned*)(ws + WS_CTL) + 256, xst);
#define XBAR() do { XcdBarrier _b; _b.bar = (unsigned*)(p.ws + WS_CTL) + 256; _b.x = xb_xcc_id(); _b.st = (volatile LAS unsigned*)((LAS unsigned char*)shm + 133120); xcd_barrier(_b); } while (0)
#if PROBE_MASK
    unsigned long long tph = __builtin_amdgcn_s_memrealtime();
#endif
    for (int ph = p.ph_lo; ph < p.ph_hi; ++ph) {
        if (ph > p.ph_lo) {
            if (ph == 1) cg::this_grid().sync();
            else XBAR();
#if PROBE_MASK
            {
                const unsigned long long t1 = __builtin_amdgcn_s_memrealtime();
                if ((PROBE_MASK >> (ph - 1)) & 1u) { const unsigned long long dt = t1 - tph; while (__builtin_amdgcn_s_memrealtime() - t1 < dt) __builtin_amdgcn_s_sleep(8); }
                tph = __builtin_amdgcn_s_memrealtime();
            }
#endif
        }
        if (EN(0) && ph == 0) phase_prologue(p, ldsf);
        else if (EN(1) && (ph == 1 || ph == 5 || ph == 8 || ph == 14)) {
            pg8::Gemm g; pg8::EpiScaleBf16 E; int N;
            if (ph != 1) { float* sd = ssb + (ph == 5 ? 1 : (ph == 8 ? 2 : 3)) * MT; if (ph == 8) finalize_sample_rows<11>(p, sd); else finalize_sample_rows<16>(p, sd); XBAR(); }
            g.A = (const char*)(ws + WS_XB); g.lda = 2048; g.ldb = 2048;
            if (ph == 1) { g.Bt = (const char*)(ws + WS_WIN0); N = LD0; E.ss = ssb; }
            else if (ph == 5) { g.Bt = (const char*)(ws + WS_WUP0); N = LDU; E.ss = ssb + MT; }
            else if (ph == 8) { g.Bt = (const char*)(ws + WS_WIN1); N = LD1; E.ss = ssb + 2 * MT; }
            else { g.Bt = (const char*)(ws + WS_WUP1); N = LDU; E.ss = ssb + 3 * MT; }
            E.O = (bf16_t*)(ws + WS_PROJ); E.ldc = N;
            pg8::Order S; S.nMm = 32; S.nN = N / 256; S.n_main = 32 * S.nN; S.n_tail = 2 * S.nN; S.ksplit = 1; S.nt_full = 32; S.G = gridDim.x; S.c = blockIdx.x;
            S.a_t = (size_t)256 * 2048 * 2; S.b_t = (size_t)256 * 2048 * 2; S.acol = 0;
            pg8::gemm_phase<pg8::EpiScaleBf16>(ldsg, g, S, E);
        }
        else if (EN(4) && (ph == 4 || ph == 7 || ph == 13 || ph == 16)) {
            pg8::Gemm g; pg8::EpiResid E;
            g.A = (const char*)(ws + WS_ACT);
            if (ph == 4) { g.Bt = (const char*)(ws + WS_WOUT0); g.lda = 4096; E.ssout = ssb + MT; }
            else if (ph == 7) { g.Bt = (const char*)(ws + WS_WDN0); g.lda = DFF; E.ssout = ssb + 2 * MT; }
            else if (ph == 13) { g.Bt = (const char*)(ws + WS_WOUT1); g.lda = 4096; E.ssout = ssb + 3 * MT; }
            else { g.Bt = (const char*)(ws + WS_WDN1); g.lda = DFF; E.ssout = ssb + 4 * MT; }
            g.ldb = g.lda;
            E.X = (float*)(ws + WS_X); E.XB = (bf16_t*)(ws + WS_XB); E.part = (float*)(ws + WS_PROJ);
            pg8::Order S; S.nMm = 32; S.nN = 8; S.n_main = 256; S.nt_full = g.lda / 64; S.ksplit = (g.lda == 4096) ? 16 : 11; S.n_tail = 16 * S.ksplit; S.G = gridDim.x; S.c = blockIdx.x;
            S.a_t = (size_t)256 * g.lda * 2; S.b_t = (size_t)256 * g.ldb * 2; S.acol = 0;
            pg8::gemm_phase<pg8::EpiResid>(ldsg, g, S, E);
        }
        else if (EN(10) && ph == 10) {
            pg8::Gemm g; pg8::EpiLru E;
            g.A = (const char*)(ws + WS_XR); g.Bt = (const char*)(ws + WS_WLRU); g.lda = 2048; g.ldb = 256;
            E.br = p.in[26 + p.z]; E.bi = p.in[28 + p.z]; E.sp = (const float*)(ws + WS_SP); E.XR = (const bf16_t*)(ws + WS_XR);
            E.LA = (float*)(ws + WS_LA); E.LBv = (bf16_t*)(ws + WS_LBB);
            pg8::Order S; S.nMm = 34; S.nN = 16; S.n_main = 34 * 16; S.n_tail = 0; S.ksplit = 1; S.nt_full = 4 + p.z; S.G = gridDim.x; S.c = blockIdx.x;
            S.a_t = (size_t)256 * 2048 * 2; S.b_t = (size_t)256 * 256 * 2; S.acol = 512;
            pg8::gemm_phase<pg8::EpiLru>(ldsg, g, S, E);
        }
        else if (EN(2) && ph == 2) phase_rec0(p, ldsf);
        else if (EN(3) && ph == 3) phase_prep0(p);
        else if (EN(6) && ph == 6) phase_act(p, 0);
        else if (EN(9) && ph == 9) phase_lruconv(p);
        else if (EN(11) && ph == 11) phase_rec1(p, ldsf);
        else if (EN(12) && ph == 12) phase_prep1(p);
        else if (EN(15) && ph == 15) phase_act(p, 1);
        else if (EN(17) && ph == 17) phase_final(p);
    }
}

#ifndef N_LAUNCH_MODE
#define N_LAUNCH_MODE 0
#endif

extern "C" void kernel_launch(void* const* d_in, const int* in_sizes, int n_in, void* d_out, int out_size, void* d_ws, size_t ws_size, hipStream_t stream) {
    static int grid = 0;
    if (grid == 0) {
        if (n_in != 35 || (size_t)out_size != O_END || ws_size < WS_END) { fprintf(stderr, "kernel_launch: unexpected shapes: n_in %d out %d ws %zu (need %zu)\n", n_in, out_size, ws_size, (size_t)WS_END); grid = -1; return; }
        int dev = 0, cus = 0, per_cu = 0;
        hipGetDevice(&dev);
        hipDeviceGetAttribute(&cus, hipDeviceAttributeMultiprocessorCount, dev);
        if (hipFuncSetAttribute((const void*)fwd_megakernel, hipFuncAttributeMaxDynamicSharedMemorySize, LDS_BYTES) != hipSuccess) { fprintf(stderr, "kernel_launch: hipFuncSetAttribute failed\n"); grid = -1; return; }
        if (hipOccupancyMaxActiveBlocksPerMultiprocessor(&per_cu, (const void*)fwd_megakernel, 512, LDS_BYTES) != hipSuccess || per_cu < 1) { fprintf(stderr, "kernel_launch: occupancy query says %d\n", per_cu); per_cu = 1; }
        (void)hipGetLastError();
        grid = cus;
    }
    if (grid < 0) return;
    (void)hipMemsetAsync((char*)d_ws + WS_CTL, 0, 16384, stream);
    Params p{};
    for (int i = 0; i < 35; ++i) p.in[i] = (const float*)d_in[i];
    p.z = 0; p.pad = 0;
    p.out = (float*)d_out; p.ws = (unsigned char*)d_ws;
#if N_LAUNCH_MODE == 0
    p.ph_lo = 0; p.ph_hi = NPHASE;
    void* args[] = {&p};
    hipError_t e = hipLaunchCooperativeKernel((const void*)fwd_megakernel, dim3(grid), dim3(512), args, LDS_BYTES, stream);
    if (e != hipSuccess) fprintf(stderr, "cooperative launch failed: %s (grid %d)\n", hipGetErrorString(e), grid);
#else
    for (int ph = 0; ph < NPHASE; ++ph) {
        p.ph_lo = ph; p.ph_hi = ph + 1;
        hipLaunchKernelGGL(fwd_megakernel, dim3(grid), dim3(512), LDS_BYTES, stream, p);
    }
#endif
}
```

```cpp
#include <hip/hip_runtime.h>
#include <hip/hip_cooperative_groups.h>
#include <cstdio>
#include <cstdint>
namespace cg = cooperative_groups;

#define LAS __attribute__((address_space(3)))
typedef unsigned short bf16_t;
typedef short bf16x8 __attribute__((ext_vector_type(8)));
typedef float f32x4 __attribute__((ext_vector_type(4)));
typedef float f32x2 __attribute__((ext_vector_type(2)));
typedef unsigned u32x4 __attribute__((ext_vector_type(4)));
typedef unsigned u32x2 __attribute__((ext_vector_type(2)));

constexpr int D = 2048, MP = 8192, MS = 512, MT = 8704;
constexpr int LD0 = 11520, LD1 = 12288, LDU = 11264, DFF = 5632;
constexpr float EPS = 1e-6f;
constexpr size_t O_YP = 0;
constexpr size_t O_YS = O_YP + (size_t)4 * 2048 * 2048;
constexpr size_t O_SSMP = O_YS + (size_t)128 * 4 * 2048;
constexpr size_t O_SSMS = O_SSMP + (size_t)4 * 32 * 128 * 64;
constexpr size_t O_SCP = O_SSMS + (size_t)128 * 32 * 128 * 64;
constexpr size_t O_SCS = O_SCP + (size_t)4 * 3 * 3072;
constexpr size_t O_RETP = O_SCS + (size_t)128 * 3 * 3072;
constexpr size_t O_RETS = O_RETP + (size_t)4 * 8 * 128 * 256;
constexpr size_t O_HGP = O_RETS + (size_t)128 * 8 * 128 * 256;
constexpr size_t O_HGS = O_HGP + (size_t)4 * 16 * 128 * 128;
constexpr size_t O_LRUP = O_HGS + (size_t)128 * 16 * 128 * 128;
constexpr size_t O_LRUS = O_LRUP + (size_t)4 * 2048;
constexpr size_t O_LCP = O_LRUS + (size_t)128 * 2048;
constexpr size_t O_LCS = O_LCP + (size_t)4 * 3 * 2048;
constexpr size_t O_FCP = O_LCS + (size_t)128 * 3 * 2048;
constexpr size_t O_FCS = O_FCP + (size_t)2 * 4 * 2 * 5632;
constexpr size_t O_END = O_FCS + (size_t)2 * 128 * 2 * 5632;
constexpr size_t al256(size_t x) { return (x + 255) & ~(size_t)255; }
constexpr size_t WS_CTL = 0;
constexpr size_t WS_SS = 16384;
constexpr size_t WS_SP = al256(WS_SS + (size_t)5 * MT * 4);
constexpr size_t WS_LB = WS_SP + 8192;
constexpr size_t WS_WIN0 = WS_LB + 8192;
constexpr size_t WS_WOUT0 = WS_WIN0 + (size_t)LD0 * 2048 * 2;
constexpr size_t WS_WUP0 = WS_WOUT0 + (size_t)2048 * 4096 * 2;
constexpr size_t WS_WDN0 = WS_WUP0 + (size_t)LDU * 2048 * 2;
constexpr size_t WS_WIN1 = WS_WDN0 + (size_t)2048 * DFF * 2;
constexpr size_t WS_WOUT1 = WS_WIN1 + (size_t)LD1 * 2048 * 2;
constexpr size_t WS_WUP1 = WS_WOUT1 + (size_t)2048 * 4096 * 2;
constexpr size_t WS_WDN1 = WS_WUP1 + (size_t)LDU * 2048 * 2;
constexpr size_t WS_WLRU = WS_WDN1 + (size_t)2048 * DFF * 2;
constexpr size_t WS_X = WS_WLRU + (size_t)16 * 256 * 256 * 2;
constexpr size_t WS_XB = WS_X + (size_t)MT * 2048 * 4;
constexpr size_t WS_PROJ = WS_XB + (size_t)MT * 2048 * 2;
constexpr size_t WS_ACT = WS_PROJ + (size_t)MT * LD1 * 2;
constexpr size_t WS_YZ = WS_ACT + (size_t)MT * DFF * 2;
constexpr size_t WS_LA = WS_YZ + (size_t)MT * 4096 * 2;
constexpr size_t WS_LBB = WS_LA + (size_t)MT * 2048 * 4;
constexpr size_t WS_XR = WS_LBB + (size_t)MT * 2048 * 2;
constexpr size_t WS_END = WS_XR + (size_t)MT * 2048 * 2;

constexpr int LDS_BYTES = 133120 + 256;
constexpr int NPHASE = 18;

struct Params {
    const float* in[35];
    float* out;
    unsigned char* ws;
    int ph_lo, ph_hi;
    int z, pad;
};

__device__ __forceinline__ float bf2f(unsigned v) { return __uint_as_float(v << 16); }
__device__ __forceinline__ unsigned pk2(float lo, float hi) { unsigned r; asm volatile("v_cvt_pk_bf16_f32 %0, %1, %2" : "=v"(r) : "v"(lo), "v"(hi)); return r; }
__device__ __forceinline__ unsigned pk2_sw(float lo, float hi) {
    unsigned a = __float_as_uint(lo), b = __float_as_uint(hi); a += 0x7fffu + ((a >> 16) & 1u); b += 0x7fffu + ((b >> 16) & 1u); return (a >> 16) | (b & 0xffff0000u); }
__device__ __forceinline__ bf16_t f2bf(float x) { return (bf16_t)(pk2(x, 0.f) & 0xffffu); }
__device__ __forceinline__ float sigm(float x) { return __builtin_amdgcn_rcpf(1.f + __expf(-x)); }
__device__ __forceinline__ float silu(float x) { return x * __builtin_amdgcn_rcpf(1.f + __expf(-x)); }
__device__ __forceinline__ float softplus(float x) { return fmaxf(x, 0.f) + log1pf(__expf(-fabsf(x))); }
__device__ __forceinline__ float gelu_tanh(float x) { const float u = 0.7978845608f * (x + 0.044715f * x * x * x); const float t = 1.f - 2.f * __builtin_amdgcn_rcpf(1.f + __expf(2.f * u)); return 0.5f * x * (1.f + t); }
__device__ __forceinline__ float wave_sum(float v) {
#pragma unroll
    for (int o = 1; o < 64; o <<= 1) v += __shfl_xor(v, o);
    return v;
}
__device__ __forceinline__ void unpack8(u32x4 r, float* f) {
    f[0] = bf2f(r.x & 0xffffu); f[1] = __uint_as_float(r.x & 0xffff0000u); f[2] = bf2f(r.y & 0xffffu); f[3] = __uint_as_float(r.y & 0xffff0000u);
    f[4] = bf2f(r.z & 0xffffu); f[5] = __uint_as_float(r.z & 0xffff0000u); f[6] = bf2f(r.w & 0xffffu); f[7] = __uint_as_float(r.w & 0xffff0000u);
}
__device__ __forceinline__ void unpack4(u32x2 r, float* f) {
    f[0] = bf2f(r.x & 0xffffu); f[1] = __uint_as_float(r.x & 0xffff0000u); f[2] = bf2f(r.y & 0xffffu); f[3] = __uint_as_float(r.y & 0xffff0000u);
}
#define LDS_WAIT() asm volatile("s_waitcnt lgkmcnt(0)" ::: "memory")

namespace pg8 {
constexpr int BM = 256, BK = 64, HALF = 128, HTB = HALF * BK * 2, NXCD = 8, WGM = 8;
__device__ __forceinline__ int lds_byte(int r, int c) { const int st = (r >> 4) * 2 + (c >> 5), rr = r & 15, cc = c & 31, ob = rr * 64 + cc * 2; return st * 1024 + (ob ^ (((ob >> 9) & 1) << 5)); }
__device__ __forceinline__ void stage_rc(int b, int& R, int& C) { const int st = b / 1024, sb = b % 1024, swz = sb ^ (((sb >> 9) & 1) << 5); R = (st >> 1) * 16 + swz / 64; C = (st & 1) * 32 + (swz % 64) / 2; }
__device__ __forceinline__ int perm32(int rho) { const int n = rho >> 4, i = rho & 15; return 8 * (i >> 2) + 4 * n + (i & 3); }

struct Unit { int pm, pn, nt, kind, ks; size_t aoff, boff; };
struct Gemm { const char* A; const char* Bt; int lda, ldb; };
struct Order {
    int nMm, nN, n_main, n_tail, ksplit, nt_full, G, c; size_t a_t, b_t, acol;
    __device__ __forceinline__ bool next(int i, Unit& u) const {
        const long L = (long)i * G + c;
        if (L < n_main) {
            const int nwg = n_main;
            int wgid = (int)L; { const int q = nwg / NXCD, r = nwg % NXCD, xcd = wgid % NXCD, off = wgid / NXCD; wgid = (xcd < r ? xcd * (q + 1) : r * (q + 1) + (xcd - r) * q) + off; }
            const int nig = WGM * nN, gid = wgid / nig, fm = gid * WGM, gsz = (nMm - fm) < WGM ? (nMm - fm) : WGM;
            u.pm = fm + ((wgid % nig) % gsz); u.pn = (wgid % nig) / gsz; u.nt = nt_full; u.kind = 0; u.ks = 0;
            u.aoff = (size_t)u.pm * a_t + (size_t)(u.pn >> 1) * acol; u.boff = (size_t)u.pn * b_t; return true;
        }
        const int Lt = (int)(L - n_main); if (Lt >= n_tail) return false;
        const int ks = Lt % ksplit, r = Lt / ksplit;
        u.pm = nMm + (r & 1); u.pn = r >> 1; u.nt = nt_full / ksplit; u.kind = ksplit > 1 ? 1 : 0; u.ks = ks;
        const size_t kofs = (size_t)ks * u.nt * (BK * 2);
        u.aoff = (size_t)u.pm * a_t + (size_t)(u.pn >> 1) * acol + kofs; u.boff = (size_t)u.pn * b_t + kofs; return true;
    }
};

struct EpiScaleBf16 {
    static constexpr bool PERM = true;
    bf16_t* O; int ldc; const float* ss;
    __device__ __forceinline__ void prefetch(const Unit& u, int wr, int fr, float (&ssv)[8]) const {
        const int row0 = u.pm * BM + wr * 64 + fr;
#pragma unroll
        for (int ai = 0; ai < 2; ++ai)
#pragma unroll
            for (int m = 0; m < 4; ++m) ssv[ai * 4 + m] = ss[row0 + ai * HALF + m * 16];
    }
    __device__ __forceinline__ void operator()(const f32x4 (&acc)[2][2][4][2], const Unit& u, int wr, int wc, int fr, int fq, const float (&ssv)[8]) const {
        const int row0 = u.pm * BM + wr * 64 + fr, col0 = u.pn * BM + wc * 32 + 8 * fq;
#pragma unroll
        for (int ai = 0; ai < 2; ++ai)
#pragma unroll
            for (int m = 0; m < 4; ++m) {
                const int row = row0 + ai * HALF + m * 16;
                const float rs = rsqrtf(ssv[ai * 4 + m] * (1.0f / 2048.0f) + EPS);
                bf16_t* rowp = O + ((unsigned)row * (unsigned)ldc + (unsigned)col0);
#pragma unroll
                for (int bj = 0; bj < 2; ++bj) {
                    const f32x4 v0 = acc[ai][bj][m][0] * rs, v1 = acc[ai][bj][m][1] * rs;
                    u32x4 w; w.x = pk2(v0[0], v0[1]); w.y = pk2(v0[2], v0[3]); w.z = pk2(v1[0], v1[1]); w.w = pk2(v1[2], v1[3]);
                    *(u32x4*)(rowp + bj * HALF) = w;
                }
            }
    }
};
struct EpiResid {
    static constexpr bool PERM = false;
    float* X; bf16_t* XB; float* ssout; float* part;
    __device__ __forceinline__ void prefetch(const Unit&, int, int, float (&)[8]) const {}
    __device__ __forceinline__ void operator()(const f32x4 (&acc)[2][2][4][2], const Unit& u, int wr, int wc, int fr, int fq, const float (&)[8]) const {
        const int row0 = u.pm * BM + wr * 64 + fr, col0 = u.pn * BM + wc * 32 + 4 * fq;
        if (u.kind == 1) {
            float* P = part + (size_t)u.ks * (512 * 2048);
#pragma unroll
            for (int ai = 0; ai < 2; ++ai)
#pragma unroll
                for (int m = 0; m < 4; ++m) {
                    const unsigned off = (unsigned)(row0 - MP + ai * HALF + m * 16) * 2048u + (unsigned)col0;
#pragma unroll
                    for (int bj = 0; bj < 2; ++bj)
#pragma unroll
                        for (int n = 0; n < 2; ++n) *(f32x4*)(P + off + bj * HALF + n * 16) = acc[ai][bj][m][n];
                }
            return;
        }
#pragma unroll
        for (int ai = 0; ai < 2; ++ai)
#pragma unroll
            for (int mp = 0; mp < 4; mp += 2) {
                f32x4 xin[2][2][2];
#pragma unroll
                for (int mm = 0; mm < 2; ++mm)
#pragma unroll
                    for (int bj = 0; bj < 2; ++bj)
#pragma unroll
                        for (int n = 0; n < 2; ++n) xin[mm][bj][n] = *(const f32x4*)(X + ((unsigned)(row0 + ai * HALF + (mp + mm) * 16) * 2048u + (unsigned)col0 + bj * HALF + n * 16));
#pragma unroll
                for (int mm = 0; mm < 2; ++mm) {
                    const int row = row0 + ai * HALF + (mp + mm) * 16;
                    const unsigned off = (unsigned)row * 2048u + (unsigned)col0;
                    float sq = 0.f;
#pragma unroll
                    for (int bj = 0; bj < 2; ++bj)
#pragma unroll
                        for (int n = 0; n < 2; ++n) {
                            const unsigned o = off + bj * HALF + n * 16;
                            const f32x4 x = xin[mm][bj][n] + acc[ai][bj][mp + mm][n];
                            *(f32x4*)(X + o) = x;
                            u32x2 w; w.x = pk2(x[0], x[1]); w.y = pk2(x[2], x[3]);
                            *(u32x2*)(XB + o) = w;
                            sq += (x[0] * x[0] + x[1] * x[1]) + (x[2] * x[2] + x[3] * x[3]);
                        }
                    sq += __shfl_xor(sq, 16); sq += __shfl_xor(sq, 32);
                    if (fq == 0) atomicAdd(ssout + row, sq);
                }
                asm volatile("" ::: "memory");
            }
    }
};
struct EpiLru {
    static constexpr bool PERM = false;
    const float* br; const float* bi; const float* sp; const bf16_t* XR; float* LA; bf16_t* LBv;
    __device__ __forceinline__ void prefetch(const Unit&, int, int, float (&)[8]) const {}
    __device__ __forceinline__ void operator()(const f32x4 (&acc)[2][2][4][2], const Unit& u, int wr, int wc, int fr, int fq, const float (&)[8]) const {
        const int row0 = u.pm * BM + wr * 64 + fr;
        const int cbase = (u.pn >> 1) * 256 + (u.pn & 1) * 128 + wc * 32 + 4 * fq;
        f32x4 br4[2], bi4[2], sp4[2];
#pragma unroll
        for (int n = 0; n < 2; ++n) { br4[n] = *(const f32x4*)(br + cbase + n * 16); bi4[n] = *(const f32x4*)(bi + cbase + n * 16); sp4[n] = *(const f32x4*)(sp + cbase + n * 16); }
#pragma unroll
        for (int ai = 0; ai < 2; ++ai)
#pragma unroll
            for (int mp = 0; mp < 4; mp += 2) {
                u32x2 xrr[2][2];
#pragma unroll
                for (int mm = 0; mm < 2; ++mm)
#pragma unroll
                    for (int n = 0; n < 2; ++n) xrr[mm][n] = *(const u32x2*)(XR + ((unsigned)(row0 + ai * HALF + (mp + mm) * 16) * 2048u + (unsigned)(cbase + n * 16)));
#pragma unroll
                for (int mm = 0; mm < 2; ++mm) {
                    const int row = row0 + ai * HALF + (mp + mm) * 16;
                    const bool first = (row < MP) && ((row & 2047) == 0);
#pragma unroll
                    for (int n = 0; n < 2; ++n) {
                        const unsigned o = (unsigned)row * 2048u + (unsigned)(cbase + n * 16);
                        float xr[4]; unpack4(xrr[mm][n], xr);
                        f32x4 av; float bb[4];
#pragma unroll
                        for (int j = 0; j < 4; ++j) {
                            const float r = sigm(acc[ai][0][mp + mm][n][j] + br4[n][j]), gi = sigm(acc[ai][1][mp + mm][n][j] + bi4[n][j]);
                            const float la = -8.0f * r * sp4[n][j];
                            const float a = __expf(la);
                            const float mult = first ? 1.0f : __builtin_amdgcn_sqrtf(fmaxf(1.0f - a * a, 0.f));
                            av[j] = a; bb[j] = mult * gi * xr[j];
                        }
                        *(f32x4*)(LA + o) = av;
                        u32x2 w; w.x = pk2(bb[0], bb[1]); w.y = pk2(bb[2], bb[3]);
                        *(u32x2*)(LBv + o) = w;
                    }
                }
                asm volatile("" ::: "memory");
            }
    }
};

template <class Epi>
__device__ __forceinline__ void gemm_phase(LAS unsigned char* lds, const Gemm g, const Order& S, const Epi& E) {
    int tid = threadIdx.x; asm volatile("" : "+v"(tid));
    const int wid = __builtin_amdgcn_readfirstlane(tid >> 6), lane = tid & 63, wr = wid >> 2, wc = wid & 3, fr = lane & 15, fq = lane >> 4;
    unsigned voffA[2], voffB[2];
#pragma unroll
    for (int i = 0; i < 2; ++i) { int R, C; stage_rc(tid * 16 + i * 8192, R, C); const int Rb = Epi::PERM ? ((R & ~31) + perm32(R & 31)) : R;
        voffA[i] = (unsigned)(R * g.lda + C) * 2u; voffB[i] = (unsigned)(Rb * g.ldb + C) * 2u; }
    const size_t kstep = (size_t)(BK * 2);
    const size_t hstepA = (size_t)HALF * g.lda * 2, hstepB = (size_t)HALF * g.ldb * 2;
    const unsigned ldsw = (unsigned)wid * 1024u;
    const int aoff = lds_byte(wr * 64 + fr, fq * 8), boff = lds_byte(wc * 32 + fr, fq * 8);
#define PG8_SA(b, h) (((b) * 2 + (h)) * HTB)
#define PG8_SB(b, h) ((4 + (b) * 2 + (h)) * HTB)
#define PG8_STAGE(bufoff, gbase, voff) do { _Pragma("unroll") for (int _i = 0; _i < 2; ++_i) \
        __builtin_amdgcn_global_load_lds((const unsigned*)((const char*)(gbase) + (voff)[_i]), (LAS unsigned*)(lds + (bufoff) + ldsw + _i * 8192), 16, 0, 0); } while (0)
#define PG8_LDA(dst, b, h) do { _Pragma("unroll") for (int m = 0; m < 4; ++m) _Pragma("unroll") for (int k = 0; k < 2; ++k) dst[m][k] = *(const LAS bf16x8*)(lds + PG8_SA(b, h) + aoff + m * 2048 + k * 1024); } while (0)
#define PG8_LDB(dst, b, h) do { _Pragma("unroll") for (int n = 0; n < 2; ++n) _Pragma("unroll") for (int k = 0; k < 2; ++k) dst[n][k] = *(const LAS bf16x8*)(lds + PG8_SB(b, h) + boff + n * 2048 + k * 1024); } while (0)
#define PG8_MMA(ai, bj, At, Bt) do { __builtin_amdgcn_s_setprio(1); _Pragma("unroll") for (int m = 0; m < 4; ++m) _Pragma("unroll") for (int n = 0; n < 2; ++n) _Pragma("unroll") for (int k = 0; k < 2; ++k) \
        acc[ai][bj][m][n] = __builtin_amdgcn_mfma_f32_16x16x32_bf16(Bt[n][k], At[m][k], acc[ai][bj][m][n], 0, 0, 0); __builtin_amdgcn_s_setprio(0); } while (0)
#define PG8_WAIT_V(n) asm volatile("s_waitcnt vmcnt(" #n ")" ::: "memory")
#define PG8_WAIT_L(n) asm volatile("s_waitcnt lgkmcnt(" #n ")" ::: "memory")
#define PG8_BAR __builtin_amdgcn_s_barrier()
#define PG8_SCHED __builtin_amdgcn_sched_barrier(0)
    Unit cur, nxt; int ui = 0;
    if (!S.next(0, cur)) return;
    f32x4 acc[2][2][4][2];
#pragma unroll
    for (int a = 0; a < 2; ++a)
#pragma unroll
        for (int b = 0; b < 2; ++b)
#pragma unroll
            for (int m = 0; m < 4; ++m)
#pragma unroll
                for (int n = 0; n < 2; ++n) acc[a][b][m][n] = (f32x4){0.f, 0.f, 0.f, 0.f};
    bf16x8 At[4][2], B0[2][2], B1[2][2];
    const char* cA = g.A + cur.aoff; const char* cB = g.Bt + cur.boff;
    float epf[8] = {0.f, 0.f, 0.f, 0.f, 0.f, 0.f, 0.f, 0.f};
    E.prefetch(cur, wr, fr, epf);
    PG8_STAGE(PG8_SB(0, 0), cB, voffB); PG8_STAGE(PG8_SA(0, 0), cA, voffA); PG8_STAGE(PG8_SB(0, 1), cB + hstepB, voffB); PG8_STAGE(PG8_SA(0, 1), cA + hstepA, voffA);
    if (wr == 1) PG8_BAR;
    PG8_WAIT_V(4); PG8_BAR;
    PG8_STAGE(PG8_SB(1, 0), cB + kstep, voffB); PG8_STAGE(PG8_SA(1, 0), cA + kstep, voffA); PG8_STAGE(PG8_SB(1, 1), cB + hstepB + kstep, voffB);
    PG8_WAIT_V(6); PG8_BAR;
    for (;;) {
        const bool has_next = S.next(ui + 1, nxt);
        const char* nA = has_next ? g.A + nxt.aoff : cA; const char* nB = has_next ? g.Bt + nxt.boff : cB;
        const int nt = cur.nt;
        for (int t = 0; t < nt; t += 2) {
            const bool last = (t == nt - 2);
            const char* a1 = cA + (size_t)(t + 1) * kstep;
            const char* a2 = last ? nA : cA + (size_t)(t + 2) * kstep; const char* b2 = last ? nB : cB + (size_t)(t + 2) * kstep;
            const char* a3 = a2 + kstep; const char* b3 = b2 + kstep;
            PG8_LDB(B0, 0, 0); PG8_SCHED; PG8_LDA(At, 0, 0); PG8_STAGE(PG8_SA(1, 1), a1 + hstepA, voffA);
            PG8_WAIT_L(8); PG8_BAR; PG8_WAIT_L(0); PG8_MMA(0, 0, At, B0); PG8_BAR; PG8_SCHED;
            PG8_LDB(B1, 0, 1); PG8_STAGE(PG8_SB(0, 0), b2, voffB);
            PG8_BAR; PG8_WAIT_L(0); PG8_MMA(0, 1, At, B1); PG8_BAR;
            PG8_LDA(At, 0, 1); PG8_STAGE(PG8_SA(0, 0), a2, voffA);
            PG8_BAR; PG8_WAIT_L(0); PG8_MMA(1, 0, At, B0); PG8_BAR; PG8_SCHED;
            PG8_STAGE(PG8_SB(0, 1), b2 + hstepB, voffB);
            PG8_WAIT_V(6); PG8_BAR; PG8_MMA(1, 1, At, B1); PG8_BAR;
            PG8_LDB(B0, 1, 0); PG8_SCHED; PG8_LDA(At, 1, 0); PG8_STAGE(PG8_SA(0, 1), a2 + hstepA, voffA);
            PG8_WAIT_L(8); PG8_BAR; PG8_WAIT_L(0); PG8_MMA(0, 0, At, B0); PG8_BAR; PG8_SCHED;
            PG8_LDB(B1, 1, 1); PG8_STAGE(PG8_SB(1, 0), b3, voffB);
            PG8_BAR; PG8_WAIT_L(0); PG8_MMA(0, 1, At, B1); PG8_BAR;
            PG8_LDA(At, 1, 1); PG8_STAGE(PG8_SA(1, 0), a3, voffA);
            PG8_BAR; PG8_WAIT_L(0); PG8_MMA(1, 0, At, B0); PG8_BAR; PG8_SCHED;
            PG8_STAGE(PG8_SB(1, 1), b3 + hstepB, voffB);
            PG8_WAIT_V(6); PG8_BAR; PG8_MMA(1, 1, At, B1); PG8_BAR;
        }
        if (wr == 0) PG8_BAR;
        E(acc, cur, wr, wc, fr, fq, epf);
        if (!has_next) break;
#pragma unroll
        for (int a = 0; a < 2; ++a)
#pragma unroll
            for (int b = 0; b < 2; ++b)
#pragma unroll
                for (int m = 0; m < 4; ++m)
#pragma unroll
                    for (int n = 0; n < 2; ++n) acc[a][b][m][n] = (f32x4){0.f, 0.f, 0.f, 0.f};
        cur = nxt; cA = nA; cB = nB; ++ui;
        E.prefetch(cur, wr, fr, epf);
        if (wr == 1) PG8_BAR;
    }
    PG8_WAIT_V(0);
    PG8_BAR;
#undef PG8_SA
#undef PG8_SB
#undef PG8_STAGE
#undef PG8_LDA
#undef PG8_LDB
#undef PG8_MMA
#undef PG8_WAIT_V
#undef PG8_WAIT_L
#undef PG8_BAR
#undef PG8_SCHED
}
}

__device__ __forceinline__ void tr_item(const float* __restrict__ W, int ldw, int N, int k0, int n0, const float* __restrict__ scale, bf16_t* __restrict__ dst, int ldd, float* scr, int lane) {
    const int r4 = lane >> 4, c4 = (lane & 15) * 4;
    const bool inb = (n0 + c4) < N;
    f32x4 v[16];
#pragma unroll
    for (int i = 0; i < 16; ++i) v[i] = inb ? __builtin_nontemporal_load((const f32x4*)(W + (size_t)(k0 + 4 * i + r4) * ldw + n0 + c4)) : (f32x4){0.f, 0.f, 0.f, 0.f};
#pragma unroll
    for (int i = 0; i < 16; ++i) { float* d = scr + (4 * i + r4) * 65 + c4; d[0] = v[i][0]; d[1] = v[i][1]; d[2] = v[i][2]; d[3] = v[i][3]; }
    LDS_WAIT();
    const int c = lane & 7;
    f32x4 s0 = (f32x4){1.f, 1.f, 1.f, 1.f}, s1 = s0;
    if (scale) { s0 = *(const f32x4*)(scale + k0 + 8 * c); s1 = *(const f32x4*)(scale + k0 + 8 * c + 4); }
#pragma unroll
    for (int j = 0; j < 8; ++j) { const int n = (lane >> 3) + 8 * j; const float* sp = scr + (8 * c) * 65 + n;
        u32x4 o; o.x = pk2(sp[0 * 65] * s0[0], sp[1 * 65] * s0[1]); o.y = pk2(sp[2 * 65] * s0[2], sp[3 * 65] * s0[3]); o.z = pk2(sp[4 * 65] * s1[0], sp[5 * 65] * s1[1]); o.w = pk2(sp[6 * 65] * s1[2], sp[7 * 65] * s1[3]);
        *(u32x4*)(dst + (size_t)n * ldd + 8 * c) = o; }
    LDS_WAIT();
}

__device__ __forceinline__ void phase_prologue(const Params& p, float* ldsf) {
    int tid = threadIdx.x; asm volatile("" : "+v"(tid));
    const int wave = tid >> 6, lane = tid & 63;
    const int gw = blockIdx.x * 8 + wave, NGW = gridDim.x * 8;
    float* scr = ldsf + wave * 4160;
    unsigned char* ws = p.ws;
    constexpr int I0 = 32 * 177, I1 = 64 * 32, I2 = 32 * 176, I3 = 88 * 32, I4 = 32 * 192, I5 = I1, I6 = I2, I7 = I3, I8 = 128, I9 = 128;
    constexpr int NIT = I0 + I1 + I2 + I3 + I4 + I5 + I6 + I7 + I8 + I9;
    for (int it = gw; it < NIT; it += NGW) {
        int r = it;
        const float* W; int K, N; const float* sc = nullptr; bf16_t* WT;
        if (r < I0) { W = p.in[12 + p.z]; K = 2048; N = 11296; sc = p.in[9 + p.z]; WT = (bf16_t*)(ws + WS_WIN0); }
        else if ((r -= I0) < I1) { W = p.in[19 + p.z]; K = 4096; N = 2048; WT = (bf16_t*)(ws + WS_WOUT0); }
        else if ((r -= I1) < I2) { W = p.in[31 + p.z]; K = 2048; N = 11264; sc = p.in[10 + p.z]; WT = (bf16_t*)(ws + WS_WUP0); }
        else if ((r -= I2) < I3) { W = p.in[34 + p.z]; K = 5632; N = 2048; WT = (bf16_t*)(ws + WS_WDN0); }
        else if ((r -= I3) < I4) { W = p.in[20 + p.z]; K = 2048; N = 12288; sc = p.in[9 + p.z] + 2048; WT = (bf16_t*)(ws + WS_WIN1); }
        else if ((r -= I4) < I5) { W = p.in[30 + p.z]; K = 4096; N = 2048; WT = (bf16_t*)(ws + WS_WOUT1); }
        else if ((r -= I5) < I6) { W = p.in[31 + p.z] + (size_t)2048 * 11264; K = 2048; N = 11264; sc = p.in[10 + p.z] + 2048; WT = (bf16_t*)(ws + WS_WUP1); }
        else if ((r -= I6) < I7) { W = p.in[34 + p.z] + (size_t)5632 * 2048; K = 5632; N = 2048; WT = (bf16_t*)(ws + WS_WDN1); }
        else {
            r -= I7; const int which = r >> 7; r &= 127;
            const int blk = r >> 4, kb = (r >> 2) & 3, nb = r & 3, n0 = 64 * nb, k0 = 64 * kb;
            const float* Wl = (which ? p.in[27 + p.z] : p.in[25 + p.z]) + (size_t)blk * 65536;
            const int drow = (blk * 2 + (n0 >> 7)) * 256 + which * 128 + (n0 & 127);
            tr_item(Wl, 256, 256, k0, n0, nullptr, (bf16_t*)(ws + WS_WLRU) + (size_t)drow * 256 + k0, 256, scr, lane);
            continue;
        }
        const int nblk = (N + 63) / 64, kbl = r & 7, r8 = r >> 3, nb = r8 % nblk, kb = (r8 / nblk) * 8 + kbl, k0 = 64 * kb, n0 = 64 * nb;
        tr_item(W, N, N, k0, n0, sc, WT + (size_t)n0 * K + k0, K, scr, lane);
    }
    {
        u32x4* z = (u32x4*)((bf16_t*)(ws + WS_WIN0) + (size_t)11296 * 2048);
        const int n16 = 224 * 2048 * 2 / 16;
        for (int i = blockIdx.x * 512 + tid; i < n16; i += gridDim.x * 512) z[i] = (u32x4){0u, 0u, 0u, 0u};
    }
    float* X = (float*)(ws + WS_X); bf16_t* XB = (bf16_t*)(ws + WS_XB); float* ss = (float*)(ws + WS_SS);
    for (int row = gw; row < MT; row += NGW) {
        const float* src = row < MP ? p.in[0 + p.z] + (size_t)row * 2048 : p.in[1 + p.z] + (size_t)(row - MP) * 2048;
        float s = 0.f;
#pragma unroll
        for (int j = 0; j < 8; ++j) {
            const f32x4 v = __builtin_nontemporal_load((const f32x4*)(src + (lane + 64 * j) * 4));
            *(f32x4*)(X + (size_t)row * 2048 + (lane + 64 * j) * 4) = v;
            u32x2 w; w.x = pk2(v[0], v[1]); w.y = pk2(v[2], v[3]);
            *(u32x2*)(XB + (size_t)row * 2048 + (lane + 64 * j) * 4) = w;
            s += (v[0] * v[0] + v[1] * v[1]) + (v[2] * v[2] + v[3] * v[3]);
        }
        s = wave_sum(s);
        if (lane == 0) ss[row] = s;
    }
    for (int i = blockIdx.x * 512 + tid; i < 4 * MT; i += gridDim.x * 512) ss[MT + i] = 0.f;
    for (int i = blockIdx.x * 512 + tid; i < 2048; i += gridDim.x * 512) {
        ((float*)(ws + WS_SP))[i] = softplus(-p.in[29 + p.z][i]);
        ((float*)(ws + WS_LB))[i] = sigm(p.in[21 + p.z][2048 + i] - p.in[21 + p.z][i]);
    }
}

__device__ __forceinline__ int next_item(unsigned* ctr, float* ldsf) {
    __syncthreads();
    if (threadIdx.x == 0) ((volatile unsigned*)ldsf)[33284] = atomicAdd(ctr, 1u);
    __syncthreads();
    return (int)((volatile unsigned*)ldsf)[33284];
}

template <int TYPE, int VW>
__device__ __forceinline__ void rec_item(const Params& p, float* ldsf, int sample, int b, int h, int s) {
    constexpr int NV = VW / 16;
    typedef float VT __attribute__((ext_vector_type(NV)));
    int tid = threadIdx.x; asm volatile("" : "+v"(tid));
    const int w = tid >> 6, lane = tid & 63, kg = lane >> 4, vq = lane & 15, kb = 16 * w + 4 * kg;
    const int L = sample ? 4 : 2048, row0 = sample ? MP + 4 * b : 2048 * b, pos0 = sample ? 16384 : 0;
    constexpr int LDP = TYPE < 2 ? LD0 : LD1;
    const bf16_t* proj = (const bf16_t*)(p.ws + WS_PROJ) + (size_t)row0 * LDP;
    bf16_t* yz = (bf16_t*)(p.ws + WS_YZ) + (size_t)row0 * 4096;
    float* part = ldsf + 8192;
    int colA = -1, colB = -1, role = -1, didx = 0;
    float w0 = 0.f, w1 = 0.f, w2 = 0.f, w3 = 0.f, cbias = 0.f, c0 = 0.f, c1 = 0.f, c2 = 0.f, aux = 0.f, aux2 = 0.f;
    if constexpr (TYPE == 0) {
        if (tid < 320) {
            role = tid < 128 ? 0 : (tid < 256 ? 1 : 2);
            didx = tid < 128 ? tid : (tid < 256 ? tid - 128 : tid - 256);
            const int ch = tid < 128 ? 2560 + (h >> 3) * 128 + tid : (tid < 256 ? 2048 + (h >> 3) * 128 + (tid - 128) : h * 64 + (tid - 256));
            colA = 2048 + ch;
            const float* cw = p.in[13 + p.z];
            w0 = cw[ch]; w1 = cw[3072 + ch]; w2 = cw[2 * 3072 + ch]; w3 = cw[3 * 3072 + ch]; cbias = p.in[14 + p.z][ch];
            if (sample) { const float* st = p.in[3 + p.z] + (size_t)b * 3 * 3072; c0 = st[ch]; c1 = st[3072 + ch]; c2 = st[2 * 3072 + ch]; }
        } else if (tid < 328) { role = 3; didx = tid - 320; colA = 5120 + h; aux = p.in[15 + p.z][h]; aux2 = -__expf(p.in[16 + p.z][h]); }
    } else if constexpr (TYPE == 1) {
        if (tid < 128) { role = tid < 64 ? 0 : 1; didx = tid & 63; colA = (tid < 64 ? 5152 : 6176) + h * 128 + didx; colB = colA + 64;
            aux = exp2f(-(float)didx * 0.20762050593046014f); }
        else if (tid < 128 + VW) { role = 2; didx = tid - 128; colA = 7200 + h * 256 + s * VW + didx; }
    } else {
        if (tid < 128) { role = 0; didx = tid; colA = h * 128 + tid; }
        else if (tid < 256) { role = 1; didx = tid - 128; colA = 2048 + h * 128 + didx; aux = ((const float*)(p.ws + WS_LB))[h * 128 + didx]; }
        else if (tid < 256 + VW) { role = 2; didx = tid - 256; colA = 4096 + h * 128 + s * VW + didx; }
    }
    const float Dh = TYPE == 0 ? p.in[17 + p.z][h] : 0.f;
    const float gamma = TYPE == 1 ? 1.0f - exp2f(-5.0f - (float)h * (4.0f / 7.0f)) : 0.f;
    const int ldS = TYPE == 0 ? 64 : (TYPE == 1 ? 256 : 128);
    size_t soff;
    if constexpr (TYPE == 0) soff = ((size_t)(b * 32 + h) * 128) * 64;
    else if constexpr (TYPE == 1) soff = ((size_t)(b * 8 + h) * 128) * 256 + s * VW;
    else soff = ((size_t)(b * 16 + h) * 128) * 128 + s * VW;
    const float* S0 = TYPE == 0 ? p.in[2 + p.z] : (TYPE == 1 ? p.in[4 + p.z] : p.in[5 + p.z]);
    float* Sout = p.out + (TYPE == 0 ? (sample ? O_SSMS : O_SSMP) : (TYPE == 1 ? (sample ? O_RETS : O_RETP) : (sample ? O_HGS : O_HGP))) + soff;
    VT S[4];
#pragma unroll
    for (int i = 0; i < 4; ++i) { if (sample) S[i] = *(const VT*)(S0 + soff + (size_t)(kb + i) * ldS + NV * vq); else S[i] = (VT)(0.f); }
    unsigned short ra[8], rb[8]; unsigned short zr = 0;
    const int R = (L + 7) >> 3;
    auto load_raw = [&](int r) {
#pragma unroll
        for (int t = 0; t < 8; ++t) {
            const int tt = 8 * r + t;
            ra[t] = 0; rb[t] = 0;
            if (tt < L) {
                if (colA >= 0) ra[t] = proj[(size_t)tt * LDP + colA];
                if (TYPE == 1 && colB >= 0) rb[t] = proj[(size_t)tt * LDP + colB];
            }
        }
        if (TYPE == 0) { const int tt = 8 * r + w; if (tt < L) zr = proj[(size_t)tt * LDP + h * 64 + lane]; }
    };
    load_raw(0);
    for (int r = 0; r < R; ++r) {
        const int nv = (L - 8 * r) < 8 ? (L - 8 * r) : 8;
        float* stg = ldsf + (r & 1) * 4096;
        float* qs = stg; float* ks = stg + 1024; float* as = stg + 2048; float* vs = stg + 3072; float* ad = stg + 3584;
        if constexpr (TYPE == 0) {
            if (role >= 0 && role < 3) {
                float* dst = role == 0 ? qs : (role == 1 ? ks : vs); const int dstr = role == 2 ? 64 : 128;
#pragma unroll
                for (int t = 0; t < 8; ++t) {
                    const float x = bf2f(ra[t]);
                    const float y = cbias + w0 * c0 + w1 * c1 + w2 * c2 + w3 * x;
                    c0 = c1; c1 = c2; c2 = x;
                    dst[t * dstr + didx] = silu(y);
                }
            } else if (role == 3) {
                float xv = 0.f;
#pragma unroll
                for (int t = 0; t < 8; ++t) if (t == didx) xv = bf2f(ra[t]);
                const float dt = softplus(xv + aux);
                ad[2 * didx] = __expf(dt * aux2); ad[2 * didx + 1] = dt;
            }
        } else if constexpr (TYPE == 1) {
            if (role == 0 || role == 1) {
                float* dst = role == 0 ? qs : ks; const float sc = role == 0 ? 1.0f : 0.08838834764831845f;
#pragma unroll
                for (int t = 0; t < 8; ++t) {
                    const int pos = pos0 + 8 * r + t;
                    const double rev = (double)pos * (double)aux * 0.15915494309189535;
                    const float fr = (float)(rev - floor(rev));
                    const float sn = __builtin_amdgcn_sinf(fr), cs = __builtin_amdgcn_cosf(fr);
                    const float x1 = bf2f(ra[t]) * sc, x2 = bf2f(rb[t]) * sc;
                    dst[t * 128 + didx] = x1 * cs - x2 * sn;
                    dst[t * 128 + 64 + didx] = x1 * sn + x2 * cs;
                }
            } else if (role == 2) {
#pragma unroll
                for (int t = 0; t < 8; ++t) vs[t * VW + didx] = bf2f(ra[t]);
            }
        } else {
            if (role == 0) {
#pragma unroll
                for (int t = 0; t < 8; ++t) qs[t * 128 + didx] = silu(bf2f(ra[t]));
            } else if (role == 1) {
#pragma unroll
                for (int t = 0; t < 8; ++t) { const float f = aux + (1.0f - aux) * sigm(bf2f(ra[t])); as[t * 128 + didx] = f; ks[t * 128 + didx] = 1.0f - f; }
            } else if (role == 2) {
#pragma unroll
                for (int t = 0; t < 8; ++t) vs[t * VW + didx] = bf2f(ra[t]);
            }
        }
        const unsigned short zc = zr;
        __syncthreads();
        if (r + 1 < R) load_raw(r + 1);
        for (int t0 = 0; t0 < nv; t0 += 4) {
#pragma unroll
            for (int tt = 0; tt < 4; ++tt) {
                const int t = t0 + tt;
                const f32x4 q4 = *(const f32x4*)(qs + t * 128 + kb);
                f32x4 k4 = *(const f32x4*)(ks + t * 128 + kb);
                const VT v4 = *(const VT*)(vs + t * VW + NV * vq);
                f32x4 a4;
                if constexpr (TYPE == 0) { const f32x2 adv = *(const f32x2*)(ad + 2 * t); a4 = (f32x4){adv.x, adv.x, adv.x, adv.x}; k4 = k4 * adv.y; }
                else if constexpr (TYPE == 1) a4 = (f32x4){gamma, gamma, gamma, gamma};
                else a4 = *(const f32x4*)(as + t * 128 + kb);
                VT o = (VT)(0.f);
#pragma unroll
                for (int i = 0; i < 4; ++i) { S[i] = a4[i] * S[i] + k4[i] * v4; o += q4[i] * S[i]; }
                *(VT*)(part + ((t * 32 + w * 4 + kg) * VW + NV * vq)) = o;
            }
        }
        __syncthreads();
        const int rt = tid / VW, rv = tid % VW;
        if (tid < 8 * VW && rt < nv) {
            float o = 0.f;
#pragma unroll
            for (int pp = 0; pp < 32; ++pp) o += part[(rt * 32 + pp) * VW + rv];
            const size_t trow = (size_t)(8 * r + rt);
            if constexpr (TYPE == 0) {
                const float y = (o + Dh * vs[rt * 64 + rv]) * silu(bf2f(zc));
                yz[trow * 4096 + h * 64 + rv] = f2bf(y);
            } else if constexpr (TYPE == 1) {
                yz[trow * 4096 + 2048 + h * 256 + s * VW + rv] = f2bf(o);
            } else {
                yz[trow * 4096 + h * 128 + s * VW + rv] = f2bf(o);
            }
        }
    }
#pragma unroll
    for (int i = 0; i < 4; ++i) *(VT*)(Sout + (size_t)(kb + i) * ldS + NV * vq) = S[i];
}

template <int TYPE>
__device__ __forceinline__ void dec_unit(const Params& p, float* ldsf, int b, int u) {
    int tid = threadIdx.x; asm volatile("" : "+v"(tid));
    const int w = tid >> 6, lane = tid & 63, kg = lane >> 4, vq = lane & 15;
    const int row0 = MP + 4 * b;
    constexpr int LDP = TYPE < 2 ? LD0 : LD1;
    const bf16_t* proj = (const bf16_t*)(p.ws + WS_PROJ) + (size_t)row0 * LDP;
    bf16_t* yz = (bf16_t*)(p.ws + WS_YZ) + (size_t)row0 * 4096;
    int h, sl; size_t soff; int ldS;
    if constexpr (TYPE == 0) { h = 8 * u + w; sl = 0; ldS = 64; soff = ((size_t)(b * 32 + h) * 128) * 64; }
    else if constexpr (TYPE == 1) { h = 2 * u + (w >> 2); sl = w & 3; ldS = 256; soff = ((size_t)(b * 8 + h) * 128) * 256 + sl * 64; }
    else { h = 4 * u + (w >> 1); sl = w & 1; ldS = 128; soff = ((size_t)(b * 16 + h) * 128) * 128 + sl * 64; }
    const float* S0 = (TYPE == 0 ? p.in[2 + p.z] : (TYPE == 1 ? p.in[4 + p.z] : p.in[5 + p.z])) + soff + (size_t)(32 * kg) * ldS + 4 * vq;
    float* Sout = p.out + (TYPE == 0 ? O_SSMS : (TYPE == 1 ? O_RETS : O_HGS)) + soff + (size_t)(32 * kg) * ldS + 4 * vq;
    if constexpr (TYPE == 0) {
        float* qs = ldsf; float* ks = ldsf + 512; float* xs = ldsf + 1024; float* zs = ldsf + 3072; float* ad = ldsf + 5120;
        unsigned short xr[2][4]; float cw[2][4], cb[2], st[2][3]; unsigned short zr[4]; unsigned short dr = 0;
#pragma unroll
        for (int q = 0; q < 2; ++q) {
            const int idx = tid + 512 * q;
            if (idx < 768) {
                const int ch = idx < 128 ? 2560 + u * 128 + idx : (idx < 256 ? 2048 + u * 128 + (idx - 128) : u * 512 + (idx - 256));
#pragma unroll
                for (int t = 0; t < 4; ++t) xr[q][t] = proj[(size_t)t * LDP + 2048 + ch];
#pragma unroll
                for (int j = 0; j < 4; ++j) cw[q][j] = p.in[13 + p.z][j * 3072 + ch];
                cb[q] = p.in[14 + p.z][ch];
#pragma unroll
                for (int j = 0; j < 3; ++j) st[q][j] = p.in[3 + p.z][((size_t)b * 3 + j) * 3072 + ch];
            }
        }
#pragma unroll
        for (int t = 0; t < 4; ++t) zr[t] = proj[(size_t)t * LDP + u * 512 + tid];
        if (tid < 32) dr = proj[(size_t)(tid >> 3) * LDP + 5120 + 8 * u + (tid & 7)];
        f32x4 S[32];
#pragma unroll
        for (int i = 0; i < 32; ++i) S[i] = __builtin_nontemporal_load((const f32x4*)(S0 + (size_t)i * ldS));
#pragma unroll
        for (int q = 0; q < 2; ++q) {
            const int idx = tid + 512 * q;
            if (idx < 768) {
                float* dst = idx < 128 ? qs + idx : (idx < 256 ? ks + (idx - 128) : xs + (idx - 256));
                const int dstr = idx < 256 ? 128 : 512;
                float c0 = st[q][0], c1 = st[q][1], c2 = st[q][2];
#pragma unroll
                for (int t = 0; t < 4; ++t) {
                    const float x = bf2f(xr[q][t]);
                    const float y = cb[q] + cw[q][0] * c0 + cw[q][1] * c1 + cw[q][2] * c2 + cw[q][3] * x;
                    c0 = c1; c1 = c2; c2 = x;
                    dst[t * dstr] = silu(y);
                }
            }
        }
#pragma unroll
        for (int t = 0; t < 4; ++t) zs[t * 512 + tid] = silu(bf2f(zr[t]));
        if (tid < 32) {
            const int hh = 8 * u + (tid & 7);
            const float dt = softplus(bf2f(dr) + p.in[15 + p.z][hh]);
            ad[2 * tid] = __expf(-dt * __expf(p.in[16 + p.z][hh])); ad[2 * tid + 1] = dt;
        }
        __syncthreads();
        const float Dh = p.in[17 + p.z][h];
#pragma unroll 1
        for (int t = 0; t < 4; ++t) {
            const f32x2 adv = *(const f32x2*)(ad + 2 * (t * 8 + w));
            const f32x4 v4 = *(const f32x4*)(xs + t * 512 + w * 64 + 4 * vq);
            f32x4 o = (f32x4){0.f, 0.f, 0.f, 0.f};
#pragma unroll
            for (int i4 = 0; i4 < 8; ++i4) {
                const f32x4 q4 = *(const f32x4*)(qs + t * 128 + 32 * kg + 4 * i4);
                const f32x4 k4 = *(const f32x4*)(ks + t * 128 + 32 * kg + 4 * i4) * adv.y;
#pragma unroll
                for (int ii = 0; ii < 4; ++ii) { S[4 * i4 + ii] = adv.x * S[4 * i4 + ii] + k4[ii] * v4; o += q4[ii] * S[4 * i4 + ii]; }
            }
#pragma unroll
            for (int j = 0; j < 4; ++j) { o[j] += __shfl_xor(o[j], 16); o[j] += __shfl_xor(o[j], 32); }
            if (kg == 0) {
                const f32x4 z4 = *(const f32x4*)(zs + t * 512 + w * 64 + 4 * vq);
                const f32x4 y = (o + Dh * v4) * z4;
                u32x2 ov; ov.x = pk2(y[0], y[1]); ov.y = pk2(y[2], y[3]);
                *(u32x2*)(yz + (size_t)t * 4096 + h * 64 + 4 * vq) = ov;
            }
        }
#pragma unroll
        for (int i = 0; i < 32; ++i) __builtin_nontemporal_store(S[i], (f32x4*)(Sout + (size_t)i * ldS));
    } else if constexpr (TYPE == 1) {
        float* qs = ldsf; float* ks = ldsf + 1024; float* vs = ldsf + 2048;
        unsigned short x1[4], x2[4], vr[4];
        const int hl = tid >> 7, isk = (tid >> 6) & 1, jf = tid & 63;
        if (tid < 256) {
            const int col = (isk ? 6176 : 5152) + (2 * u + hl) * 128 + jf;
#pragma unroll
            for (int t = 0; t < 4; ++t) { x1[t] = proj[(size_t)t * LDP + col]; x2[t] = proj[(size_t)t * LDP + col + 64]; }
        }
#pragma unroll
        for (int t = 0; t < 4; ++t) vr[t] = proj[(size_t)t * LDP + 7200 + (2 * u + (tid >> 8)) * 256 + (tid & 255)];
        f32x4 S[32];
#pragma unroll
        for (int i = 0; i < 32; ++i) S[i] = __builtin_nontemporal_load((const f32x4*)(S0 + (size_t)i * ldS));
        if (tid < 256) {
            const float inv = exp2f(-(float)jf * 0.20762050593046014f);
            float* dst = isk ? ks : qs; const float sc = isk ? 0.08838834764831845f : 1.0f;
#pragma unroll
            for (int t = 0; t < 4; ++t) {
                const double rev = (double)(16384 + t) * (double)inv * 0.15915494309189535;
                const float fr = (float)(rev - floor(rev));
                const float sn = __builtin_amdgcn_sinf(fr), cs = __builtin_amdgcn_cosf(fr);
                const float a1 = bf2f(x1[t]) * sc, a2 = bf2f(x2[t]) * sc;
                dst[(t * 2 + hl) * 128 + jf] = a1 * cs - a2 * sn;
                dst[(t * 2 + hl) * 128 + 64 + jf] = a1 * sn + a2 * cs;
            }
        }
#pragma unroll
        for (int t = 0; t < 4; ++t) vs[(t * 2 + (tid >> 8)) * 256 + (tid & 255)] = bf2f(vr[t]);
        __syncthreads();
        const float gamma = 1.0f - exp2f(-5.0f - (float)h * (4.0f / 7.0f));
        const int hw = w >> 2;
#pragma unroll 1
        for (int t = 0; t < 4; ++t) {
            const f32x4 v4 = *(const f32x4*)(vs + (t * 2 + hw) * 256 + sl * 64 + 4 * vq);
            f32x4 o = (f32x4){0.f, 0.f, 0.f, 0.f};
#pragma unroll
            for (int i4 = 0; i4 < 8; ++i4) {
                const f32x4 q4 = *(const f32x4*)(qs + (t * 2 + hw) * 128 + 32 * kg + 4 * i4);
                const f32x4 k4 = *(const f32x4*)(ks + (t * 2 + hw) * 128 + 32 * kg + 4 * i4);
#pragma unroll
                for (int ii = 0; ii < 4; ++ii) { S[4 * i4 + ii] = gamma * S[4 * i4 + ii] + k4[ii] * v4; o += q4[ii] * S[4 * i4 + ii]; }
            }
#pragma unroll
            for (int j = 0; j < 4; ++j) { o[j] += __shfl_xor(o[j], 16); o[j] += __shfl_xor(o[j], 32); }
            if (kg == 0) {
                u32x2 ov; ov.x = pk2(o[0], o[1]); ov.y = pk2(o[2], o[3]);
                *(u32x2*)(yz + (size_t)t * 4096 + 2048 + h * 256 + sl * 64 + 4 * vq) = ov;
            }
        }
#pragma unroll
        for (int i = 0; i < 32; ++i) __builtin_nontemporal_store(S[i], (f32x4*)(Sout + (size_t)i * ldS));
    } else {
        float* qs = ldsf; float* ks = ldsf + 2048; float* as = ldsf + 4096; float* vs = ldsf + 6144;
        unsigned short qr[4], fr_[4], vr[4];
        const int hl = tid >> 7, kk = tid & 127, col = (4 * u + hl) * 128 + kk;
#pragma unroll
        for (int t = 0; t < 4; ++t) { qr[t] = proj[(size_t)t * LDP + col]; fr_[t] = proj[(size_t)t * LDP + 2048 + col]; vr[t] = proj[(size_t)t * LDP + 4096 + col]; }
        const float lb = ((const float*)(p.ws + WS_LB))[col];
        f32x4 S[32];
#pragma unroll
        for (int i = 0; i < 32; ++i) S[i] = __builtin_nontemporal_load((const f32x4*)(S0 + (size_t)i * ldS));
#pragma unroll
        for (int t = 0; t < 4; ++t) {
            const int o = (t * 4 + hl) * 128 + kk;
            qs[o] = silu(bf2f(qr[t]));
            const float f = lb + (1.0f - lb) * sigm(bf2f(fr_[t]));
            as[o] = f; ks[o] = 1.0f - f; vs[o] = bf2f(vr[t]);
        }
        __syncthreads();
        const int hw = w >> 1;
#pragma unroll 1
        for (int t = 0; t < 4; ++t) {
            const f32x4 v4 = *(const f32x4*)(vs + (t * 4 + hw) * 128 + sl * 64 + 4 * vq);
            f32x4 o = (f32x4){0.f, 0.f, 0.f, 0.f};
#pragma unroll
            for (int i4 = 0; i4 < 8; ++i4) {
                const int off = (t * 4 + hw) * 128 + 32 * kg + 4 * i4;
                const f32x4 q4 = *(const f32x4*)(qs + off), k4 = *(const f32x4*)(ks + off), a4 = *(const f32x4*)(as + off);
#pragma unroll
                for (int ii = 0; ii < 4; ++ii) { S[4 * i4 + ii] = a4[ii] * S[4 * i4 + ii] + k4[ii] * v4; o += q4[ii] * S[4 * i4 + ii]; }
            }
#pragma unroll
            for (int j = 0; j < 4; ++j) { o[j] += __shfl_xor(o[j], 16); o[j] += __shfl_xor(o[j], 32); }
            if (kg == 0) {
                u32x2 ov; ov.x = pk2(o[0], o[1]); ov.y = pk2(o[2], o[3]);
                *(u32x2*)(yz + (size_t)t * 4096 + h * 128 + sl * 64 + 4 * vq) = ov;
            }
        }
#pragma unroll
        for (int i = 0; i < 32; ++i) __builtin_nontemporal_store(S[i], (f32x4*)(Sout + (size_t)i * ldS));
    }
}

#define CK_QS 0
#define CK_KS 17408
#define CK_KT 34816
#define CK_VT 53248
#define CK_PS 62464
#define CK_ST 71680
#define CK_CUM 89088
__device__ __forceinline__ bf16x8 ck_frag(const unsigned char* lds, int base, int pitch, int row, int kb, int q) {
    return *(const bf16x8*)(lds + base + row * pitch + (32 * kb + 8 * q) * 2);
}
template <int TYPE>
__device__ __forceinline__ void chunk_item(const Params& p, unsigned char* lds, int b, int h, int s) {
    int tid = threadIdx.x; asm volatile("" : "+v"(tid));
    const int w = tid >> 6, lane = tid & 63, r = lane & 15, q = lane >> 4;
    constexpr int LDP = TYPE < 2 ? LD0 : LD1;
    const bf16_t* proj = (const bf16_t*)(p.ws + WS_PROJ) + (size_t)(2048 * b) * LDP;
    bf16_t* yz = (bf16_t*)(p.ws + WS_YZ) + (size_t)(2048 * b) * 4096;
    const int I = w >> 1, Vn0 = 2 * (w & 1);
    const int c1 = tid & 127, tq = tid >> 7;
    const int cx = tid & 63, tx = tid >> 6;
    const int g = h >> 3;
    float cwC[4], cwB[4], cwX[4], cbC = 0.f, cbB = 0.f, cbX = 0.f, inv = 0.f, dtb = 0.f, Aneg = 0.f, Dh = 0.f, sstep = 0.f, cstep = 1.f;
    (void)sstep; (void)cstep;
    int colC = 0, colB = 0, colX = 0;
    if constexpr (TYPE == 0) {
        const int chC = 2560 + g * 128 + c1, chB = 2048 + g * 128 + c1, chX = h * 64 + cx;
        colC = 2048 + chC; colB = 2048 + chB; colX = 2048 + chX;
#pragma unroll
        for (int j = 0; j < 4; ++j) { cwC[j] = p.in[13 + p.z][j * 3072 + chC]; cwB[j] = p.in[13 + p.z][j * 3072 + chB]; cwX[j] = p.in[13 + p.z][j * 3072 + chX]; }
        cbC = p.in[14 + p.z][chC]; cbB = p.in[14 + p.z][chB]; cbX = p.in[14 + p.z][chX];
        dtb = p.in[15 + p.z][h]; Aneg = -__expf(p.in[16 + p.z][h]); Dh = p.in[17 + p.z][h];
    } else if constexpr (TYPE == 1) {
        const int isk = c1 >> 6, jf = c1 & 63;
        colC = (isk ? 6176 : 5152) + h * 128 + jf; colB = colC + 64; colX = 7200 + h * 256 + s * 64 + cx;
        inv = exp2f(-(float)jf * 0.20762050593046014f);
        { const float frs = inv * 0.15915494309189535f; sstep = __builtin_amdgcn_sinf(frs); cstep = __builtin_amdgcn_cosf(frs); }
    } else {
        colC = h * 128 + c1; colB = 2048 + h * 128 + c1; colX = 4096 + h * 128 + s * 64 + cx;
        inv = ((const float*)(p.ws + WS_LB))[h * 128 + c1];
    }
    float* cumb = (float*)(lds + CK_CUM);
    if constexpr (TYPE == 1) {
        const float lg = __logf(1.0f - exp2f(-5.0f - (float)h * (4.0f / 7.0f)));
        if (tid < 64) {
#pragma unroll
            for (int bfi = 0; bfi < 2; ++bfi) { float* cb = cumb + bfi * 320; cb[tid] = (tid + 1) * lg; cb[64 + tid] = __expf((tid + 1) * lg); cb[128 + tid] = __expf((63 - tid) * lg); cb[192 + tid] = 1.0f; if (tid == 0) cb[256] = __expf(64.0f * lg); }
        }
    }
    for (int i = tid; i < 17408 / 4; i += 512) ((unsigned*)(lds + CK_ST))[i] = 0u;
    f32x4 Sacc[4];
#pragma unroll
    for (int i = 0; i < 4; ++i) Sacc[i] = (f32x4){0.f, 0.f, 0.f, 0.f};
    unsigned short xc[19], xb[19], xx[11], zr[8], dr = 0;
    auto load_raw = [&](int c) {
        const int t0 = 64 * c;
        if constexpr (TYPE == 0) {
#pragma unroll
            for (int i = 0; i < 19; ++i) { const int t = t0 + 16 * tq - 3 + i; xc[i] = 0; xb[i] = 0; if (t >= 0) { xc[i] = proj[(size_t)t * LDP + colC]; xb[i] = proj[(size_t)t * LDP + colB]; } }
#pragma unroll
            for (int i = 0; i < 11; ++i) { const int t = t0 + 8 * tx - 3 + i; xx[i] = 0; if (t >= 0) xx[i] = proj[(size_t)t * LDP + colX]; }
            if (w == 7) dr = proj[(size_t)(t0 + lane) * LDP + 5120 + h];
#pragma unroll
            for (int vv = 0; vv < 2; ++vv)
#pragma unroll
                for (int jx = 0; jx < 4; ++jx) zr[vv * 4 + jx] = proj[(size_t)(t0 + 16 * I + 4 * q + jx) * LDP + h * 64 + 16 * (Vn0 + vv) + r];
        } else {
#pragma unroll
            for (int i = 0; i < 16; ++i) { const int t = t0 + 16 * tq + i; xc[i] = proj[(size_t)t * LDP + colC]; xb[i] = proj[(size_t)t * LDP + colB]; }
#pragma unroll
            for (int i = 0; i < 8; ++i) xx[i] = proj[(size_t)(t0 + 8 * tx + i) * LDP + colX];
        }
    };
    load_raw(0);
    for (int c = 0; c < 32; ++c) {
        const int t0 = 64 * c;
        float* cum = cumb + (TYPE == 0 ? (c & 1) * 320 : 0);
        float vq_[16], vk_[16], vx_[8], kt_[16], Eval = 0.f;
        (void)kt_; (void)Eval;
        if constexpr (TYPE == 0) {
#pragma unroll
            for (int i = 0; i < 16; ++i) {
                vq_[i] = silu(cbC + cwC[0] * bf2f(xc[i]) + cwC[1] * bf2f(xc[i + 1]) + cwC[2] * bf2f(xc[i + 2]) + cwC[3] * bf2f(xc[i + 3]));
                vk_[i] = silu(cbB + cwB[0] * bf2f(xb[i]) + cwB[1] * bf2f(xb[i + 1]) + cwB[2] * bf2f(xb[i + 2]) + cwB[3] * bf2f(xb[i + 3]));
            }
#pragma unroll
            for (int i = 0; i < 8; ++i) vx_[i] = silu(cbX + cwX[0] * bf2f(xx[i]) + cwX[1] * bf2f(xx[i + 1]) + cwX[2] * bf2f(xx[i + 2]) + cwX[3] * bf2f(xx[i + 3]));
            if (w == 7) {
                const float dt = softplus(bf2f(dr) + dtb);
                float cs = dt * Aneg;
#pragma unroll
                for (int o = 1; o < 64; o <<= 1) { const float t = __shfl_up(cs, o); if (lane >= o) cs += t; }
                const float last = __shfl(cs, 63);
                cum[lane] = cs; cum[64 + lane] = __expf(cs); cum[128 + lane] = __expf(last - cs); cum[192 + lane] = dt;
                if (lane == 0) cum[256] = __expf(last);
            }
        } else if constexpr (TYPE == 2) {
            float pr[16], om[16];
            float run = 1.f;
#pragma unroll
            for (int i = 0; i < 16; ++i) { const float f = inv + (1.0f - inv) * sigm(bf2f(xb[i])); run *= f; pr[i] = run; om[i] = 1.0f - f; }
#pragma unroll
            for (int i = 0; i < 16; ++i) { const float ip = __builtin_amdgcn_rcpf(pr[i]); vq_[i] = silu(bf2f(xc[i])) * pr[i]; vk_[i] = om[i] * ip; kt_[i] = om[i] * ip * run; }
            Eval = run;
#pragma unroll
            for (int i = 0; i < 8; ++i) vx_[i] = bf2f(xx[i]);
        } else {
            {
                const double rev = (double)(t0 + 16 * tq) * (double)inv * 0.15915494309189535;
                const float fr = (float)(rev - floor(rev));
                float sn = __builtin_amdgcn_sinf(fr), cs = __builtin_amdgcn_cosf(fr);
#pragma unroll
                for (int i = 0; i < 16; ++i) {
                    const float a1 = bf2f(xc[i]), a2 = bf2f(xb[i]);
                    vq_[i] = a1 * cs - a2 * sn; vk_[i] = a1 * sn + a2 * cs;
                    const float c2 = cs * cstep - sn * sstep, s2 = sn * cstep + cs * sstep;
                    cs = c2; sn = s2;
                }
            }
#pragma unroll
            for (int i = 0; i < 8; ++i) vx_[i] = bf2f(xx[i]);
        }
        unsigned short zc[8];
#pragma unroll
        for (int i = 0; i < 8; ++i) zc[i] = zr[i];
        __syncthreads();
        if constexpr (TYPE == 0) {
            unsigned kt[8];
#pragma unroll
            for (int i = 0; i < 16; i += 2) {
                const int t = 16 * tq + i;
                const float k0 = vk_[i] * cum[192 + t], k1 = vk_[i + 1] * cum[192 + t + 1];
                *(bf16_t*)(lds + CK_QS + t * 272 + c1 * 2) = f2bf(vq_[i]); *(bf16_t*)(lds + CK_QS + (t + 1) * 272 + c1 * 2) = f2bf(vq_[i + 1]);
                *(bf16_t*)(lds + CK_KS + t * 272 + c1 * 2) = f2bf(k0); *(bf16_t*)(lds + CK_KS + (t + 1) * 272 + c1 * 2) = f2bf(k1);
                kt[i >> 1] = pk2(k0 * cum[128 + t], k1 * cum[128 + t + 1]);
            }
            *(u32x4*)(lds + CK_KT + c1 * 144 + 32 * tq) = (u32x4){kt[0], kt[1], kt[2], kt[3]};
            *(u32x4*)(lds + CK_KT + c1 * 144 + 32 * tq + 16) = (u32x4){kt[4], kt[5], kt[6], kt[7]};
        } else if constexpr (TYPE == 2) {
            unsigned kt[8];
#pragma unroll
            for (int i = 0; i < 16; i += 2) {
                const int t = 16 * tq + i;
                *(bf16_t*)(lds + CK_QS + t * 272 + c1 * 2) = f2bf(vq_[i]); *(bf16_t*)(lds + CK_QS + (t + 1) * 272 + c1 * 2) = f2bf(vq_[i + 1]);
                *(bf16_t*)(lds + CK_KS + t * 272 + c1 * 2) = f2bf(vk_[i]); *(bf16_t*)(lds + CK_KS + (t + 1) * 272 + c1 * 2) = f2bf(vk_[i + 1]);
                kt[i >> 1] = pk2(kt_[i], kt_[i + 1]);
            }
            *(u32x4*)(lds + CK_KT + c1 * 144 + 32 * tq) = (u32x4){kt[0], kt[1], kt[2], kt[3]};
            *(u32x4*)(lds + CK_KT + c1 * 144 + 32 * tq + 16) = (u32x4){kt[4], kt[5], kt[6], kt[7]};
            cum[tq * 128 + c1] = Eval;
        } else {
            const int isk = c1 >> 6, jf = c1 & 63;
            if (isk == 0) {
#pragma unroll
                for (int i = 0; i < 16; ++i) { const int t = 16 * tq + i; *(bf16_t*)(lds + CK_QS + t * 272 + jf * 2) = f2bf(vq_[i]); *(bf16_t*)(lds + CK_QS + t * 272 + (jf + 64) * 2) = f2bf(vk_[i]); }
            } else {
                unsigned kta[8], ktb[8];
#pragma unroll
                for (int i = 0; i < 16; i += 2) {
                    const int t = 16 * tq + i;
                    const float a0 = vq_[i] * 0.08838834764831845f, a1 = vq_[i + 1] * 0.08838834764831845f, b0 = vk_[i] * 0.08838834764831845f, b1 = vk_[i + 1] * 0.08838834764831845f;
                    *(bf16_t*)(lds + CK_KS + t * 272 + jf * 2) = f2bf(a0); *(bf16_t*)(lds + CK_KS + (t + 1) * 272 + jf * 2) = f2bf(a1);
                    *(bf16_t*)(lds + CK_KS + t * 272 + (jf + 64) * 2) = f2bf(b0); *(bf16_t*)(lds + CK_KS + (t + 1) * 272 + (jf + 64) * 2) = f2bf(b1);
                    kta[i >> 1] = pk2(a0 * cum[128 + t], a1 * cum[128 + t + 1]); ktb[i >> 1] = pk2(b0 * cum[128 + t], b1 * cum[128 + t + 1]);
                }
                *(u32x4*)(lds + CK_KT + jf * 144 + 32 * tq) = (u32x4){kta[0], kta[1], kta[2], kta[3]};
                *(u32x4*)(lds + CK_KT + jf * 144 + 32 * tq + 16) = (u32x4){kta[4], kta[5], kta[6], kta[7]};
                *(u32x4*)(lds + CK_KT + (jf + 64) * 144 + 32 * tq) = (u32x4){ktb[0], ktb[1], ktb[2], ktb[3]};
                *(u32x4*)(lds + CK_KT + (jf + 64) * 144 + 32 * tq + 16) = (u32x4){ktb[4], ktb[5], ktb[6], ktb[7]};
            }
        }
        *(u32x4*)(lds + CK_VT + cx * 144 + 16 * tx) = (u32x4){pk2(vx_[0], vx_[1]), pk2(vx_[2], vx_[3]), pk2(vx_[4], vx_[5]), pk2(vx_[6], vx_[7])};
        __syncthreads();
        if (c + 1 < 32) load_raw(c + 1);
        if constexpr (TYPE < 2) {
        bf16x8 aQ[4];
#pragma unroll
        for (int kb = 0; kb < 4; ++kb) aQ[kb] = ck_frag(lds, CK_QS, 272, 16 * I + r, kb, q);
        float cumi[4];
#pragma unroll
        for (int jx = 0; jx < 4; ++jx) cumi[jx] = cum[16 * I + 4 * q + jx];
#pragma unroll
        for (int jj = 0; jj < 2; ++jj) {
            const int J = Vn0 + jj;
            f32x4 acc = (f32x4){0.f, 0.f, 0.f, 0.f};
#pragma unroll
            for (int kb = 0; kb < 4; ++kb) acc = __builtin_amdgcn_mfma_f32_16x16x32_bf16(aQ[kb], ck_frag(lds, CK_KS, 272, 16 * J + r, kb, q), acc, 0, 0, 0);
            const int jcol = 16 * J + r; const float cumj = cum[jcol];
#pragma unroll
            for (int jx = 0; jx < 4; ++jx) {
                const int i = 16 * I + 4 * q + jx;
                const float v = (jcol <= i) ? acc[jx] * __expf(fminf(cumi[jx] - cumj, 0.f)) : 0.f;
                *(bf16_t*)(lds + CK_PS + i * 144 + jcol * 2) = f2bf(v);
            }
        }
        __syncthreads();
#pragma unroll
        for (int vv = 0; vv < 2; ++vv) {
            const int Vn = Vn0 + vv;
            f32x4 aPV = (f32x4){0.f, 0.f, 0.f, 0.f}, aQS = (f32x4){0.f, 0.f, 0.f, 0.f};
#pragma unroll
            for (int jb = 0; jb < 2; ++jb) aPV = __builtin_amdgcn_mfma_f32_16x16x32_bf16(ck_frag(lds, CK_PS, 144, 16 * I + r, jb, q), ck_frag(lds, CK_VT, 144, 16 * Vn + r, jb, q), aPV, 0, 0, 0);
#pragma unroll
            for (int kb = 0; kb < 4; ++kb) aQS = __builtin_amdgcn_mfma_f32_16x16x32_bf16(aQ[kb], ck_frag(lds, CK_ST, 272, 16 * Vn + r, kb, q), aQS, 0, 0, 0);
#pragma unroll
            for (int jx = 0; jx < 4; ++jx) {
                const int i = 16 * I + 4 * q + jx, v = 16 * Vn + r;
                const float o = aPV[jx] + cum[64 + i] * aQS[jx];
                if constexpr (TYPE == 0) {
                    const float xsv = bf2f(*(const bf16_t*)(lds + CK_VT + v * 144 + i * 2));
                    yz[(size_t)(t0 + i) * 4096 + h * 64 + v] = f2bf((o + Dh * xsv) * silu(bf2f(zc[vv * 4 + jx])));
                } else {
                    yz[(size_t)(t0 + i) * 4096 + 2048 + h * 256 + s * 64 + v] = f2bf(o);
                }
            }
        }
        __syncthreads();
        const float elast = cum[256];
#pragma unroll
        for (int Vn = 0; Vn < 4; ++Vn) {
            Sacc[Vn] = Sacc[Vn] * elast;
#pragma unroll
            for (int tb = 0; tb < 2; ++tb) Sacc[Vn] = __builtin_amdgcn_mfma_f32_16x16x32_bf16(ck_frag(lds, CK_KT, 144, 16 * w + r, tb, q), ck_frag(lds, CK_VT, 144, 16 * Vn + r, tb, q), Sacc[Vn], 0, 0, 0);
            *(u32x2*)(lds + CK_ST + (16 * Vn + r) * 272 + (16 * w + 4 * q) * 2) = (u32x2){pk2_sw(Sacc[Vn][0], Sacc[Vn][1]), pk2_sw(Sacc[Vn][2], Sacc[Vn][3])};
        }
            } else {
            const bf16x8 zf = (bf16x8){0, 0, 0, 0, 0, 0, 0, 0};
            if ((w & 1) == 0) {
                f32x4 acc = (f32x4){0.f, 0.f, 0.f, 0.f};
#pragma unroll
                for (int kb = 0; kb < 4; ++kb) acc = __builtin_amdgcn_mfma_f32_16x16x32_bf16(ck_frag(lds, CK_QS, 272, 16 * I + r, kb, q), ck_frag(lds, CK_KS, 272, 16 * I + r, kb, q), acc, 0, 0, 0);
#pragma unroll
                for (int jx = 0; jx < 4; ++jx) {
                    const float v = (r <= 4 * q + jx) ? acc[jx] : 0.f;
                    *(bf16_t*)(lds + CK_PS + (16 * I + 4 * q + jx) * 144 + (16 * I + r) * 2) = f2bf(v);
                }
            }
            __syncthreads();
#pragma unroll
            for (int sc = 0; sc < 4; ++sc) {
                const int stb = sc == 0 ? CK_ST : (sc == 1 ? CK_KS : (sc == 2 ? 91648 : 109056));
                const f32x4 e4 = *(const f32x4*)(cum + sc * 128 + 16 * w + 4 * q);
                const bf16x8 ka = (q < 2) ? *(const bf16x8*)(lds + CK_KT + (16 * w + r) * 144 + (16 * sc + 8 * q) * 2) : zf;
#pragma unroll
                for (int Vn = 0; Vn < 4; ++Vn) {
                    *(u32x2*)(lds + stb + (16 * Vn + r) * 272 + (16 * w + 4 * q) * 2) = (u32x2){pk2_sw(Sacc[Vn][0], Sacc[Vn][1]), pk2_sw(Sacc[Vn][2], Sacc[Vn][3])};
                    const bf16x8 vb = (q < 2) ? *(const bf16x8*)(lds + CK_VT + (16 * Vn + r) * 144 + (16 * sc + 8 * q) * 2) : zf;
                    Sacc[Vn] = __builtin_amdgcn_mfma_f32_16x16x32_bf16(ka, vb, Sacc[Vn] * e4, 0, 0, 0);
                }
            }
            __syncthreads();
            {
                const int sc = I;
                const int stb = sc == 0 ? CK_ST : (sc == 1 ? CK_KS : (sc == 2 ? 91648 : 109056));
                const bf16x8 pa = (q < 2) ? *(const bf16x8*)(lds + CK_PS + (16 * sc + r) * 144 + (16 * sc + 8 * q) * 2) : zf;
                bf16x8 qa[4];
#pragma unroll
                for (int kb = 0; kb < 4; ++kb) qa[kb] = ck_frag(lds, CK_QS, 272, 16 * sc + r, kb, q);
#pragma unroll
                for (int vv = 0; vv < 2; ++vv) {
                    const int Vn = Vn0 + vv;
                    const bf16x8 vb = (q < 2) ? *(const bf16x8*)(lds + CK_VT + (16 * Vn + r) * 144 + (16 * sc + 8 * q) * 2) : zf;
                    f32x4 aO = __builtin_amdgcn_mfma_f32_16x16x32_bf16(pa, vb, (f32x4){0.f, 0.f, 0.f, 0.f}, 0, 0, 0);
#pragma unroll
                    for (int kb = 0; kb < 4; ++kb) aO = __builtin_amdgcn_mfma_f32_16x16x32_bf16(qa[kb], ck_frag(lds, stb, 272, 16 * Vn + r, kb, q), aO, 0, 0, 0);
#pragma unroll
                    for (int jx = 0; jx < 4; ++jx) yz[(size_t)(t0 + 16 * sc + 4 * q + jx) * 4096 + h * 128 + s * 64 + 16 * Vn + r] = (bf16_t)(pk2_sw(aO[jx], 0.f) & 0xffffu);
                }
            }
        }
    }
    const int ldS = TYPE == 0 ? 64 : (TYPE == 1 ? 256 : 128);
    float* Sout = p.out + (TYPE == 0 ? O_SSMP + ((size_t)(b * 32 + h) * 128) * 64 : (TYPE == 1 ? O_RETP + ((size_t)(b * 8 + h) * 128) * 256 + s * 64 : O_HGP + ((size_t)(b * 16 + h) * 128) * 128 + s * 64));
#pragma unroll
    for (int Vn = 0; Vn < 4; ++Vn)
#pragma unroll
        for (int jx = 0; jx < 4; ++jx) Sout[(size_t)(16 * w + 4 * q + jx) * ldS + 16 * Vn + r] = Sacc[Vn][jx];
}

__device__ __forceinline__ void lru_dec_unit(const Params& p, int b) {
    int tid = threadIdx.x; asm volatile("" : "+v"(tid));
    const int c = tid * 4;
    const int row0 = MP + 4 * b;
    const float* LA = (const float*)(p.ws + WS_LA) + (size_t)row0 * 2048 + c;
    const bf16_t* LBv = (const bf16_t*)(p.ws + WS_LBB) + (size_t)row0 * 2048 + c;
    const bf16_t* rg = (const bf16_t*)(p.ws + WS_PROJ) + (size_t)row0 * LD1 + 10240 + c;
    bf16_t* mixa = (bf16_t*)(p.ws + WS_ACT) + (size_t)row0 * 4096 + 2048 + c;
    f32x4 hst = *(const f32x4*)(p.in[6 + p.z] + (size_t)b * 2048 + c);
#pragma unroll
    for (int t = 0; t < 4; ++t) {
        const f32x4 a = *(const f32x4*)(LA + (size_t)t * 2048);
        float bb[4], gg[4]; unpack4(*(const u32x2*)(LBv + (size_t)t * 2048), bb); unpack4(*(const u32x2*)(rg + (size_t)t * LD1), gg);
        float y[4];
#pragma unroll
        for (int j = 0; j < 4; ++j) { hst[j] = a[j] * hst[j] + bb[j]; y[j] = hst[j] * gelu_tanh(gg[j]); }
        u32x2 ov; ov.x = pk2(y[0], y[1]); ov.y = pk2(y[2], y[3]);
        *(u32x2*)(mixa + (size_t)t * 4096) = ov;
    }
    *(f32x4*)(p.out + O_LRUS + (size_t)b * 2048 + c) = hst;
}

__device__ __forceinline__ void lru_scan_item(const Params& p, float* ldsf, int b, int cg) {
    int tid = threadIdx.x; asm volatile("" : "+v"(tid));
    const int w = tid >> 6, lane = tid & 63, c = cg * 64 + lane;
    const size_t row0 = (size_t)2048 * b + 256 * w;
    const float* LA = (const float*)(p.ws + WS_LA) + row0 * 2048 + c;
    const bf16_t* LBv = (const bf16_t*)(p.ws + WS_LBB) + row0 * 2048 + c;
    const bf16_t* rg = (const bf16_t*)(p.ws + WS_PROJ) + row0 * LD1 + 10240 + c;
    bf16_t* mixa = (bf16_t*)(p.ws + WS_ACT) + row0 * 4096 + 2048 + c;
    float hl = 0.f, pr = 1.f;
    for (int tb = 0; tb < 256; tb += 16) {
        float a0[16]; unsigned short b0[16];
#pragma unroll
        for (int t = 0; t < 16; ++t) { a0[t] = LA[(size_t)(tb + t) * 2048]; b0[t] = LBv[(size_t)(tb + t) * 2048]; }
#pragma unroll
        for (int t = 0; t < 16; ++t) { hl = a0[t] * hl + bf2f(b0[t]); pr *= a0[t]; }
    }
    ldsf[w * 128 + lane] = pr; ldsf[w * 128 + 64 + lane] = hl;
    __syncthreads();
    float hst = 0.f;
    for (int ww = 0; ww < w; ++ww) hst = ldsf[ww * 128 + lane] * hst + ldsf[ww * 128 + 64 + lane];
    for (int tb = 0; tb < 256; tb += 16) {
        float a0[16]; unsigned short b0[16], g0[16];
#pragma unroll
        for (int t = 0; t < 16; ++t) { a0[t] = LA[(size_t)(tb + t) * 2048]; b0[t] = LBv[(size_t)(tb + t) * 2048]; g0[t] = rg[(size_t)(tb + t) * LD1]; }
#pragma unroll
        for (int t = 0; t < 16; ++t) {
            hst = a0[t] * hst + bf2f(b0[t]);
            mixa[(size_t)(tb + t) * 4096] = f2bf(hst * gelu_tanh(bf2f(g0[t])));
        }
    }
    if (w == 7) p.out[O_LRUP + (size_t)b * 2048 + c] = hst;
}

__device__ __forceinline__ void phase_rec0(const Params& p, float* ldsf) {
    unsigned* ctr = (unsigned*)(p.ws + WS_CTL);
    const int total = 256 + 512 + 512;
    for (;;) {
        const int it = next_item(ctr, ldsf);
        if (it >= total) break;
        if (it < 128) chunk_item<0>(p, (unsigned char*)ldsf, it >> 5, it & 31, 0);
        else if (it < 256) { const int j = it - 128; chunk_item<1>(p, (unsigned char*)ldsf, j >> 5, (j & 31) >> 2, j & 3); }
        else if (it < 768) { const int j = it - 256; dec_unit<0>(p, ldsf, j >> 2, j & 3); }
        else { const int j = it - 768; dec_unit<1>(p, ldsf, j >> 2, j & 3); }
    }
}
__device__ __forceinline__ void phase_rec1(const Params& p, float* ldsf) {
    unsigned* ctr = (unsigned*)(p.ws + WS_CTL) + 64;
    const int total = 128 + 128 + 512 + 128;
    for (;;) {
        const int it = next_item(ctr, ldsf);
        if (it >= total) break;
        if (it < 128) chunk_item<2>(p, (unsigned char*)ldsf, it >> 5, (it & 31) >> 1, it & 1);
        else if (it < 256) { const int j = it - 128; lru_scan_item(p, ldsf, j >> 5, j & 31); }
        else if (it < 768) { const int j = it - 256; dec_unit<2>(p, ldsf, j >> 2, j & 3); }
        else lru_dec_unit(p, it - 768);
    }
}

__device__ __forceinline__ void seq_of_row(int row, int& sample, int& b, int& t, int& L) {
    if (row < MP) { sample = 0; b = row >> 11; t = row & 2047; L = 2048; } else { sample = 1; b = (row - MP) >> 2; t = (row - MP) & 3; L = 4; }
}

__device__ __forceinline__ void phase_prep0(const Params& p) {
    int tid = threadIdx.x; asm volatile("" : "+v"(tid));
    const int wave = tid >> 6, lane = tid & 63;
    const int gw = blockIdx.x * 8 + wave, NGW = gridDim.x * 8;
    const bf16_t* YZ = (const bf16_t*)(p.ws + WS_YZ); const bf16_t* PR = (const bf16_t*)(p.ws + WS_PROJ);
    bf16_t* MX = (bf16_t*)(p.ws + WS_ACT);
    const float* nw = p.in[18 + p.z];
    u32x4 nya[4]; u32x2 nyb[8], ngb[8];
    auto ldrow = [&](int row) {
#pragma unroll
        for (int g = 0; g < 4; ++g) nya[g] = __builtin_nontemporal_load((const u32x4*)(YZ + (size_t)row * 4096 + g * 512 + lane * 8));
#pragma unroll
        for (int hh = 0; hh < 8; ++hh) { nyb[hh] = __builtin_nontemporal_load((const u32x2*)(YZ + (size_t)row * 4096 + 2048 + hh * 256 + lane * 4)); ngb[hh] = __builtin_nontemporal_load((const u32x2*)(PR + (size_t)row * LD0 + 9248 + hh * 256 + lane * 4)); }
    };
    if (gw < MT) ldrow(gw);
    for (int row = gw; row < MT; row += NGW) {
        bf16_t* mx = MX + (size_t)row * 4096;
        u32x4 ya[4]; u32x2 yb[8], gb[8];
#pragma unroll
        for (int g = 0; g < 4; ++g) ya[g] = nya[g];
#pragma unroll
        for (int hh = 0; hh < 8; ++hh) { yb[hh] = nyb[hh]; gb[hh] = ngb[hh]; }
        if (row + NGW < MT) ldrow(row + NGW);
#pragma unroll
        for (int g = 0; g < 4; ++g) {
            const int c = g * 512 + lane * 8;
            float v[8]; unpack8(ya[g], v);
            float s = 0.f;
#pragma unroll
            for (int j = 0; j < 8; ++j) s += v[j] * v[j];
            s = wave_sum(s);
            const float rs = rsqrtf(s * (1.0f / 512.0f) + EPS);
            const f32x4 n0 = *(const f32x4*)(nw + c), n1 = *(const f32x4*)(nw + c + 4);
            u32x4 o; o.x = pk2(v[0] * rs * n0[0], v[1] * rs * n0[1]); o.y = pk2(v[2] * rs * n0[2], v[3] * rs * n0[3]);
            o.z = pk2(v[4] * rs * n1[0], v[5] * rs * n1[1]); o.w = pk2(v[6] * rs * n1[2], v[7] * rs * n1[3]);
            *(u32x4*)(mx + c) = o;
        }
#pragma unroll
        for (int hh = 0; hh < 8; ++hh) {
            const int c = hh * 256 + lane * 4;
            float v[4]; unpack4(yb[hh], v);
            float gt[4]; unpack4(gb[hh], gt);
            float s = (v[0] * v[0] + v[1] * v[1]) + (v[2] * v[2] + v[3] * v[3]);
            s = wave_sum(s);
            const float rs = rsqrtf(s * (1.0f / 256.0f) + EPS);
            u32x2 o; o.x = pk2(v[0] * rs * silu(gt[0]), v[1] * rs * silu(gt[1])); o.y = pk2(v[2] * rs * silu(gt[2]), v[3] * rs * silu(gt[3]));
            *(u32x2*)(mx + 2048 + c) = o;
        }
        int sample, b, t, L; seq_of_row(row, sample, b, t, L);
        if (t >= L - 3) {
            float* dst = p.out + (sample ? O_SCS : O_SCP) + ((size_t)b * 3 + (t - (L - 3))) * 3072;
            const bf16_t* src = PR + (size_t)row * LD0 + 2048;
#pragma unroll 4
            for (int c = lane; c < 3072; c += 64) dst[c] = bf2f(src[c]);
        }
    }
}

__device__ __forceinline__ void phase_prep1(const Params& p) {
    int tid = threadIdx.x; asm volatile("" : "+v"(tid));
    const int wave = tid >> 6, lane = tid & 63;
    const int gw = blockIdx.x * 8 + wave, NGW = gridDim.x * 8;
    const bf16_t* YZ = (const bf16_t*)(p.ws + WS_YZ); const bf16_t* PR = (const bf16_t*)(p.ws + WS_PROJ);
    bf16_t* MX = (bf16_t*)(p.ws + WS_ACT);
    const float* nw = p.in[22 + p.z];
    u32x4 nya[4], nga[4];
    auto ldrow = [&](int row) {
#pragma unroll
        for (int it = 0; it < 4; ++it) { nya[it] = __builtin_nontemporal_load((const u32x4*)(YZ + (size_t)row * 4096 + it * 512 + lane * 8)); nga[it] = __builtin_nontemporal_load((const u32x4*)(PR + (size_t)row * LD1 + 6144 + it * 512 + lane * 8)); }
    };
    if (gw < MT) ldrow(gw);
    for (int row = gw; row < MT; row += NGW) {
        u32x4 ya[4], ga[4];
#pragma unroll
        for (int it = 0; it < 4; ++it) { ya[it] = nya[it]; ga[it] = nga[it]; }
        if (row + NGW < MT) ldrow(row + NGW);
#pragma unroll
        for (int it = 0; it < 4; ++it) {
            const int c = it * 512 + lane * 8;
            float v[8]; unpack8(ya[it], v);
            float gt[8]; unpack8(ga[it], gt);
            float s = 0.f;
#pragma unroll
            for (int j = 0; j < 8; ++j) s += v[j] * v[j];
            s += __shfl_xor(s, 1); s += __shfl_xor(s, 2); s += __shfl_xor(s, 4); s += __shfl_xor(s, 8);
            const float rs = rsqrtf(s * (1.0f / 128.0f) + EPS);
            const f32x4 n0 = *(const f32x4*)(nw + (c & 127)), n1 = *(const f32x4*)(nw + (c & 127) + 4);
            float o[8];
#pragma unroll
            for (int j = 0; j < 8; ++j) o[j] = v[j] * rs * (j < 4 ? n0[j] : n1[j - 4]) * silu(gt[j]);
            u32x4 ov; ov.x = pk2(o[0], o[1]); ov.y = pk2(o[2], o[3]); ov.z = pk2(o[4], o[5]); ov.w = pk2(o[6], o[7]);
            *(u32x4*)(MX + (size_t)row * 4096 + c) = ov;
        }
    }
}

__device__ __forceinline__ void phase_act(const Params& p, int l) {
    int tid = threadIdx.x; asm volatile("" : "+v"(tid));
    const bf16_t* PR = (const bf16_t*)(p.ws + WS_PROJ); bf16_t* ACT = (bf16_t*)(p.ws + WS_ACT);
    const float* cw = p.in[32 + p.z] + (size_t)l * 3 * DFF; const float* cbv = p.in[33 + p.z] + (size_t)l * DFF;
    const float* st = p.in[8 + p.z] + (size_t)l * 128 * 2 * DFF;
    const int total = (MT / 4) * 704;
    for (int idx = blockIdx.x * 512 + tid; idx < total; idx += gridDim.x * 512) {
        const int rb = idx / 704, c = (idx - rb * 704) * 8, r0 = rb * 4;
        int sample, b, t0, L; seq_of_row(r0, sample, b, t0, L);
        u32x4 gr[6], ur[4];
#pragma unroll
        for (int i = 0; i < 4; ++i) { gr[i + 2] = *(const u32x4*)(PR + (size_t)(r0 + i) * LDU + c); ur[i] = __builtin_nontemporal_load((const u32x4*)(PR + (size_t)(r0 + i) * LDU + DFF + c)); }
        float g[6][8];
        if (t0 >= 2) { gr[0] = *(const u32x4*)(PR + (size_t)(r0 - 2) * LDU + c); gr[1] = *(const u32x4*)(PR + (size_t)(r0 - 1) * LDU + c); unpack8(gr[0], g[0]); unpack8(gr[1], g[1]); }
        else {
#pragma unroll
            for (int j = 0; j < 8; ++j) { g[0][j] = sample ? st[((size_t)b * 2 + 0) * DFF + c + j] : 0.f; g[1][j] = sample ? st[((size_t)b * 2 + 1) * DFF + c + j] : 0.f; }
        }
#pragma unroll
        for (int i = 0; i < 4; ++i) unpack8(gr[i + 2], g[i + 2]);
        float w0[8], w1[8], w2[8], bb[8];
#pragma unroll
        for (int j = 0; j < 8; ++j) { w0[j] = cw[c + j]; w1[j] = cw[DFF + c + j]; w2[j] = cw[2 * DFF + c + j]; bb[j] = cbv[c + j]; }
#pragma unroll
        for (int i = 0; i < 4; ++i) {
            float uu[8], o[8]; unpack8(ur[i], uu);
#pragma unroll
            for (int j = 0; j < 8; ++j) o[j] = silu(bb[j] + w0[j] * g[i][j] + w1[j] * g[i + 1][j] + w2[j] * g[i + 2][j]) * uu[j];
            u32x4 ov; ov.x = pk2(o[0], o[1]); ov.y = pk2(o[2], o[3]); ov.z = pk2(o[4], o[5]); ov.w = pk2(o[6], o[7]);
            *(u32x4*)(ACT + (size_t)(r0 + i) * DFF + c) = ov;
        }
        if (t0 + 4 == L) {
#pragma unroll
            for (int i = 0; i < 2; ++i) {
                float* dst = p.out + (sample ? O_FCS + (((size_t)l * 128 + b) * 2 + i) * DFF : O_FCP + (((size_t)l * 4 + b) * 2 + i) * DFF) + c;
                *(f32x4*)dst = (f32x4){g[4 + i][0], g[4 + i][1], g[4 + i][2], g[4 + i][3]}; *(f32x4*)(dst + 4) = (f32x4){g[4 + i][4], g[4 + i][5], g[4 + i][6], g[4 + i][7]};
            }
        }
    }
}

__device__ __forceinline__ void phase_lruconv(const Params& p) {
    int tid = threadIdx.x; asm volatile("" : "+v"(tid));
    const bf16_t* PR = (const bf16_t*)(p.ws + WS_PROJ); bf16_t* XR = (bf16_t*)(p.ws + WS_XR);
    const float* cw = p.in[23 + p.z]; const float* cbv = p.in[24 + p.z]; const float* st = p.in[7 + p.z];
    const int total = (MT / 4) * 256;
    for (int idx = blockIdx.x * 512 + tid; idx < total; idx += gridDim.x * 512) {
        const int rb = idx >> 8, c = (idx & 255) * 8, r0 = rb * 4;
        int sample, b, t0, L; seq_of_row(r0, sample, b, t0, L);
        float x[7][8];
#pragma unroll
        for (int j = 3; j < 7; ++j) unpack8(*(const u32x4*)(PR + (size_t)(r0 - 3 + j) * LD1 + 8192 + c), x[j]);
        if (t0 >= 3) {
#pragma unroll
            for (int j = 0; j < 3; ++j) unpack8(*(const u32x4*)(PR + (size_t)(r0 - 3 + j) * LD1 + 8192 + c), x[j]);
        } else {
#pragma unroll
            for (int j = 0; j < 3; ++j)
#pragma unroll
                for (int i = 0; i < 8; ++i) x[j][i] = sample ? st[((size_t)b * 3 + j) * 2048 + c + i] : 0.f;
        }
        float w0[8], w1[8], w2[8], w3[8], bb[8];
#pragma unroll
        for (int i = 0; i < 8; ++i) { w0[i] = cw[c + i]; w1[i] = cw[2048 + c + i]; w2[i] = cw[4096 + c + i]; w3[i] = cw[6144 + c + i]; bb[i] = cbv[c + i]; }
#pragma unroll
        for (int rr = 0; rr < 4; ++rr) {
            float o[8];
#pragma unroll
            for (int i = 0; i < 8; ++i) o[i] = bb[i] + w0[i] * x[rr][i] + w1[i] * x[rr + 1][i] + w2[i] * x[rr + 2][i] + w3[i] * x[rr + 3][i];
            u32x4 ov; ov.x = pk2(o[0], o[1]); ov.y = pk2(o[2], o[3]); ov.z = pk2(o[4], o[5]); ov.w = pk2(o[6], o[7]);
            *(u32x4*)(XR + (size_t)(r0 + rr) * 2048 + c) = ov;
        }
        if (t0 + 4 == L) {
#pragma unroll
            for (int j = 0; j < 3; ++j) {
                float* dst = p.out + (sample ? O_LCS : O_LCP) + ((size_t)b * 3 + j) * 2048 + c;
                *(f32x4*)dst = (f32x4){x[4 + j][0], x[4 + j][1], x[4 + j][2], x[4 + j][3]}; *(f32x4*)(dst + 4) = (f32x4){x[4 + j][4], x[4 + j][5], x[4 + j][6], x[4 + j][7]};
            }
        }
    }
}

template <int NS>
__device__ __forceinline__ void finalize_sample_rows(const Params& p, float* ssdst) {
    int tid = threadIdx.x; asm volatile("" : "+v"(tid));
    float* X = (float*)(p.ws + WS_X); bf16_t* XB = (bf16_t*)(p.ws + WS_XB); const float* PT = (const float*)(p.ws + WS_PROJ);
    for (int item = blockIdx.x * 512 + tid; item < 512 * 512; item += gridDim.x * 512) {
        const int row = item >> 9, c4 = item & 511;
        const unsigned o = (unsigned)(MP + row) * 2048u + (unsigned)c4 * 4u, po = (unsigned)row * 2048u + (unsigned)c4 * 4u;
        f32x4 v = *(const f32x4*)(X + o);
        f32x4 pv[NS];
#pragma unroll
        for (int ks = 0; ks < NS; ++ks) pv[ks] = __builtin_nontemporal_load((const f32x4*)(PT + (size_t)ks * (512 * 2048) + po));
#pragma unroll
        for (int ks = 0; ks < NS; ++ks) v += pv[ks];
        *(f32x4*)(X + o) = v;
        u32x2 w; w.x = pk2(v[0], v[1]); w.y = pk2(v[2], v[3]);
        *(u32x2*)(XB + o) = w;
        float s2 = (v[0] * v[0] + v[1] * v[1]) + (v[2] * v[2] + v[3] * v[3]);
        s2 = wave_sum(s2);
        if ((tid & 63) == 0) atomicAdd(ssdst + MP + row, s2);
    }
}

__device__ __forceinline__ void phase_final(const Params& p) {
    int tid = threadIdx.x; asm volatile("" : "+v"(tid));
    const int wave = tid >> 6, lane = tid & 63;
    const int gw = blockIdx.x * 8 + wave, NGW = gridDim.x * 8;
    const float* X = (const float*)(p.ws + WS_X); const float* nf = p.in[11 + p.z];
    f32x4 nv[8];
    auto ldrow = [&](int row) {
#pragma unroll
        for (int j = 0; j < 8; ++j) nv[j] = __builtin_nontemporal_load((const f32x4*)(X + (size_t)row * 2048 + (lane + 64 * j) * 4));
    };
    if (gw < MT) ldrow(gw);
    for (int row = gw; row < MT; row += NGW) {
        f32x4 v[8]; float sq = 0.f;
#pragma unroll
        for (int j = 0; j < 8; ++j) v[j] = nv[j];
        if (row + NGW < MT) ldrow(row + NGW);
        if (row >= MP) {
#pragma unroll
            for (int j = 0; j < 8; ++j) {
                f32x4 pv[11];
#pragma unroll
                for (int ks = 0; ks < 11; ++ks) pv[ks] = *(const f32x4*)((const float*)(p.ws + WS_PROJ) + (size_t)ks * (512 * 2048) + (size_t)(row - MP) * 2048 + (lane + 64 * j) * 4);
#pragma unroll
                for (int ks = 0; ks < 11; ++ks) v[j] += pv[ks];
            }
        }
#pragma unroll
        for (int j = 0; j < 8; ++j) sq += (v[j][0] * v[j][0] + v[j][1] * v[j][1]) + (v[j][2] * v[j][2] + v[j][3] * v[j][3]);
        sq = wave_sum(sq);
        const float rs = rsqrtf(sq * (1.0f / 2048.0f) + EPS);
        float* dst = p.out + (row < MP ? O_YP + (size_t)row * 2048 : O_YS + (size_t)(row - MP) * 2048);
#pragma unroll
        for (int j = 0; j < 8; ++j) {
            const int c = (lane + 64 * j) * 4;
            __builtin_nontemporal_store(v[j] * rs * *(const f32x4*)(nf + c), (f32x4*)(dst + c));
        }
    }
}

#define XB_TMO      128
#define XB_XCNT(j)  (256  + 64 * (j))
#define XB_XSUB(j)  (1280 + 64 * (j))
#define XB_XGEN(j)  (2304 + 64 * (j))
#define XB_TOP      3328
#define XB_TOPGEN   3392
#define XCD_BAR_WORDS 3456
#define XB_SPIN_CAP (1u << 22)
__device__ __forceinline__ unsigned xb_ld(unsigned* p)              { return __hip_atomic_load(p, __ATOMIC_RELAXED, __HIP_MEMORY_SCOPE_AGENT); }
__device__ __forceinline__ unsigned xb_add(unsigned* p, unsigned v) { return __hip_atomic_fetch_add(p, v, __ATOMIC_RELAXED, __HIP_MEMORY_SCOPE_AGENT); }
__device__ __forceinline__ unsigned xb_xcc_id() { return (unsigned)__builtin_amdgcn_s_getreg((3 << 11) | 20) & 0xFu; }
#define XB_SPIN(cond, bar) do { unsigned _sp = 0; while (cond) { __builtin_amdgcn_s_sleep(1); \
    if ((++_sp & 255u) == 0u) { if (xb_ld(&(bar)[XB_TMO])) break; if (_sp > XB_SPIN_CAP) { atomicAdd(&(bar)[XB_TMO], 1u); break; } } } } while (0)
struct XcdBarrier { unsigned* bar; unsigned x; volatile LAS unsigned* st; };
__device__ __forceinline__ XcdBarrier xcd_barrier_post(unsigned* bar, volatile LAS unsigned* st) {
    XcdBarrier b; b.bar = bar; b.x = xb_xcc_id(); b.st = st;
    if (threadIdx.x == 0) (void)xb_add(&bar[XB_XCNT(b.x)], 1u);
    return b;
}
__device__ __forceinline__ void xcd_barrier_complete(unsigned* bar, unsigned x, unsigned& nloc, unsigned& nx) {
    const unsigned G = gridDim.x * gridDim.y * gridDim.z;
    unsigned sum, cnt, mine, sp = 0u;
    for (;;) {
        sum = 0u; cnt = 0u; mine = 0u;
#pragma unroll
        for (unsigned j = 0; j < 16; ++j) { const unsigned c = xb_ld(&bar[XB_XCNT(j)]); sum += c; cnt += (c > 0u) ? 1u : 0u; mine = (j == x) ? c : mine; }
        if (sum == G) break;
        __builtin_amdgcn_s_sleep(1);
        if ((++sp & 255u) == 0u) { if (xb_ld(&bar[XB_TMO])) break; if (sp > XB_SPIN_CAP) { atomicAdd(&bar[XB_TMO], 1u); break; } }
    }
    nloc = mine > 0u ? mine : 1u; nx = cnt > 0u ? cnt : 1u;
}
__device__ __forceinline__ void xcd_barrier(const XcdBarrier& b) {
    asm volatile("s_waitcnt vmcnt(0)" ::: "memory");
    __syncthreads();
    if (threadIdx.x == 0) {
        unsigned* bar = b.bar;
        __builtin_amdgcn_s_waitcnt(0);
        unsigned nloc = b.st[0], nx = b.st[1];
        if (nloc == 0u) { xcd_barrier_complete(bar, b.x, nloc, nx); b.st[0] = nloc; b.st[1] = nx; }
        const unsigned old = xb_add(&bar[XB_XSUB(b.x)], 1u);
        const unsigned gen = old / nloc;
        if (old + 1u == (gen + 1u) * nloc) {
            __builtin_amdgcn_fence(__ATOMIC_RELEASE, "agent");
            asm volatile("s_waitcnt vmcnt(0)" ::: "memory");
            const unsigned og = xb_add(&bar[XB_TOP], 1u);
            const unsigned tg = og / nx;
            if (og + 1u == (tg + 1u) * nx) xb_add(&bar[XB_TOPGEN], 1u);
            else XB_SPIN(xb_ld(&bar[XB_TOPGEN]) == tg, bar);
            __builtin_amdgcn_fence(__ATOMIC_ACQUIRE, "agent");
            xb_add(&bar[XB_XGEN(b.x)], 1u);
            asm volatile("s_waitcnt vmcnt(0)" ::: "memory");
        } else {
            XB_SPIN(xb_ld(&bar[XB_XGEN(b.x)]) == gen, bar);
            __builtin_amdgcn_fence(__ATOMIC_ACQUIRE, "agent");
            asm volatile("s_waitcnt vmcnt(0)" ::: "memory");
        }
    }
    __syncthreads();
}

#ifndef PROBE_MASK
#define PROBE_MASK 0u
#endif
#ifndef PHMASK
#define PHMASK 0xFFFFFFFFu
#endif
#define EN(i) (((PHMASK) >> (i)) & 1u)
__global__ void __launch_bounds__(512, 2) fwd_megakernel(Params p) {
    extern __shared__ __attribute__((aligned(16))) unsigned char shm[];
    float* ldsf = (float*)shm;
    LAS unsigned char* ldsg = (LAS unsigned char*)shm;
    unsigned char* ws = p.ws;
    float* ssb = (float*)(ws + WS_SS);
    volatile LAS unsigned* xst = (volatile LAS unsigned*)(ldsg + 133120);
    if (threadIdx.x == 0) { xst[0] = 0u; xst[1] = 0u; }
    __syncthreads();
    (void)xcd_barrier_post((unsigned*)(ws + WS_CTL) + 256, xst);
#define XBAR() do { XcdBarrier _b; _b.bar = (unsigned*)(p.ws + WS_CTL) + 256; _b.x = xb_xcc_id(); _b.st = (volatile LAS unsigned*)((LAS unsigned char*)shm + 133120); xcd_barrier(_b); } while (0)
#if PROBE_MASK
    unsigned long long tph = __builtin_amdgcn_s_memrealtime();
#endif
    for (int ph = p.ph_lo; ph < p.ph_hi; ++ph) {
        if (ph > p.ph_lo) {
            if (ph == 1) cg::this_grid().sync();
            else XBAR();
#if PROBE_MASK
            {
                const unsigned long long t1 = __builtin_amdgcn_s_memrealtime();
                if ((PROBE_MASK >> (ph - 1)) & 1u) { const unsigned long long dt = t1 - tph; while (__builtin_amdgcn_s_memrealtime() - t1 < dt) __builtin_amdgcn_s_sleep(8); }
                tph = __builtin_amdgcn_s_memrealtime();
            }
#endif
        }
        if (EN(0) && ph == 0) phase_prologue(p, ldsf);
        else if (EN(1) && (ph == 1 || ph == 5 || ph == 8 || ph == 14)) {
            pg8::Gemm g; pg8::EpiScaleBf16 E; int N;
            if (ph != 1) { float* sd = ssb + (ph == 5 ? 1 : (ph == 8 ? 2 : 3)) * MT; if (ph == 8) finalize_sample_rows<11>(p, sd); else finalize_sample_rows<16>(p, sd); XBAR(); }
            g.A = (const char*)(ws + WS_XB); g.lda = 2048; g.ldb = 2048;
            if (ph == 1) { g.Bt = (const char*)(ws + WS_WIN0); N = LD0; E.ss = ssb; }
            else if (ph == 5) { g.Bt = (const char*)(ws + WS_WUP0); N = LDU; E.ss = ssb + MT; }
            else if (ph == 8) { g.Bt = (const char*)(ws + WS_WIN1); N = LD1; E.ss = ssb + 2 * MT; }
            else { g.Bt = (const char*)(ws + WS_WUP1); N = LDU; E.ss = ssb + 3 * MT; }
            E.O = (bf16_t*)(ws + WS_PROJ); E.ldc = N;
            pg8::Order S; S.nMm = 32; S.nN = N / 256; S.n_main = 32 * S.nN; S.n_tail = 2 * S.nN; S.ksplit = 1; S.nt_full = 32; S.G = gridDim.x; S.c = blockIdx.x;
            S.a_t = (size_t)256 * 2048 * 2; S.b_t = (size_t)256 * 2048 * 2; S.acol = 0;
            pg8::gemm_phase<pg8::EpiScaleBf16>(ldsg, g, S, E);
        }
        else if (EN(4) && (ph == 4 || ph == 7 || ph == 13 || ph == 16)) {
            pg8::Gemm g; pg8::EpiResid E;
            g.A = (const char*)(ws + WS_ACT);
            if (ph == 4) { g.Bt = (const char*)(ws + WS_WOUT0); g.lda = 4096; E.ssout = ssb + MT; }
            else if (ph == 7) { g.Bt = (const char*)(ws + WS_WDN0); g.lda = DFF; E.ssout = ssb + 2 * MT; }
            else if (ph == 13) { g.Bt = (const char*)(ws + WS_WOUT1); g.lda = 4096; E.ssout = ssb + 3 * MT; }
            else { g.Bt = (const char*)(ws + WS_WDN1); g.lda = DFF; E.ssout = ssb + 4 * MT; }
            g.ldb = g.lda;
            E.X = (float*)(ws + WS_X); E.XB = (bf16_t*)(ws + WS_XB); E.part = (float*)(ws + WS_PROJ);
            pg8::Order S; S.nMm = 32; S.nN = 8; S.n_main = 256; S.nt_full = g.lda / 64; S.ksplit = (g.lda == 4096) ? 16 : 11; S.n_tail = 16 * S.ksplit; S.G = gridDim.x; S.c = blockIdx.x;
            S.a_t = (size_t)256 * g.lda * 2; S.b_t = (size_t)256 * g.ldb * 2; S.acol = 0;
            pg8::gemm_phase<pg8::EpiResid>(ldsg, g, S, E);
        }
        else if (EN(10) && ph == 10) {
            pg8::Gemm g; pg8::EpiLru E;
            g.A = (const char*)(ws + WS_XR); g.Bt = (const char*)(ws + WS_WLRU); g.lda = 2048; g.ldb = 256;
            E.br = p.in[26 + p.z]; E.bi = p.in[28 + p.z]; E.sp = (const float*)(ws + WS_SP); E.XR = (const bf16_t*)(ws + WS_XR);
            E.LA = (float*)(ws + WS_LA); E.LBv = (bf16_t*)(ws + WS_LBB);
            pg8::Order S; S.nMm = 34; S.nN = 16; S.n_main = 34 * 16; S.n_tail = 0; S.ksplit = 1; S.nt_full = 4 + p.z; S.G = gridDim.x; S.c = blockIdx.x;
            S.a_t = (size_t)256 * 2048 * 2; S.b_t = (size_t)256 * 256 * 2; S.acol = 512;
            pg8::gemm_phase<pg8::EpiLru>(ldsg, g, S, E);
        }
        else if (EN(2) && ph == 2) phase_rec0(p, ldsf);
        else if (EN(3) && ph == 3) phase_prep0(p);
        else if (EN(6) && ph == 6) phase_act(p, 0);
        else if (EN(9) && ph == 9) phase_lruconv(p);
        else if (EN(11) && ph == 11) phase_rec1(p, ldsf);
        else if (EN(12) && ph == 12) phase_prep1(p);
        else if (EN(15) && ph == 15) phase_act(p, 1);
        else if (EN(17) && ph == 17) phase_final(p);
    }
}

#ifndef N_LAUNCH_MODE
#define N_LAUNCH_MODE 0
#endif

extern "C" void kernel_launch(void* const* d_in, const int* in_sizes, int n_in, void* d_out, int out_size, void* d_ws, size_t ws_size, hipStream_t stream) {
    static int grid = 0;
    if (grid == 0) {
        if (n_in != 35 || (size_t)out_size != O_END || ws_size < WS_END) { fprintf(stderr, "kernel_launch: unexpected shapes: n_in %d out %d ws %zu (need %zu)\n", n_in, out_size, ws_size, (size_t)WS_END); grid = -1; return; }
        int dev = 0, cus = 0, per_cu = 0;
        hipGetDevice(&dev);
        hipDeviceGetAttribute(&cus, hipDeviceAttributeMultiprocessorCount, dev);
        if (hipFuncSetAttribute((const void*)fwd_megakernel, hipFuncAttributeMaxDynamicSharedMemorySize, LDS_BYTES) != hipSuccess) { fprintf(stderr, "kernel_launch: hipFuncSetAttribute failed\n"); grid = -1; return; }
        if (hipOccupancyMaxActiveBlocksPerMultiprocessor(&per_cu, (const void*)fwd_megakernel, 512, LDS_BYTES) != hipSuccess || per_cu < 1) { fprintf(stderr, "kernel_launch: occupancy query says %d\n", per_cu); per_cu = 1; }
        (void)hipGetLastError();
        grid = cus;
    }
    if (grid < 0) return;
    (void)hipMemsetAsync((char*)d_ws + WS_CTL, 0, 16384, stream);
    Params p{};
    for (int i = 0; i < 35; ++i) p.in[i] = (const float*)d_in[i];
    p.z = 0; p.pad = 0;
    p.out = (float*)d_out; p.ws = (unsigned char*)d_ws;
#if N_LAUNCH_MODE == 0
    p.ph_lo = 0; p.ph_hi = NPHASE;
    void* args[] = {&p};
    hipError_t e = hipLaunchCooperativeKernel((const void*)fwd_megakernel, dim3(grid), dim3(512), args, LDS_BYTES, stream);
    if (e != hipSuccess) fprintf(stderr, "cooperative launch failed: %s (grid %d)\n", hipGetErrorString(e), grid);
#else
    for (int ph = 0; ph < NPHASE; ++ph) {
        p.ph_lo = ph; p.ph_hi = ph + 1;
        hipLaunchKernelGGL(fwd_megakernel, dim3(grid), dim3(512), LDS_BYTES, stream, p);
    }
#endif
}
```

```cpp
#include <hip/hip_runtime.h>
#include <hip/hip_cooperative_groups.h>
#include <cstdio>
#include <cstdint>
namespace cg = cooperative_groups;

#define LAS __attribute__((address_space(3)))
typedef unsigned short bf16_t;
typedef short bf16x8 __attribute__((ext_vector_type(8)));
typedef float f32x4 __attribute__((ext_vector_type(4)));
typedef float f32x2 __attribute__((ext_vector_type(2)));
typedef unsigned u32x4 __attribute__((ext_vector_type(4)));
typedef unsigned u32x2 __attribute__((ext_vector_type(2)));

constexpr int D = 2048, MP = 8192, MS = 512, MT = 8704;
constexpr int LD0 = 11520, LD1 = 12288, LDU = 11264, DFF = 5632;
constexpr float EPS = 1e-6f;
constexpr size_t O_YP = 0;
constexpr size_t O_YS = O_YP + (size_t)4 * 2048 * 2048;
constexpr size_t O_SSMP = O_YS + (size_t)128 * 4 * 2048;
constexpr size_t O_SSMS = O_SSMP + (size_t)4 * 32 * 128 * 64;
constexpr size_t O_SCP = O_SSMS + (size_t)128 * 32 * 128 * 64;
constexpr size_t O_SCS = O_SCP + (size_t)4 * 3 * 3072;
constexpr size_t O_RETP = O_SCS + (size_t)128 * 3 * 3072;
constexpr size_t O_RETS = O_RETP + (size_t)4 * 8 * 128 * 256;
constexpr size_t O_HGP = O_RETS + (size_t)128 * 8 * 128 * 256;
constexpr size_t O_HGS = O_HGP + (size_t)4 * 16 * 128 * 128;
constexpr size_t O_LRUP = O_HGS + (size_t)128 * 16 * 128 * 128;
constexpr size_t O_LRUS = O_LRUP + (size_t)4 * 2048;
constexpr size_t O_LCP = O_LRUS + (size_t)128 * 2048;
constexpr size_t O_LCS = O_LCP + (size_t)4 * 3 * 2048;
constexpr size_t O_FCP = O_LCS + (size_t)128 * 3 * 2048;
constexpr size_t O_FCS = O_FCP + (size_t)2 * 4 * 2 * 5632;
constexpr size_t O_END = O_FCS + (size_t)2 * 128 * 2 * 5632;
constexpr size_t al256(size_t x) { return (x + 255) & ~(size_t)255; }
constexpr size_t WS_CTL = 0;
constexpr size_t WS_SS = 16384;
constexpr size_t WS_SP = al256(WS_SS + (size_t)5 * MT * 4);
constexpr size_t WS_LB = WS_SP + 8192;
constexpr size_t WS_WIN0 = WS_LB + 8192;
constexpr size_t WS_WOUT0 = WS_WIN0 + (size_t)LD0 * 2048 * 2;
constexpr size_t WS_WUP0 = WS_WOUT0 + (size_t)2048 * 4096 * 2;
constexpr size_t WS_WDN0 = WS_WUP0 + (size_t)LDU * 2048 * 2;
constexpr size_t WS_WIN1 = WS_WDN0 + (size_t)2048 * DFF * 2;
constexpr size_t WS_WOUT1 = WS_WIN1 + (size_t)LD1 * 2048 * 2;
constexpr size_t WS_WUP1 = WS_WOUT1 + (size_t)2048 * 4096 * 2;
constexpr size_t WS_WDN1 = WS_WUP1 + (size_t)LDU * 2048 * 2;
constexpr size_t WS_WLRU = WS_WDN1 + (size_t)2048 * DFF * 2;
constexpr size_t WS_X = WS_WLRU + (size_t)16 * 256 * 256 * 2;
constexpr size_t WS_XB = WS_X + (size_t)MT * 2048 * 4;
constexpr size_t WS_PROJ = WS_XB + (size_t)MT * 2048 * 2;
constexpr size_t WS_ACT = WS_PROJ + (size_t)MT * LD1 * 2;
constexpr size_t WS_YZ = WS_ACT + (size_t)MT * DFF * 2;
constexpr size_t WS_LA = WS_YZ + (size_t)MT * 4096 * 2;
constexpr size_t WS_LBB = WS_LA + (size_t)MT * 2048 * 4;
constexpr size_t WS_XR = WS_LBB + (size_t)MT * 2048 * 2;
constexpr size_t WS_END = WS_XR + (size_t)MT * 2048 * 2;

constexpr int LDS_BYTES = 133120 + 256;
constexpr int NPHASE = 18;

struct Params {
    const float* in[35];
    float* out;
    unsigned char* ws;
    int ph_lo, ph_hi;
    int z, pad;
};

__device__ __forceinline__ float bf2f(unsigned v) { return __uint_as_float(v << 16); }
__device__ __forceinline__ unsigned pk2(float lo, float hi) { unsigned r; asm volatile("v_cvt_pk_bf16_f32 %0, %1, %2" : "=v"(r) : "v"(lo), "v"(hi)); return r; }
__device__ __forceinline__ unsigned pk2_sw(float lo, float hi) {
    unsigned a = __float_as_uint(lo), b = __float_as_uint(hi); a += 0x7fffu + ((a >> 16) & 1u); b += 0x7fffu + ((b >> 16) & 1u); return (a >> 16) | (b & 0xffff0000u); }
__device__ __forceinline__ bf16_t f2bf(float x) { return (bf16_t)(pk2(x, 0.f) & 0xffffu); }
__device__ __forceinline__ float sigm(float x) { return __builtin_amdgcn_rcpf(1.f + __expf(-x)); }
__device__ __forceinline__ float silu(float x) { return x * __builtin_amdgcn_rcpf(1.f + __expf(-x)); }
__device__ __forceinline__ float softplus(float x) { return fmaxf(x, 0.f) + log1pf(__expf(-fabsf(x))); }
__device__ __forceinline__ float gelu_tanh(float x) { const float u = 0.7978845608f * (x + 0.044715f * x * x * x); const float t = 1.f - 2.f * __builtin_amdgcn_rcpf(1.f + __expf(2.f * u)); return 0.5f * x * (1.f + t); }
__device__ __forceinline__ float wave_sum(float v) {
#pragma unroll
    for (int o = 1; o < 64; o <<= 1) v += __shfl_xor(v, o);
    return v;
}
__device__ __forceinline__ void unpack8(u32x4 r, float* f) {
    f[0] = bf2f(r.x & 0xffffu); f[1] = __uint_as_float(r.x & 0xffff0000u); f[2] = bf2f(r.y & 0xffffu); f[3] = __uint_as_float(r.y & 0xffff0000u);
    f[4] = bf2f(r.z & 0xffffu); f[5] = __uint_as_float(r.z & 0xffff0000u); f[6] = bf2f(r.w & 0xffffu); f[7] = __uint_as_float(r.w & 0xffff0000u);
}
__device__ __forceinline__ void unpack4(u32x2 r, float* f) {
    f[0] = bf2f(r.x & 0xffffu); f[1] = __uint_as_float(r.x & 0xffff0000u); f[2] = bf2f(r.y & 0xffffu); f[3] = __uint_as_float(r.y & 0xffff0000u);
}
#define LDS_WAIT() asm volatile("s_waitcnt lgkmcnt(0)" ::: "memory")

namespace pg8 {
constexpr int BM = 256, BK = 64, HALF = 128, HTB = HALF * BK * 2, NXCD = 8, WGM = 8;
__device__ __forceinline__ int lds_byte(int r, int c) { const int st = (r >> 4) * 2 + (c >> 5), rr = r & 15, cc = c & 31, ob = rr * 64 + cc * 2; return st * 1024 + (ob ^ (((ob >> 9) & 1) << 5)); }
__device__ __forceinline__ void stage_rc(int b, int& R, int& C) { const int st = b / 1024, sb = b % 1024, swz = sb ^ (((sb >> 9) & 1) << 5); R = (st >> 1) * 16 + swz / 64; C = (st & 1) * 32 + (swz % 64) / 2; }
__device__ __forceinline__ int perm32(int rho) { const int n = rho >> 4, i = rho & 15; return 8 * (i >> 2) + 4 * n + (i & 3); }

struct Unit { int pm, pn, nt, kind, ks; size_t aoff, boff; };
struct Gemm { const char* A; const char* Bt; int lda, ldb; };
struct Order {
    int nMm, nN, n_main, n_tail, ksplit, nt_full, G, c; size_t a_t, b_t, acol;
    __device__ __forceinline__ bool next(int i, Unit& u) const {
        const long L = (long)i * G + c;
        if (L < n_main) {
            const int nwg = n_main;
            int wgid = (int)L; { const int q = nwg / NXCD, r = nwg % NXCD, xcd = wgid % NXCD, off = wgid / NXCD; wgid = (xcd < r ? xcd * (q + 1) : r * (q + 1) + (xcd - r) * q) + off; }
            const int nig = WGM * nN, gid = wgid / nig, fm = gid * WGM, gsz = (nMm - fm) < WGM ? (nMm - fm) : WGM;
            u.pm = fm + ((wgid % nig) % gsz); u.pn = (wgid % nig) / gsz; u.nt = nt_full; u.kind = 0; u.ks = 0;
            u.aoff = (size_t)u.pm * a_t + (size_t)(u.pn >> 1) * acol; u.boff = (size_t)u.pn * b_t; return true;
        }
        const int Lt = (int)(L - n_main); if (Lt >= n_tail) return false;
        const int ks = Lt % ksplit, r = Lt / ksplit;
        u.pm = nMm + (r & 1); u.pn = r >> 1; u.nt = nt_full / ksplit; u.kind = ksplit > 1 ? 1 : 0; u.ks = ks;
        const size_t kofs = (size_t)ks * u.nt * (BK * 2);
        u.aoff = (size_t)u.pm * a_t + (size_t)(u.pn >> 1) * acol + kofs; u.boff = (size_t)u.pn * b_t + kofs; return true;
    }
};

struct EpiScaleBf16 {
    static constexpr bool PERM = true;
    bf16_t* O; int ldc; const float* ss;
    __device__ __forceinline__ void prefetch(const Unit& u, int wr, int fr, float (&ssv)[8]) const {
        const int row0 = u.pm * BM + wr * 64 + fr;
#pragma unroll
        for (int ai = 0; ai < 2; ++ai)
#pragma unroll
            for (int m = 0; m < 4; ++m) ssv[ai * 4 + m] = ss[row0 + ai * HALF + m * 16];
    }
    __device__ __forceinline__ void operator()(const f32x4 (&acc)[2][2][4][2], const Unit& u, int wr, int wc, int fr, int fq, const float (&ssv)[8]) const {
        const int row0 = u.pm * BM + wr * 64 + fr, col0 = u.pn * BM + wc * 32 + 8 * fq;
#pragma unroll
        for (int ai = 0; ai < 2; ++ai)
#pragma unroll
            for (int m = 0; m < 4; ++m) {
                const int row = row0 + ai * HALF + m * 16;
                const float rs = rsqrtf(ssv[ai * 4 + m] * (1.0f / 2048.0f) + EPS);
                bf16_t* rowp = O + ((unsigned)row * (unsigned)ldc + (unsigned)col0);
#pragma unroll
                for (int bj = 0; bj < 2; ++bj) {
                    const f32x4 v0 = acc[ai][bj][m][0] * rs, v1 = acc[ai][bj][m][1] * rs;
                    u32x4 w; w.x = pk2(v0[0], v0[1]); w.y = pk2(v0[2], v0[3]); w.z = pk2(v1[0], v1[1]); w.w = pk2(v1[2], v1[3]);
                    *(u32x4*)(rowp + bj * HALF) = w;
                }
            }
    }
};
struct EpiResid {
    static constexpr bool PERM = false;
    float* X; bf16_t* XB; float* ssout; float* part;
    __device__ __forceinline__ void prefetch(const Unit&, int, int, float (&)[8]) const {}
    __device__ __forceinline__ void operator()(const f32x4 (&acc)[2][2][4][2], const Unit& u, int wr, int wc, int fr, int fq, const float (&)[8]) const {
        const int row0 = u.pm * BM + wr * 64 + fr, col0 = u.pn * BM + wc * 32 + 4 * fq;
        if (u.kind == 1) {
            float* P = part + (size_t)u.ks * (512 * 2048);
#pragma unroll
            for (int ai = 0; ai < 2; ++ai)
#pragma unroll
                for (int m = 0; m < 4; ++m) {
                    const unsigned off = (unsigned)(row0 - MP + ai * HALF + m * 16) * 2048u + (unsigned)col0;
#pragma unroll
                    for (int bj = 0; bj < 2; ++bj)
#pragma unroll
                        for (int n = 0; n < 2; ++n) *(f32x4*)(P + off + bj * HALF + n * 16) = acc[ai][bj][m][n];
                }
            return;
        }
#pragma unroll
        for (int ai = 0; ai < 2; ++ai)
#pragma unroll
            for (int mp = 0; mp < 4; mp += 2) {
                f32x4 xin[2][2][2];
#pragma unroll
                for (int mm = 0; mm < 2; ++mm)
#pragma unroll
                    for (int bj = 0; bj < 2; ++bj)
#pragma unroll
                        for (int n = 0; n < 2; ++n) xin[mm][bj][n] = *(const f32x4*)(X + ((unsigned)(row0 + ai * HALF + (mp + mm) * 16) * 2048u + (unsigned)col0 + bj * HALF + n * 16));
#pragma unroll
                for (int mm = 0; mm < 2; ++mm) {
                    const int row = row0 + ai * HALF + (mp + mm) * 16;
                    const unsigned off = (unsigned)row * 2048u + (unsigned)col0;
                    float sq = 0.f;
#pragma unroll
                    for (int bj = 0; bj < 2; ++bj)
#pragma unroll
                        for (int n = 0; n < 2; ++n) {
                            const unsigned o = off + bj * HALF + n * 16;
                            const f32x4 x = xin[mm][bj][n] + acc[ai][bj][mp + mm][n];
                            *(f32x4*)(X + o) = x;
                            u32x2 w; w.x = pk2(x[0], x[1]); w.y = pk2(x[2], x[3]);
                            *(u32x2*)(XB + o) = w;
                            sq += (x[0] * x[0] + x[1] * x[1]) + (x[2] * x[2] + x[3] * x[3]);
                        }
                    sq += __shfl_xor(sq, 16); sq += __shfl_xor(sq, 32);
                    if (fq == 0) atomicAdd(ssout + row, sq);
                }
                asm volatile("" ::: "memory");
            }
    }
};
struct EpiLru {
    static constexpr bool PERM = false;
    const float* br; const float* bi; const float* sp; const bf16_t* XR; float* LA; bf16_t* LBv;
    __device__ __forceinline__ void prefetch(const Unit&, int, int, float (&)[8]) const {}
    __device__ __forceinline__ void operator()(const f32x4 (&acc)[2][2][4][2], const Unit& u, int wr, int wc, int fr, int fq, const float (&)[8]) const {
        const int row0 = u.pm * BM + wr * 64 + fr;
        const int cbase = (u.pn >> 1) * 256 + (u.pn & 1) * 128 + wc * 32 + 4 * fq;
        f32x4 br4[2], bi4[2], sp4[2];
#pragma unroll
        for (int n = 0; n < 2; ++n) { br4[n] = *(const f32x4*)(br + cbase + n * 16); bi4[n] = *(const f32x4*)(bi + cbase + n * 16); sp4[n] = *(const f32x4*)(sp + cbase + n * 16); }
#pragma unroll
        for (int ai = 0; ai < 2; ++ai)
#pragma unroll
            for (int mp = 0; mp < 4; mp += 2) {
                u32x2 xrr[2][2];
#pragma unroll
                for (int mm = 0; mm < 2; ++mm)
#pragma unroll
                    for (int n = 0; n < 2; ++n) xrr[mm][n] = *(const u32x2*)(XR + ((unsigned)(row0 + ai * HALF + (mp + mm) * 16) * 2048u + (unsigned)(cbase + n * 16)));
#pragma unroll
                for (int mm = 0; mm < 2; ++mm) {
                    const int row = row0 + ai * HALF + (mp + mm) * 16;
                    const bool first = (row < MP) && ((row & 2047) == 0);
#pragma unroll
                    for (int n = 0; n < 2; ++n) {
                        const unsigned o = (unsigned)row * 2048u + (unsigned)(cbase + n * 16);
                        float xr[4]; unpack4(xrr[mm][n], xr);
                        f32x4 av; float bb[4];
#pragma unroll
                        for (int j = 0; j < 4; ++j) {
                            const float r = sigm(acc[ai][0][mp + mm][n][j] + br4[n][j]), gi = sigm(acc[ai][1][mp + mm][n][j] + bi4[n][j]);
                            const float la = -8.0f * r * sp4[n][j];
                            const float a = __expf(la);
                            const float mult = first ? 1.0f : __builtin_amdgcn_sqrtf(fmaxf(1.0f - a * a, 0.f));
                            av[j] = a; bb[j] = mult * gi * xr[j];
                        }
                        *(f32x4*)(LA + o) = av;
                        u32x2 w; w.x = pk2(bb[0], bb[1]); w.y = pk2(bb[2], bb[3]);
                        *(u32x2*)(LBv + o) = w;
                    }
                }
                asm volatile("" ::: "memory");
            }
    }
};

template <class Epi>
__device__ __forceinline__ void gemm_phase(LAS unsigned char* lds, const Gemm g, const Order& S, const Epi& E) {
    int tid = threadIdx.x; asm volatile("" : "+v"(tid));
    const int wid = __builtin_amdgcn_readfirstlane(tid >> 6), lane = tid & 63, wr = wid >> 2, wc = wid & 3, fr = lane & 15, fq = lane >> 4;
    unsigned voffA[2], voffB[2];
#pragma unroll
    for (int i = 0; i < 2; ++i) { int R, C; stage_rc(tid * 16 + i * 8192, R, C); const int Rb = Epi::PERM ? ((R & ~31) + perm32(R & 31)) : R;
        voffA[i] = (unsigned)(R * g.lda + C) * 2u; voffB[i] = (unsigned)(Rb * g.ldb + C) * 2u; }
    const size_t kstep = (size_t)(BK * 2);
    const size_t hstepA = (size_t)HALF * g.lda * 2, hstepB = (size_t)HALF * g.ldb * 2;
    const unsigned ldsw = (unsigned)wid * 1024u;
    const int aoff = lds_byte(wr * 64 + fr, fq * 8), boff = lds_byte(wc * 32 + fr, fq * 8);
#define PG8_SA(b, h) (((b) * 2 + (h)) * HTB)
#define PG8_SB(b, h) ((4 + (b) * 2 + (h)) * HTB)
#define PG8_STAGE(bufoff, gbase, voff) do { _Pragma("unroll") for (int _i = 0; _i < 2; ++_i) \
        __builtin_amdgcn_global_load_lds((const unsigned*)((const char*)(gbase) + (voff)[_i]), (LAS unsigned*)(lds + (bufoff) + ldsw + _i * 8192), 16, 0, 0); } while (0)
#define PG8_LDA(dst, b, h) do { _Pragma("unroll") for (int m = 0; m < 4; ++m) _Pragma("unroll") for (int k = 0; k < 2; ++k) dst[m][k] = *(const LAS bf16x8*)(lds + PG8_SA(b, h) + aoff + m * 2048 + k * 1024); } while (0)
#define PG8_LDB(dst, b, h) do { _Pragma("unroll") for (int n = 0; n < 2; ++n) _Pragma("unroll") for (int k = 0; k < 2; ++k) dst[n][k] = *(const LAS bf16x8*)(lds + PG8_SB(b, h) + boff + n * 2048 + k * 1024); } while (0)
#define PG8_MMA(ai, bj, At, Bt) do { __builtin_amdgcn_s_setprio(1); _Pragma("unroll") for (int m = 0; m < 4; ++m) _Pragma("unroll") for (int n = 0; n < 2; ++n) _Pragma("unroll") for (int k = 0; k < 2; ++k) \
        acc[ai][bj][m][n] = __builtin_amdgcn_mfma_f32_16x16x32_bf16(Bt[n][k], At[m][k], acc[ai][bj][m][n], 0, 0, 0); __builtin_amdgcn_s_setprio(0); } while (0)
#define PG8_WAIT_V(n) asm volatile("s_waitcnt vmcnt(" #n ")" ::: "memory")
#define PG8_WAIT_L(n) asm volatile("s_waitcnt lgkmcnt(" #n ")" ::: "memory")
#define PG8_BAR __builtin_amdgcn_s_barrier()
#define PG8_SCHED __builtin_amdgcn_sched_barrier(0)
    Unit cur, nxt; int ui = 0;
    if (!S.next(0, cur)) return;
    f32x4 acc[2][2][4][2];
#pragma unroll
    for (int a = 0; a < 2; ++a)
#pragma unroll
        for (int b = 0; b < 2; ++b)
#pragma unroll
            for (int m = 0; m < 4; ++m)
#pragma unroll
                for (int n = 0; n < 2; ++n) acc[a][b][m][n] = (f32x4){0.f, 0.f, 0.f, 0.f};
    bf16x8 At[4][2], B0[2][2], B1[2][2];
    const char* cA = g.A + cur.aoff; const char* cB = g.Bt + cur.boff;
    float epf[8] = {0.f, 0.f, 0.f, 0.f, 0.f, 0.f, 0.f, 0.f};
    E.prefetch(cur, wr, fr, epf);
    PG8_STAGE(PG8_SB(0, 0), cB, voffB); PG8_STAGE(PG8_SA(0, 0), cA, voffA); PG8_STAGE(PG8_SB(0, 1), cB + hstepB, voffB); PG8_STAGE(PG8_SA(0, 1), cA + hstepA, voffA);
    if (wr == 1) PG8_BAR;
    PG8_WAIT_V(4); PG8_BAR;
    PG8_STAGE(PG8_SB(1, 0), cB + kstep, voffB); PG8_STAGE(PG8_SA(1, 0), cA + kstep, voffA); PG8_STAGE(PG8_SB(1, 1), cB + hstepB + kstep, voffB);
    PG8_WAIT_V(6); PG8_BAR;
    for (;;) {
        const bool has_next = S.next(ui + 1, nxt);
        const char* nA = has_next ? g.A + nxt.aoff : cA; const char* nB = has_next ? g.Bt + nxt.boff : cB;
        const int nt = cur.nt;
        for (int t = 0; t < nt; t += 2) {
            const bool last = (t == nt - 2);
            const char* a1 = cA + (size_t)(t + 1) * kstep;
            const char* a2 = last ? nA : cA + (size_t)(t + 2) * kstep; const char* b2 = last ? nB : cB + (size_t)(t + 2) * kstep;
            const char* a3 = a2 + kstep; const char* b3 = b2 + kstep;
            PG8_LDB(B0, 0, 0); PG8_SCHED; PG8_LDA(At, 0, 0); PG8_STAGE(PG8_SA(1, 1), a1 + hstepA, voffA);
            PG8_WAIT_L(8); PG8_BAR; PG8_WAIT_L(0); PG8_MMA(0, 0, At, B0); PG8_BAR; PG8_SCHED;
            PG8_LDB(B1, 0, 1); PG8_STAGE(PG8_SB(0, 0), b2, voffB);
            PG8_BAR; PG8_WAIT_L(0); PG8_MMA(0, 1, At, B1); PG8_BAR;
            PG8_LDA(At, 0, 1); PG8_STAGE(PG8_SA(0, 0), a2, voffA);
            PG8_BAR; PG8_WAIT_L(0); PG8_MMA(1, 0, At, B0); PG8_BAR; PG8_SCHED;
            PG8_STAGE(PG8_SB(0, 1), b2 + hstepB, voffB);
            PG8_WAIT_V(6); PG8_BAR; PG8_MMA(1, 1, At, B1); PG8_BAR;
            PG8_LDB(B0, 1, 0); PG8_SCHED; PG8_LDA(At, 1, 0); PG8_STAGE(PG8_SA(0, 1), a2 + hstepA, voffA);
            PG8_WAIT_L(8); PG8_BAR; PG8_WAIT_L(0); PG8_MMA(0, 0, At, B0); PG8_BAR; PG8_SCHED;
            PG8_LDB(B1, 1, 1); PG8_STAGE(PG8_SB(1, 0), b3, voffB);
            PG8_BAR; PG8_WAIT_L(0); PG8_MMA(0, 1, At, B1); PG8_BAR;
            PG8_LDA(At, 1, 1); PG8_STAGE(PG8_SA(1, 0), a3, voffA);
            PG8_BAR; PG8_WAIT_L(0); PG8_MMA(1, 0, At, B0); PG8_BAR; PG8_SCHED;
            PG8_STAGE(PG8_SB(1, 1), b3 + hstepB, voffB);
            PG8_WAIT_V(6); PG8_BAR; PG8_MMA(1, 1, At, B1); PG8_BAR;
        }
        if (wr == 0) PG8_BAR;
        E(acc, cur, wr, wc, fr, fq, epf);
        if (!has_next) break;
#pragma unroll
        for (int a = 0; a < 2; ++a)
#pragma unroll
            for (int b = 0; b < 2; ++b)
#pragma unroll
                for (int m = 0; m < 4; ++m)
#pragma unroll
                    for (int n = 0; n < 2; ++n) acc[a][b][m][n] = (f32x4){0.f, 0.f, 0.f, 0.f};
        cur = nxt; cA = nA; cB = nB; ++ui;
        E.prefetch(cur, wr, fr, epf);
        if (wr == 1) PG8_BAR;
    }
    PG8_WAIT_V(0);
    PG8_BAR;
#undef PG8_SA
#undef PG8_SB
#undef PG8_STAGE
#undef PG8_LDA
#undef PG8_LDB
#undef PG8_MMA
#undef PG8_WAIT_V
#undef PG8_WAIT_L
#undef PG8_BAR
#undef PG8_SCHED
}
}

__device__ __forceinline__ void tr_item(const float* __restrict__ W, int ldw, int N, int k0, int n0, const float* __restrict__ scale, bf16_t* __restrict__ dst, int ldd, float* scr, int lane) {
    const int r4 = lane >> 4, c4 = (lane & 15) * 4;
    const bool inb = (n0 + c4) < N;
    f32x4 v[16];
#pragma unroll
    for (int i = 0; i < 16; ++i) v[i] = inb ? __builtin_nontemporal_load((const f32x4*)(W + (size_t)(k0 + 4 * i + r4) * ldw + n0 + c4)) : (f32x4){0.f, 0.f, 0.f, 0.f};
#pragma unroll
    for (int i = 0; i < 16; ++i) { float* d = scr + (4 * i + r4) * 65 + c4; d[0] = v[i][0]; d[1] = v[i][1]; d[2] = v[i][2]; d[3] = v[i][3]; }
    LDS_WAIT();
    const int c = lane & 7;
    f32x4 s0 = (f32x4){1.f, 1.f, 1.f, 1.f}, s1 = s0;
    if (scale) { s0 = *(const f32x4*)(scale + k0 + 8 * c); s1 = *(const f32x4*)(scale + k0 + 8 * c + 4); }
#pragma unroll
    for (int j = 0; j < 8; ++j) { const int n = (lane >> 3) + 8 * j; const float* sp = scr + (8 * c) * 65 + n;
        u32x4 o; o.x = pk2(sp[0 * 65] * s0[0], sp[1 * 65] * s0[1]); o.y = pk2(sp[2 * 65] * s0[2], sp[3 * 65] * s0[3]); o.z = pk2(sp[4 * 65] * s1[0], sp[5 * 65] * s1[1]); o.w = pk2(sp[6 * 65] * s1[2], sp[7 * 65] * s1[3]);
        *(u32x4*)(dst + (size_t)n * ldd + 8 * c) = o; }
    LDS_WAIT();
}

__device__ __forceinline__ void phase_prologue(const Params& p, float* ldsf) {
    int tid = threadIdx.x; asm volatile("" : "+v"(tid));
    const int wave = tid >> 6, lane = tid & 63;
    const int gw = blockIdx.x * 8 + wave, NGW = gridDim.x * 8;
    float* scr = ldsf + wave * 4160;
    unsigned char* ws = p.ws;
    constexpr int I0 = 32 * 177, I1 = 64 * 32, I2 = 32 * 176, I3 = 88 * 32, I4 = 32 * 192, I5 = I1, I6 = I2, I7 = I3, I8 = 128, I9 = 128;
    constexpr int NIT = I0 + I1 + I2 + I3 + I4 + I5 + I6 + I7 + I8 + I9;
    for (int it = gw; it < NIT; it += NGW) {
        int r = it;
        const float* W; int K, N; const float* sc = nullptr; bf16_t* WT;
        if (r < I0) { W = p.in[12 + p.z]; K = 2048; N = 11296; sc = p.in[9 + p.z]; WT = (bf16_t*)(ws + WS_WIN0); }
        else if ((r -= I0) < I1) { W = p.in[19 + p.z]; K = 4096; N = 2048; WT = (bf16_t*)(ws + WS_WOUT0); }
        else if ((r -= I1) < I2) { W = p.in[31 + p.z]; K = 2048; N = 11264; sc = p.in[10 + p.z]; WT = (bf16_t*)(ws + WS_WUP0); }
        else if ((r -= I2) < I3) { W = p.in[34 + p.z]; K = 5632; N = 2048; WT = (bf16_t*)(ws + WS_WDN0); }
        else if ((r -= I3) < I4) { W = p.in[20 + p.z]; K = 2048; N = 12288; sc = p.in[9 + p.z] + 2048; WT = (bf16_t*)(ws + WS_WIN1); }
        else if ((r -= I4) < I5) { W = p.in[30 + p.z]; K = 4096; N = 2048; WT = (bf16_t*)(ws + WS_WOUT1); }
        else if ((r -= I5) < I6) { W = p.in[31 + p.z] + (size_t)2048 * 11264; K = 2048; N = 11264; sc = p.in[10 + p.z] + 2048; WT = (bf16_t*)(ws + WS_WUP1); }
        else if ((r -= I6) < I7) { W = p.in[34 + p.z] + (size_t)5632 * 2048; K = 5632; N = 2048; WT = (bf16_t*)(ws + WS_WDN1); }
        else {
            r -= I7; const int which = r >> 7; r &= 127;
            const int blk = r >> 4, kb = (r >> 2) & 3, nb = r & 3, n0 = 64 * nb, k0 = 64 * kb;
            const float* Wl = (which ? p.in[27 + p.z] : p.in[25 + p.z]) + (size_t)blk * 65536;
            const int drow = (blk * 2 + (n0 >> 7)) * 256 + which * 128 + (n0 & 127);
            tr_item(Wl, 256, 256, k0, n0, nullptr, (bf16_t*)(ws + WS_WLRU) + (size_t)drow * 256 + k0, 256, scr, lane);
            continue;
        }
        const int nblk = (N + 63) / 64, kbl = r & 7, r8 = r >> 3, nb = r8 % nblk, kb = (r8 / nblk) * 8 + kbl, k0 = 64 * kb, n0 = 64 * nb;
        tr_item(W, N, N, k0, n0, sc, WT + (size_t)n0 * K + k0, K, scr, lane);
    }
    {
        u32x4* z = (u32x4*)((bf16_t*)(ws + WS_WIN0) + (size_t)11296 * 2048);
        const int n16 = 224 * 2048 * 2 / 16;
        for (int i = blockIdx.x * 512 + tid; i < n16; i += gridDim.x * 512) z[i] = (u32x4){0u, 0u, 0u, 0u};
    }
    float* X = (float*)(ws + WS_X); bf16_t* XB = (bf16_t*)(ws + WS_XB); float* ss = (float*)(ws + WS_SS);
    for (int row = gw; row < MT; row += NGW) {
        const float* src = row < MP ? p.in[0 + p.z] + (size_t)row * 2048 : p.in[1 + p.z] + (size_t)(row - MP) * 2048;
        float s = 0.f;
#pragma unroll
        for (int j = 0; j < 8; ++j) {
            const f32x4 v = __builtin_nontemporal_load((const f32x4*)(src + (lane + 64 * j) * 4));
            *(f32x4*)(X + (size_t)row * 2048 + (lane + 64 * j) * 4) = v;
            u32x2 w; w.x = pk2(v[0], v[1]); w.y = pk2(v[2], v[3]);
            *(u32x2*)(XB + (size_t)row * 2048 + (lane + 64 * j) * 4) = w;
            s += (v[0] * v[0] + v[1] * v[1]) + (v[2] * v[2] + v[3] * v[3]);
        }
        s = wave_sum(s);
        if (lane == 0) ss[row] = s;
    }
    for (int i = blockIdx.x * 512 + tid; i < 4 * MT; i += gridDim.x * 512) ss[MT + i] = 0.f;
    for (int i = blockIdx.x * 512 + tid; i < 2048; i += gridDim.x * 512) {
        ((float*)(ws + WS_SP))[i] = softplus(-p.in[29 + p.z][i]);
        ((float*)(ws + WS_LB))[i] = sigm(p.in[21 + p.z][2048 + i] - p.in[21 + p.z][i]);
    }
}

__device__ __forceinline__ int next_item(unsigned* ctr, float* ldsf) {
    __syncthreads();
    if (threadIdx.x == 0) ((volatile unsigned*)ldsf)[33284] = atomicAdd(ctr, 1u);
    __syncthreads();
    return (int)((volatile unsigned*)ldsf)[33284];
}

template <int TYPE, int VW>
__device__ __forceinline__ void rec_item(const Params& p, float* ldsf, int sample, int b, int h, int s) {
    constexpr int NV = VW / 16;
    typedef float VT __attribute__((ext_vector_type(NV)));
    int tid = threadIdx.x; asm volatile("" : "+v"(tid));
    const int w = tid >> 6, lane = tid & 63, kg = lane >> 4, vq = lane & 15, kb = 16 * w + 4 * kg;
    const int L = sample ? 4 : 2048, row0 = sample ? MP + 4 * b : 2048 * b, pos0 = sample ? 16384 : 0;
    constexpr int LDP = TYPE < 2 ? LD0 : LD1;
    const bf16_t* proj = (const bf16_t*)(p.ws + WS_PROJ) + (size_t)row0 * LDP;
    bf16_t* yz = (bf16_t*)(p.ws + WS_YZ) + (size_t)row0 * 4096;
    float* part = ldsf + 8192;
    int colA = -1, colB = -1, role = -1, didx = 0;
    float w0 = 0.f, w1 = 0.f, w2 = 0.f, w3 = 0.f, cbias = 0.f, c0 = 0.f, c1 = 0.f, c2 = 0.f, aux = 0.f, aux2 = 0.f;
    if constexpr (TYPE == 0) {
        if (tid < 320) {
            role = tid < 128 ? 0 : (tid < 256 ? 1 : 2);
            didx = tid < 128 ? tid : (tid < 256 ? tid - 128 : tid - 256);
            const int ch = tid < 128 ? 2560 + (h >> 3) * 128 + tid : (tid < 256 ? 2048 + (h >> 3) * 128 + (tid - 128) : h * 64 + (tid - 256));
            colA = 2048 + ch;
            const float* cw = p.in[13 + p.z];
            w0 = cw[ch]; w1 = cw[3072 + ch]; w2 = cw[2 * 3072 + ch]; w3 = cw[3 * 3072 + ch]; cbias = p.in[14 + p.z][ch];
            if (sample) { const float* st = p.in[3 + p.z] + (size_t)b * 3 * 3072; c0 = st[ch]; c1 = st[3072 + ch]; c2 = st[2 * 3072 + ch]; }
        } else if (tid < 328) { role = 3; didx = tid - 320; colA = 5120 + h; aux = p.in[15 + p.z][h]; aux2 = -__expf(p.in[16 + p.z][h]); }
    } else if constexpr (TYPE == 1) {
        if (tid < 128) { role = tid < 64 ? 0 : 1; didx = tid & 63; colA = (tid < 64 ? 5152 : 6176) + h * 128 + didx; colB = colA + 64;
            aux = exp2f(-(float)didx * 0.20762050593046014f); }
        else if (tid < 128 + VW) { role = 2; didx = tid - 128; colA = 7200 + h * 256 + s * VW + didx; }
    } else {
        if (tid < 128) { role = 0; didx = tid; colA = h * 128 + tid; }
        else if (tid < 256) { role = 1; didx = tid - 128; colA = 2048 + h * 128 + didx; aux = ((const float*)(p.ws + WS_LB))[h * 128 + didx]; }
        else if (tid < 256 + VW) { role = 2; didx = tid - 256; colA = 4096 + h * 128 + s * VW + didx; }
    }
    const float Dh = TYPE == 0 ? p.in[17 + p.z][h] : 0.f;
    const float gamma = TYPE == 1 ? 1.0f - exp2f(-5.0f - (float)h * (4.0f / 7.0f)) : 0.f;
    const int ldS = TYPE == 0 ? 64 : (TYPE == 1 ? 256 : 128);
    size_t soff;
    if constexpr (TYPE == 0) soff = ((size_t)(b * 32 + h) * 128) * 64;
    else if constexpr (TYPE == 1) soff = ((size_t)(b * 8 + h) * 128) * 256 + s * VW;
    else soff = ((size_t)(b * 16 + h) * 128) * 128 + s * VW;
    const float* S0 = TYPE == 0 ? p.in[2 + p.z] : (TYPE == 1 ? p.in[4 + p.z] : p.in[5 + p.z]);
    float* Sout = p.out + (TYPE == 0 ? (sample ? O_SSMS : O_SSMP) : (TYPE == 1 ? (sample ? O_RETS : O_RETP) : (sample ? O_HGS : O_HGP))) + soff;
    VT S[4];
#pragma unroll
    for (int i = 0; i < 4; ++i) { if (sample) S[i] = *(const VT*)(S0 + soff + (size_t)(kb + i) * ldS + NV * vq); else S[i] = (VT)(0.f); }
    unsigned short ra[8], rb[8]; unsigned short zr = 0;
    const int R = (L + 7) >> 3;
    auto load_raw = [&](int r) {
#pragma unroll
        for (int t = 0; t < 8; ++t) {
            const int tt = 8 * r + t;
            ra[t] = 0; rb[t] = 0;
            if (tt < L) {
                if (colA >= 0) ra[t] = proj[(size_t)tt * LDP + colA];
                if (TYPE == 1 && colB >= 0) rb[t] = proj[(size_t)tt * LDP + colB];
            }
        }
        if (TYPE == 0) { const int tt = 8 * r + w; if (tt < L) zr = proj[(size_t)tt * LDP + h * 64 + lane]; }
    };
    load_raw(0);
    for (int r = 0; r < R; ++r) {
        const int nv = (L - 8 * r) < 8 ? (L - 8 * r) : 8;
        float* stg = ldsf + (r & 1) * 4096;
        float* qs = stg; float* ks = stg + 1024; float* as = stg + 2048; float* vs = stg + 3072; float* ad = stg + 3584;
        if constexpr (TYPE == 0) {
            if (role >= 0 && role < 3) {
                float* dst = role == 0 ? qs : (role == 1 ? ks : vs); const int dstr = role == 2 ? 64 : 128;
#pragma unroll
                for (int t = 0; t < 8; ++t) {
                    const float x = bf2f(ra[t]);
                    const float y = cbias + w0 * c0 + w1 * c1 + w2 * c2 + w3 * x;
                    c0 = c1; c1 = c2; c2 = x;
                    dst[t * dstr + didx] = silu(y);
                }
            } else if (role == 3) {
                float xv = 0.f;
#pragma unroll
                for (int t = 0; t < 8; ++t) if (t == didx) xv = bf2f(ra[t]);
                const float dt = softplus(xv + aux);
                ad[2 * didx] = __expf(dt * aux2); ad[2 * didx + 1] = dt;
            }
        } else if constexpr (TYPE == 1) {
            if (role == 0 || role == 1) {
                float* dst = role == 0 ? qs : ks; const float sc = role == 0 ? 1.0f : 0.08838834764831845f;
#pragma unroll
                for (int t = 0; t < 8; ++t) {
                    const int pos = pos0 + 8 * r + t;
                    const double rev = (double)pos * (double)aux * 0.15915494309189535;
                    const float fr = (float)(rev - floor(rev));
                    const float sn = __builtin_amdgcn_sinf(fr), cs = __builtin_amdgcn_cosf(fr);
                    const float x1 = bf2f(ra[t]) * sc, x2 = bf2f(rb[t]) * sc;
                    dst[t * 128 + didx] = x1 * cs - x2 * sn;
                    dst[t * 128 + 64 + didx] = x1 * sn + x2 * cs;
                }
            } else if (role == 2) {
#pragma unroll
                for (int t = 0; t < 8; ++t) vs[t * VW + didx] = bf2f(ra[t]);
            }
        } else {
            if (role == 0) {
#pragma unroll
                for (int t = 0; t < 8; ++t) qs[t * 128 + didx] = silu(bf2f(ra[t]));
            } else if (role == 1) {
#pragma unroll
                for (int t = 0; t < 8; ++t) { const float f = aux + (1.0f - aux) * sigm(bf2f(ra[t])); as[t * 128 + didx] = f; ks[t * 128 + didx] = 1.0f - f; }
            } else if (role == 2) {
#pragma unroll
                for (int t = 0; t < 8; ++t) vs[t * VW + didx] = bf2f(ra[t]);
            }
        }
        const unsigned short zc = zr;
        __syncthreads();
        if (r + 1 < R) load_raw(r + 1);
        for (int t0 = 0; t0 < nv; t0 += 4) {
#pragma unroll
            for (int tt = 0; tt < 4; ++tt) {
                const int t = t0 + tt;
                const f32x4 q4 = *(const f32x4*)(qs + t * 128 + kb);
                f32x4 k4 = *(const f32x4*)(ks + t * 128 + kb);
                const VT v4 = *(const VT*)(vs + t * VW + NV * vq);
                f32x4 a4;
                if constexpr (TYPE == 0) { const f32x2 adv = *(const f32x2*)(ad + 2 * t); a4 = (f32x4){adv.x, adv.x, adv.x, adv.x}; k4 = k4 * adv.y; }
                else if constexpr (TYPE == 1) a4 = (f32x4){gamma, gamma, gamma, gamma};
                else a4 = *(const f32x4*)(as + t * 128 + kb);
                VT o = (VT)(0.f);
#pragma unroll
                for (int i = 0; i < 4; ++i) { S[i] = a4[i] * S[i] + k4[i] * v4; o += q4[i] * S[i]; }
                *(VT*)(part + ((t * 32 + w * 4 + kg) * VW + NV * vq)) = o;
            }
        }
        __syncthreads();
        const int rt = tid / VW, rv = tid % VW;
        if (tid < 8 * VW && rt < nv) {
            float o = 0.f;
#pragma unroll
            for (int pp = 0; pp < 32; ++pp) o += part[(rt * 32 + pp) * VW + rv];
            const size_t trow = (size_t)(8 * r + rt);
            if constexpr (TYPE == 0) {
                const float y = (o + Dh * vs[rt * 64 + rv]) * silu(bf2f(zc));
                yz[trow * 4096 + h * 64 + rv] = f2bf(y);
            } else if constexpr (TYPE == 1) {
                yz[trow * 4096 + 2048 + h * 256 + s * VW + rv] = f2bf(o);
            } else {
                yz[trow * 4096 + h * 128 + s * VW + rv] = f2bf(o);
            }
        }
    }
#pragma unroll
    for (int i = 0; i < 4; ++i) *(VT*)(Sout + (size_t)(kb + i) * ldS + NV * vq) = S[i];
}

template <int TYPE>
__device__ __forceinline__ void dec_unit(const Params& p, float* ldsf, int b, int u, unsigned* ctr, unsigned& nx) {
    int tid = threadIdx.x; asm volatile("" : "+v"(tid));
    const int w = tid >> 6, lane = tid & 63, kg = lane >> 4, vq = lane & 15;
    const int row0 = MP + 4 * b;
    constexpr int LDP = TYPE < 2 ? LD0 : LD1;
    const bf16_t* proj = (const bf16_t*)(p.ws + WS_PROJ) + (size_t)row0 * LDP;
    bf16_t* yz = (bf16_t*)(p.ws + WS_YZ) + (size_t)row0 * 4096;
    int h, sl; size_t soff; int ldS;
    if constexpr (TYPE == 0) { h = 8 * u + w; sl = 0; ldS = 64; soff = ((size_t)(b * 32 + h) * 128) * 64; }
    else if constexpr (TYPE == 1) { h = 2 * u + (w >> 2); sl = w & 3; ldS = 256; soff = ((size_t)(b * 8 + h) * 128) * 256 + sl * 64; }
    else { h = 4 * u + (w >> 1); sl = w & 1; ldS = 128; soff = ((size_t)(b * 16 + h) * 128) * 128 + sl * 64; }
    const float* S0 = (TYPE == 0 ? p.in[2 + p.z] : (TYPE == 1 ? p.in[4 + p.z] : p.in[5 + p.z])) + soff + (size_t)(32 * kg) * ldS + 4 * vq;
    float* Sout = p.out + (TYPE == 0 ? O_SSMS : (TYPE == 1 ? O_RETS : O_HGS)) + soff + (size_t)(32 * kg) * ldS + 4 * vq;
    if constexpr (TYPE == 0) {
        float* qs = ldsf; float* ks = ldsf + 512; float* xs = ldsf + 1024; float* zs = ldsf + 3072; float* ad = ldsf + 5120;
        unsigned short xr[2][4]; float cw[2][4], cb[2], st[2][3]; unsigned short zr[4]; unsigned short dr = 0;
#pragma unroll
        for (int q = 0; q < 2; ++q) {
            const int idx = tid + 512 * q;
            if (idx < 768) {
                const int ch = idx < 128 ? 2560 + u * 128 + idx : (idx < 256 ? 2048 + u * 128 + (idx - 128) : u * 512 + (idx - 256));
#pragma unroll
                for (int t = 0; t < 4; ++t) xr[q][t] = proj[(size_t)t * LDP + 2048 + ch];
#pragma unroll
                for (int j = 0; j < 4; ++j) cw[q][j] = p.in[13 + p.z][j * 3072 + ch];
                cb[q] = p.in[14 + p.z][ch];
#pragma unroll
                for (int j = 0; j < 3; ++j) st[q][j] = p.in[3 + p.z][((size_t)b * 3 + j) * 3072 + ch];
            }
        }
#pragma unroll
        for (int t = 0; t < 4; ++t) zr[t] = proj[(size_t)t * LDP + u * 512 + tid];
        if (tid < 32) dr = proj[(size_t)(tid >> 3) * LDP + 5120 + 8 * u + (tid & 7)];
        f32x4 S[32];
#pragma unroll
        for (int i = 0; i < 32; ++i) S[i] = __builtin_nontemporal_load((const f32x4*)(S0 + (size_t)i * ldS));
#pragma unroll
        for (int q = 0; q < 2; ++q) {
            const int idx = tid + 512 * q;
            if (idx < 768) {
                float* dst = idx < 128 ? qs + idx : (idx < 256 ? ks + (idx - 128) : xs + (idx - 256));
                const int dstr = idx < 256 ? 128 : 512;
                float c0 = st[q][0], c1 = st[q][1], c2 = st[q][2];
#pragma unroll
                for (int t = 0; t < 4; ++t) {
                    const float x = bf2f(xr[q][t]);
                    const float y = cb[q] + cw[q][0] * c0 + cw[q][1] * c1 + cw[q][2] * c2 + cw[q][3] * x;
                    c0 = c1; c1 = c2; c2 = x;
                    dst[t * dstr] = silu(y);
                }
            }
        }
#pragma unroll
        for (int t = 0; t < 4; ++t) zs[t * 512 + tid] = silu(bf2f(zr[t]));
        if (tid < 32) {
            const int hh = 8 * u + (tid & 7);
            const float dt = softplus(bf2f(dr) + p.in[15 + p.z][hh]);
            ad[2 * tid] = __expf(-dt * __expf(p.in[16 + p.z][hh])); ad[2 * tid + 1] = dt;
        }
        __syncthreads();
        const float Dh = p.in[17 + p.z][h];
#pragma unroll 1
        for (int t = 0; t < 4; ++t) {
            const f32x2 adv = *(const f32x2*)(ad + 2 * (t * 8 + w));
            const f32x4 v4 = *(const f32x4*)(xs + t * 512 + w * 64 + 4 * vq);
            f32x4 o = (f32x4){0.f, 0.f, 0.f, 0.f};
#pragma unroll
            for (int i4 = 0; i4 < 8; ++i4) {
                const f32x4 q4 = *(const f32x4*)(qs + t * 128 + 32 * kg + 4 * i4);
                const f32x4 k4 = *(const f32x4*)(ks + t * 128 + 32 * kg + 4 * i4) * adv.y;
#pragma unroll
                for (int ii = 0; ii < 4; ++ii) { S[4 * i4 + ii] = adv.x * S[4 * i4 + ii] + k4[ii] * v4; o += q4[ii] * S[4 * i4 + ii]; }
            }
#pragma unroll
            for (int j = 0; j < 4; ++j) { o[j] += __shfl_xor(o[j], 16); o[j] += __shfl_xor(o[j], 32); }
            if (kg == 0) {
                const f32x4 z4 = *(const f32x4*)(zs + t * 512 + w * 64 + 4 * vq);
                const f32x4 y = (o + Dh * v4) * z4;
                u32x2 ov; ov.x = pk2(y[0], y[1]); ov.y = pk2(y[2], y[3]);
                *(u32x2*)(yz + (size_t)t * 4096 + h * 64 + 4 * vq) = ov;
            }
        }
        if (tid == 0) nx = atomicAdd(ctr, 1u);
#pragma unroll
        for (int i = 0; i < 32; ++i) __builtin_nontemporal_store(S[i], (f32x4*)(Sout + (size_t)i * ldS));
    } else if constexpr (TYPE == 1) {
        float* qs = ldsf; float* ks = ldsf + 1024; float* vs = ldsf + 2048;
        unsigned short x1[4], x2[4], vr[4];
        const int hl = tid >> 7, isk = (tid >> 6) & 1, jf = tid & 63;
        if (tid < 256) {
            const int col = (isk ? 6176 : 5152) + (2 * u + hl) * 128 + jf;
#pragma unroll
            for (int t = 0; t < 4; ++t) { x1[t] = proj[(size_t)t * LDP + col]; x2[t] = proj[(size_t)t * LDP + col + 64]; }
        }
#pragma unroll
        for (int t = 0; t < 4; ++t) vr[t] = proj[(size_t)t * LDP + 7200 + (2 * u + (tid >> 8)) * 256 + (tid & 255)];
        f32x4 S[32];
#pragma unroll
        for (int i = 0; i < 32; ++i) S[i] = __builtin_nontemporal_load((const f32x4*)(S0 + (size_t)i * ldS));
        if (tid < 256) {
            const float inv = exp2f(-(float)jf * 0.20762050593046014f);
            float* dst = isk ? ks : qs; const float sc = isk ? 0.08838834764831845f : 1.0f;
#pragma unroll
            for (int t = 0; t < 4; ++t) {
                const double rev = (double)(16384 + t) * (double)inv * 0.15915494309189535;
                const float fr = (float)(rev - floor(rev));
                const float sn = __builtin_amdgcn_sinf(fr), cs = __builtin_amdgcn_cosf(fr);
                const float a1 = bf2f(x1[t]) * sc, a2 = bf2f(x2[t]) * sc;
                dst[(t * 2 + hl) * 128 + jf] = a1 * cs - a2 * sn;
                dst[(t * 2 + hl) * 128 + 64 + jf] = a1 * sn + a2 * cs;
            }
        }
#pragma unroll
        for (int t = 0; t < 4; ++t) vs[(t * 2 + (tid >> 8)) * 256 + (tid & 255)] = bf2f(vr[t]);
        __syncthreads();
        const float gamma = 1.0f - exp2f(-5.0f - (float)h * (4.0f / 7.0f));
        const int hw = w >> 2;
#pragma unroll 1
        for (int t = 0; t < 4; ++t) {
            const f32x4 v4 = *(const f32x4*)(vs + (t * 2 + hw) * 256 + sl * 64 + 4 * vq);
            f32x4 o = (f32x4){0.f, 0.f, 0.f, 0.f};
#pragma unroll
            for (int i4 = 0; i4 < 8; ++i4) {
                const f32x4 q4 = *(const f32x4*)(qs + (t * 2 + hw) * 128 + 32 * kg + 4 * i4);
                const f32x4 k4 = *(const f32x4*)(ks + (t * 2 + hw) * 128 + 32 * kg + 4 * i4);
#pragma unroll
                for (int ii = 0; ii < 4; ++ii) { S[4 * i4 + ii] = gamma * S[4 * i4 + ii] + k4[ii] * v4; o += q4[ii] * S[4 * i4 + ii]; }
            }
#pragma unroll
            for (int j = 0; j < 4; ++j) { o[j] += __shfl_xor(o[j], 16); o[j] += __shfl_xor(o[j], 32); }
            if (kg == 0) {
                u32x2 ov; ov.x = pk2(o[0], o[1]); ov.y = pk2(o[2], o[3]);
                *(u32x2*)(yz + (size_t)t * 4096 + 2048 + h * 256 + sl * 64 + 4 * vq) = ov;
            }
        }
        if (tid == 0) nx = atomicAdd(ctr, 1u);
#pragma unroll
        for (int i = 0; i < 32; ++i) __builtin_nontemporal_store(S[i], (f32x4*)(Sout + (size_t)i * ldS));
    } else {
        float* qs = ldsf; float* ks = ldsf + 2048; float* as = ldsf + 4096; float* vs = ldsf + 6144;
        unsigned short qr[4], fr_[4], vr[4];
        const int hl = tid >> 7, kk = tid & 127, col = (4 * u + hl) * 128 + kk;
#pragma unroll
        for (int t = 0; t < 4; ++t) { qr[t] = proj[(size_t)t * LDP + col]; fr_[t] = proj[(size_t)t * LDP + 2048 + col]; vr[t] = proj[(size_t)t * LDP + 4096 + col]; }
        const float lb = ((const float*)(p.ws + WS_LB))[col];
        f32x4 S[32];
#pragma unroll
        for (int i = 0; i < 32; ++i) S[i] = __builtin_nontemporal_load((const f32x4*)(S0 + (size_t)i * ldS));
#pragma unroll
        for (int t = 0; t < 4; ++t) {
            const int o = (t * 4 + hl) * 128 + kk;
            qs[o] = silu(bf2f(qr[t]));
            const float f = lb + (1.0f - lb) * sigm(bf2f(fr_[t]));
            as[o] = f; ks[o] = 1.0f - f; vs[o] = bf2f(vr[t]);
        }
        __syncthreads();
        const int hw = w >> 1;
#pragma unroll 1
        for (int t = 0; t < 4; ++t) {
            const f32x4 v4 = *(const f32x4*)(vs + (t * 4 + hw) * 128 + sl * 64 + 4 * vq);
            f32x4 o = (f32x4){0.f, 0.f, 0.f, 0.f};
#pragma unroll
            for (int i4 = 0; i4 < 8; ++i4) {
                const int off = (t * 4 + hw) * 128 + 32 * kg + 4 * i4;
                const f32x4 q4 = *(const f32x4*)(qs + off), k4 = *(const f32x4*)(ks + off), a4 = *(const f32x4*)(as + off);
#pragma unroll
                for (int ii = 0; ii < 4; ++ii) { S[4 * i4 + ii] = a4[ii] * S[4 * i4 + ii] + k4[ii] * v4; o += q4[ii] * S[4 * i4 + ii]; }
            }
#pragma unroll
            for (int j = 0; j < 4; ++j) { o[j] += __shfl_xor(o[j], 16); o[j] += __shfl_xor(o[j], 32); }
            if (kg == 0) {
                u32x2 ov; ov.x = pk2(o[0], o[1]); ov.y = pk2(o[2], o[3]);
                *(u32x2*)(yz + (size_t)t * 4096 + h * 128 + sl * 64 + 4 * vq) = ov;
            }
        }
        if (tid == 0) nx = atomicAdd(ctr, 1u);
#pragma unroll
        for (int i = 0; i < 32; ++i) __builtin_nontemporal_store(S[i], (f32x4*)(Sout + (size_t)i * ldS));
    }
}

#define CK_QS 0
#define CK_KS 17408
#define CK_KT 34816
#define CK_VT 53248
#define CK_PS 62464
#define CK_ST 71680
#define CK_CUM 89088
__device__ __forceinline__ bf16x8 ck_frag(const unsigned char* lds, int base, int pitch, int row, int kb, int q) {
    return *(const bf16x8*)(lds + base + row * pitch + (32 * kb + 8 * q) * 2);
}
template <int TYPE>
__device__ __forceinline__ void chunk_item(const Params& p, unsigned char* lds, int b, int h, int s) {
    int tid = threadIdx.x; asm volatile("" : "+v"(tid));
    const int w = tid >> 6, lane = tid & 63, r = lane & 15, q = lane >> 4;
    constexpr int LDP = TYPE < 2 ? LD0 : LD1;
    const bf16_t* proj = (const bf16_t*)(p.ws + WS_PROJ) + (size_t)(2048 * b) * LDP;
    bf16_t* yz = (bf16_t*)(p.ws + WS_YZ) + (size_t)(2048 * b) * 4096;
    const int I = w >> 1, Vn0 = 2 * (w & 1);
    const int c1 = tid & 127, tq = tid >> 7;
    const int cx = tid & 63, tx = tid >> 6;
    const int g = h >> 3;
    float cwC[4], cwB[4], cwX[4], cbC = 0.f, cbB = 0.f, cbX = 0.f, inv = 0.f, dtb = 0.f, Aneg = 0.f, Dh = 0.f, sstep = 0.f, cstep = 1.f;
    (void)sstep; (void)cstep;
    int colC = 0, colB = 0, colX = 0;
    if constexpr (TYPE == 0) {
        const int chC = 2560 + g * 128 + c1, chB = 2048 + g * 128 + c1, chX = h * 64 + cx;
        colC = 2048 + chC; colB = 2048 + chB; colX = 2048 + chX;
#pragma unroll
        for (int j = 0; j < 4; ++j) { cwC[j] = p.in[13 + p.z][j * 3072 + chC]; cwB[j] = p.in[13 + p.z][j * 3072 + chB]; cwX[j] = p.in[13 + p.z][j * 3072 + chX]; }
        cbC = p.in[14 + p.z][chC]; cbB = p.in[14 + p.z][chB]; cbX = p.in[14 + p.z][chX];
        dtb = p.in[15 + p.z][h]; Aneg = -__expf(p.in[16 + p.z][h]); Dh = p.in[17 + p.z][h];
    } else if constexpr (TYPE == 1) {
        const int isk = c1 >> 6, jf = c1 & 63;
        colC = (isk ? 6176 : 5152) + h * 128 + jf; colB = colC + 64; colX = 7200 + h * 256 + s * 64 + cx;
        inv = exp2f(-(float)jf * 0.20762050593046014f);
        { const float frs = inv * 0.15915494309189535f; sstep = __builtin_amdgcn_sinf(frs); cstep = __builtin_amdgcn_cosf(frs); }
    } else {
        colC = h * 128 + c1; colB = 2048 + h * 128 + c1; colX = 4096 + h * 128 + s * 64 + cx;
        inv = ((const float*)(p.ws + WS_LB))[h * 128 + c1];
    }
    float* cumb = (float*)(lds + CK_CUM);
    if constexpr (TYPE == 1) {
        const float lg = __logf(1.0f - exp2f(-5.0f - (float)h * (4.0f / 7.0f)));
        if (tid < 64) {
#pragma unroll
            for (int bfi = 0; bfi < 2; ++bfi) { float* cb = cumb + bfi * 320; cb[tid] = (tid + 1) * lg; cb[64 + tid] = __expf((tid + 1) * lg); cb[128 + tid] = __expf((63 - tid) * lg); cb[192 + tid] = 1.0f; if (tid == 0) cb[256] = __expf(64.0f * lg); }
        }
    }
    for (int i = tid; i < 17408 / 4; i += 512) ((unsigned*)(lds + CK_ST))[i] = 0u;
    f32x4 Sacc[4];
#pragma unroll
    for (int i = 0; i < 4; ++i) Sacc[i] = (f32x4){0.f, 0.f, 0.f, 0.f};
    unsigned short xc[19], xb[19], xx[11], zr[8], dr = 0;
    auto load_raw = [&](int c) {
        const int t0 = 64 * c;
        if constexpr (TYPE == 0) {
#pragma unroll
            for (int i = 0; i < 19; ++i) { const int t = t0 + 16 * tq - 3 + i; xc[i] = 0; xb[i] = 0; if (t >= 0) { xc[i] = proj[(size_t)t * LDP + colC]; xb[i] = proj[(size_t)t * LDP + colB]; } }
#pragma unroll
            for (int i = 0; i < 11; ++i) { const int t = t0 + 8 * tx - 3 + i; xx[i] = 0; if (t >= 0) xx[i] = proj[(size_t)t * LDP + colX]; }
            if (w == 7) dr = proj[(size_t)(t0 + lane) * LDP + 5120 + h];
#pragma unroll
            for (int vv = 0; vv < 2; ++vv)
#pragma unroll
                for (int jx = 0; jx < 4; ++jx) zr[vv * 4 + jx] = proj[(size_t)(t0 + 16 * I + 4 * q + jx) * LDP + h * 64 + 16 * (Vn0 + vv) + r];
        } else {
#pragma unroll
            for (int i = 0; i < 16; ++i) { const int t = t0 + 16 * tq + i; xc[i] = proj[(size_t)t * LDP + colC]; xb[i] = proj[(size_t)t * LDP + colB]; }
#pragma unroll
            for (int i = 0; i < 8; ++i) xx[i] = proj[(size_t)(t0 + 8 * tx + i) * LDP + colX];
        }
    };
    load_raw(0);
    for (int c = 0; c < 32; ++c) {
        const int t0 = 64 * c;
        float* cum = cumb + (TYPE == 0 ? (c & 1) * 320 : 0);
        float vq_[16], vk_[16], vx_[8], kt_[16], Eval = 0.f;
        (void)kt_; (void)Eval;
        if constexpr (TYPE == 0) {
#pragma unroll
            for (int i = 0; i < 16; ++i) {
                vq_[i] = silu(cbC + cwC[0] * bf2f(xc[i]) + cwC[1] * bf2f(xc[i + 1]) + cwC[2] * bf2f(xc[i + 2]) + cwC[3] * bf2f(xc[i + 3]));
                vk_[i] = silu(cbB + cwB[0] * bf2f(xb[i]) + cwB[1] * bf2f(xb[i + 1]) + cwB[2] * bf2f(xb[i + 2]) + cwB[3] * bf2f(xb[i + 3]));
            }
#pragma unroll
            for (int i = 0; i < 8; ++i) vx_[i] = silu(cbX + cwX[0] * bf2f(xx[i]) + cwX[1] * bf2f(xx[i + 1]) + cwX[2] * bf2f(xx[i + 2]) + cwX[3] * bf2f(xx[i + 3]));
            if (w == 7) {
                const float dt = softplus(bf2f(dr) + dtb);
                float cs = dt * Aneg;
#pragma unroll
                for (int o = 1; o < 64; o <<= 1) { const float t = __shfl_up(cs, o); if (lane >= o) cs += t; }
                const float last = __shfl(cs, 63);
                cum[lane] = cs; cum[64 + lane] = __expf(cs); cum[128 + lane] = __expf(last - cs); cum[192 + lane] = dt;
                if (lane == 0) cum[256] = __expf(last);
            }
        } else if constexpr (TYPE == 2) {
            float pr[16], om[16];
            float run = 1.f;
#pragma unroll
            for (int i = 0; i < 16; ++i) { const float f = inv + (1.0f - inv) * sigm(bf2f(xb[i])); run *= f; pr[i] = run; om[i] = 1.0f - f; }
#pragma unroll
            for (int i = 0; i < 16; ++i) { const float ip = __builtin_amdgcn_rcpf(pr[i]); vq_[i] = silu(bf2f(xc[i])) * pr[i]; vk_[i] = om[i] * ip; kt_[i] = om[i] * ip * run; }
            Eval = run;
#pragma unroll
            for (int i = 0; i < 8; ++i) vx_[i] = bf2f(xx[i]);
        } else {
            {
                const double rev = (double)(t0 + 16 * tq) * (double)inv * 0.15915494309189535;
                const float fr = (float)(rev - floor(rev));
                float sn = __builtin_amdgcn_sinf(fr), cs = __builtin_amdgcn_cosf(fr);
#pragma unroll
                for (int i = 0; i < 16; ++i) {
                    const float a1 = bf2f(xc[i]), a2 = bf2f(xb[i]);
                    vq_[i] = a1 * cs - a2 * sn; vk_[i] = a1 * sn + a2 * cs;
                    const float c2 = cs * cstep - sn * sstep, s2 = sn * cstep + cs * sstep;
                    cs = c2; sn = s2;
                }
            }
#pragma unroll
            for (int i = 0; i < 8; ++i) vx_[i] = bf2f(xx[i]);
        }
        unsigned short zc[8];
#pragma unroll
        for (int i = 0; i < 8; ++i) zc[i] = zr[i];
        __syncthreads();
        if constexpr (TYPE == 0) {
            unsigned kt[8];
#pragma unroll
            for (int i = 0; i < 16; i += 2) {
                const int t = 16 * tq + i;
                const float k0 = vk_[i] * cum[192 + t], k1 = vk_[i + 1] * cum[192 + t + 1];
                *(bf16_t*)(lds + CK_QS + t * 272 + c1 * 2) = f2bf(vq_[i]); *(bf16_t*)(lds + CK_QS + (t + 1) * 272 + c1 * 2) = f2bf(vq_[i + 1]);
                *(bf16_t*)(lds + CK_KS + t * 272 + c1 * 2) = f2bf(k0); *(bf16_t*)(lds + CK_KS + (t + 1) * 272 + c1 * 2) = f2bf(k1);
                kt[i >> 1] = pk2(k0 * cum[128 + t], k1 * cum[128 + t + 1]);
            }
            *(u32x4*)(lds + CK_KT + c1 * 144 + 32 * tq) = (u32x4){kt[0], kt[1], kt[2], kt[3]};
            *(u32x4*)(lds + CK_KT + c1 * 144 + 32 * tq + 16) = (u32x4){kt[4], kt[5], kt[6], kt[7]};
        } else if constexpr (TYPE == 2) {
            unsigned kt[8];
#pragma unroll
            for (int i = 0; i < 16; i += 2) {
                const int t = 16 * tq + i;
                *(bf16_t*)(lds + CK_QS + t * 272 + c1 * 2) = f2bf(vq_[i]); *(bf16_t*)(lds + CK_QS + (t + 1) * 272 + c1 * 2) = f2bf(vq_[i + 1]);
                *(bf16_t*)(lds + CK_KS + t * 272 + c1 * 2) = f2bf(vk_[i]); *(bf16_t*)(lds + CK_KS + (t + 1) * 272 + c1 * 2) = f2bf(vk_[i + 1]);
                kt[i >> 1] = pk2(kt_[i], kt_[i + 1]);
            }
            *(u32x4*)(lds + CK_KT + c1 * 144 + 32 * tq) = (u32x4){kt[0], kt[1], kt[2], kt[3]};
            *(u32x4*)(lds + CK_KT + c1 * 144 + 32 * tq + 16) = (u32x4){kt[4], kt[5], kt[6], kt[7]};
            cum[tq * 128 + c1] = Eval;
        } else {
            const int isk = c1 >> 6, jf = c1 & 63;
            if (isk == 0) {
#pragma unroll
                for (int i = 0; i < 16; ++i) { const int t = 16 * tq + i; *(bf16_t*)(lds + CK_QS + t * 272 + jf * 2) = f2bf(vq_[i]); *(bf16_t*)(lds + CK_QS + t * 272 + (jf + 64) * 2) = f2bf(vk_[i]); }
            } else {
                unsigned kta[8], ktb[8];
#pragma unroll
                for (int i = 0; i < 16; i += 2) {
                    const int t = 16 * tq + i;
                    const float a0 = vq_[i] * 0.08838834764831845f, a1 = vq_[i + 1] * 0.08838834764831845f, b0 = vk_[i] * 0.08838834764831845f, b1 = vk_[i + 1] * 0.08838834764831845f;
                    *(bf16_t*)(lds + CK_KS + t * 272 + jf * 2) = f2bf(a0); *(bf16_t*)(lds + CK_KS + (t + 1) * 272 + jf * 2) = f2bf(a1);
                    *(bf16_t*)(lds + CK_KS + t * 272 + (jf + 64) * 2) = f2bf(b0); *(bf16_t*)(lds + CK_KS + (t + 1) * 272 + (jf + 64) * 2) = f2bf(b1);
                    kta[i >> 1] = pk2(a0 * cum[128 + t], a1 * cum[128 + t + 1]); ktb[i >> 1] = pk2(b0 * cum[128 + t], b1 * cum[128 + t + 1]);
                }
                *(u32x4*)(lds + CK_KT + jf * 144 + 32 * tq) = (u32x4){kta[0], kta[1], kta[2], kta[3]};
                *(u32x4*)(lds + CK_KT + jf * 144 + 32 * tq + 16) = (u32x4){kta[4], kta[5], kta[6], kta[7]};
                *(u32x4*)(lds + CK_KT + (jf + 64) * 144 + 32 * tq) = (u32x4){ktb[0], ktb[1], ktb[2], ktb[3]};
                *(u32x4*)(lds + CK_KT + (jf + 64) * 144 + 32 * tq + 16) = (u32x4){ktb[4], ktb[5], ktb[6], ktb[7]};
            }
        }
        *(u32x4*)(lds + CK_VT + cx * 144 + 16 * tx) = (u32x4){pk2(vx_[0], vx_[1]), pk2(vx_[2], vx_[3]), pk2(vx_[4], vx_[5]), pk2(vx_[6], vx_[7])};
        __syncthreads();
        if (c + 1 < 32) load_raw(c + 1);
        if constexpr (TYPE < 2) {
        bf16x8 aQ[4];
#pragma unroll
        for (int kb = 0; kb < 4; ++kb) aQ[kb] = ck_frag(lds, CK_QS, 272, 16 * I + r, kb, q);
        float cumi[4];
#pragma unroll
        for (int jx = 0; jx < 4; ++jx) cumi[jx] = cum[16 * I + 4 * q + jx];
#pragma unroll
        for (int jj = 0; jj < 2; ++jj) {
            const int J = Vn0 + jj;
            f32x4 acc = (f32x4){0.f, 0.f, 0.f, 0.f};
#pragma unroll
            for (int kb = 0; kb < 4; ++kb) acc = __builtin_amdgcn_mfma_f32_16x16x32_bf16(aQ[kb], ck_frag(lds, CK_KS, 272, 16 * J + r, kb, q), acc, 0, 0, 0);
            const int jcol = 16 * J + r; const float cumj = cum[jcol];
#pragma unroll
            for (int jx = 0; jx < 4; ++jx) {
                const int i = 16 * I + 4 * q + jx;
                const float v = (jcol <= i) ? acc[jx] * __expf(fminf(cumi[jx] - cumj, 0.f)) : 0.f;
                *(bf16_t*)(lds + CK_PS + i * 144 + jcol * 2) = f2bf(v);
            }
        }
        __syncthreads();
#pragma unroll
        for (int vv = 0; vv < 2; ++vv) {
            const int Vn = Vn0 + vv;
            f32x4 aPV = (f32x4){0.f, 0.f, 0.f, 0.f}, aQS = (f32x4){0.f, 0.f, 0.f, 0.f};
#pragma unroll
            for (int jb = 0; jb < 2; ++jb) aPV = __builtin_amdgcn_mfma_f32_16x16x32_bf16(ck_frag(lds, CK_PS, 144, 16 * I + r, jb, q), ck_frag(lds, CK_VT, 144, 16 * Vn + r, jb, q), aPV, 0, 0, 0);
#pragma unroll
            for (int kb = 0; kb < 4; ++kb) aQS = __builtin_amdgcn_mfma_f32_16x16x32_bf16(aQ[kb], ck_frag(lds, CK_ST, 272, 16 * Vn + r, kb, q), aQS, 0, 0, 0);
#pragma unroll
            for (int jx = 0; jx < 4; ++jx) {
                const int i = 16 * I + 4 * q + jx, v = 16 * Vn + r;
                const float o = aPV[jx] + cum[64 + i] * aQS[jx];
                if constexpr (TYPE == 0) {
                    const float xsv = bf2f(*(const bf16_t*)(lds + CK_VT + v * 144 + i * 2));
                    yz[(size_t)(t0 + i) * 4096 + h * 64 + v] = f2bf((o + Dh * xsv) * silu(bf2f(zc[vv * 4 + jx])));
                } else {
                    yz[(size_t)(t0 + i) * 4096 + 2048 + h * 256 + s * 64 + v] = f2bf(o);
                }
            }
        }
        __syncthreads();
        const float elast = cum[256];
#pragma unroll
        for (int Vn = 0; Vn < 4; ++Vn) {
            Sacc[Vn] = Sacc[Vn] * elast;
#pragma unroll
            for (int tb = 0; tb < 2; ++tb) Sacc[Vn] = __builtin_amdgcn_mfma_f32_16x16x32_bf16(ck_frag(lds, CK_KT, 144, 16 * w + r, tb, q), ck_frag(lds, CK_VT, 144, 16 * Vn + r, tb, q), Sacc[Vn], 0, 0, 0);
            *(u32x2*)(lds + CK_ST + (16 * Vn + r) * 272 + (16 * w + 4 * q) * 2) = (u32x2){pk2_sw(Sacc[Vn][0], Sacc[Vn][1]), pk2_sw(Sacc[Vn][2], Sacc[Vn][3])};
        }
            } else {
            const bf16x8 zf = (bf16x8){0, 0, 0, 0, 0, 0, 0, 0};
            if ((w & 1) == 0) {
                f32x4 acc = (f32x4){0.f, 0.f, 0.f, 0.f};
#pragma unroll
                for (int kb = 0; kb < 4; ++kb) acc = __builtin_amdgcn_mfma_f32_16x16x32_bf16(ck_frag(lds, CK_QS, 272, 16 * I + r, kb, q), ck_frag(lds, CK_KS, 272, 16 * I + r, kb, q), acc, 0, 0, 0);
#pragma unroll
                for (int jx = 0; jx < 4; ++jx) {
                    const float v = (r <= 4 * q + jx) ? acc[jx] : 0.f;
                    *(bf16_t*)(lds + CK_PS + (16 * I + 4 * q + jx) * 144 + (16 * I + r) * 2) = f2bf(v);
                }
            }
            __syncthreads();
#pragma unroll
            for (int sc = 0; sc < 4; ++sc) {
                const int stb = sc == 0 ? CK_ST : (sc == 1 ? CK_KS : (sc == 2 ? 91648 : 109056));
                const f32x4 e4 = *(const f32x4*)(cum + sc * 128 + 16 * w + 4 * q);
                const bf16x8 ka = (q < 2) ? *(const bf16x8*)(lds + CK_KT + (16 * w + r) * 144 + (16 * sc + 8 * q) * 2) : zf;
#pragma unroll
                for (int Vn = 0; Vn < 4; ++Vn) {
                    *(u32x2*)(lds + stb + (16 * Vn + r) * 272 + (16 * w + 4 * q) * 2) = (u32x2){pk2_sw(Sacc[Vn][0], Sacc[Vn][1]), pk2_sw(Sacc[Vn][2], Sacc[Vn][3])};
                    const bf16x8 vb = (q < 2) ? *(const bf16x8*)(lds + CK_VT + (16 * Vn + r) * 144 + (16 * sc + 8 * q) * 2) : zf;
                    Sacc[Vn] = __builtin_amdgcn_mfma_f32_16x16x32_bf16(ka, vb, Sacc[Vn] * e4, 0, 0, 0);
                }
            }
            __syncthreads();
            {
                const int sc = I;
                const int stb = sc == 0 ? CK_ST : (sc == 1 ? CK_KS : (sc == 2 ? 91648 : 109056));
                const bf16x8 pa = (q < 2) ? *(const bf16x8*)(lds + CK_PS + (16 * sc + r) * 144 + (16 * sc + 8 * q) * 2) : zf;
                bf16x8 qa[4];
#pragma unroll
                for (int kb = 0; kb < 4; ++kb) qa[kb] = ck_frag(lds, CK_QS, 272, 16 * sc + r, kb, q);
#pragma unroll
                for (int vv = 0; vv < 2; ++vv) {
                    const int Vn = Vn0 + vv;
                    const bf16x8 vb = (q < 2) ? *(const bf16x8*)(lds + CK_VT + (16 * Vn + r) * 144 + (16 * sc + 8 * q) * 2) : zf;
                    f32x4 aO = __builtin_amdgcn_mfma_f32_16x16x32_bf16(pa, vb, (f32x4){0.f, 0.f, 0.f, 0.f}, 0, 0, 0);
#pragma unroll
                    for (int kb = 0; kb < 4; ++kb) aO = __builtin_amdgcn_mfma_f32_16x16x32_bf16(qa[kb], ck_frag(lds, stb, 272, 16 * Vn + r, kb, q), aO, 0, 0, 0);
#pragma unroll
                    for (int jx = 0; jx < 4; ++jx) yz[(size_t)(t0 + 16 * sc + 4 * q + jx) * 4096 + h * 128 + s * 64 + 16 * Vn + r] = (bf16_t)(pk2_sw(aO[jx], 0.f) & 0xffffu);
                }
            }
        }
    }
    const int ldS = TYPE == 0 ? 64 : (TYPE == 1 ? 256 : 128);
    float* Sout = p.out + (TYPE == 0 ? O_SSMP + ((size_t)(b * 32 + h) * 128) * 64 : (TYPE == 1 ? O_RETP + ((size_t)(b * 8 + h) * 128) * 256 + s * 64 : O_HGP + ((size_t)(b * 16 + h) * 128) * 128 + s * 64));
#pragma unroll
    for (int Vn = 0; Vn < 4; ++Vn)
#pragma unroll
        for (int jx = 0; jx < 4; ++jx) Sout[(size_t)(16 * w + 4 * q + jx) * ldS + 16 * Vn + r] = Sacc[Vn][jx];
}

__device__ __forceinline__ void lru_dec_unit(const Params& p, int b) {
    int tid = threadIdx.x; asm volatile("" : "+v"(tid));
    const int c = tid * 4;
    const int row0 = MP + 4 * b;
    const float* LA = (const float*)(p.ws + WS_LA) + (size_t)row0 * 2048 + c;
    const bf16_t* LBv = (const bf16_t*)(p.ws + WS_LBB) + (size_t)row0 * 2048 + c;
    const bf16_t* rg = (const bf16_t*)(p.ws + WS_PROJ) + (size_t)row0 * LD1 + 10240 + c;
    bf16_t* mixa = (bf16_t*)(p.ws + WS_ACT) + (size_t)row0 * 4096 + 2048 + c;
    f32x4 hst = *(const f32x4*)(p.in[6 + p.z] + (size_t)b * 2048 + c);
#pragma unroll
    for (int t = 0; t < 4; ++t) {
        const f32x4 a = *(const f32x4*)(LA + (size_t)t * 2048);
        float bb[4], gg[4]; unpack4(*(const u32x2*)(LBv + (size_t)t * 2048), bb); unpack4(*(const u32x2*)(rg + (size_t)t * LD1), gg);
        float y[4];
#pragma unroll
        for (int j = 0; j < 4; ++j) { hst[j] = a[j] * hst[j] + bb[j]; y[j] = hst[j] * gelu_tanh(gg[j]); }
        u32x2 ov; ov.x = pk2(y[0], y[1]); ov.y = pk2(y[2], y[3]);
        *(u32x2*)(mixa + (size_t)t * 4096) = ov;
    }
    *(f32x4*)(p.out + O_LRUS + (size_t)b * 2048 + c) = hst;
}

__device__ __forceinline__ void lru_scan_item(const Params& p, float* ldsf, int b, int cg) {
    int tid = threadIdx.x; asm volatile("" : "+v"(tid));
    const int w = tid >> 6, lane = tid & 63, c = cg * 64 + lane;
    const size_t row0 = (size_t)2048 * b + 256 * w;
    const float* LA = (const float*)(p.ws + WS_LA) + row0 * 2048 + c;
    const bf16_t* LBv = (const bf16_t*)(p.ws + WS_LBB) + row0 * 2048 + c;
    const bf16_t* rg = (const bf16_t*)(p.ws + WS_PROJ) + row0 * LD1 + 10240 + c;
    bf16_t* mixa = (bf16_t*)(p.ws + WS_ACT) + row0 * 4096 + 2048 + c;
    float hl = 0.f, pr = 1.f;
    for (int tb = 0; tb < 256; tb += 16) {
        float a0[16]; unsigned short b0[16];
#pragma unroll
        for (int t = 0; t < 16; ++t) { a0[t] = LA[(size_t)(tb + t) * 2048]; b0[t] = LBv[(size_t)(tb + t) * 2048]; }
#pragma unroll
        for (int t = 0; t < 16; ++t) { hl = a0[t] * hl + bf2f(b0[t]); pr *= a0[t]; }
    }
    ldsf[w * 128 + lane] = pr; ldsf[w * 128 + 64 + lane] = hl;
    __syncthreads();
    float hst = 0.f;
    for (int ww = 0; ww < w; ++ww) hst = ldsf[ww * 128 + lane] * hst + ldsf[ww * 128 + 64 + lane];
    for (int tb = 0; tb < 256; tb += 16) {
        float a0[16]; unsigned short b0[16], g0[16];
#pragma unroll
        for (int t = 0; t < 16; ++t) { a0[t] = LA[(size_t)(tb + t) * 2048]; b0[t] = LBv[(size_t)(tb + t) * 2048]; g0[t] = rg[(size_t)(tb + t) * LD1]; }
#pragma unroll
        for (int t = 0; t < 16; ++t) {
            hst = a0[t] * hst + bf2f(b0[t]);
            mixa[(size_t)(tb + t) * 4096] = f2bf(hst * gelu_tanh(bf2f(g0[t])));
        }
    }
    if (w == 7) p.out[O_LRUP + (size_t)b * 2048 + c] = hst;
}

__device__ __forceinline__ int handover(float* ldsf, unsigned nx) {
    asm volatile("s_waitcnt lgkmcnt(0)" ::: "memory"); __builtin_amdgcn_s_barrier(); asm volatile("" ::: "memory");
    if (threadIdx.x == 0) ((volatile unsigned*)ldsf)[33284] = nx;
    asm volatile("s_waitcnt lgkmcnt(0)" ::: "memory"); __builtin_amdgcn_s_barrier(); asm volatile("" ::: "memory");
    return (int)((volatile unsigned*)ldsf)[33284];
}
__device__ __forceinline__ void phase_rec0(const Params& p, float* ldsf) {
    unsigned* ctr = (unsigned*)(p.ws + WS_CTL);
    const int total = 256 + 512 + 512;
    int it = next_item(ctr, ldsf);
    while (it < total) {
        if (it < 256) {
            if (it < 128) chunk_item<0>(p, (unsigned char*)ldsf, it >> 5, it & 31, 0);
            else { const int j = it - 128; chunk_item<1>(p, (unsigned char*)ldsf, j >> 5, (j & 31) >> 2, j & 3); }
            it = next_item(ctr, ldsf);
        } else {
            unsigned nx = 0u;
            if (it < 768) { const int j = it - 256; dec_unit<0>(p, ldsf, j >> 2, j & 3, ctr, nx); }
            else { const int j = it - 768; dec_unit<1>(p, ldsf, j >> 2, j & 3, ctr, nx); }
            it = handover(ldsf, nx);
        }
    }
}
__device__ __forceinline__ void phase_rec1(const Params& p, float* ldsf) {
    unsigned* ctr = (unsigned*)(p.ws + WS_CTL) + 64;
    const int total = 128 + 128 + 512 + 128;
    int it = next_item(ctr, ldsf);
    while (it < total) {
        if (it >= 256 && it < 768) {
            unsigned nx = 0u;
            const int j = it - 256; dec_unit<2>(p, ldsf, j >> 2, j & 3, ctr, nx);
            it = handover(ldsf, nx);
        } else {
            if (it < 128) chunk_item<2>(p, (unsigned char*)ldsf, it >> 5, (it & 31) >> 1, it & 1);
            else if (it < 256) { const int j = it - 128; lru_scan_item(p, ldsf, j >> 5, j & 31); }
            else lru_dec_unit(p, it - 768);
            it = next_item(ctr, ldsf);
        }
    }
}

__device__ __forceinline__ void seq_of_row(int row, int& sample, int& b, int& t, int& L) {
    if (row < MP) { sample = 0; b = row >> 11; t = row & 2047; L = 2048; } else { sample = 1; b = (row - MP) >> 2; t = (row - MP) & 3; L = 4; }
}

__device__ __forceinline__ void phase_prep0(const Params& p) {
    int tid = threadIdx.x; asm volatile("" : "+v"(tid));
    const int wave = tid >> 6, lane = tid & 63;
    const int gw = blockIdx.x * 8 + wave, NGW = gridDim.x * 8;
    const bf16_t* YZ = (const bf16_t*)(p.ws + WS_YZ); const bf16_t* PR = (const bf16_t*)(p.ws + WS_PROJ);
    bf16_t* MX = (bf16_t*)(p.ws + WS_ACT);
    const float* nw = p.in[18 + p.z];
    u32x4 nya[4]; u32x2 nyb[8], ngb[8];
    auto ldrow = [&](int row) {
#pragma unroll
        for (int g = 0; g < 4; ++g) nya[g] = __builtin_nontemporal_load((const u32x4*)(YZ + (size_t)row * 4096 + g * 512 + lane * 8));
#pragma unroll
        for (int hh = 0; hh < 8; ++hh) { nyb[hh] = __builtin_nontemporal_load((const u32x2*)(YZ + (size_t)row * 4096 + 2048 + hh * 256 + lane * 4)); ngb[hh] = __builtin_nontemporal_load((const u32x2*)(PR + (size_t)row * LD0 + 9248 + hh * 256 + lane * 4)); }
    };
    if (gw < MT) ldrow(gw);
    for (int row = gw; row < MT; row += NGW) {
        bf16_t* mx = MX + (size_t)row * 4096;
        u32x4 ya[4]; u32x2 yb[8], gb[8];
#pragma unroll
        for (int g = 0; g < 4; ++g) ya[g] = nya[g];
#pragma unroll
        for (int hh = 0; hh < 8; ++hh) { yb[hh] = nyb[hh]; gb[hh] = ngb[hh]; }
        if (row + NGW < MT) ldrow(row + NGW);
#pragma unroll
        for (int g = 0; g < 4; ++g) {
            const int c = g * 512 + lane * 8;
            float v[8]; unpack8(ya[g], v);
            float s = 0.f;
#pragma unroll
            for (int j = 0; j < 8; ++j) s += v[j] * v[j];
            s = wave_sum(s);
            const float rs = rsqrtf(s * (1.0f / 512.0f) + EPS);
            const f32x4 n0 = *(const f32x4*)(nw + c), n1 = *(const f32x4*)(nw + c + 4);
            u32x4 o; o.x = pk2(v[0] * rs * n0[0], v[1] * rs * n0[1]); o.y = pk2(v[2] * rs * n0[2], v[3] * rs * n0[3]);
            o.z = pk2(v[4] * rs * n1[0], v[5] * rs * n1[1]); o.w = pk2(v[6] * rs * n1[2], v[7] * rs * n1[3]);
            *(u32x4*)(mx + c) = o;
        }
#pragma unroll
        for (int hh = 0; hh < 8; ++hh) {
            const int c = hh * 256 + lane * 4;
            float v[4]; unpack4(yb[hh], v);
            float gt[4]; unpack4(gb[hh], gt);
            float s = (v[0] * v[0] + v[1] * v[1]) + (v[2] * v[2] + v[3] * v[3]);
            s = wave_sum(s);
            const float rs = rsqrtf(s * (1.0f / 256.0f) + EPS);
            u32x2 o; o.x = pk2(v[0] * rs * silu(gt[0]), v[1] * rs * silu(gt[1])); o.y = pk2(v[2] * rs * silu(gt[2]), v[3] * rs * silu(gt[3]));
            *(u32x2*)(mx + 2048 + c) = o;
        }
        int sample, b, t, L; seq_of_row(row, sample, b, t, L);
        if (t >= L - 3) {
            float* dst = p.out + (sample ? O_SCS : O_SCP) + ((size_t)b * 3 + (t - (L - 3))) * 3072;
            const bf16_t* src = PR + (size_t)row * LD0 + 2048;
#pragma unroll 4
            for (int c = lane; c < 3072; c += 64) dst[c] = bf2f(src[c]);
        }
    }
}

__device__ __forceinline__ void phase_prep1(const Params& p) {
    int tid = threadIdx.x; asm volatile("" : "+v"(tid));
    const int wave = tid >> 6, lane = tid & 63;
    const int gw = blockIdx.x * 8 + wave, NGW = gridDim.x * 8;
    const bf16_t* YZ = (const bf16_t*)(p.ws + WS_YZ); const bf16_t* PR = (const bf16_t*)(p.ws + WS_PROJ);
    bf16_t* MX = (bf16_t*)(p.ws + WS_ACT);
    const float* nw = p.in[22 + p.z];
    u32x4 nya[4], nga[4];
    auto ldrow = [&](int row) {
#pragma unroll
        for (int it = 0; it < 4; ++it) { nya[it] = __builtin_nontemporal_load((const u32x4*)(YZ + (size_t)row * 4096 + it * 512 + lane * 8)); nga[it] = __builtin_nontemporal_load((const u32x4*)(PR + (size_t)row * LD1 + 6144 + it * 512 + lane * 8)); }
    };
    if (gw < MT) ldrow(gw);
    for (int row = gw; row < MT; row += NGW) {
        u32x4 ya[4], ga[4];
#pragma unroll
        for (int it = 0; it < 4; ++it) { ya[it] = nya[it]; ga[it] = nga[it]; }
        if (row + NGW < MT) ldrow(row + NGW);
#pragma unroll
        for (int it = 0; it < 4; ++it) {
            const int c = it * 512 + lane * 8;
            float v[8]; unpack8(ya[it], v);
            float gt[8]; unpack8(ga[it], gt);
            float s = 0.f;
#pragma unroll
            for (int j = 0; j < 8; ++j) s += v[j] * v[j];
            s += __shfl_xor(s, 1); s += __shfl_xor(s, 2); s += __shfl_xor(s, 4); s += __shfl_xor(s, 8);
            const float rs = rsqrtf(s * (1.0f / 128.0f) + EPS);
            const f32x4 n0 = *(const f32x4*)(nw + (c & 127)), n1 = *(const f32x4*)(nw + (c & 127) + 4);
            float o[8];
#pragma unroll
            for (int j = 0; j < 8; ++j) o[j] = v[j] * rs * (j < 4 ? n0[j] : n1[j - 4]) * silu(gt[j]);
            u32x4 ov; ov.x = pk2(o[0], o[1]); ov.y = pk2(o[2], o[3]); ov.z = pk2(o[4], o[5]); ov.w = pk2(o[6], o[7]);
            *(u32x4*)(MX + (size_t)row * 4096 + c) = ov;
        }
    }
}

__device__ __forceinline__ void phase_act(const Params& p, int l) {
    int tid = threadIdx.x; asm volatile("" : "+v"(tid));
    const bf16_t* PR = (const bf16_t*)(p.ws + WS_PROJ); bf16_t* ACT = (bf16_t*)(p.ws + WS_ACT);
    const float* cw = p.in[32 + p.z] + (size_t)l * 3 * DFF; const float* cbv = p.in[33 + p.z] + (size_t)l * DFF;
    const float* st = p.in[8 + p.z] + (size_t)l * 128 * 2 * DFF;
    const int total = (MT / 4) * 704;
    for (int idx = blockIdx.x * 512 + tid; idx < total; idx += gridDim.x * 512) {
        const int rb = idx / 704, c = (idx - rb * 704) * 8, r0 = rb * 4;
        int sample, b, t0, L; seq_of_row(r0, sample, b, t0, L);
        u32x4 gr[6], ur[4];
#pragma unroll
        for (int i = 0; i < 4; ++i) { gr[i + 2] = *(const u32x4*)(PR + (size_t)(r0 + i) * LDU + c); ur[i] = __builtin_nontemporal_load((const u32x4*)(PR + (size_t)(r0 + i) * LDU + DFF + c)); }
        float g[6][8];
        if (t0 >= 2) { gr[0] = *(const u32x4*)(PR + (size_t)(r0 - 2) * LDU + c); gr[1] = *(const u32x4*)(PR + (size_t)(r0 - 1) * LDU + c); unpack8(gr[0], g[0]); unpack8(gr[1], g[1]); }
        else {
#pragma unroll
            for (int j = 0; j < 8; ++j) { g[0][j] = sample ? st[((size_t)b * 2 + 0) * DFF + c + j] : 0.f; g[1][j] = sample ? st[((size_t)b * 2 + 1) * DFF + c + j] : 0.f; }
        }
#pragma unroll
        for (int i = 0; i < 4; ++i) unpack8(gr[i + 2], g[i + 2]);
        float w0[8], w1[8], w2[8], bb[8];
#pragma unroll
        for (int j = 0; j < 8; ++j) { w0[j] = cw[c + j]; w1[j] = cw[DFF + c + j]; w2[j] = cw[2 * DFF + c + j]; bb[j] = cbv[c + j]; }
#pragma unroll
        for (int i = 0; i < 4; ++i) {
            float uu[8], o[8]; unpack8(ur[i], uu);
#pragma unroll
            for (int j = 0; j < 8; ++j) o[j] = silu(bb[j] + w0[j] * g[i][j] + w1[j] * g[i + 1][j] + w2[j] * g[i + 2][j]) * uu[j];
            u32x4 ov; ov.x = pk2(o[0], o[1]); ov.y = pk2(o[2], o[3]); ov.z = pk2(o[4], o[5]); ov.w = pk2(o[6], o[7]);
            *(u32x4*)(ACT + (size_t)(r0 + i) * DFF + c) = ov;
        }
        if (t0 + 4 == L) {
#pragma unroll
            for (int i = 0; i < 2; ++i) {
                float* dst = p.out + (sample ? O_FCS + (((size_t)l * 128 + b) * 2 + i) * DFF : O_FCP + (((size_t)l * 4 + b) * 2 + i) * DFF) + c;
                *(f32x4*)dst = (f32x4){g[4 + i][0], g[4 + i][1], g[4 + i][2], g[4 + i][3]}; *(f32x4*)(dst + 4) = (f32x4){g[4 + i][4], g[4 + i][5], g[4 + i][6], g[4 + i][7]};
            }
        }
    }
}

__device__ __forceinline__ void phase_lruconv(const Params& p) {
    int tid = threadIdx.x; asm volatile("" : "+v"(tid));
    const bf16_t* PR = (const bf16_t*)(p.ws + WS_PROJ); bf16_t* XR = (bf16_t*)(p.ws + WS_XR);
    const float* cw = p.in[23 + p.z]; const float* cbv = p.in[24 + p.z]; const float* st = p.in[7 + p.z];
    const int total = (MT / 4) * 256;
    for (int idx = blockIdx.x * 512 + tid; idx < total; idx += gridDim.x * 512) {
        const int rb = idx >> 8, c = (idx & 255) * 8, r0 = rb * 4;
        int sample, b, t0, L; seq_of_row(r0, sample, b, t0, L);
        float x[7][8];
#pragma unroll
        for (int j = 3; j < 7; ++j) unpack8(*(const u32x4*)(PR + (size_t)(r0 - 3 + j) * LD1 + 8192 + c), x[j]);
        if (t0 >= 3) {
#pragma unroll
            for (int j = 0; j < 3; ++j) unpack8(*(const u32x4*)(PR + (size_t)(r0 - 3 + j) * LD1 + 8192 + c), x[j]);
        } else {
#pragma unroll
            for (int j = 0; j < 3; ++j)
#pragma unroll
                for (int i = 0; i < 8; ++i) x[j][i] = sample ? st[((size_t)b * 3 + j) * 2048 + c + i] : 0.f;
        }
        float w0[8], w1[8], w2[8], w3[8], bb[8];
#pragma unroll
        for (int i = 0; i < 8; ++i) { w0[i] = cw[c + i]; w1[i] = cw[2048 + c + i]; w2[i] = cw[4096 + c + i]; w3[i] = cw[6144 + c + i]; bb[i] = cbv[c + i]; }
#pragma unroll
        for (int rr = 0; rr < 4; ++rr) {
            float o[8];
#pragma unroll
            for (int i = 0; i < 8; ++i) o[i] = bb[i] + w0[i] * x[rr][i] + w1[i] * x[rr + 1][i] + w2[i] * x[rr + 2][i] + w3[i] * x[rr + 3][i];
            u32x4 ov; ov.x = pk2(o[0], o[1]); ov.y = pk2(o[2], o[3]); ov.z = pk2(o[4], o[5]); ov.w = pk2(o[6], o[7]);
            *(u32x4*)(XR + (size_t)(r0 + rr) * 2048 + c) = ov;
        }
        if (t0 + 4 == L) {
#pragma unroll
            for (int j = 0; j < 3; ++j) {
                float* dst = p.out + (sample ? O_LCS : O_LCP) + ((size_t)b * 3 + j) * 2048 + c;
                *(f32x4*)dst = (f32x4){x[4 + j][0], x[4 + j][1], x[4 + j][2], x[4 + j][3]}; *(f32x4*)(dst + 4) = (f32x4){x[4 + j][4], x[4 + j][5], x[4 + j][6], x[4 + j][7]};
            }
        }
    }
}

template <int NS>
__device__ __forceinline__ void finalize_sample_rows(const Params& p, float* ssdst) {
    int tid = threadIdx.x; asm volatile("" : "+v"(tid));
    float* X = (float*)(p.ws + WS_X); bf16_t* XB = (bf16_t*)(p.ws + WS_XB); const float* PT = (const float*)(p.ws + WS_PROJ);
    for (int item = blockIdx.x * 512 + tid; item < 512 * 512; item += gridDim.x * 512) {
        const int row = item >> 9, c4 = item & 511;
        const unsigned o = (unsigned)(MP + row) * 2048u + (unsigned)c4 * 4u, po = (unsigned)row * 2048u + (unsigned)c4 * 4u;
        f32x4 v = *(const f32x4*)(X + o);
        f32x4 pv[NS];
#pragma unroll
        for (int ks = 0; ks < NS; ++ks) pv[ks] = __builtin_nontemporal_load((const f32x4*)(PT + (size_t)ks * (512 * 2048) + po));
#pragma unroll
        for (int ks = 0; ks < NS; ++ks) v += pv[ks];
        *(f32x4*)(X + o) = v;
        u32x2 w; w.x = pk2(v[0], v[1]); w.y = pk2(v[2], v[3]);
        *(u32x2*)(XB + o) = w;
        float s2 = (v[0] * v[0] + v[1] * v[1]) + (v[2] * v[2] + v[3] * v[3]);
        s2 = wave_sum(s2);
        if ((tid & 63) == 0) atomicAdd(ssdst + MP + row, s2);
    }
}

__device__ __forceinline__ void phase_final(const Params& p) {
    int tid = threadIdx.x; asm volatile("" : "+v"(tid));
    const int wave = tid >> 6, lane = tid & 63;
    const int gw = blockIdx.x * 8 + wave, NGW = gridDim.x * 8;
    const float* X = (const float*)(p.ws + WS_X); const float* nf = p.in[11 + p.z];
    f32x4 nv[8];
    auto ldrow = [&](int row) {
#pragma unroll
        for (int j = 0; j < 8; ++j) nv[j] = __builtin_nontemporal_load((const f32x4*)(X + (size_t)row * 2048 + (lane + 64 * j) * 4));
    };
    if (gw < MT) ldrow(gw);
    for (int row = gw; row < MT; row += NGW) {
        f32x4 v[8]; float sq = 0.f;
#pragma unroll
        for (int j = 0; j < 8; ++j) v[j] = nv[j];
        if (row + NGW < MT) ldrow(row + NGW);
        if (row >= MP) {
#pragma unroll
            for (int j = 0; j < 8; ++j) {
                f32x4 pv[11];
#pragma unroll
                for (int ks = 0; ks < 11; ++ks) pv[ks] = *(const f32x4*)((const float*)(p.ws + WS_PROJ) + (size_t)ks * (512 * 2048) + (size_t)(row - MP) * 2048 + (lane + 64 * j) * 4);
#pragma unroll
                for (int ks = 0; ks < 11; ++ks) v[j] += pv[ks];
            }
        }
#pragma unroll
        for (int j = 0; j < 8; ++j) sq += (v[j][0] * v[j][0] + v[j][1] * v[j][1]) + (v[j][2] * v[j][2] + v[j][3] * v[j][3]);
        sq = wave_sum(sq);
        const float rs = rsqrtf(sq * (1.0f / 2048.0f) + EPS);
        float* dst = p.out + (row < MP ? O_YP + (size_t)row * 2048 : O_YS + (size_t)(row - MP) * 2048);
#pragma unroll
        for (int j = 0; j < 8; ++j) {
            const int c = (lane + 64 * j) * 4;
            __builtin_nontemporal_store(v[j] * rs * *(const f32x4*)(nf + c), (f32x4*)(dst + c));
        }
    }
}

#define XB_TMO      128
#define XB_XCNT(j)  (256  + 64 * (j))
#define XB_XSUB(j)  (1280 + 64 * (j))
#define XB_XGEN(j)  (2304 + 64 * (j))
#define XB_TOP      3328
#define XB_TOPGEN   3392
#define XCD_BAR_WORDS 3456
#define XB_SPIN_CAP (1u << 22)
__device__ __forceinline__ unsigned xb_ld(unsigned* p)              { return __hip_atomic_load(p, __ATOMIC_RELAXED, __HIP_MEMORY_SCOPE_AGENT); }
__device__ __forceinline__ unsigned xb_add(unsigned* p, unsigned v) { return __hip_atomic_fetch_add(p, v, __ATOMIC_RELAXED, __HIP_MEMORY_SCOPE_AGENT); }
__device__ __forceinline__ unsigned xb_xcc_id() { return (unsigned)__builtin_amdgcn_s_getreg((3 << 11) | 20) & 0xFu; }
#define XB_SPIN(cond, bar) do { unsigned _sp = 0; while (cond) { __builtin_amdgcn_s_sleep(1); \
    if ((++_sp & 255u) == 0u) { if (xb_ld(&(bar)[XB_TMO])) break; if (_sp > XB_SPIN_CAP) { atomicAdd(&(bar)[XB_TMO], 1u); break; } } } } while (0)
struct XcdBarrier { unsigned* bar; unsigned x; volatile LAS unsigned* st; };
__device__ __forceinline__ XcdBarrier xcd_barrier_post(unsigned* bar, volatile LAS unsigned* st) {
    XcdBarrier b; b.bar = bar; b.x = xb_xcc_id(); b.st = st;
    if (threadIdx.x == 0) (void)xb_add(&bar[XB_XCNT(b.x)], 1u);
    return b;
}
__device__ __forceinline__ void xcd_barrier_complete(unsigned* bar, unsigned x, unsigned& nloc, unsigned& nx) {
    const unsigned G = gridDim.x * gridDim.y * gridDim.z;
    unsigned sum, cnt, mine, sp = 0u;
    for (;;) {
        sum = 0u; cnt = 0u; mine = 0u;
#pragma unroll
        for (unsigned j = 0; j < 16; ++j) { const unsigned c = xb_ld(&bar[XB_XCNT(j)]); sum += c; cnt += (c > 0u) ? 1u : 0u; mine = (j == x) ? c : mine; }
        if (sum == G) break;
        __builtin_amdgcn_s_sleep(1);
        if ((++sp & 255u) == 0u) { if (xb_ld(&bar[XB_TMO])) break; if (sp > XB_SPIN_CAP) { atomicAdd(&bar[XB_TMO], 1u); break; } }
    }
    nloc = mine > 0u ? mine : 1u; nx = cnt > 0u ? cnt : 1u;
}
__device__ __forceinline__ void xcd_barrier(const XcdBarrier& b) {
    asm volatile("s_waitcnt vmcnt(0)" ::: "memory");
    __syncthreads();
    if (threadIdx.x == 0) {
        unsigned* bar = b.bar;
        __builtin_amdgcn_s_waitcnt(0);
        unsigned nloc = b.st[0], nx = b.st[1];
        if (nloc == 0u) { xcd_barrier_complete(bar, b.x, nloc, nx); b.st[0] = nloc; b.st[1] = nx; }
        const unsigned old = xb_add(&bar[XB_XSUB(b.x)], 1u);
        const unsigned gen = old / nloc;
        if (old + 1u == (gen + 1u) * nloc) {
            __builtin_amdgcn_fence(__ATOMIC_RELEASE, "agent");
            asm volatile("s_waitcnt vmcnt(0)" ::: "memory");
            const unsigned og = xb_add(&bar[XB_TOP], 1u);
            const unsigned tg = og / nx;
            if (og + 1u == (tg + 1u) * nx) xb_add(&bar[XB_TOPGEN], 1u);
            else XB_SPIN(xb_ld(&bar[XB_TOPGEN]) == tg, bar);
            __builtin_amdgcn_fence(__ATOMIC_ACQUIRE, "agent");
            xb_add(&bar[XB_XGEN(b.x)], 1u);
            asm volatile("s_waitcnt vmcnt(0)" ::: "memory");
        } else {
            XB_SPIN(xb_ld(&bar[XB_XGEN(b.x)]) == gen, bar);
            __builtin_amdgcn_fence(__ATOMIC_ACQUIRE, "agent");
            asm volatile("s_waitcnt vmcnt(0)" ::: "memory");
        }
    }
    __syncthreads();
}

#ifndef PROBE_MASK
#define PROBE_MASK 0u
#endif
#ifndef PHMASK
#define PHMASK 0xFFFFFFFFu
#endif
#define EN(i) (((PHMASK) >> (i)) & 1u)
__global__ void __launch_bounds__(512, 2) fwd_megakernel(Params p) {
    extern __shared__ __attribute__((aligned(16))) unsigned char shm[];
    float* ldsf = (float*)shm;
    LAS unsigned char* ldsg = (LAS unsigned char*)shm;
    unsigned char* ws = p.ws;
    float* ssb = (float*)(ws + WS_SS);
    volatile LAS unsigned* xst = (volatile LAS unsigned*)(ldsg + 133120);
    if (threadIdx.x == 0) { xst[0] = 0u; xst[1] = 0u; }
    __syncthreads();
    (void)xcd_barrier_post((unsigned*)(ws + WS_CTL) + 256, xst);
#define XBAR() do { XcdBarrier _b; _b.bar = (unsigned*)(p.ws + WS_CTL) + 256; _b.x = xb_xcc_id(); _b.st = (volatile LAS unsigned*)((LAS unsigned char*)shm + 133120); xcd_barrier(_b); } while (0)
#if PROBE_MASK
    unsigned long long tph = __builtin_amdgcn_s_memrealtime();
#endif
    for (int ph = p.ph_lo; ph < p.ph_hi; ++ph) {
        if (ph > p.ph_lo) {
            if (ph == 1) cg::this_grid().sync();
            else XBAR();
#if PROBE_MASK
            {
                const unsigned long long t1 = __builtin_amdgcn_s_memrealtime();
                if ((PROBE_MASK >> (ph - 1)) & 1u) { const unsigned long long dt = t1 - tph; while (__builtin_amdgcn_s_memrealtime() - t1 < dt) __builtin_amdgcn_s_sleep(8); }
                tph = __builtin_amdgcn_s_memrealtime();
            }
#endif
        }
        if (EN(0) && ph == 0) phase_prologue(p, ldsf);
        else if (EN(1) && (ph == 1 || ph == 5 || ph == 8 || ph == 14)) {
            pg8::Gemm g; pg8::EpiScaleBf16 E; int N;
            if (ph != 1) { float* sd = ssb + (ph == 5 ? 1 : (ph == 8 ? 2 : 3)) * MT; if (ph == 8) finalize_sample_rows<11>(p, sd); else finalize_sample_rows<16>(p, sd); XBAR(); }
            g.A = (const char*)(ws + WS_XB); g.lda = 2048; g.ldb = 2048;
            if (ph == 1) { g.Bt = (const char*)(ws + WS_WIN0); N = LD0; E.ss = ssb; }
            else if (ph == 5) { g.Bt = (const char*)(ws + WS_WUP0); N = LDU; E.ss = ssb + MT; }
            else if (ph == 8) { g.Bt = (const char*)(ws + WS_WIN1); N = LD1; E.ss = ssb + 2 * MT; }
            else { g.Bt = (const char*)(ws + WS_WUP1); N = LDU; E.ss = ssb + 3 * MT; }
            E.O = (bf16_t*)(ws + WS_PROJ); E.ldc = N;
            pg8::Order S; S.nMm = 32; S.nN = N / 256; S.n_main = 32 * S.nN; S.n_tail = 2 * S.nN; S.ksplit = 1; S.nt_full = 32; S.G = gridDim.x; S.c = blockIdx.x;
            S.a_t = (size_t)256 * 2048 * 2; S.b_t = (size_t)256 * 2048 * 2; S.acol = 0;
            pg8::gemm_phase<pg8::EpiScaleBf16>(ldsg, g, S, E);
        }
        else if (EN(4) && (ph == 4 || ph == 7 || ph == 13 || ph == 16)) {
            pg8::Gemm g; pg8::EpiResid E;
            g.A = (const char*)(ws + WS_ACT);
            if (ph == 4) { g.Bt = (const char*)(ws + WS_WOUT0); g.lda = 4096; E.ssout = ssb + MT; }
            else if (ph == 7) { g.Bt = (const char*)(ws + WS_WDN0); g.lda = DFF; E.ssout = ssb + 2 * MT; }
            else if (ph == 13) { g.Bt = (const char*)(ws + WS_WOUT1); g.lda = 4096; E.ssout = ssb + 3 * MT; }
            else { g.Bt = (const char*)(ws + WS_WDN1); g.lda = DFF; E.ssout = ssb + 4 * MT; }
            g.ldb = g.lda;
            E.X = (float*)(ws + WS_X); E.XB = (bf16_t*)(ws + WS_XB); E.part = (float*)(ws + WS_PROJ);
            pg8::Order S; S.nMm = 32; S.nN = 8; S.n_main = 256; S.nt_full = g.lda / 64; S.ksplit = (g.lda == 4096) ? 16 : 11; S.n_tail = 16 * S.ksplit; S.G = gridDim.x; S.c = blockIdx.x;
            S.a_t = (size_t)256 * g.lda * 2; S.b_t = (size_t)256 * g.ldb * 2; S.acol = 0;
            pg8::gemm_phase<pg8::EpiResid>(ldsg, g, S, E);
        }
        else if (EN(10) && ph == 10) {
            pg8::Gemm g; pg8::EpiLru E;
            g.A = (const char*)(ws + WS_XR); g.Bt = (const char*)(ws + WS_WLRU); g.lda = 2048; g.ldb = 256;
            E.br = p.in[26 + p.z]; E.bi = p.in[28 + p.z]; E.sp = (const float*)(ws + WS_SP); E.XR = (const bf16_t*)(ws + WS_XR);
            E.LA = (float*)(ws + WS_LA); E.LBv = (bf16_t*)(ws + WS_LBB);
            pg8::Order S; S.nMm = 34; S.nN = 16; S.n_main = 34 * 16; S.n_tail = 0; S.ksplit = 1; S.nt_full = 4 + p.z; S.G = gridDim.x; S.c = blockIdx.x;
            S.a_t = (size_t)256 * 2048 * 2; S.b_t = (size_t)256 * 256 * 2; S.acol = 512;
            pg8::gemm_phase<pg8::EpiLru>(ldsg, g, S, E);
        }
        else if (EN(2) && ph == 2) phase_rec0(p, ldsf);
        else if (EN(3) && ph == 3) phase_prep0(p);
        else if (EN(6) && ph == 6) phase_act(p, 0);
        else if (EN(9) && ph == 9) phase_lruconv(p);
        else if (EN(11) && ph == 11) phase_rec1(p, ldsf);
        else if (EN(12) && ph == 12) phase_prep1(p);
        else if (EN(15) && ph == 15) phase_act(p, 1);
        else if (EN(17) && ph == 17) phase_final(p);
    }
}

#ifndef N_LAUNCH_MODE
#define N_LAUNCH_MODE 0
#endif

extern "C" void kernel_launch(void* const* d_in, const int* in_sizes, int n_in, void* d_out, int out_size, void* d_ws, size_t ws_size, hipStream_t stream) {
    static int grid = 0;
    if (grid == 0) {
        if (n_in != 35 || (size_t)out_size != O_END || ws_size < WS_END) { fprintf(stderr, "kernel_launch: unexpected shapes: n_in %d out %d ws %zu (need %zu)\n", n_in, out_size, ws_size, (size_t)WS_END); grid = -1; return; }
        int dev = 0, cus = 0, per_cu = 0;
        hipGetDevice(&dev);
        hipDeviceGetAttribute(&cus, hipDeviceAttributeMultiprocessorCount, dev);
        if (hipFuncSetAttribute((const void*)fwd_megakernel, hipFuncAttributeMaxDynamicSharedMemorySize, LDS_BYTES) != hipSuccess) { fprintf(stderr, "kernel_launch: hipFuncSetAttribute failed\n"); grid = -1; return; }
        if (hipOccupancyMaxActiveBlocksPerMultiprocessor(&per_cu, (const void*)fwd_megakernel, 512, LDS_BYTES) != hipSuccess || per_cu < 1) { fprintf(stderr, "kernel_launch: occupancy query says %d\n", per_cu); per_cu = 1; }
        (void)hipGetLastError();
        grid = cus;
    }
    if (grid < 0) return;
    (void)hipMemsetAsync((char*)d_ws + WS_CTL, 0, 16384, stream);
    Params p{};
    for (int i = 0; i < 35; ++i) p.in[i] = (const float*)d_in[i];
    p.z = 0; p.pad = 0;
    p.out = (float*)d_out; p.ws = (unsigned char*)d_ws;
#if N_LAUNCH_MODE == 0
    p.ph_lo = 0; p.ph_hi = NPHASE;
    void* args[] = {&p};
    hipError_t e = hipLaunchCooperativeKernel((const void*)fwd_megakernel, dim3(grid), dim3(512), args, LDS_BYTES, stream);
    if (e != hipSuccess) fprintf(stderr, "cooperative launch failed: %s (grid %d)\n", hipGetErrorString(e), grid);
#else
    for (int ph = 0; ph < NPHASE; ++ph) {
        p.ph_lo = ph; p.ph_hi = ph + 1;
        hipLaunchKernelGGL(fwd_megakernel, dim3(grid), dim3(512), LDS_BYTES, stream, p);
    }
#endif
}
```

```cpp
#include <hip/hip_runtime.h>
#include <hip/hip_cooperative_groups.h>
#include <cstdio>
#include <cstdint>
namespace cg = cooperative_groups;

#define LAS __attribute__((address_space(3)))
typedef unsigned short bf16_t;
typedef short bf16x8 __attribute__((ext_vector_type(8)));
typedef float f32x4 __attribute__((ext_vector_type(4)));
typedef float f32x2 __attribute__((ext_vector_type(2)));
typedef unsigned u32x4 __attribute__((ext_vector_type(4)));
typedef unsigned u32x2 __attribute__((ext_vector_type(2)));

constexpr int D = 2048, MP = 8192, MS = 512, MT = 8704;
constexpr int LD0 = 11520, LD1 = 12288, LDU = 11264, DFF = 5632;
constexpr float EPS = 1e-6f;
constexpr size_t O_YP = 0;
constexpr size_t O_YS = O_YP + (size_t)4 * 2048 * 2048;
constexpr size_t O_SSMP = O_YS + (size_t)128 * 4 * 2048;
constexpr size_t O_SSMS = O_SSMP + (size_t)4 * 32 * 128 * 64;
constexpr size_t O_SCP = O_SSMS + (size_t)128 * 32 * 128 * 64;
constexpr size_t O_SCS = O_SCP + (size_t)4 * 3 * 3072;
constexpr size_t O_RETP = O_SCS + (size_t)128 * 3 * 3072;
constexpr size_t O_RETS = O_RETP + (size_t)4 * 8 * 128 * 256;
constexpr size_t O_HGP = O_RETS + (size_t)128 * 8 * 128 * 256;
constexpr size_t O_HGS = O_HGP + (size_t)4 * 16 * 128 * 128;
constexpr size_t O_LRUP = O_HGS + (size_t)128 * 16 * 128 * 128;
constexpr size_t O_LRUS = O_LRUP + (size_t)4 * 2048;
constexpr size_t O_LCP = O_LRUS + (size_t)128 * 2048;
constexpr size_t O_LCS = O_LCP + (size_t)4 * 3 * 2048;
constexpr size_t O_FCP = O_LCS + (size_t)128 * 3 * 2048;
constexpr size_t O_FCS = O_FCP + (size_t)2 * 4 * 2 * 5632;
constexpr size_t O_END = O_FCS + (size_t)2 * 128 * 2 * 5632;
constexpr size_t al256(size_t x) { return (x + 255) & ~(size_t)255; }
constexpr size_t WS_CTL = 0;
constexpr size_t WS_SS = 16384;
constexpr size_t WS_SP = al256(WS_SS + (size_t)5 * MT * 4);
constexpr size_t WS_LB = WS_SP + 8192;
constexpr size_t WS_WIN0 = WS_LB + 8192;
constexpr size_t WS_WOUT0 = WS_WIN0 + (size_t)LD0 * 2048 * 2;
constexpr size_t WS_WUP0 = WS_WOUT0 + (size_t)2048 * 4096 * 2;
constexpr size_t WS_WDN0 = WS_WUP0 + (size_t)LDU * 2048 * 2;
constexpr size_t WS_WIN1 = WS_WDN0 + (size_t)2048 * DFF * 2;
constexpr size_t WS_WOUT1 = WS_WIN1 + (size_t)LD1 * 2048 * 2;
constexpr size_t WS_WUP1 = WS_WOUT1 + (size_t)2048 * 4096 * 2;
constexpr size_t WS_WDN1 = WS_WUP1 + (size_t)LDU * 2048 * 2;
constexpr size_t WS_WLRU = WS_WDN1 + (size_t)2048 * DFF * 2;
constexpr size_t WS_X = WS_WLRU + (size_t)16 * 256 * 256 * 2;
constexpr size_t WS_XB = WS_X + (size_t)MT * 2048 * 4;
constexpr size_t WS_PROJ = WS_XB + (size_t)MT * 2048 * 2;
constexpr size_t WS_ACT = WS_PROJ + (size_t)MT * LD1 * 2;
constexpr size_t WS_YZ = WS_ACT + (size_t)MT * DFF * 2;
constexpr size_t WS_LA = WS_YZ + (size_t)MT * 4096 * 2;
constexpr size_t WS_LBB = WS_LA + (size_t)MT * 2048 * 4;
constexpr size_t WS_XR = WS_LBB + (size_t)MT * 2048 * 2;
constexpr size_t WS_END = WS_XR + (size_t)MT * 2048 * 2;

constexpr int LDS_BYTES = 133120 + 256;
constexpr int NPHASE = 18;

struct Params {
    const float* in[35];
    float* out;
    unsigned char* ws;
    int ph_lo, ph_hi;
    int z, pad;
};

__device__ __forceinline__ float bf2f(unsigned v) { return __uint_as_float(v << 16); }
__device__ __forceinline__ unsigned pk2(float lo, float hi) { unsigned r; asm volatile("v_cvt_pk_bf16_f32 %0, %1, %2" : "=v"(r) : "v"(lo), "v"(hi)); return r; }
__device__ __forceinline__ unsigned pk2_sw(float lo, float hi) {
    unsigned a = __float_as_uint(lo), b = __float_as_uint(hi); a += 0x7fffu + ((a >> 16) & 1u); b += 0x7fffu + ((b >> 16) & 1u); return (a >> 16) | (b & 0xffff0000u); }
__device__ __forceinline__ bf16_t f2bf(float x) { return (bf16_t)(pk2(x, 0.f) & 0xffffu); }
__device__ __forceinline__ float sigm(float x) { return __builtin_amdgcn_rcpf(1.f + __expf(-x)); }
__device__ __forceinline__ float silu(float x) { return x * __builtin_amdgcn_rcpf(1.f + __expf(-x)); }
__device__ __forceinline__ float softplus(float x) { return fmaxf(x, 0.f) + log1pf(__expf(-fabsf(x))); }
__device__ __forceinline__ float gelu_tanh(float x) { const float u = 0.7978845608f * (x + 0.044715f * x * x * x); const float t = 1.f - 2.f * __builtin_amdgcn_rcpf(1.f + __expf(2.f * u)); return 0.5f * x * (1.f + t); }
__device__ __forceinline__ float wave_sum(float v) {
#pragma unroll
    for (int o = 1; o < 64; o <<= 1) v += __shfl_xor(v, o);
    return v;
}
__device__ __forceinline__ void unpack8(u32x4 r, float* f) {
    f[0] = bf2f(r.x & 0xffffu); f[1] = __uint_as_float(r.x & 0xffff0000u); f[2] = bf2f(r.y & 0xffffu); f[3] = __uint_as_float(r.y & 0xffff0000u);
    f[4] = bf2f(r.z & 0xffffu); f[5] = __uint_as_float(r.z & 0xffff0000u); f[6] = bf2f(r.w & 0xffffu); f[7] = __uint_as_float(r.w & 0xffff0000u);
}
__device__ __forceinline__ void unpack4(u32x2 r, float* f) {
    f[0] = bf2f(r.x & 0xffffu); f[1] = __uint_as_float(r.x & 0xffff0000u); f[2] = bf2f(r.y & 0xffffu); f[3] = __uint_as_float(r.y & 0xffff0000u);
}
#define LDS_WAIT() asm volatile("s_waitcnt lgkmcnt(0)" ::: "memory")

namespace pg8 {
constexpr int BM = 256, BK = 64, HALF = 128, HTB = HALF * BK * 2, NXCD = 8, WGM = 8;
__device__ __forceinline__ int lds_byte(int r, int c) { const int st = (r >> 4) * 2 + (c >> 5), rr = r & 15, cc = c & 31, ob = rr * 64 + cc * 2; return st * 1024 + (ob ^ (((ob >> 9) & 1) << 5)); }
__device__ __forceinline__ void stage_rc(int b, int& R, int& C) { const int st = b / 1024, sb = b % 1024, swz = sb ^ (((sb >> 9) & 1) << 5); R = (st >> 1) * 16 + swz / 64; C = (st & 1) * 32 + (swz % 64) / 2; }
__device__ __forceinline__ int perm32(int rho) { const int n = rho >> 4, i = rho & 15; return 8 * (i >> 2) + 4 * n + (i & 3); }

struct Unit { int pm, pn, nt, kind, ks; size_t aoff, boff; };
struct Gemm { const char* A; const char* Bt; int lda, ldb; };
struct Order {
    int nMm, nN, n_main, n_tail, ksplit, nt_full, G, c; size_t a_t, b_t, acol;
    __device__ __forceinline__ bool next(int i, Unit& u) const {
        const long L = (long)i * G + c;
        if (L < n_main) {
            const int nwg = n_main;
            int wgid = (int)L; { const int q = nwg / NXCD, r = nwg % NXCD, xcd = wgid % NXCD, off = wgid / NXCD; wgid = (xcd < r ? xcd * (q + 1) : r * (q + 1) + (xcd - r) * q) + off; }
            const int nig = WGM * nN, gid = wgid / nig, fm = gid * WGM, gsz = (nMm - fm) < WGM ? (nMm - fm) : WGM;
            u.pm = fm + ((wgid % nig) % gsz); u.pn = (wgid % nig) / gsz; u.nt = nt_full; u.kind = 0; u.ks = 0;
            u.aoff = (size_t)u.pm * a_t + (size_t)(u.pn >> 1) * acol; u.boff = (size_t)u.pn * b_t; return true;
        }
        const int Lt = (int)(L - n_main); if (Lt >= n_tail) return false;
        const int ks = Lt % ksplit, r = Lt / ksplit;
        u.pm = nMm + (r & 1); u.pn = r >> 1; u.nt = nt_full / ksplit; u.kind = ksplit > 1 ? 1 : 0; u.ks = ks;
        const size_t kofs = (size_t)ks * u.nt * (BK * 2);
        u.aoff = (size_t)u.pm * a_t + (size_t)(u.pn >> 1) * acol + kofs; u.boff = (size_t)u.pn * b_t + kofs; return true;
    }
};

struct EpiScaleBf16 {
    static constexpr bool PERM = true;
    bf16_t* O; int ldc; const float* ss;
    __device__ __forceinline__ void prefetch(const Unit&, int, int, float (&)[8]) const {}
    __device__ __forceinline__ void operator()(const f32x4 (&acc)[2][2][4][2], const Unit& u, int wr, int wc, int fr, int fq, const float (&)[8]) const {
        float ssv[8];
        {
            const int r0 = u.pm * BM + wr * 64 + fr;
#pragma unroll
            for (int ai = 0; ai < 2; ++ai)
#pragma unroll
                for (int m = 0; m < 4; ++m) ssv[ai * 4 + m] = ss[r0 + ai * HALF + m * 16];
        }
        const int row0 = u.pm * BM + wr * 64 + fr, col0 = u.pn * BM + wc * 32 + 8 * fq;
#pragma unroll
        for (int ai = 0; ai < 2; ++ai)
#pragma unroll
            for (int m = 0; m < 4; ++m) {
                const int row = row0 + ai * HALF + m * 16;
                const float rs = rsqrtf(ssv[ai * 4 + m] * (1.0f / 2048.0f) + EPS);
                bf16_t* rowp = O + ((unsigned)row * (unsigned)ldc + (unsigned)col0);
#pragma unroll
                for (int bj = 0; bj < 2; ++bj) {
                    const f32x4 v0 = acc[ai][bj][m][0] * rs, v1 = acc[ai][bj][m][1] * rs;
                    u32x4 w; w.x = pk2(v0[0], v0[1]); w.y = pk2(v0[2], v0[3]); w.z = pk2(v1[0], v1[1]); w.w = pk2(v1[2], v1[3]);
                    *(u32x4*)(rowp + bj * HALF) = w;
                }
            }
    }
};
struct EpiResid {
    static constexpr bool PERM = false;
    float* X; bf16_t* XB; float* ssout; float* part;
    __device__ __forceinline__ void prefetch(const Unit&, int, int, float (&)[8]) const {}
    __device__ __forceinline__ void operator()(const f32x4 (&acc)[2][2][4][2], const Unit& u, int wr, int wc, int fr, int fq, const float (&)[8]) const {
        const int row0 = u.pm * BM + wr * 64 + fr, col0 = u.pn * BM + wc * 32 + 4 * fq;
        if (u.kind == 1) {
            float* P = part + (size_t)u.ks * (512 * 2048);
#pragma unroll
            for (int ai = 0; ai < 2; ++ai)
#pragma unroll
                for (int m = 0; m < 4; ++m) {
                    const unsigned off = (unsigned)(row0 - MP + ai * HALF + m * 16) * 2048u + (unsigned)col0;
#pragma unroll
                    for (int bj = 0; bj < 2; ++bj)
#pragma unroll
                        for (int n = 0; n < 2; ++n) *(f32x4*)(P + off + bj * HALF + n * 16) = acc[ai][bj][m][n];
                }
            return;
        }
#pragma unroll
        for (int ai = 0; ai < 2; ++ai)
#pragma unroll
            for (int mp = 0; mp < 4; mp += 2) {
                f32x4 xin[2][2][2];
#pragma unroll
                for (int mm = 0; mm < 2; ++mm)
#pragma unroll
                    for (int bj = 0; bj < 2; ++bj)
#pragma unroll
                        for (int n = 0; n < 2; ++n) xin[mm][bj][n] = *(const f32x4*)(X + ((unsigned)(row0 + ai * HALF + (mp + mm) * 16) * 2048u + (unsigned)col0 + bj * HALF + n * 16));
#pragma unroll
                for (int mm = 0; mm < 2; ++mm) {
                    const int row = row0 + ai * HALF + (mp + mm) * 16;
                    const unsigned off = (unsigned)row * 2048u + (unsigned)col0;
                    float sq = 0.f;
#pragma unroll
                    for (int bj = 0; bj < 2; ++bj)
#pragma unroll
                        for (int n = 0; n < 2; ++n) {
                            const unsigned o = off + bj * HALF + n * 16;
                            const f32x4 x = xin[mm][bj][n] + acc[ai][bj][mp + mm][n];
                            *(f32x4*)(X + o) = x;
                            u32x2 w; w.x = pk2(x[0], x[1]); w.y = pk2(x[2], x[3]);
                            *(u32x2*)(XB + o) = w;
                            sq += (x[0] * x[0] + x[1] * x[1]) + (x[2] * x[2] + x[3] * x[3]);
                        }
                    sq += __shfl_xor(sq, 16); sq += __shfl_xor(sq, 32);
                    if (fq == 0) atomicAdd(ssout + row, sq);
                }
                asm volatile("" ::: "memory");
            }
    }
};
struct EpiLru {
    static constexpr bool PERM = false;
    const float* br; const float* bi; const float* sp; const bf16_t* XR; float* LA; bf16_t* LBv;
    __device__ __forceinline__ void prefetch(const Unit&, int, int, float (&)[8]) const {}
    __device__ __forceinline__ void operator()(const f32x4 (&acc)[2][2][4][2], const Unit& u, int wr, int wc, int fr, int fq, const float (&)[8]) const {
        const int row0 = u.pm * BM + wr * 64 + fr;
        const int cbase = (u.pn >> 1) * 256 + (u.pn & 1) * 128 + wc * 32 + 4 * fq;
        f32x4 br4[2], bi4[2], sp4[2];
#pragma unroll
        for (int n = 0; n < 2; ++n) { br4[n] = *(const f32x4*)(br + cbase + n * 16); bi4[n] = *(const f32x4*)(bi + cbase + n * 16); sp4[n] = *(const f32x4*)(sp + cbase + n * 16); }
#pragma unroll
        for (int ai = 0; ai < 2; ++ai)
#pragma unroll
            for (int mp = 0; mp < 4; mp += 2) {
                u32x2 xrr[2][2];
#pragma unroll
                for (int mm = 0; mm < 2; ++mm)
#pragma unroll
                    for (int n = 0; n < 2; ++n) xrr[mm][n] = *(const u32x2*)(XR + ((unsigned)(row0 + ai * HALF + (mp + mm) * 16) * 2048u + (unsigned)(cbase + n * 16)));
#pragma unroll
                for (int mm = 0; mm < 2; ++mm) {
                    const int row = row0 + ai * HALF + (mp + mm) * 16;
                    const bool first = (row < MP) && ((row & 2047) == 0);
#pragma unroll
                    for (int n = 0; n < 2; ++n) {
                        const unsigned o = (unsigned)row * 2048u + (unsigned)(cbase + n * 16);
                        float xr[4]; unpack4(xrr[mm][n], xr);
                        f32x4 av; float bb[4];
#pragma unroll
                        for (int j = 0; j < 4; ++j) {
                            const float r = sigm(acc[ai][0][mp + mm][n][j] + br4[n][j]), gi = sigm(acc[ai][1][mp + mm][n][j] + bi4[n][j]);
                            const float la = -8.0f * r * sp4[n][j];
                            const float a = __expf(la);
                            const float mult = first ? 1.0f : __builtin_amdgcn_sqrtf(fmaxf(1.0f - a * a, 0.f));
                            av[j] = a; bb[j] = mult * gi * xr[j];
                        }
                        *(f32x4*)(LA + o) = av;
                        u32x2 w; w.x = pk2(bb[0], bb[1]); w.y = pk2(bb[2], bb[3]);
                        *(u32x2*)(LBv + o) = w;
                    }
                }
                asm volatile("" ::: "memory");
            }
    }
};

template <class Epi>
__device__ __forceinline__ void gemm_phase(LAS unsigned char* lds, const Gemm g, const Order& S, const Epi& E) {
    int tid = threadIdx.x; asm volatile("" : "+v"(tid));
    const int wid = __builtin_amdgcn_readfirstlane(tid >> 6), lane = tid & 63, wr = wid >> 2, wc = wid & 3, fr = lane & 15, fq = lane >> 4;
    unsigned voffA[2], voffB[2];
#pragma unroll
    for (int i = 0; i < 2; ++i) { int R, C; stage_rc(tid * 16 + i * 8192, R, C); const int Rb = Epi::PERM ? ((R & ~31) + perm32(R & 31)) : R;
        voffA[i] = (unsigned)(R * g.lda + C) * 2u; voffB[i] = (unsigned)(Rb * g.ldb + C) * 2u; }
    const size_t kstep = (size_t)(BK * 2);
    const size_t hstepA = (size_t)HALF * g.lda * 2, hstepB = (size_t)HALF * g.ldb * 2;
    const unsigned ldsw = (unsigned)wid * 1024u;
    const int aoff = lds_byte(wr * 64 + fr, fq * 8), boff = lds_byte(wc * 32 + fr, fq * 8);
#define PG8_SA(b, h) (((b) * 2 + (h)) * HTB)
#define PG8_SB(b, h) ((4 + (b) * 2 + (h)) * HTB)
#define PG8_STAGE(bufoff, gbase, voff) do { _Pragma("unroll") for (int _i = 0; _i < 2; ++_i) \
        __builtin_amdgcn_global_load_lds((const unsigned*)((const char*)(gbase) + (voff)[_i]), (LAS unsigned*)(lds + (bufoff) + ldsw + _i * 8192), 16, 0, 0); } while (0)
#define PG8_LDA(dst, b, h) do { _Pragma("unroll") for (int m = 0; m < 4; ++m) _Pragma("unroll") for (int k = 0; k < 2; ++k) dst[m][k] = *(const LAS bf16x8*)(lds + PG8_SA(b, h) + aoff + m * 2048 + k * 1024); } while (0)
#define PG8_LDB(dst, b, h) do { _Pragma("unroll") for (int n = 0; n < 2; ++n) _Pragma("unroll") for (int k = 0; k < 2; ++k) dst[n][k] = *(const LAS bf16x8*)(lds + PG8_SB(b, h) + boff + n * 2048 + k * 1024); } while (0)
#define PG8_MMA(ai, bj, At, Bt) do { __builtin_amdgcn_s_setprio(1); _Pragma("unroll") for (int m = 0; m < 4; ++m) _Pragma("unroll") for (int n = 0; n < 2; ++n) _Pragma("unroll") for (int k = 0; k < 2; ++k) \
        acc[ai][bj][m][n] = __builtin_amdgcn_mfma_f32_16x16x32_bf16(Bt[n][k], At[m][k], acc[ai][bj][m][n], 0, 0, 0); __builtin_amdgcn_s_setprio(0); } while (0)
#define PG8_WAIT_V(n) asm volatile("s_waitcnt vmcnt(" #n ")" ::: "memory")
#define PG8_WAIT_L(n) asm volatile("s_waitcnt lgkmcnt(" #n ")" ::: "memory")
#define PG8_BAR __builtin_amdgcn_s_barrier()
#define PG8_SCHED __builtin_amdgcn_sched_barrier(0)
    Unit cur, nxt; int ui = 0;
    if (!S.next(0, cur)) return;
    f32x4 acc[2][2][4][2];
#pragma unroll
    for (int a = 0; a < 2; ++a)
#pragma unroll
        for (int b = 0; b < 2; ++b)
#pragma unroll
            for (int m = 0; m < 4; ++m)
#pragma unroll
                for (int n = 0; n < 2; ++n) acc[a][b][m][n] = (f32x4){0.f, 0.f, 0.f, 0.f};
    bf16x8 At[4][2], B0[2][2], B1[2][2];
    const char* cA = g.A + cur.aoff; const char* cB = g.Bt + cur.boff;
    float epf[8] = {0.f, 0.f, 0.f, 0.f, 0.f, 0.f, 0.f, 0.f};
    E.prefetch(cur, wr, fr, epf);
    PG8_STAGE(PG8_SB(0, 0), cB, voffB); PG8_STAGE(PG8_SB(0, 1), cB + hstepB, voffB); PG8_STAGE(PG8_SA(0, 0), cA, voffA); PG8_STAGE(PG8_SA(0, 1), cA + hstepA, voffA);
    if (wr == 1) PG8_BAR;
    PG8_WAIT_V(2); PG8_BAR;
    PG8_STAGE(PG8_SB(1, 0), cB + kstep, voffB); PG8_STAGE(PG8_SA(1, 0), cA + kstep, voffA); PG8_STAGE(PG8_SB(1, 1), cB + hstepB + kstep, voffB);
    PG8_WAIT_V(6); PG8_BAR;
    for (;;) {
        const bool has_next = S.next(ui + 1, nxt);
        const char* nA = has_next ? g.A + nxt.aoff : cA; const char* nB = has_next ? g.Bt + nxt.boff : cB;
        const int nt = cur.nt;
        for (int t = 0; t < nt; t += 2) {
            const bool last = (t == nt - 2);
            const char* a1 = cA + (size_t)(t + 1) * kstep;
            const char* a2 = last ? nA : cA + (size_t)(t + 2) * kstep; const char* b2 = last ? nB : cB + (size_t)(t + 2) * kstep;
            const char* a3 = a2 + kstep; const char* b3 = b2 + kstep;
            PG8_LDB(B0, 0, 0); PG8_LDB(B1, 0, 1); PG8_SCHED; PG8_LDA(At, 0, 0); PG8_STAGE(PG8_SA(1, 1), a1 + hstepA, voffA);
            PG8_WAIT_V(8); PG8_WAIT_L(0); PG8_BAR; PG8_MMA(0, 0, At, B0); PG8_MMA(0, 1, At, B1); PG8_BAR; PG8_SCHED;
            PG8_LDA(At, 0, 1); PG8_STAGE(PG8_SB(0, 0), b2, voffB); PG8_STAGE(PG8_SB(0, 1), b2 + hstepB, voffB); PG8_STAGE(PG8_SA(0, 0), a2, voffA);
            PG8_WAIT_V(8); PG8_WAIT_L(0); PG8_BAR; PG8_MMA(1, 0, At, B0); PG8_MMA(1, 1, At, B1); PG8_BAR; PG8_SCHED;
            PG8_LDB(B0, 1, 0); PG8_LDB(B1, 1, 1); PG8_SCHED; PG8_LDA(At, 1, 0); PG8_STAGE(PG8_SA(0, 1), a2 + hstepA, voffA);
            PG8_WAIT_V(8); PG8_WAIT_L(0); PG8_BAR; PG8_MMA(0, 0, At, B0); PG8_MMA(0, 1, At, B1); PG8_BAR; PG8_SCHED;
            PG8_LDA(At, 1, 1); PG8_STAGE(PG8_SB(1, 0), b3, voffB); PG8_STAGE(PG8_SB(1, 1), b3 + hstepB, voffB); PG8_STAGE(PG8_SA(1, 0), a3, voffA);
            PG8_WAIT_V(8); PG8_WAIT_L(0); PG8_BAR; PG8_MMA(1, 0, At, B0); PG8_MMA(1, 1, At, B1); PG8_BAR; PG8_SCHED;
        }
        if (wr == 0) PG8_BAR;
        E(acc, cur, wr, wc, fr, fq, epf);
        if (!has_next) break;
#pragma unroll
        for (int a = 0; a < 2; ++a)
#pragma unroll
            for (int b = 0; b < 2; ++b)
#pragma unroll
                for (int m = 0; m < 4; ++m)
#pragma unroll
                    for (int n = 0; n < 2; ++n) acc[a][b][m][n] = (f32x4){0.f, 0.f, 0.f, 0.f};
        cur = nxt; cA = nA; cB = nB; ++ui;
        E.prefetch(cur, wr, fr, epf);
        if (wr == 1) PG8_BAR;
    }
    PG8_WAIT_V(0);
    PG8_BAR;
#undef PG8_SA
#undef PG8_SB
#undef PG8_STAGE
#undef PG8_LDA
#undef PG8_LDB
#undef PG8_MMA
#undef PG8_WAIT_V
#undef PG8_WAIT_L
#undef PG8_BAR
#undef PG8_SCHED
}
}

__device__ __forceinline__ void tr_item(const float* __restrict__ W, int ldw, int N, int k0, int n0, const float* __restrict__ scale, bf16_t* __restrict__ dst, int ldd, float* scr, int lane) {
    const int r4 = lane >> 4, c4 = (lane & 15) * 4;
    const bool inb = (n0 + c4) < N;
    f32x4 v[16];
#pragma unroll
    for (int i = 0; i < 16; ++i) v[i] = inb ? __builtin_nontemporal_load((const f32x4*)(W + (size_t)(k0 + 4 * i + r4) * ldw + n0 + c4)) : (f32x4){0.f, 0.f, 0.f, 0.f};
#pragma unroll
    for (int i = 0; i < 16; ++i) { float* d = scr + (4 * i + r4) * 65 + c4; d[0] = v[i][0]; d[1] = v[i][1]; d[2] = v[i][2]; d[3] = v[i][3]; }
    LDS_WAIT();
    const int c = lane & 7;
    f32x4 s0 = (f32x4){1.f, 1.f, 1.f, 1.f}, s1 = s0;
    if (scale) { s0 = *(const f32x4*)(scale + k0 + 8 * c); s1 = *(const f32x4*)(scale + k0 + 8 * c + 4); }
#pragma unroll
    for (int j = 0; j < 8; ++j) { const int n = (lane >> 3) + 8 * j; const float* sp = scr + (8 * c) * 65 + n;
        u32x4 o; o.x = pk2(sp[0 * 65] * s0[0], sp[1 * 65] * s0[1]); o.y = pk2(sp[2 * 65] * s0[2], sp[3 * 65] * s0[3]); o.z = pk2(sp[4 * 65] * s1[0], sp[5 * 65] * s1[1]); o.w = pk2(sp[6 * 65] * s1[2], sp[7 * 65] * s1[3]);
        *(u32x4*)(dst + (size_t)n * ldd + 8 * c) = o; }
    LDS_WAIT();
}

__device__ __forceinline__ void phase_prologue(const Params& p, float* ldsf) {
    int tid = threadIdx.x; asm volatile("" : "+v"(tid));
    const int wave = tid >> 6, lane = tid & 63;
    int bid = blockIdx.x; asm volatile("" : "+s"(bid));
    const int gw = bid * 8 + wave, NGW = gridDim.x * 8;
    float* scr = ldsf + wave * 4160;
    unsigned char* ws = p.ws;
    constexpr int I0 = 32 * 177, I1 = 64 * 32, I2 = 32 * 176, I3 = 88 * 32, I4 = 32 * 192, I5 = I1, I6 = I2, I7 = I3, I8 = 128, I9 = 128;
    constexpr int NIT = I0 + I1 + I2 + I3 + I4 + I5 + I6 + I7 + I8 + I9;
    for (int it = gw; it < NIT; it += NGW) {
        int r = it;
        const float* W; int K, N; const float* sc = nullptr; bf16_t* WT;
        if (r < I0) { W = p.in[12 + p.z]; K = 2048; N = 11296; sc = p.in[9 + p.z]; WT = (bf16_t*)(ws + WS_WIN0); }
        else if ((r -= I0) < I1) { W = p.in[19 + p.z]; K = 4096; N = 2048; WT = (bf16_t*)(ws + WS_WOUT0); }
        else if ((r -= I1) < I2) { W = p.in[31 + p.z]; K = 2048; N = 11264; sc = p.in[10 + p.z]; WT = (bf16_t*)(ws + WS_WUP0); }
        else if ((r -= I2) < I3) { W = p.in[34 + p.z]; K = 5632; N = 2048; WT = (bf16_t*)(ws + WS_WDN0); }
        else if ((r -= I3) < I4) { W = p.in[20 + p.z]; K = 2048; N = 12288; sc = p.in[9 + p.z] + 2048; WT = (bf16_t*)(ws + WS_WIN1); }
        else if ((r -= I4) < I5) { W = p.in[30 + p.z]; K = 4096; N = 2048; WT = (bf16_t*)(ws + WS_WOUT1); }
        else if ((r -= I5) < I6) { W = p.in[31 + p.z] + (size_t)2048 * 11264; K = 2048; N = 11264; sc = p.in[10 + p.z] + 2048; WT = (bf16_t*)(ws + WS_WUP1); }
        else if ((r -= I6) < I7) { W = p.in[34 + p.z] + (size_t)5632 * 2048; K = 5632; N = 2048; WT = (bf16_t*)(ws + WS_WDN1); }
        else {
            r -= I7; const int which = r >> 7; r &= 127;
            const int blk = r >> 4, kb = (r >> 2) & 3, nb = r & 3, n0 = 64 * nb, k0 = 64 * kb;
            const float* Wl = (which ? p.in[27 + p.z] : p.in[25 + p.z]) + (size_t)blk * 65536;
            const int drow = (blk * 2 + (n0 >> 7)) * 256 + which * 128 + (n0 & 127);
            tr_item(Wl, 256, 256, k0, n0, nullptr, (bf16_t*)(ws + WS_WLRU) + (size_t)drow * 256 + k0, 256, scr, lane);
            continue;
        }
        const int nblk = (N + 63) / 64, kbl = r & 7, r8 = r >> 3, nb = r8 % nblk, kb = (r8 / nblk) * 8 + kbl, k0 = 64 * kb, n0 = 64 * nb;
        tr_item(W, N, N, k0, n0, sc, WT + (size_t)n0 * K + k0, K, scr, lane);
    }
    {
        u32x4* z = (u32x4*)((bf16_t*)(ws + WS_WIN0) + (size_t)11296 * 2048);
        const int n16 = 224 * 2048 * 2 / 16;
        for (int i = blockIdx.x * 512 + tid; i < n16; i += gridDim.x * 512) z[i] = (u32x4){0u, 0u, 0u, 0u};
    }
    float* X = (float*)(ws + WS_X); bf16_t* XB = (bf16_t*)(ws + WS_XB); float* ss = (float*)(ws + WS_SS);
    for (int row = gw; row < MT; row += NGW) {
        const float* src = row < MP ? p.in[0 + p.z] + (size_t)row * 2048 : p.in[1 + p.z] + (size_t)(row - MP) * 2048;
        float s = 0.f;
#pragma unroll
        for (int j = 0; j < 8; ++j) {
            const f32x4 v = __builtin_nontemporal_load((const f32x4*)(src + (lane + 64 * j) * 4));
            *(f32x4*)(X + (size_t)row * 2048 + (lane + 64 * j) * 4) = v;
            u32x2 w; w.x = pk2(v[0], v[1]); w.y = pk2(v[2], v[3]);
            *(u32x2*)(XB + (size_t)row * 2048 + (lane + 64 * j) * 4) = w;
            s += (v[0] * v[0] + v[1] * v[1]) + (v[2] * v[2] + v[3] * v[3]);
        }
        s = wave_sum(s);
        if (lane == 0) ss[row] = s;
    }
    for (int i = blockIdx.x * 512 + tid; i < 4 * MT; i += gridDim.x * 512) ss[MT + i] = 0.f;
    for (int i = blockIdx.x * 512 + tid; i < 2048; i += gridDim.x * 512) {
        ((float*)(ws + WS_SP))[i] = softplus(-p.in[29 + p.z][i]);
        ((float*)(ws + WS_LB))[i] = sigm(p.in[21 + p.z][2048 + i] - p.in[21 + p.z][i]);
    }
}

__device__ __forceinline__ int next_item(unsigned* ctr, float* ldsf) {
    __syncthreads();
    if (threadIdx.x == 0) ((volatile unsigned*)ldsf)[33284] = atomicAdd(ctr, 1u);
    __syncthreads();
    return (int)((volatile unsigned*)ldsf)[33284];
}

template <int TYPE, int VW>
__device__ __forceinline__ void rec_item(const Params& p, float* ldsf, int sample, int b, int h, int s) {
    constexpr int NV = VW / 16;
    typedef float VT __attribute__((ext_vector_type(NV)));
    int tid = threadIdx.x; asm volatile("" : "+v"(tid));
    const int w = tid >> 6, lane = tid & 63, kg = lane >> 4, vq = lane & 15, kb = 16 * w + 4 * kg;
    const int L = sample ? 4 : 2048, row0 = sample ? MP + 4 * b : 2048 * b, pos0 = sample ? 16384 : 0;
    constexpr int LDP = TYPE < 2 ? LD0 : LD1;
    const bf16_t* proj = (const bf16_t*)(p.ws + WS_PROJ) + (size_t)row0 * LDP;
    bf16_t* yz = (bf16_t*)(p.ws + WS_YZ) + (size_t)row0 * 4096;
    float* part = ldsf + 8192;
    int colA = -1, colB = -1, role = -1, didx = 0;
    float w0 = 0.f, w1 = 0.f, w2 = 0.f, w3 = 0.f, cbias = 0.f, c0 = 0.f, c1 = 0.f, c2 = 0.f, aux = 0.f, aux2 = 0.f;
    if constexpr (TYPE == 0) {
        if (tid < 320) {
            role = tid < 128 ? 0 : (tid < 256 ? 1 : 2);
            didx = tid < 128 ? tid : (tid < 256 ? tid - 128 : tid - 256);
            const int ch = tid < 128 ? 2560 + (h >> 3) * 128 + tid : (tid < 256 ? 2048 + (h >> 3) * 128 + (tid - 128) : h * 64 + (tid - 256));
            colA = 2048 + ch;
            const float* cw = p.in[13 + p.z];
            w0 = cw[ch]; w1 = cw[3072 + ch]; w2 = cw[2 * 3072 + ch]; w3 = cw[3 * 3072 + ch]; cbias = p.in[14 + p.z][ch];
            if (sample) { const float* st = p.in[3 + p.z] + (size_t)b * 3 * 3072; c0 = st[ch]; c1 = st[3072 + ch]; c2 = st[2 * 3072 + ch]; }
        } else if (tid < 328) { role = 3; didx = tid - 320; colA = 5120 + h; aux = p.in[15 + p.z][h]; aux2 = -__expf(p.in[16 + p.z][h]); }
    } else if constexpr (TYPE == 1) {
        if (tid < 128) { role = tid < 64 ? 0 : 1; didx = tid & 63; colA = (tid < 64 ? 5152 : 6176) + h * 128 + didx; colB = colA + 64;
            aux = exp2f(-(float)didx * 0.20762050593046014f); }
        else if (tid < 128 + VW) { role = 2; didx = tid - 128; colA = 7200 + h * 256 + s * VW + didx; }
    } else {
        if (tid < 128) { role = 0; didx = tid; colA = h * 128 + tid; }
        else if (tid < 256) { role = 1; didx = tid - 128; colA = 2048 + h * 128 + didx; aux = ((const float*)(p.ws + WS_LB))[h * 128 + didx]; }
        else if (tid < 256 + VW) { role = 2; didx = tid - 256; colA = 4096 + h * 128 + s * VW + didx; }
    }
    const float Dh = TYPE == 0 ? p.in[17 + p.z][h] : 0.f;
    const float gamma = TYPE == 1 ? 1.0f - exp2f(-5.0f - (float)h * (4.0f / 7.0f)) : 0.f;
    const int ldS = TYPE == 0 ? 64 : (TYPE == 1 ? 256 : 128);
    size_t soff;
    if constexpr (TYPE == 0) soff = ((size_t)(b * 32 + h) * 128) * 64;
    else if constexpr (TYPE == 1) soff = ((size_t)(b * 8 + h) * 128) * 256 + s * VW;
    else soff = ((size_t)(b * 16 + h) * 128) * 128 + s * VW;
    const float* S0 = TYPE == 0 ? p.in[2 + p.z] : (TYPE == 1 ? p.in[4 + p.z] : p.in[5 + p.z]);
    float* Sout = p.out + (TYPE == 0 ? (sample ? O_SSMS : O_SSMP) : (TYPE == 1 ? (sample ? O_RETS : O_RETP) : (sample ? O_HGS : O_HGP))) + soff;
    VT S[4];
#pragma unroll
    for (int i = 0; i < 4; ++i) { if (sample) S[i] = *(const VT*)(S0 + soff + (size_t)(kb + i) * ldS + NV * vq); else S[i] = (VT)(0.f); }
    unsigned short ra[8], rb[8]; unsigned short zr = 0;
    const int R = (L + 7) >> 3;
    auto load_raw = [&](int r) {
#pragma unroll
        for (int t = 0; t < 8; ++t) {
            const int tt = 8 * r + t;
            ra[t] = 0; rb[t] = 0;
            if (tt < L) {
                if (colA >= 0) ra[t] = proj[(size_t)tt * LDP + colA];
                if (TYPE == 1 && colB >= 0) rb[t] = proj[(size_t)tt * LDP + colB];
            }
        }
        if (TYPE == 0) { const int tt = 8 * r + w; if (tt < L) zr = proj[(size_t)tt * LDP + h * 64 + lane]; }
    };
    load_raw(0);
    for (int r = 0; r < R; ++r) {
        const int nv = (L - 8 * r) < 8 ? (L - 8 * r) : 8;
        float* stg = ldsf + (r & 1) * 4096;
        float* qs = stg; float* ks = stg + 1024; float* as = stg + 2048; float* vs = stg + 3072; float* ad = stg + 3584;
        if constexpr (TYPE == 0) {
            if (role >= 0 && role < 3) {
                float* dst = role == 0 ? qs : (role == 1 ? ks : vs); const int dstr = role == 2 ? 64 : 128;
#pragma unroll
                for (int t = 0; t < 8; ++t) {
                    const float x = bf2f(ra[t]);
                    const float y = cbias + w0 * c0 + w1 * c1 + w2 * c2 + w3 * x;
                    c0 = c1; c1 = c2; c2 = x;
                    dst[t * dstr + didx] = silu(y);
                }
            } else if (role == 3) {
                float xv = 0.f;
#pragma unroll
                for (int t = 0; t < 8; ++t) if (t == didx) xv = bf2f(ra[t]);
                const float dt = softplus(xv + aux);
                ad[2 * didx] = __expf(dt * aux2); ad[2 * didx + 1] = dt;
            }
        } else if constexpr (TYPE == 1) {
            if (role == 0 || role == 1) {
                float* dst = role == 0 ? qs : ks; const float sc = role == 0 ? 1.0f : 0.08838834764831845f;
#pragma unroll
                for (int t = 0; t < 8; ++t) {
                    const int pos = pos0 + 8 * r + t;
                    const double rev = (double)pos * (double)aux * 0.15915494309189535;
                    const float fr = (float)(rev - floor(rev));
                    const float sn = __builtin_amdgcn_sinf(fr), cs = __builtin_amdgcn_cosf(fr);
                    const float x1 = bf2f(ra[t]) * sc, x2 = bf2f(rb[t]) * sc;
                    dst[t * 128 + didx] = x1 * cs - x2 * sn;
                    dst[t * 128 + 64 + didx] = x1 * sn + x2 * cs;
                }
            } else if (role == 2) {
#pragma unroll
                for (int t = 0; t < 8; ++t) vs[t * VW + didx] = bf2f(ra[t]);
            }
        } else {
            if (role == 0) {
#pragma unroll
                for (int t = 0; t < 8; ++t) qs[t * 128 + didx] = silu(bf2f(ra[t]));
            } else if (role == 1) {
#pragma unroll
                for (int t = 0; t < 8; ++t) { const float f = aux + (1.0f - aux) * sigm(bf2f(ra[t])); as[t * 128 + didx] = f; ks[t * 128 + didx] = 1.0f - f; }
            } else if (role == 2) {
#pragma unroll
                for (int t = 0; t < 8; ++t) vs[t * VW + didx] = bf2f(ra[t]);
            }
        }
        const unsigned short zc = zr;
        __syncthreads();
        if (r + 1 < R) load_raw(r + 1);
        for (int t0 = 0; t0 < nv; t0 += 4) {
#pragma unroll
            for (int tt = 0; tt < 4; ++tt) {
                const int t = t0 + tt;
                const f32x4 q4 = *(const f32x4*)(qs + t * 128 + kb);
                f32x4 k4 = *(const f32x4*)(ks + t * 128 + kb);
                const VT v4 = *(const VT*)(vs + t * VW + NV * vq);
                f32x4 a4;
                if constexpr (TYPE == 0) { const f32x2 adv = *(const f32x2*)(ad + 2 * t); a4 = (f32x4){adv.x, adv.x, adv.x, adv.x}; k4 = k4 * adv.y; }
                else if constexpr (TYPE == 1) a4 = (f32x4){gamma, gamma, gamma, gamma};
                else a4 = *(const f32x4*)(as + t * 128 + kb);
                VT o = (VT)(0.f);
#pragma unroll
                for (int i = 0; i < 4; ++i) { S[i] = a4[i] * S[i] + k4[i] * v4; o += q4[i] * S[i]; }
                *(VT*)(part + ((t * 32 + w * 4 + kg) * VW + NV * vq)) = o;
            }
        }
        __syncthreads();
        const int rt = tid / VW, rv = tid % VW;
        if (tid < 8 * VW && rt < nv) {
            float o = 0.f;
#pragma unroll
            for (int pp = 0; pp < 32; ++pp) o += part[(rt * 32 + pp) * VW + rv];
            const size_t trow = (size_t)(8 * r + rt);
            if constexpr (TYPE == 0) {
                const float y = (o + Dh * vs[rt * 64 + rv]) * silu(bf2f(zc));
                yz[trow * 4096 + h * 64 + rv] = f2bf(y);
            } else if constexpr (TYPE == 1) {
                yz[trow * 4096 + 2048 + h * 256 + s * VW + rv] = f2bf(o);
            } else {
                yz[trow * 4096 + h * 128 + s * VW + rv] = f2bf(o);
            }
        }
    }
#pragma unroll
    for (int i = 0; i < 4; ++i) *(VT*)(Sout + (size_t)(kb + i) * ldS + NV * vq) = S[i];
}

template <int TYPE>
__device__ __forceinline__ void dec_unit(const Params& p, float* ldsf, int b, int u, unsigned* ctr, unsigned& nx) {
    int tid = threadIdx.x; asm volatile("" : "+v"(tid));
    const int w = tid >> 6, lane = tid & 63, kg = lane >> 4, vq = lane & 15;
    const int row0 = MP + 4 * b;
    constexpr int LDP = TYPE < 2 ? LD0 : LD1;
    const bf16_t* proj = (const bf16_t*)(p.ws + WS_PROJ) + (size_t)row0 * LDP;
    bf16_t* yz = (bf16_t*)(p.ws + WS_YZ) + (size_t)row0 * 4096;
    int h, sl; size_t soff; int ldS;
    if constexpr (TYPE == 0) { h = 8 * u + w; sl = 0; ldS = 64; soff = ((size_t)(b * 32 + h) * 128) * 64; }
    else if constexpr (TYPE == 1) { h = 2 * u + (w >> 2); sl = w & 3; ldS = 256; soff = ((size_t)(b * 8 + h) * 128) * 256 + sl * 64; }
    else { h = 4 * u + (w >> 1); sl = w & 1; ldS = 128; soff = ((size_t)(b * 16 + h) * 128) * 128 + sl * 64; }
    const float* S0 = (TYPE == 0 ? p.in[2 + p.z] : (TYPE == 1 ? p.in[4 + p.z] : p.in[5 + p.z])) + soff + (size_t)(32 * kg) * ldS + 4 * vq;
    float* Sout = p.out + (TYPE == 0 ? O_SSMS : (TYPE == 1 ? O_RETS : O_HGS)) + soff + (size_t)(32 * kg) * ldS + 4 * vq;
    if constexpr (TYPE == 0) {
        float* qs = ldsf; float* ks = ldsf + 512; float* xs = ldsf + 1024; float* zs = ldsf + 3072; float* ad = ldsf + 5120;
        unsigned short xr[2][4]; float cw[2][4], cb[2], st[2][3]; unsigned short zr[4]; unsigned short dr = 0;
#pragma unroll
        for (int q = 0; q < 2; ++q) {
            const int idx = tid + 512 * q;
            if (idx < 768) {
                const int ch = idx < 128 ? 2560 + u * 128 + idx : (idx < 256 ? 2048 + u * 128 + (idx - 128) : u * 512 + (idx - 256));
#pragma unroll
                for (int t = 0; t < 4; ++t) xr[q][t] = proj[(size_t)t * LDP + 2048 + ch];
#pragma unroll
                for (int j = 0; j < 4; ++j) cw[q][j] = p.in[13 + p.z][j * 3072 + ch];
                cb[q] = p.in[14 + p.z][ch];
#pragma unroll
                for (int j = 0; j < 3; ++j) st[q][j] = p.in[3 + p.z][((size_t)b * 3 + j) * 3072 + ch];
            }
        }
#pragma unroll
        for (int t = 0; t < 4; ++t) zr[t] = proj[(size_t)t * LDP + u * 512 + tid];
        if (tid < 32) dr = proj[(size_t)(tid >> 3) * LDP + 5120 + 8 * u + (tid & 7)];
        f32x4 S[32];
#pragma unroll
        for (int i = 0; i < 32; ++i) S[i] = __builtin_nontemporal_load((const f32x4*)(S0 + (size_t)i * ldS));
#pragma unroll
        for (int q = 0; q < 2; ++q) {
            const int idx = tid + 512 * q;
            if (idx < 768) {
                float* dst = idx < 128 ? qs + idx : (idx < 256 ? ks + (idx - 128) : xs + (idx - 256));
                const int dstr = idx < 256 ? 128 : 512;
                float c0 = st[q][0], c1 = st[q][1], c2 = st[q][2];
#pragma unroll
                for (int t = 0; t < 4; ++t) {
                    const float x = bf2f(xr[q][t]);
                    const float y = cb[q] + cw[q][0] * c0 + cw[q][1] * c1 + cw[q][2] * c2 + cw[q][3] * x;
                    c0 = c1; c1 = c2; c2 = x;
                    dst[t * dstr] = silu(y);
                }
            }
        }
#pragma unroll
        for (int t = 0; t < 4; ++t) zs[t * 512 + tid] = silu(bf2f(zr[t]));
        if (tid < 32) {
            const int hh = 8 * u + (tid & 7);
            const float dt = softplus(bf2f(dr) + p.in[15 + p.z][hh]);
            ad[2 * tid] = __expf(-dt * __expf(p.in[16 + p.z][hh])); ad[2 * tid + 1] = dt;
        }
        __syncthreads();
        const float Dh = p.in[17 + p.z][h];
#pragma unroll 1
        for (int t = 0; t < 4; ++t) {
            const f32x2 adv = *(const f32x2*)(ad + 2 * (t * 8 + w));
            const f32x4 v4 = *(const f32x4*)(xs + t * 512 + w * 64 + 4 * vq);
            f32x4 o = (f32x4){0.f, 0.f, 0.f, 0.f};
#pragma unroll
            for (int i4 = 0; i4 < 8; ++i4) {
                const f32x4 q4 = *(const f32x4*)(qs + t * 128 + 32 * kg + 4 * i4);
                const f32x4 k4 = *(const f32x4*)(ks + t * 128 + 32 * kg + 4 * i4) * adv.y;
#pragma unroll
                for (int ii = 0; ii < 4; ++ii) { S[4 * i4 + ii] = adv.x * S[4 * i4 + ii] + k4[ii] * v4; o += q4[ii] * S[4 * i4 + ii]; }
            }
#pragma unroll
            for (int j = 0; j < 4; ++j) { o[j] += __shfl_xor(o[j], 16); o[j] += __shfl_xor(o[j], 32); }
            if (kg == 0) {
                const f32x4 z4 = *(const f32x4*)(zs + t * 512 + w * 64 + 4 * vq);
                const f32x4 y = (o + Dh * v4) * z4;
                u32x2 ov; ov.x = pk2(y[0], y[1]); ov.y = pk2(y[2], y[3]);
                *(u32x2*)(yz + (size_t)t * 4096 + h * 64 + 4 * vq) = ov;
            }
        }
        if (tid == 0) nx = atomicAdd(ctr, 1u);
#pragma unroll
        for (int i = 0; i < 32; ++i) __builtin_nontemporal_store(S[i], (f32x4*)(Sout + (size_t)i * ldS));
    } else if constexpr (TYPE == 1) {
        float* qs = ldsf; float* ks = ldsf + 1024; float* vs = ldsf + 2048;
        unsigned short x1[4], x2[4], vr[4];
        const int hl = tid >> 7, isk = (tid >> 6) & 1, jf = tid & 63;
        if (tid < 256) {
            const int col = (isk ? 6176 : 5152) + (2 * u + hl) * 128 + jf;
#pragma unroll
            for (int t = 0; t < 4; ++t) { x1[t] = proj[(size_t)t * LDP + col]; x2[t] = proj[(size_t)t * LDP + col + 64]; }
        }
#pragma unroll
        for (int t = 0; t < 4; ++t) vr[t] = proj[(size_t)t * LDP + 7200 + (2 * u + (tid >> 8)) * 256 + (tid & 255)];
        f32x4 S[32];
#pragma unroll
        for (int i = 0; i < 32; ++i) S[i] = __builtin_nontemporal_load((const f32x4*)(S0 + (size_t)i * ldS));
        if (tid < 256) {
            const float inv = exp2f(-(float)jf * 0.20762050593046014f);
            float* dst = isk ? ks : qs; const float sc = isk ? 0.08838834764831845f : 1.0f;
#pragma unroll
            for (int t = 0; t < 4; ++t) {
                const double rev = (double)(16384 + t) * (double)inv * 0.15915494309189535;
                const float fr = (float)(rev - floor(rev));
                const float sn = __builtin_amdgcn_sinf(fr), cs = __builtin_amdgcn_cosf(fr);
                const float a1 = bf2f(x1[t]) * sc, a2 = bf2f(x2[t]) * sc;
                dst[(t * 2 + hl) * 128 + jf] = a1 * cs - a2 * sn;
                dst[(t * 2 + hl) * 128 + 64 + jf] = a1 * sn + a2 * cs;
            }
        }
#pragma unroll
        for (int t = 0; t < 4; ++t) vs[(t * 2 + (tid >> 8)) * 256 + (tid & 255)] = bf2f(vr[t]);
        __syncthreads();
        const float gamma = 1.0f - exp2f(-5.0f - (float)h * (4.0f / 7.0f));
        const int hw = w >> 2;
#pragma unroll 1
        for (int t = 0; t < 4; ++t) {
            const f32x4 v4 = *(const f32x4*)(vs + (t * 2 + hw) * 256 + sl * 64 + 4 * vq);
            f32x4 o = (f32x4){0.f, 0.f, 0.f, 0.f};
#pragma unroll
            for (int i4 = 0; i4 < 8; ++i4) {
                const f32x4 q4 = *(const f32x4*)(qs + (t * 2 + hw) * 128 + 32 * kg + 4 * i4);
                const f32x4 k4 = *(const f32x4*)(ks + (t * 2 + hw) * 128 + 32 * kg + 4 * i4);
#pragma unroll
                for (int ii = 0; ii < 4; ++ii) { S[4 * i4 + ii] = gamma * S[4 * i4 + ii] + k4[ii] * v4; o += q4[ii] * S[4 * i4 + ii]; }
            }
#pragma unroll
            for (int j = 0; j < 4; ++j) { o[j] += __shfl_xor(o[j], 16); o[j] += __shfl_xor(o[j], 32); }
            if (kg == 0) {
                u32x2 ov; ov.x = pk2(o[0], o[1]); ov.y = pk2(o[2], o[3]);
                *(u32x2*)(yz + (size_t)t * 4096 + 2048 + h * 256 + sl * 64 + 4 * vq) = ov;
            }
        }
        if (tid == 0) nx = atomicAdd(ctr, 1u);
#pragma unroll
        for (int i = 0; i < 32; ++i) __builtin_nontemporal_store(S[i], (f32x4*)(Sout + (size_t)i * ldS));
    } else {
        float* qs = ldsf; float* ks = ldsf + 2048; float* as = ldsf + 4096; float* vs = ldsf + 6144;
        unsigned short qr[4], fr_[4], vr[4];
        const int hl = tid >> 7, kk = tid & 127, col = (4 * u + hl) * 128 + kk;
#pragma unroll
        for (int t = 0; t < 4; ++t) { qr[t] = proj[(size_t)t * LDP + col]; fr_[t] = proj[(size_t)t * LDP + 2048 + col]; vr[t] = proj[(size_t)t * LDP + 4096 + col]; }
        const float lb = ((const float*)(p.ws + WS_LB))[col];
        f32x4 S[32];
#pragma unroll
        for (int i = 0; i < 32; ++i) S[i] = __builtin_nontemporal_load((const f32x4*)(S0 + (size_t)i * ldS));
#pragma unroll
        for (int t = 0; t < 4; ++t) {
            const int o = (t * 4 + hl) * 128 + kk;
            qs[o] = silu(bf2f(qr[t]));
            const float f = lb + (1.0f - lb) * sigm(bf2f(fr_[t]));
            as[o] = f; ks[o] = 1.0f - f; vs[o] = bf2f(vr[t]);
        }
        __syncthreads();
        const int hw = w >> 1;
#pragma unroll 1
        for (int t = 0; t < 4; ++t) {
            const f32x4 v4 = *(const f32x4*)(vs + (t * 4 + hw) * 128 + sl * 64 + 4 * vq);
            f32x4 o = (f32x4){0.f, 0.f, 0.f, 0.f};
#pragma unroll
            for (int i4 = 0; i4 < 8; ++i4) {
                const int off = (t * 4 + hw) * 128 + 32 * kg + 4 * i4;
                const f32x4 q4 = *(const f32x4*)(qs + off), k4 = *(const f32x4*)(ks + off), a4 = *(const f32x4*)(as + off);
#pragma unroll
                for (int ii = 0; ii < 4; ++ii) { S[4 * i4 + ii] = a4[ii] * S[4 * i4 + ii] + k4[ii] * v4; o += q4[ii] * S[4 * i4 + ii]; }
            }
#pragma unroll
            for (int j = 0; j < 4; ++j) { o[j] += __shfl_xor(o[j], 16); o[j] += __shfl_xor(o[j], 32); }
            if (kg == 0) {
                u32x2 ov; ov.x = pk2(o[0], o[1]); ov.y = pk2(o[2], o[3]);
                *(u32x2*)(yz + (size_t)t * 4096 + h * 128 + sl * 64 + 4 * vq) = ov;
            }
        }
        if (tid == 0) nx = atomicAdd(ctr, 1u);
#pragma unroll
        for (int i = 0; i < 32; ++i) __builtin_nontemporal_store(S[i], (f32x4*)(Sout + (size_t)i * ldS));
    }
}

#define CK_QS 0
#define CK_KS 17408
#define CK_KT 34816
#define CK_VT 53248
#define CK_PS 62464
#define CK_ST 71680
#define CK_CUM 89088
__device__ __forceinline__ bf16x8 ck_frag(const unsigned char* lds, int base, int pitch, int row, int kb, int q) {
    return *(const bf16x8*)(lds + base + row * pitch + (32 * kb + 8 * q) * 2);
}
template <int TYPE>
__device__ __forceinline__ void chunk_item(const Params& p, unsigned char* lds, int b, int h, int s) {
    int tid = threadIdx.x; asm volatile("" : "+v"(tid));
    const int w = tid >> 6, lane = tid & 63, r = lane & 15, q = lane >> 4;
    constexpr int LDP = TYPE < 2 ? LD0 : LD1;
    const bf16_t* proj = (const bf16_t*)(p.ws + WS_PROJ) + (size_t)(2048 * b) * LDP;
    bf16_t* yz = (bf16_t*)(p.ws + WS_YZ) + (size_t)(2048 * b) * 4096;
    const int I = w >> 1, Vn0 = 2 * (w & 1);
    const int c1 = tid & 127, tq = tid >> 7;
    const int cx = tid & 63, tx = tid >> 6;
    const int g = h >> 3;
    float cwC[4], cwB[4], cwX[4], cbC = 0.f, cbB = 0.f, cbX = 0.f, inv = 0.f, dtb = 0.f, Aneg = 0.f, Dh = 0.f, sstep = 0.f, cstep = 1.f;
    (void)sstep; (void)cstep;
    int colC = 0, colB = 0, colX = 0;
    if constexpr (TYPE == 0) {
        const int chC = 2560 + g * 128 + c1, chB = 2048 + g * 128 + c1, chX = h * 64 + cx;
        colC = 2048 + chC; colB = 2048 + chB; colX = 2048 + chX;
#pragma unroll
        for (int j = 0; j < 4; ++j) { cwC[j] = p.in[13 + p.z][j * 3072 + chC]; cwB[j] = p.in[13 + p.z][j * 3072 + chB]; cwX[j] = p.in[13 + p.z][j * 3072 + chX]; }
        cbC = p.in[14 + p.z][chC]; cbB = p.in[14 + p.z][chB]; cbX = p.in[14 + p.z][chX];
        dtb = p.in[15 + p.z][h]; Aneg = -__expf(p.in[16 + p.z][h]); Dh = p.in[17 + p.z][h];
    } else if constexpr (TYPE == 1) {
        const int isk = c1 >> 6, jf = c1 & 63;
        colC = (isk ? 6176 : 5152) + h * 128 + jf; colB = colC + 64; colX = 7200 + h * 256 + s * 64 + cx;
        inv = exp2f(-(float)jf * 0.20762050593046014f);
        { const float frs = inv * 0.15915494309189535f; sstep = __builtin_amdgcn_sinf(frs); cstep = __builtin_amdgcn_cosf(frs); }
    } else {
        colC = h * 128 + c1; colB = 2048 + h * 128 + c1; colX = 4096 + h * 128 + s * 64 + cx;
        inv = ((const float*)(p.ws + WS_LB))[h * 128 + c1];
    }
    float* cumb = (float*)(lds + CK_CUM);
    if constexpr (TYPE == 1) {
        const float lg = __logf(1.0f - exp2f(-5.0f - (float)h * (4.0f / 7.0f)));
        if (tid < 64) {
#pragma unroll
            for (int bfi = 0; bfi < 2; ++bfi) { float* cb = cumb + bfi * 320; cb[tid] = (tid + 1) * lg; cb[64 + tid] = __expf((tid + 1) * lg); cb[128 + tid] = __expf((63 - tid) * lg); cb[192 + tid] = 1.0f; if (tid == 0) cb[256] = __expf(64.0f * lg); }
        }
    }
    for (int i = tid; i < 17408 / 4; i += 512) ((unsigned*)(lds + CK_ST))[i] = 0u;
    f32x4 Sacc[4];
#pragma unroll
    for (int i = 0; i < 4; ++i) Sacc[i] = (f32x4){0.f, 0.f, 0.f, 0.f};
    unsigned short xc[19], xb[19], xx[11], zr[8], dr = 0;
    auto load_raw = [&](int c) {
        const int t0 = 64 * c;
        if constexpr (TYPE == 0) {
#pragma unroll
            for (int i = 0; i < 19; ++i) { const int t = t0 + 16 * tq - 3 + i; xc[i] = 0; xb[i] = 0; if (t >= 0) { xc[i] = proj[(size_t)t * LDP + colC]; xb[i] = proj[(size_t)t * LDP + colB]; } }
#pragma unroll
            for (int i = 0; i < 11; ++i) { const int t = t0 + 8 * tx - 3 + i; xx[i] = 0; if (t >= 0) xx[i] = proj[(size_t)t * LDP + colX]; }
            if (w == 7) dr = proj[(size_t)(t0 + lane) * LDP + 5120 + h];
#pragma unroll
            for (int vv = 0; vv < 2; ++vv)
#pragma unroll
                for (int jx = 0; jx < 4; ++jx) zr[vv * 4 + jx] = proj[(size_t)(t0 + 16 * I + 4 * q + jx) * LDP + h * 64 + 16 * (Vn0 + vv) + r];
        } else {
#pragma unroll
            for (int i = 0; i < 16; ++i) { const int t = t0 + 16 * tq + i; xc[i] = proj[(size_t)t * LDP + colC]; xb[i] = proj[(size_t)t * LDP + colB]; }
#pragma unroll
            for (int i = 0; i < 8; ++i) xx[i] = proj[(size_t)(t0 + 8 * tx + i) * LDP + colX];
        }
    };
    load_raw(0);
    for (int c = 0; c < 32; ++c) {
        const int t0 = 64 * c;
        float* cum = cumb + (TYPE == 0 ? (c & 1) * 320 : 0);
        float vq_[16], vk_[16], vx_[8], kt_[16], Eval = 0.f;
        (void)kt_; (void)Eval;
        if constexpr (TYPE == 0) {
#pragma unroll
            for (int i = 0; i < 16; ++i) {
                vq_[i] = silu(cbC + cwC[0] * bf2f(xc[i]) + cwC[1] * bf2f(xc[i + 1]) + cwC[2] * bf2f(xc[i + 2]) + cwC[3] * bf2f(xc[i + 3]));
                vk_[i] = silu(cbB + cwB[0] * bf2f(xb[i]) + cwB[1] * bf2f(xb[i + 1]) + cwB[2] * bf2f(xb[i + 2]) + cwB[3] * bf2f(xb[i + 3]));
            }
#pragma unroll
            for (int i = 0; i < 8; ++i) vx_[i] = silu(cbX + cwX[0] * bf2f(xx[i]) + cwX[1] * bf2f(xx[i + 1]) + cwX[2] * bf2f(xx[i + 2]) + cwX[3] * bf2f(xx[i + 3]));
            if (w == 7) {
                const float dt = softplus(bf2f(dr) + dtb);
                float cs = dt * Aneg;
#pragma unroll
                for (int o = 1; o < 64; o <<= 1) { const float t = __shfl_up(cs, o); if (lane >= o) cs += t; }
                const float last = __shfl(cs, 63);
                cum[lane] = cs; cum[64 + lane] = __expf(cs); cum[128 + lane] = __expf(last - cs); cum[192 + lane] = dt;
                if (lane == 0) cum[256] = __expf(last);
            }
        } else if constexpr (TYPE == 2) {
            float pr[16], om[16];
            float run = 1.f;
#pragma unroll
            for (int i = 0; i < 16; ++i) { const float f = inv + (1.0f - inv) * sigm(bf2f(xb[i])); run *= f; pr[i] = run; om[i] = 1.0f - f; }
#pragma unroll
            for (int i = 0; i < 16; ++i) { const float ip = __builtin_amdgcn_rcpf(pr[i]); vq_[i] = silu(bf2f(xc[i])) * pr[i]; vk_[i] = om[i] * ip; kt_[i] = om[i] * ip * run; }
            Eval = run;
#pragma unroll
            for (int i = 0; i < 8; ++i) vx_[i] = bf2f(xx[i]);
        } else {
            {
                const double rev = (double)(t0 + 16 * tq) * (double)inv * 0.15915494309189535;
                const float fr = (float)(rev - floor(rev));
                float sn = __builtin_amdgcn_sinf(fr), cs = __builtin_amdgcn_cosf(fr);
#pragma unroll
                for (int i = 0; i < 16; ++i) {
                    const float a1 = bf2f(xc[i]), a2 = bf2f(xb[i]);
                    vq_[i] = a1 * cs - a2 * sn; vk_[i] = a1 * sn + a2 * cs;
                    const float c2 = cs * cstep - sn * sstep, s2 = sn * cstep + cs * sstep;
                    cs = c2; sn = s2;
                }
            }
#pragma unroll
            for (int i = 0; i < 8; ++i) vx_[i] = bf2f(xx[i]);
        }
        unsigned short zc[8];
#pragma unroll
        for (int i = 0; i < 8; ++i) zc[i] = zr[i];
        __syncthreads();
        if constexpr (TYPE == 0) {
            unsigned kt[8];
#pragma unroll
            for (int i = 0; i < 16; i += 2) {
                const int t = 16 * tq + i;
                const float k0 = vk_[i] * cum[192 + t], k1 = vk_[i + 1] * cum[192 + t + 1];
                *(bf16_t*)(lds + CK_QS + t * 272 + c1 * 2) = f2bf(vq_[i]); *(bf16_t*)(lds + CK_QS + (t + 1) * 272 + c1 * 2) = f2bf(vq_[i + 1]);
                *(bf16_t*)(lds + CK_KS + t * 272 + c1 * 2) = f2bf(k0); *(bf16_t*)(lds + CK_KS + (t + 1) * 272 + c1 * 2) = f2bf(k1);
                kt[i >> 1] = pk2(k0 * cum[128 + t], k1 * cum[128 + t + 1]);
            }
            *(u32x4*)(lds + CK_KT + c1 * 144 + 32 * tq) = (u32x4){kt[0], kt[1], kt[2], kt[3]};
            *(u32x4*)(lds + CK_KT + c1 * 144 + 32 * tq + 16) = (u32x4){kt[4], kt[5], kt[6], kt[7]};
        } else if constexpr (TYPE == 2) {
            unsigned kt[8];
#pragma unroll
            for (int i = 0; i < 16; i += 2) {
                const int t = 16 * tq + i;
                *(bf16_t*)(lds + CK_QS + t * 272 + c1 * 2) = f2bf(vq_[i]); *(bf16_t*)(lds + CK_QS + (t + 1) * 272 + c1 * 2) = f2bf(vq_[i + 1]);
                *(bf16_t*)(lds + CK_KS + t * 272 + c1 * 2) = f2bf(vk_[i]); *(bf16_t*)(lds + CK_KS + (t + 1) * 272 + c1 * 2) = f2bf(vk_[i + 1]);
                kt[i >> 1] = pk2(kt_[i], kt_[i + 1]);
            }
            *(u32x4*)(lds + CK_KT + c1 * 144 + 32 * tq) = (u32x4){kt[0], kt[1], kt[2], kt[3]};
            *(u32x4*)(lds + CK_KT + c1 * 144 + 32 * tq + 16) = (u32x4){kt[4], kt[5], kt[6], kt[7]};
            cum[tq * 128 + c1] = Eval;
        } else {
            const int isk = c1 >> 6, jf = c1 & 63;
            if (isk == 0) {
#pragma unroll
                for (int i = 0; i < 16; ++i) { const int t = 16 * tq + i; *(bf16_t*)(lds + CK_QS + t * 272 + jf * 2) = f2bf(vq_[i]); *(bf16_t*)(lds + CK_QS + t * 272 + (jf + 64) * 2) = f2bf(vk_[i]); }
            } else {
                unsigned kta[8], ktb[8];
#pragma unroll
                for (int i = 0; i < 16; i += 2) {
                    const int t = 16 * tq + i;
                    const float a0 = vq_[i] * 0.08838834764831845f, a1 = vq_[i + 1] * 0.08838834764831845f, b0 = vk_[i] * 0.08838834764831845f, b1 = vk_[i + 1] * 0.08838834764831845f;
                    *(bf16_t*)(lds + CK_KS + t * 272 + jf * 2) = f2bf(a0); *(bf16_t*)(lds + CK_KS + (t + 1) * 272 + jf * 2) = f2bf(a1);
                    *(bf16_t*)(lds + CK_KS + t * 272 + (jf + 64) * 2) = f2bf(b0); *(bf16_t*)(lds + CK_KS + (t + 1) * 272 + (jf + 64) * 2) = f2bf(b1);
                    kta[i >> 1] = pk2(a0 * cum[128 + t], a1 * cum[128 + t + 1]); ktb[i >> 1] = pk2(b0 * cum[128 + t], b1 * cum[128 + t + 1]);
                }
                *(u32x4*)(lds + CK_KT + jf * 144 + 32 * tq) = (u32x4){kta[0], kta[1], kta[2], kta[3]};
                *(u32x4*)(lds + CK_KT + jf * 144 + 32 * tq + 16) = (u32x4){kta[4], kta[5], kta[6], kta[7]};
                *(u32x4*)(lds + CK_KT + (jf + 64) * 144 + 32 * tq) = (u32x4){ktb[0], ktb[1], ktb[2], ktb[3]};
                *(u32x4*)(lds + CK_KT + (jf + 64) * 144 + 32 * tq + 16) = (u32x4){ktb[4], ktb[5], ktb[6], ktb[7]};
            }
        }
        *(u32x4*)(lds + CK_VT + cx * 144 + 16 * tx) = (u32x4){pk2(vx_[0], vx_[1]), pk2(vx_[2], vx_[3]), pk2(vx_[4], vx_[5]), pk2(vx_[6], vx_[7])};
        __syncthreads();
        if (c + 1 < 32) load_raw(c + 1);
        if constexpr (TYPE < 2) {
        bf16x8 aQ[4];
#pragma unroll
        for (int kb = 0; kb < 4; ++kb) aQ[kb] = ck_frag(lds, CK_QS, 272, 16 * I + r, kb, q);
        float cumi[4];
#pragma unroll
        for (int jx = 0; jx < 4; ++jx) cumi[jx] = cum[16 * I + 4 * q + jx];
#pragma unroll
        for (int jj = 0; jj < 2; ++jj) {
            const int J = Vn0 + jj;
            f32x4 acc = (f32x4){0.f, 0.f, 0.f, 0.f};
#pragma unroll
            for (int kb = 0; kb < 4; ++kb) acc = __builtin_amdgcn_mfma_f32_16x16x32_bf16(aQ[kb], ck_frag(lds, CK_KS, 272, 16 * J + r, kb, q), acc, 0, 0, 0);
            const int jcol = 16 * J + r; const float cumj = cum[jcol];
#pragma unroll
            for (int jx = 0; jx < 4; ++jx) {
                const int i = 16 * I + 4 * q + jx;
                const float v = (jcol <= i) ? acc[jx] * __expf(fminf(cumi[jx] - cumj, 0.f)) : 0.f;
                *(bf16_t*)(lds + CK_PS + i * 144 + jcol * 2) = f2bf(v);
            }
        }
        __syncthreads();
#pragma unroll
        for (int vv = 0; vv < 2; ++vv) {
            const int Vn = Vn0 + vv;
            f32x4 aPV = (f32x4){0.f, 0.f, 0.f, 0.f}, aQS = (f32x4){0.f, 0.f, 0.f, 0.f};
#pragma unroll
            for (int jb = 0; jb < 2; ++jb) aPV = __builtin_amdgcn_mfma_f32_16x16x32_bf16(ck_frag(lds, CK_PS, 144, 16 * I + r, jb, q), ck_frag(lds, CK_VT, 144, 16 * Vn + r, jb, q), aPV, 0, 0, 0);
#pragma unroll
            for (int kb = 0; kb < 4; ++kb) aQS = __builtin_amdgcn_mfma_f32_16x16x32_bf16(aQ[kb], ck_frag(lds, CK_ST, 272, 16 * Vn + r, kb, q), aQS, 0, 0, 0);
#pragma unroll
            for (int jx = 0; jx < 4; ++jx) {
                const int i = 16 * I + 4 * q + jx, v = 16 * Vn + r;
                const float o = aPV[jx] + cum[64 + i] * aQS[jx];
                if constexpr (TYPE == 0) {
                    const float xsv = bf2f(*(const bf16_t*)(lds + CK_VT + v * 144 + i * 2));
                    yz[(size_t)(t0 + i) * 4096 + h * 64 + v] = f2bf((o + Dh * xsv) * silu(bf2f(zc[vv * 4 + jx])));
                } else {
                    yz[(size_t)(t0 + i) * 4096 + 2048 + h * 256 + s * 64 + v] = f2bf(o);
                }
            }
        }
        __syncthreads();
        const float elast = cum[256];
#pragma unroll
        for (int Vn = 0; Vn < 4; ++Vn) {
            Sacc[Vn] = Sacc[Vn] * elast;
#pragma unroll
            for (int tb = 0; tb < 2; ++tb) Sacc[Vn] = __builtin_amdgcn_mfma_f32_16x16x32_bf16(ck_frag(lds, CK_KT, 144, 16 * w + r, tb, q), ck_frag(lds, CK_VT, 144, 16 * Vn + r, tb, q), Sacc[Vn], 0, 0, 0);
            *(u32x2*)(lds + CK_ST + (16 * Vn + r) * 272 + (16 * w + 4 * q) * 2) = (u32x2){pk2_sw(Sacc[Vn][0], Sacc[Vn][1]), pk2_sw(Sacc[Vn][2], Sacc[Vn][3])};
        }
            } else {
            const bf16x8 zf = (bf16x8){0, 0, 0, 0, 0, 0, 0, 0};
            if ((w & 1) == 0) {
                f32x4 acc = (f32x4){0.f, 0.f, 0.f, 0.f};
#pragma unroll
                for (int kb = 0; kb < 4; ++kb) acc = __builtin_amdgcn_mfma_f32_16x16x32_bf16(ck_frag(lds, CK_QS, 272, 16 * I + r, kb, q), ck_frag(lds, CK_KS, 272, 16 * I + r, kb, q), acc, 0, 0, 0);
#pragma unroll
                for (int jx = 0; jx < 4; ++jx) {
                    const float v = (r <= 4 * q + jx) ? acc[jx] : 0.f;
                    *(bf16_t*)(lds + CK_PS + (16 * I + 4 * q + jx) * 144 + (16 * I + r) * 2) = f2bf(v);
                }
            }
            __syncthreads();
#pragma unroll
            for (int sc = 0; sc < 4; ++sc) {
                const int stb = sc == 0 ? CK_ST : (sc == 1 ? CK_KS : (sc == 2 ? 91648 : 109056));
                const f32x4 e4 = *(const f32x4*)(cum + sc * 128 + 16 * w + 4 * q);
                const bf16x8 ka = (q < 2) ? *(const bf16x8*)(lds + CK_KT + (16 * w + r) * 144 + (16 * sc + 8 * q) * 2) : zf;
#pragma unroll
                for (int Vn = 0; Vn < 4; ++Vn) {
                    *(u32x2*)(lds + stb + (16 * Vn + r) * 272 + (16 * w + 4 * q) * 2) = (u32x2){pk2_sw(Sacc[Vn][0], Sacc[Vn][1]), pk2_sw(Sacc[Vn][2], Sacc[Vn][3])};
                    const bf16x8 vb = (q < 2) ? *(const bf16x8*)(lds + CK_VT + (16 * Vn + r) * 144 + (16 * sc + 8 * q) * 2) : zf;
                    Sacc[Vn] = __builtin_amdgcn_mfma_f32_16x16x32_bf16(ka, vb, Sacc[Vn] * e4, 0, 0, 0);
                }
            }
            __syncthreads();
            {
                const int sc = I;
                const int stb = sc == 0 ? CK_ST : (sc == 1 ? CK_KS : (sc == 2 ? 91648 : 109056));
                const bf16x8 pa = (q < 2) ? *(const bf16x8*)(lds + CK_PS + (16 * sc + r) * 144 + (16 * sc + 8 * q) * 2) : zf;
                bf16x8 qa[4];
#pragma unroll
                for (int kb = 0; kb < 4; ++kb) qa[kb] = ck_frag(lds, CK_QS, 272, 16 * sc + r, kb, q);
#pragma unroll
                for (int vv = 0; vv < 2; ++vv) {
                    const int Vn = Vn0 + vv;
                    const bf16x8 vb = (q < 2) ? *(const bf16x8*)(lds + CK_VT + (16 * Vn + r) * 144 + (16 * sc + 8 * q) * 2) : zf;
                    f32x4 aO = __builtin_amdgcn_mfma_f32_16x16x32_bf16(pa, vb, (f32x4){0.f, 0.f, 0.f, 0.f}, 0, 0, 0);
#pragma unroll
                    for (int kb = 0; kb < 4; ++kb) aO = __builtin_amdgcn_mfma_f32_16x16x32_bf16(qa[kb], ck_frag(lds, stb, 272, 16 * Vn + r, kb, q), aO, 0, 0, 0);
#pragma unroll
                    for (int jx = 0; jx < 4; ++jx) yz[(size_t)(t0 + 16 * sc + 4 * q + jx) * 4096 + h * 128 + s * 64 + 16 * Vn + r] = (bf16_t)(pk2_sw(aO[jx], 0.f) & 0xffffu);
                }
            }
        }
    }
    const int ldS = TYPE == 0 ? 64 : (TYPE == 1 ? 256 : 128);
    float* Sout = p.out + (TYPE == 0 ? O_SSMP + ((size_t)(b * 32 + h) * 128) * 64 : (TYPE == 1 ? O_RETP + ((size_t)(b * 8 + h) * 128) * 256 + s * 64 : O_HGP + ((size_t)(b * 16 + h) * 128) * 128 + s * 64));
#pragma unroll
    for (int Vn = 0; Vn < 4; ++Vn)
#pragma unroll
        for (int jx = 0; jx < 4; ++jx) Sout[(size_t)(16 * w + 4 * q + jx) * ldS + 16 * Vn + r] = Sacc[Vn][jx];
}

__device__ __forceinline__ void lru_dec_unit(const Params& p, int b) {
    int tid = threadIdx.x; asm volatile("" : "+v"(tid));
    const int c = tid * 4;
    const int row0 = MP + 4 * b;
    const float* LA = (const float*)(p.ws + WS_LA) + (size_t)row0 * 2048 + c;
    const bf16_t* LBv = (const bf16_t*)(p.ws + WS_LBB) + (size_t)row0 * 2048 + c;
    const bf16_t* rg = (const bf16_t*)(p.ws + WS_PROJ) + (size_t)row0 * LD1 + 10240 + c;
    bf16_t* mixa = (bf16_t*)(p.ws + WS_ACT) + (size_t)row0 * 4096 + 2048 + c;
    f32x4 hst = *(const f32x4*)(p.in[6 + p.z] + (size_t)b * 2048 + c);
#pragma unroll
    for (int t = 0; t < 4; ++t) {
        const f32x4 a = *(const f32x4*)(LA + (size_t)t * 2048);
        float bb[4], gg[4]; unpack4(*(const u32x2*)(LBv + (size_t)t * 2048), bb); unpack4(*(const u32x2*)(rg + (size_t)t * LD1), gg);
        float y[4];
#pragma unroll
        for (int j = 0; j < 4; ++j) { hst[j] = a[j] * hst[j] + bb[j]; y[j] = hst[j] * gelu_tanh(gg[j]); }
        u32x2 ov; ov.x = pk2(y[0], y[1]); ov.y = pk2(y[2], y[3]);
        *(u32x2*)(mixa + (size_t)t * 4096) = ov;
    }
    *(f32x4*)(p.out + O_LRUS + (size_t)b * 2048 + c) = hst;
}

__device__ __forceinline__ void lru_scan_item(const Params& p, float* ldsf, int b, int cg) {
    int tid = threadIdx.x; asm volatile("" : "+v"(tid));
    const int w = tid >> 6, lane = tid & 63, c = cg * 64 + lane;
    const size_t row0 = (size_t)2048 * b + 256 * w;
    const float* LA = (const float*)(p.ws + WS_LA) + row0 * 2048 + c;
    const bf16_t* LBv = (const bf16_t*)(p.ws + WS_LBB) + row0 * 2048 + c;
    const bf16_t* rg = (const bf16_t*)(p.ws + WS_PROJ) + row0 * LD1 + 10240 + c;
    bf16_t* mixa = (bf16_t*)(p.ws + WS_ACT) + row0 * 4096 + 2048 + c;
    float hl = 0.f, pr = 1.f;
    for (int tb = 0; tb < 256; tb += 16) {
        float a0[16]; unsigned short b0[16];
#pragma unroll
        for (int t = 0; t < 16; ++t) { a0[t] = LA[(size_t)(tb + t) * 2048]; b0[t] = LBv[(size_t)(tb + t) * 2048]; }
#pragma unroll
        for (int t = 0; t < 16; ++t) { hl = a0[t] * hl + bf2f(b0[t]); pr *= a0[t]; }
    }
    ldsf[w * 128 + lane] = pr; ldsf[w * 128 + 64 + lane] = hl;
    __syncthreads();
    float hst = 0.f;
    for (int ww = 0; ww < w; ++ww) hst = ldsf[ww * 128 + lane] * hst + ldsf[ww * 128 + 64 + lane];
    for (int tb = 0; tb < 256; tb += 16) {
        float a0[16]; unsigned short b0[16], g0[16];
#pragma unroll
        for (int t = 0; t < 16; ++t) { a0[t] = LA[(size_t)(tb + t) * 2048]; b0[t] = LBv[(size_t)(tb + t) * 2048]; g0[t] = rg[(size_t)(tb + t) * LD1]; }
#pragma unroll
        for (int t = 0; t < 16; ++t) {
            hst = a0[t] * hst + bf2f(b0[t]);
            mixa[(size_t)(tb + t) * 4096] = f2bf(hst * gelu_tanh(bf2f(g0[t])));
        }
    }
    if (w == 7) p.out[O_LRUP + (size_t)b * 2048 + c] = hst;
}

__device__ __forceinline__ int handover(float* ldsf, unsigned nx) {
    asm volatile("s_waitcnt lgkmcnt(0)" ::: "memory"); __builtin_amdgcn_s_barrier(); asm volatile("" ::: "memory");
    if (threadIdx.x == 0) ((volatile unsigned*)ldsf)[33284] = nx;
    asm volatile("s_waitcnt lgkmcnt(0)" ::: "memory"); __builtin_amdgcn_s_barrier(); asm volatile("" ::: "memory");
    return (int)((volatile unsigned*)ldsf)[33284];
}
__device__ __forceinline__ void phase_rec0(const Params& p, float* ldsf) {
    unsigned* ctr = (unsigned*)(p.ws + WS_CTL);
    const int total = 256 + 512 + 512;
    int it = next_item(ctr, ldsf);
    while (it < total) {
        if (it < 256) {
            if (it < 128) chunk_item<0>(p, (unsigned char*)ldsf, it >> 5, it & 31, 0);
            else { const int j = it - 128; chunk_item<1>(p, (unsigned char*)ldsf, j >> 5, (j & 31) >> 2, j & 3); }
            it = next_item(ctr, ldsf);
        } else {
            unsigned nx = 0u;
            if (it < 768) { const int j = it - 256; dec_unit<0>(p, ldsf, j >> 2, j & 3, ctr, nx); }
            else { const int j = it - 768; dec_unit<1>(p, ldsf, j >> 2, j & 3, ctr, nx); }
            it = handover(ldsf, nx);
        }
    }
}
__device__ __forceinline__ void phase_rec1(const Params& p, float* ldsf) {
    unsigned* ctr = (unsigned*)(p.ws + WS_CTL) + 64;
    const int total = 128 + 128 + 512 + 128;
    int it = next_item(ctr, ldsf);
    while (it < total) {
        if (it >= 256 && it < 768) {
            unsigned nx = 0u;
            const int j = it - 256; dec_unit<2>(p, ldsf, j >> 2, j & 3, ctr, nx);
            it = handover(ldsf, nx);
        } else {
            if (it < 128) chunk_item<2>(p, (unsigned char*)ldsf, it >> 5, (it & 31) >> 1, it & 1);
            else if (it < 256) { const int j = it - 128; lru_scan_item(p, ldsf, j >> 5, j & 31); }
            else lru_dec_unit(p, it - 768);
            it = next_item(ctr, ldsf);
        }
    }
}

__device__ __forceinline__ void seq_of_row(int row, int& sample, int& b, int& t, int& L) {
    if (row < MP) { sample = 0; b = row >> 11; t = row & 2047; L = 2048; } else { sample = 1; b = (row - MP) >> 2; t = (row - MP) & 3; L = 4; }
}

__device__ __forceinline__ void phase_prep0(const Params& p) {
    int tid = threadIdx.x; asm volatile("" : "+v"(tid));
    const int wave = tid >> 6, lane = tid & 63;
    const int gw = blockIdx.x * 8 + wave, NGW = gridDim.x * 8;
    const bf16_t* YZ = (const bf16_t*)(p.ws + WS_YZ); const bf16_t* PR = (const bf16_t*)(p.ws + WS_PROJ);
    bf16_t* MX = (bf16_t*)(p.ws + WS_ACT);
    const float* nw = p.in[18 + p.z];
    u32x4 nya[4]; u32x2 nyb[8], ngb[8];
    auto ldrow = [&](int row) {
#pragma unroll
        for (int g = 0; g < 4; ++g) nya[g] = __builtin_nontemporal_load((const u32x4*)(YZ + (size_t)row * 4096 + g * 512 + lane * 8));
#pragma unroll
        for (int hh = 0; hh < 8; ++hh) { nyb[hh] = __builtin_nontemporal_load((const u32x2*)(YZ + (size_t)row * 4096 + 2048 + hh * 256 + lane * 4)); ngb[hh] = __builtin_nontemporal_load((const u32x2*)(PR + (size_t)row * LD0 + 9248 + hh * 256 + lane * 4)); }
    };
    if (gw < MT) ldrow(gw);
    for (int row = gw; row < MT; row += NGW) {
        bf16_t* mx = MX + (size_t)row * 4096;
        u32x4 ya[4]; u32x2 yb[8], gb[8];
#pragma unroll
        for (int g = 0; g < 4; ++g) ya[g] = nya[g];
#pragma unroll
        for (int hh = 0; hh < 8; ++hh) { yb[hh] = nyb[hh]; gb[hh] = ngb[hh]; }
        if (row + NGW < MT) ldrow(row + NGW);
#pragma unroll
        for (int g = 0; g < 4; ++g) {
            const int c = g * 512 + lane * 8;
            float v[8]; unpack8(ya[g], v);
            float s = 0.f;
#pragma unroll
            for (int j = 0; j < 8; ++j) s += v[j] * v[j];
            s = wave_sum(s);
            const float rs = rsqrtf(s * (1.0f / 512.0f) + EPS);
            const f32x4 n0 = *(const f32x4*)(nw + c), n1 = *(const f32x4*)(nw + c + 4);
            u32x4 o; o.x = pk2(v[0] * rs * n0[0], v[1] * rs * n0[1]); o.y = pk2(v[2] * rs * n0[2], v[3] * rs * n0[3]);
            o.z = pk2(v[4] * rs * n1[0], v[5] * rs * n1[1]); o.w = pk2(v[6] * rs * n1[2], v[7] * rs * n1[3]);
            *(u32x4*)(mx + c) = o;
        }
#pragma unroll
        for (int hh = 0; hh < 8; ++hh) {
            const int c = hh * 256 + lane * 4;
            float v[4]; unpack4(yb[hh], v);
            float gt[4]; unpack4(gb[hh], gt);
            float s = (v[0] * v[0] + v[1] * v[1]) + (v[2] * v[2] + v[3] * v[3]);
            s = wave_sum(s);
            const float rs = rsqrtf(s * (1.0f / 256.0f) + EPS);
            u32x2 o; o.x = pk2(v[0] * rs * silu(gt[0]), v[1] * rs * silu(gt[1])); o.y = pk2(v[2] * rs * silu(gt[2]), v[3] * rs * silu(gt[3]));
            *(u32x2*)(mx + 2048 + c) = o;
        }
        int sample, b, t, L; seq_of_row(row, sample, b, t, L);
        if (t >= L - 3) {
            float* dst = p.out + (sample ? O_SCS : O_SCP) + ((size_t)b * 3 + (t - (L - 3))) * 3072;
            const bf16_t* src = PR + (size_t)row * LD0 + 2048;
#pragma unroll 4
            for (int c = lane; c < 3072; c += 64) dst[c] = bf2f(src[c]);
        }
    }
}

__device__ __forceinline__ void phase_prep1(const Params& p) {
    int tid = threadIdx.x; asm volatile("" : "+v"(tid));
    const int wave = tid >> 6, lane = tid & 63;
    const int gw = blockIdx.x * 8 + wave, NGW = gridDim.x * 8;
    const bf16_t* YZ = (const bf16_t*)(p.ws + WS_YZ); const bf16_t* PR = (const bf16_t*)(p.ws + WS_PROJ);
    bf16_t* MX = (bf16_t*)(p.ws + WS_ACT);
    const float* nw = p.in[22 + p.z];
    u32x4 nya[4], nga[4];
    auto ldrow = [&](int row) {
#pragma unroll
        for (int it = 0; it < 4; ++it) { nya[it] = __builtin_nontemporal_load((const u32x4*)(YZ + (size_t)row * 4096 + it * 512 + lane * 8)); nga[it] = __builtin_nontemporal_load((const u32x4*)(PR + (size_t)row * LD1 + 6144 + it * 512 + lane * 8)); }
    };
    if (gw < MT) ldrow(gw);
    for (int row = gw; row < MT; row += NGW) {
        u32x4 ya[4], ga[4];
#pragma unroll
        for (int it = 0; it < 4; ++it) { ya[it] = nya[it]; ga[it] = nga[it]; }
        if (row + NGW < MT) ldrow(row + NGW);
#pragma unroll
        for (int it = 0; it < 4; ++it) {
            const int c = it * 512 + lane * 8;
            float v[8]; unpack8(ya[it], v);
            float gt[8]; unpack8(ga[it], gt);
            float s = 0.f;
#pragma unroll
            for (int j = 0; j < 8; ++j) s += v[j] * v[j];
            s += __shfl_xor(s, 1); s += __shfl_xor(s, 2); s += __shfl_xor(s, 4); s += __shfl_xor(s, 8);
            const float rs = rsqrtf(s * (1.0f / 128.0f) + EPS);
            const f32x4 n0 = *(const f32x4*)(nw + (c & 127)), n1 = *(const f32x4*)(nw + (c & 127) + 4);
            float o[8];
#pragma unroll
            for (int j = 0; j < 8; ++j) o[j] = v[j] * rs * (j < 4 ? n0[j] : n1[j - 4]) * silu(gt[j]);
            u32x4 ov; ov.x = pk2(o[0], o[1]); ov.y = pk2(o[2], o[3]); ov.z = pk2(o[4], o[5]); ov.w = pk2(o[6], o[7]);
            *(u32x4*)(MX + (size_t)row * 4096 + c) = ov;
        }
    }
}

__device__ __forceinline__ void phase_act(const Params& p, int l) {
    int tid = threadIdx.x; asm volatile("" : "+v"(tid));
    const bf16_t* PR = (const bf16_t*)(p.ws + WS_PROJ); bf16_t* ACT = (bf16_t*)(p.ws + WS_ACT);
    const float* cw = p.in[32 + p.z] + (size_t)l * 3 * DFF; const float* cbv = p.in[33 + p.z] + (size_t)l * DFF;
    const float* st = p.in[8 + p.z] + (size_t)l * 128 * 2 * DFF;
    const int total = (MT / 4) * 704;
    for (int idx = blockIdx.x * 512 + tid; idx < total; idx += gridDim.x * 512) {
        const int rb = idx / 704, c = (idx - rb * 704) * 8, r0 = rb * 4;
        int sample, b, t0, L; seq_of_row(r0, sample, b, t0, L);
        u32x4 gr[6], ur[4];
#pragma unroll
        for (int i = 0; i < 4; ++i) { gr[i + 2] = *(const u32x4*)(PR + (size_t)(r0 + i) * LDU + c); ur[i] = __builtin_nontemporal_load((const u32x4*)(PR + (size_t)(r0 + i) * LDU + DFF + c)); }
        float g[6][8];
        if (t0 >= 2) { gr[0] = *(const u32x4*)(PR + (size_t)(r0 - 2) * LDU + c); gr[1] = *(const u32x4*)(PR + (size_t)(r0 - 1) * LDU + c); unpack8(gr[0], g[0]); unpack8(gr[1], g[1]); }
        else {
#pragma unroll
            for (int j = 0; j < 8; ++j) { g[0][j] = sample ? st[((size_t)b * 2 + 0) * DFF + c + j] : 0.f; g[1][j] = sample ? st[((size_t)b * 2 + 1) * DFF + c + j] : 0.f; }
        }
#pragma unroll
        for (int i = 0; i < 4; ++i) unpack8(gr[i + 2], g[i + 2]);
        float w0[8], w1[8], w2[8], bb[8];
#pragma unroll
        for (int j = 0; j < 8; ++j) { w0[j] = cw[c + j]; w1[j] = cw[DFF + c + j]; w2[j] = cw[2 * DFF + c + j]; bb[j] = cbv[c + j]; }
#pragma unroll
        for (int i = 0; i < 4; ++i) {
            float uu[8], o[8]; unpack8(ur[i], uu);
#pragma unroll
            for (int j = 0; j < 8; ++j) o[j] = silu(bb[j] + w0[j] * g[i][j] + w1[j] * g[i + 1][j] + w2[j] * g[i + 2][j]) * uu[j];
            u32x4 ov; ov.x = pk2(o[0], o[1]); ov.y = pk2(o[2], o[3]); ov.z = pk2(o[4], o[5]); ov.w = pk2(o[6], o[7]);
            *(u32x4*)(ACT + (size_t)(r0 + i) * DFF + c) = ov;
        }
        if (t0 + 4 == L) {
#pragma unroll
            for (int i = 0; i < 2; ++i) {
                float* dst = p.out + (sample ? O_FCS + (((size_t)l * 128 + b) * 2 + i) * DFF : O_FCP + (((size_t)l * 4 + b) * 2 + i) * DFF) + c;
                *(f32x4*)dst = (f32x4){g[4 + i][0], g[4 + i][1], g[4 + i][2], g[4 + i][3]}; *(f32x4*)(dst + 4) = (f32x4){g[4 + i][4], g[4 + i][5], g[4 + i][6], g[4 + i][7]};
            }
        }
    }
}

__device__ __forceinline__ void phase_lruconv(const Params& p) {
    int tid = threadIdx.x; asm volatile("" : "+v"(tid));
    const bf16_t* PR = (const bf16_t*)(p.ws + WS_PROJ); bf16_t* XR = (bf16_t*)(p.ws + WS_XR);
    const float* cw = p.in[23 + p.z]; const float* cbv = p.in[24 + p.z]; const float* st = p.in[7 + p.z];
    const int total = (MT / 4) * 256;
    for (int idx = blockIdx.x * 512 + tid; idx < total; idx += gridDim.x * 512) {
        const int rb = idx >> 8, c = (idx & 255) * 8, r0 = rb * 4;
        int sample, b, t0, L; seq_of_row(r0, sample, b, t0, L);
        float x[7][8];
#pragma unroll
        for (int j = 3; j < 7; ++j) unpack8(*(const u32x4*)(PR + (size_t)(r0 - 3 + j) * LD1 + 8192 + c), x[j]);
        if (t0 >= 3) {
#pragma unroll
            for (int j = 0; j < 3; ++j) unpack8(*(const u32x4*)(PR + (size_t)(r0 - 3 + j) * LD1 + 8192 + c), x[j]);
        } else {
#pragma unroll
            for (int j = 0; j < 3; ++j)
#pragma unroll
                for (int i = 0; i < 8; ++i) x[j][i] = sample ? st[((size_t)b * 3 + j) * 2048 + c + i] : 0.f;
        }
        float w0[8], w1[8], w2[8], w3[8], bb[8];
#pragma unroll
        for (int i = 0; i < 8; ++i) { w0[i] = cw[c + i]; w1[i] = cw[2048 + c + i]; w2[i] = cw[4096 + c + i]; w3[i] = cw[6144 + c + i]; bb[i] = cbv[c + i]; }
#pragma unroll
        for (int rr = 0; rr < 4; ++rr) {
            float o[8];
#pragma unroll
            for (int i = 0; i < 8; ++i) o[i] = bb[i] + w0[i] * x[rr][i] + w1[i] * x[rr + 1][i] + w2[i] * x[rr + 2][i] + w3[i] * x[rr + 3][i];
            u32x4 ov; ov.x = pk2(o[0], o[1]); ov.y = pk2(o[2], o[3]); ov.z = pk2(o[4], o[5]); ov.w = pk2(o[6], o[7]);
            *(u32x4*)(XR + (size_t)(r0 + rr) * 2048 + c) = ov;
        }
        if (t0 + 4 == L) {
#pragma unroll
            for (int j = 0; j < 3; ++j) {
                float* dst = p.out + (sample ? O_LCS : O_LCP) + ((size_t)b * 3 + j) * 2048 + c;
                *(f32x4*)dst = (f32x4){x[4 + j][0], x[4 + j][1], x[4 + j][2], x[4 + j][3]}; *(f32x4*)(dst + 4) = (f32x4){x[4 + j][4], x[4 + j][5], x[4 + j][6], x[4 + j][7]};
            }
        }
    }
}

template <int NS>
__device__ __forceinline__ void finalize_sample_rows(const Params& p, float* ssdst) {
    int tid = threadIdx.x; asm volatile("" : "+v"(tid));
    float* X = (float*)(p.ws + WS_X); bf16_t* XB = (bf16_t*)(p.ws + WS_XB); const float* PT = (const float*)(p.ws + WS_PROJ);
    for (int item = blockIdx.x * 512 + tid; item < 512 * 512; item += gridDim.x * 512) {
        const int row = item >> 9, c4 = item & 511;
        const unsigned o = (unsigned)(MP + row) * 2048u + (unsigned)c4 * 4u, po = (unsigned)row * 2048u + (unsigned)c4 * 4u;
        f32x4 v = *(const f32x4*)(X + o);
        f32x4 pv[NS];
#pragma unroll
        for (int ks = 0; ks < NS; ++ks) pv[ks] = __builtin_nontemporal_load((const f32x4*)(PT + (size_t)ks * (512 * 2048) + po));
#pragma unroll
        for (int ks = 0; ks < NS; ++ks) v += pv[ks];
        *(f32x4*)(X + o) = v;
        u32x2 w; w.x = pk2(v[0], v[1]); w.y = pk2(v[2], v[3]);
        *(u32x2*)(XB + o) = w;
        float s2 = (v[0] * v[0] + v[1] * v[1]) + (v[2] * v[2] + v[3] * v[3]);
        s2 = wave_sum(s2);
        if ((tid & 63) == 0) atomicAdd(ssdst + MP + row, s2);
    }
}

__device__ __forceinline__ void phase_final(const Params& p) {
    int tid = threadIdx.x; asm volatile("" : "+v"(tid));
    const int wave = tid >> 6, lane = tid & 63;
    const int gw = blockIdx.x * 8 + wave, NGW = gridDim.x * 8;
    const float* X = (const float*)(p.ws + WS_X); const float* nf = p.in[11 + p.z];
    f32x4 nv[8];
    auto ldrow = [&](int row) {
#pragma unroll
        for (int j = 0; j < 8; ++j) nv[j] = __builtin_nontemporal_load((const f32x4*)(X + (size_t)row * 2048 + (lane + 64 * j) * 4));
    };
    if (gw < MT) ldrow(gw);
    for (int row = gw; row < MT; row += NGW) {
        f32x4 v[8]; float sq = 0.f;
#pragma unroll
        for (int j = 0; j < 8; ++j) v[j] = nv[j];
        if (row + NGW < MT) ldrow(row + NGW);
        if (row >= MP) {
#pragma unroll
            for (int j = 0; j < 8; ++j) {
                f32x4 pv[11];
#pragma unroll
                for (int ks = 0; ks < 11; ++ks) pv[ks] = *(const f32x4*)((const float*)(p.ws + WS_PROJ) + (size_t)ks * (512 * 2048) + (size_t)(row - MP) * 2048 + (lane + 64 * j) * 4);
#pragma unroll
                for (int ks = 0; ks < 11; ++ks) v[j] += pv[ks];
            }
        }
#pragma unroll
        for (int j = 0; j < 8; ++j) sq += (v[j][0] * v[j][0] + v[j][1] * v[j][1]) + (v[j][2] * v[j][2] + v[j][3] * v[j][3]);
        sq = wave_sum(sq);
        const float rs = rsqrtf(sq * (1.0f / 2048.0f) + EPS);
        float* dst = p.out + (row < MP ? O_YP + (size_t)row * 2048 : O_YS + (size_t)(row - MP) * 2048);
#pragma unroll
        for (int j = 0; j < 8; ++j) {
            const int c = (lane + 64 * j) * 4;
            __builtin_nontemporal_store(v[j] * rs * *(const f32x4*)(nf + c), (f32x4*)(dst + c));
        }
    }
}

#define XB_TMO      128
#define XB_XCNT(j)  (256  + 64 * (j))
#define XB_XSUB(j)  (1280 + 64 * (j))
#define XB_XGEN(j)  (2304 + 64 * (j))
#define XB_TOP      3328
#define XB_TOPGEN   3392
#define XCD_BAR_WORDS 3456
#define XB_SPIN_CAP (1u << 22)
__device__ __forceinline__ unsigned xb_ld(unsigned* p)              { return __hip_atomic_load(p, __ATOMIC_RELAXED, __HIP_MEMORY_SCOPE_AGENT); }
__device__ __forceinline__ unsigned xb_add(unsigned* p, unsigned v) { return __hip_atomic_fetch_add(p, v, __ATOMIC_RELAXED, __HIP_MEMORY_SCOPE_AGENT); }
__device__ __forceinline__ unsigned xb_xcc_id() { return (unsigned)__builtin_amdgcn_s_getreg((3 << 11) | 20) & 0xFu; }
#define XB_SPIN(cond, bar) do { unsigned _sp = 0; while (cond) { __builtin_amdgcn_s_sleep(1); \
    if ((++_sp & 255u) == 0u) { if (xb_ld(&(bar)[XB_TMO])) break; if (_sp > XB_SPIN_CAP) { atomicAdd(&(bar)[XB_TMO], 1u); break; } } } } while (0)
struct XcdBarrier { unsigned* bar; unsigned x; volatile LAS unsigned* st; };
__device__ __forceinline__ XcdBarrier xcd_barrier_post(unsigned* bar, volatile LAS unsigned* st) {
    XcdBarrier b; b.bar = bar; b.x = xb_xcc_id(); b.st = st;
    if (threadIdx.x == 0) (void)xb_add(&bar[XB_XCNT(b.x)], 1u);
    return b;
}
__device__ __forceinline__ void xcd_barrier_complete(unsigned* bar, unsigned x, unsigned& nloc, unsigned& nx) {
    const unsigned G = gridDim.x * gridDim.y * gridDim.z;
    unsigned sum, cnt, mine, sp = 0u;
    for (;;) {
        sum = 0u; cnt = 0u; mine = 0u;
#pragma unroll
        for (unsigned j = 0; j < 16; ++j) { const unsigned c = xb_ld(&bar[XB_XCNT(j)]); sum += c; cnt += (c > 0u) ? 1u : 0u; mine = (j == x) ? c : mine; }
        if (sum == G) break;
        __builtin_amdgcn_s_sleep(1);
        if ((++sp & 255u) == 0u) { if (xb_ld(&bar[XB_TMO])) break; if (sp > XB_SPIN_CAP) { atomicAdd(&bar[XB_TMO], 1u); break; } }
    }
    nloc = mine > 0u ? mine : 1u; nx = cnt > 0u ? cnt : 1u;
}
__device__ __forceinline__ void xcd_barrier(const XcdBarrier& b) {
    asm volatile("s_waitcnt vmcnt(0)" ::: "memory");
    __syncthreads();
    if (threadIdx.x == 0) {
        unsigned* bar = b.bar;
        __builtin_amdgcn_s_waitcnt(0);
        unsigned nloc = b.st[0], nx = b.st[1];
        if (nloc == 0u) { xcd_barrier_complete(bar, b.x, nloc, nx); b.st[0] = nloc; b.st[1] = nx; }
        const unsigned old = xb_add(&bar[XB_XSUB(b.x)], 1u);
        const unsigned gen = old / nloc;
        if (old + 1u == (gen + 1u) * nloc) {
            __builtin_amdgcn_fence(__ATOMIC_RELEASE, "agent");
            asm volatile("s_waitcnt vmcnt(0)" ::: "memory");
            const unsigned og = xb_add(&bar[XB_TOP], 1u);
            const unsigned tg = og / nx;
            if (og + 1u == (tg + 1u) * nx) xb_add(&bar[XB_TOPGEN], 1u);
            else XB_SPIN(xb_ld(&bar[XB_TOPGEN]) == tg, bar);
            __builtin_amdgcn_fence(__ATOMIC_ACQUIRE, "agent");
            xb_add(&bar[XB_XGEN(b.x)], 1u);
            asm volatile("s_waitcnt vmcnt(0)" ::: "memory");
        } else {
            XB_SPIN(xb_ld(&bar[XB_XGEN(b.x)]) == gen, bar);
            __builtin_amdgcn_fence(__ATOMIC_ACQUIRE, "agent");
            asm volatile("s_waitcnt vmcnt(0)" ::: "memory");
        }
    }
    __syncthreads();
}

#ifndef PROBE_MASK
#define PROBE_MASK 0u
#endif
#ifndef PHMASK
#define PHMASK 0xFFFFFFFFu
#endif
#define EN(i) (((PHMASK) >> (i)) & 1u)
__global__ void __launch_bounds__(512, 2) fwd_megakernel(Params p) {
    extern __shared__ __attribute__((aligned(16))) unsigned char shm[];
    float* ldsf = (float*)shm;
    LAS unsigned char* ldsg = (LAS unsigned char*)shm;
    unsigned char* ws = p.ws;
    float* ssb = (float*)(ws + WS_SS);
    volatile LAS unsigned* xst = (volatile LAS unsigned*)(ldsg + 133120);
    if (threadIdx.x == 0) { xst[0] = 0u; xst[1] = 0u; }
    __syncthreads();
    (void)xcd_barrier_post((unsigned*)(ws + WS_CTL) + 256, xst);
#define XBAR() do { XcdBarrier _b; _b.bar = (unsigned*)(p.ws + WS_CTL) + 256; _b.x = xb_xcc_id(); _b.st = (volatile LAS unsigned*)((LAS unsigned char*)shm + 133120); xcd_barrier(_b); } while (0)
#if PROBE_MASK
    unsigned long long tph = __builtin_amdgcn_s_memrealtime();
#endif
    for (int ph = p.ph_lo; ph < p.ph_hi; ++ph) {
        if (ph > p.ph_lo) {
            if (ph == 1) cg::this_grid().sync();
            else XBAR();
#if PROBE_MASK
            {
                const unsigned long long t1 = __builtin_amdgcn_s_memrealtime();
                if ((PROBE_MASK >> (ph - 1)) & 1u) { const unsigned long long dt = t1 - tph; while (__builtin_amdgcn_s_memrealtime() - t1 < dt) __builtin_amdgcn_s_sleep(8); }
                tph = __builtin_amdgcn_s_memrealtime();
            }
#endif
        }
        if (EN(0) && ph == 0) phase_prologue(p, ldsf);
        else if (EN(1) && (ph == 1 || ph == 5 || ph == 8 || ph == 14)) {
            pg8::Gemm g; pg8::EpiScaleBf16 E; int N;
            if (ph != 1) { float* sd = ssb + (ph == 5 ? 1 : (ph == 8 ? 2 : 3)) * MT; if (ph == 8) finalize_sample_rows<11>(p, sd); else finalize_sample_rows<16>(p, sd); XBAR(); }
            g.A = (const char*)(ws + WS_XB); g.lda = 2048; g.ldb = 2048;
            if (ph == 1) { g.Bt = (const char*)(ws + WS_WIN0); N = LD0; E.ss = ssb; }
            else if (ph == 5) { g.Bt = (const char*)(ws + WS_WUP0); N = LDU; E.ss = ssb + MT; }
            else if (ph == 8) { g.Bt = (const char*)(ws + WS_WIN1); N = LD1; E.ss = ssb + 2 * MT; }
            else { g.Bt = (const char*)(ws + WS_WUP1); N = LDU; E.ss = ssb + 3 * MT; }
            E.O = (bf16_t*)(ws + WS_PROJ); E.ldc = N;
            pg8::Order S; S.nMm = 32; S.nN = N / 256; S.n_main = 32 * S.nN; S.n_tail = 2 * S.nN; S.ksplit = 1; S.nt_full = 32; S.G = gridDim.x; S.c = blockIdx.x;
            S.a_t = (size_t)256 * 2048 * 2; S.b_t = (size_t)256 * 2048 * 2; S.acol = 0;
            pg8::gemm_phase<pg8::EpiScaleBf16>(ldsg, g, S, E);
        }
        else if (EN(4) && (ph == 4 || ph == 7 || ph == 13 || ph == 16)) {
            pg8::Gemm g; pg8::EpiResid E;
            g.A = (const char*)(ws + WS_ACT);
            if (ph == 4) { g.Bt = (const char*)(ws + WS_WOUT0); g.lda = 4096; E.ssout = ssb + MT; }
            else if (ph == 7) { g.Bt = (const char*)(ws + WS_WDN0); g.lda = DFF; E.ssout = ssb + 2 * MT; }
            else if (ph == 13) { g.Bt = (const char*)(ws + WS_WOUT1); g.lda = 4096; E.ssout = ssb + 3 * MT; }
            else { g.Bt = (const char*)(ws + WS_WDN1); g.lda = DFF; E.ssout = ssb + 4 * MT; }
            g.ldb = g.lda;
            E.X = (float*)(ws + WS_X); E.XB = (bf16_t*)(ws + WS_XB); E.part = (float*)(ws + WS_PROJ);
            pg8::Order S; S.nMm = 32; S.nN = 8; S.n_main = 256; S.nt_full = g.lda / 64; S.ksplit = (g.lda == 4096) ? 16 : 11; S.n_tail = 16 * S.ksplit; S.G = gridDim.x; S.c = blockIdx.x;
            S.a_t = (size_t)256 * g.lda * 2; S.b_t = (size_t)256 * g.ldb * 2; S.acol = 0;
            pg8::gemm_phase<pg8::EpiResid>(ldsg, g, S, E);
        }
        else if (EN(10) && ph == 10) {
            pg8::Gemm g; pg8::EpiLru E;
            g.A = (const char*)(ws + WS_XR); g.Bt = (const char*)(ws + WS_WLRU); g.lda = 2048; g.ldb = 256;
            E.br = p.in[26 + p.z]; E.bi = p.in[28 + p.z]; E.sp = (const float*)(ws + WS_SP); E.XR = (const bf16_t*)(ws + WS_XR);
            E.LA = (float*)(ws + WS_LA); E.LBv = (bf16_t*)(ws + WS_LBB);
            pg8::Order S; S.nMm = 34; S.nN = 16; S.n_main = 34 * 16; S.n_tail = 0; S.ksplit = 1; S.nt_full = 4 + p.z; S.G = gridDim.x; S.c = blockIdx.x;
            S.a_t = (size_t)256 * 2048 * 2; S.b_t = (size_t)256 * 256 * 2; S.acol = 512;
            pg8::gemm_phase<pg8::EpiLru>(ldsg, g, S, E);
        }
        else if (EN(2) && ph == 2) phase_rec0(p, ldsf);
        else if (EN(3) && ph == 3) phase_prep0(p);
        else if (EN(6) && ph == 6) phase_act(p, 0);
        else if (EN(9) && ph == 9) phase_lruconv(p);
        else if (EN(11) && ph == 11) phase_rec1(p, ldsf);
        else if (EN(12) && ph == 12) phase_prep1(p);
        else if (EN(15) && ph == 15) phase_act(p, 1);
        else if (EN(17) && ph == 17) phase_final(p);
    }
}

#ifndef N_LAUNCH_MODE
#define N_LAUNCH_MODE 0
#endif

extern "C" void kernel_launch(void* const* d_in, const int* in_sizes, int n_in, void* d_out, int out_size, void* d_ws, size_t ws_size, hipStream_t stream) {
    static int grid = 0;
    if (grid == 0) {
        if (n_in != 35 || (size_t)out_size != O_END || ws_size < WS_END) { fprintf(stderr, "kernel_launch: unexpected shapes: n_in %d out %d ws %zu (need %zu)\n", n_in, out_size, ws_size, (size_t)WS_END); grid = -1; return; }
        int dev = 0, cus = 0, per_cu = 0;
        hipGetDevice(&dev);
        hipDeviceGetAttribute(&cus, hipDeviceAttributeMultiprocessorCount, dev);
        if (hipFuncSetAttribute((const void*)fwd_megakernel, hipFuncAttributeMaxDynamicSharedMemorySize, LDS_BYTES) != hipSuccess) { fprintf(stderr, "kernel_launch: hipFuncSetAttribute failed\n"); grid = -1; return; }
        if (hipOccupancyMaxActiveBlocksPerMultiprocessor(&per_cu, (const void*)fwd_megakernel, 512, LDS_BYTES) != hipSuccess || per_cu < 1) { fprintf(stderr, "kernel_launch: occupancy query says %d\n", per_cu); per_cu = 1; }
        (void)hipGetLastError();
        grid = cus;
    }
    if (grid < 0) return;
    (void)hipMemsetAsync((char*)d_ws + WS_CTL, 0, 16384, stream);
    Params p{};
    for (int i = 0; i < 35; ++i) p.in[i] = (const float*)d_in[i];
    p.z = 0; p.pad = 0;
    p.out = (float*)d_out; p.ws = (unsigned char*)d_ws;
#if N_LAUNCH_MODE == 0
    p.ph_lo = 0; p.ph_hi = NPHASE;
    void* args[] = {&p};
    hipError_t e = hipLaunchCooperativeKernel((const void*)fwd_megakernel, dim3(grid), dim3(512), args, LDS_BYTES, stream);
    if (e != hipSuccess) fprintf(stderr, "cooperative launch failed: %s (grid %d)\n", hipGetErrorString(e), grid);
#else
    for (int ph = 0; ph < NPHASE; ++ph) {
        p.ph_lo = ph; p.ph_hi = ph + 1;
        hipLaunchKernelGGL(fwd_megakernel, dim3(grid), dim3(512), LDS_BYTES, stream, p);
    }
#endif
}
```
